# Optimizing an MI355X kernel written in HIP

```python
import jax, jax.numpy as jnp
from jax import lax
import numpy as np


D_MODEL = 1024
BATCH = 16
SEQ = 4096
DEPTH = 2
DEC_BATCH = 2
DEC_SEQ = 16384
PAST_LEN = 128

GRID_W = 64
HEAD_DIM = 64
NA_HEADS = 8
RW_HEADS = 8
NA_WIDTH = NA_HEADS * HEAD_DIM
RW_WIDTH = RW_HEADS * HEAD_DIM
MIX_WIDTH = NA_WIDTH + RW_WIDTH
WIN_ROWS_MAX = 8
WIN_COLS = 16
DECAY_LORA = 64
AAA_LORA = 64
GATE_LORA = 128
N_DIR = 2
RW_COLS = 3 * RW_WIDTH + N_DIR * DECAY_LORA + N_DIR * AAA_LORA + GATE_LORA
PROJ_WIDTH = 3 * NA_WIDTH + RW_COLS
D_FF = 2816
PLE_DIM = 256
NORM_EPS = 1e-6
LNX_EPS = 64e-5
DECAY_SCALE = 0.606531

kernel_name = 'hybrid_natten_rwkv7_encoder'


def rms_norm(x, g):
    xf = x.astype(jnp.float32)
    y = xf * lax.rsqrt(jnp.mean(xf * xf, axis=-1, keepdims=True) + NORM_EPS)
    return (y * g.astype(jnp.float32)).astype(x.dtype)


def swiglu(x, wg, wu, wd):
    return (jax.nn.silu(x @ wg) * (x @ wu)) @ wd


def centred_shift_delta(u):
    prev = jnp.pad(u[:, :-1], ((0, 0), (1, 0), (0, 0)))
    nxt = jnp.pad(u[:, 1:], ((0, 0), (0, 1), (0, 0)))
    return 0.5 * (prev + nxt) - u


def neighbourhood_attention(q, k, v, rpb):
    B, T, _ = q.shape
    rows = T // GRID_W
    wr = min(WIN_ROWS_MAX, rows)
    scale = HEAD_DIM ** -0.5

    def grid(z):
        return z.reshape(B, rows, GRID_W, NA_HEADS, HEAD_DIM)

    qg = grid(q * scale)
    kg = grid(k)
    vg = grid(v)
    col = jnp.arange(GRID_W)
    col_start = jnp.clip(col - WIN_COLS // 2, 0, GRID_W - WIN_COLS)
    col_idx = col_start[:, None] + jnp.arange(WIN_COLS)[None, :]
    col_bias_idx = col_idx - col[:, None] + (WIN_COLS - 1)

    def one_row(args):
        i, q_row = args
        row_start = jnp.clip(i - wr // 2, 0, rows - wr)
        k_rows = lax.dynamic_slice_in_dim(kg, row_start, wr, axis=1)
        v_rows = lax.dynamic_slice_in_dim(vg, row_start, wr, axis=1)
        k_win = k_rows[:, :, col_idx]
        v_win = v_rows[:, :, col_idx]
        row_bias_idx = row_start + jnp.arange(wr) - i + (WIN_ROWS_MAX - 1)
        bias = rpb[:, row_bias_idx[:, None, None], col_bias_idx[None, :, :]]
        s = jnp.einsum('bjhd,bajchd->bhjac', q_row, k_win).astype(jnp.float32)
        s = s + jnp.transpose(bias, (0, 2, 1, 3)).astype(jnp.float32)[None]
        p = jax.nn.softmax(s.reshape(B, NA_HEADS, GRID_W, wr * WIN_COLS), axis=-1)
        p = p.reshape(B, NA_HEADS, GRID_W, wr, WIN_COLS).astype(v.dtype)
        return jnp.einsum('bhjac,bajchd->bjhd', p, v_win)

    o = lax.map(one_row, (jnp.arange(rows), jnp.moveaxis(qg, 1, 0)))
    return jnp.moveaxis(o, 0, 1).reshape(B, T, NA_WIDTH)


def wkv7_scan(r, w, k, v, a, b, reverse):
    T, B, H, N = r.shape

    def step(S, inp):
        r_t, w_t, k_t, v_t, a_t, b_t = inp
        sa = jnp.einsum('bhvk,bhk->bhv', S, a_t)
        S = S * w_t[:, :, None, :] + sa[..., None] * b_t[:, :, None, :] + v_t[..., None] * k_t[:, :, None, :]
        y = jnp.einsum('bhvk,bhk->bhv', S, r_t)
        return S, y

    S0 = jnp.zeros((B, H, N, N), jnp.float32)
    _, y = lax.scan(step, S0, (r, w, k, v, a, b), reverse=reverse)
    return y


def rwkv7_bidirectional(u, mu, w0, w_up, a0, a_up, g_up, k_k, k_a, r_k, lnx_w, lnx_b):
    B, T, _ = u.shape
    out_dtype = u.dtype
    u = (u + mu * centred_shift_delta(u)).astype(jnp.float32)
    r = u[..., 0:RW_WIDTH]
    k = u[..., RW_WIDTH:2 * RW_WIDTH]
    v = u[..., 2 * RW_WIDTH:3 * RW_WIDTH]
    lo = 3 * RW_WIDTH
    w_low = [u[..., lo + d * DECAY_LORA:lo + (d + 1) * DECAY_LORA] for d in range(N_DIR)]
    lo = lo + N_DIR * DECAY_LORA
    a_low = [u[..., lo + d * AAA_LORA:lo + (d + 1) * AAA_LORA] for d in range(N_DIR)]
    lo = lo + N_DIR * AAA_LORA
    g_low = u[..., lo:lo + GATE_LORA]

    def heads(z):
        return z.reshape(B, T, RW_HEADS, HEAD_DIM)

    def tmajor(z):
        return jnp.swapaxes(z, 0, 1)

    g = jax.nn.sigmoid(g_low) @ g_up.astype(jnp.float32)
    kk = heads(k * k_k)
    kk = kk / jnp.maximum(jnp.sqrt(jnp.sum(kk * kk, axis=-1, keepdims=True)), 1e-12)
    rh = heads(r)
    vh = heads(v)
    wkv = None
    bonus = None
    for d in range(N_DIR):
        z = w0[d] + jnp.tanh(w_low[d]) @ w_up[d]
        w = jnp.exp(-DECAY_SCALE * jax.nn.sigmoid(z.astype(jnp.float32)))
        a = jax.nn.sigmoid((a0[d] + a_low[d] @ a_up[d]).astype(jnp.float32))
        kd = heads(k * (1.0 + (a - 1.0) * k_a))
        ah = heads(a)
        y = wkv7_scan(tmajor(rh), tmajor(heads(w)), tmajor(kd), tmajor(vh), tmajor(-kk), tmajor(kk * ah), reverse=(d == 1))
        y = tmajor(y)
        bd = jnp.sum(rh * kd * r_k, axis=-1, keepdims=True) * vh
        wkv = y if wkv is None else wkv + y
        bonus = bd if bonus is None else bonus + bd
    mean = jnp.mean(wkv, axis=-1, keepdims=True)
    var = jnp.mean(jnp.square(wkv - mean), axis=-1, keepdims=True)
    yn = ((wkv - mean) * lax.rsqrt(var + LNX_EPS)).reshape(B, T, RW_WIDTH) * lnx_w + lnx_b
    out = (yn + bonus.reshape(B, T, RW_WIDTH)) * g
    return out.astype(out_dtype)


def encoder_trunk(x, p, w):
    h = x
    for i in range(DEPTH):
        h = h + 0.5 * swiglu(rms_norm(h, w['ffn1_norm'][i]), w['ffn1_wg'][i], w['ffn1_wu'][i], w['ffn1_wd'][i])
        n = rms_norm(h, w['mix_norm'][i])
        proj = n @ w['w_in'][i]
        q = proj[..., 0:NA_WIDTH]
        k = proj[..., NA_WIDTH:2 * NA_WIDTH]
        v = proj[..., 2 * NA_WIDTH:3 * NA_WIDTH]
        y_na = neighbourhood_attention(q, k, v, w['na_rpb'][i])
        y_rw = rwkv7_bidirectional(proj[..., 3 * NA_WIDTH:], w['rw_mu'][i], w['rw_w0'][i], w['rw_w_up'][i],
                                   w['rw_a0'][i], w['rw_a_up'][i], w['rw_g_up'][i], w['rw_k_k'][i],
                                   w['rw_k_a'][i], w['rw_r_k'][i], w['rw_lnx_w'][i], w['rw_lnx_b'][i])
        h = h + jnp.concatenate([y_na, y_rw], axis=-1) @ w['w_out'][i]
        h = h + 0.5 * swiglu(rms_norm(h, w['ffn2_norm'][i]), w['ffn2_wg'][i], w['ffn2_wu'][i], w['ffn2_wd'][i])
        gate = jax.nn.sigmoid(rms_norm(h, w['ple_norm'][i]) @ w['ple_gate'][i])
        h = h + gate * (p[i] @ w['ple_up'][i])
    return rms_norm(h, w['final_norm'])


def setup_inputs(seed: int = 0) -> dict:
    key = jax.random.key(seed)
    ks = jax.random.split(key, 40)
    f32 = jnp.float32

    def nrm(k, shape, scale):
        return jax.random.normal(k, shape, f32) * scale

    L = DEPTH
    return {
        'x_prompt': nrm(ks[0], (BATCH, SEQ, D_MODEL), 1.0),
        'x_sample': nrm(ks[1], (DEC_BATCH, DEC_SEQ, D_MODEL), 1.0),
        'p_prompt': nrm(ks[2], (DEPTH, BATCH, SEQ, PLE_DIM), 1.0),
        'p_sample': nrm(ks[3], (DEPTH, DEC_BATCH, DEC_SEQ, PLE_DIM), 1.0),
        'ffn1_norm': 1.0 + nrm(ks[4], (L, D_MODEL), 0.05),
        'ffn1_wg': nrm(ks[5], (L, D_MODEL, D_FF), D_MODEL ** -0.5),
        'ffn1_wu': nrm(ks[6], (L, D_MODEL, D_FF), D_MODEL ** -0.5),
        'ffn1_wd': nrm(ks[7], (L, D_FF, D_MODEL), D_FF ** -0.5),
        'mix_norm': 1.0 + nrm(ks[8], (L, D_MODEL), 0.05),
        'w_in': nrm(ks[9], (L, D_MODEL, PROJ_WIDTH), D_MODEL ** -0.5),
        'na_rpb': nrm(ks[10], (L, NA_HEADS, 2 * WIN_ROWS_MAX - 1, 2 * WIN_COLS - 1), 0.5),
        'rw_mu': jax.random.uniform(ks[11], (L, RW_COLS), f32),
        'rw_w0': -1.0 + nrm(ks[12], (L, N_DIR, RW_WIDTH), 1.5),
        'rw_w_up': nrm(ks[13], (L, N_DIR, DECAY_LORA, RW_WIDTH), 0.5 * DECAY_LORA ** -0.5),
        'rw_a0': nrm(ks[14], (L, N_DIR, RW_WIDTH), 0.5),
        'rw_a_up': nrm(ks[15], (L, N_DIR, AAA_LORA, RW_WIDTH), 0.5 * AAA_LORA ** -0.5),
        'rw_g_up': nrm(ks[16], (L, GATE_LORA, RW_WIDTH), GATE_LORA ** -0.5),
        'rw_k_k': 0.85 + nrm(ks[17], (L, RW_WIDTH), 0.05),
        'rw_k_a': 1.0 + nrm(ks[18], (L, RW_WIDTH), 0.05),
        'rw_r_k': nrm(ks[19], (L, RW_HEADS, HEAD_DIM), 0.1),
        'rw_lnx_w': 1.0 + nrm(ks[20], (L, RW_WIDTH), 0.05),
        'rw_lnx_b': nrm(ks[21], (L, RW_WIDTH), 0.01),
        'w_out': nrm(ks[22], (L, MIX_WIDTH, D_MODEL), MIX_WIDTH ** -0.5),
        'ffn2_norm': 1.0 + nrm(ks[23], (L, D_MODEL), 0.05),
        'ffn2_wg': nrm(ks[24], (L, D_MODEL, D_FF), D_MODEL ** -0.5),
        'ffn2_wu': nrm(ks[25], (L, D_MODEL, D_FF), D_MODEL ** -0.5),
        'ffn2_wd': nrm(ks[26], (L, D_FF, D_MODEL), D_FF ** -0.5),
        'ple_norm': 1.0 + nrm(ks[27], (L, D_MODEL), 0.05),
        'ple_gate': nrm(ks[28], (L, D_MODEL, D_MODEL), D_MODEL ** -0.5),
        'ple_up': nrm(ks[29], (L, PLE_DIM, D_MODEL), PLE_DIM ** -0.5),
        'final_norm': 1.0 + nrm(ks[30], (D_MODEL,), 0.05),
    }


def reference(x_prompt, x_sample, p_prompt, p_sample, ffn1_norm, ffn1_wg, ffn1_wu, ffn1_wd, mix_norm, w_in,
              na_rpb, rw_mu, rw_w0, rw_w_up, rw_a0, rw_a_up, rw_g_up, rw_k_k, rw_k_a, rw_r_k, rw_lnx_w,
              rw_lnx_b, w_out, ffn2_norm, ffn2_wg, ffn2_wu, ffn2_wd, ple_norm, ple_gate, ple_up, final_norm):
    weights = dict(ffn1_norm=ffn1_norm, ffn1_wg=ffn1_wg, ffn1_wu=ffn1_wu, ffn1_wd=ffn1_wd, mix_norm=mix_norm,
                   w_in=w_in, na_rpb=na_rpb, rw_mu=rw_mu, rw_w0=rw_w0, rw_w_up=rw_w_up, rw_a0=rw_a0,
                   rw_a_up=rw_a_up, rw_g_up=rw_g_up, rw_k_k=rw_k_k, rw_k_a=rw_k_a, rw_r_k=rw_r_k,
                   rw_lnx_w=rw_lnx_w, rw_lnx_b=rw_lnx_b, w_out=w_out, ffn2_norm=ffn2_norm, ffn2_wg=ffn2_wg,
                   ffn2_wu=ffn2_wu, ffn2_wd=ffn2_wd, ple_norm=ple_norm, ple_gate=ple_gate, ple_up=ple_up,
                   final_norm=final_norm)
    y_prompt = encoder_trunk(x_prompt, p_prompt, weights)
    y_sample = encoder_trunk(x_sample, p_sample, weights)
    return (y_prompt, y_sample)
```

```cpp
#include <hip/hip_runtime.h>
#include <hip/hip_cooperative_groups.h>
#include <cstdio>
#include <cstdint>
namespace cg = cooperative_groups;
#ifndef PHM
#define PHM 0xFFFF
#endif
#define PH(k) ((PHM >> (k)) & 1)

#define LAS __attribute__((address_space(3)))
typedef _Float16 h16;
typedef _Float16 h16x2 __attribute__((ext_vector_type(2)));
typedef _Float16 h16x4 __attribute__((ext_vector_type(4)));
typedef _Float16 h16x8 __attribute__((ext_vector_type(8)));
typedef float f32x2 __attribute__((ext_vector_type(2)));
typedef float f32x4 __attribute__((ext_vector_type(4)));
typedef unsigned u32x2 __attribute__((ext_vector_type(2)));
typedef unsigned u32x4 __attribute__((ext_vector_type(4)));
typedef unsigned u32x4a __attribute__((ext_vector_type(4), may_alias));

constexpr int D = 1024, FF = 2816, MP = 65536, MS = 32768, M = MP + MS, TP = 4096, TS = 16384, PLE = 256;
constexpr int NPROJ = 3584;
constexpr int NTHREADS = 512, NWAVES = 8;
constexpr int LDS_BYTES = 147456;
constexpr size_t MiB = 1u << 20;
constexpr size_t WS_W = 1 * MiB;
constexpr size_t WS_SSA = 46 * MiB;
constexpr size_t WS_H16 = 52 * MiB;
constexpr size_t WS_MIX = 244 * MiB;
constexpr size_t WS_KNA = 436 * MiB, WS_VNA = 532 * MiB, WS_RR = 628 * MiB, WS_RK = 724 * MiB, WS_RV = 820 * MiB;
constexpr size_t WS_LOWS = 916 * MiB;
constexpr size_t WS_ACT = 244 * MiB;
constexpr size_t WS_P16 = 772 * MiB;
constexpr size_t WS_PU = 244 * MiB;
constexpr size_t WS_H16B = 772 * MiB;
constexpr size_t WS_YB = WS_H16;
constexpr size_t WS_BSC = WS_H16 + 96 * MiB;
constexpr size_t WS_SSB = 1012 * MiB;
constexpr size_t WS_END = 1018 * MiB;
constexpr size_t W_FFN1U = 0;
constexpr size_t W_FFN1D = W_FFN1U + (size_t)5632 * 1024;
constexpr size_t W_IN = W_FFN1D + (size_t)1024 * 2816;
constexpr size_t W_OUT = W_IN + (size_t)3584 * 1024;
constexpr size_t W_FFN2U = W_OUT + (size_t)1024 * 1024;
constexpr size_t W_FFN2D = W_FFN2U + (size_t)5632 * 1024;
constexpr size_t W_GATE = W_FFN2D + (size_t)1024 * 2816;
constexpr size_t W_UP = W_GATE + (size_t)1024 * 1024;
constexpr size_t W_ENDE = W_UP + (size_t)1024 * 256;
static_assert(WS_W + W_ENDE * 2 <= WS_SSA, "weights fit");

enum { I_XP = 0, I_XS, I_PP, I_PS, I_F1N, I_F1G, I_F1U, I_F1D, I_MIXN, I_WIN, I_RPB, I_MU, I_W0, I_WUP, I_A0, I_AUP, I_GUP, I_KK, I_KA, I_RK, I_LNW, I_LNB,
       I_WOUT, I_F2N, I_F2G, I_F2U, I_F2D, I_PLEN, I_PLEG, I_PLEU, I_FINAL, N_IN };
struct Args { const float* in[N_IN]; float* out; unsigned char* ws; };

__device__ __forceinline__ float wave_sum(float v) {
#pragma unroll
    for (int o = 1; o < 64; o <<= 1) v += __shfl_xor(v, o);
    return v;
}
__device__ __forceinline__ unsigned pk2h(float a, float b) { h16x2 p = {(h16)a, (h16)b}; return __builtin_bit_cast(unsigned, p); }
__device__ __forceinline__ h16x2 as_h2(unsigned u) { return __builtin_bit_cast(h16x2, u); }
__device__ __forceinline__ float dot2h(unsigned a, h16x2 b, float c) { return __builtin_amdgcn_fdot2(as_h2(a), b, c, false); }
__device__ __forceinline__ float dot8(u32x4 a, u32x4 b, float c) { const unsigned a0 = a[0], a1 = a[1], a2 = a[2], a3 = a[3], b0 = b[0], b1 = b[1], b2 = b[2], b3 = b[3];
    c = __builtin_amdgcn_fdot2(as_h2(a0), as_h2(b0), c, false); c = __builtin_amdgcn_fdot2(as_h2(a1), as_h2(b1), c, false); c = __builtin_amdgcn_fdot2(as_h2(a2), as_h2(b2), c, false); c = __builtin_amdgcn_fdot2(as_h2(a3), as_h2(b3), c, false); return c; }
__device__ __forceinline__ float dot8w(u32x4 a, h16x2 w0, h16x2 w1, h16x2 w2, h16x2 w3, float c) { const unsigned a0 = a[0], a1 = a[1], a2 = a[2], a3 = a[3];
    c = __builtin_amdgcn_fdot2(as_h2(a0), w0, c, false); c = __builtin_amdgcn_fdot2(as_h2(a1), w1, c, false); c = __builtin_amdgcn_fdot2(as_h2(a2), w2, c, false); c = __builtin_amdgcn_fdot2(as_h2(a3), w3, c, false); return c; }
__device__ __forceinline__ float fma_mix_lo(float p, unsigned v, float o) { asm("v_fma_mix_f32 %0, %1, %2, %0 op_sel_hi:[0,1,0]" : "+v"(o) : "v"(p), "v"(v)); return o; }
__device__ __forceinline__ float fma_mix_hi(float p, unsigned v, float o) { asm("v_fma_mix_f32 %0, %1, %2, %0 op_sel:[0,1,0] op_sel_hi:[0,1,0]" : "+v"(o) : "v"(p), "v"(v)); return o; }
__device__ __forceinline__ float sigmoidf_(float x) { return __builtin_amdgcn_rcpf(1.0f + __expf(-x)); }
__device__ __forceinline__ float row_rstd(const float* ss, int row) {
    const f32x4* p = (const f32x4*)(ss + (size_t)row * 16);
    const f32x4 a = p[0], b = p[1], c = p[2], d = p[3];
    const float s = ((a.x + a.y) + (a.z + a.w)) + ((b.x + b.y) + (b.z + b.w)) + ((c.x + c.y) + (c.z + c.w)) + ((d.x + d.y) + (d.z + d.w));
    return __builtin_amdgcn_rsqf(s * (1.0f / 1024.0f) + 1e-6f);
}
template <int CTRL> __device__ __forceinline__ float dpp_f(float v) { return __builtin_bit_cast(float, __builtin_amdgcn_update_dpp(0, __builtin_bit_cast(int, v), CTRL, 0xF, 0xF, true)); }
__device__ __forceinline__ float row16_sum(float v) {
    v += dpp_f<0xB1>(v);
    v += dpp_f<0x4E>(v);
    v += dpp_f<0x141>(v);
    v += dpp_f<0x140>(v);
    return v;
}
__device__ __forceinline__ void grid_sync(cg::grid_group& grid) {
    asm volatile("s_waitcnt vmcnt(0) lgkmcnt(0)" ::: "memory"); grid.sync();
    __builtin_amdgcn_fence(__ATOMIC_ACQUIRE, "agent"); asm volatile("s_waitcnt vmcnt(0)" ::: "memory"); }

namespace pg8 {
constexpr int BM = 256, BK = 64, HALF = 128, HTB = HALF * BK * 2, STAGE_BYTES = 8 * HTB, NXCD = 8, WGM = 8;
__host__ __device__ __forceinline__ int lds_byte(int r, int c) { const int st = (r >> 4) * 2 + (c >> 5), rr = r & 15, cc = c & 31, ob = rr * 64 + cc * 2; return st * 1024 + (ob ^ (((ob >> 9) & 1) << 5)); }
__host__ __device__ __forceinline__ void stage_rc(int b, int& R, int& C) { const int st = b / 1024, sb = b % 1024, swz = sb ^ (((sb >> 9) & 1) << 5); R = (st >> 1) * 16 + swz / 64; C = (st & 1) * 32 + (swz % 64) / 2; }
__host__ __device__ __forceinline__ int perm32(int rho) { const int n = rho >> 4, i = rho & 15; return 8 * (i >> 2) + 4 * n + (i & 3); }
struct Unit { int pm, pn; };
struct Gemm { const h16* A; const h16* Bt; int M, N, K, lda; };
struct StaticOrder {
    int nM, nN, nwg, G, c;
    __device__ void init(int M_, int N_, int G_, int c_) { nM = M_ / BM; nN = N_ / BM; nwg = nM * nN; G = G_; c = c_; }
    __device__ bool next(int i, Unit& u) const {
        const long L = (long)i * G + c; if (L >= nwg) return false;
        int wgid = (int)L; { const int q = nwg / NXCD, r = nwg % NXCD, xcd = wgid % NXCD, off = wgid / NXCD; wgid = (xcd < r ? xcd * (q + 1) : r * (q + 1) + (xcd - r) * q) + off; }
        const int nig = WGM * nN, gid = wgid / nig, fm = gid * WGM, gsz = (nM - fm) < WGM ? (nM - fm) : WGM;
        u.pm = fm + ((wgid % nig) % gsz); u.pn = (wgid % nig) / gsz; return true;
    }
};
typedef f32x4 Acc[2][2][4][2];

template <class Epi>
__device__ __forceinline__ void gemm_phase(LAS unsigned char* lds, const Gemm g, const StaticOrder& S, const Epi& E, const int tid) {
    const int wid = __builtin_amdgcn_readfirstlane(tid >> 6), lane = tid & 63, wr = wid >> 2, wc = wid & 3, fr = lane & 15, fq = lane >> 4;
    const int K = g.K, nt = K / BK, lda = g.lda;
    unsigned voffA[2], voffB[2];
#pragma unroll
    for (int i = 0; i < 2; ++i) { int R, C; stage_rc(tid * 16 + i * 8192, R, C); const int Rb = Epi::PERM ? ((R & ~31) + perm32(R & 31)) : R;
        voffA[i] = (unsigned)(R * lda + C) * 2u; voffB[i] = (unsigned)(Rb * K + C) * 2u; }
    const size_t kstep = (size_t)(BK * 2);
    const size_t hstepA = (size_t)HALF * lda * 2, hstepB = (size_t)HALF * K * 2;
    const size_t tstepA = 2 * hstepA, tstepB = 2 * hstepB;
    const unsigned ldsw = (unsigned)wid * 1024u;
    const int aoff = lds_byte(wr * 64 + fr, fq * 8), boff = lds_byte(wc * 32 + fr, fq * 8);
#define PG8_SA(b, h) (((b) * 2 + (h)) * HTB)
#define PG8_SB(b, h) ((4 + (b) * 2 + (h)) * HTB)
#define PG8_STAGE(bufoff, gbase, voff) do { _Pragma("unroll") for (int _i = 0; _i < 2; ++_i) \
        __builtin_amdgcn_global_load_lds((const unsigned*)((const char*)(gbase) + (voff)[_i]), (LAS unsigned*)(lds + (bufoff) + ldsw + _i * 8192), 16, 0, 0); } while (0)
#define PG8_LDA(dst, b, h) do { _Pragma("unroll") for (int m = 0; m < 4; ++m) _Pragma("unroll") for (int k = 0; k < 2; ++k) dst[m][k] = *(const LAS h16x8*)(lds + PG8_SA(b, h) + aoff + m * 2048 + k * 1024); } while (0)
#define PG8_LDB(dst, b, h) do { _Pragma("unroll") for (int n = 0; n < 2; ++n) _Pragma("unroll") for (int k = 0; k < 2; ++k) dst[n][k] = *(const LAS h16x8*)(lds + PG8_SB(b, h) + boff + n * 2048 + k * 1024); } while (0)
#define PG8_MMA(ai, bj, At, Bt) do { __builtin_amdgcn_s_setprio(1); _Pragma("unroll") for (int m = 0; m < 4; ++m) _Pragma("unroll") for (int n = 0; n < 2; ++n) _Pragma("unroll") for (int k = 0; k < 2; ++k) \
        acc[ai][bj][m][n] = __builtin_amdgcn_mfma_f32_16x16x32_f16(Bt[n][k], At[m][k], acc[ai][bj][m][n], 0, 0, 0); __builtin_amdgcn_s_setprio(0); } while (0)
#define PG8_WAIT_V(n) asm volatile("s_waitcnt vmcnt(" #n ")" ::: "memory")
#define PG8_WAIT_L(n) asm volatile("s_waitcnt lgkmcnt(" #n ")" ::: "memory")
#define PG8_BAR __builtin_amdgcn_s_barrier()
#define PG8_SCHED __builtin_amdgcn_sched_barrier(0)
    Unit cur, nxt; int ui = 0;
    if (!S.next(0, cur)) return;
    f32x4 acc[2][2][4][2];
#pragma unroll
    for (int a = 0; a < 2; ++a)
#pragma unroll
        for (int b = 0; b < 2; ++b)
#pragma unroll
            for (int m = 0; m < 4; ++m)
#pragma unroll
                for (int n = 0; n < 2; ++n) acc[a][b][m][n] = (f32x4){0.f, 0.f, 0.f, 0.f};
    h16x8 At[4][2], B0[2][2], B1[2][2];
    const char* cA = (const char*)g.A + (size_t)cur.pm * tstepA; const char* cB = (const char*)g.Bt + (size_t)cur.pn * tstepB;
    PG8_STAGE(PG8_SB(0, 0), cB, voffB); PG8_STAGE(PG8_SB(0, 1), cB + hstepB, voffB); PG8_STAGE(PG8_SA(0, 0), cA, voffA); PG8_STAGE(PG8_SA(0, 1), cA + hstepA, voffA);
    if (wr == 1) PG8_BAR;
    PG8_WAIT_V(2); PG8_BAR;
    PG8_STAGE(PG8_SB(1, 0), cB + kstep, voffB); PG8_STAGE(PG8_SA(1, 0), cA + kstep, voffA); PG8_STAGE(PG8_SB(1, 1), cB + hstepB + kstep, voffB);
    PG8_WAIT_V(6); PG8_BAR;
    for (;;) {
        const bool has_next = S.next(ui + 1, nxt);
        const char* nA = has_next ? (const char*)g.A + (size_t)nxt.pm * tstepA : cA; const char* nB = has_next ? (const char*)g.Bt + (size_t)nxt.pn * tstepB : cB;
        for (int t = 0; t < nt; t += 2) {
            const bool last = (t == nt - 2);
            const char* a1 = cA + (size_t)(t + 1) * kstep;
            const char* a2 = last ? nA : cA + (size_t)(t + 2) * kstep; const char* b2 = last ? nB : cB + (size_t)(t + 2) * kstep;
            const char* a3 = a2 + kstep; const char* b3 = b2 + kstep;
            PG8_LDB(B0, 0, 0); PG8_LDB(B1, 0, 1); PG8_SCHED; PG8_LDA(At, 0, 0); PG8_STAGE(PG8_SA(1, 1), a1 + hstepA, voffA);
            PG8_WAIT_V(8); PG8_WAIT_L(0); PG8_BAR; PG8_MMA(0, 0, At, B0); PG8_MMA(0, 1, At, B1); PG8_BAR; PG8_SCHED;
            PG8_LDA(At, 0, 1); PG8_STAGE(PG8_SB(0, 0), b2, voffB); PG8_STAGE(PG8_SB(0, 1), b2 + hstepB, voffB); PG8_STAGE(PG8_SA(0, 0), a2, voffA);
            PG8_WAIT_V(8); PG8_WAIT_L(0); PG8_BAR; PG8_MMA(1, 0, At, B0); PG8_MMA(1, 1, At, B1); PG8_BAR; PG8_SCHED;
            PG8_LDB(B0, 1, 0); PG8_LDB(B1, 1, 1); PG8_SCHED; PG8_LDA(At, 1, 0); PG8_STAGE(PG8_SA(0, 1), a2 + hstepA, voffA);
            PG8_WAIT_V(8); PG8_WAIT_L(0); PG8_BAR; PG8_MMA(0, 0, At, B0); PG8_MMA(0, 1, At, B1); PG8_BAR; PG8_SCHED;
            PG8_LDA(At, 1, 1); PG8_STAGE(PG8_SB(1, 0), b3, voffB); PG8_STAGE(PG8_SB(1, 1), b3 + hstepB, voffB); PG8_STAGE(PG8_SA(1, 0), a3, voffA);
            PG8_WAIT_V(8); PG8_WAIT_L(0); PG8_BAR; PG8_MMA(1, 0, At, B0); PG8_MMA(1, 1, At, B1); PG8_BAR; PG8_SCHED;
        }
        if (wr == 0) PG8_BAR;
        E(acc, cur, wr, wc, fr, fq);
        if (!has_next) break;
#pragma unroll
        for (int a = 0; a < 2; ++a)
#pragma unroll
            for (int b = 0; b < 2; ++b)
#pragma unroll
                for (int m = 0; m < 4; ++m)
#pragma unroll
                    for (int n = 0; n < 2; ++n) acc[a][b][m][n] = (f32x4){0.f, 0.f, 0.f, 0.f};
        cur = nxt; cA = nA; cB = nB; ++ui;
        if (wr == 1) PG8_BAR;
    }
    PG8_WAIT_V(0);
    PG8_BAR;
#undef PG8_SA
#undef PG8_SB
#undef PG8_STAGE
#undef PG8_LDA
#undef PG8_LDB
#undef PG8_MMA
#undef PG8_WAIT_V
#undef PG8_WAIT_L
#undef PG8_BAR
#undef PG8_SCHED
}


struct EpiSwiglu {
    static constexpr bool PERM = true;
    h16* O; const float* ss;
    __device__ __forceinline__ void operator()(const Acc& acc, const Unit& u, int wr, int wc, int fr, int fq) const {
        const int row0 = u.pm * BM + wr * 64 + fr, col0 = u.pn * 128 + wc * 32 + 8 * fq;
#pragma unroll
        for (int ai = 0; ai < 2; ++ai)
#pragma unroll
            for (int m = 0; m < 4; ++m) {
                const int row = row0 + ai * HALF + m * 16; const float rs = row_rstd(ss, row);
                float o[8];
#pragma unroll
                for (int n = 0; n < 2; ++n)
#pragma unroll
                    for (int j = 0; j < 4; ++j) { const float gg = acc[ai][0][m][n][j] * rs, uu = acc[ai][1][m][n][j] * rs; o[n * 4 + j] = gg * sigmoidf_(gg) * uu; }
                u32x4 w; w.x = pk2h(o[0], o[1]); w.y = pk2h(o[2], o[3]); w.z = pk2h(o[4], o[5]); w.w = pk2h(o[6], o[7]);
                *(u32x4*)(O + (size_t)row * FF + col0) = w;
            }
    }
};
struct EpiResid {
    static constexpr bool PERM = false;
    const float* res_p; const float* res_s; float* out; h16* o16; float* ss; float alpha;
    __device__ __forceinline__ void operator()(const Acc& acc, const Unit& u, int wr, int wc, int fr, int fq) const {
        const int row0 = u.pm * BM + wr * 64 + fr, col0 = u.pn * BM + wc * 32 + 4 * fq;
        const float* res = (u.pm * BM < MP) ? res_p : res_s;
#pragma unroll
        for (int ai = 0; ai < 2; ++ai)
#pragma unroll
            for (int m = 0; m < 4; ++m) {
                const int row = row0 + ai * HALF + m * 16; const size_t off = (size_t)row * D + col0; float sq = 0.f;
#pragma unroll
                for (int bj = 0; bj < 2; ++bj)
#pragma unroll
                    for (int n = 0; n < 2; ++n) { const size_t o = off + bj * HALF + n * 16; const f32x4 r = *(const f32x4*)(res + o); const f32x4 v = r + acc[ai][bj][m][n] * alpha;
                        *(f32x4*)(out + o) = v; u32x2 w; w.x = pk2h(v.x, v.y); w.y = pk2h(v.z, v.w); *(u32x2*)(o16 + o) = w; sq += (v.x * v.x + v.y * v.y) + (v.z * v.z + v.w * v.w); }
                sq += __shfl_xor(sq, 16); sq += __shfl_xor(sq, 32);
                if (fq == 0) ss[(size_t)row * 16 + u.pn * 4 + wc] = sq;
                asm volatile("" ::: "memory");
            }
    }
};
struct EpiProj {
    static constexpr bool PERM = true;
    unsigned char* ws; const float* ss;
    __device__ __forceinline__ void operator()(const Acc& acc, const Unit& u, int wr, int wc, int fr, int fq) const {
        const int pn = u.pn; h16* base; int ldc, c0; float sc = 1.f; int nbj = 2;
        if (pn < 2) { base = (h16*)(ws + WS_MIX); ldc = 1024; c0 = pn * 256; sc = 0.125f; }
        else if (pn < 12) { base = (h16*)(ws + WS_KNA + (size_t)((pn - 2) >> 1) * (96 * MiB)); ldc = 512; c0 = ((pn - 2) & 1) * 256; }
        else { base = (h16*)(ws + WS_LOWS); ldc = 384; c0 = (pn - 12) * 256; if (pn == 13) nbj = 1; }
        const int row0 = u.pm * BM + wr * 64 + fr, col0 = c0 + wc * 32 + 8 * fq;
#pragma unroll
        for (int ai = 0; ai < 2; ++ai)
#pragma unroll
            for (int m = 0; m < 4; ++m) {
                const int row = row0 + ai * HALF + m * 16; const float rs = row_rstd(ss, row) * sc;
#pragma unroll
                for (int bj = 0; bj < 2; ++bj) if (bj < nbj) {
                    const f32x4 v0 = acc[ai][bj][m][0] * rs, v1 = acc[ai][bj][m][1] * rs;
                    u32x4 w; w.x = pk2h(v0.x, v0.y); w.y = pk2h(v0.z, v0.w); w.z = pk2h(v1.x, v1.y); w.w = pk2h(v1.z, v1.w);
                    *(u32x4*)(base + (size_t)row * ldc + col0 + bj * HALF) = w; }
            }
    }
};
struct EpiPU {
    static constexpr bool PERM = true;
    h16* O;
    __device__ __forceinline__ void operator()(const Acc& acc, const Unit& u, int wr, int wc, int fr, int fq) const {
        const int row0 = u.pm * BM + wr * 64 + fr, col0 = u.pn * BM + wc * 32 + 8 * fq;
#pragma unroll
        for (int ai = 0; ai < 2; ++ai)
#pragma unroll
            for (int m = 0; m < 4; ++m) {
                const int row = row0 + ai * HALF + m * 16;
#pragma unroll
                for (int bj = 0; bj < 2; ++bj) {
                    const f32x4 v0 = acc[ai][bj][m][0], v1 = acc[ai][bj][m][1];
                    u32x4 w; w.x = pk2h(v0.x, v0.y); w.y = pk2h(v0.z, v0.w); w.z = pk2h(v1.x, v1.y); w.w = pk2h(v1.z, v1.w);
                    *(u32x4*)(O + (size_t)row * D + col0 + bj * HALF) = w; }
            }
    }
};
struct EpiPle {
    static constexpr bool PERM = false;
    float* out; h16* o16; float* ssw; const float* ssr; const h16* pu;
    __device__ __forceinline__ void operator()(const Acc& acc, const Unit& u, int wr, int wc, int fr, int fq) const {
        const int row0 = u.pm * BM + wr * 64 + fr, col0 = u.pn * BM + wc * 32 + 4 * fq;
#pragma unroll
        for (int ai = 0; ai < 2; ++ai)
#pragma unroll
            for (int m = 0; m < 4; ++m) {
                const int row = row0 + ai * HALF + m * 16; const size_t off = (size_t)row * D + col0; float sq = 0.f; const float rs = row_rstd(ssr, row);
#pragma unroll
                for (int bj = 0; bj < 2; ++bj)
#pragma unroll
                    for (int n = 0; n < 2; ++n) { const size_t o = off + bj * HALF + n * 16; const f32x4 r = *(const f32x4*)(out + o); const h16x4 p = *(const h16x4*)(pu + o);
                        const f32x4 a = acc[ai][bj][m][n] * rs; f32x4 v;
                        v.x = r.x + sigmoidf_(a.x) * (float)p.x; v.y = r.y + sigmoidf_(a.y) * (float)p.y; v.z = r.z + sigmoidf_(a.z) * (float)p.z; v.w = r.w + sigmoidf_(a.w) * (float)p.w;
                        *(f32x4*)(out + o) = v; u32x2 w; w.x = pk2h(v.x, v.y); w.y = pk2h(v.z, v.w); *(u32x2*)(o16 + o) = w; sq += (v.x * v.x + v.y * v.y) + (v.z * v.z + v.w * v.w); }
                sq += __shfl_xor(sq, 16); sq += __shfl_xor(sq, 32);
                if (fq == 0) ssw[(size_t)row * 16 + u.pn * 4 + wc] = sq;
                asm volatile("" ::: "memory");
            }
    }
};
}

__device__ __forceinline__ void convert_matrix(const float* W, int K, int N, const float* gamma, h16* WT, int mode, LAS float* scr, int gw, int NGW, int lane) {
    const int nblk = N / 32, nitems = (K / 64) * nblk;
    for (int item = gw; item < nitems; item += NGW) {
        const int kb = item / nblk, nb = item % nblk, k0 = 64 * kb, n0 = 32 * nb;
        const int drow0 = (mode == 0) ? n0 : ((n0 >> 7) * 256 + (n0 & 127) + (mode == 2 ? 128 : 0));
#pragma unroll 8
        for (int i = 0; i < 32; ++i) { const int kk = 2 * i + (lane >> 5); float v = W[(size_t)(k0 + kk) * N + n0 + (lane & 31)]; if (gamma) v *= gamma[k0 + kk]; scr[kk * 33 + (lane & 31)] = v; }
        asm volatile("s_waitcnt lgkmcnt(0)" ::: "memory");
        const int c = lane & 7;
#pragma unroll
        for (int j = 0; j < 4; ++j) { const int n = (lane >> 3) + 8 * j; const LAS float* s = scr + (8 * c) * 33 + n;
            u32x4 o; o.x = pk2h(s[0 * 33], s[1 * 33]); o.y = pk2h(s[2 * 33], s[3 * 33]); o.z = pk2h(s[4 * 33], s[5 * 33]); o.w = pk2h(s[6 * 33], s[7 * 33]);
            *(u32x4*)(WT + (size_t)(drow0 + n) * K + k0 + 8 * c) = o; }
        asm volatile("s_waitcnt lgkmcnt(0)" ::: "memory");
    }
}

__device__ __forceinline__ void phase_convert(const Args& a, int layer, LAS unsigned char* lds, int tid, int lane, int wave, int bid, int G) {
    LAS float* scr = (LAS float*)(lds + wave * 16384);
    const int gw = bid * NWAVES + wave, NGW = G * NWAVES;
    h16* W = (h16*)(a.ws + WS_W);
    const size_t l = (size_t)layer;
    convert_matrix(a.in[I_F1G] + l * D * FF, D, FF, a.in[I_F1N] + l * D, W + W_FFN1U, 1, scr, gw, NGW, lane);
    convert_matrix(a.in[I_F1U] + l * D * FF, D, FF, a.in[I_F1N] + l * D, W + W_FFN1U, 2, scr, gw, NGW, lane);
    convert_matrix(a.in[I_F1D] + l * FF * D, FF, D, nullptr, W + W_FFN1D, 0, scr, gw, NGW, lane);
    convert_matrix(a.in[I_WIN] + l * D * 3456, D, 3456, a.in[I_MIXN] + l * D, W + W_IN, 0, scr, gw, NGW, lane);
    convert_matrix(a.in[I_WOUT] + l * D * D, D, D, nullptr, W + W_OUT, 0, scr, gw, NGW, lane);
    convert_matrix(a.in[I_F2G] + l * D * FF, D, FF, a.in[I_F2N] + l * D, W + W_FFN2U, 1, scr, gw, NGW, lane);
    convert_matrix(a.in[I_F2U] + l * D * FF, D, FF, a.in[I_F2N] + l * D, W + W_FFN2U, 2, scr, gw, NGW, lane);
    convert_matrix(a.in[I_F2D] + l * FF * D, FF, D, nullptr, W + W_FFN2D, 0, scr, gw, NGW, lane);
    convert_matrix(a.in[I_PLEG] + l * D * D, D, D, a.in[I_PLEN] + l * D, W + W_GATE, 0, scr, gw, NGW, lane);
    convert_matrix(a.in[I_PLEU] + l * PLE * D, PLE, D, nullptr, W + W_UP, 0, scr, gw, NGW, lane);
    { u32x4* z = (u32x4*)(W + W_IN + (size_t)3456 * 1024); const int n16 = 128 * 1024 * 2 / 16;
      for (int i = bid * NTHREADS + tid; i < n16; i += G * NTHREADS) z[i] = (u32x4){0u, 0u, 0u, 0u}; }
    if (layer == 0) {
        h16* H = (h16*)(a.ws + WS_H16B); float* ss = (float*)(a.ws + WS_SSB);
        for (int m = gw; m < M; m += NGW) {
            const float* xr = (m < MP) ? a.in[I_XP] + (size_t)m * D : a.in[I_XS] + (size_t)(m - MP) * D;
            const f32x4* x4 = (const f32x4*)xr + lane; float s = 0.f;
            u32x2* o = (u32x2*)(H + (size_t)m * D) + lane;
#pragma unroll
            for (int j = 0; j < 4; ++j) { const f32x4 v = x4[64 * j]; s += (v.x * v.x + v.y * v.y) + (v.z * v.z + v.w * v.w); u32x2 w; w.x = pk2h(v.x, v.y); w.y = pk2h(v.z, v.w); o[64 * j] = w; }
            s = wave_sum(s);
            if (lane < 16) ss[(size_t)m * 16 + lane] = (lane == 0) ? s : 0.f;
        }
    }
}

__device__ __forceinline__ void convert_p(const Args& a, int layer, int tid, int bid, int G) {
    u32x2* o = (u32x2*)(a.ws + WS_P16);
    const f32x4* pp = (const f32x4*)(a.in[I_PP] + (size_t)layer * MP * PLE);
    const f32x4* ps = (const f32x4*)(a.in[I_PS] + (size_t)layer * MS * PLE);
    const int NP4 = MP * PLE / 4, NT4 = M * PLE / 4;
    for (int i = bid * NTHREADS + tid; i < NT4; i += G * NTHREADS) { const f32x4 v = (i < NP4) ? pp[i] : ps[i - NP4]; u32x2 w; w.x = pk2h(v.x, v.y); w.y = pk2h(v.z, v.w); o[i] = w; }
}

constexpr int NA_PITCH = 144;
constexpr int NA_VOFF = 512 * NA_PITCH;
constexpr int NA_PP = 67;
__device__ __forceinline__ void na_item(const Args& a, int layer, int item, LAS unsigned char* lds, int tid, int lane, int wave) {
    int tok0, i, rows;
    if (item < 1024) { tok0 = (item >> 6) * TP; i = item & 63; rows = 64; } else { const int it2 = item - 1024; tok0 = MP + (it2 >> 8) * TS; i = it2 & 255; rows = 256; }
    int rs = i - 4; rs = rs < 0 ? 0 : (rs > rows - 8 ? rows - 8 : rs);
    h16* MIX = (h16*)(a.ws + WS_MIX); const h16* KNA = (const h16*)(a.ws + WS_KNA); const h16* VNA = (const h16*)(a.ws + WS_VNA);
    const float* rpb = a.in[I_RPB] + (size_t)layer * 8 * 15 * 31;
    const int wtok0 = tok0 + rs * 64;
    const int j = lane, aw = wave;
    const int tokq = tok0 + i * 64 + j;
    int cs = j - 8; cs = cs < 0 ? 0 : (cs > 48 ? 48 : cs);
#pragma unroll 1
    for (int h = 0; h < 8; ++h) {
#pragma unroll
        for (int it = 0; it < 8; ++it) { const int key = (tid >> 3) + 64 * it, ch = tid & 7;
            const u32x4 kv = *(const u32x4*)(KNA + (size_t)(wtok0 + key) * 512 + h * 64 + ch * 8);
            const u32x4 vv = *(const u32x4*)(VNA + (size_t)(wtok0 + key) * 512 + h * 64 + ch * 8);
            *(LAS u32x4*)(lds + key * NA_PITCH + ch * 16) = kv; *(LAS u32x4*)(lds + NA_VOFF + key * NA_PITCH + ch * 16) = vv; }
        u32x4 qv[8];
#pragma unroll
        for (int c = 0; c < 8; ++c) qv[c] = *(const u32x4*)(MIX + (size_t)tokq * 1024 + h * 64 + c * 8);
        __syncthreads();
        float sc[16];
        const float* bias = rpb + ((size_t)h * 15 + (rs + aw - i + 7)) * 31 + (cs - j + 15);
#pragma unroll
        for (int c = 0; c < 16; ++c) {
            const LAS unsigned char* kp = lds + (aw * 64 + cs + c) * NA_PITCH; float s = 0.f;
#pragma unroll
            for (int c8 = 0; c8 < 8; ++c8) { const u32x4 kk = *(const LAS u32x4*)(kp + c8 * 16); s = dot8(qv[c8], kk, s); }
            sc[c] = s + bias[c];
            asm volatile("" ::: "memory");
        }
        float mx = sc[0];
#pragma unroll
        for (int c = 1; c < 16; ++c) mx = fmaxf(mx, sc[c]);
        float l = 0.f;
#pragma unroll
        for (int c = 0; c < 16; ++c) { sc[c] = __expf(sc[c] - mx); l += sc[c]; }
        float o[64];
#pragma unroll
        for (int d = 0; d < 64; ++d) o[d] = 0.f;
#pragma unroll
        for (int c = 0; c < 16; ++c) {
            const LAS unsigned char* vp = lds + NA_VOFF + (aw * 64 + cs + c) * NA_PITCH; const float p = sc[c];
#pragma unroll
            for (int c8 = 0; c8 < 8; ++c8) { const u32x4 vv = *(const LAS u32x4*)(vp + c8 * 16);
#pragma unroll
                for (int e = 0; e < 4; ++e) { const unsigned ve = vv[e]; o[c8 * 8 + 2 * e] = fma_mix_lo(p, ve, o[c8 * 8 + 2 * e]); o[c8 * 8 + 2 * e + 1] = fma_mix_hi(p, ve, o[c8 * 8 + 2 * e + 1]); } }
            asm volatile("" ::: "memory");
        }
        __syncthreads();
        LAS float* part = (LAS float*)lds + (size_t)(aw * 64 + j) * NA_PP;
#pragma unroll
        for (int d = 0; d < 64; ++d) part[d] = o[d];
        part[64] = mx; part[65] = l;
        __syncthreads();
        {
            const int jq = tid & 63, e8 = tid >> 6;
            float mw[8], M_ = -3.0e38f;
#pragma unroll
            for (int w = 0; w < 8; ++w) { mw[w] = ((const LAS float*)lds)[(size_t)(w * 64 + jq) * NA_PP + 64]; M_ = fmaxf(M_, mw[w]); }
            float L = 0.f, ov[8];
#pragma unroll
            for (int e = 0; e < 8; ++e) ov[e] = 0.f;
#pragma unroll
            for (int w = 0; w < 8; ++w) { const float f = __expf(mw[w] - M_); const LAS float* pw = (const LAS float*)lds + (size_t)(w * 64 + jq) * NA_PP; L += f * pw[65];
#pragma unroll
                for (int e = 0; e < 8; ++e) ov[e] += f * pw[e8 * 8 + e]; }
            const float inv = 1.0f / L;
            u32x4 w4; w4.x = pk2h(ov[0] * inv, ov[1] * inv); w4.y = pk2h(ov[2] * inv, ov[3] * inv); w4.z = pk2h(ov[4] * inv, ov[5] * inv); w4.w = pk2h(ov[6] * inv, ov[7] * inv);
            *(u32x4*)(MIX + (size_t)(tok0 + i * 64 + jq) * 1024 + h * 64 + e8 * 8) = w4;
        }
        __syncthreads();
    }
}

__device__ __forceinline__ float shiftmix(const h16* base, size_t stride, int t, int T, float mu) {
    const float c = (float)base[0];
    const float p = (t > 0) ? (float)*(base - stride) : 0.f;
    const float n = (t < T - 1) ? (float)*(base + stride) : 0.f;
    return c + mu * (0.5f * (p + n) - c);
}
constexpr int SC_CH = 32;
constexpr int SC_OPB = SC_CH * 6 * 64 * 4;
constexpr int SC_YOFF = 2 * SC_OPB;
constexpr int SC_YB = SC_CH * 64 * 4;
constexpr int SC_XOFF = SC_YOFF + 2 * SC_YB;
__device__ __forceinline__ void scan_flush(LAS unsigned char* lds, int cf, int pw, int lane, int d, int T, int tok0, int h, h16* Yf, h16* Yb) {
    const LAS float* yb = (const LAS float*)(lds + SC_YOFF + (cf & 1) * SC_YB);
    const int s = pw * 8 + (lane >> 3), r8 = (lane & 7) * 8; const int g = cf * SC_CH + s; const int t = d ? (T - 1 - g) : g;
    const f32x4 y0 = *(const LAS f32x4*)(yb + s * 64 + r8), y1 = *(const LAS f32x4*)(yb + s * 64 + r8 + 4);
    u32x4 w4; w4.x = pk2h(y0.x, y0.y); w4.y = pk2h(y0.z, y0.w); w4.z = pk2h(y1.x, y1.y); w4.w = pk2h(y1.z, y1.w);
    if (d == 0) *(u32x4*)(Yf + (size_t)(tok0 + t) * 1024 + 512 + h * 64 + r8) = w4; else *(u32x4*)(Yb + (size_t)(tok0 + t) * 512 + h * 64 + r8) = w4;
}
__device__ __forceinline__ void scan_item(const Args& a, int layer, int q, LAS unsigned char* lds, int tid, int lane, int wave) {
    int tok0, T, h, d;
    if (q < 32) { tok0 = MP + (q >> 4) * TS; T = TS; h = (q >> 1) & 7; d = q & 1; } else { const int q2 = q - 32; tok0 = (q2 >> 4) * TP; T = TP; h = (q2 >> 1) & 7; d = q2 & 1; }
    const int nch = T / SC_CH;
    const h16* RR = (const h16*)(a.ws + WS_RR); const h16* RK = (const h16*)(a.ws + WS_RK); const h16* RV = (const h16*)(a.ws + WS_RV); const h16* LOWS = (const h16*)(a.ws + WS_LOWS);
    h16* Yf = (h16*)(a.ws + WS_MIX); h16* Yb = (h16*)(a.ws + WS_YB); float* BSC = (float*)(a.ws + WS_BSC);
    const size_t l = (size_t)layer;
    if (wave >= 4) {
        const int pw = wave - 4, j = lane, col = h * 64 + j;
        const float* mu = a.in[I_MU] + l * 1920;
        const float mu_r = mu[col], mu_k = mu[512 + col], mu_v = mu[1024 + col], mu_wl = mu[1536 + d * 64 + j], mu_al = mu[1536 + 128 + d * 64 + j];
        const float k_k = a.in[I_KK][l * 512 + col], k_a = a.in[I_KA][l * 512 + col], r_k = a.in[I_RK][l * 512 + col];
        const float w0 = a.in[I_W0][(l * 2 + d) * 512 + col], a0 = a.in[I_A0][(l * 2 + d) * 512 + col];
        h16x2 wup[32], aup[32];
        { const float* wu = a.in[I_WUP] + ((l * 2 + d) * 64) * 512 + col; const float* au = a.in[I_AUP] + ((l * 2 + d) * 64) * 512 + col;
#pragma unroll
          for (int i2 = 0; i2 < 32; ++i2) { const float w0_ = wu[0], w1_ = wu[512], a0_ = au[0], a1_ = au[512]; wu += 1024; au += 1024; asm volatile("" : "+v"(wu), "+v"(au));
              wup[i2] = (h16x2){(h16)w0_, (h16)w1_}; aup[i2] = (h16x2){(h16)a0_, (h16)a1_}; } }
        LAS h16* xs = (LAS h16*)(lds + SC_XOFF + pw * 256);
        for (int c = -1; c < nch; ++c) {
            if (c >= 1) scan_flush(lds, c - 1, pw, lane, d, T, tok0, h, Yf, Yb);
            if (c + 1 < nch) {
                const int cp = c + 1; LAS float* op = (LAS float*)(lds + (cp & 1) * SC_OPB);
                for (int s8 = 0; s8 < 8; ++s8) {
                    const int s = pw * 8 + s8; const int g = cp * SC_CH + s; const int t = d ? (T - 1 - g) : g; const size_t tok = (size_t)(tok0 + t);
                    const float wl = shiftmix(LOWS + tok * 384 + d * 64 + j, 384, t, T, mu_wl);
                    const float al = shiftmix(LOWS + tok * 384 + 128 + d * 64 + j, 384, t, T, mu_al);
                    const float rr = shiftmix(RR + tok * 512 + col, 512, t, T, mu_r);
                    const float kk0 = shiftmix(RK + tok * 512 + col, 512, t, T, mu_k);
                    const float vv = shiftmix(RV + tok * 512 + col, 512, t, T, mu_v);
                    const float e2 = __expf(2.0f * wl); const float th = 1.0f - 2.0f * __builtin_amdgcn_rcpf(e2 + 1.0f);
                    xs[j] = (h16)th; xs[64 + j] = (h16)al;
                    float z = w0, az = a0;
#pragma unroll
                    for (int c8 = 0; c8 < 8; ++c8) { const u32x4 xw = *(const LAS u32x4a*)((const LAS unsigned char*)xs + c8 * 16), xa = *(const LAS u32x4a*)((const LAS unsigned char*)xs + 128 + c8 * 16);
                        z = dot8w(xw, wup[c8 * 4 + 0], wup[c8 * 4 + 1], wup[c8 * 4 + 2], wup[c8 * 4 + 3], z);
                        az = dot8w(xa, aup[c8 * 4 + 0], aup[c8 * 4 + 1], aup[c8 * 4 + 2], aup[c8 * 4 + 3], az); }
                    const float wdec = __expf(-0.606531f * sigmoidf_(z)); const float av = sigmoidf_(az);
                    float kk = kk0 * k_k; const float n2 = wave_sum(kk * kk); kk = kk / fmaxf(sqrtf(n2), 1e-12f);
                    const float kd = kk0 * (1.0f + (av - 1.0f) * k_a); const float bb = kk * av;
                    const float bs = wave_sum(rr * kd * r_k);
                    if (lane == 0) BSC[(tok * 8 + h) * 2 + d] = bs;
                    LAS float* o = op + s * 384 + j;
                    o[0] = -kk; o[64] = wdec; o[128] = bb; o[192] = kd; o[256] = rr; o[320] = vv;
                }
            }
            __syncthreads();
        }
        scan_flush(lds, nch - 1, pw, lane, d, T, tok0, h, Yf, Yb);
    } else {
        const int ri = lane >> 4, ci = lane & 15;
        f32x2 S[4][2];
#pragma unroll
        for (int i = 0; i < 4; ++i) { S[i][0] = (f32x2){0.f, 0.f}; S[i][1] = (f32x2){0.f, 0.f}; }
        __syncthreads();
        for (int c = 0; c < nch; ++c) {
            const LAS f32x4* op = (const LAS f32x4*)(lds + (c & 1) * SC_OPB);
            LAS float* yb = (LAS float*)(lds + SC_YOFF + (c & 1) * SC_YB);
            f32x4 a4 = op[ci], w4 = op[16 + ci], b4 = op[32 + ci], k4 = op[48 + ci], r4 = op[64 + ci], v4 = op[80 + 4 * wave + ri];
#pragma unroll 2
            for (int s = 0; s < SC_CH; ++s) {
                const int sn = (s + 1 < SC_CH) ? s + 1 : s; const LAS f32x4* on = op + sn * 96;
                const f32x4 na4 = on[ci], nw4 = on[16 + ci], nb4 = on[32 + ci], nk4 = on[48 + ci], nr4 = on[64 + ci], nv4 = on[80 + 4 * wave + ri];
                const f32x2 a01 = {a4.x, a4.y}, a23 = {a4.z, a4.w}, w01 = {w4.x, w4.y}, w23 = {w4.z, w4.w}, b01 = {b4.x, b4.y}, b23 = {b4.z, b4.w};
                const f32x2 k01 = {k4.x, k4.y}, k23 = {k4.z, k4.w}, r01 = {r4.x, r4.y}, r23 = {r4.z, r4.w};
                float sa[4];
#pragma unroll
                for (int i = 0; i < 4; ++i) { const f32x2 p = S[i][0] * a01 + S[i][1] * a23; sa[i] = row16_sum(p.x + p.y); }
                float y[4];
#pragma unroll
                for (int i = 0; i < 4; ++i) { const f32x2 sa2 = {sa[i], sa[i]}, v2 = {v4[i], v4[i]};
                    S[i][0] = S[i][0] * w01 + sa2 * b01 + v2 * k01; S[i][1] = S[i][1] * w23 + sa2 * b23 + v2 * k23;
                    const f32x2 p = S[i][0] * r01 + S[i][1] * r23; y[i] = row16_sum(p.x + p.y); }
                if (ci == 0) *(LAS f32x4*)(yb + s * 64 + 16 * wave + 4 * ri) = (f32x4){y[0], y[1], y[2], y[3]};
                a4 = na4; w4 = nw4; b4 = nb4; k4 = nk4; r4 = nr4; v4 = nv4;
            }
            __syncthreads();
        }
    }
}

__device__ __forceinline__ void rwpost_tile(const Args& a, int layer, int tile, LAS unsigned char* lds, int tid, int lane, int wave) {
    const size_t l = (size_t)layer; const int col = tid, h = wave;
    const int m0 = tile * 64; int tok0s, T; if (m0 < MP) { T = TP; tok0s = (m0 / TP) * TP; } else { T = TS; tok0s = MP + ((m0 - MP) / TS) * TS; }
    const h16* LOWS = (const h16*)(a.ws + WS_LOWS); const h16* RV = (const h16*)(a.ws + WS_RV); h16* MIX = (h16*)(a.ws + WS_MIX); const h16* Yb = (const h16*)(a.ws + WS_YB); const float* BSC = (const float*)(a.ws + WS_BSC);
    const float* mu = a.in[I_MU] + l * 1920;
    LAS h16* G = (LAS h16*)lds;
    for (int e = tid; e < 64 * 128; e += NTHREADS) { const int tk = e >> 7, c = e & 127; const int m = m0 + tk; const int t = m - tok0s;
        const float gl = shiftmix(LOWS + (size_t)m * 384 + 256 + c, 384, t, T, mu[1536 + 256 + c]); G[e] = (h16)sigmoidf_(gl); }
    h16x2 gup[64];
    { const float* gu = a.in[I_GUP] + l * 128 * 512 + col;
#pragma unroll
      for (int i2 = 0; i2 < 64; ++i2) { const float g0 = gu[0], g1 = gu[512]; gu += 1024; asm volatile("" : "+v"(gu)); gup[i2] = (h16x2){(h16)g0, (h16)g1}; } }
    const float mu_v = mu[1024 + col], lw = a.in[I_LNW][l * 512 + col], lb = a.in[I_LNB][l * 512 + col];
    __syncthreads();
#pragma unroll 1
    for (int tk = 0; tk < 64; ++tk) {
        const int m = m0 + tk; const int t = m - tok0s;
        float g = 0.f;
#pragma unroll
        for (int c8 = 0; c8 < 16; ++c8) { const u32x4 x = *(const LAS u32x4a*)((const LAS unsigned char*)G + tk * 256 + c8 * 16);
            g = dot8w(x, gup[c8 * 4 + 0], gup[c8 * 4 + 1], gup[c8 * 4 + 2], gup[c8 * 4 + 3], g); }
        const float wkv = (float)MIX[(size_t)m * 1024 + 512 + col] + (float)Yb[(size_t)m * 512 + col];
        const float mean = wave_sum(wkv) * (1.0f / 64.0f); const float dv = wkv - mean; const float var = wave_sum(dv * dv) * (1.0f / 64.0f);
        const float yn = dv * __builtin_amdgcn_rsqf(var + 64e-5f) * lw + lb;
        const float vv = shiftmix(RV + (size_t)m * 512 + col, 512, t, T, mu_v);
        const float bs = BSC[((size_t)m * 8 + h) * 2] + BSC[((size_t)m * 8 + h) * 2 + 1];
        MIX[(size_t)m * 1024 + 512 + col] = (h16)((yn + bs * vv) * g);
    }
    __syncthreads();
}

__global__ void __launch_bounds__(NTHREADS, 2) fwd_megakernel(Args args) {
    extern __shared__ __attribute__((aligned(16))) unsigned char lds_raw[];
    LAS unsigned char* lds = (LAS unsigned char*)lds_raw;
    cg::grid_group grid = cg::this_grid();
    const int bid = blockIdx.x, G = gridDim.x;
#define FRESH_TID int tid = threadIdx.x; asm volatile("" : "+v"(tid)); const int lane = tid & 63, wave = __builtin_amdgcn_readfirstlane(tid >> 6); (void)lane; (void)wave;
    unsigned char* ws = args.ws;
    h16* W = (h16*)(ws + WS_W); float* SSA = (float*)(ws + WS_SSA); float* SSB = (float*)(ws + WS_SSB); h16* H16 = (h16*)(ws + WS_H16);
    float* out = args.out;

    for (int layer = 0; layer < 2; ++layer) {
        if (PH(0)) { FRESH_TID phase_convert(args, layer, lds, tid, lane, wave, bid, G); }
        grid_sync(grid);
        if (PH(1)) { FRESH_TID pg8::Gemm g{(const h16*)(ws + WS_H16B), W + W_FFN1U, M, 2 * FF, D, D}; pg8::StaticOrder S; S.init(M, 2 * FF, G, bid); pg8::EpiSwiglu E{(h16*)(ws + WS_ACT), SSB}; pg8::gemm_phase(lds, g, S, E, tid); }
        grid_sync(grid);
        if (PH(2)) { FRESH_TID pg8::Gemm g{(const h16*)(ws + WS_ACT), W + W_FFN1D, M, D, FF, FF}; pg8::StaticOrder S; S.init(M, D, G, bid);
          const float* rp = layer == 0 ? args.in[I_XP] : (const float*)out; const float* rsm = layer == 0 ? args.in[I_XS] - (size_t)MP * D : (const float*)out;
          pg8::EpiResid E{rp, rsm, out, H16, SSA, 0.5f}; pg8::gemm_phase(lds, g, S, E, tid); }
        grid_sync(grid);
        if (PH(3)) { FRESH_TID pg8::Gemm g{H16, W + W_IN, M, NPROJ, D, D}; pg8::StaticOrder S; S.init(M, NPROJ, G, bid); pg8::EpiProj E{ws, SSA}; pg8::gemm_phase(lds, g, S, E, tid); }
        grid_sync(grid);
        {
            if (PH(4)) { FRESH_TID scan_item(args, layer, bid, lds, tid, lane, wave);
            __syncthreads();
            if (bid >= 32 && bid < 64) { scan_item(args, layer, bid + 224, lds, tid, lane, wave); __syncthreads(); } }
            if (PH(5)) if (bid >= 32) { FRESH_TID for (int it = bid - 32; it < 1536; it += G - 32) na_item(args, layer, it, lds, tid, lane, wave); }
        }
        grid_sync(grid);
        if (PH(6)) { FRESH_TID for (int tile = bid; tile < M / 64; tile += G) rwpost_tile(args, layer, tile, lds, tid, lane, wave); }
        grid_sync(grid);
        if (PH(7)) { FRESH_TID pg8::Gemm g{(const h16*)(ws + WS_MIX), W + W_OUT, M, D, D, D}; pg8::StaticOrder S; S.init(M, D, G, bid); pg8::EpiResid E{out, out, out, H16, SSA, 1.0f}; pg8::gemm_phase(lds, g, S, E, tid); }
        grid_sync(grid);
        if (PH(8)) { FRESH_TID pg8::Gemm g{H16, W + W_FFN2U, M, 2 * FF, D, D}; pg8::StaticOrder S; S.init(M, 2 * FF, G, bid); pg8::EpiSwiglu E{(h16*)(ws + WS_ACT), SSA}; pg8::gemm_phase(lds, g, S, E, tid); }
        grid_sync(grid);
        if (PH(9)) { FRESH_TID pg8::Gemm g{(const h16*)(ws + WS_ACT), W + W_FFN2D, M, D, FF, FF}; pg8::StaticOrder S; S.init(M, D, G, bid); pg8::EpiResid E{out, out, out, H16, SSA, 0.5f}; pg8::gemm_phase(lds, g, S, E, tid);
          convert_p(args, layer, tid, bid, G); }
        grid_sync(grid);
        if (PH(10)) { FRESH_TID int kpu = PLE; asm volatile("" : "+s"(kpu)); pg8::Gemm g{(const h16*)(ws + WS_P16), W + W_UP, M, D, kpu, kpu}; pg8::StaticOrder S; S.init(M, D, G, bid); pg8::EpiPU E{(h16*)(ws + WS_PU)}; pg8::gemm_phase(lds, g, S, E, tid); }
        grid_sync(grid);
        if (PH(11)) { FRESH_TID pg8::Gemm g{H16, W + W_GATE, M, D, D, D}; pg8::StaticOrder S; S.init(M, D, G, bid); pg8::EpiPle E{out, (h16*)(ws + WS_H16B), SSB, SSA, (const h16*)(ws + WS_PU)}; pg8::gemm_phase(lds, g, S, E, tid); }
        grid_sync(grid);
    }
    {
        FRESH_TID
        const int gw = bid * NWAVES + wave, NGW = G * NWAVES; const f32x4* gm = (const f32x4*)args.in[I_FINAL] + lane;
        f32x4 gv[4];
#pragma unroll
        for (int j = 0; j < 4; ++j) gv[j] = gm[64 * j];
        for (int m = gw; m < M; m += NGW) {
            const float rs = row_rstd(SSB, m); f32x4* o = (f32x4*)(out + (size_t)m * D) + lane;
#pragma unroll
            for (int j = 0; j < 4; ++j) { const f32x4 v = o[64 * j]; o[64 * j] = v * rs * gv[j]; }
        }
    }
}

extern "C" void kernel_launch(void* const* d_in, const int* in_sizes, int n_in, void* d_out, int out_size, void* d_ws, size_t ws_size, hipStream_t stream) {
    static int grid = 0;
    if (grid == 0) {
        if (n_in != N_IN || out_size != M * D || ws_size < WS_END) { fprintf(stderr, "kernel_launch: unexpected shapes (n_in %d, out %d, ws %zu)\n", n_in, out_size, ws_size); grid = -1; return; }
        int dev = 0, cus = 0, per_cu = 0;
        (void)hipGetDevice(&dev); (void)hipDeviceGetAttribute(&cus, hipDeviceAttributeMultiprocessorCount, dev);
        (void)hipFuncSetAttribute((const void*)fwd_megakernel, hipFuncAttributeMaxDynamicSharedMemorySize, LDS_BYTES);
        (void)hipOccupancyMaxActiveBlocksPerMultiprocessor(&per_cu, (const void*)fwd_megakernel, NTHREADS, LDS_BYTES);
        if (per_cu < 1) fprintf(stderr, "kernel_launch: occupancy query says %d blocks per CU\n", per_cu);
        grid = cus;
        if (grid != 256) fprintf(stderr, "kernel_launch: grid %d (expected 256)\n", grid);
    }
    if (grid < 0) return;
    Args a{};
    for (int i = 0; i < N_IN; ++i) a.in[i] = (const float*)d_in[i];
    a.out = (float*)d_out; a.ws = (unsigned char*)d_ws;
    void* kargs[] = {&a};
    hipError_t e = hipLaunchCooperativeKernel((const void*)fwd_megakernel, dim3(grid), dim3(NTHREADS), kargs, LDS_BYTES, stream);
    if (e != hipSuccess) fprintf(stderr, "kernel_launch: cooperative launch failed: %s\n", hipGetErrorString(e));
}
```

```cpp
#include <hip/hip_runtime.h>
#include <hip/hip_cooperative_groups.h>
#include <cstdio>
#include <cstdint>
namespace cg = cooperative_groups;
#ifndef PHM
#define PHM 0xFFFF
#endif
#define PH(k) ((PHM >> (k)) & 1)

#define LAS __attribute__((address_space(3)))
typedef _Float16 h16;
typedef _Float16 h16x2 __attribute__((ext_vector_type(2)));
typedef _Float16 h16x4 __attribute__((ext_vector_type(4)));
typedef _Float16 h16x8 __attribute__((ext_vector_type(8)));
typedef float f32x2 __attribute__((ext_vector_type(2)));
typedef float f32x4 __attribute__((ext_vector_type(4)));
typedef unsigned u32x2 __attribute__((ext_vector_type(2)));
typedef unsigned u32x4 __attribute__((ext_vector_type(4)));
typedef unsigned u32x4a __attribute__((ext_vector_type(4), may_alias));

constexpr int D = 1024, FF = 2816, MP = 65536, MS = 32768, M = MP + MS, TP = 4096, TS = 16384, PLE = 256;
constexpr int NPROJ = 3584;
constexpr int NTHREADS = 512, NWAVES = 8;
constexpr int LDS_BYTES = 147456;
constexpr size_t MiB = 1u << 20;
constexpr size_t WS_W = 1 * MiB;
constexpr size_t WS_SSA = 46 * MiB;
constexpr size_t WS_H16 = 52 * MiB;
constexpr size_t WS_MIX = 244 * MiB;
constexpr size_t WS_KNA = 436 * MiB, WS_VNA = 532 * MiB, WS_RR = 628 * MiB, WS_RK = 724 * MiB, WS_RV = 820 * MiB;
constexpr size_t WS_LOWS = 916 * MiB;
constexpr size_t WS_ACT = 244 * MiB;
constexpr size_t WS_P16 = 772 * MiB;
constexpr size_t WS_PU = 244 * MiB;
constexpr size_t WS_H16B = 772 * MiB;
constexpr size_t WS_YB = WS_H16;
constexpr size_t WS_BSC = WS_H16 + 96 * MiB;
constexpr size_t WS_SSB = 1012 * MiB;
constexpr size_t WS_END = 1018 * MiB;
constexpr size_t W_FFN1U = 0;
constexpr size_t W_FFN1D = W_FFN1U + (size_t)5632 * 1024;
constexpr size_t W_IN = W_FFN1D + (size_t)1024 * 2816;
constexpr size_t W_OUT = W_IN + (size_t)3584 * 1024;
constexpr size_t W_FFN2U = W_OUT + (size_t)1024 * 1024;
constexpr size_t W_FFN2D = W_FFN2U + (size_t)5632 * 1024;
constexpr size_t W_GATE = W_FFN2D + (size_t)1024 * 2816;
constexpr size_t W_UP = W_GATE + (size_t)1024 * 1024;
constexpr size_t W_ENDE = W_UP + (size_t)1024 * 256;
static_assert(WS_W + W_ENDE * 2 <= WS_SSA, "weights fit");

enum { I_XP = 0, I_XS, I_PP, I_PS, I_F1N, I_F1G, I_F1U, I_F1D, I_MIXN, I_WIN, I_RPB, I_MU, I_W0, I_WUP, I_A0, I_AUP, I_GUP, I_KK, I_KA, I_RK, I_LNW, I_LNB,
       I_WOUT, I_F2N, I_F2G, I_F2U, I_F2D, I_PLEN, I_PLEG, I_PLEU, I_FINAL, N_IN };
struct Args { const float* in[N_IN]; float* out; unsigned char* ws; };

__device__ __forceinline__ float wave_sum(float v) {
#pragma unroll
    for (int o = 1; o < 64; o <<= 1) v += __shfl_xor(v, o);
    return v;
}
__device__ __forceinline__ unsigned pk2h(float a, float b) { h16x2 p = {(h16)a, (h16)b}; return __builtin_bit_cast(unsigned, p); }
__device__ __forceinline__ h16x2 as_h2(unsigned u) { return __builtin_bit_cast(h16x2, u); }
__device__ __forceinline__ float dot2h(unsigned a, h16x2 b, float c) { return __builtin_amdgcn_fdot2(as_h2(a), b, c, false); }
__device__ __forceinline__ float dot8(u32x4 a, u32x4 b, float c) { const unsigned a0 = a[0], a1 = a[1], a2 = a[2], a3 = a[3], b0 = b[0], b1 = b[1], b2 = b[2], b3 = b[3];
    c = __builtin_amdgcn_fdot2(as_h2(a0), as_h2(b0), c, false); c = __builtin_amdgcn_fdot2(as_h2(a1), as_h2(b1), c, false); c = __builtin_amdgcn_fdot2(as_h2(a2), as_h2(b2), c, false); c = __builtin_amdgcn_fdot2(as_h2(a3), as_h2(b3), c, false); return c; }
__device__ __forceinline__ float dot8w(u32x4 a, h16x2 w0, h16x2 w1, h16x2 w2, h16x2 w3, float c) { const unsigned a0 = a[0], a1 = a[1], a2 = a[2], a3 = a[3];
    c = __builtin_amdgcn_fdot2(as_h2(a0), w0, c, false); c = __builtin_amdgcn_fdot2(as_h2(a1), w1, c, false); c = __builtin_amdgcn_fdot2(as_h2(a2), w2, c, false); c = __builtin_amdgcn_fdot2(as_h2(a3), w3, c, false); return c; }
__device__ __forceinline__ float fma_mix_lo(float p, unsigned v, float o) { asm("v_fma_mix_f32 %0, %1, %2, %0 op_sel_hi:[0,1,0]" : "+v"(o) : "v"(p), "v"(v)); return o; }
__device__ __forceinline__ float fma_mix_hi(float p, unsigned v, float o) { asm("v_fma_mix_f32 %0, %1, %2, %0 op_sel:[0,1,0] op_sel_hi:[0,1,0]" : "+v"(o) : "v"(p), "v"(v)); return o; }
__device__ __forceinline__ float sigmoidf_(float x) { return __builtin_amdgcn_rcpf(1.0f + __expf(-x)); }
__device__ __forceinline__ float row_rstd(const float* ss, int row) {
    const f32x4* p = (const f32x4*)(ss + (size_t)row * 16);
    const f32x4 a = p[0], b = p[1], c = p[2], d = p[3];
    const float s = ((a.x + a.y) + (a.z + a.w)) + ((b.x + b.y) + (b.z + b.w)) + ((c.x + c.y) + (c.z + c.w)) + ((d.x + d.y) + (d.z + d.w));
    return __builtin_amdgcn_rsqf(s * (1.0f / 1024.0f) + 1e-6f);
}
template <int CTRL> __device__ __forceinline__ float dpp_f(float v) { return __builtin_bit_cast(float, __builtin_amdgcn_update_dpp(0, __builtin_bit_cast(int, v), CTRL, 0xF, 0xF, true)); }
__device__ __forceinline__ float row16_sum(float v) {
    v += dpp_f<0xB1>(v);
    v += dpp_f<0x4E>(v);
    v += dpp_f<0x141>(v);
    v += dpp_f<0x140>(v);
    return v;
}
__device__ __forceinline__ void grid_sync(cg::grid_group& grid) {
    asm volatile("s_waitcnt vmcnt(0) lgkmcnt(0)" ::: "memory"); grid.sync();
    __builtin_amdgcn_fence(__ATOMIC_ACQUIRE, "agent"); asm volatile("s_waitcnt vmcnt(0)" ::: "memory"); }

namespace pg8 {
constexpr int BM = 256, BK = 64, HALF = 128, HTB = HALF * BK * 2, STAGE_BYTES = 8 * HTB, NXCD = 8, WGM = 8;
__host__ __device__ __forceinline__ int lds_byte(int r, int c) { const int st = (r >> 4) * 2 + (c >> 5), rr = r & 15, cc = c & 31, ob = rr * 64 + cc * 2; return st * 1024 + (ob ^ (((ob >> 9) & 1) << 5)); }
__host__ __device__ __forceinline__ void stage_rc(int b, int& R, int& C) { const int st = b / 1024, sb = b % 1024, swz = sb ^ (((sb >> 9) & 1) << 5); R = (st >> 1) * 16 + swz / 64; C = (st & 1) * 32 + (swz % 64) / 2; }
__host__ __device__ __forceinline__ int perm32(int rho) { const int n = rho >> 4, i = rho & 15; return 8 * (i >> 2) + 4 * n + (i & 3); }
struct Unit { int pm, pn; };
struct Gemm { const h16* A; const h16* Bt; int M, N, K, lda; };
struct StaticOrder {
    int nM, nN, nwg, G, c;
    __device__ void init(int M_, int N_, int G_, int c_) { nM = M_ / BM; nN = N_ / BM; nwg = nM * nN; G = G_; c = c_; }
    __device__ bool next(int i, Unit& u) const {
        const long L = (long)i * G + c; if (L >= nwg) return false;
        int wgid = (int)L; { const int q = nwg / NXCD, r = nwg % NXCD, xcd = wgid % NXCD, off = wgid / NXCD; wgid = (xcd < r ? xcd * (q + 1) : r * (q + 1) + (xcd - r) * q) + off; }
        const int nig = WGM * nN, gid = wgid / nig, fm = gid * WGM, gsz = (nM - fm) < WGM ? (nM - fm) : WGM;
        u.pm = fm + ((wgid % nig) % gsz); u.pn = (wgid % nig) / gsz; return true;
    }
};
typedef f32x4 Acc[2][2][4][2];

template <class Epi>
__device__ __forceinline__ void gemm_phase(LAS unsigned char* lds, const Gemm g, const StaticOrder& S, const Epi& E, const int tid) {
    const int wid = __builtin_amdgcn_readfirstlane(tid >> 6), lane = tid & 63, wr = wid >> 2, wc = wid & 3, fr = lane & 15, fq = lane >> 4;
    const int K = g.K, nt = K / BK, lda = g.lda;
    unsigned voffA[2], voffB[2];
#pragma unroll
    for (int i = 0; i < 2; ++i) { int R, C; stage_rc(tid * 16 + i * 8192, R, C); const int Rb = Epi::PERM ? ((R & ~31) + perm32(R & 31)) : R;
        voffA[i] = (unsigned)(R * lda + C) * 2u; voffB[i] = (unsigned)(Rb * K + C) * 2u; }
    const size_t kstep = (size_t)(BK * 2);
    const size_t hstepA = (size_t)HALF * lda * 2, hstepB = (size_t)HALF * K * 2;
    const size_t tstepA = 2 * hstepA, tstepB = 2 * hstepB;
    const unsigned ldsw = (unsigned)wid * 1024u;
    const int aoff = lds_byte(wr * 64 + fr, fq * 8), boff = lds_byte(wc * 32 + fr, fq * 8);
#define PG8_SA(b, h) (((b) * 2 + (h)) * HTB)
#define PG8_SB(b, h) ((4 + (b) * 2 + (h)) * HTB)
#define PG8_STAGE(bufoff, gbase, voff) do { _Pragma("unroll") for (int _i = 0; _i < 2; ++_i) \
        __builtin_amdgcn_global_load_lds((const unsigned*)((const char*)(gbase) + (voff)[_i]), (LAS unsigned*)(lds + (bufoff) + ldsw + _i * 8192), 16, 0, 0); } while (0)
#define PG8_LDA(dst, b, h) do { _Pragma("unroll") for (int m = 0; m < 4; ++m) _Pragma("unroll") for (int k = 0; k < 2; ++k) dst[m][k] = *(const LAS h16x8*)(lds + PG8_SA(b, h) + aoff + m * 2048 + k * 1024); } while (0)
#define PG8_LDB(dst, b, h) do { _Pragma("unroll") for (int n = 0; n < 2; ++n) _Pragma("unroll") for (int k = 0; k < 2; ++k) dst[n][k] = *(const LAS h16x8*)(lds + PG8_SB(b, h) + boff + n * 2048 + k * 1024); } while (0)
#define PG8_MMA(ai, bj, At, Bt) do { __builtin_amdgcn_s_setprio(1); _Pragma("unroll") for (int m = 0; m < 4; ++m) _Pragma("unroll") for (int n = 0; n < 2; ++n) _Pragma("unroll") for (int k = 0; k < 2; ++k) \
        acc[ai][bj][m][n] = __builtin_amdgcn_mfma_f32_16x16x32_f16(Bt[n][k], At[m][k], acc[ai][bj][m][n], 0, 0, 0); __builtin_amdgcn_s_setprio(0); } while (0)
#define PG8_WAIT_V(n) asm volatile("s_waitcnt vmcnt(" #n ")" ::: "memory")
#define PG8_WAIT_L(n) asm volatile("s_waitcnt lgkmcnt(" #n ")" ::: "memory")
#define PG8_BAR __builtin_amdgcn_s_barrier()
#define PG8_SCHED __builtin_amdgcn_sched_barrier(0)
    Unit cur, nxt; int ui = 0;
    if (!S.next(0, cur)) return;
    f32x4 acc[2][2][4][2];
#pragma unroll
    for (int a = 0; a < 2; ++a)
#pragma unroll
        for (int b = 0; b < 2; ++b)
#pragma unroll
            for (int m = 0; m < 4; ++m)
#pragma unroll
                for (int n = 0; n < 2; ++n) acc[a][b][m][n] = (f32x4){0.f, 0.f, 0.f, 0.f};
    h16x8 At[4][2], B0[2][2], B1[2][2];
    const char* cA = (const char*)g.A + (size_t)cur.pm * tstepA; const char* cB = (const char*)g.Bt + (size_t)cur.pn * tstepB;
    PG8_STAGE(PG8_SB(0, 0), cB, voffB); PG8_STAGE(PG8_SB(0, 1), cB + hstepB, voffB); PG8_STAGE(PG8_SA(0, 0), cA, voffA); PG8_STAGE(PG8_SA(0, 1), cA + hstepA, voffA);
    if (wr == 1) PG8_BAR;
    PG8_WAIT_V(2); PG8_BAR;
    PG8_STAGE(PG8_SB(1, 0), cB + kstep, voffB); PG8_STAGE(PG8_SA(1, 0), cA + kstep, voffA); PG8_STAGE(PG8_SB(1, 1), cB + hstepB + kstep, voffB);
    PG8_WAIT_V(6); PG8_BAR;
    for (;;) {
        const bool has_next = S.next(ui + 1, nxt);
        const char* nA = has_next ? (const char*)g.A + (size_t)nxt.pm * tstepA : cA; const char* nB = has_next ? (const char*)g.Bt + (size_t)nxt.pn * tstepB : cB;
        for (int t = 0; t < nt; t += 2) {
            const bool last = (t == nt - 2);
            const char* a1 = cA + (size_t)(t + 1) * kstep;
            const char* a2 = last ? nA : cA + (size_t)(t + 2) * kstep; const char* b2 = last ? nB : cB + (size_t)(t + 2) * kstep;
            const char* a3 = a2 + kstep; const char* b3 = b2 + kstep;
            PG8_LDB(B0, 0, 0); PG8_LDB(B1, 0, 1); PG8_SCHED; PG8_LDA(At, 0, 0); PG8_STAGE(PG8_SA(1, 1), a1 + hstepA, voffA);
            PG8_WAIT_V(8); PG8_WAIT_L(0); PG8_BAR; PG8_MMA(0, 0, At, B0); PG8_MMA(0, 1, At, B1); PG8_BAR; PG8_SCHED;
            PG8_LDA(At, 0, 1); PG8_STAGE(PG8_SB(0, 0), b2, voffB); PG8_STAGE(PG8_SB(0, 1), b2 + hstepB, voffB); PG8_STAGE(PG8_SA(0, 0), a2, voffA);
            PG8_WAIT_V(8); PG8_WAIT_L(0); PG8_BAR; PG8_MMA(1, 0, At, B0); PG8_MMA(1, 1, At, B1); PG8_BAR; PG8_SCHED;
            PG8_LDB(B0, 1, 0); PG8_LDB(B1, 1, 1); PG8_SCHED; PG8_LDA(At, 1, 0); PG8_STAGE(PG8_SA(0, 1), a2 + hstepA, voffA);
            PG8_WAIT_V(8); PG8_WAIT_L(0); PG8_BAR; PG8_MMA(0, 0, At, B0); PG8_MMA(0, 1, At, B1); PG8_BAR; PG8_SCHED;
            PG8_LDA(At, 1, 1); PG8_STAGE(PG8_SB(1, 0), b3, voffB); PG8_STAGE(PG8_SB(1, 1), b3 + hstepB, voffB); PG8_STAGE(PG8_SA(1, 0), a3, voffA);
            PG8_WAIT_V(8); PG8_WAIT_L(0); PG8_BAR; PG8_MMA(1, 0, At, B0); PG8_MMA(1, 1, At, B1); PG8_BAR; PG8_SCHED;
        }
        if (wr == 0) PG8_BAR;
        E(acc, cur, wr, wc, fr, fq);
        if (!has_next) break;
#pragma unroll
        for (int a = 0; a < 2; ++a)
#pragma unroll
            for (int b = 0; b < 2; ++b)
#pragma unroll
                for (int m = 0; m < 4; ++m)
#pragma unroll
                    for (int n = 0; n < 2; ++n) acc[a][b][m][n] = (f32x4){0.f, 0.f, 0.f, 0.f};
        cur = nxt; cA = nA; cB = nB; ++ui;
        if (wr == 1) PG8_BAR;
    }
    PG8_WAIT_V(0);
    PG8_BAR;
#undef PG8_SA
#undef PG8_SB
#undef PG8_STAGE
#undef PG8_LDA
#undef PG8_LDB
#undef PG8_MMA
#undef PG8_WAIT_V
#undef PG8_WAIT_L
#undef PG8_BAR
#undef PG8_SCHED
}


struct EpiSwiglu {
    static constexpr bool PERM = true;
    h16* O; const float* ss;
    __device__ __forceinline__ void operator()(const Acc& acc, const Unit& u, int wr, int wc, int fr, int fq) const {
        const int row0 = u.pm * BM + wr * 64 + fr, col0 = u.pn * 128 + wc * 32 + 8 * fq;
#pragma unroll
        for (int ai = 0; ai < 2; ++ai)
#pragma unroll
            for (int m = 0; m < 4; ++m) {
                const int row = row0 + ai * HALF + m * 16; const float rs = row_rstd(ss, row);
                float o[8];
#pragma unroll
                for (int n = 0; n < 2; ++n)
#pragma unroll
                    for (int j = 0; j < 4; ++j) { const float gg = acc[ai][0][m][n][j] * rs, uu = acc[ai][1][m][n][j] * rs; o[n * 4 + j] = gg * sigmoidf_(gg) * uu; }
                u32x4 w; w.x = pk2h(o[0], o[1]); w.y = pk2h(o[2], o[3]); w.z = pk2h(o[4], o[5]); w.w = pk2h(o[6], o[7]);
                *(u32x4*)(O + (size_t)row * FF + col0) = w;
            }
    }
};
struct EpiResid {
    static constexpr bool PERM = false;
    const float* res_p; const float* res_s; float* out; h16* o16; float* ss; float alpha;
    __device__ __forceinline__ void operator()(const Acc& acc, const Unit& u, int wr, int wc, int fr, int fq) const {
        const int row0 = u.pm * BM + wr * 64 + fr, col0 = u.pn * BM + wc * 32 + 4 * fq;
        const float* res = (u.pm * BM < MP) ? res_p : res_s;
#pragma unroll
        for (int ai = 0; ai < 2; ++ai)
#pragma unroll
            for (int m = 0; m < 4; ++m) {
                const int row = row0 + ai * HALF + m * 16; const size_t off = (size_t)row * D + col0; float sq = 0.f;
#pragma unroll
                for (int bj = 0; bj < 2; ++bj)
#pragma unroll
                    for (int n = 0; n < 2; ++n) { const size_t o = off + bj * HALF + n * 16; const f32x4 r = *(const f32x4*)(res + o); const f32x4 v = r + acc[ai][bj][m][n] * alpha;
                        *(f32x4*)(out + o) = v; u32x2 w; w.x = pk2h(v.x, v.y); w.y = pk2h(v.z, v.w); *(u32x2*)(o16 + o) = w; sq += (v.x * v.x + v.y * v.y) + (v.z * v.z + v.w * v.w); }
                sq += __shfl_xor(sq, 16); sq += __shfl_xor(sq, 32);
                if (fq == 0) ss[(size_t)row * 16 + u.pn * 4 + wc] = sq;
                asm volatile("" ::: "memory");
            }
    }
};
struct EpiProj {
    static constexpr bool PERM = true;
    unsigned char* ws; const float* ss;
    __device__ __forceinline__ void operator()(const Acc& acc, const Unit& u, int wr, int wc, int fr, int fq) const {
        const int pn = u.pn; h16* base; int ldc, c0; float sc = 1.f; int nbj = 2;
        if (pn < 2) { base = (h16*)(ws + WS_MIX); ldc = 1024; c0 = pn * 256; sc = 0.125f; }
        else if (pn < 12) { base = (h16*)(ws + WS_KNA + (size_t)((pn - 2) >> 1) * (96 * MiB)); ldc = 512; c0 = ((pn - 2) & 1) * 256; }
        else { base = (h16*)(ws + WS_LOWS); ldc = 384; c0 = (pn - 12) * 256; if (pn == 13) nbj = 1; }
        const int row0 = u.pm * BM + wr * 64 + fr, col0 = c0 + wc * 32 + 8 * fq;
#pragma unroll
        for (int ai = 0; ai < 2; ++ai)
#pragma unroll
            for (int m = 0; m < 4; ++m) {
                const int row = row0 + ai * HALF + m * 16; const float rs = row_rstd(ss, row) * sc;
#pragma unroll
                for (int bj = 0; bj < 2; ++bj) if (bj < nbj) {
                    const f32x4 v0 = acc[ai][bj][m][0] * rs, v1 = acc[ai][bj][m][1] * rs;
                    u32x4 w; w.x = pk2h(v0.x, v0.y); w.y = pk2h(v0.z, v0.w); w.z = pk2h(v1.x, v1.y); w.w = pk2h(v1.z, v1.w);
                    *(u32x4*)(base + (size_t)row * ldc + col0 + bj * HALF) = w; }
            }
    }
};
struct EpiPU {
    static constexpr bool PERM = true;
    h16* O;
    __device__ __forceinline__ void operator()(const Acc& acc, const Unit& u, int wr, int wc, int fr, int fq) const {
        const int row0 = u.pm * BM + wr * 64 + fr, col0 = u.pn * BM + wc * 32 + 8 * fq;
#pragma unroll
        for (int ai = 0; ai < 2; ++ai)
#pragma unroll
            for (int m = 0; m < 4; ++m) {
                const int row = row0 + ai * HALF + m * 16;
#pragma unroll
                for (int bj = 0; bj < 2; ++bj) {
                    const f32x4 v0 = acc[ai][bj][m][0], v1 = acc[ai][bj][m][1];
                    u32x4 w; w.x = pk2h(v0.x, v0.y); w.y = pk2h(v0.z, v0.w); w.z = pk2h(v1.x, v1.y); w.w = pk2h(v1.z, v1.w);
                    *(u32x4*)(O + (size_t)row * D + col0 + bj * HALF) = w; }
            }
    }
};
struct EpiPle {
    static constexpr bool PERM = false;
    float* out; h16* o16; float* ssw; const float* ssr; const h16* pu;
    __device__ __forceinline__ void operator()(const Acc& acc, const Unit& u, int wr, int wc, int fr, int fq) const {
        const int row0 = u.pm * BM + wr * 64 + fr, col0 = u.pn * BM + wc * 32 + 4 * fq;
#pragma unroll
        for (int ai = 0; ai < 2; ++ai)
#pragma unroll
            for (int m = 0; m < 4; ++m) {
                const int row = row0 + ai * HALF + m * 16; const size_t off = (size_t)row * D + col0; float sq = 0.f; const float rs = row_rstd(ssr, row);
#pragma unroll
                for (int bj = 0; bj < 2; ++bj)
#pragma unroll
                    for (int n = 0; n < 2; ++n) { const size_t o = off + bj * HALF + n * 16; const f32x4 r = *(const f32x4*)(out + o); const h16x4 p = *(const h16x4*)(pu + o);
                        const f32x4 a = acc[ai][bj][m][n] * rs; f32x4 v;
                        v.x = r.x + sigmoidf_(a.x) * (float)p.x; v.y = r.y + sigmoidf_(a.y) * (float)p.y; v.z = r.z + sigmoidf_(a.z) * (float)p.z; v.w = r.w + sigmoidf_(a.w) * (float)p.w;
                        *(f32x4*)(out + o) = v; u32x2 w; w.x = pk2h(v.x, v.y); w.y = pk2h(v.z, v.w); *(u32x2*)(o16 + o) = w; sq += (v.x * v.x + v.y * v.y) + (v.z * v.z + v.w * v.w); }
                sq += __shfl_xor(sq, 16); sq += __shfl_xor(sq, 32);
                if (fq == 0) ssw[(size_t)row * 16 + u.pn * 4 + wc] = sq;
                asm volatile("" ::: "memory");
            }
    }
};
}

__device__ __forceinline__ void convert_matrix(const float* W, int K, int N, const float* gamma, h16* WT, int mode, LAS float* scr, int gw, int NGW, int lane) {
    const int nblk = N / 32, nitems = (K / 64) * nblk;
    for (int item = gw; item < nitems; item += NGW) {
        const int kb = item / nblk, nb = item % nblk, k0 = 64 * kb, n0 = 32 * nb;
        const int drow0 = (mode == 0) ? n0 : ((n0 >> 7) * 256 + (n0 & 127) + (mode == 2 ? 128 : 0));
#pragma unroll 8
        for (int i = 0; i < 32; ++i) { const int kk = 2 * i + (lane >> 5); float v = W[(size_t)(k0 + kk) * N + n0 + (lane & 31)]; if (gamma) v *= gamma[k0 + kk]; scr[kk * 33 + (lane & 31)] = v; }
        asm volatile("s_waitcnt lgkmcnt(0)" ::: "memory");
        const int c = lane & 7;
#pragma unroll
        for (int j = 0; j < 4; ++j) { const int n = (lane >> 3) + 8 * j; const LAS float* s = scr + (8 * c) * 33 + n;
            u32x4 o; o.x = pk2h(s[0 * 33], s[1 * 33]); o.y = pk2h(s[2 * 33], s[3 * 33]); o.z = pk2h(s[4 * 33], s[5 * 33]); o.w = pk2h(s[6 * 33], s[7 * 33]);
            *(u32x4*)(WT + (size_t)(drow0 + n) * K + k0 + 8 * c) = o; }
        asm volatile("s_waitcnt lgkmcnt(0)" ::: "memory");
    }
}

__device__ __forceinline__ void phase_convert(const Args& a, int layer, LAS unsigned char* lds, int tid, int lane, int wave, int bid, int G) {
    LAS float* scr = (LAS float*)(lds + wave * 16384);
    const int gw = bid * NWAVES + wave, NGW = G * NWAVES;
    h16* W = (h16*)(a.ws + WS_W);
    const size_t l = (size_t)layer;
    convert_matrix(a.in[I_F1G] + l * D * FF, D, FF, a.in[I_F1N] + l * D, W + W_FFN1U, 1, scr, gw, NGW, lane);
    convert_matrix(a.in[I_F1U] + l * D * FF, D, FF, a.in[I_F1N] + l * D, W + W_FFN1U, 2, scr, gw, NGW, lane);
    convert_matrix(a.in[I_F1D] + l * FF * D, FF, D, nullptr, W + W_FFN1D, 0, scr, gw, NGW, lane);
    convert_matrix(a.in[I_WIN] + l * D * 3456, D, 3456, a.in[I_MIXN] + l * D, W + W_IN, 0, scr, gw, NGW, lane);
    convert_matrix(a.in[I_WOUT] + l * D * D, D, D, nullptr, W + W_OUT, 0, scr, gw, NGW, lane);
    convert_matrix(a.in[I_F2G] + l * D * FF, D, FF, a.in[I_F2N] + l * D, W + W_FFN2U, 1, scr, gw, NGW, lane);
    convert_matrix(a.in[I_F2U] + l * D * FF, D, FF, a.in[I_F2N] + l * D, W + W_FFN2U, 2, scr, gw, NGW, lane);
    convert_matrix(a.in[I_F2D] + l * FF * D, FF, D, nullptr, W + W_FFN2D, 0, scr, gw, NGW, lane);
    convert_matrix(a.in[I_PLEG] + l * D * D, D, D, a.in[I_PLEN] + l * D, W + W_GATE, 0, scr, gw, NGW, lane);
    convert_matrix(a.in[I_PLEU] + l * PLE * D, PLE, D, nullptr, W + W_UP, 0, scr, gw, NGW, lane);
    { u32x4* z = (u32x4*)(W + W_IN + (size_t)3456 * 1024); const int n16 = 128 * 1024 * 2 / 16;
      for (int i = bid * NTHREADS + tid; i < n16; i += G * NTHREADS) z[i] = (u32x4){0u, 0u, 0u, 0u}; }
    if (layer == 0) {
        h16* H = (h16*)(a.ws + WS_H16B); float* ss = (float*)(a.ws + WS_SSB);
        for (int m = gw; m < M; m += NGW) {
            const float* xr = (m < MP) ? a.in[I_XP] + (size_t)m * D : a.in[I_XS] + (size_t)(m - MP) * D;
            const f32x4* x4 = (const f32x4*)xr + lane; float s = 0.f;
            u32x2* o = (u32x2*)(H + (size_t)m * D) + lane;
#pragma unroll
            for (int j = 0; j < 4; ++j) { const f32x4 v = x4[64 * j]; s += (v.x * v.x + v.y * v.y) + (v.z * v.z + v.w * v.w); u32x2 w; w.x = pk2h(v.x, v.y); w.y = pk2h(v.z, v.w); o[64 * j] = w; }
            s = wave_sum(s);
            if (lane < 16) ss[(size_t)m * 16 + lane] = (lane == 0) ? s : 0.f;
        }
    }
}

__device__ __forceinline__ void convert_p(const Args& a, int layer, int tid, int bid, int G) {
    u32x2* o = (u32x2*)(a.ws + WS_P16);
    const f32x4* pp = (const f32x4*)(a.in[I_PP] + (size_t)layer * MP * PLE);
    const f32x4* ps = (const f32x4*)(a.in[I_PS] + (size_t)layer * MS * PLE);
    const int NP4 = MP * PLE / 4, NT4 = M * PLE / 4;
    for (int i = bid * NTHREADS + tid; i < NT4; i += G * NTHREADS) { const f32x4 v = (i < NP4) ? pp[i] : ps[i - NP4]; u32x2 w; w.x = pk2h(v.x, v.y); w.y = pk2h(v.z, v.w); o[i] = w; }
}

constexpr int NA_PITCH = 144;
constexpr int NA_VOFF = 512 * NA_PITCH;
constexpr int NA_PP = 67;
__device__ __forceinline__ void na_item(const Args& a, int layer, int item, LAS unsigned char* lds, int tid, int lane, int wave) {
    int tok0, i, rows;
    if (item < 1024) { tok0 = (item >> 6) * TP; i = item & 63; rows = 64; } else { const int it2 = item - 1024; tok0 = MP + (it2 >> 8) * TS; i = it2 & 255; rows = 256; }
    int rs = i - 4; rs = rs < 0 ? 0 : (rs > rows - 8 ? rows - 8 : rs);
    h16* MIX = (h16*)(a.ws + WS_MIX); const h16* KNA = (const h16*)(a.ws + WS_KNA); const h16* VNA = (const h16*)(a.ws + WS_VNA);
    const float* rpb = a.in[I_RPB] + (size_t)layer * 8 * 15 * 31;
    const int wtok0 = tok0 + rs * 64;
    const int j = lane, aw = wave;
    const int tokq = tok0 + i * 64 + j;
    int cs = j - 8; cs = cs < 0 ? 0 : (cs > 48 ? 48 : cs);
#pragma unroll 1
    for (int h = 0; h < 8; ++h) {
#pragma unroll
        for (int it = 0; it < 8; ++it) { const int key = (tid >> 3) + 64 * it, ch = tid & 7;
            const u32x4 kv = *(const u32x4*)(KNA + (size_t)(wtok0 + key) * 512 + h * 64 + ch * 8);
            const u32x4 vv = *(const u32x4*)(VNA + (size_t)(wtok0 + key) * 512 + h * 64 + ch * 8);
            *(LAS u32x4*)(lds + key * NA_PITCH + ch * 16) = kv; *(LAS u32x4*)(lds + NA_VOFF + key * NA_PITCH + ch * 16) = vv; }
        u32x4 qv[8];
#pragma unroll
        for (int c = 0; c < 8; ++c) qv[c] = *(const u32x4*)(MIX + (size_t)tokq * 1024 + h * 64 + c * 8);
        __syncthreads();
        float sc[16];
        const float* bias = rpb + ((size_t)h * 15 + (rs + aw - i + 7)) * 31 + (cs - j + 15);
#pragma unroll
        for (int c = 0; c < 16; ++c) {
            const LAS unsigned char* kp = lds + (aw * 64 + cs + c) * NA_PITCH; float s = 0.f;
#pragma unroll
            for (int c8 = 0; c8 < 8; ++c8) { const u32x4 kk = *(const LAS u32x4*)(kp + c8 * 16); s = dot8(qv[c8], kk, s); }
            sc[c] = s + bias[c];
            asm volatile("" ::: "memory");
        }
        float mx = sc[0];
#pragma unroll
        for (int c = 1; c < 16; ++c) mx = fmaxf(mx, sc[c]);
        float l = 0.f;
#pragma unroll
        for (int c = 0; c < 16; ++c) { sc[c] = __expf(sc[c] - mx); l += sc[c]; }
        float o[64];
#pragma unroll
        for (int d = 0; d < 64; ++d) o[d] = 0.f;
#pragma unroll
        for (int c = 0; c < 16; ++c) {
            const LAS unsigned char* vp = lds + NA_VOFF + (aw * 64 + cs + c) * NA_PITCH; const float p = sc[c];
#pragma unroll
            for (int c8 = 0; c8 < 8; ++c8) { const u32x4 vv = *(const LAS u32x4*)(vp + c8 * 16);
#pragma unroll
                for (int e = 0; e < 4; ++e) { const unsigned ve = vv[e]; o[c8 * 8 + 2 * e] = fma_mix_lo(p, ve, o[c8 * 8 + 2 * e]); o[c8 * 8 + 2 * e + 1] = fma_mix_hi(p, ve, o[c8 * 8 + 2 * e + 1]); } }
            asm volatile("" ::: "memory");
        }
        __syncthreads();
        LAS float* part = (LAS float*)lds + (size_t)(aw * 64 + j) * NA_PP;
#pragma unroll
        for (int d = 0; d < 64; ++d) part[d] = o[d];
        part[64] = mx; part[65] = l;
        __syncthreads();
        {
            const int jq = tid & 63, e8 = tid >> 6;
            float mw[8], M_ = -3.0e38f;
#pragma unroll
            for (int w = 0; w < 8; ++w) { mw[w] = ((const LAS float*)lds)[(size_t)(w * 64 + jq) * NA_PP + 64]; M_ = fmaxf(M_, mw[w]); }
            float L = 0.f, ov[8];
#pragma unroll
            for (int e = 0; e < 8; ++e) ov[e] = 0.f;
#pragma unroll
            for (int w = 0; w < 8; ++w) { const float f = __expf(mw[w] - M_); const LAS float* pw = (const LAS float*)lds + (size_t)(w * 64 + jq) * NA_PP; L += f * pw[65];
#pragma unroll
                for (int e = 0; e < 8; ++e) ov[e] += f * pw[e8 * 8 + e]; }
            const float inv = 1.0f / L;
            u32x4 w4; w4.x = pk2h(ov[0] * inv, ov[1] * inv); w4.y = pk2h(ov[2] * inv, ov[3] * inv); w4.z = pk2h(ov[4] * inv, ov[5] * inv); w4.w = pk2h(ov[6] * inv, ov[7] * inv);
            *(u32x4*)(MIX + (size_t)(tok0 + i * 64 + jq) * 1024 + h * 64 + e8 * 8) = w4;
        }
        __syncthreads();
    }
}

__device__ __forceinline__ float shiftmix(const h16* base, size_t stride, int t, int T, float mu) {
    const float c = (float)base[0];
    const float p = (t > 0) ? (float)*(base - stride) : 0.f;
    const float n = (t < T - 1) ? (float)*(base + stride) : 0.f;
    return c + mu * (0.5f * (p + n) - c);
}
constexpr int SC_CH = 32;
constexpr int SC_OPB = SC_CH * 6 * 64 * 4;
constexpr int SC_YOFF = 2 * SC_OPB;
constexpr int SC_YB = SC_CH * 64 * 4;
constexpr int SC_XOFF = SC_YOFF + 2 * SC_YB;
__device__ __forceinline__ float wave_sum_fast(float v) {
    v = row16_sum(v);
    { const auto r = __builtin_amdgcn_permlane16_swap(__builtin_bit_cast(unsigned, v), __builtin_bit_cast(unsigned, v), false, false);
      const unsigned r0 = r[0], r1 = r[1]; v = __builtin_bit_cast(float, r0) + __builtin_bit_cast(float, r1); }
    { const auto r = __builtin_amdgcn_permlane32_swap(__builtin_bit_cast(unsigned, v), __builtin_bit_cast(unsigned, v), false, false);
      const unsigned r0 = r[0], r1 = r[1]; v = __builtin_bit_cast(float, r0) + __builtin_bit_cast(float, r1); }
    return v;
}
__device__ __forceinline__ float mix3(h16 p, h16 c, h16 n, float mu) { const float cf = (float)c; return cf + mu * (0.5f * ((float)p + (float)n) - cf); }
struct ScanWin { h16 r[10], k[10], v[10], wl[10], al[10]; };
template <int R>
__device__ __forceinline__ void scan_flush(LAS unsigned char* lds, int cf, int pw, int lane, int d, int T, int tok0, int h, int rowbase, h16* Yf, h16* Yb) {
    const LAS float* yb = (const LAS float*)(lds + SC_YOFF + (cf & 1) * SC_YB);
    const int s = pw * 8 + (lane >> 3); const int g = cf * SC_CH + s; const int t = d ? (T - 1 - g) : g;
    if (R == 4) {
        const int r8 = (lane & 7) * 8;
        const f32x4 y0 = *(const LAS f32x4*)(yb + s * 64 + r8), y1 = *(const LAS f32x4*)(yb + s * 64 + r8 + 4);
        u32x4 w4; w4.x = pk2h(y0.x, y0.y); w4.y = pk2h(y0.z, y0.w); w4.z = pk2h(y1.x, y1.y); w4.w = pk2h(y1.z, y1.w);
        if (d == 0) *(u32x4*)(Yf + (size_t)(tok0 + t) * 1024 + 512 + h * 64 + r8) = w4; else *(u32x4*)(Yb + (size_t)(tok0 + t) * 512 + h * 64 + r8) = w4;
    } else {
        const int r4 = (lane & 7) * 4;
        const f32x4 y0 = *(const LAS f32x4*)(yb + s * 32 + r4);
        u32x2 w2; w2.x = pk2h(y0.x, y0.y); w2.y = pk2h(y0.z, y0.w);
        if (d == 0) *(u32x2*)(Yf + (size_t)(tok0 + t) * 1024 + 512 + h * 64 + rowbase + r4) = w2; else *(u32x2*)(Yb + (size_t)(tok0 + t) * 512 + h * 64 + rowbase + r4) = w2;
    }
}
template <int R>
__device__ __forceinline__ void scan_item(const Args& a, int layer, int q, int rowhalf, LAS unsigned char* lds, int tid, int lane, int wave) {
    int tok0, T, h, d;
    if (q < 32) { tok0 = MP + (q >> 4) * TS; T = TS; h = (q >> 1) & 7; d = q & 1; } else { const int q2 = q - 32; tok0 = (q2 >> 4) * TP; T = TP; h = (q2 >> 1) & 7; d = q2 & 1; }
    const int nch = T / SC_CH, rowbase = rowhalf * 16 * R;
    const h16* RR = (const h16*)(a.ws + WS_RR); const h16* RK = (const h16*)(a.ws + WS_RK); const h16* RV = (const h16*)(a.ws + WS_RV); const h16* LOWS = (const h16*)(a.ws + WS_LOWS);
    h16* Yf = (h16*)(a.ws + WS_MIX); h16* Yb = (h16*)(a.ws + WS_YB); float* BSC = (float*)(a.ws + WS_BSC);
    const size_t l = (size_t)layer;
    if (wave >= 4) {
        const int pw = wave - 4, j = lane, col = h * 64 + j;
        const float* mu = a.in[I_MU] + l * 1920;
        const float mu_r = mu[col], mu_k = mu[512 + col], mu_v = mu[1024 + col], mu_wl = mu[1536 + d * 64 + j], mu_al = mu[1536 + 128 + d * 64 + j];
        const float k_k = a.in[I_KK][l * 512 + col], k_a = a.in[I_KA][l * 512 + col], r_k = a.in[I_RK][l * 512 + col];
        const float w0 = a.in[I_W0][(l * 2 + d) * 512 + col], a0 = a.in[I_A0][(l * 2 + d) * 512 + col];
        h16x2 wup[32], aup[32];
        { const float* wu = a.in[I_WUP] + ((l * 2 + d) * 64) * 512 + col; const float* au = a.in[I_AUP] + ((l * 2 + d) * 64) * 512 + col;
#pragma unroll
          for (int i2 = 0; i2 < 32; ++i2) { const float w0_ = wu[0], w1_ = wu[512], a0_ = au[0], a1_ = au[512]; wu += 1024; au += 1024; asm volatile("" : "+v"(wu), "+v"(au));
              wup[i2] = (h16x2){(h16)w0_, (h16)w1_}; aup[i2] = (h16x2){(h16)a0_, (h16)a1_}; } }
        LAS unsigned char* xsb = lds + SC_XOFF + pw * 2048;
        ScanWin cur, nxt;
#define SCAN_LOAD_WIN(W_, cp_) do { const int g0_ = (cp_) * SC_CH + pw * 8; \
            _Pragma("unroll") for (int w = 0; w < 10; ++w) { const int tt = d ? (T - 1 - g0_) + 1 - w : g0_ - 1 + w; const bool ok = (tt >= 0) && (tt < T); const size_t tok = (size_t)(tok0 + (ok ? tt : 0)); \
                const h16 z_ = (h16)0.f; const h16 r_ = RR[tok * 512 + col], k_ = RK[tok * 512 + col], v_ = RV[tok * 512 + col], wl_ = LOWS[tok * 384 + d * 64 + j], al_ = LOWS[tok * 384 + 128 + d * 64 + j]; \
                W_.r[w] = ok ? r_ : z_; W_.k[w] = ok ? k_ : z_; W_.v[w] = ok ? v_ : z_; W_.wl[w] = ok ? wl_ : z_; W_.al[w] = ok ? al_ : z_; } } while (0)
        SCAN_LOAD_WIN(cur, 0);
        for (int c = -1; c < nch; ++c) {
            if (c >= 1) scan_flush<R>(lds, c - 1, pw, lane, d, T, tok0, h, rowbase, Yf, Yb);
            if (c + 1 < nch) {
                const int cp = c + 1; LAS float* op = (LAS float*)(lds + (cp & 1) * SC_OPB);
                if (c + 2 < nch) SCAN_LOAD_WIN(nxt, c + 2);
#pragma unroll
                for (int s8 = 0; s8 < 8; ++s8) {
                    const int s = pw * 8 + s8; const int g = cp * SC_CH + s; const int t = d ? (T - 1 - g) : g; const size_t tok = (size_t)(tok0 + t);
                    const float wl = mix3(cur.wl[s8], cur.wl[s8 + 1], cur.wl[s8 + 2], mu_wl);
                    const float al = mix3(cur.al[s8], cur.al[s8 + 1], cur.al[s8 + 2], mu_al);
                    const float rr = mix3(cur.r[s8], cur.r[s8 + 1], cur.r[s8 + 2], mu_r);
                    const float kk0 = mix3(cur.k[s8], cur.k[s8 + 1], cur.k[s8 + 2], mu_k);
                    const float vv = mix3(cur.v[s8], cur.v[s8 + 1], cur.v[s8 + 2], mu_v);
                    const float e2 = __expf(2.0f * wl); const float th = 1.0f - 2.0f * __builtin_amdgcn_rcpf(e2 + 1.0f);
                    LAS h16* xs = (LAS h16*)(xsb + s8 * 256);
                    xs[j] = (h16)th; xs[64 + j] = (h16)al;
                    float z = w0, az = a0;
#pragma unroll
                    for (int c8 = 0; c8 < 8; ++c8) { const u32x4 xw = *(const LAS u32x4a*)((const LAS unsigned char*)xs + c8 * 16), xa = *(const LAS u32x4a*)((const LAS unsigned char*)xs + 128 + c8 * 16);
                        z = dot8w(xw, wup[c8 * 4 + 0], wup[c8 * 4 + 1], wup[c8 * 4 + 2], wup[c8 * 4 + 3], z);
                        az = dot8w(xa, aup[c8 * 4 + 0], aup[c8 * 4 + 1], aup[c8 * 4 + 2], aup[c8 * 4 + 3], az); }
                    const float wdec = __expf(-0.606531f * sigmoidf_(z)); const float av = sigmoidf_(az);
                    float kk = kk0 * k_k; const float n2 = wave_sum_fast(kk * kk); kk = kk * __builtin_amdgcn_rcpf(fmaxf(__builtin_amdgcn_sqrtf(n2), 1e-12f));
                    const float kd = kk0 * (1.0f + (av - 1.0f) * k_a); const float bb = kk * av;
                    const float bs = wave_sum_fast(rr * kd * r_k);
                    if (lane == 0 && rowhalf == 0) BSC[(tok * 8 + h) * 2 + d] = bs;
                    LAS float* o = op + s * 384 + j;
                    o[0] = -kk; o[64] = wdec; o[128] = bb; o[192] = kd; o[256] = rr; o[320] = vv;
                }
                cur = nxt;
            }
            __syncthreads();
        }
        scan_flush<R>(lds, nch - 1, pw, lane, d, T, tok0, h, rowbase, Yf, Yb);
#undef SCAN_LOAD_WIN
    } else {
        const int ri = lane >> 4, ci = lane & 15;
        const int vrow = rowbase + wave * 4 * R + ri * R, yrow = wave * 4 * R + ri * R;
        f32x2 S[R][2];
#pragma unroll
        for (int i = 0; i < R; ++i) { S[i][0] = (f32x2){0.f, 0.f}; S[i][1] = (f32x2){0.f, 0.f}; }
        typedef float vecR __attribute__((ext_vector_type(R)));
        __syncthreads();
        for (int c = 0; c < nch; ++c) {
            const LAS f32x4* op = (const LAS f32x4*)(lds + (c & 1) * SC_OPB);
            LAS float* yb = (LAS float*)(lds + SC_YOFF + (c & 1) * SC_YB);
            f32x4 a4 = op[ci], w4 = op[16 + ci], b4 = op[32 + ci], k4 = op[48 + ci], r4 = op[64 + ci]; vecR v4 = *(const LAS vecR*)((const LAS float*)op + 320 + vrow);
#pragma unroll 2
            for (int s = 0; s < SC_CH; ++s) {
                const int sn = (s + 1 < SC_CH) ? s + 1 : s; const LAS f32x4* on = op + sn * 96;
                const f32x4 na4 = on[ci], nw4 = on[16 + ci], nb4 = on[32 + ci], nk4 = on[48 + ci], nr4 = on[64 + ci]; const vecR nv4 = *(const LAS vecR*)((const LAS float*)on + 320 + vrow);
                const f32x2 a01 = {a4.x, a4.y}, a23 = {a4.z, a4.w}, w01 = {w4.x, w4.y}, w23 = {w4.z, w4.w}, b01 = {b4.x, b4.y}, b23 = {b4.z, b4.w};
                const f32x2 k01 = {k4.x, k4.y}, k23 = {k4.z, k4.w}, r01 = {r4.x, r4.y}, r23 = {r4.z, r4.w};
                float sa[R];
#pragma unroll
                for (int i = 0; i < R; ++i) { const f32x2 p = S[i][0] * a01 + S[i][1] * a23; sa[i] = row16_sum(p.x + p.y); }
                vecR y;
#pragma unroll
                for (int i = 0; i < R; ++i) { const f32x2 sa2 = {sa[i], sa[i]}, v2 = {v4[i], v4[i]};
                    S[i][0] = S[i][0] * w01 + sa2 * b01 + v2 * k01; S[i][1] = S[i][1] * w23 + sa2 * b23 + v2 * k23;
                    const f32x2 p = S[i][0] * r01 + S[i][1] * r23; y[i] = row16_sum(p.x + p.y); }
                if (ci == 0) *(LAS vecR*)(yb + s * (16 * R) + yrow) = y;
                a4 = na4; w4 = nw4; b4 = nb4; k4 = nk4; r4 = nr4; v4 = nv4;
            }
            __syncthreads();
        }
    }
}

__device__ __forceinline__ void rwpost_tile(const Args& a, int layer, int tile, LAS unsigned char* lds, int tid, int lane, int wave) {
    const size_t l = (size_t)layer; const int col = tid, h = wave;
    const int m0 = tile * 64; int tok0s, T; if (m0 < MP) { T = TP; tok0s = (m0 / TP) * TP; } else { T = TS; tok0s = MP + ((m0 - MP) / TS) * TS; }
    const h16* LOWS = (const h16*)(a.ws + WS_LOWS); const h16* RV = (const h16*)(a.ws + WS_RV); h16* MIX = (h16*)(a.ws + WS_MIX); const h16* Yb = (const h16*)(a.ws + WS_YB); const float* BSC = (const float*)(a.ws + WS_BSC);
    const float* mu = a.in[I_MU] + l * 1920;
    LAS h16* G = (LAS h16*)lds;
    for (int e = tid; e < 64 * 128; e += NTHREADS) { const int tk = e >> 7, c = e & 127; const int m = m0 + tk; const int t = m - tok0s;
        const float gl = shiftmix(LOWS + (size_t)m * 384 + 256 + c, 384, t, T, mu[1536 + 256 + c]); G[e] = (h16)sigmoidf_(gl); }
    h16x2 gup[64];
    { const float* gu = a.in[I_GUP] + l * 128 * 512 + col;
#pragma unroll
      for (int i2 = 0; i2 < 64; ++i2) { const float g0 = gu[0], g1 = gu[512]; gu += 1024; asm volatile("" : "+v"(gu)); gup[i2] = (h16x2){(h16)g0, (h16)g1}; } }
    const float mu_v = mu[1024 + col], lw = a.in[I_LNW][l * 512 + col], lb = a.in[I_LNB][l * 512 + col];
    __syncthreads();
#pragma unroll 1
    for (int tk = 0; tk < 64; ++tk) {
        const int m = m0 + tk; const int t = m - tok0s;
        float g = 0.f;
#pragma unroll
        for (int c8 = 0; c8 < 16; ++c8) { const u32x4 x = *(const LAS u32x4a*)((const LAS unsigned char*)G + tk * 256 + c8 * 16);
            g = dot8w(x, gup[c8 * 4 + 0], gup[c8 * 4 + 1], gup[c8 * 4 + 2], gup[c8 * 4 + 3], g); }
        const float wkv = (float)MIX[(size_t)m * 1024 + 512 + col] + (float)Yb[(size_t)m * 512 + col];
        const float mean = wave_sum(wkv) * (1.0f / 64.0f); const float dv = wkv - mean; const float var = wave_sum(dv * dv) * (1.0f / 64.0f);
        const float yn = dv * __builtin_amdgcn_rsqf(var + 64e-5f) * lw + lb;
        const float vv = shiftmix(RV + (size_t)m * 512 + col, 512, t, T, mu_v);
        const float bs = BSC[((size_t)m * 8 + h) * 2] + BSC[((size_t)m * 8 + h) * 2 + 1];
        MIX[(size_t)m * 1024 + 512 + col] = (h16)((yn + bs * vv) * g);
    }
    __syncthreads();
}

__global__ void __launch_bounds__(NTHREADS, 2) fwd_megakernel(Args args) {
    extern __shared__ __attribute__((aligned(16))) unsigned char lds_raw[];
    LAS unsigned char* lds = (LAS unsigned char*)lds_raw;
    cg::grid_group grid = cg::this_grid();
    const int bid = blockIdx.x, G = gridDim.x;
#define FRESH_TID int tid = threadIdx.x; asm volatile("" : "+v"(tid)); const int lane = tid & 63, wave = __builtin_amdgcn_readfirstlane(tid >> 6); (void)lane; (void)wave;
    unsigned char* ws = args.ws;
    h16* W = (h16*)(ws + WS_W); float* SSA = (float*)(ws + WS_SSA); float* SSB = (float*)(ws + WS_SSB); h16* H16 = (h16*)(ws + WS_H16);
    float* out = args.out;

    for (int layer = 0; layer < 2; ++layer) {
        if (PH(0)) { FRESH_TID phase_convert(args, layer, lds, tid, lane, wave, bid, G); }
        grid_sync(grid);
        if (PH(1)) { FRESH_TID pg8::Gemm g{(const h16*)(ws + WS_H16B), W + W_FFN1U, M, 2 * FF, D, D}; pg8::StaticOrder S; S.init(M, 2 * FF, G, bid); pg8::EpiSwiglu E{(h16*)(ws + WS_ACT), SSB}; pg8::gemm_phase(lds, g, S, E, tid); }
        grid_sync(grid);
        if (PH(2)) { FRESH_TID pg8::Gemm g{(const h16*)(ws + WS_ACT), W + W_FFN1D, M, D, FF, FF}; pg8::StaticOrder S; S.init(M, D, G, bid);
          const float* rp = layer == 0 ? args.in[I_XP] : (const float*)out; const float* rsm = layer == 0 ? args.in[I_XS] - (size_t)MP * D : (const float*)out;
          pg8::EpiResid E{rp, rsm, out, H16, SSA, 0.5f}; pg8::gemm_phase(lds, g, S, E, tid); }
        grid_sync(grid);
        if (PH(3)) { FRESH_TID pg8::Gemm g{H16, W + W_IN, M, NPROJ, D, D}; pg8::StaticOrder S; S.init(M, NPROJ, G, bid); pg8::EpiProj E{ws, SSA}; pg8::gemm_phase(lds, g, S, E, tid); }
        grid_sync(grid);
        {
            if (PH(4)) { FRESH_TID
                if (bid < 64) { scan_item<2>(args, layer, bid >> 1, bid & 1, lds, tid, lane, wave); }
                else { scan_item<4>(args, layer, 32 + (bid - 64), 0, lds, tid, lane, wave); __syncthreads();
                       if (bid < 128) { scan_item<4>(args, layer, 32 + 192 + (bid - 64), 0, lds, tid, lane, wave); } }
                __syncthreads(); }
            if (PH(5)) if (bid >= 64) { FRESH_TID for (int it = bid - 64; it < 1536; it += G - 64) na_item(args, layer, it, lds, tid, lane, wave); }
        }
        grid_sync(grid);
        if (PH(6)) { FRESH_TID for (int tile = bid; tile < M / 64; tile += G) rwpost_tile(args, layer, tile, lds, tid, lane, wave); }
        grid_sync(grid);
        if (PH(7)) { FRESH_TID pg8::Gemm g{(const h16*)(ws + WS_MIX), W + W_OUT, M, D, D, D}; pg8::StaticOrder S; S.init(M, D, G, bid); pg8::EpiResid E{out, out, out, H16, SSA, 1.0f}; pg8::gemm_phase(lds, g, S, E, tid); }
        grid_sync(grid);
        if (PH(8)) { FRESH_TID pg8::Gemm g{H16, W + W_FFN2U, M, 2 * FF, D, D}; pg8::StaticOrder S; S.init(M, 2 * FF, G, bid); pg8::EpiSwiglu E{(h16*)(ws + WS_ACT), SSA}; pg8::gemm_phase(lds, g, S, E, tid); }
        grid_sync(grid);
        if (PH(9)) { FRESH_TID pg8::Gemm g{(const h16*)(ws + WS_ACT), W + W_FFN2D, M, D, FF, FF}; pg8::StaticOrder S; S.init(M, D, G, bid); pg8::EpiResid E{out, out, out, H16, SSA, 0.5f}; pg8::gemm_phase(lds, g, S, E, tid);
          convert_p(args, layer, tid, bid, G); }
        grid_sync(grid);
        if (PH(10)) { FRESH_TID int kpu = PLE; asm volatile("" : "+s"(kpu)); pg8::Gemm g{(const h16*)(ws + WS_P16), W + W_UP, M, D, kpu, kpu}; pg8::StaticOrder S; S.init(M, D, G, bid); pg8::EpiPU E{(h16*)(ws + WS_PU)}; pg8::gemm_phase(lds, g, S, E, tid); }
        grid_sync(grid);
        if (PH(11)) { FRESH_TID pg8::Gemm g{H16, W + W_GATE, M, D, D, D}; pg8::StaticOrder S; S.init(M, D, G, bid); pg8::EpiPle E{out, (h16*)(ws + WS_H16B), SSB, SSA, (const h16*)(ws + WS_PU)}; pg8::gemm_phase(lds, g, S, E, tid); }
        grid_sync(grid);
    }
    {
        FRESH_TID
        const int gw = bid * NWAVES + wave, NGW = G * NWAVES; const f32x4* gm = (const f32x4*)args.in[I_FINAL] + lane;
        f32x4 gv[4];
#pragma unroll
        for (int j = 0; j < 4; ++j) gv[j] = gm[64 * j];
        for (int m = gw; m < M; m += NGW) {
            const float rs = row_rstd(SSB, m); f32x4* o = (f32x4*)(out + (size_t)m * D) + lane;
#pragma unroll
            for (int j = 0; j < 4; ++j) { const f32x4 v = o[64 * j]; o[64 * j] = v * rs * gv[j]; }
        }
    }
}

extern "C" void kernel_launch(void* const* d_in, const int* in_sizes, int n_in, void* d_out, int out_size, void* d_ws, size_t ws_size, hipStream_t stream) {
    static int grid = 0;
    if (grid == 0) {
        if (n_in != N_IN || out_size != M * D || ws_size < WS_END) { fprintf(stderr, "kernel_launch: unexpected shapes (n_in %d, out %d, ws %zu)\n", n_in, out_size, ws_size); grid = -1; return; }
        int dev = 0, cus = 0, per_cu = 0;
        (void)hipGetDevice(&dev); (void)hipDeviceGetAttribute(&cus, hipDeviceAttributeMultiprocessorCount, dev);
        (void)hipFuncSetAttribute((const void*)fwd_megakernel, hipFuncAttributeMaxDynamicSharedMemorySize, LDS_BYTES);
        (void)hipOccupancyMaxActiveBlocksPerMultiprocessor(&per_cu, (const void*)fwd_megakernel, NTHREADS, LDS_BYTES);
        if (per_cu < 1) fprintf(stderr, "kernel_launch: occupancy query says %d blocks per CU\n", per_cu);
        grid = cus;
        if (grid != 256) fprintf(stderr, "kernel_launch: grid %d (expected 256)\n", grid);
    }
    if (grid < 0) return;
    Args a{};
    for (int i = 0; i < N_IN; ++i) a.in[i] = (const float*)d_in[i];
    a.out = (float*)d_out; a.ws = (unsigned char*)d_ws;
    void* kargs[] = {&a};
    hipError_t e = hipLaunchCooperativeKernel((const void*)fwd_megakernel, dim3(grid), dim3(NTHREADS), kargs, LDS_BYTES, stream);
    if (e != hipSuccess) fprintf(stderr, "kernel_launch: cooperative launch failed: %s\n", hipGetErrorString(e));
}
```

```cpp
#include <hip/hip_runtime.h>
#include <hip/hip_cooperative_groups.h>
#include <cstdio>
#include <cstdint>
namespace cg = cooperative_groups;
#ifndef PHM
#define PHM 0xFFFF
#endif
#define PH(k) ((PHM >> (k)) & 1)

#define LAS __attribute__((address_space(3)))
typedef _Float16 h16;
typedef _Float16 h16x2 __attribute__((ext_vector_type(2)));
typedef _Float16 h16x4 __attribute__((ext_vector_type(4)));
typedef _Float16 h16x8 __attribute__((ext_vector_type(8)));
typedef float f32x2 __attribute__((ext_vector_type(2)));
typedef float f32x4 __attribute__((ext_vector_type(4)));
typedef unsigned u32x2 __attribute__((ext_vector_type(2)));
typedef unsigned u32x4 __attribute__((ext_vector_type(4)));
typedef unsigned u32x4a __attribute__((ext_vector_type(4), may_alias));

constexpr int D = 1024, FF = 2816, MP = 65536, MS = 32768, M = MP + MS, TP = 4096, TS = 16384, PLE = 256;
constexpr int NPROJ = 3584;
constexpr int NTHREADS = 512, NWAVES = 8;
constexpr int LDS_BYTES = 147456;
constexpr size_t MiB = 1u << 20;
constexpr size_t WS_CTR = 256;
constexpr size_t WS_W = 1 * MiB;
constexpr size_t WS_SSA = 46 * MiB;
constexpr size_t WS_SSB = 52 * MiB;
constexpr size_t REG_P = 58 * MiB, REG_S = 682 * MiB, WS_END = 994 * MiB;
constexpr size_t OFF_H16 = 0;
constexpr size_t OFF_MIX = 2048;
constexpr size_t OFF_KNA = 4096, OFF_VNA = 5120, OFF_RR = 6144, OFF_RK = 7168, OFF_RV = 8192;
constexpr size_t OFF_LOWS = 9216;
constexpr size_t OFF_ACT = 2048;
constexpr size_t OFF_P16 = 7680;
constexpr size_t OFF_PU = 2048;
constexpr size_t OFF_H16B = 7680;
constexpr size_t OFF_YB = 0, OFF_BSC = 1024;
constexpr size_t OFF_END = 9984;
static_assert(REG_P + OFF_END * MP <= REG_S && REG_S + OFF_END * MS <= WS_END, "group regions");
__device__ __forceinline__ unsigned char* gbuf(unsigned char* ws, int g, size_t off, size_t stride) {
    const size_t reg = g ? REG_S : REG_P, rows = g ? (size_t)MS : (size_t)MP, row0 = g ? (size_t)MP : 0;
    return ws + (reg + off * rows - row0 * stride);
}
#define GB_H16(g)  ((h16*)gbuf(ws, g, OFF_H16, 2048))
#define GB_H16B(g) ((h16*)gbuf(ws, g, OFF_H16B, 2048))
#define GB_MIX(g)  ((h16*)gbuf(ws, g, OFF_MIX, 2048))
#define GB_KNA(g)  ((h16*)gbuf(ws, g, OFF_KNA, 1024))
#define GB_VNA(g)  ((h16*)gbuf(ws, g, OFF_VNA, 1024))
#define GB_RR(g)   ((h16*)gbuf(ws, g, OFF_RR, 1024))
#define GB_RK(g)   ((h16*)gbuf(ws, g, OFF_RK, 1024))
#define GB_RV(g)   ((h16*)gbuf(ws, g, OFF_RV, 1024))
#define GB_LOWS(g) ((h16*)gbuf(ws, g, OFF_LOWS, 768))
#define GB_ACT(g)  ((h16*)gbuf(ws, g, OFF_ACT, 5632))
#define GB_P16(g)  ((h16*)gbuf(ws, g, OFF_P16, 512))
#define GB_PU(g)   ((h16*)gbuf(ws, g, OFF_PU, 2048))
#define GB_YB(g)   ((h16*)gbuf(ws, g, OFF_YB, 1024))
#define GB_BSC(g)  ((float*)gbuf(ws, g, OFF_BSC, 64))
constexpr size_t W_FFN1U = 0;
constexpr size_t W_FFN1D = W_FFN1U + (size_t)5632 * 1024;
constexpr size_t W_IN = W_FFN1D + (size_t)1024 * 2816;
constexpr size_t W_OUT = W_IN + (size_t)3584 * 1024;
constexpr size_t W_FFN2U = W_OUT + (size_t)1024 * 1024;
constexpr size_t W_FFN2D = W_FFN2U + (size_t)5632 * 1024;
constexpr size_t W_GATE = W_FFN2D + (size_t)1024 * 2816;
constexpr size_t W_UP = W_GATE + (size_t)1024 * 1024;
constexpr size_t W_ENDE = W_UP + (size_t)1024 * 256;
static_assert(WS_W + W_ENDE * 2 <= WS_SSA, "weights fit");

enum { I_XP = 0, I_XS, I_PP, I_PS, I_F1N, I_F1G, I_F1U, I_F1D, I_MIXN, I_WIN, I_RPB, I_MU, I_W0, I_WUP, I_A0, I_AUP, I_GUP, I_KK, I_KA, I_RK, I_LNW, I_LNB,
       I_WOUT, I_F2N, I_F2G, I_F2U, I_F2D, I_PLEN, I_PLEG, I_PLEU, I_FINAL, N_IN };
struct Args { const float* in[N_IN]; float* out; unsigned char* ws; };

__device__ __forceinline__ float wave_sum(float v) {
#pragma unroll
    for (int o = 1; o < 64; o <<= 1) v += __shfl_xor(v, o);
    return v;
}
__device__ __forceinline__ unsigned pk2h(float a, float b) { h16x2 p = {(h16)a, (h16)b}; return __builtin_bit_cast(unsigned, p); }
__device__ __forceinline__ h16x2 as_h2(unsigned u) { return __builtin_bit_cast(h16x2, u); }
__device__ __forceinline__ float dot2h(unsigned a, h16x2 b, float c) { return __builtin_amdgcn_fdot2(as_h2(a), b, c, false); }
__device__ __forceinline__ float dot8(u32x4 a, u32x4 b, float c) { const unsigned a0 = a[0], a1 = a[1], a2 = a[2], a3 = a[3], b0 = b[0], b1 = b[1], b2 = b[2], b3 = b[3];
    c = __builtin_amdgcn_fdot2(as_h2(a0), as_h2(b0), c, false); c = __builtin_amdgcn_fdot2(as_h2(a1), as_h2(b1), c, false); c = __builtin_amdgcn_fdot2(as_h2(a2), as_h2(b2), c, false); c = __builtin_amdgcn_fdot2(as_h2(a3), as_h2(b3), c, false); return c; }
__device__ __forceinline__ float dot8w(u32x4 a, h16x2 w0, h16x2 w1, h16x2 w2, h16x2 w3, float c) { const unsigned a0 = a[0], a1 = a[1], a2 = a[2], a3 = a[3];
    c = __builtin_amdgcn_fdot2(as_h2(a0), w0, c, false); c = __builtin_amdgcn_fdot2(as_h2(a1), w1, c, false); c = __builtin_amdgcn_fdot2(as_h2(a2), w2, c, false); c = __builtin_amdgcn_fdot2(as_h2(a3), w3, c, false); return c; }
__device__ __forceinline__ float fma_mix_lo(float p, unsigned v, float o) { asm("v_fma_mix_f32 %0, %1, %2, %0 op_sel_hi:[0,1,0]" : "+v"(o) : "v"(p), "v"(v)); return o; }
__device__ __forceinline__ float fma_mix_hi(float p, unsigned v, float o) { asm("v_fma_mix_f32 %0, %1, %2, %0 op_sel:[0,1,0] op_sel_hi:[0,1,0]" : "+v"(o) : "v"(p), "v"(v)); return o; }
__device__ __forceinline__ float sigmoidf_(float x) { return __builtin_amdgcn_rcpf(1.0f + __expf(-x)); }
__device__ __forceinline__ float row_rstd(const float* ss, int row) {
    const f32x4* p = (const f32x4*)(ss + (size_t)row * 16);
    const f32x4 a = p[0], b = p[1], c = p[2], d = p[3];
    const float s = ((a.x + a.y) + (a.z + a.w)) + ((b.x + b.y) + (b.z + b.w)) + ((c.x + c.y) + (c.z + c.w)) + ((d.x + d.y) + (d.z + d.w));
    return __builtin_amdgcn_rsqf(s * (1.0f / 1024.0f) + 1e-6f);
}
template <int CTRL> __device__ __forceinline__ float dpp_f(float v) { return __builtin_bit_cast(float, __builtin_amdgcn_update_dpp(0, __builtin_bit_cast(int, v), CTRL, 0xF, 0xF, true)); }
__device__ __forceinline__ float row16_sum(float v) {
    v += dpp_f<0xB1>(v);
    v += dpp_f<0x4E>(v);
    v += dpp_f<0x141>(v);
    v += dpp_f<0x140>(v);
    return v;
}
__device__ __forceinline__ void grid_sync(cg::grid_group& grid) {
    asm volatile("s_waitcnt vmcnt(0) lgkmcnt(0)" ::: "memory"); grid.sync();
    __builtin_amdgcn_fence(__ATOMIC_ACQUIRE, "agent"); asm volatile("s_waitcnt vmcnt(0)" ::: "memory"); }

namespace pg8 {
constexpr int BM = 256, BK = 64, HALF = 128, HTB = HALF * BK * 2, STAGE_BYTES = 8 * HTB, NXCD = 8, WGM = 8;
__host__ __device__ __forceinline__ int lds_byte(int r, int c) { const int st = (r >> 4) * 2 + (c >> 5), rr = r & 15, cc = c & 31, ob = rr * 64 + cc * 2; return st * 1024 + (ob ^ (((ob >> 9) & 1) << 5)); }
__host__ __device__ __forceinline__ void stage_rc(int b, int& R, int& C) { const int st = b / 1024, sb = b % 1024, swz = sb ^ (((sb >> 9) & 1) << 5); R = (st >> 1) * 16 + swz / 64; C = (st & 1) * 32 + (swz % 64) / 2; }
__host__ __device__ __forceinline__ int perm32(int rho) { const int n = rho >> 4, i = rho & 15; return 8 * (i >> 2) + 4 * n + (i & 3); }
struct Unit { int pm, pn; };
struct Gemm { const h16* A; const h16* Bt; int M, N, K, lda; };
struct StaticOrder {
    int nM, nN, nwg, G, c, pm0;
    __device__ void init(int M_, int N_, int G_, int c_, int pm0_) { nM = M_ / BM; nN = N_ / BM; nwg = nM * nN; G = G_; c = c_; pm0 = pm0_; }
    __device__ bool next(int i, Unit& u) const {
        const long L = (long)i * G + c; if (L >= nwg) return false;
        int wgid = (int)L; { const int q = nwg / NXCD, r = nwg % NXCD, xcd = wgid % NXCD, off = wgid / NXCD; wgid = (xcd < r ? xcd * (q + 1) : r * (q + 1) + (xcd - r) * q) + off; }
        const int nig = WGM * nN, gid = wgid / nig, fm = gid * WGM, gsz = (nM - fm) < WGM ? (nM - fm) : WGM;
        u.pm = pm0 + fm + ((wgid % nig) % gsz); u.pn = (wgid % nig) / gsz; return true;
    }
};
typedef f32x4 Acc[2][2][4][2];

template <class Epi>
__device__ __forceinline__ void gemm_phase(LAS unsigned char* lds, const Gemm g, const StaticOrder& S, const Epi& E, const int tid) {
    const int wid = __builtin_amdgcn_readfirstlane(tid >> 6), lane = tid & 63, wr = wid >> 2, wc = wid & 3, fr = lane & 15, fq = lane >> 4;
    const int K = g.K, nt = K / BK, lda = g.lda;
    unsigned voffA[2], voffB[2];
#pragma unroll
    for (int i = 0; i < 2; ++i) { int R, C; stage_rc(tid * 16 + i * 8192, R, C); const int Rb = Epi::PERM ? ((R & ~31) + perm32(R & 31)) : R;
        voffA[i] = (unsigned)(R * lda + C) * 2u; voffB[i] = (unsigned)(Rb * K + C) * 2u; }
    const size_t kstep = (size_t)(BK * 2);
    const size_t hstepA = (size_t)HALF * lda * 2, hstepB = (size_t)HALF * K * 2;
    const size_t tstepA = 2 * hstepA, tstepB = 2 * hstepB;
    const unsigned ldsw = (unsigned)wid * 1024u;
    const int aoff = lds_byte(wr * 64 + fr, fq * 8), boff = lds_byte(wc * 32 + fr, fq * 8);
#define PG8_SA(b, h) (((b) * 2 + (h)) * HTB)
#define PG8_SB(b, h) ((4 + (b) * 2 + (h)) * HTB)
#define PG8_STAGE(bufoff, gbase, voff) do { _Pragma("unroll") for (int _i = 0; _i < 2; ++_i) \
        __builtin_amdgcn_global_load_lds((const unsigned*)((const char*)(gbase) + (voff)[_i]), (LAS unsigned*)(lds + (bufoff) + ldsw + _i * 8192), 16, 0, 0); } while (0)
#define PG8_LDA(dst, b, h) do { _Pragma("unroll") for (int m = 0; m < 4; ++m) _Pragma("unroll") for (int k = 0; k < 2; ++k) dst[m][k] = *(const LAS h16x8*)(lds + PG8_SA(b, h) + aoff + m * 2048 + k * 1024); } while (0)
#define PG8_LDB(dst, b, h) do { _Pragma("unroll") for (int n = 0; n < 2; ++n) _Pragma("unroll") for (int k = 0; k < 2; ++k) dst[n][k] = *(const LAS h16x8*)(lds + PG8_SB(b, h) + boff + n * 2048 + k * 1024); } while (0)
#define PG8_MMA(ai, bj, At, Bt) do { __builtin_amdgcn_s_setprio(1); _Pragma("unroll") for (int m = 0; m < 4; ++m) _Pragma("unroll") for (int n = 0; n < 2; ++n) _Pragma("unroll") for (int k = 0; k < 2; ++k) \
        acc[ai][bj][m][n] = __builtin_amdgcn_mfma_f32_16x16x32_f16(Bt[n][k], At[m][k], acc[ai][bj][m][n], 0, 0, 0); __builtin_amdgcn_s_setprio(0); } while (0)
#define PG8_WAIT_V(n) asm volatile("s_waitcnt vmcnt(" #n ")" ::: "memory")
#define PG8_WAIT_L(n) asm volatile("s_waitcnt lgkmcnt(" #n ")" ::: "memory")
#define PG8_BAR __builtin_amdgcn_s_barrier()
#define PG8_SCHED __builtin_amdgcn_sched_barrier(0)
    Unit cur, nxt; int ui = 0;
    if (!S.next(0, cur)) return;
    f32x4 acc[2][2][4][2];
#pragma unroll
    for (int a = 0; a < 2; ++a)
#pragma unroll
        for (int b = 0; b < 2; ++b)
#pragma unroll
            for (int m = 0; m < 4; ++m)
#pragma unroll
                for (int n = 0; n < 2; ++n) acc[a][b][m][n] = (f32x4){0.f, 0.f, 0.f, 0.f};
    h16x8 At[4][2], B0[2][2], B1[2][2];
    const char* cA = (const char*)g.A + (size_t)cur.pm * tstepA; const char* cB = (const char*)g.Bt + (size_t)cur.pn * tstepB;
    PG8_STAGE(PG8_SB(0, 0), cB, voffB); PG8_STAGE(PG8_SB(0, 1), cB + hstepB, voffB); PG8_STAGE(PG8_SA(0, 0), cA, voffA); PG8_STAGE(PG8_SA(0, 1), cA + hstepA, voffA);
    if (wr == 1) PG8_BAR;
    PG8_WAIT_V(2); PG8_BAR;
    PG8_STAGE(PG8_SB(1, 0), cB + kstep, voffB); PG8_STAGE(PG8_SA(1, 0), cA + kstep, voffA); PG8_STAGE(PG8_SB(1, 1), cB + hstepB + kstep, voffB);
    PG8_WAIT_V(6); PG8_BAR;
    for (;;) {
        const bool has_next = S.next(ui + 1, nxt);
        const char* nA = has_next ? (const char*)g.A + (size_t)nxt.pm * tstepA : cA; const char* nB = has_next ? (const char*)g.Bt + (size_t)nxt.pn * tstepB : cB;
        for (int t = 0; t < nt; t += 2) {
            const bool last = (t == nt - 2);
            const char* a1 = cA + (size_t)(t + 1) * kstep;
            const char* a2 = last ? nA : cA + (size_t)(t + 2) * kstep; const char* b2 = last ? nB : cB + (size_t)(t + 2) * kstep;
            const char* a3 = a2 + kstep; const char* b3 = b2 + kstep;
            PG8_LDB(B0, 0, 0); PG8_LDB(B1, 0, 1); PG8_SCHED; PG8_LDA(At, 0, 0); PG8_STAGE(PG8_SA(1, 1), a1 + hstepA, voffA);
            PG8_WAIT_V(8); PG8_WAIT_L(0); PG8_BAR; PG8_MMA(0, 0, At, B0); PG8_MMA(0, 1, At, B1); PG8_BAR; PG8_SCHED;
            PG8_LDA(At, 0, 1); PG8_STAGE(PG8_SB(0, 0), b2, voffB); PG8_STAGE(PG8_SB(0, 1), b2 + hstepB, voffB); PG8_STAGE(PG8_SA(0, 0), a2, voffA);
            PG8_WAIT_V(8); PG8_WAIT_L(0); PG8_BAR; PG8_MMA(1, 0, At, B0); PG8_MMA(1, 1, At, B1); PG8_BAR; PG8_SCHED;
            PG8_LDB(B0, 1, 0); PG8_LDB(B1, 1, 1); PG8_SCHED; PG8_LDA(At, 1, 0); PG8_STAGE(PG8_SA(0, 1), a2 + hstepA, voffA);
            PG8_WAIT_V(8); PG8_WAIT_L(0); PG8_BAR; PG8_MMA(0, 0, At, B0); PG8_MMA(0, 1, At, B1); PG8_BAR; PG8_SCHED;
            PG8_LDA(At, 1, 1); PG8_STAGE(PG8_SB(1, 0), b3, voffB); PG8_STAGE(PG8_SB(1, 1), b3 + hstepB, voffB); PG8_STAGE(PG8_SA(1, 0), a3, voffA);
            PG8_WAIT_V(8); PG8_WAIT_L(0); PG8_BAR; PG8_MMA(1, 0, At, B0); PG8_MMA(1, 1, At, B1); PG8_BAR; PG8_SCHED;
        }
        if (wr == 0) PG8_BAR;
        E(acc, cur, wr, wc, fr, fq);
        if (!has_next) break;
#pragma unroll
        for (int a = 0; a < 2; ++a)
#pragma unroll
            for (int b = 0; b < 2; ++b)
#pragma unroll
                for (int m = 0; m < 4; ++m)
#pragma unroll
                    for (int n = 0; n < 2; ++n) acc[a][b][m][n] = (f32x4){0.f, 0.f, 0.f, 0.f};
        cur = nxt; cA = nA; cB = nB; ++ui;
        if (wr == 1) PG8_BAR;
    }
    PG8_WAIT_V(0);
    PG8_BAR;
#undef PG8_SA
#undef PG8_SB
#undef PG8_STAGE
#undef PG8_LDA
#undef PG8_LDB
#undef PG8_MMA
#undef PG8_WAIT_V
#undef PG8_WAIT_L
#undef PG8_BAR
#undef PG8_SCHED
}


struct EpiSwiglu {
    static constexpr bool PERM = true;
    h16* O; const float* ss;
    __device__ __forceinline__ void operator()(const Acc& acc, const Unit& u, int wr, int wc, int fr, int fq) const {
        const int row0 = u.pm * BM + wr * 64 + fr, col0 = u.pn * 128 + wc * 32 + 8 * fq;
#pragma unroll
        for (int ai = 0; ai < 2; ++ai)
#pragma unroll
            for (int m = 0; m < 4; ++m) {
                const int row = row0 + ai * HALF + m * 16; const float rs = row_rstd(ss, row);
                float o[8];
#pragma unroll
                for (int n = 0; n < 2; ++n)
#pragma unroll
                    for (int j = 0; j < 4; ++j) { const float gg = acc[ai][0][m][n][j] * rs, uu = acc[ai][1][m][n][j] * rs; o[n * 4 + j] = gg * sigmoidf_(gg) * uu; }
                u32x4 w; w.x = pk2h(o[0], o[1]); w.y = pk2h(o[2], o[3]); w.z = pk2h(o[4], o[5]); w.w = pk2h(o[6], o[7]);
                *(u32x4*)(O + (size_t)row * FF + col0) = w;
            }
    }
};
struct EpiResid {
    static constexpr bool PERM = false;
    const float* res_p; const float* res_s; float* out; h16* o16; float* ss; float alpha;
    __device__ __forceinline__ void operator()(const Acc& acc, const Unit& u, int wr, int wc, int fr, int fq) const {
        const int row0 = u.pm * BM + wr * 64 + fr, col0 = u.pn * BM + wc * 32 + 4 * fq;
        const float* res = (u.pm * BM < MP) ? res_p : res_s;
#pragma unroll
        for (int ai = 0; ai < 2; ++ai)
#pragma unroll
            for (int m = 0; m < 4; ++m) {
                const int row = row0 + ai * HALF + m * 16; const size_t off = (size_t)row * D + col0; float sq = 0.f;
#pragma unroll
                for (int bj = 0; bj < 2; ++bj)
#pragma unroll
                    for (int n = 0; n < 2; ++n) { const size_t o = off + bj * HALF + n * 16; const f32x4 r = *(const f32x4*)(res + o); const f32x4 v = r + acc[ai][bj][m][n] * alpha;
                        *(f32x4*)(out + o) = v; u32x2 w; w.x = pk2h(v.x, v.y); w.y = pk2h(v.z, v.w); *(u32x2*)(o16 + o) = w; sq += (v.x * v.x + v.y * v.y) + (v.z * v.z + v.w * v.w); }
                sq += __shfl_xor(sq, 16); sq += __shfl_xor(sq, 32);
                if (fq == 0) ss[(size_t)row * 16 + u.pn * 4 + wc] = sq;
                asm volatile("" ::: "memory");
            }
    }
};
struct EpiProj {
    static constexpr bool PERM = true;
    h16* mix; h16* kna; size_t bufstep; h16* lows; const float* ss;
    __device__ __forceinline__ void operator()(const Acc& acc, const Unit& u, int wr, int wc, int fr, int fq) const {
        const int pn = u.pn; h16* base; int ldc, c0; float sc = 1.f; int nbj = 2;
        if (pn < 2) { base = mix; ldc = 1024; c0 = pn * 256; sc = 0.125f; }
        else if (pn < 12) { base = kna + (size_t)((pn - 2) >> 1) * bufstep; ldc = 512; c0 = ((pn - 2) & 1) * 256; }
        else { base = lows; ldc = 384; c0 = (pn - 12) * 256; if (pn == 13) nbj = 1; }
        const int row0 = u.pm * BM + wr * 64 + fr, col0 = c0 + wc * 32 + 8 * fq;
#pragma unroll
        for (int ai = 0; ai < 2; ++ai)
#pragma unroll
            for (int m = 0; m < 4; ++m) {
                const int row = row0 + ai * HALF + m * 16; const float rs = row_rstd(ss, row) * sc;
#pragma unroll
                for (int bj = 0; bj < 2; ++bj) if (bj < nbj) {
                    const f32x4 v0 = acc[ai][bj][m][0] * rs, v1 = acc[ai][bj][m][1] * rs;
                    u32x4 w; w.x = pk2h(v0.x, v0.y); w.y = pk2h(v0.z, v0.w); w.z = pk2h(v1.x, v1.y); w.w = pk2h(v1.z, v1.w);
                    *(u32x4*)(base + (size_t)row * ldc + col0 + bj * HALF) = w; }
            }
    }
};
struct EpiPU {
    static constexpr bool PERM = true;
    h16* O;
    __device__ __forceinline__ void operator()(const Acc& acc, const Unit& u, int wr, int wc, int fr, int fq) const {
        const int row0 = u.pm * BM + wr * 64 + fr, col0 = u.pn * BM + wc * 32 + 8 * fq;
#pragma unroll
        for (int ai = 0; ai < 2; ++ai)
#pragma unroll
            for (int m = 0; m < 4; ++m) {
                const int row = row0 + ai * HALF + m * 16;
#pragma unroll
                for (int bj = 0; bj < 2; ++bj) {
                    const f32x4 v0 = acc[ai][bj][m][0], v1 = acc[ai][bj][m][1];
                    u32x4 w; w.x = pk2h(v0.x, v0.y); w.y = pk2h(v0.z, v0.w); w.z = pk2h(v1.x, v1.y); w.w = pk2h(v1.z, v1.w);
                    *(u32x4*)(O + (size_t)row * D + col0 + bj * HALF) = w; }
            }
    }
};
struct EpiPle {
    static constexpr bool PERM = false;
    float* out; h16* o16; float* ssw; const float* ssr; const h16* pu;
    __device__ __forceinline__ void operator()(const Acc& acc, const Unit& u, int wr, int wc, int fr, int fq) const {
        const int row0 = u.pm * BM + wr * 64 + fr, col0 = u.pn * BM + wc * 32 + 4 * fq;
#pragma unroll
        for (int ai = 0; ai < 2; ++ai)
#pragma unroll
            for (int m = 0; m < 4; ++m) {
                const int row = row0 + ai * HALF + m * 16; const size_t off = (size_t)row * D + col0; float sq = 0.f; const float rs = row_rstd(ssr, row);
#pragma unroll
                for (int bj = 0; bj < 2; ++bj)
#pragma unroll
                    for (int n = 0; n < 2; ++n) { const size_t o = off + bj * HALF + n * 16; const f32x4 r = *(const f32x4*)(out + o); const h16x4 p = *(const h16x4*)(pu + o);
                        const f32x4 a = acc[ai][bj][m][n] * rs; f32x4 v;
                        v.x = r.x + sigmoidf_(a.x) * (float)p.x; v.y = r.y + sigmoidf_(a.y) * (float)p.y; v.z = r.z + sigmoidf_(a.z) * (float)p.z; v.w = r.w + sigmoidf_(a.w) * (float)p.w;
                        *(f32x4*)(out + o) = v; u32x2 w; w.x = pk2h(v.x, v.y); w.y = pk2h(v.z, v.w); *(u32x2*)(o16 + o) = w; sq += (v.x * v.x + v.y * v.y) + (v.z * v.z + v.w * v.w); }
                sq += __shfl_xor(sq, 16); sq += __shfl_xor(sq, 32);
                if (fq == 0) ssw[(size_t)row * 16 + u.pn * 4 + wc] = sq;
                asm volatile("" ::: "memory");
            }
    }
};
}

__device__ __forceinline__ void convert_matrix(const float* W, int K, int N, const float* gamma, h16* WT, int mode, LAS float* scr, int gw, int NGW, int lane) {
    const int nblk = N / 32, nitems = (K / 64) * nblk;
    for (int item = gw; item < nitems; item += NGW) {
        const int kb = item / nblk, nb = item % nblk, k0 = 64 * kb, n0 = 32 * nb;
        const int drow0 = (mode == 0) ? n0 : ((n0 >> 7) * 256 + (n0 & 127) + (mode == 2 ? 128 : 0));
#pragma unroll 8
        for (int i = 0; i < 32; ++i) { const int kk = 2 * i + (lane >> 5); float v = W[(size_t)(k0 + kk) * N + n0 + (lane & 31)]; if (gamma) v *= gamma[k0 + kk]; scr[kk * 33 + (lane & 31)] = v; }
        asm volatile("s_waitcnt lgkmcnt(0)" ::: "memory");
        const int c = lane & 7;
#pragma unroll
        for (int j = 0; j < 4; ++j) { const int n = (lane >> 3) + 8 * j; const LAS float* s = scr + (8 * c) * 33 + n;
            u32x4 o; o.x = pk2h(s[0 * 33], s[1 * 33]); o.y = pk2h(s[2 * 33], s[3 * 33]); o.z = pk2h(s[4 * 33], s[5 * 33]); o.w = pk2h(s[6 * 33], s[7 * 33]);
            *(u32x4*)(WT + (size_t)(drow0 + n) * K + k0 + 8 * c) = o; }
        asm volatile("s_waitcnt lgkmcnt(0)" ::: "memory");
    }
}

__device__ __forceinline__ void phase_convert(const Args& a, int layer, LAS unsigned char* lds, int tid, int lane, int wave, int bid, int G) {
    LAS float* scr = (LAS float*)(lds + wave * 16384);
    const int gw = bid * NWAVES + wave, NGW = G * NWAVES;
    h16* W = (h16*)(a.ws + WS_W);
    const size_t l = (size_t)layer;
    convert_matrix(a.in[I_F1G] + l * D * FF, D, FF, a.in[I_F1N] + l * D, W + W_FFN1U, 1, scr, gw, NGW, lane);
    convert_matrix(a.in[I_F1U] + l * D * FF, D, FF, a.in[I_F1N] + l * D, W + W_FFN1U, 2, scr, gw, NGW, lane);
    convert_matrix(a.in[I_F1D] + l * FF * D, FF, D, nullptr, W + W_FFN1D, 0, scr, gw, NGW, lane);
    convert_matrix(a.in[I_WIN] + l * D * 3456, D, 3456, a.in[I_MIXN] + l * D, W + W_IN, 0, scr, gw, NGW, lane);
    convert_matrix(a.in[I_WOUT] + l * D * D, D, D, nullptr, W + W_OUT, 0, scr, gw, NGW, lane);
    convert_matrix(a.in[I_F2G] + l * D * FF, D, FF, a.in[I_F2N] + l * D, W + W_FFN2U, 1, scr, gw, NGW, lane);
    convert_matrix(a.in[I_F2U] + l * D * FF, D, FF, a.in[I_F2N] + l * D, W + W_FFN2U, 2, scr, gw, NGW, lane);
    convert_matrix(a.in[I_F2D] + l * FF * D, FF, D, nullptr, W + W_FFN2D, 0, scr, gw, NGW, lane);
    convert_matrix(a.in[I_PLEG] + l * D * D, D, D, a.in[I_PLEN] + l * D, W + W_GATE, 0, scr, gw, NGW, lane);
    convert_matrix(a.in[I_PLEU] + l * PLE * D, PLE, D, nullptr, W + W_UP, 0, scr, gw, NGW, lane);
    { u32x4* z = (u32x4*)(W + W_IN + (size_t)3456 * 1024); const int n16 = 128 * 1024 * 2 / 16;
      for (int i = bid * NTHREADS + tid; i < n16; i += G * NTHREADS) z[i] = (u32x4){0u, 0u, 0u, 0u}; }
    if (layer == 0) {
        unsigned char* ws = a.ws; h16* Hp = GB_H16B(0); h16* Hs = GB_H16B(1); float* ss = (float*)(a.ws + WS_SSB);
        for (int m = gw; m < M; m += NGW) {
            h16* H = (m < MP) ? Hp : Hs;
            const float* xr = (m < MP) ? a.in[I_XP] + (size_t)m * D : a.in[I_XS] + (size_t)(m - MP) * D;
            const f32x4* x4 = (const f32x4*)xr + lane; float s = 0.f;
            u32x2* o = (u32x2*)(H + (size_t)m * D) + lane;
#pragma unroll
            for (int j = 0; j < 4; ++j) { const f32x4 v = x4[64 * j]; s += (v.x * v.x + v.y * v.y) + (v.z * v.z + v.w * v.w); u32x2 w; w.x = pk2h(v.x, v.y); w.y = pk2h(v.z, v.w); o[64 * j] = w; }
            s = wave_sum(s);
            if (lane < 16) ss[(size_t)m * 16 + lane] = (lane == 0) ? s : 0.f;
        }
    }
}

__device__ __forceinline__ void convert_p(const Args& a, int layer, int g, int nb, int cb, int tid) {
    unsigned char* ws = a.ws; const int rows = g ? MS : MP, row0 = g ? MP : 0;
    u32x2* o = (u32x2*)(GB_P16(g) + (size_t)row0 * PLE);
    const f32x4* p = (const f32x4*)((g ? a.in[I_PS] + (size_t)layer * MS * PLE : a.in[I_PP] + (size_t)layer * MP * PLE));
    const int N4 = rows * PLE / 4;
    for (int i = cb * NTHREADS + tid; i < N4; i += nb * NTHREADS) { const f32x4 v = p[i]; u32x2 w; w.x = pk2h(v.x, v.y); w.y = pk2h(v.z, v.w); o[i] = w; }
}

constexpr int NA_PITCH = 144;
constexpr int NA_VOFF = 512 * NA_PITCH;
constexpr int NA_PP = 67;
__device__ __forceinline__ void na_item(const Args& a, int layer, int item, LAS unsigned char* lds, int tid, int lane, int wave) {
    int tok0, i, rows;
    if (item < 1024) { tok0 = (item >> 6) * TP; i = item & 63; rows = 64; } else { const int it2 = item - 1024; tok0 = MP + (it2 >> 8) * TS; i = it2 & 255; rows = 256; }
    int rs = i - 4; rs = rs < 0 ? 0 : (rs > rows - 8 ? rows - 8 : rs);
    unsigned char* ws = a.ws; const int g = item < 1024 ? 0 : 1;
    h16* MIX = GB_MIX(g); const h16* KNA = GB_KNA(g); const h16* VNA = GB_VNA(g);
    const float* rpb = a.in[I_RPB] + (size_t)layer * 8 * 15 * 31;
    const int wtok0 = tok0 + rs * 64;
    const int j = lane, aw = wave;
    const int tokq = tok0 + i * 64 + j;
    int cs = j - 8; cs = cs < 0 ? 0 : (cs > 48 ? 48 : cs);
#pragma unroll 1
    for (int h = 0; h < 8; ++h) {
#pragma unroll
        for (int it = 0; it < 8; ++it) { const int key = (tid >> 3) + 64 * it, ch = tid & 7;
            const u32x4 kv = *(const u32x4*)(KNA + (size_t)(wtok0 + key) * 512 + h * 64 + ch * 8);
            const u32x4 vv = *(const u32x4*)(VNA + (size_t)(wtok0 + key) * 512 + h * 64 + ch * 8);
            *(LAS u32x4*)(lds + key * NA_PITCH + ch * 16) = kv; *(LAS u32x4*)(lds + NA_VOFF + key * NA_PITCH + ch * 16) = vv; }
        u32x4 qv[8];
#pragma unroll
        for (int c = 0; c < 8; ++c) qv[c] = *(const u32x4*)(MIX + (size_t)tokq * 1024 + h * 64 + c * 8);
        __syncthreads();
        float sc[16];
        const float* bias = rpb + ((size_t)h * 15 + (rs + aw - i + 7)) * 31 + (cs - j + 15);
#pragma unroll
        for (int c = 0; c < 16; ++c) {
            const LAS unsigned char* kp = lds + (aw * 64 + cs + c) * NA_PITCH; float s = 0.f;
#pragma unroll
            for (int c8 = 0; c8 < 8; ++c8) { const u32x4 kk = *(const LAS u32x4*)(kp + c8 * 16); s = dot8(qv[c8], kk, s); }
            sc[c] = s + bias[c];
            asm volatile("" ::: "memory");
        }
        float mx = sc[0];
#pragma unroll
        for (int c = 1; c < 16; ++c) mx = fmaxf(mx, sc[c]);
        float l = 0.f;
#pragma unroll
        for (int c = 0; c < 16; ++c) { sc[c] = __expf(sc[c] - mx); l += sc[c]; }
        float o[64];
#pragma unroll
        for (int d = 0; d < 64; ++d) o[d] = 0.f;
#pragma unroll
        for (int c = 0; c < 16; ++c) {
            const LAS unsigned char* vp = lds + NA_VOFF + (aw * 64 + cs + c) * NA_PITCH; const float p = sc[c];
#pragma unroll
            for (int c8 = 0; c8 < 8; ++c8) { const u32x4 vv = *(const LAS u32x4*)(vp + c8 * 16);
#pragma unroll
                for (int e = 0; e < 4; ++e) { const unsigned ve = vv[e]; o[c8 * 8 + 2 * e] = fma_mix_lo(p, ve, o[c8 * 8 + 2 * e]); o[c8 * 8 + 2 * e + 1] = fma_mix_hi(p, ve, o[c8 * 8 + 2 * e + 1]); } }
            asm volatile("" ::: "memory");
        }
        __syncthreads();
        LAS float* part = (LAS float*)lds + (size_t)(aw * 64 + j) * NA_PP;
#pragma unroll
        for (int d = 0; d < 64; ++d) part[d] = o[d];
        part[64] = mx; part[65] = l;
        __syncthreads();
        {
            const int jq = tid & 63, e8 = tid >> 6;
            float mw[8], M_ = -3.0e38f;
#pragma unroll
            for (int w = 0; w < 8; ++w) { mw[w] = ((const LAS float*)lds)[(size_t)(w * 64 + jq) * NA_PP + 64]; M_ = fmaxf(M_, mw[w]); }
            float L = 0.f, ov[8];
#pragma unroll
            for (int e = 0; e < 8; ++e) ov[e] = 0.f;
#pragma unroll
            for (int w = 0; w < 8; ++w) { const float f = __expf(mw[w] - M_); const LAS float* pw = (const LAS float*)lds + (size_t)(w * 64 + jq) * NA_PP; L += f * pw[65];
#pragma unroll
                for (int e = 0; e < 8; ++e) ov[e] += f * pw[e8 * 8 + e]; }
            const float inv = 1.0f / L;
            u32x4 w4; w4.x = pk2h(ov[0] * inv, ov[1] * inv); w4.y = pk2h(ov[2] * inv, ov[3] * inv); w4.z = pk2h(ov[4] * inv, ov[5] * inv); w4.w = pk2h(ov[6] * inv, ov[7] * inv);
            *(u32x4*)(MIX + (size_t)(tok0 + i * 64 + jq) * 1024 + h * 64 + e8 * 8) = w4;
        }
        __syncthreads();
    }
}

__device__ __forceinline__ float shiftmix(const h16* base, size_t stride, int t, int T, float mu) {
    const float c = (float)base[0];
    const float p = (t > 0) ? (float)*(base - stride) : 0.f;
    const float n = (t < T - 1) ? (float)*(base + stride) : 0.f;
    return c + mu * (0.5f * (p + n) - c);
}
constexpr int SC_CH = 32;
constexpr int SC_OPB = SC_CH * 6 * 64 * 4;
constexpr int SC_YOFF = 2 * SC_OPB;
constexpr int SC_YB = SC_CH * 64 * 4;
constexpr int SC_XOFF = SC_YOFF + 2 * SC_YB;
__device__ __forceinline__ float wave_sum_fast(float v) {
    v = row16_sum(v);
    { const auto r = __builtin_amdgcn_permlane16_swap(__builtin_bit_cast(unsigned, v), __builtin_bit_cast(unsigned, v), false, false);
      const unsigned r0 = r[0], r1 = r[1]; v = __builtin_bit_cast(float, r0) + __builtin_bit_cast(float, r1); }
    { const auto r = __builtin_amdgcn_permlane32_swap(__builtin_bit_cast(unsigned, v), __builtin_bit_cast(unsigned, v), false, false);
      const unsigned r0 = r[0], r1 = r[1]; v = __builtin_bit_cast(float, r0) + __builtin_bit_cast(float, r1); }
    return v;
}
__device__ __forceinline__ float mix3(h16 p, h16 c, h16 n, float mu) { const float cf = (float)c; return cf + mu * (0.5f * ((float)p + (float)n) - cf); }
struct ScanWin { h16 r[10], k[10], v[10], wl[10], al[10]; };
template <int R>
__device__ __forceinline__ void scan_flush(LAS unsigned char* lds, int cf, int pw, int lane, int d, int T, int tok0, int h, int rowbase, h16* Yf, h16* Yb) {
    const LAS float* yb = (const LAS float*)(lds + SC_YOFF + (cf & 1) * SC_YB);
    const int s = pw * 8 + (lane >> 3); const int g = cf * SC_CH + s; const int t = d ? (T - 1 - g) : g;
    if (R == 4) {
        const int r8 = (lane & 7) * 8;
        const f32x4 y0 = *(const LAS f32x4*)(yb + s * 64 + r8), y1 = *(const LAS f32x4*)(yb + s * 64 + r8 + 4);
        u32x4 w4; w4.x = pk2h(y0.x, y0.y); w4.y = pk2h(y0.z, y0.w); w4.z = pk2h(y1.x, y1.y); w4.w = pk2h(y1.z, y1.w);
        if (d == 0) *(u32x4*)(Yf + (size_t)(tok0 + t) * 1024 + 512 + h * 64 + r8) = w4; else *(u32x4*)(Yb + (size_t)(tok0 + t) * 512 + h * 64 + r8) = w4;
    } else {
        const int r4 = (lane & 7) * 4;
        const f32x4 y0 = *(const LAS f32x4*)(yb + s * 32 + r4);
        u32x2 w2; w2.x = pk2h(y0.x, y0.y); w2.y = pk2h(y0.z, y0.w);
        if (d == 0) *(u32x2*)(Yf + (size_t)(tok0 + t) * 1024 + 512 + h * 64 + rowbase + r4) = w2; else *(u32x2*)(Yb + (size_t)(tok0 + t) * 512 + h * 64 + rowbase + r4) = w2;
    }
}
template <int R>
__device__ __forceinline__ void scan_item(const Args& a, int layer, int q, int rowhalf, LAS unsigned char* lds, int tid, int lane, int wave) {
    int tok0, T, h, d;
    if (q < 32) { tok0 = MP + (q >> 4) * TS; T = TS; h = (q >> 1) & 7; d = q & 1; } else { const int q2 = q - 32; tok0 = (q2 >> 4) * TP; T = TP; h = (q2 >> 1) & 7; d = q2 & 1; }
    const int nch = T / SC_CH, rowbase = rowhalf * 16 * R;
    unsigned char* ws = a.ws; const int g = q < 32 ? 1 : 0;
    const h16* RR = GB_RR(g); const h16* RK = GB_RK(g); const h16* RV = GB_RV(g); const h16* LOWS = GB_LOWS(g);
    h16* Yf = GB_MIX(g); h16* Yb = GB_YB(g); float* BSC = GB_BSC(g);
    const size_t l = (size_t)layer;
    if (wave >= 4) {
        const int pw = wave - 4, j = lane, col = h * 64 + j;
        const float* mu = a.in[I_MU] + l * 1920;
        const float mu_r = mu[col], mu_k = mu[512 + col], mu_v = mu[1024 + col], mu_wl = mu[1536 + d * 64 + j], mu_al = mu[1536 + 128 + d * 64 + j];
        const float k_k = a.in[I_KK][l * 512 + col], k_a = a.in[I_KA][l * 512 + col], r_k = a.in[I_RK][l * 512 + col];
        const float w0 = a.in[I_W0][(l * 2 + d) * 512 + col], a0 = a.in[I_A0][(l * 2 + d) * 512 + col];
        h16x2 wup[32], aup[32];
        { const float* wu = a.in[I_WUP] + ((l * 2 + d) * 64) * 512 + col; const float* au = a.in[I_AUP] + ((l * 2 + d) * 64) * 512 + col;
#pragma unroll
          for (int i2 = 0; i2 < 32; ++i2) { const float w0_ = wu[0], w1_ = wu[512], a0_ = au[0], a1_ = au[512]; wu += 1024; au += 1024; asm volatile("" : "+v"(wu), "+v"(au));
              wup[i2] = (h16x2){(h16)w0_, (h16)w1_}; aup[i2] = (h16x2){(h16)a0_, (h16)a1_}; } }
        LAS unsigned char* xsb = lds + SC_XOFF + pw * 2048;
        ScanWin cur, nxt;
#define SCAN_LOAD_WIN(W_, cp_) do { const int g0_ = (cp_) * SC_CH + pw * 8; \
            _Pragma("unroll") for (int w = 0; w < 10; ++w) { const int tt = d ? (T - 1 - g0_) + 1 - w : g0_ - 1 + w; const bool ok = (tt >= 0) && (tt < T); const size_t tok = (size_t)(tok0 + (ok ? tt : 0)); \
                const h16 z_ = (h16)0.f; const h16 r_ = RR[tok * 512 + col], k_ = RK[tok * 512 + col], v_ = RV[tok * 512 + col], wl_ = LOWS[tok * 384 + d * 64 + j], al_ = LOWS[tok * 384 + 128 + d * 64 + j]; \
                W_.r[w] = ok ? r_ : z_; W_.k[w] = ok ? k_ : z_; W_.v[w] = ok ? v_ : z_; W_.wl[w] = ok ? wl_ : z_; W_.al[w] = ok ? al_ : z_; } } while (0)
        SCAN_LOAD_WIN(cur, 0);
        for (int c = -1; c < nch; ++c) {
            if (c >= 1) scan_flush<R>(lds, c - 1, pw, lane, d, T, tok0, h, rowbase, Yf, Yb);
            if (c + 1 < nch) {
                const int cp = c + 1; LAS float* op = (LAS float*)(lds + (cp & 1) * SC_OPB);
                if (c + 2 < nch) SCAN_LOAD_WIN(nxt, c + 2);
#pragma unroll
                for (int s8 = 0; s8 < 8; ++s8) {
                    const int s = pw * 8 + s8; const int g = cp * SC_CH + s; const int t = d ? (T - 1 - g) : g; const size_t tok = (size_t)(tok0 + t);
                    const float wl = mix3(cur.wl[s8], cur.wl[s8 + 1], cur.wl[s8 + 2], mu_wl);
                    const float al = mix3(cur.al[s8], cur.al[s8 + 1], cur.al[s8 + 2], mu_al);
                    const float rr = mix3(cur.r[s8], cur.r[s8 + 1], cur.r[s8 + 2], mu_r);
                    const float kk0 = mix3(cur.k[s8], cur.k[s8 + 1], cur.k[s8 + 2], mu_k);
                    const float vv = mix3(cur.v[s8], cur.v[s8 + 1], cur.v[s8 + 2], mu_v);
                    const float e2 = __expf(2.0f * wl); const float th = 1.0f - 2.0f * __builtin_amdgcn_rcpf(e2 + 1.0f);
                    LAS h16* xs = (LAS h16*)(xsb + s8 * 256);
                    xs[j] = (h16)th; xs[64 + j] = (h16)al;
                    float z = w0, az = a0;
#pragma unroll
                    for (int c8 = 0; c8 < 8; ++c8) { const u32x4 xw = *(const LAS u32x4a*)((const LAS unsigned char*)xs + c8 * 16), xa = *(const LAS u32x4a*)((const LAS unsigned char*)xs + 128 + c8 * 16);
                        z = dot8w(xw, wup[c8 * 4 + 0], wup[c8 * 4 + 1], wup[c8 * 4 + 2], wup[c8 * 4 + 3], z);
                        az = dot8w(xa, aup[c8 * 4 + 0], aup[c8 * 4 + 1], aup[c8 * 4 + 2], aup[c8 * 4 + 3], az); }
                    const float wdec = __expf(-0.606531f * sigmoidf_(z)); const float av = sigmoidf_(az);
                    float kk = kk0 * k_k; const float n2 = wave_sum_fast(kk * kk); kk = kk * __builtin_amdgcn_rcpf(fmaxf(__builtin_amdgcn_sqrtf(n2), 1e-12f));
                    const float kd = kk0 * (1.0f + (av - 1.0f) * k_a); const float bb = kk * av;
                    const float bs = wave_sum_fast(rr * kd * r_k);
                    if (lane == 0 && rowhalf == 0) BSC[(tok * 8 + h) * 2 + d] = bs;
                    LAS float* o = op + s * 384 + j;
                    o[0] = -kk; o[64] = wdec; o[128] = bb; o[192] = kd; o[256] = rr; o[320] = vv;
                }
                cur = nxt;
            }
            __syncthreads();
        }
        scan_flush<R>(lds, nch - 1, pw, lane, d, T, tok0, h, rowbase, Yf, Yb);
#undef SCAN_LOAD_WIN
    } else {
        const int ri = lane >> 4, ci = lane & 15;
        const int vrow = rowbase + wave * 4 * R + ri * R, yrow = wave * 4 * R + ri * R;
        f32x2 S[R][2];
#pragma unroll
        for (int i = 0; i < R; ++i) { S[i][0] = (f32x2){0.f, 0.f}; S[i][1] = (f32x2){0.f, 0.f}; }
        typedef float vecR __attribute__((ext_vector_type(R)));
        __syncthreads();
        for (int c = 0; c < nch; ++c) {
            const LAS f32x4* op = (const LAS f32x4*)(lds + (c & 1) * SC_OPB);
            LAS float* yb = (LAS float*)(lds + SC_YOFF + (c & 1) * SC_YB);
            f32x4 a4 = op[ci], w4 = op[16 + ci], b4 = op[32 + ci], k4 = op[48 + ci], r4 = op[64 + ci]; vecR v4 = *(const LAS vecR*)((const LAS float*)op + 320 + vrow);
#pragma unroll 2
            for (int s = 0; s < SC_CH; ++s) {
                const int sn = (s + 1 < SC_CH) ? s + 1 : s; const LAS f32x4* on = op + sn * 96;
                const f32x4 na4 = on[ci], nw4 = on[16 + ci], nb4 = on[32 + ci], nk4 = on[48 + ci], nr4 = on[64 + ci]; const vecR nv4 = *(const LAS vecR*)((const LAS float*)on + 320 + vrow);
                const f32x2 a01 = {a4.x, a4.y}, a23 = {a4.z, a4.w}, w01 = {w4.x, w4.y}, w23 = {w4.z, w4.w}, b01 = {b4.x, b4.y}, b23 = {b4.z, b4.w};
                const f32x2 k01 = {k4.x, k4.y}, k23 = {k4.z, k4.w}, r01 = {r4.x, r4.y}, r23 = {r4.z, r4.w};
                float sa[R];
#pragma unroll
                for (int i = 0; i < R; ++i) { const f32x2 p = S[i][0] * a01 + S[i][1] * a23; sa[i] = row16_sum(p.x + p.y); }
                vecR y;
#pragma unroll
                for (int i = 0; i < R; ++i) { const f32x2 sa2 = {sa[i], sa[i]}, v2 = {v4[i], v4[i]};
                    S[i][0] = S[i][0] * w01 + sa2 * b01 + v2 * k01; S[i][1] = S[i][1] * w23 + sa2 * b23 + v2 * k23;
                    const f32x2 p = S[i][0] * r01 + S[i][1] * r23; y[i] = row16_sum(p.x + p.y); }
                if (ci == 0) *(LAS vecR*)(yb + s * (16 * R) + yrow) = y;
                a4 = na4; w4 = nw4; b4 = nb4; k4 = nk4; r4 = nr4; v4 = nv4;
            }
            __syncthreads();
        }
    }
}

__device__ __forceinline__ void rwpost_tile(const Args& a, int layer, int tile, LAS unsigned char* lds, int tid, int lane, int wave) {
    const size_t l = (size_t)layer; const int col = tid, h = wave;
    const int m0 = tile * 64; int tok0s, T; if (m0 < MP) { T = TP; tok0s = (m0 / TP) * TP; } else { T = TS; tok0s = MP + ((m0 - MP) / TS) * TS; }
    unsigned char* ws = a.ws; const int g = m0 < MP ? 0 : 1;
    const h16* LOWS = GB_LOWS(g); const h16* RV = GB_RV(g); h16* MIX = GB_MIX(g); const h16* Yb = GB_YB(g); const float* BSC = GB_BSC(g);
    const float* mu = a.in[I_MU] + l * 1920;
    LAS h16* G = (LAS h16*)lds;
    for (int e = tid; e < 64 * 128; e += NTHREADS) { const int tk = e >> 7, c = e & 127; const int m = m0 + tk; const int t = m - tok0s;
        const float gl = shiftmix(LOWS + (size_t)m * 384 + 256 + c, 384, t, T, mu[1536 + 256 + c]); G[e] = (h16)sigmoidf_(gl); }
    h16x2 gup[64];
    { const float* gu = a.in[I_GUP] + l * 128 * 512 + col;
#pragma unroll
      for (int i2 = 0; i2 < 64; ++i2) { const float g0 = gu[0], g1 = gu[512]; gu += 1024; asm volatile("" : "+v"(gu)); gup[i2] = (h16x2){(h16)g0, (h16)g1}; } }
    const float mu_v = mu[1024 + col], lw = a.in[I_LNW][l * 512 + col], lb = a.in[I_LNB][l * 512 + col];
    __syncthreads();
#pragma unroll 1
    for (int tk = 0; tk < 64; ++tk) {
        const int m = m0 + tk; const int t = m - tok0s;
        float g = 0.f;
#pragma unroll
        for (int c8 = 0; c8 < 16; ++c8) { const u32x4 x = *(const LAS u32x4a*)((const LAS unsigned char*)G + tk * 256 + c8 * 16);
            g = dot8w(x, gup[c8 * 4 + 0], gup[c8 * 4 + 1], gup[c8 * 4 + 2], gup[c8 * 4 + 3], g); }
        const float wkv = (float)MIX[(size_t)m * 1024 + 512 + col] + (float)Yb[(size_t)m * 512 + col];
        const float mean = wave_sum(wkv) * (1.0f / 64.0f); const float dv = wkv - mean; const float var = wave_sum(dv * dv) * (1.0f / 64.0f);
        const float yn = dv * __builtin_amdgcn_rsqf(var + 64e-5f) * lw + lb;
        const float vv = shiftmix(RV + (size_t)m * 512 + col, 512, t, T, mu_v);
        const float bs = BSC[((size_t)m * 8 + h) * 2] + BSC[((size_t)m * 8 + h) * 2 + 1];
        MIX[(size_t)m * 1024 + 512 + col] = (h16)((yn + bs * vv) * g);
    }
    __syncthreads();
}

#define STAGE_ARGS const Args& args, int layer, int g, int nb, int cb, LAS unsigned char* lds
#define FRESH_TID int tid = threadIdx.x; asm volatile("" : "+v"(tid)); const int lane = tid & 63, wave = __builtin_amdgcn_readfirstlane(tid >> 6); (void)lane; (void)wave;
__device__ __forceinline__ int g_rows(int g) { return g ? MS : MP; }
__device__ __forceinline__ int g_pm0(int g) { return g ? MP / 256 : 0; }
template <class Epi> __device__ __forceinline__ void run_gemm(LAS unsigned char* lds, const h16* A, int lda, const h16* Bt, int N, int K, int g, int nb, int cb, const Epi& E, int tid) {
    pg8::Gemm gm{A, Bt, g_rows(g), N, K, lda}; pg8::StaticOrder S; S.init(g_rows(g), N, nb, cb, g_pm0(g)); pg8::gemm_phase(lds, gm, S, E, tid);
}
__device__ __forceinline__ void st_ffn_up(STAGE_ARGS, int which) {
    FRESH_TID unsigned char* ws = args.ws; const h16* W = (const h16*)(ws + WS_W);
    pg8::EpiSwiglu E{GB_ACT(g), (const float*)(ws + (which ? WS_SSA : WS_SSB))};
    run_gemm(lds, which ? GB_H16(g) : GB_H16B(g), D, W + (which ? W_FFN2U : W_FFN1U), 2 * FF, D, g, nb, cb, E, tid);
}
__device__ __forceinline__ void st_ffn_down(STAGE_ARGS, int which) {
    FRESH_TID unsigned char* ws = args.ws; const h16* W = (const h16*)(ws + WS_W); float* out = args.out;
    const bool first = (which == 0 && layer == 0);
    const float* rp = first ? args.in[I_XP] : (const float*)out; const float* rsm = first ? args.in[I_XS] - (size_t)MP * D : (const float*)out;
    pg8::EpiResid E{rp, rsm, out, GB_H16(g), (float*)(ws + WS_SSA), 0.5f};
    run_gemm(lds, GB_ACT(g), FF, W + (which ? W_FFN2D : W_FFN1D), D, FF, g, nb, cb, E, tid);
}
__device__ __forceinline__ void st_win(STAGE_ARGS) {
    FRESH_TID unsigned char* ws = args.ws; const h16* W = (const h16*)(ws + WS_W);
    pg8::EpiProj E{GB_MIX(g), GB_KNA(g), (size_t)512 * g_rows(g), GB_LOWS(g), (const float*)(ws + WS_SSA)};
    run_gemm(lds, GB_H16(g), D, W + W_IN, NPROJ, D, g, nb, cb, E, tid);
}
__device__ __forceinline__ void st_wout(STAGE_ARGS) {
    FRESH_TID unsigned char* ws = args.ws; const h16* W = (const h16*)(ws + WS_W); float* out = args.out;
    pg8::EpiResid E{out, out, out, GB_H16(g), (float*)(ws + WS_SSA), 1.0f};
    run_gemm(lds, GB_MIX(g), D, W + W_OUT, D, D, g, nb, cb, E, tid);
}
__device__ __forceinline__ void st_pu(STAGE_ARGS) {
    FRESH_TID unsigned char* ws = args.ws; const h16* W = (const h16*)(ws + WS_W);
    int kpu = PLE; asm volatile("" : "+s"(kpu));
    pg8::EpiPU E{GB_PU(g)};
    run_gemm(lds, GB_P16(g), kpu, W + W_UP, D, kpu, g, nb, cb, E, tid);
}
__device__ __forceinline__ void st_ple(STAGE_ARGS) {
    FRESH_TID unsigned char* ws = args.ws; const h16* W = (const h16*)(ws + WS_W); float* out = args.out;
    pg8::EpiPle E{out, GB_H16B(g), (float*)(ws + WS_SSB), (const float*)(ws + WS_SSA), GB_PU(g)};
    run_gemm(lds, GB_H16(g), D, W + W_GATE, D, D, g, nb, cb, E, tid);
}
__device__ __forceinline__ void st_rwpost(STAGE_ARGS) {
    FRESH_TID const int t0 = g ? MP / 64 : 0, nt = g_rows(g) / 64;
    for (int tile = cb; tile < nt; tile += nb) rwpost_tile(args, layer, t0 + tile, lds, tid, lane, wave);
}
__device__ __forceinline__ void st_convp(STAGE_ARGS) { FRESH_TID convert_p(args, layer, g, nb, cb, tid); }

__device__ __forceinline__ void sub_sync(unsigned* ctr, unsigned target) {
    asm volatile("s_waitcnt vmcnt(0) lgkmcnt(0)" ::: "memory");
    __syncthreads();
    if (threadIdx.x == 0) {
        __builtin_amdgcn_fence(__ATOMIC_RELEASE, "agent"); asm volatile("s_waitcnt vmcnt(0)" ::: "memory");
        __hip_atomic_fetch_add(ctr, 1u, __ATOMIC_RELAXED, __HIP_MEMORY_SCOPE_AGENT);
        while (__hip_atomic_load(ctr, __ATOMIC_RELAXED, __HIP_MEMORY_SCOPE_AGENT) < target) __builtin_amdgcn_s_sleep(2);
    }
    __syncthreads();
    __builtin_amdgcn_fence(__ATOMIC_ACQUIRE, "agent"); asm volatile("s_waitcnt vmcnt(0)" ::: "memory");
}

constexpr int NSB = 32;
__global__ void __launch_bounds__(NTHREADS, 2) fwd_megakernel(Args args) {
    extern __shared__ __attribute__((aligned(16))) unsigned char lds_raw[];
    LAS unsigned char* lds = (LAS unsigned char*)lds_raw;
    cg::grid_group grid = cg::this_grid();
    const int bid = blockIdx.x, G = gridDim.x;
    const int NPB = G - NSB, pb = bid - NSB;
    unsigned* ctr = (unsigned*)(args.ws + WS_CTR);
    if (bid == 0 && threadIdx.x == 0) __hip_atomic_store(ctr, 0u, __ATOMIC_RELAXED, __HIP_MEMORY_SCOPE_AGENT);
    unsigned sbt = 0;
#define SUBSYNC() do { sbt += (unsigned)NPB; sub_sync(ctr, sbt); } while (0)

    for (int layer = 0; layer < 2; ++layer) {
        { FRESH_TID phase_convert(args, layer, lds, tid, lane, wave, bid, G); }
        grid_sync(grid);
        st_ffn_up(args, layer, 1, G, bid, lds, 0); grid_sync(grid);
        st_ffn_down(args, layer, 1, G, bid, lds, 0); grid_sync(grid);
        st_win(args, layer, 1, G, bid, lds); grid_sync(grid);
        { FRESH_TID for (int it = 1024 + bid; it < 1536; it += G) na_item(args, layer, it, lds, tid, lane, wave); }
        grid_sync(grid);
        if (bid < NSB) {
            FRESH_TID scan_item<4>(args, layer, bid, 0, lds, tid, lane, wave);
        } else {
            st_ffn_up(args, layer, 0, NPB, pb, lds, 0); SUBSYNC();
            st_ffn_down(args, layer, 0, NPB, pb, lds, 0); SUBSYNC();
            st_win(args, layer, 0, NPB, pb, lds); SUBSYNC();
            { FRESH_TID
              scan_item<4>(args, layer, 32 + pb, 0, lds, tid, lane, wave); __syncthreads();
              if (pb < 256 - NPB) { scan_item<4>(args, layer, 32 + NPB + pb, 0, lds, tid, lane, wave); __syncthreads(); }
              else { for (int it = pb - (256 - NPB); it < 1024; it += NPB - (256 - NPB)) na_item(args, layer, it, lds, tid, lane, wave); } }
            SUBSYNC();
            st_rwpost(args, layer, 0, NPB, pb, lds); SUBSYNC();
            st_wout(args, layer, 0, NPB, pb, lds); SUBSYNC();
            st_ffn_up(args, layer, 0, NPB, pb, lds, 1); SUBSYNC();
            st_ffn_down(args, layer, 0, NPB, pb, lds, 1); st_convp(args, layer, 0, NPB, pb, lds); SUBSYNC();
            st_pu(args, layer, 0, NPB, pb, lds); SUBSYNC();
            st_ple(args, layer, 0, NPB, pb, lds);
        }
        grid_sync(grid);
        st_rwpost(args, layer, 1, G, bid, lds); grid_sync(grid);
        st_wout(args, layer, 1, G, bid, lds); grid_sync(grid);
        st_ffn_up(args, layer, 1, G, bid, lds, 1); grid_sync(grid);
        st_ffn_down(args, layer, 1, G, bid, lds, 1); st_convp(args, layer, 1, G, bid, lds); grid_sync(grid);
        st_pu(args, layer, 1, G, bid, lds); grid_sync(grid);
        st_ple(args, layer, 1, G, bid, lds); grid_sync(grid);
    }
    {
        FRESH_TID
        const float* SSB = (const float*)(args.ws + WS_SSB); float* out = args.out;
        const int gw = bid * NWAVES + wave, NGW = G * NWAVES; const f32x4* gm = (const f32x4*)args.in[I_FINAL] + lane;
        f32x4 gv[4];
#pragma unroll
        for (int j = 0; j < 4; ++j) gv[j] = gm[64 * j];
        for (int m = gw; m < M; m += NGW) {
            const float rs = row_rstd(SSB, m); f32x4* o = (f32x4*)(out + (size_t)m * D) + lane;
#pragma unroll
            for (int j = 0; j < 4; ++j) { const f32x4 v = o[64 * j]; o[64 * j] = v * rs * gv[j]; }
        }
    }
}

extern "C" void kernel_launch(void* const* d_in, const int* in_sizes, int n_in, void* d_out, int out_size, void* d_ws, size_t ws_size, hipStream_t stream) {
    static int grid = 0;
    if (grid == 0) {
        if (n_in != N_IN || out_size != M * D || ws_size < WS_END) { fprintf(stderr, "kernel_launch: unexpected shapes (n_in %d, out %d, ws %zu)\n", n_in, out_size, ws_size); grid = -1; return; }
        int dev = 0, cus = 0, per_cu = 0;
        (void)hipGetDevice(&dev); (void)hipDeviceGetAttribute(&cus, hipDeviceAttributeMultiprocessorCount, dev);
        (void)hipFuncSetAttribute((const void*)fwd_megakernel, hipFuncAttributeMaxDynamicSharedMemorySize, LDS_BYTES);
        (void)hipOccupancyMaxActiveBlocksPerMultiprocessor(&per_cu, (const void*)fwd_megakernel, NTHREADS, LDS_BYTES);
        if (per_cu < 1) fprintf(stderr, "kernel_launch: occupancy query says %d blocks per CU\n", per_cu);
        grid = cus;
        if (grid != 256) fprintf(stderr, "kernel_launch: grid %d (expected 256)\n", grid);
        if (grid <= NSB + 64) { fprintf(stderr, "kernel_launch: grid too small\n"); grid = -1; return; }
    }
    if (grid < 0) return;
    Args a{};
    for (int i = 0; i < N_IN; ++i) a.in[i] = (const float*)d_in[i];
    a.out = (float*)d_out; a.ws = (unsigned char*)d_ws;
    void* kargs[] = {&a};
    hipError_t e = hipLaunchCooperativeKernel((const void*)fwd_megakernel, dim3(grid), dim3(NTHREADS), kargs, LDS_BYTES, stream);
    if (e != hipSuccess) fprintf(stderr, "kernel_launch: cooperative launch failed: %s\n", hipGetErrorString(e));
}
```

```cpp
#include <hip/hip_runtime.h>
#include <hip/hip_cooperative_groups.h>
#include <cstdio>
#include <cstdint>
namespace cg = cooperative_groups;
#ifndef PHM
#define PHM 0xFFFF
#endif
#define PH(k) ((PHM >> (k)) & 1)

#define LAS __attribute__((address_space(3)))
typedef _Float16 h16;
typedef _Float16 h16x2 __attribute__((ext_vector_type(2)));
typedef _Float16 h16x4 __attribute__((ext_vector_type(4)));
typedef _Float16 h16x8 __attribute__((ext_vector_type(8)));
typedef float f32x2 __attribute__((ext_vector_type(2)));
typedef float f32x4 __attribute__((ext_vector_type(4)));
typedef unsigned u32x2 __attribute__((ext_vector_type(2)));
typedef unsigned u32x4 __attribute__((ext_vector_type(4)));
typedef unsigned u32x4a __attribute__((ext_vector_type(4), may_alias));

constexpr int D = 1024, FF = 2816, MP = 65536, MS = 32768, M = MP + MS, TP = 4096, TS = 16384, PLE = 256;
constexpr int NPROJ = 3584;
constexpr int NTHREADS = 512, NWAVES = 8;
constexpr int LDS_BYTES = 147456;
constexpr size_t MiB = 1u << 20;
constexpr size_t WS_CTR = 256;
constexpr size_t WS_W = 1 * MiB;
constexpr size_t WS_SSA = 46 * MiB;
constexpr size_t WS_SSB = 52 * MiB;
constexpr size_t REG_P = 58 * MiB, REG_S = 682 * MiB, WS_END = 994 * MiB;
constexpr size_t OFF_H16 = 0;
constexpr size_t OFF_MIX = 2048;
constexpr size_t OFF_KNA = 4096, OFF_VNA = 5120, OFF_RR = 6144, OFF_RK = 7168, OFF_RV = 8192;
constexpr size_t OFF_LOWS = 9216;
constexpr size_t OFF_ACT = 2048;
constexpr size_t OFF_P16 = 7680;
constexpr size_t OFF_PU = 2048;
constexpr size_t OFF_H16B = 7680;
constexpr size_t OFF_YB = 0, OFF_BSC = 1024;
constexpr size_t OFF_END = 9984;
static_assert(REG_P + OFF_END * MP <= REG_S && REG_S + OFF_END * MS <= WS_END, "group regions");
__device__ __forceinline__ unsigned char* gbuf(unsigned char* ws, int g, size_t off, size_t stride) {
    const size_t reg = g ? REG_S : REG_P, rows = g ? (size_t)MS : (size_t)MP, row0 = g ? (size_t)MP : 0;
    return ws + (reg + off * rows - row0 * stride);
}
#define GB_H16(g)  ((h16*)gbuf(ws, g, OFF_H16, 2048))
#define GB_H16B(g) ((h16*)gbuf(ws, g, OFF_H16B, 2048))
#define GB_MIX(g)  ((h16*)gbuf(ws, g, OFF_MIX, 2048))
#define GB_KNA(g)  ((h16*)gbuf(ws, g, OFF_KNA, 1024))
#define GB_VNA(g)  ((h16*)gbuf(ws, g, OFF_VNA, 1024))
#define GB_RR(g)   ((h16*)gbuf(ws, g, OFF_RR, 1024))
#define GB_RK(g)   ((h16*)gbuf(ws, g, OFF_RK, 1024))
#define GB_RV(g)   ((h16*)gbuf(ws, g, OFF_RV, 1024))
#define GB_LOWS(g) ((h16*)gbuf(ws, g, OFF_LOWS, 768))
#define GB_ACT(g)  ((h16*)gbuf(ws, g, OFF_ACT, 5632))
#define GB_P16(g)  ((h16*)gbuf(ws, g, OFF_P16, 512))
#define GB_PU(g)   ((h16*)gbuf(ws, g, OFF_PU, 2048))
#define GB_YB(g)   ((h16*)gbuf(ws, g, OFF_YB, 1024))
#define GB_BSC(g)  ((float*)gbuf(ws, g, OFF_BSC, 64))
constexpr size_t W_FFN1U = 0;
constexpr size_t W_FFN1D = W_FFN1U + (size_t)5632 * 1024;
constexpr size_t W_IN = W_FFN1D + (size_t)1024 * 2816;
constexpr size_t W_OUT = W_IN + (size_t)3584 * 1024;
constexpr size_t W_FFN2U = W_OUT + (size_t)1024 * 1024;
constexpr size_t W_FFN2D = W_FFN2U + (size_t)5632 * 1024;
constexpr size_t W_GATE = W_FFN2D + (size_t)1024 * 2816;
constexpr size_t W_UP = W_GATE + (size_t)1024 * 1024;
constexpr size_t W_ENDE = W_UP + (size_t)1024 * 256;
static_assert(WS_W + W_ENDE * 2 <= WS_SSA, "weights fit");

enum { I_XP = 0, I_XS, I_PP, I_PS, I_F1N, I_F1G, I_F1U, I_F1D, I_MIXN, I_WIN, I_RPB, I_MU, I_W0, I_WUP, I_A0, I_AUP, I_GUP, I_KK, I_KA, I_RK, I_LNW, I_LNB,
       I_WOUT, I_F2N, I_F2G, I_F2U, I_F2D, I_PLEN, I_PLEG, I_PLEU, I_FINAL, N_IN };
struct Args { const float* in[N_IN]; float* out; unsigned char* ws; };

__device__ __forceinline__ float wave_sum(float v) {
#pragma unroll
    for (int o = 1; o < 64; o <<= 1) v += __shfl_xor(v, o);
    return v;
}
__device__ __forceinline__ unsigned pk2h(float a, float b) { h16x2 p = {(h16)a, (h16)b}; return __builtin_bit_cast(unsigned, p); }
__device__ __forceinline__ h16x2 as_h2(unsigned u) { return __builtin_bit_cast(h16x2, u); }
__device__ __forceinline__ float dot2h(unsigned a, h16x2 b, float c) { return __builtin_amdgcn_fdot2(as_h2(a), b, c, false); }
__device__ __forceinline__ float dot8(u32x4 a, u32x4 b, float c) { const unsigned a0 = a[0], a1 = a[1], a2 = a[2], a3 = a[3], b0 = b[0], b1 = b[1], b2 = b[2], b3 = b[3];
    c = __builtin_amdgcn_fdot2(as_h2(a0), as_h2(b0), c, false); c = __builtin_amdgcn_fdot2(as_h2(a1), as_h2(b1), c, false); c = __builtin_amdgcn_fdot2(as_h2(a2), as_h2(b2), c, false); c = __builtin_amdgcn_fdot2(as_h2(a3), as_h2(b3), c, false); return c; }
__device__ __forceinline__ float dot8w(u32x4 a, h16x2 w0, h16x2 w1, h16x2 w2, h16x2 w3, float c) { const unsigned a0 = a[0], a1 = a[1], a2 = a[2], a3 = a[3];
    c = __builtin_amdgcn_fdot2(as_h2(a0), w0, c, false); c = __builtin_amdgcn_fdot2(as_h2(a1), w1, c, false); c = __builtin_amdgcn_fdot2(as_h2(a2), w2, c, false); c = __builtin_amdgcn_fdot2(as_h2(a3), w3, c, false); return c; }
__device__ __forceinline__ float fma_mix_lo(float p, unsigned v, float o) { asm("v_fma_mix_f32 %0, %1, %2, %0 op_sel_hi:[0,1,0]" : "+v"(o) : "v"(p), "v"(v)); return o; }
__device__ __forceinline__ float fma_mix_hi(float p, unsigned v, float o) { asm("v_fma_mix_f32 %0, %1, %2, %0 op_sel:[0,1,0] op_sel_hi:[0,1,0]" : "+v"(o) : "v"(p), "v"(v)); return o; }
__device__ __forceinline__ float sigmoidf_(float x) { return __builtin_amdgcn_rcpf(1.0f + __expf(-x)); }
__device__ __forceinline__ float row_rstd(const float* ss, int row) {
    const f32x4* p = (const f32x4*)(ss + (size_t)row * 16);
    const f32x4 a = p[0], b = p[1], c = p[2], d = p[3];
    const float s = ((a.x + a.y) + (a.z + a.w)) + ((b.x + b.y) + (b.z + b.w)) + ((c.x + c.y) + (c.z + c.w)) + ((d.x + d.y) + (d.z + d.w));
    return __builtin_amdgcn_rsqf(s * (1.0f / 1024.0f) + 1e-6f);
}
template <int CTRL> __device__ __forceinline__ float dpp_f(float v) { return __builtin_bit_cast(float, __builtin_amdgcn_update_dpp(0, __builtin_bit_cast(int, v), CTRL, 0xF, 0xF, true)); }
__device__ __forceinline__ float row16_sum(float v) {
    v += dpp_f<0xB1>(v);
    v += dpp_f<0x4E>(v);
    v += dpp_f<0x141>(v);
    v += dpp_f<0x140>(v);
    return v;
}
__device__ __forceinline__ void grid_sync(cg::grid_group& grid) {
    asm volatile("s_waitcnt vmcnt(0) lgkmcnt(0)" ::: "memory"); grid.sync();
    __builtin_amdgcn_fence(__ATOMIC_ACQUIRE, "agent"); asm volatile("s_waitcnt vmcnt(0)" ::: "memory"); }

namespace pg8 {
constexpr int BM = 256, BK = 64, HALF = 128, HTB = HALF * BK * 2, STAGE_BYTES = 8 * HTB, NXCD = 8, WGM = 8;
__host__ __device__ __forceinline__ int lds_byte(int r, int c) { const int st = (r >> 4) * 2 + (c >> 5), rr = r & 15, cc = c & 31, ob = rr * 64 + cc * 2; return st * 1024 + (ob ^ (((ob >> 9) & 1) << 5)); }
__host__ __device__ __forceinline__ void stage_rc(int b, int& R, int& C) { const int st = b / 1024, sb = b % 1024, swz = sb ^ (((sb >> 9) & 1) << 5); R = (st >> 1) * 16 + swz / 64; C = (st & 1) * 32 + (swz % 64) / 2; }
__host__ __device__ __forceinline__ int perm32(int rho) { const int n = rho >> 4, i = rho & 15; return 8 * (i >> 2) + 4 * n + (i & 3); }
struct Unit { int pm, pn; };
struct Gemm { const h16* A; const h16* Bt; int M, N, K, lda; };
struct StaticOrder {
    int nM, nN, nwg, G, c, pm0;
    __device__ void init(int M_, int N_, int G_, int c_, int pm0_) { nM = M_ / BM; nN = N_ / BM; nwg = nM * nN; G = G_; c = c_; pm0 = pm0_; }
    __device__ bool next(int i, Unit& u) const {
        const long L = (long)i * G + c; if (L >= nwg) return false;
        int wgid = (int)L; { const int q = nwg / NXCD, r = nwg % NXCD, xcd = wgid % NXCD, off = wgid / NXCD; wgid = (xcd < r ? xcd * (q + 1) : r * (q + 1) + (xcd - r) * q) + off; }
        const int nig = WGM * nN, gid = wgid / nig, fm = gid * WGM, gsz = (nM - fm) < WGM ? (nM - fm) : WGM;
        u.pm = pm0 + fm + ((wgid % nig) % gsz); u.pn = (wgid % nig) / gsz; return true;
    }
};
typedef f32x4 Acc[2][2][4][2];

template <class Epi>
__device__ __forceinline__ void gemm_phase(LAS unsigned char* lds, const Gemm g, const StaticOrder& S, const Epi& E, const int tid) {
    const int wid = __builtin_amdgcn_readfirstlane(tid >> 6), lane = tid & 63, wr = wid >> 2, wc = wid & 3, fr = lane & 15, fq = lane >> 4;
    const int K = g.K, nt = K / BK, lda = g.lda;
    unsigned voffA[2], voffB[2];
#pragma unroll
    for (int i = 0; i < 2; ++i) { int R, C; stage_rc(tid * 16 + i * 8192, R, C); const int Rb = Epi::PERM ? ((R & ~31) + perm32(R & 31)) : R;
        voffA[i] = (unsigned)(R * lda + C) * 2u; voffB[i] = (unsigned)(Rb * K + C) * 2u; }
    const size_t kstep = (size_t)(BK * 2);
    const size_t hstepA = (size_t)HALF * lda * 2, hstepB = (size_t)HALF * K * 2;
    const size_t tstepA = 2 * hstepA, tstepB = 2 * hstepB;
    const unsigned ldsw = (unsigned)wid * 1024u;
    const int aoff = lds_byte(wr * 64 + fr, fq * 8), boff = lds_byte(wc * 32 + fr, fq * 8);
#define PG8_SA(b, h) (((b) * 2 + (h)) * HTB)
#define PG8_SB(b, h) ((4 + (b) * 2 + (h)) * HTB)
#define PG8_STAGE(bufoff, gbase, voff) do { _Pragma("unroll") for (int _i = 0; _i < 2; ++_i) \
        __builtin_amdgcn_global_load_lds((const unsigned*)((const char*)(gbase) + (voff)[_i]), (LAS unsigned*)(lds + (bufoff) + ldsw + _i * 8192), 16, 0, 0); } while (0)
#define PG8_LDA(dst, b, h) do { _Pragma("unroll") for (int m = 0; m < 4; ++m) _Pragma("unroll") for (int k = 0; k < 2; ++k) dst[m][k] = *(const LAS h16x8*)(lds + PG8_SA(b, h) + aoff + m * 2048 + k * 1024); } while (0)
#define PG8_LDB(dst, b, h) do { _Pragma("unroll") for (int n = 0; n < 2; ++n) _Pragma("unroll") for (int k = 0; k < 2; ++k) dst[n][k] = *(const LAS h16x8*)(lds + PG8_SB(b, h) + boff + n * 2048 + k * 1024); } while (0)
#define PG8_MMA(ai, bj, At, Bt) do { __builtin_amdgcn_s_setprio(1); _Pragma("unroll") for (int m = 0; m < 4; ++m) _Pragma("unroll") for (int n = 0; n < 2; ++n) _Pragma("unroll") for (int k = 0; k < 2; ++k) \
        acc[ai][bj][m][n] = __builtin_amdgcn_mfma_f32_16x16x32_f16(Bt[n][k], At[m][k], acc[ai][bj][m][n], 0, 0, 0); __builtin_amdgcn_s_setprio(0); } while (0)
#define PG8_WAIT_V(n) asm volatile("s_waitcnt vmcnt(" #n ")" ::: "memory")
#define PG8_WAIT_L(n) asm volatile("s_waitcnt lgkmcnt(" #n ")" ::: "memory")
#define PG8_BAR __builtin_amdgcn_s_barrier()
#define PG8_SCHED __builtin_amdgcn_sched_barrier(0)
    Unit cur, nxt; int ui = 0;
    if (!S.next(0, cur)) return;
    f32x4 acc[2][2][4][2];
#pragma unroll
    for (int a = 0; a < 2; ++a)
#pragma unroll
        for (int b = 0; b < 2; ++b)
#pragma unroll
            for (int m = 0; m < 4; ++m)
#pragma unroll
                for (int n = 0; n < 2; ++n) acc[a][b][m][n] = (f32x4){0.f, 0.f, 0.f, 0.f};
    h16x8 At[4][2], B0[2][2], B1[2][2];
    const char* cA = (const char*)g.A + (size_t)cur.pm * tstepA; const char* cB = (const char*)g.Bt + (size_t)cur.pn * tstepB;
    PG8_STAGE(PG8_SB(0, 0), cB, voffB); PG8_STAGE(PG8_SB(0, 1), cB + hstepB, voffB); PG8_STAGE(PG8_SA(0, 0), cA, voffA); PG8_STAGE(PG8_SA(0, 1), cA + hstepA, voffA);
    if (wr == 1) PG8_BAR;
    PG8_WAIT_V(2); PG8_BAR;
    PG8_STAGE(PG8_SB(1, 0), cB + kstep, voffB); PG8_STAGE(PG8_SA(1, 0), cA + kstep, voffA); PG8_STAGE(PG8_SB(1, 1), cB + hstepB + kstep, voffB);
    PG8_WAIT_V(6); PG8_BAR;
    for (;;) {
        const bool has_next = S.next(ui + 1, nxt);
        const char* nA = has_next ? (const char*)g.A + (size_t)nxt.pm * tstepA : cA; const char* nB = has_next ? (const char*)g.Bt + (size_t)nxt.pn * tstepB : cB;
        for (int t = 0; t < nt; t += 2) {
            const bool last = (t == nt - 2);
            const char* a1 = cA + (size_t)(t + 1) * kstep;
            const char* a2 = last ? nA : cA + (size_t)(t + 2) * kstep; const char* b2 = last ? nB : cB + (size_t)(t + 2) * kstep;
            const char* a3 = a2 + kstep; const char* b3 = b2 + kstep;
            PG8_LDB(B0, 0, 0); PG8_LDB(B1, 0, 1); PG8_SCHED; PG8_LDA(At, 0, 0); PG8_STAGE(PG8_SA(1, 1), a1 + hstepA, voffA);
            PG8_WAIT_V(8); PG8_WAIT_L(0); PG8_BAR; PG8_MMA(0, 0, At, B0); PG8_MMA(0, 1, At, B1); PG8_BAR; PG8_SCHED;
            PG8_LDA(At, 0, 1); PG8_STAGE(PG8_SB(0, 0), b2, voffB); PG8_STAGE(PG8_SB(0, 1), b2 + hstepB, voffB); PG8_STAGE(PG8_SA(0, 0), a2, voffA);
            PG8_WAIT_V(8); PG8_WAIT_L(0); PG8_BAR; PG8_MMA(1, 0, At, B0); PG8_MMA(1, 1, At, B1); PG8_BAR; PG8_SCHED;
            PG8_LDB(B0, 1, 0); PG8_LDB(B1, 1, 1); PG8_SCHED; PG8_LDA(At, 1, 0); PG8_STAGE(PG8_SA(0, 1), a2 + hstepA, voffA);
            PG8_WAIT_V(8); PG8_WAIT_L(0); PG8_BAR; PG8_MMA(0, 0, At, B0); PG8_MMA(0, 1, At, B1); PG8_BAR; PG8_SCHED;
            PG8_LDA(At, 1, 1); PG8_STAGE(PG8_SB(1, 0), b3, voffB); PG8_STAGE(PG8_SB(1, 1), b3 + hstepB, voffB); PG8_STAGE(PG8_SA(1, 0), a3, voffA);
            PG8_WAIT_V(8); PG8_WAIT_L(0); PG8_BAR; PG8_MMA(1, 0, At, B0); PG8_MMA(1, 1, At, B1); PG8_BAR; PG8_SCHED;
        }
        if (wr == 0) PG8_BAR;
        E(acc, cur, wr, wc, fr, fq);
        if (!has_next) break;
#pragma unroll
        for (int a = 0; a < 2; ++a)
#pragma unroll
            for (int b = 0; b < 2; ++b)
#pragma unroll
                for (int m = 0; m < 4; ++m)
#pragma unroll
                    for (int n = 0; n < 2; ++n) acc[a][b][m][n] = (f32x4){0.f, 0.f, 0.f, 0.f};
        cur = nxt; cA = nA; cB = nB; ++ui;
        if (wr == 1) PG8_BAR;
    }
    PG8_WAIT_V(0);
    PG8_BAR;
#undef PG8_SA
#undef PG8_SB
#undef PG8_STAGE
#undef PG8_LDA
#undef PG8_LDB
#undef PG8_MMA
#undef PG8_WAIT_V
#undef PG8_WAIT_L
#undef PG8_BAR
#undef PG8_SCHED
}


struct EpiSwiglu {
    static constexpr bool PERM = true;
    h16* O; const float* ss;
    __device__ __forceinline__ void operator()(const Acc& acc, const Unit& u, int wr, int wc, int fr, int fq) const {
        const int row0 = u.pm * BM + wr * 64 + fr, col0 = u.pn * 128 + wc * 32 + 8 * fq;
#pragma unroll
        for (int ai = 0; ai < 2; ++ai)
#pragma unroll
            for (int m = 0; m < 4; ++m) {
                const int row = row0 + ai * HALF + m * 16; const float rs = row_rstd(ss, row);
                float o[8];
#pragma unroll
                for (int n = 0; n < 2; ++n)
#pragma unroll
                    for (int j = 0; j < 4; ++j) { const float gg = acc[ai][0][m][n][j] * rs, uu = acc[ai][1][m][n][j] * rs; o[n * 4 + j] = gg * sigmoidf_(gg) * uu; }
                u32x4 w; w.x = pk2h(o[0], o[1]); w.y = pk2h(o[2], o[3]); w.z = pk2h(o[4], o[5]); w.w = pk2h(o[6], o[7]);
                *(u32x4*)(O + (size_t)row * FF + col0) = w;
            }
    }
};
struct EpiResid {
    static constexpr bool PERM = false;
    const float* res_p; const float* res_s; float* out; h16* o16; float* ss; float alpha;
    __device__ __forceinline__ void operator()(const Acc& acc, const Unit& u, int wr, int wc, int fr, int fq) const {
        const int row0 = u.pm * BM + wr * 64 + fr, col0 = u.pn * BM + wc * 32 + 4 * fq;
        const float* res = (u.pm * BM < MP) ? res_p : res_s;
#pragma unroll
        for (int ai = 0; ai < 2; ++ai)
#pragma unroll
            for (int m = 0; m < 4; ++m) {
                const int row = row0 + ai * HALF + m * 16; const size_t off = (size_t)row * D + col0; float sq = 0.f;
#pragma unroll
                for (int bj = 0; bj < 2; ++bj)
#pragma unroll
                    for (int n = 0; n < 2; ++n) { const size_t o = off + bj * HALF + n * 16; const f32x4 r = *(const f32x4*)(res + o); const f32x4 v = r + acc[ai][bj][m][n] * alpha;
                        *(f32x4*)(out + o) = v; u32x2 w; w.x = pk2h(v.x, v.y); w.y = pk2h(v.z, v.w); *(u32x2*)(o16 + o) = w; sq += (v.x * v.x + v.y * v.y) + (v.z * v.z + v.w * v.w); }
                sq += __shfl_xor(sq, 16); sq += __shfl_xor(sq, 32);
                if (fq == 0) ss[(size_t)row * 16 + u.pn * 4 + wc] = sq;
                asm volatile("" ::: "memory");
            }
    }
};
struct EpiProj {
    static constexpr bool PERM = true;
    h16* mix; h16* kna; size_t bufstep; h16* lows; const float* ss;
    __device__ __forceinline__ void operator()(const Acc& acc, const Unit& u, int wr, int wc, int fr, int fq) const {
        const int pn = u.pn; h16* base; int ldc, c0; float sc = 1.f; int nbj = 2;
        if (pn < 2) { base = mix; ldc = 1024; c0 = pn * 256; sc = 0.125f; }
        else if (pn < 12) { base = kna + (size_t)((pn - 2) >> 1) * bufstep; ldc = 512; c0 = ((pn - 2) & 1) * 256; }
        else { base = lows; ldc = 384; c0 = (pn - 12) * 256; if (pn == 13) nbj = 1; }
        const int row0 = u.pm * BM + wr * 64 + fr, col0 = c0 + wc * 32 + 8 * fq;
#pragma unroll
        for (int ai = 0; ai < 2; ++ai)
#pragma unroll
            for (int m = 0; m < 4; ++m) {
                const int row = row0 + ai * HALF + m * 16; const float rs = row_rstd(ss, row) * sc;
#pragma unroll
                for (int bj = 0; bj < 2; ++bj) if (bj < nbj) {
                    const f32x4 v0 = acc[ai][bj][m][0] * rs, v1 = acc[ai][bj][m][1] * rs;
                    u32x4 w; w.x = pk2h(v0.x, v0.y); w.y = pk2h(v0.z, v0.w); w.z = pk2h(v1.x, v1.y); w.w = pk2h(v1.z, v1.w);
                    *(u32x4*)(base + (size_t)row * ldc + col0 + bj * HALF) = w; }
            }
    }
};
struct EpiPU {
    static constexpr bool PERM = true;
    h16* O;
    __device__ __forceinline__ void operator()(const Acc& acc, const Unit& u, int wr, int wc, int fr, int fq) const {
        const int row0 = u.pm * BM + wr * 64 + fr, col0 = u.pn * BM + wc * 32 + 8 * fq;
#pragma unroll
        for (int ai = 0; ai < 2; ++ai)
#pragma unroll
            for (int m = 0; m < 4; ++m) {
                const int row = row0 + ai * HALF + m * 16;
#pragma unroll
                for (int bj = 0; bj < 2; ++bj) {
                    const f32x4 v0 = acc[ai][bj][m][0], v1 = acc[ai][bj][m][1];
                    u32x4 w; w.x = pk2h(v0.x, v0.y); w.y = pk2h(v0.z, v0.w); w.z = pk2h(v1.x, v1.y); w.w = pk2h(v1.z, v1.w);
                    *(u32x4*)(O + (size_t)row * D + col0 + bj * HALF) = w; }
            }
    }
};
struct EpiPle {
    static constexpr bool PERM = false;
    float* out; h16* o16; float* ssw; const float* ssr; const h16* pu;
    __device__ __forceinline__ void operator()(const Acc& acc, const Unit& u, int wr, int wc, int fr, int fq) const {
        const int row0 = u.pm * BM + wr * 64 + fr, col0 = u.pn * BM + wc * 32 + 4 * fq;
#pragma unroll
        for (int ai = 0; ai < 2; ++ai)
#pragma unroll
            for (int m = 0; m < 4; ++m) {
                const int row = row0 + ai * HALF + m * 16; const size_t off = (size_t)row * D + col0; float sq = 0.f; const float rs = row_rstd(ssr, row);
#pragma unroll
                for (int bj = 0; bj < 2; ++bj)
#pragma unroll
                    for (int n = 0; n < 2; ++n) { const size_t o = off + bj * HALF + n * 16; const f32x4 r = *(const f32x4*)(out + o); const h16x4 p = *(const h16x4*)(pu + o);
                        const f32x4 a = acc[ai][bj][m][n] * rs; f32x4 v;
                        v.x = r.x + sigmoidf_(a.x) * (float)p.x; v.y = r.y + sigmoidf_(a.y) * (float)p.y; v.z = r.z + sigmoidf_(a.z) * (float)p.z; v.w = r.w + sigmoidf_(a.w) * (float)p.w;
                        *(f32x4*)(out + o) = v; u32x2 w; w.x = pk2h(v.x, v.y); w.y = pk2h(v.z, v.w); *(u32x2*)(o16 + o) = w; sq += (v.x * v.x + v.y * v.y) + (v.z * v.z + v.w * v.w); }
                sq += __shfl_xor(sq, 16); sq += __shfl_xor(sq, 32);
                if (fq == 0) ssw[(size_t)row * 16 + u.pn * 4 + wc] = sq;
                asm volatile("" ::: "memory");
            }
    }
};
}

__device__ __forceinline__ void convert_matrix(const float* W, int K, int N, const float* gamma, h16* WT, int mode, LAS float* scr, int gw, int NGW, int lane) {
    const int nblk = N / 32, nitems = (K / 64) * nblk;
    for (int item = gw; item < nitems; item += NGW) {
        const int kb = item / nblk, nb = item % nblk, k0 = 64 * kb, n0 = 32 * nb;
        const int drow0 = (mode == 0) ? n0 : ((n0 >> 7) * 256 + (n0 & 127) + (mode == 2 ? 128 : 0));
#pragma unroll 8
        for (int i = 0; i < 32; ++i) { const int kk = 2 * i + (lane >> 5); float v = W[(size_t)(k0 + kk) * N + n0 + (lane & 31)]; if (gamma) v *= gamma[k0 + kk]; scr[kk * 33 + (lane & 31)] = v; }
        asm volatile("s_waitcnt lgkmcnt(0)" ::: "memory");
        const int c = lane & 7;
#pragma unroll
        for (int j = 0; j < 4; ++j) { const int n = (lane >> 3) + 8 * j; const LAS float* s = scr + (8 * c) * 33 + n;
            u32x4 o; o.x = pk2h(s[0 * 33], s[1 * 33]); o.y = pk2h(s[2 * 33], s[3 * 33]); o.z = pk2h(s[4 * 33], s[5 * 33]); o.w = pk2h(s[6 * 33], s[7 * 33]);
            *(u32x4*)(WT + (size_t)(drow0 + n) * K + k0 + 8 * c) = o; }
        asm volatile("s_waitcnt lgkmcnt(0)" ::: "memory");
    }
}

__device__ __forceinline__ void phase_convert(const Args& a, int layer, LAS unsigned char* lds, int tid, int lane, int wave, int bid, int G) {
    LAS float* scr = (LAS float*)(lds + wave * 16384);
    const int gw = bid * NWAVES + wave, NGW = G * NWAVES;
    h16* W = (h16*)(a.ws + WS_W);
    const size_t l = (size_t)layer;
    convert_matrix(a.in[I_F1G] + l * D * FF, D, FF, a.in[I_F1N] + l * D, W + W_FFN1U, 1, scr, gw, NGW, lane);
    convert_matrix(a.in[I_F1U] + l * D * FF, D, FF, a.in[I_F1N] + l * D, W + W_FFN1U, 2, scr, gw, NGW, lane);
    convert_matrix(a.in[I_F1D] + l * FF * D, FF, D, nullptr, W + W_FFN1D, 0, scr, gw, NGW, lane);
    convert_matrix(a.in[I_WIN] + l * D * 3456, D, 3456, a.in[I_MIXN] + l * D, W + W_IN, 0, scr, gw, NGW, lane);
    convert_matrix(a.in[I_WOUT] + l * D * D, D, D, nullptr, W + W_OUT, 0, scr, gw, NGW, lane);
    convert_matrix(a.in[I_F2G] + l * D * FF, D, FF, a.in[I_F2N] + l * D, W + W_FFN2U, 1, scr, gw, NGW, lane);
    convert_matrix(a.in[I_F2U] + l * D * FF, D, FF, a.in[I_F2N] + l * D, W + W_FFN2U, 2, scr, gw, NGW, lane);
    convert_matrix(a.in[I_F2D] + l * FF * D, FF, D, nullptr, W + W_FFN2D, 0, scr, gw, NGW, lane);
    convert_matrix(a.in[I_PLEG] + l * D * D, D, D, a.in[I_PLEN] + l * D, W + W_GATE, 0, scr, gw, NGW, lane);
    convert_matrix(a.in[I_PLEU] + l * PLE * D, PLE, D, nullptr, W + W_UP, 0, scr, gw, NGW, lane);
    { u32x4* z = (u32x4*)(W + W_IN + (size_t)3456 * 1024); const int n16 = 128 * 1024 * 2 / 16;
      for (int i = bid * NTHREADS + tid; i < n16; i += G * NTHREADS) z[i] = (u32x4){0u, 0u, 0u, 0u}; }
    if (layer == 0) {
        unsigned char* ws = a.ws; h16* Hp = GB_H16B(0); h16* Hs = GB_H16B(1); float* ss = (float*)(a.ws + WS_SSB);
        for (int m = gw; m < M; m += NGW) {
            h16* H = (m < MP) ? Hp : Hs;
            const float* xr = (m < MP) ? a.in[I_XP] + (size_t)m * D : a.in[I_XS] + (size_t)(m - MP) * D;
            const f32x4* x4 = (const f32x4*)xr + lane; float s = 0.f;
            u32x2* o = (u32x2*)(H + (size_t)m * D) + lane;
#pragma unroll
            for (int j = 0; j < 4; ++j) { const f32x4 v = x4[64 * j]; s += (v.x * v.x + v.y * v.y) + (v.z * v.z + v.w * v.w); u32x2 w; w.x = pk2h(v.x, v.y); w.y = pk2h(v.z, v.w); o[64 * j] = w; }
            s = wave_sum(s);
            if (lane < 16) ss[(size_t)m * 16 + lane] = (lane == 0) ? s : 0.f;
        }
    }
}

__device__ __forceinline__ void convert_p(const Args& a, int layer, int g, int nb, int cb, int tid) {
    unsigned char* ws = a.ws; const int rows = g ? MS : MP, row0 = g ? MP : 0;
    u32x2* o = (u32x2*)(GB_P16(g) + (size_t)row0 * PLE);
    const f32x4* p = (const f32x4*)((g ? a.in[I_PS] + (size_t)layer * MS * PLE : a.in[I_PP] + (size_t)layer * MP * PLE));
    const int N4 = rows * PLE / 4;
    for (int i = cb * NTHREADS + tid; i < N4; i += nb * NTHREADS) { const f32x4 v = p[i]; u32x2 w; w.x = pk2h(v.x, v.y); w.y = pk2h(v.z, v.w); o[i] = w; }
}

constexpr int NA_PITCH = 144;
constexpr int NA_VOFF = 512 * NA_PITCH;
constexpr int NA_PP = 67;
__device__ __forceinline__ void na_item(const Args& a, int layer, int item, LAS unsigned char* lds, int tid, int lane, int wave) {
    int tok0, i, rows;
    if (item < 1024) { tok0 = (item >> 6) * TP; i = item & 63; rows = 64; } else { const int it2 = item - 1024; tok0 = MP + (it2 >> 8) * TS; i = it2 & 255; rows = 256; }
    int rs = i - 4; rs = rs < 0 ? 0 : (rs > rows - 8 ? rows - 8 : rs);
    unsigned char* ws = a.ws; const int g = item < 1024 ? 0 : 1;
    h16* MIX = GB_MIX(g); const h16* KNA = GB_KNA(g); const h16* VNA = GB_VNA(g);
    const float* rpb = a.in[I_RPB] + (size_t)layer * 8 * 15 * 31;
    const int wtok0 = tok0 + rs * 64;
    const int j = lane, aw = wave;
    const int tokq = tok0 + i * 64 + j;
    int cs = j - 8; cs = cs < 0 ? 0 : (cs > 48 ? 48 : cs);
#pragma unroll 1
    for (int h = 0; h < 8; ++h) {
#pragma unroll
        for (int it = 0; it < 8; ++it) { const int key = (tid >> 3) + 64 * it, ch = tid & 7;
            const u32x4 kv = *(const u32x4*)(KNA + (size_t)(wtok0 + key) * 512 + h * 64 + ch * 8);
            const u32x4 vv = *(const u32x4*)(VNA + (size_t)(wtok0 + key) * 512 + h * 64 + ch * 8);
            *(LAS u32x4*)(lds + key * NA_PITCH + ch * 16) = kv; *(LAS u32x4*)(lds + NA_VOFF + key * NA_PITCH + ch * 16) = vv; }
        u32x4 qv[8];
#pragma unroll
        for (int c = 0; c < 8; ++c) qv[c] = *(const u32x4*)(MIX + (size_t)tokq * 1024 + h * 64 + c * 8);
        __syncthreads();
        float sc[16];
        const float* bias = rpb + ((size_t)h * 15 + (rs + aw - i + 7)) * 31 + (cs - j + 15);
#pragma unroll
        for (int c = 0; c < 16; ++c) {
            const LAS unsigned char* kp = lds + (aw * 64 + cs + c) * NA_PITCH; float s = 0.f;
#pragma unroll
            for (int c8 = 0; c8 < 8; ++c8) { const u32x4 kk = *(const LAS u32x4*)(kp + c8 * 16); s = dot8(qv[c8], kk, s); }
            sc[c] = s + bias[c];
            asm volatile("" ::: "memory");
        }
        float mx = sc[0];
#pragma unroll
        for (int c = 1; c < 16; ++c) mx = fmaxf(mx, sc[c]);
        float l = 0.f;
#pragma unroll
        for (int c = 0; c < 16; ++c) { sc[c] = __expf(sc[c] - mx); l += sc[c]; }
        float o[64];
#pragma unroll
        for (int d = 0; d < 64; ++d) o[d] = 0.f;
#pragma unroll
        for (int c = 0; c < 16; ++c) {
            const LAS unsigned char* vp = lds + NA_VOFF + (aw * 64 + cs + c) * NA_PITCH; const float p = sc[c];
#pragma unroll
            for (int c8 = 0; c8 < 8; ++c8) { const u32x4 vv = *(const LAS u32x4*)(vp + c8 * 16);
#pragma unroll
                for (int e = 0; e < 4; ++e) { const unsigned ve = vv[e]; o[c8 * 8 + 2 * e] = fma_mix_lo(p, ve, o[c8 * 8 + 2 * e]); o[c8 * 8 + 2 * e + 1] = fma_mix_hi(p, ve, o[c8 * 8 + 2 * e + 1]); } }
            asm volatile("" ::: "memory");
        }
        __syncthreads();
        LAS float* part = (LAS float*)lds + (size_t)(aw * 64 + j) * NA_PP;
#pragma unroll
        for (int d = 0; d < 64; ++d) part[d] = o[d];
        part[64] = mx; part[65] = l;
        __syncthreads();
        {
            const int jq = tid & 63, e8 = tid >> 6;
            float mw[8], M_ = -3.0e38f;
#pragma unroll
            for (int w = 0; w < 8; ++w) { mw[w] = ((const LAS float*)lds)[(size_t)(w * 64 + jq) * NA_PP + 64]; M_ = fmaxf(M_, mw[w]); }
            float L = 0.f, ov[8];
#pragma unroll
            for (int e = 0; e < 8; ++e) ov[e] = 0.f;
#pragma unroll
            for (int w = 0; w < 8; ++w) { const float f = __expf(mw[w] - M_); const LAS float* pw = (const LAS float*)lds + (size_t)(w * 64 + jq) * NA_PP; L += f * pw[65];
#pragma unroll
                for (int e = 0; e < 8; ++e) ov[e] += f * pw[e8 * 8 + e]; }
            const float inv = 1.0f / L;
            u32x4 w4; w4.x = pk2h(ov[0] * inv, ov[1] * inv); w4.y = pk2h(ov[2] * inv, ov[3] * inv); w4.z = pk2h(ov[4] * inv, ov[5] * inv); w4.w = pk2h(ov[6] * inv, ov[7] * inv);
            *(u32x4*)(MIX + (size_t)(tok0 + i * 64 + jq) * 1024 + h * 64 + e8 * 8) = w4;
        }
        __syncthreads();
    }
}

__device__ __forceinline__ float shiftmix(const h16* base, size_t stride, int t, int T, float mu) {
    const float c = (float)base[0];
    const float p = (t > 0) ? (float)*(base - stride) : 0.f;
    const float n = (t < T - 1) ? (float)*(base + stride) : 0.f;
    return c + mu * (0.5f * (p + n) - c);
}
constexpr int SC_CH = 32;
constexpr int SC_OPB = SC_CH * 6 * 64 * 4;
constexpr int SC_YOFF = 2 * SC_OPB;
constexpr int SC_YB = SC_CH * 64 * 4;
constexpr int SC_XOFF = SC_YOFF + 2 * SC_YB;
__device__ __forceinline__ float wave_sum_fast(float v) {
    v = row16_sum(v);
    { const auto r = __builtin_amdgcn_permlane16_swap(__builtin_bit_cast(unsigned, v), __builtin_bit_cast(unsigned, v), false, false);
      const unsigned r0 = r[0], r1 = r[1]; v = __builtin_bit_cast(float, r0) + __builtin_bit_cast(float, r1); }
    { const auto r = __builtin_amdgcn_permlane32_swap(__builtin_bit_cast(unsigned, v), __builtin_bit_cast(unsigned, v), false, false);
      const unsigned r0 = r[0], r1 = r[1]; v = __builtin_bit_cast(float, r0) + __builtin_bit_cast(float, r1); }
    return v;
}
__device__ __forceinline__ float mix3(h16 p, h16 c, h16 n, float mu) { const float cf = (float)c; return cf + mu * (0.5f * ((float)p + (float)n) - cf); }
struct ScanWin { h16 r[10], k[10], v[10], wl[10], al[10]; };
template <int R>
__device__ __forceinline__ void scan_flush(LAS unsigned char* lds, int cf, int pw, int lane, int d, int T, int tok0, int h, int rowbase, h16* Yf, h16* Yb) {
    const LAS float* yb = (const LAS float*)(lds + SC_YOFF + (cf & 1) * SC_YB);
    const int s = pw * 8 + (lane >> 3); const int g = cf * SC_CH + s; const int t = d ? (T - 1 - g) : g;
    if (R == 4) {
        const int r8 = (lane & 7) * 8;
        const f32x4 y0 = *(const LAS f32x4*)(yb + s * 64 + r8), y1 = *(const LAS f32x4*)(yb + s * 64 + r8 + 4);
        u32x4 w4; w4.x = pk2h(y0.x, y0.y); w4.y = pk2h(y0.z, y0.w); w4.z = pk2h(y1.x, y1.y); w4.w = pk2h(y1.z, y1.w);
        if (d == 0) *(u32x4*)(Yf + (size_t)(tok0 + t) * 1024 + 512 + h * 64 + r8) = w4; else *(u32x4*)(Yb + (size_t)(tok0 + t) * 512 + h * 64 + r8) = w4;
    } else {
        const int r4 = (lane & 7) * 4;
        const f32x4 y0 = *(const LAS f32x4*)(yb + s * 32 + r4);
        u32x2 w2; w2.x = pk2h(y0.x, y0.y); w2.y = pk2h(y0.z, y0.w);
        if (d == 0) *(u32x2*)(Yf + (size_t)(tok0 + t) * 1024 + 512 + h * 64 + rowbase + r4) = w2; else *(u32x2*)(Yb + (size_t)(tok0 + t) * 512 + h * 64 + rowbase + r4) = w2;
    }
}
template <int R>
__device__ __forceinline__ void scan_item(const Args& a, int layer, int q, int rowhalf, LAS unsigned char* lds, int tid, int lane, int wave) {
    int tok0, T, h, d;
    if (q < 32) { tok0 = MP + (q >> 4) * TS; T = TS; h = (q >> 1) & 7; d = q & 1; } else { const int q2 = q - 32; tok0 = (q2 >> 4) * TP; T = TP; h = (q2 >> 1) & 7; d = q2 & 1; }
    const int nch = T / SC_CH, rowbase = rowhalf * 16 * R;
    unsigned char* ws = a.ws; const int g = q < 32 ? 1 : 0;
    const h16* RR = GB_RR(g); const h16* RK = GB_RK(g); const h16* RV = GB_RV(g); const h16* LOWS = GB_LOWS(g);
    h16* Yf = GB_MIX(g); h16* Yb = GB_YB(g); float* BSC = GB_BSC(g);
    const size_t l = (size_t)layer;
    if (wave >= 4) {
        const int pw = wave - 4, j = lane, col = h * 64 + j;
        const float* mu = a.in[I_MU] + l * 1920;
        const float mu_r = mu[col], mu_k = mu[512 + col], mu_v = mu[1024 + col], mu_wl = mu[1536 + d * 64 + j], mu_al = mu[1536 + 128 + d * 64 + j];
        const float k_k = a.in[I_KK][l * 512 + col], k_a = a.in[I_KA][l * 512 + col], r_k = a.in[I_RK][l * 512 + col];
        const float w0 = a.in[I_W0][(l * 2 + d) * 512 + col], a0 = a.in[I_A0][(l * 2 + d) * 512 + col];
        h16x2 wup[32], aup[32];
        { const float* wu = a.in[I_WUP] + ((l * 2 + d) * 64) * 512 + col; const float* au = a.in[I_AUP] + ((l * 2 + d) * 64) * 512 + col;
#pragma unroll
          for (int i2 = 0; i2 < 32; ++i2) { const float w0_ = wu[0], w1_ = wu[512], a0_ = au[0], a1_ = au[512]; wu += 1024; au += 1024; asm volatile("" : "+v"(wu), "+v"(au));
              wup[i2] = (h16x2){(h16)w0_, (h16)w1_}; aup[i2] = (h16x2){(h16)a0_, (h16)a1_}; } }
        LAS unsigned char* xsb = lds + SC_XOFF + pw * 2048;
        ScanWin cur, nxt;
#define SCAN_LOAD_WIN(W_, cp_) do { const int g0_ = (cp_) * SC_CH + pw * 8; \
            _Pragma("unroll") for (int w = 0; w < 10; ++w) { const int tt = d ? (T - 1 - g0_) + 1 - w : g0_ - 1 + w; const bool ok = (tt >= 0) && (tt < T); const size_t tok = (size_t)(tok0 + (ok ? tt : 0)); \
                const h16 z_ = (h16)0.f; const h16 r_ = RR[tok * 512 + col], k_ = RK[tok * 512 + col], v_ = RV[tok * 512 + col], wl_ = LOWS[tok * 384 + d * 64 + j], al_ = LOWS[tok * 384 + 128 + d * 64 + j]; \
                W_.r[w] = ok ? r_ : z_; W_.k[w] = ok ? k_ : z_; W_.v[w] = ok ? v_ : z_; W_.wl[w] = ok ? wl_ : z_; W_.al[w] = ok ? al_ : z_; } } while (0)
        SCAN_LOAD_WIN(cur, 0);
        for (int c = -1; c < nch; ++c) {
            if (c >= 1) scan_flush<R>(lds, c - 1, pw, lane, d, T, tok0, h, rowbase, Yf, Yb);
            if (c + 1 < nch) {
                const int cp = c + 1; LAS float* op = (LAS float*)(lds + (cp & 1) * SC_OPB);
                if (c + 2 < nch) SCAN_LOAD_WIN(nxt, c + 2);
#pragma unroll
                for (int s8 = 0; s8 < 8; ++s8) {
                    const int s = pw * 8 + s8; const int g = cp * SC_CH + s; const int t = d ? (T - 1 - g) : g; const size_t tok = (size_t)(tok0 + t);
                    const float wl = mix3(cur.wl[s8], cur.wl[s8 + 1], cur.wl[s8 + 2], mu_wl);
                    const float al = mix3(cur.al[s8], cur.al[s8 + 1], cur.al[s8 + 2], mu_al);
                    const float rr = mix3(cur.r[s8], cur.r[s8 + 1], cur.r[s8 + 2], mu_r);
                    const float kk0 = mix3(cur.k[s8], cur.k[s8 + 1], cur.k[s8 + 2], mu_k);
                    const float vv = mix3(cur.v[s8], cur.v[s8 + 1], cur.v[s8 + 2], mu_v);
                    const float e2 = __expf(2.0f * wl); const float th = 1.0f - 2.0f * __builtin_amdgcn_rcpf(e2 + 1.0f);
                    LAS h16* xs = (LAS h16*)(xsb + s8 * 256);
                    xs[j] = (h16)th; xs[64 + j] = (h16)al;
                    float z = w0, az = a0;
#pragma unroll
                    for (int c8 = 0; c8 < 8; ++c8) { const u32x4 xw = *(const LAS u32x4a*)((const LAS unsigned char*)xs + c8 * 16), xa = *(const LAS u32x4a*)((const LAS unsigned char*)xs + 128 + c8 * 16);
                        z = dot8w(xw, wup[c8 * 4 + 0], wup[c8 * 4 + 1], wup[c8 * 4 + 2], wup[c8 * 4 + 3], z);
                        az = dot8w(xa, aup[c8 * 4 + 0], aup[c8 * 4 + 1], aup[c8 * 4 + 2], aup[c8 * 4 + 3], az); }
                    const float wdec = __expf(-0.606531f * sigmoidf_(z)); const float av = sigmoidf_(az);
                    float kk = kk0 * k_k; const float n2 = wave_sum_fast(kk * kk); kk = kk * __builtin_amdgcn_rcpf(fmaxf(__builtin_amdgcn_sqrtf(n2), 1e-12f));
                    const float kd = kk0 * (1.0f + (av - 1.0f) * k_a); const float bb = kk * av;
                    const float bs = wave_sum_fast(rr * kd * r_k);
                    if (lane == 0 && rowhalf == 0) BSC[(tok * 8 + h) * 2 + d] = bs;
                    LAS float* o = op + s * 384 + j;
                    o[0] = -kk; o[64] = wdec; o[128] = bb; o[192] = kd; o[256] = rr; o[320] = vv;
                }
                cur = nxt;
            }
            __syncthreads();
        }
        scan_flush<R>(lds, nch - 1, pw, lane, d, T, tok0, h, rowbase, Yf, Yb);
#undef SCAN_LOAD_WIN
    } else {
        constexpr int RL = R / 2;
        const int ri = lane >> 3, ci = lane & 7;
        const int yrow = wave * 8 * RL + ri * RL, vrow = rowbase + yrow;
        f32x2 S[RL][4];
#pragma unroll
        for (int i = 0; i < RL; ++i)
#pragma unroll
            for (int c2 = 0; c2 < 4; ++c2) S[i][c2] = (f32x2){0.f, 0.f};
        typedef float vecR __attribute__((ext_vector_type(RL)));
        __syncthreads();
        for (int c = 0; c < nch; ++c) {
            const LAS f32x4* op = (const LAS f32x4*)(lds + (c & 1) * SC_OPB);
            LAS float* yb = (LAS float*)(lds + SC_YOFF + (c & 1) * SC_YB);
            f32x4 a0 = op[2 * ci], a1 = op[2 * ci + 1], w0 = op[16 + 2 * ci], w1 = op[17 + 2 * ci], b0 = op[32 + 2 * ci], b1 = op[33 + 2 * ci];
            f32x4 k0 = op[48 + 2 * ci], k1 = op[49 + 2 * ci], r0 = op[64 + 2 * ci], r1 = op[65 + 2 * ci]; vecR v4 = *(const LAS vecR*)((const LAS float*)op + 320 + vrow);
#pragma unroll 2
            for (int s = 0; s < SC_CH; ++s) {
                const int sn = (s + 1 < SC_CH) ? s + 1 : s; const LAS f32x4* on = op + sn * 96;
                const f32x4 na0 = on[2 * ci], na1 = on[2 * ci + 1], nw0 = on[16 + 2 * ci], nw1 = on[17 + 2 * ci], nb0 = on[32 + 2 * ci], nb1 = on[33 + 2 * ci];
                const f32x4 nk0 = on[48 + 2 * ci], nk1 = on[49 + 2 * ci], nr0 = on[64 + 2 * ci], nr1 = on[65 + 2 * ci]; const vecR nv4 = *(const LAS vecR*)((const LAS float*)on + 320 + vrow);
                const f32x2 av[4] = {{a0.x, a0.y}, {a0.z, a0.w}, {a1.x, a1.y}, {a1.z, a1.w}}, wv[4] = {{w0.x, w0.y}, {w0.z, w0.w}, {w1.x, w1.y}, {w1.z, w1.w}};
                const f32x2 bv[4] = {{b0.x, b0.y}, {b0.z, b0.w}, {b1.x, b1.y}, {b1.z, b1.w}}, kv[4] = {{k0.x, k0.y}, {k0.z, k0.w}, {k1.x, k1.y}, {k1.z, k1.w}};
                const f32x2 rv[4] = {{r0.x, r0.y}, {r0.z, r0.w}, {r1.x, r1.y}, {r1.z, r1.w}};
                float sa[RL];
#pragma unroll
                for (int i = 0; i < RL; ++i) { f32x2 p = S[i][0] * av[0]; p = S[i][1] * av[1] + p; p = S[i][2] * av[2] + p; p = S[i][3] * av[3] + p;
                    float t = p.x + p.y; t += dpp_f<0xB1>(t); t += dpp_f<0x4E>(t); t += dpp_f<0x141>(t); sa[i] = t; }
                vecR y;
#pragma unroll
                for (int i = 0; i < RL; ++i) { const f32x2 sa2 = {sa[i], sa[i]}, v2 = {v4[i], v4[i]};
#pragma unroll
                    for (int c2 = 0; c2 < 4; ++c2) S[i][c2] = S[i][c2] * wv[c2] + sa2 * bv[c2] + v2 * kv[c2];
                    f32x2 p = S[i][0] * rv[0]; p = S[i][1] * rv[1] + p; p = S[i][2] * rv[2] + p; p = S[i][3] * rv[3] + p;
                    float t = p.x + p.y; t += dpp_f<0xB1>(t); t += dpp_f<0x4E>(t); t += dpp_f<0x141>(t); y[i] = t; }
                if (ci == 0) *(LAS vecR*)(yb + s * (32 * RL) + yrow) = y;
                a0 = na0; a1 = na1; w0 = nw0; w1 = nw1; b0 = nb0; b1 = nb1; k0 = nk0; k1 = nk1; r0 = nr0; r1 = nr1; v4 = nv4;
            }
            __syncthreads();
        }
    }
}

__device__ __forceinline__ void rwpost_tile(const Args& a, int layer, int tile, LAS unsigned char* lds, int tid, int lane, int wave, const h16x2 (&gup)[64]) {
    const size_t l = (size_t)layer; const int col = tid, h = wave;
    const int m0 = tile * 64; int tok0s, T; if (m0 < MP) { T = TP; tok0s = (m0 / TP) * TP; } else { T = TS; tok0s = MP + ((m0 - MP) / TS) * TS; }
    unsigned char* ws = a.ws; const int g = m0 < MP ? 0 : 1;
    const h16* LOWS = GB_LOWS(g); const h16* RV = GB_RV(g); h16* MIX = GB_MIX(g); const h16* Yb = GB_YB(g); const float* BSC = GB_BSC(g);
    const float* mu = a.in[I_MU] + l * 1920;
    LAS h16* G = (LAS h16*)lds;
    { const int c = tid & 127; const float mug = mu[1536 + 256 + c];
#pragma unroll 4
      for (int e = tid; e < 64 * 128; e += NTHREADS) { const int tk = e >> 7; const int m = m0 + tk; const int t = m - tok0s;
        const float gl = shiftmix(LOWS + (size_t)m * 384 + 256 + c, 384, t, T, mug); G[e] = (h16)sigmoidf_(gl); } }
    const float mu_v = mu[1024 + col], lw = a.in[I_LNW][l * 512 + col], lb = a.in[I_LNB][l * 512 + col];
    __syncthreads();
#pragma unroll 1
    for (int tk0 = 0; tk0 < 64; tk0 += 8) {
        h16 ym[8], yb[8], rv[10]; float b0[8], b1[8];
#pragma unroll
        for (int w = 0; w < 10; ++w) { const int m = m0 + tk0 - 1 + w; const int t = m - tok0s; const bool ok = (t >= 0) && (t < T); const h16 v = RV[(size_t)(ok ? m : m0) * 512 + col]; rv[w] = ok ? v : (h16)0.f; }
#pragma unroll
        for (int jj = 0; jj < 8; ++jj) { const size_t m = (size_t)(m0 + tk0 + jj); ym[jj] = MIX[m * 1024 + 512 + col]; yb[jj] = Yb[m * 512 + col]; b0[jj] = BSC[(m * 8 + h) * 2]; b1[jj] = BSC[(m * 8 + h) * 2 + 1]; }
#pragma unroll
        for (int jj = 0; jj < 8; ++jj) {
            const int tk = tk0 + jj; const size_t m = (size_t)(m0 + tk);
            float gg = 0.f;
#pragma unroll
            for (int c8 = 0; c8 < 16; ++c8) { const u32x4 x = *(const LAS u32x4a*)((const LAS unsigned char*)G + tk * 256 + c8 * 16);
                gg = dot8w(x, gup[c8 * 4 + 0], gup[c8 * 4 + 1], gup[c8 * 4 + 2], gup[c8 * 4 + 3], gg); }
            const float wkv = (float)ym[jj] + (float)yb[jj];
            const float mean = wave_sum_fast(wkv) * (1.0f / 64.0f); const float dv = wkv - mean; const float var = wave_sum_fast(dv * dv) * (1.0f / 64.0f);
            const float yn = dv * __builtin_amdgcn_rsqf(var + 64e-5f) * lw + lb;
            const float vv = mix3(rv[jj], rv[jj + 1], rv[jj + 2], mu_v);
            MIX[m * 1024 + 512 + col] = (h16)((yn + (b0[jj] + b1[jj]) * vv) * gg);
        }
    }
    __syncthreads();
}

#define STAGE_ARGS const Args& args, int layer, int g, int nb, int cb, LAS unsigned char* lds
#define FRESH_TID int tid = threadIdx.x; asm volatile("" : "+v"(tid)); const int lane = tid & 63, wave = __builtin_amdgcn_readfirstlane(tid >> 6); (void)lane; (void)wave;
__device__ __forceinline__ int g_rows(int g) { return g ? MS : MP; }
__device__ __forceinline__ int g_pm0(int g) { return g ? MP / 256 : 0; }
template <class Epi> __device__ __forceinline__ void run_gemm(LAS unsigned char* lds, const h16* A, int lda, const h16* Bt, int N, int K, int g, int nb, int cb, const Epi& E, int tid) {
    pg8::Gemm gm{A, Bt, g_rows(g), N, K, lda}; pg8::StaticOrder S; S.init(g_rows(g), N, nb, cb, g_pm0(g)); pg8::gemm_phase(lds, gm, S, E, tid);
}
__device__ __forceinline__ void st_ffn_up(STAGE_ARGS, int which) {
    FRESH_TID unsigned char* ws = args.ws; const h16* W = (const h16*)(ws + WS_W);
    pg8::EpiSwiglu E{GB_ACT(g), (const float*)(ws + (which ? WS_SSA : WS_SSB))};
    run_gemm(lds, which ? GB_H16(g) : GB_H16B(g), D, W + (which ? W_FFN2U : W_FFN1U), 2 * FF, D, g, nb, cb, E, tid);
}
__device__ __forceinline__ void st_ffn_down(STAGE_ARGS, int which) {
    FRESH_TID unsigned char* ws = args.ws; const h16* W = (const h16*)(ws + WS_W); float* out = args.out;
    const bool first = (which == 0 && layer == 0);
    const float* rp = first ? args.in[I_XP] : (const float*)out; const float* rsm = first ? args.in[I_XS] - (size_t)MP * D : (const float*)out;
    pg8::EpiResid E{rp, rsm, out, GB_H16(g), (float*)(ws + WS_SSA), 0.5f};
    run_gemm(lds, GB_ACT(g), FF, W + (which ? W_FFN2D : W_FFN1D), D, FF, g, nb, cb, E, tid);
}
__device__ __forceinline__ void st_win(STAGE_ARGS) {
    FRESH_TID unsigned char* ws = args.ws; const h16* W = (const h16*)(ws + WS_W);
    pg8::EpiProj E{GB_MIX(g), GB_KNA(g), (size_t)512 * g_rows(g), GB_LOWS(g), (const float*)(ws + WS_SSA)};
    run_gemm(lds, GB_H16(g), D, W + W_IN, NPROJ, D, g, nb, cb, E, tid);
}
__device__ __forceinline__ void st_wout(STAGE_ARGS) {
    FRESH_TID unsigned char* ws = args.ws; const h16* W = (const h16*)(ws + WS_W); float* out = args.out;
    pg8::EpiResid E{out, out, out, GB_H16(g), (float*)(ws + WS_SSA), 1.0f};
    run_gemm(lds, GB_MIX(g), D, W + W_OUT, D, D, g, nb, cb, E, tid);
}
__device__ __forceinline__ void st_pu(STAGE_ARGS) {
    FRESH_TID unsigned char* ws = args.ws; const h16* W = (const h16*)(ws + WS_W);
    int kpu = PLE; asm volatile("" : "+s"(kpu));
    pg8::EpiPU E{GB_PU(g)};
    run_gemm(lds, GB_P16(g), kpu, W + W_UP, D, kpu, g, nb, cb, E, tid);
}
__device__ __forceinline__ void st_ple(STAGE_ARGS) {
    FRESH_TID unsigned char* ws = args.ws; const h16* W = (const h16*)(ws + WS_W); float* out = args.out;
    pg8::EpiPle E{out, GB_H16B(g), (float*)(ws + WS_SSB), (const float*)(ws + WS_SSA), GB_PU(g)};
    run_gemm(lds, GB_H16(g), D, W + W_GATE, D, D, g, nb, cb, E, tid);
}
__device__ __forceinline__ void st_rwpost(STAGE_ARGS) {
    FRESH_TID const int t0 = g ? MP / 64 : 0, nt = g_rows(g) / 64;
    h16x2 gup[64];
    { const float* gu = args.in[I_GUP] + (size_t)layer * 128 * 512 + tid;
#pragma unroll
      for (int i2 = 0; i2 < 64; ++i2) { const float g0 = gu[0], g1 = gu[512]; gu += 1024; asm volatile("" : "+v"(gu)); gup[i2] = (h16x2){(h16)g0, (h16)g1}; } }
    for (int tile = cb; tile < nt; tile += nb) rwpost_tile(args, layer, t0 + tile, lds, tid, lane, wave, gup);
}
__device__ __forceinline__ void st_convp(STAGE_ARGS) { FRESH_TID convert_p(args, layer, g, nb, cb, tid); }

__device__ __forceinline__ void sub_sync(unsigned* ctr, unsigned target) {
    asm volatile("s_waitcnt vmcnt(0) lgkmcnt(0)" ::: "memory");
    __syncthreads();
    if (threadIdx.x == 0) {
        __builtin_amdgcn_fence(__ATOMIC_RELEASE, "agent"); asm volatile("s_waitcnt vmcnt(0)" ::: "memory");
        __hip_atomic_fetch_add(ctr, 1u, __ATOMIC_RELAXED, __HIP_MEMORY_SCOPE_AGENT);
        while (__hip_atomic_load(ctr, __ATOMIC_RELAXED, __HIP_MEMORY_SCOPE_AGENT) < target) __builtin_amdgcn_s_sleep(2);
    }
    __syncthreads();
    __builtin_amdgcn_fence(__ATOMIC_ACQUIRE, "agent"); asm volatile("s_waitcnt vmcnt(0)" ::: "memory");
}

constexpr int NSB = 32;
__global__ void __launch_bounds__(NTHREADS, 2) fwd_megakernel(Args args) {
    extern __shared__ __attribute__((aligned(16))) unsigned char lds_raw[];
    LAS unsigned char* lds = (LAS unsigned char*)lds_raw;
    cg::grid_group grid = cg::this_grid();
    const int bid = blockIdx.x, G = gridDim.x;
    const int NPB = G - NSB, pb = bid - NSB;
    unsigned* ctr = (unsigned*)(args.ws + WS_CTR);
    if (bid == 0 && threadIdx.x == 0) __hip_atomic_store(ctr, 0u, __ATOMIC_RELAXED, __HIP_MEMORY_SCOPE_AGENT);
    unsigned sbt = 0;
#define SUBSYNC() do { sbt += (unsigned)NPB; sub_sync(ctr, sbt); } while (0)

    for (int layer = 0; layer < 2; ++layer) {
        { FRESH_TID phase_convert(args, layer, lds, tid, lane, wave, bid, G); }
        grid_sync(grid);
        st_ffn_up(args, layer, 1, G, bid, lds, 0); grid_sync(grid);
        st_ffn_down(args, layer, 1, G, bid, lds, 0); grid_sync(grid);
        st_win(args, layer, 1, G, bid, lds); grid_sync(grid);
        { FRESH_TID for (int it = 1024 + bid; it < 1536; it += G) na_item(args, layer, it, lds, tid, lane, wave); }
        grid_sync(grid);
        if (bid < NSB) {
            FRESH_TID scan_item<4>(args, layer, bid, 0, lds, tid, lane, wave);
        } else {
            st_ffn_up(args, layer, 0, NPB, pb, lds, 0); SUBSYNC();
            st_ffn_down(args, layer, 0, NPB, pb, lds, 0); SUBSYNC();
            st_win(args, layer, 0, NPB, pb, lds); SUBSYNC();
            { FRESH_TID
              scan_item<4>(args, layer, 32 + pb, 0, lds, tid, lane, wave); __syncthreads();
              if (pb < 2 * (256 - NPB)) { scan_item<2>(args, layer, 32 + NPB + (pb >> 1), pb & 1, lds, tid, lane, wave); __syncthreads(); }
              else { for (int it = pb - 2 * (256 - NPB); it < 1024; it += NPB - 2 * (256 - NPB)) na_item(args, layer, it, lds, tid, lane, wave); } }
            SUBSYNC();
            st_rwpost(args, layer, 0, NPB, pb, lds); SUBSYNC();
            st_wout(args, layer, 0, NPB, pb, lds); SUBSYNC();
            st_ffn_up(args, layer, 0, NPB, pb, lds, 1); SUBSYNC();
            st_ffn_down(args, layer, 0, NPB, pb, lds, 1); st_convp(args, layer, 0, NPB, pb, lds); SUBSYNC();
            st_pu(args, layer, 0, NPB, pb, lds); SUBSYNC();
            st_ple(args, layer, 0, NPB, pb, lds);
        }
        grid_sync(grid);
        st_rwpost(args, layer, 1, G, bid, lds); grid_sync(grid);
        st_wout(args, layer, 1, G, bid, lds); grid_sync(grid);
        st_ffn_up(args, layer, 1, G, bid, lds, 1); grid_sync(grid);
        st_ffn_down(args, layer, 1, G, bid, lds, 1); st_convp(args, layer, 1, G, bid, lds); grid_sync(grid);
        st_pu(args, layer, 1, G, bid, lds); grid_sync(grid);
        st_ple(args, layer, 1, G, bid, lds); grid_sync(grid);
    }
    {
        FRESH_TID
        const float* SSB = (const float*)(args.ws + WS_SSB); float* out = args.out;
        const int gw = bid * NWAVES + wave, NGW = G * NWAVES; const f32x4* gm = (const f32x4*)args.in[I_FINAL] + lane;
        f32x4 gv[4];
#pragma unroll
        for (int j = 0; j < 4; ++j) gv[j] = gm[64 * j];
        for (int m = gw; m < M; m += NGW) {
            const float rs = row_rstd(SSB, m); f32x4* o = (f32x4*)(out + (size_t)m * D) + lane;
#pragma unroll
            for (int j = 0; j < 4; ++j) { const f32x4 v = o[64 * j]; o[64 * j] = v * rs * gv[j]; }
        }
    }
}

extern "C" void kernel_launch(void* const* d_in, const int* in_sizes, int n_in, void* d_out, int out_size, void* d_ws, size_t ws_size, hipStream_t stream) {
    static int grid = 0;
    if (grid == 0) {
        if (n_in != N_IN || out_size != M * D || ws_size < WS_END) { fprintf(stderr, "kernel_launch: unexpected shapes (n_in %d, out %d, ws %zu)\n", n_in, out_size, ws_size); grid = -1; return; }
        int dev = 0, cus = 0, per_cu = 0;
        (void)hipGetDevice(&dev); (void)hipDeviceGetAttribute(&cus, hipDeviceAttributeMultiprocessorCount, dev);
        (void)hipFuncSetAttribute((const void*)fwd_megakernel, hipFuncAttributeMaxDynamicSharedMemorySize, LDS_BYTES);
        (void)hipOccupancyMaxActiveBlocksPerMultiprocessor(&per_cu, (const void*)fwd_megakernel, NTHREADS, LDS_BYTES);
        if (per_cu < 1) fprintf(stderr, "kernel_launch: occupancy query says %d blocks per CU\n", per_cu);
        grid = cus;
        if (grid != 256) fprintf(stderr, "kernel_launch: grid %d (expected 256)\n", grid);
        if (grid <= NSB + 64) { fprintf(stderr, "kernel_launch: grid too small\n"); grid = -1; return; }
    }
    if (grid < 0) return;
    Args a{};
    for (int i = 0; i < N_IN; ++i) a.in[i] = (const float*)d_in[i];
    a.out = (float*)d_out; a.ws = (unsigned char*)d_ws;
    void* kargs[] = {&a};
    hipError_t e = hipLaunchCooperativeKernel((const void*)fwd_megakernel, dim3(grid), dim3(NTHREADS), kargs, LDS_BYTES, stream);
    if (e != hipSuccess) fprintf(stderr, "kernel_launch: cooperative launch failed: %s\n", hipGetErrorString(e));
}
```

```cpp
#include <hip/hip_runtime.h>
#include <hip/hip_cooperative_groups.h>
#include <cstdio>
#include <cstdint>
namespace cg = cooperative_groups;
#ifndef PHM
#define PHM 0xFFFF
#endif
#define PH(k) ((PHM >> (k)) & 1)

#define LAS __attribute__((address_space(3)))
typedef _Float16 h16;
typedef _Float16 h16x2 __attribute__((ext_vector_type(2)));
typedef _Float16 h16x4 __attribute__((ext_vector_type(4)));
typedef _Float16 h16x8 __attribute__((ext_vector_type(8)));
typedef _Float16 h16x8a __attribute__((ext_vector_type(8), may_alias));
typedef float f32x2 __attribute__((ext_vector_type(2)));
typedef float f32x4 __attribute__((ext_vector_type(4)));
typedef unsigned u32x2 __attribute__((ext_vector_type(2)));
typedef unsigned u32x4 __attribute__((ext_vector_type(4)));
typedef unsigned u32x4a __attribute__((ext_vector_type(4), may_alias));

constexpr int D = 1024, FF = 2816, MP = 65536, MS = 32768, M = MP + MS, TP = 4096, TS = 16384, PLE = 256;
constexpr int NPROJ = 3584;
constexpr int NTHREADS = 512, NWAVES = 8;
constexpr int LDS_BYTES = 147456;
constexpr size_t MiB = 1u << 20;
constexpr size_t WS_CTR = 256;
constexpr size_t WS_W = 1 * MiB;
constexpr size_t WS_SSA = 46 * MiB;
constexpr size_t WS_SSB = 52 * MiB;
constexpr size_t REG_P = 58 * MiB, REG_S = 682 * MiB, WS_END = 994 * MiB;
constexpr size_t OFF_H16 = 0;
constexpr size_t OFF_MIX = 2048;
constexpr size_t OFF_KNA = 4096, OFF_VNA = 5120, OFF_RR = 6144, OFF_RK = 7168, OFF_RV = 8192;
constexpr size_t OFF_LOWS = 9216;
constexpr size_t OFF_ACT = 2048;
constexpr size_t OFF_P16 = 7680;
constexpr size_t OFF_PU = 2048;
constexpr size_t OFF_H16B = 7680;
constexpr size_t OFF_YB = 0, OFF_BSC = 1024;
constexpr size_t OFF_END = 9984;
static_assert(REG_P + OFF_END * MP <= REG_S && REG_S + OFF_END * MS <= WS_END, "group regions");
__device__ __forceinline__ unsigned char* gbuf(unsigned char* ws, int g, size_t off, size_t stride) {
    const size_t reg = g ? REG_S : REG_P, rows = g ? (size_t)MS : (size_t)MP, row0 = g ? (size_t)MP : 0;
    return ws + (reg + off * rows - row0 * stride);
}
#define GB_H16(g)  ((h16*)gbuf(ws, g, OFF_H16, 2048))
#define GB_H16B(g) ((h16*)gbuf(ws, g, OFF_H16B, 2048))
#define GB_MIX(g)  ((h16*)gbuf(ws, g, OFF_MIX, 2048))
#define GB_KNA(g)  ((h16*)gbuf(ws, g, OFF_KNA, 1024))
#define GB_VNA(g)  ((h16*)gbuf(ws, g, OFF_VNA, 1024))
#define GB_RR(g)   ((h16*)gbuf(ws, g, OFF_RR, 1024))
#define GB_RK(g)   ((h16*)gbuf(ws, g, OFF_RK, 1024))
#define GB_RV(g)   ((h16*)gbuf(ws, g, OFF_RV, 1024))
#define GB_LOWS(g) ((h16*)gbuf(ws, g, OFF_LOWS, 768))
#define GB_ACT(g)  ((h16*)gbuf(ws, g, OFF_ACT, 5632))
#define GB_P16(g)  ((h16*)gbuf(ws, g, OFF_P16, 512))
#define GB_PU(g)   ((h16*)gbuf(ws, g, OFF_PU, 2048))
#define GB_YB(g)   ((h16*)gbuf(ws, g, OFF_YB, 1024))
#define GB_BSC(g)  ((float*)gbuf(ws, g, OFF_BSC, 64))
constexpr size_t W_FFN1U = 0;
constexpr size_t W_FFN1D = W_FFN1U + (size_t)5632 * 1024;
constexpr size_t W_IN = W_FFN1D + (size_t)1024 * 2816;
constexpr size_t W_OUT = W_IN + (size_t)3584 * 1024;
constexpr size_t W_FFN2U = W_OUT + (size_t)1024 * 1024;
constexpr size_t W_FFN2D = W_FFN2U + (size_t)5632 * 1024;
constexpr size_t W_GATE = W_FFN2D + (size_t)1024 * 2816;
constexpr size_t W_UP = W_GATE + (size_t)1024 * 1024;
constexpr size_t W_ENDE = W_UP + (size_t)1024 * 256;
static_assert(WS_W + W_ENDE * 2 <= WS_SSA, "weights fit");

enum { I_XP = 0, I_XS, I_PP, I_PS, I_F1N, I_F1G, I_F1U, I_F1D, I_MIXN, I_WIN, I_RPB, I_MU, I_W0, I_WUP, I_A0, I_AUP, I_GUP, I_KK, I_KA, I_RK, I_LNW, I_LNB,
       I_WOUT, I_F2N, I_F2G, I_F2U, I_F2D, I_PLEN, I_PLEG, I_PLEU, I_FINAL, N_IN };
struct Args { const float* in[N_IN]; float* out; unsigned char* ws; };

__device__ __forceinline__ float wave_sum(float v) {
#pragma unroll
    for (int o = 1; o < 64; o <<= 1) v += __shfl_xor(v, o);
    return v;
}
__device__ __forceinline__ unsigned pk2h(float a, float b) { h16x2 p = {(h16)a, (h16)b}; return __builtin_bit_cast(unsigned, p); }
__device__ __forceinline__ h16x2 as_h2(unsigned u) { return __builtin_bit_cast(h16x2, u); }
__device__ __forceinline__ float dot2h(unsigned a, h16x2 b, float c) { return __builtin_amdgcn_fdot2(as_h2(a), b, c, false); }
__device__ __forceinline__ float dot8(u32x4 a, u32x4 b, float c) { const unsigned a0 = a[0], a1 = a[1], a2 = a[2], a3 = a[3], b0 = b[0], b1 = b[1], b2 = b[2], b3 = b[3];
    c = __builtin_amdgcn_fdot2(as_h2(a0), as_h2(b0), c, false); c = __builtin_amdgcn_fdot2(as_h2(a1), as_h2(b1), c, false); c = __builtin_amdgcn_fdot2(as_h2(a2), as_h2(b2), c, false); c = __builtin_amdgcn_fdot2(as_h2(a3), as_h2(b3), c, false); return c; }
__device__ __forceinline__ float dot8w(u32x4 a, h16x2 w0, h16x2 w1, h16x2 w2, h16x2 w3, float c) { const unsigned a0 = a[0], a1 = a[1], a2 = a[2], a3 = a[3];
    c = __builtin_amdgcn_fdot2(as_h2(a0), w0, c, false); c = __builtin_amdgcn_fdot2(as_h2(a1), w1, c, false); c = __builtin_amdgcn_fdot2(as_h2(a2), w2, c, false); c = __builtin_amdgcn_fdot2(as_h2(a3), w3, c, false); return c; }
__device__ __forceinline__ float fma_mix_lo(float p, unsigned v, float o) { asm("v_fma_mix_f32 %0, %1, %2, %0 op_sel_hi:[0,1,0]" : "+v"(o) : "v"(p), "v"(v)); return o; }
__device__ __forceinline__ float fma_mix_hi(float p, unsigned v, float o) { asm("v_fma_mix_f32 %0, %1, %2, %0 op_sel:[0,1,0] op_sel_hi:[0,1,0]" : "+v"(o) : "v"(p), "v"(v)); return o; }
__device__ __forceinline__ float sigmoidf_(float x) { return __builtin_amdgcn_rcpf(1.0f + __expf(-x)); }
__device__ __forceinline__ float row_rstd(const float* ss, int row) {
    const f32x4* p = (const f32x4*)(ss + (size_t)row * 16);
    const f32x4 a = p[0], b = p[1], c = p[2], d = p[3];
    const float s = ((a.x + a.y) + (a.z + a.w)) + ((b.x + b.y) + (b.z + b.w)) + ((c.x + c.y) + (c.z + c.w)) + ((d.x + d.y) + (d.z + d.w));
    return __builtin_amdgcn_rsqf(s * (1.0f / 1024.0f) + 1e-6f);
}
template <int CTRL> __device__ __forceinline__ float dpp_f(float v) { return __builtin_bit_cast(float, __builtin_amdgcn_update_dpp(0, __builtin_bit_cast(int, v), CTRL, 0xF, 0xF, true)); }
__device__ __forceinline__ float row16_sum(float v) {
    v += dpp_f<0xB1>(v);
    v += dpp_f<0x4E>(v);
    v += dpp_f<0x141>(v);
    v += dpp_f<0x140>(v);
    return v;
}
__device__ __forceinline__ void grid_sync(cg::grid_group& grid) {
    asm volatile("s_waitcnt vmcnt(0) lgkmcnt(0)" ::: "memory"); grid.sync();
    __builtin_amdgcn_fence(__ATOMIC_ACQUIRE, "agent"); asm volatile("s_waitcnt vmcnt(0)" ::: "memory"); }

namespace pg8 {
constexpr int BM = 256, BK = 64, HALF = 128, HTB = HALF * BK * 2, STAGE_BYTES = 8 * HTB, NXCD = 8, WGM = 8;
__host__ __device__ __forceinline__ int lds_byte(int r, int c) { const int st = (r >> 4) * 2 + (c >> 5), rr = r & 15, cc = c & 31, ob = rr * 64 + cc * 2; return st * 1024 + (ob ^ (((ob >> 9) & 1) << 5)); }
__host__ __device__ __forceinline__ void stage_rc(int b, int& R, int& C) { const int st = b / 1024, sb = b % 1024, swz = sb ^ (((sb >> 9) & 1) << 5); R = (st >> 1) * 16 + swz / 64; C = (st & 1) * 32 + (swz % 64) / 2; }
__host__ __device__ __forceinline__ int perm32(int rho) { const int n = rho >> 4, i = rho & 15; return 8 * (i >> 2) + 4 * n + (i & 3); }
struct Unit { int pm, pn; };
struct Gemm { const h16* A; const h16* Bt; int M, N, K, lda; };
struct StaticOrder {
    int nM, nN, nwg, G, c, pm0;
    __device__ void init(int M_, int N_, int G_, int c_, int pm0_) { nM = M_ / BM; nN = N_ / BM; nwg = nM * nN; G = G_; c = c_; pm0 = pm0_; }
    __device__ bool next(int i, Unit& u) const {
        const long L = (long)i * G + c; if (L >= nwg) return false;
        int wgid = (int)L; { const int q = nwg / NXCD, r = nwg % NXCD, xcd = wgid % NXCD, off = wgid / NXCD; wgid = (xcd < r ? xcd * (q + 1) : r * (q + 1) + (xcd - r) * q) + off; }
        const int nig = WGM * nN, gid = wgid / nig, fm = gid * WGM, gsz = (nM - fm) < WGM ? (nM - fm) : WGM;
        u.pm = pm0 + fm + ((wgid % nig) % gsz); u.pn = (wgid % nig) / gsz; return true;
    }
};
typedef f32x4 Acc[2][2][4][2];

template <class Epi>
__device__ __forceinline__ void gemm_phase(LAS unsigned char* lds, const Gemm g, const StaticOrder& S, const Epi& E, const int tid) {
    const int wid = __builtin_amdgcn_readfirstlane(tid >> 6), lane = tid & 63, wr = wid >> 2, wc = wid & 3, fr = lane & 15, fq = lane >> 4;
    const int K = g.K, nt = K / BK, lda = g.lda;
    unsigned voffA[2], voffB[2];
#pragma unroll
    for (int i = 0; i < 2; ++i) { int R, C; stage_rc(tid * 16 + i * 8192, R, C); const int Rb = Epi::PERM ? ((R & ~31) + perm32(R & 31)) : R;
        voffA[i] = (unsigned)(R * lda + C) * 2u; voffB[i] = (unsigned)(Rb * K + C) * 2u; }
    const size_t kstep = (size_t)(BK * 2);
    const size_t hstepA = (size_t)HALF * lda * 2, hstepB = (size_t)HALF * K * 2;
    const size_t tstepA = 2 * hstepA, tstepB = 2 * hstepB;
    const unsigned ldsw = (unsigned)wid * 1024u;
    const int aoff = lds_byte(wr * 64 + fr, fq * 8), boff = lds_byte(wc * 32 + fr, fq * 8);
#define PG8_SA(b, h) (((b) * 2 + (h)) * HTB)
#define PG8_SB(b, h) ((4 + (b) * 2 + (h)) * HTB)
#define PG8_STAGE(bufoff, gbase, voff) do { _Pragma("unroll") for (int _i = 0; _i < 2; ++_i) \
        __builtin_amdgcn_global_load_lds((const unsigned*)((const char*)(gbase) + (voff)[_i]), (LAS unsigned*)(lds + (bufoff) + ldsw + _i * 8192), 16, 0, 0); } while (0)
#define PG8_LDA(dst, b, h) do { _Pragma("unroll") for (int m = 0; m < 4; ++m) _Pragma("unroll") for (int k = 0; k < 2; ++k) dst[m][k] = *(const LAS h16x8*)(lds + PG8_SA(b, h) + aoff + m * 2048 + k * 1024); } while (0)
#define PG8_LDB(dst, b, h) do { _Pragma("unroll") for (int n = 0; n < 2; ++n) _Pragma("unroll") for (int k = 0; k < 2; ++k) dst[n][k] = *(const LAS h16x8*)(lds + PG8_SB(b, h) + boff + n * 2048 + k * 1024); } while (0)
#define PG8_MMA(ai, bj, At, Bt) do { __builtin_amdgcn_s_setprio(1); _Pragma("unroll") for (int m = 0; m < 4; ++m) _Pragma("unroll") for (int n = 0; n < 2; ++n) _Pragma("unroll") for (int k = 0; k < 2; ++k) \
        acc[ai][bj][m][n] = __builtin_amdgcn_mfma_f32_16x16x32_f16(Bt[n][k], At[m][k], acc[ai][bj][m][n], 0, 0, 0); __builtin_amdgcn_s_setprio(0); } while (0)
#define PG8_WAIT_V(n) asm volatile("s_waitcnt vmcnt(" #n ")" ::: "memory")
#define PG8_WAIT_L(n) asm volatile("s_waitcnt lgkmcnt(" #n ")" ::: "memory")
#define PG8_BAR __builtin_amdgcn_s_barrier()
#define PG8_SCHED __builtin_amdgcn_sched_barrier(0)
    Unit cur, nxt; int ui = 0;
    if (!S.next(0, cur)) return;
    f32x4 acc[2][2][4][2];
#pragma unroll
    for (int a = 0; a < 2; ++a)
#pragma unroll
        for (int b = 0; b < 2; ++b)
#pragma unroll
            for (int m = 0; m < 4; ++m)
#pragma unroll
                for (int n = 0; n < 2; ++n) acc[a][b][m][n] = (f32x4){0.f, 0.f, 0.f, 0.f};
    h16x8 At[4][2], B0[2][2], B1[2][2];
    const char* cA = (const char*)g.A + (size_t)cur.pm * tstepA; const char* cB = (const char*)g.Bt + (size_t)cur.pn * tstepB;
    PG8_STAGE(PG8_SB(0, 0), cB, voffB); PG8_STAGE(PG8_SB(0, 1), cB + hstepB, voffB); PG8_STAGE(PG8_SA(0, 0), cA, voffA); PG8_STAGE(PG8_SA(0, 1), cA + hstepA, voffA);
    if (wr == 1) PG8_BAR;
    PG8_WAIT_V(2); PG8_BAR;
    PG8_STAGE(PG8_SB(1, 0), cB + kstep, voffB); PG8_STAGE(PG8_SA(1, 0), cA + kstep, voffA); PG8_STAGE(PG8_SB(1, 1), cB + hstepB + kstep, voffB);
    PG8_WAIT_V(6); PG8_BAR;
    for (;;) {
        const bool has_next = S.next(ui + 1, nxt);
        const char* nA = has_next ? (const char*)g.A + (size_t)nxt.pm * tstepA : cA; const char* nB = has_next ? (const char*)g.Bt + (size_t)nxt.pn * tstepB : cB;
        for (int t = 0; t < nt; t += 2) {
            const bool last = (t == nt - 2);
            const char* a1 = cA + (size_t)(t + 1) * kstep;
            const char* a2 = last ? nA : cA + (size_t)(t + 2) * kstep; const char* b2 = last ? nB : cB + (size_t)(t + 2) * kstep;
            const char* a3 = a2 + kstep; const char* b3 = b2 + kstep;
            PG8_LDB(B0, 0, 0); PG8_LDB(B1, 0, 1); PG8_SCHED; PG8_LDA(At, 0, 0); PG8_STAGE(PG8_SA(1, 1), a1 + hstepA, voffA);
            PG8_WAIT_V(8); PG8_WAIT_L(0); PG8_BAR; PG8_MMA(0, 0, At, B0); PG8_MMA(0, 1, At, B1); PG8_BAR; PG8_SCHED;
            PG8_LDA(At, 0, 1); PG8_STAGE(PG8_SB(0, 0), b2, voffB); PG8_STAGE(PG8_SB(0, 1), b2 + hstepB, voffB); PG8_STAGE(PG8_SA(0, 0), a2, voffA);
            PG8_WAIT_V(8); PG8_WAIT_L(0); PG8_BAR; PG8_MMA(1, 0, At, B0); PG8_MMA(1, 1, At, B1); PG8_BAR; PG8_SCHED;
            PG8_LDB(B0, 1, 0); PG8_LDB(B1, 1, 1); PG8_SCHED; PG8_LDA(At, 1, 0); PG8_STAGE(PG8_SA(0, 1), a2 + hstepA, voffA);
            PG8_WAIT_V(8); PG8_WAIT_L(0); PG8_BAR; PG8_MMA(0, 0, At, B0); PG8_MMA(0, 1, At, B1); PG8_BAR; PG8_SCHED;
            PG8_LDA(At, 1, 1); PG8_STAGE(PG8_SB(1, 0), b3, voffB); PG8_STAGE(PG8_SB(1, 1), b3 + hstepB, voffB); PG8_STAGE(PG8_SA(1, 0), a3, voffA);
            PG8_WAIT_V(8); PG8_WAIT_L(0); PG8_BAR; PG8_MMA(1, 0, At, B0); PG8_MMA(1, 1, At, B1); PG8_BAR; PG8_SCHED;
        }
        if (wr == 0) PG8_BAR;
        E(acc, cur, wr, wc, fr, fq);
        if (!has_next) break;
#pragma unroll
        for (int a = 0; a < 2; ++a)
#pragma unroll
            for (int b = 0; b < 2; ++b)
#pragma unroll
                for (int m = 0; m < 4; ++m)
#pragma unroll
                    for (int n = 0; n < 2; ++n) acc[a][b][m][n] = (f32x4){0.f, 0.f, 0.f, 0.f};
        cur = nxt; cA = nA; cB = nB; ++ui;
        if (wr == 1) PG8_BAR;
    }
    PG8_WAIT_V(0);
    PG8_BAR;
#undef PG8_SA
#undef PG8_SB
#undef PG8_STAGE
#undef PG8_LDA
#undef PG8_LDB
#undef PG8_MMA
#undef PG8_WAIT_V
#undef PG8_WAIT_L
#undef PG8_BAR
#undef PG8_SCHED
}


struct EpiSwiglu {
    static constexpr bool PERM = true;
    h16* O; const float* ss;
    __device__ __forceinline__ void operator()(const Acc& acc, const Unit& u, int wr, int wc, int fr, int fq) const {
        const int row0 = u.pm * BM + wr * 64 + fr, col0 = u.pn * 128 + wc * 32 + 8 * fq;
#pragma unroll
        for (int ai = 0; ai < 2; ++ai)
#pragma unroll
            for (int m = 0; m < 4; ++m) {
                const int row = row0 + ai * HALF + m * 16; const float rs = row_rstd(ss, row);
                float o[8];
#pragma unroll
                for (int n = 0; n < 2; ++n)
#pragma unroll
                    for (int j = 0; j < 4; ++j) { const float gg = acc[ai][0][m][n][j] * rs, uu = acc[ai][1][m][n][j] * rs; o[n * 4 + j] = gg * sigmoidf_(gg) * uu; }
                u32x4 w; w.x = pk2h(o[0], o[1]); w.y = pk2h(o[2], o[3]); w.z = pk2h(o[4], o[5]); w.w = pk2h(o[6], o[7]);
                *(u32x4*)(O + (size_t)row * FF + col0) = w;
            }
    }
};
struct EpiResid {
    static constexpr bool PERM = false;
    const float* res_p; const float* res_s; float* out; h16* o16; float* ss; float alpha;
    __device__ __forceinline__ void operator()(const Acc& acc, const Unit& u, int wr, int wc, int fr, int fq) const {
        const int row0 = u.pm * BM + wr * 64 + fr, col0 = u.pn * BM + wc * 32 + 4 * fq;
        const float* res = (u.pm * BM < MP) ? res_p : res_s;
#pragma unroll
        for (int ai = 0; ai < 2; ++ai)
#pragma unroll
            for (int m = 0; m < 4; ++m) {
                const int row = row0 + ai * HALF + m * 16; const size_t off = (size_t)row * D + col0; float sq = 0.f;
#pragma unroll
                for (int bj = 0; bj < 2; ++bj)
#pragma unroll
                    for (int n = 0; n < 2; ++n) { const size_t o = off + bj * HALF + n * 16; const f32x4 r = *(const f32x4*)(res + o); const f32x4 v = r + acc[ai][bj][m][n] * alpha;
                        *(f32x4*)(out + o) = v; u32x2 w; w.x = pk2h(v.x, v.y); w.y = pk2h(v.z, v.w); *(u32x2*)(o16 + o) = w; sq += (v.x * v.x + v.y * v.y) + (v.z * v.z + v.w * v.w); }
                sq += __shfl_xor(sq, 16); sq += __shfl_xor(sq, 32);
                if (fq == 0) ss[(size_t)row * 16 + u.pn * 4 + wc] = sq;
                asm volatile("" ::: "memory");
            }
    }
};
struct EpiProj {
    static constexpr bool PERM = true;
    h16* mix; h16* kna; size_t bufstep; h16* lows; const float* ss;
    __device__ __forceinline__ void operator()(const Acc& acc, const Unit& u, int wr, int wc, int fr, int fq) const {
        const int pn = u.pn; h16* base; int ldc, c0; float sc = 1.f; int nbj = 2;
        if (pn < 2) { base = mix; ldc = 1024; c0 = pn * 256; sc = 0.125f; }
        else if (pn < 12) { base = kna + (size_t)((pn - 2) >> 1) * bufstep; ldc = 512; c0 = ((pn - 2) & 1) * 256; }
        else { base = lows; ldc = 384; c0 = (pn - 12) * 256; if (pn == 13) nbj = 1; }
        const int row0 = u.pm * BM + wr * 64 + fr, col0 = c0 + wc * 32 + 8 * fq;
#pragma unroll
        for (int ai = 0; ai < 2; ++ai)
#pragma unroll
            for (int m = 0; m < 4; ++m) {
                const int row = row0 + ai * HALF + m * 16; const float rs = row_rstd(ss, row) * sc;
#pragma unroll
                for (int bj = 0; bj < 2; ++bj) if (bj < nbj) {
                    const f32x4 v0 = acc[ai][bj][m][0] * rs, v1 = acc[ai][bj][m][1] * rs;
                    u32x4 w; w.x = pk2h(v0.x, v0.y); w.y = pk2h(v0.z, v0.w); w.z = pk2h(v1.x, v1.y); w.w = pk2h(v1.z, v1.w);
                    *(u32x4*)(base + (size_t)row * ldc + col0 + bj * HALF) = w; }
            }
    }
};
struct EpiPU {
    static constexpr bool PERM = true;
    h16* O;
    __device__ __forceinline__ void operator()(const Acc& acc, const Unit& u, int wr, int wc, int fr, int fq) const {
        const int row0 = u.pm * BM + wr * 64 + fr, col0 = u.pn * BM + wc * 32 + 8 * fq;
#pragma unroll
        for (int ai = 0; ai < 2; ++ai)
#pragma unroll
            for (int m = 0; m < 4; ++m) {
                const int row = row0 + ai * HALF + m * 16;
#pragma unroll
                for (int bj = 0; bj < 2; ++bj) {
                    const f32x4 v0 = acc[ai][bj][m][0], v1 = acc[ai][bj][m][1];
                    u32x4 w; w.x = pk2h(v0.x, v0.y); w.y = pk2h(v0.z, v0.w); w.z = pk2h(v1.x, v1.y); w.w = pk2h(v1.z, v1.w);
                    *(u32x4*)(O + (size_t)row * D + col0 + bj * HALF) = w; }
            }
    }
};
struct EpiPle {
    static constexpr bool PERM = false;
    float* out; h16* o16; float* ssw; const float* ssr; const h16* pu;
    __device__ __forceinline__ void operator()(const Acc& acc, const Unit& u, int wr, int wc, int fr, int fq) const {
        const int row0 = u.pm * BM + wr * 64 + fr, col0 = u.pn * BM + wc * 32 + 4 * fq;
#pragma unroll
        for (int ai = 0; ai < 2; ++ai)
#pragma unroll
            for (int m = 0; m < 4; ++m) {
                const int row = row0 + ai * HALF + m * 16; const size_t off = (size_t)row * D + col0; float sq = 0.f; const float rs = row_rstd(ssr, row);
#pragma unroll
                for (int bj = 0; bj < 2; ++bj)
#pragma unroll
                    for (int n = 0; n < 2; ++n) { const size_t o = off + bj * HALF + n * 16; const f32x4 r = *(const f32x4*)(out + o); const h16x4 p = *(const h16x4*)(pu + o);
                        const f32x4 a = acc[ai][bj][m][n] * rs; f32x4 v;
                        v.x = r.x + sigmoidf_(a.x) * (float)p.x; v.y = r.y + sigmoidf_(a.y) * (float)p.y; v.z = r.z + sigmoidf_(a.z) * (float)p.z; v.w = r.w + sigmoidf_(a.w) * (float)p.w;
                        *(f32x4*)(out + o) = v; u32x2 w; w.x = pk2h(v.x, v.y); w.y = pk2h(v.z, v.w); *(u32x2*)(o16 + o) = w; sq += (v.x * v.x + v.y * v.y) + (v.z * v.z + v.w * v.w); }
                sq += __shfl_xor(sq, 16); sq += __shfl_xor(sq, 32);
                if (fq == 0) ssw[(size_t)row * 16 + u.pn * 4 + wc] = sq;
                asm volatile("" ::: "memory");
            }
    }
};
}

__device__ __forceinline__ void convert_matrix(const float* W, int K, int N, const float* gamma, h16* WT, int mode, LAS float* scr, int gw, int NGW, int lane) {
    const int nblk = N / 32, nitems = (K / 64) * nblk;
    for (int item = gw; item < nitems; item += NGW) {
        const int kb = item / nblk, nb = item % nblk, k0 = 64 * kb, n0 = 32 * nb;
        const int drow0 = (mode == 0) ? n0 : ((n0 >> 7) * 256 + (n0 & 127) + (mode == 2 ? 128 : 0));
#pragma unroll 8
        for (int i = 0; i < 32; ++i) { const int kk = 2 * i + (lane >> 5); float v = W[(size_t)(k0 + kk) * N + n0 + (lane & 31)]; if (gamma) v *= gamma[k0 + kk]; scr[kk * 33 + (lane & 31)] = v; }
        asm volatile("s_waitcnt lgkmcnt(0)" ::: "memory");
        const int c = lane & 7;
#pragma unroll
        for (int j = 0; j < 4; ++j) { const int n = (lane >> 3) + 8 * j; const LAS float* s = scr + (8 * c) * 33 + n;
            u32x4 o; o.x = pk2h(s[0 * 33], s[1 * 33]); o.y = pk2h(s[2 * 33], s[3 * 33]); o.z = pk2h(s[4 * 33], s[5 * 33]); o.w = pk2h(s[6 * 33], s[7 * 33]);
            *(u32x4*)(WT + (size_t)(drow0 + n) * K + k0 + 8 * c) = o; }
        asm volatile("s_waitcnt lgkmcnt(0)" ::: "memory");
    }
}

__device__ __forceinline__ void phase_convert(const Args& a, int layer, LAS unsigned char* lds, int tid, int lane, int wave, int bid, int G) {
    LAS float* scr = (LAS float*)(lds + wave * 16384);
    const int gw = bid * NWAVES + wave, NGW = G * NWAVES;
    h16* W = (h16*)(a.ws + WS_W);
    const size_t l = (size_t)layer;
    convert_matrix(a.in[I_F1G] + l * D * FF, D, FF, a.in[I_F1N] + l * D, W + W_FFN1U, 1, scr, gw, NGW, lane);
    convert_matrix(a.in[I_F1U] + l * D * FF, D, FF, a.in[I_F1N] + l * D, W + W_FFN1U, 2, scr, gw, NGW, lane);
    convert_matrix(a.in[I_F1D] + l * FF * D, FF, D, nullptr, W + W_FFN1D, 0, scr, gw, NGW, lane);
    convert_matrix(a.in[I_WIN] + l * D * 3456, D, 3456, a.in[I_MIXN] + l * D, W + W_IN, 0, scr, gw, NGW, lane);
    convert_matrix(a.in[I_WOUT] + l * D * D, D, D, nullptr, W + W_OUT, 0, scr, gw, NGW, lane);
    convert_matrix(a.in[I_F2G] + l * D * FF, D, FF, a.in[I_F2N] + l * D, W + W_FFN2U, 1, scr, gw, NGW, lane);
    convert_matrix(a.in[I_F2U] + l * D * FF, D, FF, a.in[I_F2N] + l * D, W + W_FFN2U, 2, scr, gw, NGW, lane);
    convert_matrix(a.in[I_F2D] + l * FF * D, FF, D, nullptr, W + W_FFN2D, 0, scr, gw, NGW, lane);
    convert_matrix(a.in[I_PLEG] + l * D * D, D, D, a.in[I_PLEN] + l * D, W + W_GATE, 0, scr, gw, NGW, lane);
    convert_matrix(a.in[I_PLEU] + l * PLE * D, PLE, D, nullptr, W + W_UP, 0, scr, gw, NGW, lane);
    { u32x4* z = (u32x4*)(W + W_IN + (size_t)3456 * 1024); const int n16 = 128 * 1024 * 2 / 16;
      for (int i = bid * NTHREADS + tid; i < n16; i += G * NTHREADS) z[i] = (u32x4){0u, 0u, 0u, 0u}; }
    if (layer == 0) {
        unsigned char* ws = a.ws; h16* Hp = GB_H16B(0); h16* Hs = GB_H16B(1); float* ss = (float*)(a.ws + WS_SSB);
        for (int m = gw; m < M; m += NGW) {
            h16* H = (m < MP) ? Hp : Hs;
            const float* xr = (m < MP) ? a.in[I_XP] + (size_t)m * D : a.in[I_XS] + (size_t)(m - MP) * D;
            const f32x4* x4 = (const f32x4*)xr + lane; float s = 0.f;
            u32x2* o = (u32x2*)(H + (size_t)m * D) + lane;
#pragma unroll
            for (int j = 0; j < 4; ++j) { const f32x4 v = x4[64 * j]; s += (v.x * v.x + v.y * v.y) + (v.z * v.z + v.w * v.w); u32x2 w; w.x = pk2h(v.x, v.y); w.y = pk2h(v.z, v.w); o[64 * j] = w; }
            s = wave_sum(s);
            if (lane < 16) ss[(size_t)m * 16 + lane] = (lane == 0) ? s : 0.f;
        }
    }
}

__device__ __forceinline__ void convert_p(const Args& a, int layer, int g, int nb, int cb, int tid) {
    unsigned char* ws = a.ws; const int rows = g ? MS : MP, row0 = g ? MP : 0;
    u32x2* o = (u32x2*)(GB_P16(g) + (size_t)row0 * PLE);
    const f32x4* p = (const f32x4*)((g ? a.in[I_PS] + (size_t)layer * MS * PLE : a.in[I_PP] + (size_t)layer * MP * PLE));
    const int N4 = rows * PLE / 4;
    for (int i = cb * NTHREADS + tid; i < N4; i += nb * NTHREADS) { const f32x4 v = p[i]; u32x2 w; w.x = pk2h(v.x, v.y); w.y = pk2h(v.z, v.w); o[i] = w; }
}

constexpr int NA_PITCH = 144;
constexpr int NA_VOFF = 512 * NA_PITCH;
constexpr int NA_PP = 67;
__device__ __forceinline__ void na_item(const Args& a, int layer, int item, LAS unsigned char* lds, int tid, int lane, int wave) {
    int tok0, i, rows;
    if (item < 1024) { tok0 = (item >> 6) * TP; i = item & 63; rows = 64; } else { const int it2 = item - 1024; tok0 = MP + (it2 >> 8) * TS; i = it2 & 255; rows = 256; }
    int rs = i - 4; rs = rs < 0 ? 0 : (rs > rows - 8 ? rows - 8 : rs);
    unsigned char* ws = a.ws; const int g = item < 1024 ? 0 : 1;
    h16* MIX = GB_MIX(g); const h16* KNA = GB_KNA(g); const h16* VNA = GB_VNA(g);
    const float* rpb = a.in[I_RPB] + (size_t)layer * 8 * 15 * 31;
    const int wtok0 = tok0 + rs * 64;
    const int j = lane, aw = wave;
    const int tokq = tok0 + i * 64 + j;
    int cs = j - 8; cs = cs < 0 ? 0 : (cs > 48 ? 48 : cs);
#pragma unroll 1
    for (int h = 0; h < 8; ++h) {
#pragma unroll
        for (int it = 0; it < 8; ++it) { const int key = (tid >> 3) + 64 * it, ch = tid & 7;
            const u32x4 kv = *(const u32x4*)(KNA + (size_t)(wtok0 + key) * 512 + h * 64 + ch * 8);
            const u32x4 vv = *(const u32x4*)(VNA + (size_t)(wtok0 + key) * 512 + h * 64 + ch * 8);
            *(LAS u32x4*)(lds + key * NA_PITCH + ch * 16) = kv; *(LAS u32x4*)(lds + NA_VOFF + key * NA_PITCH + ch * 16) = vv; }
        u32x4 qv[8];
#pragma unroll
        for (int c = 0; c < 8; ++c) qv[c] = *(const u32x4*)(MIX + (size_t)tokq * 1024 + h * 64 + c * 8);
        __syncthreads();
        float sc[16];
        const float* bias = rpb + ((size_t)h * 15 + (rs + aw - i + 7)) * 31 + (cs - j + 15);
#pragma unroll
        for (int c = 0; c < 16; ++c) {
            const LAS unsigned char* kp = lds + (aw * 64 + cs + c) * NA_PITCH; float s = 0.f;
#pragma unroll
            for (int c8 = 0; c8 < 8; ++c8) { const u32x4 kk = *(const LAS u32x4*)(kp + c8 * 16); s = dot8(qv[c8], kk, s); }
            sc[c] = s + bias[c];
            asm volatile("" ::: "memory");
        }
        float mx = sc[0];
#pragma unroll
        for (int c = 1; c < 16; ++c) mx = fmaxf(mx, sc[c]);
        float l = 0.f;
#pragma unroll
        for (int c = 0; c < 16; ++c) { sc[c] = __expf(sc[c] - mx); l += sc[c]; }
        float o[64];
#pragma unroll
        for (int d = 0; d < 64; ++d) o[d] = 0.f;
#pragma unroll
        for (int c = 0; c < 16; ++c) {
            const LAS unsigned char* vp = lds + NA_VOFF + (aw * 64 + cs + c) * NA_PITCH; const float p = sc[c];
#pragma unroll
            for (int c8 = 0; c8 < 8; ++c8) { const u32x4 vv = *(const LAS u32x4*)(vp + c8 * 16);
#pragma unroll
                for (int e = 0; e < 4; ++e) { const unsigned ve = vv[e]; o[c8 * 8 + 2 * e] = fma_mix_lo(p, ve, o[c8 * 8 + 2 * e]); o[c8 * 8 + 2 * e + 1] = fma_mix_hi(p, ve, o[c8 * 8 + 2 * e + 1]); } }
            asm volatile("" ::: "memory");
        }
        __syncthreads();
        LAS float* part = (LAS float*)lds + (size_t)(aw * 64 + j) * NA_PP;
#pragma unroll
        for (int d = 0; d < 64; ++d) part[d] = o[d];
        part[64] = mx; part[65] = l;
        __syncthreads();
        {
            const int jq = tid & 63, e8 = tid >> 6;
            float mw[8], M_ = -3.0e38f;
#pragma unroll
            for (int w = 0; w < 8; ++w) { mw[w] = ((const LAS float*)lds)[(size_t)(w * 64 + jq) * NA_PP + 64]; M_ = fmaxf(M_, mw[w]); }
            float L = 0.f, ov[8];
#pragma unroll
            for (int e = 0; e < 8; ++e) ov[e] = 0.f;
#pragma unroll
            for (int w = 0; w < 8; ++w) { const float f = __expf(mw[w] - M_); const LAS float* pw = (const LAS float*)lds + (size_t)(w * 64 + jq) * NA_PP; L += f * pw[65];
#pragma unroll
                for (int e = 0; e < 8; ++e) ov[e] += f * pw[e8 * 8 + e]; }
            const float inv = 1.0f / L;
            u32x4 w4; w4.x = pk2h(ov[0] * inv, ov[1] * inv); w4.y = pk2h(ov[2] * inv, ov[3] * inv); w4.z = pk2h(ov[4] * inv, ov[5] * inv); w4.w = pk2h(ov[6] * inv, ov[7] * inv);
            *(u32x4*)(MIX + (size_t)(tok0 + i * 64 + jq) * 1024 + h * 64 + e8 * 8) = w4;
        }
        __syncthreads();
    }
}

__device__ __forceinline__ float shiftmix(const h16* base, size_t stride, int t, int T, float mu) {
    const float c = (float)base[0];
    const float p = (t > 0) ? (float)*(base - stride) : 0.f;
    const float n = (t < T - 1) ? (float)*(base + stride) : 0.f;
    return c + mu * (0.5f * (p + n) - c);
}
constexpr int SC_CH = 32;
constexpr int SC_OPB = SC_CH * 6 * 64 * 4;
constexpr int SC_YOFF = 2 * SC_OPB;
constexpr int SC_YB = SC_CH * 64 * 4;
constexpr int SC_XOFF = SC_YOFF + 2 * SC_YB;
constexpr int SC_ZOFF = SC_XOFF + 8192;
static_assert(SC_ZOFF + 4 * 4096 <= LDS_BYTES, "scan LDS");
__device__ __forceinline__ float wave_sum_fast(float v) {
    v = row16_sum(v);
    { const auto r = __builtin_amdgcn_permlane16_swap(__builtin_bit_cast(unsigned, v), __builtin_bit_cast(unsigned, v), false, false);
      const unsigned r0 = r[0], r1 = r[1]; v = __builtin_bit_cast(float, r0) + __builtin_bit_cast(float, r1); }
    { const auto r = __builtin_amdgcn_permlane32_swap(__builtin_bit_cast(unsigned, v), __builtin_bit_cast(unsigned, v), false, false);
      const unsigned r0 = r[0], r1 = r[1]; v = __builtin_bit_cast(float, r0) + __builtin_bit_cast(float, r1); }
    return v;
}
__device__ __forceinline__ float mix3(h16 p, h16 c, h16 n, float mu) { const float cf = (float)c; return cf + mu * (0.5f * ((float)p + (float)n) - cf); }
struct ScanWin { h16 r[10], k[10], v[10], wl[10], al[10]; };
template <int R>
__device__ __forceinline__ void scan_flush(LAS unsigned char* lds, int cf, int pw, int lane, int d, int T, int tok0, int h, int rowbase, h16* Yf, h16* Yb) {
    const LAS float* yb = (const LAS float*)(lds + SC_YOFF + (cf & 1) * SC_YB);
    const int s = pw * 8 + (lane >> 3); const int g = cf * SC_CH + s; const int t = d ? (T - 1 - g) : g;
    if (R == 4) {
        const int r8 = (lane & 7) * 8;
        const f32x4 y0 = *(const LAS f32x4*)(yb + s * 64 + r8), y1 = *(const LAS f32x4*)(yb + s * 64 + r8 + 4);
        u32x4 w4; w4.x = pk2h(y0.x, y0.y); w4.y = pk2h(y0.z, y0.w); w4.z = pk2h(y1.x, y1.y); w4.w = pk2h(y1.z, y1.w);
        if (d == 0) *(u32x4*)(Yf + (size_t)(tok0 + t) * 1024 + 512 + h * 64 + r8) = w4; else *(u32x4*)(Yb + (size_t)(tok0 + t) * 512 + h * 64 + r8) = w4;
    } else {
        const int r4 = (lane & 7) * 4;
        const f32x4 y0 = *(const LAS f32x4*)(yb + s * 32 + r4);
        u32x2 w2; w2.x = pk2h(y0.x, y0.y); w2.y = pk2h(y0.z, y0.w);
        if (d == 0) *(u32x2*)(Yf + (size_t)(tok0 + t) * 1024 + 512 + h * 64 + rowbase + r4) = w2; else *(u32x2*)(Yb + (size_t)(tok0 + t) * 512 + h * 64 + rowbase + r4) = w2;
    }
}
template <int R>
__device__ __forceinline__ void scan_item(const Args& a, int layer, int q, int rowhalf, LAS unsigned char* lds, int tid, int lane, int wave) {
    int tok0, T, h, d;
    if (q < 32) { tok0 = MP + (q >> 4) * TS; T = TS; h = (q >> 1) & 7; d = q & 1; } else { const int q2 = q - 32; tok0 = (q2 >> 4) * TP; T = TP; h = (q2 >> 1) & 7; d = q2 & 1; }
    const int nch = T / SC_CH, rowbase = rowhalf * 16 * R;
    unsigned char* ws = a.ws; const int g = q < 32 ? 1 : 0;
    const h16* RR = GB_RR(g); const h16* RK = GB_RK(g); const h16* RV = GB_RV(g); const h16* LOWS = GB_LOWS(g);
    h16* Yf = GB_MIX(g); h16* Yb = GB_YB(g); float* BSC = GB_BSC(g);
    const size_t l = (size_t)layer;
    if (wave >= 4) {
        const int pw = wave - 4, j = lane, col = h * 64 + j;
        const float* mu = a.in[I_MU] + l * 1920;
        const float mu_r = mu[col], mu_k = mu[512 + col], mu_v = mu[1024 + col], mu_wl = mu[1536 + d * 64 + j], mu_al = mu[1536 + 128 + d * 64 + j];
        const float k_k = a.in[I_KK][l * 512 + col], k_a = a.in[I_KA][l * 512 + col], r_k = a.in[I_RK][l * 512 + col];
        const float w0 = a.in[I_W0][(l * 2 + d) * 512 + col], a0 = a.in[I_A0][(l * 2 + d) * 512 + col];
        h16x8 bw[4][2], ba[4][2];
        { const int n = lane & 15, kg = lane >> 4;
          const float* wu = a.in[I_WUP] + ((l * 2 + d) * 64 + 8 * kg) * 512 + h * 64 + n; const float* au = a.in[I_AUP] + ((l * 2 + d) * 64 + 8 * kg) * 512 + h * 64 + n;
#pragma unroll
          for (int ks = 0; ks < 2; ++ks) {
#pragma unroll
              for (int e = 0; e < 8; ++e) {
                  const float w_0 = wu[0], w_1 = wu[16], w_2 = wu[32], w_3 = wu[48], a_0 = au[0], a_1 = au[16], a_2 = au[32], a_3 = au[48];
                  wu += 512; au += 512; asm volatile("" : "+v"(wu), "+v"(au));
                  bw[0][ks][e] = (h16)w_0; bw[1][ks][e] = (h16)w_1; bw[2][ks][e] = (h16)w_2; bw[3][ks][e] = (h16)w_3;
                  ba[0][ks][e] = (h16)a_0; ba[1][ks][e] = (h16)a_1; ba[2][ks][e] = (h16)a_2; ba[3][ks][e] = (h16)a_3; }
              wu += 24 * 512; au += 24 * 512; asm volatile("" : "+v"(wu), "+v"(au)); } }
        LAS float* zl = (LAS float*)(lds + SC_ZOFF + pw * 4096);
        LAS unsigned char* xsb = lds + SC_XOFF + pw * 2048;
        ScanWin cur, nxt;
#define SCAN_LOAD_WIN(W_, cp_) do { const int g0_ = (cp_) * SC_CH + pw * 8; \
            _Pragma("unroll") for (int w = 0; w < 10; ++w) { const int tt = d ? (T - 1 - g0_) + 1 - w : g0_ - 1 + w; const bool ok = (tt >= 0) && (tt < T); const size_t tok = (size_t)(tok0 + (ok ? tt : 0)); \
                const h16 z_ = (h16)0.f; const h16 r_ = RR[tok * 512 + col], k_ = RK[tok * 512 + col], v_ = RV[tok * 512 + col], wl_ = LOWS[tok * 384 + d * 64 + j], al_ = LOWS[tok * 384 + 128 + d * 64 + j]; \
                W_.r[w] = ok ? r_ : z_; W_.k[w] = ok ? k_ : z_; W_.v[w] = ok ? v_ : z_; W_.wl[w] = ok ? wl_ : z_; W_.al[w] = ok ? al_ : z_; } } while (0)
        SCAN_LOAD_WIN(cur, 0);
        for (int c = -1; c < nch; ++c) {
            if (c >= 1) scan_flush<R>(lds, c - 1, pw, lane, d, T, tok0, h, rowbase, Yf, Yb);
            if (c + 1 < nch) {
                const int cp = c + 1; LAS float* op = (LAS float*)(lds + (cp & 1) * SC_OPB);
                if (c + 2 < nch) SCAN_LOAD_WIN(nxt, c + 2);
#pragma unroll
                for (int s8 = 0; s8 < 8; ++s8) {
                    const float wl = mix3(cur.wl[s8], cur.wl[s8 + 1], cur.wl[s8 + 2], mu_wl);
                    const float al = mix3(cur.al[s8], cur.al[s8 + 1], cur.al[s8 + 2], mu_al);
                    const float e2 = __expf(2.0f * wl); const float th = 1.0f - 2.0f * __builtin_amdgcn_rcpf(e2 + 1.0f);
                    LAS h16* xs = (LAS h16*)(xsb + s8 * 256);
                    xs[j] = (h16)th; xs[64 + j] = (h16)al;
                }
                {
                    const LAS unsigned char* xr = xsb + (lane & 7) * 256 + (lane >> 4) * 16;
                    const h16x8 xw0 = *(const LAS h16x8a*)(xr), xw1 = *(const LAS h16x8a*)(xr + 64), xa0 = *(const LAS h16x8a*)(xr + 128), xa1 = *(const LAS h16x8a*)(xr + 192);
                    f32x4 accw[4], acca[4];
#pragma unroll
                    for (int nt = 0; nt < 4; ++nt) {
                        accw[nt] = __builtin_amdgcn_mfma_f32_16x16x32_f16(xw0, bw[nt][0], (f32x4){0.f, 0.f, 0.f, 0.f}, 0, 0, 0);
                        accw[nt] = __builtin_amdgcn_mfma_f32_16x16x32_f16(xw1, bw[nt][1], accw[nt], 0, 0, 0);
                        acca[nt] = __builtin_amdgcn_mfma_f32_16x16x32_f16(xa0, ba[nt][0], (f32x4){0.f, 0.f, 0.f, 0.f}, 0, 0, 0);
                        acca[nt] = __builtin_amdgcn_mfma_f32_16x16x32_f16(xa1, ba[nt][1], acca[nt], 0, 0, 0); }
                    if (lane < 32) {
                        LAS float* zw = zl + (4 * (lane >> 4)) * 64 + (lane & 15);
#pragma unroll
                        for (int nt = 0; nt < 4; ++nt)
#pragma unroll
                            for (int r = 0; r < 4; ++r) { zw[r * 64 + 16 * nt] = accw[nt][r]; zw[512 + r * 64 + 16 * nt] = acca[nt][r]; }
                    }
                }
#pragma unroll
                for (int s8 = 0; s8 < 8; ++s8) {
                    const int s = pw * 8 + s8; const int g = cp * SC_CH + s; const int t = d ? (T - 1 - g) : g; const size_t tok = (size_t)(tok0 + t);
                    const float rr = mix3(cur.r[s8], cur.r[s8 + 1], cur.r[s8 + 2], mu_r);
                    const float kk0 = mix3(cur.k[s8], cur.k[s8 + 1], cur.k[s8 + 2], mu_k);
                    const float vv = mix3(cur.v[s8], cur.v[s8 + 1], cur.v[s8 + 2], mu_v);
                    const float z = w0 + zl[s8 * 64 + j], az = a0 + zl[512 + s8 * 64 + j];
                    const float wdec = __expf(-0.606531f * sigmoidf_(z)); const float av = sigmoidf_(az);
                    float kk = kk0 * k_k; const float n2 = wave_sum_fast(kk * kk); kk = kk * __builtin_amdgcn_rcpf(fmaxf(__builtin_amdgcn_sqrtf(n2), 1e-12f));
                    const float kd = kk0 * (1.0f + (av - 1.0f) * k_a); const float bb = kk * av;
                    const float bs = wave_sum_fast(rr * kd * r_k);
                    if (lane == 0 && rowhalf == 0) BSC[(tok * 8 + h) * 2 + d] = bs;
                    LAS float* o = op + s * 384 + j;
                    o[0] = -kk; o[64] = wdec; o[128] = bb; o[192] = kd; o[256] = rr; o[320] = vv;
                }
                cur = nxt;
            }
            __syncthreads();
        }
        scan_flush<R>(lds, nch - 1, pw, lane, d, T, tok0, h, rowbase, Yf, Yb);
#undef SCAN_LOAD_WIN
    } else {
        constexpr int RL = R / 2;
        const int ri = lane >> 3, ci = lane & 7;
        const int yrow = wave * 8 * RL + ri * RL, vrow = rowbase + yrow;
        f32x2 S[RL][4];
#pragma unroll
        for (int i = 0; i < RL; ++i)
#pragma unroll
            for (int c2 = 0; c2 < 4; ++c2) S[i][c2] = (f32x2){0.f, 0.f};
        typedef float vecR __attribute__((ext_vector_type(RL)));
        __syncthreads();
        for (int c = 0; c < nch; ++c) {
            const LAS f32x4* op = (const LAS f32x4*)(lds + (c & 1) * SC_OPB);
            LAS float* yb = (LAS float*)(lds + SC_YOFF + (c & 1) * SC_YB);
            f32x4 a0 = op[2 * ci], a1 = op[2 * ci + 1], w0 = op[16 + 2 * ci], w1 = op[17 + 2 * ci], b0 = op[32 + 2 * ci], b1 = op[33 + 2 * ci];
            f32x4 k0 = op[48 + 2 * ci], k1 = op[49 + 2 * ci], r0 = op[64 + 2 * ci], r1 = op[65 + 2 * ci]; vecR v4 = *(const LAS vecR*)((const LAS float*)op + 320 + vrow);
#pragma unroll 2
            for (int s = 0; s < SC_CH; ++s) {
                const int sn = (s + 1 < SC_CH) ? s + 1 : s; const LAS f32x4* on = op + sn * 96;
                const f32x4 na0 = on[2 * ci], na1 = on[2 * ci + 1], nw0 = on[16 + 2 * ci], nw1 = on[17 + 2 * ci], nb0 = on[32 + 2 * ci], nb1 = on[33 + 2 * ci];
                const f32x4 nk0 = on[48 + 2 * ci], nk1 = on[49 + 2 * ci], nr0 = on[64 + 2 * ci], nr1 = on[65 + 2 * ci]; const vecR nv4 = *(const LAS vecR*)((const LAS float*)on + 320 + vrow);
                const f32x2 av[4] = {{a0.x, a0.y}, {a0.z, a0.w}, {a1.x, a1.y}, {a1.z, a1.w}}, wv[4] = {{w0.x, w0.y}, {w0.z, w0.w}, {w1.x, w1.y}, {w1.z, w1.w}};
                const f32x2 bv[4] = {{b0.x, b0.y}, {b0.z, b0.w}, {b1.x, b1.y}, {b1.z, b1.w}}, kv[4] = {{k0.x, k0.y}, {k0.z, k0.w}, {k1.x, k1.y}, {k1.z, k1.w}};
                const f32x2 rv[4] = {{r0.x, r0.y}, {r0.z, r0.w}, {r1.x, r1.y}, {r1.z, r1.w}};
                float sa[RL];
#pragma unroll
                for (int i = 0; i < RL; ++i) { f32x2 p = S[i][0] * av[0]; p = S[i][1] * av[1] + p; p = S[i][2] * av[2] + p; p = S[i][3] * av[3] + p;
                    float t = p.x + p.y; t += dpp_f<0xB1>(t); t += dpp_f<0x4E>(t); t += dpp_f<0x141>(t); sa[i] = t; }
                vecR y;
#pragma unroll
                for (int i = 0; i < RL; ++i) { const f32x2 sa2 = {sa[i], sa[i]}, v2 = {v4[i], v4[i]};
#pragma unroll
                    for (int c2 = 0; c2 < 4; ++c2) S[i][c2] = S[i][c2] * wv[c2] + sa2 * bv[c2] + v2 * kv[c2];
                    f32x2 p = S[i][0] * rv[0]; p = S[i][1] * rv[1] + p; p = S[i][2] * rv[2] + p; p = S[i][3] * rv[3] + p;
                    float t = p.x + p.y; t += dpp_f<0xB1>(t); t += dpp_f<0x4E>(t); t += dpp_f<0x141>(t); y[i] = t; }
                if (ci == 0) *(LAS vecR*)(yb + s * (32 * RL) + yrow) = y;
                a0 = na0; a1 = na1; w0 = nw0; w1 = nw1; b0 = nb0; b1 = nb1; k0 = nk0; k1 = nk1; r0 = nr0; r1 = nr1; v4 = nv4;
            }
            __syncthreads();
        }
    }
}

__device__ __forceinline__ void rwpost_tile(const Args& a, int layer, int tile, LAS unsigned char* lds, int tid, int lane, int wave, const h16x2 (&gup)[64]) {
    const size_t l = (size_t)layer; const int col = tid, h = wave;
    const int m0 = tile * 64; int tok0s, T; if (m0 < MP) { T = TP; tok0s = (m0 / TP) * TP; } else { T = TS; tok0s = MP + ((m0 - MP) / TS) * TS; }
    unsigned char* ws = a.ws; const int g = m0 < MP ? 0 : 1;
    const h16* LOWS = GB_LOWS(g); const h16* RV = GB_RV(g); h16* MIX = GB_MIX(g); const h16* Yb = GB_YB(g); const float* BSC = GB_BSC(g);
    const float* mu = a.in[I_MU] + l * 1920;
    LAS h16* G = (LAS h16*)lds;
    { const int c = tid & 127; const float mug = mu[1536 + 256 + c];
#pragma unroll 4
      for (int e = tid; e < 64 * 128; e += NTHREADS) { const int tk = e >> 7; const int m = m0 + tk; const int t = m - tok0s;
        const float gl = shiftmix(LOWS + (size_t)m * 384 + 256 + c, 384, t, T, mug); G[e] = (h16)sigmoidf_(gl); } }
    const float mu_v = mu[1024 + col], lw = a.in[I_LNW][l * 512 + col], lb = a.in[I_LNB][l * 512 + col];
    __syncthreads();
#pragma unroll 1
    for (int tk0 = 0; tk0 < 64; tk0 += 8) {
        h16 ym[8], yb[8], rv[10]; float b0[8], b1[8];
#pragma unroll
        for (int w = 0; w < 10; ++w) { const int m = m0 + tk0 - 1 + w; const int t = m - tok0s; const bool ok = (t >= 0) && (t < T); const h16 v = RV[(size_t)(ok ? m : m0) * 512 + col]; rv[w] = ok ? v : (h16)0.f; }
#pragma unroll
        for (int jj = 0; jj < 8; ++jj) { const size_t m = (size_t)(m0 + tk0 + jj); ym[jj] = MIX[m * 1024 + 512 + col]; yb[jj] = Yb[m * 512 + col]; b0[jj] = BSC[(m * 8 + h) * 2]; b1[jj] = BSC[(m * 8 + h) * 2 + 1]; }
#pragma unroll
        for (int jj = 0; jj < 8; ++jj) {
            const int tk = tk0 + jj; const size_t m = (size_t)(m0 + tk);
            float gg = 0.f;
#pragma unroll
            for (int c8 = 0; c8 < 16; ++c8) { const u32x4 x = *(const LAS u32x4a*)((const LAS unsigned char*)G + tk * 256 + c8 * 16);
                gg = dot8w(x, gup[c8 * 4 + 0], gup[c8 * 4 + 1], gup[c8 * 4 + 2], gup[c8 * 4 + 3], gg); }
            const float wkv = (float)ym[jj] + (float)yb[jj];
            const float mean = wave_sum_fast(wkv) * (1.0f / 64.0f); const float dv = wkv - mean; const float var = wave_sum_fast(dv * dv) * (1.0f / 64.0f);
            const float yn = dv * __builtin_amdgcn_rsqf(var + 64e-5f) * lw + lb;
            const float vv = mix3(rv[jj], rv[jj + 1], rv[jj + 2], mu_v);
            MIX[m * 1024 + 512 + col] = (h16)((yn + (b0[jj] + b1[jj]) * vv) * gg);
        }
    }
    __syncthreads();
}

#define STAGE_ARGS const Args& args, int layer, int g, int nb, int cb, LAS unsigned char* lds
#define FRESH_TID int tid = threadIdx.x; asm volatile("" : "+v"(tid)); const int lane = tid & 63, wave = __builtin_amdgcn_readfirstlane(tid >> 6); (void)lane; (void)wave;
__device__ __forceinline__ int g_rows(int g) { return g ? MS : MP; }
__device__ __forceinline__ int g_pm0(int g) { return g ? MP / 256 : 0; }
template <class Epi> __device__ __forceinline__ void run_gemm(LAS unsigned char* lds, const h16* A, int lda, const h16* Bt, int N, int K, int g, int nb, int cb, const Epi& E, int tid) {
    pg8::Gemm gm{A, Bt, g_rows(g), N, K, lda}; pg8::StaticOrder S; S.init(g_rows(g), N, nb, cb, g_pm0(g)); pg8::gemm_phase(lds, gm, S, E, tid);
}
__device__ __forceinline__ void st_ffn_up(STAGE_ARGS, int which) {
    FRESH_TID unsigned char* ws = args.ws; const h16* W = (const h16*)(ws + WS_W);
    pg8::EpiSwiglu E{GB_ACT(g), (const float*)(ws + (which ? WS_SSA : WS_SSB))};
    run_gemm(lds, which ? GB_H16(g) : GB_H16B(g), D, W + (which ? W_FFN2U : W_FFN1U), 2 * FF, D, g, nb, cb, E, tid);
}
__device__ __forceinline__ void st_ffn_down(STAGE_ARGS, int which) {
    FRESH_TID unsigned char* ws = args.ws; const h16* W = (const h16*)(ws + WS_W); float* out = args.out;
    const bool first = (which == 0 && layer == 0);
    const float* rp = first ? args.in[I_XP] : (const float*)out; const float* rsm = first ? args.in[I_XS] - (size_t)MP * D : (const float*)out;
    pg8::EpiResid E{rp, rsm, out, GB_H16(g), (float*)(ws + WS_SSA), 0.5f};
    run_gemm(lds, GB_ACT(g), FF, W + (which ? W_FFN2D : W_FFN1D), D, FF, g, nb, cb, E, tid);
}
__device__ __forceinline__ void st_win(STAGE_ARGS) {
    FRESH_TID unsigned char* ws = args.ws; const h16* W = (const h16*)(ws + WS_W);
    pg8::EpiProj E{GB_MIX(g), GB_KNA(g), (size_t)512 * g_rows(g), GB_LOWS(g), (const float*)(ws + WS_SSA)};
    run_gemm(lds, GB_H16(g), D, W + W_IN, NPROJ, D, g, nb, cb, E, tid);
}
__device__ __forceinline__ void st_wout(STAGE_ARGS) {
    FRESH_TID unsigned char* ws = args.ws; const h16* W = (const h16*)(ws + WS_W); float* out = args.out;
    pg8::EpiResid E{out, out, out, GB_H16(g), (float*)(ws + WS_SSA), 1.0f};
    run_gemm(lds, GB_MIX(g), D, W + W_OUT, D, D, g, nb, cb, E, tid);
}
__device__ __forceinline__ void st_pu(STAGE_ARGS) {
    FRESH_TID unsigned char* ws = args.ws; const h16* W = (const h16*)(ws + WS_W);
    int kpu = PLE; asm volatile("" : "+s"(kpu));
    pg8::EpiPU E{GB_PU(g)};
    run_gemm(lds, GB_P16(g), kpu, W + W_UP, D, kpu, g, nb, cb, E, tid);
}
__device__ __forceinline__ void st_ple(STAGE_ARGS) {
    FRESH_TID unsigned char* ws = args.ws; const h16* W = (const h16*)(ws + WS_W); float* out = args.out;
    pg8::EpiPle E{out, GB_H16B(g), (float*)(ws + WS_SSB), (const float*)(ws + WS_SSA), GB_PU(g)};
    run_gemm(lds, GB_H16(g), D, W + W_GATE, D, D, g, nb, cb, E, tid);
}
__device__ __forceinline__ void st_rwpost(STAGE_ARGS) {
    FRESH_TID const int t0 = g ? MP / 64 : 0, nt = g_rows(g) / 64;
    h16x2 gup[64];
    { const float* gu = args.in[I_GUP] + (size_t)layer * 128 * 512 + tid;
#pragma unroll
      for (int i2 = 0; i2 < 64; ++i2) { const float g0 = gu[0], g1 = gu[512]; gu += 1024; asm volatile("" : "+v"(gu)); gup[i2] = (h16x2){(h16)g0, (h16)g1}; } }
    for (int tile = cb; tile < nt; tile += nb) rwpost_tile(args, layer, t0 + tile, lds, tid, lane, wave, gup);
}
__device__ __forceinline__ void st_convp(STAGE_ARGS) { FRESH_TID convert_p(args, layer, g, nb, cb, tid); }

__device__ __forceinline__ void sub_sync(unsigned* ctr, unsigned target) {
    asm volatile("s_waitcnt vmcnt(0) lgkmcnt(0)" ::: "memory");
    __syncthreads();
    if (threadIdx.x == 0) {
        __builtin_amdgcn_fence(__ATOMIC_RELEASE, "agent"); asm volatile("s_waitcnt vmcnt(0)" ::: "memory");
        __hip_atomic_fetch_add(ctr, 1u, __ATOMIC_RELAXED, __HIP_MEMORY_SCOPE_AGENT);
        while (__hip_atomic_load(ctr, __ATOMIC_RELAXED, __HIP_MEMORY_SCOPE_AGENT) < target) __builtin_amdgcn_s_sleep(2);
    }
    __syncthreads();
    __builtin_amdgcn_fence(__ATOMIC_ACQUIRE, "agent"); asm volatile("s_waitcnt vmcnt(0)" ::: "memory");
}

constexpr int NSB = 32;
__global__ void __launch_bounds__(NTHREADS, 2) fwd_megakernel(Args args) {
    extern __shared__ __attribute__((aligned(16))) unsigned char lds_raw[];
    LAS unsigned char* lds = (LAS unsigned char*)lds_raw;
    cg::grid_group grid = cg::this_grid();
    const int bid = blockIdx.x, G = gridDim.x;
    const int NPB = G - NSB, pb = bid - NSB;
    unsigned* ctr = (unsigned*)(args.ws + WS_CTR);
    if (bid == 0 && threadIdx.x == 0) __hip_atomic_store(ctr, 0u, __ATOMIC_RELAXED, __HIP_MEMORY_SCOPE_AGENT);
    unsigned sbt = 0;
#define SUBSYNC() do { sbt += (unsigned)NPB; sub_sync(ctr, sbt); } while (0)

    for (int layer = 0; layer < 2; ++layer) {
        { FRESH_TID phase_convert(args, layer, lds, tid, lane, wave, bid, G); }
        grid_sync(grid);
        st_ffn_up(args, layer, 1, G, bid, lds, 0); grid_sync(grid);
        st_ffn_down(args, layer, 1, G, bid, lds, 0); grid_sync(grid);
        st_win(args, layer, 1, G, bid, lds); grid_sync(grid);
        { FRESH_TID for (int it = 1024 + bid; it < 1536; it += G) na_item(args, layer, it, lds, tid, lane, wave); }
        grid_sync(grid);
        if (bid < NSB) {
            FRESH_TID scan_item<4>(args, layer, bid, 0, lds, tid, lane, wave);
        } else {
            st_ffn_up(args, layer, 0, NPB, pb, lds, 0); SUBSYNC();
            st_ffn_down(args, layer, 0, NPB, pb, lds, 0); SUBSYNC();
            st_win(args, layer, 0, NPB, pb, lds); SUBSYNC();
            { FRESH_TID
              scan_item<4>(args, layer, 32 + pb, 0, lds, tid, lane, wave); __syncthreads();
              if (pb < 2 * (256 - NPB)) { scan_item<2>(args, layer, 32 + NPB + (pb >> 1), pb & 1, lds, tid, lane, wave); __syncthreads(); }
              else { for (int it = pb - 2 * (256 - NPB); it < 1024; it += NPB - 2 * (256 - NPB)) na_item(args, layer, it, lds, tid, lane, wave); } }
            SUBSYNC();
            st_rwpost(args, layer, 0, NPB, pb, lds); SUBSYNC();
            st_wout(args, layer, 0, NPB, pb, lds); SUBSYNC();
            st_ffn_up(args, layer, 0, NPB, pb, lds, 1); SUBSYNC();
            st_ffn_down(args, layer, 0, NPB, pb, lds, 1); st_convp(args, layer, 0, NPB, pb, lds); SUBSYNC();
            st_pu(args, layer, 0, NPB, pb, lds); SUBSYNC();
            st_ple(args, layer, 0, NPB, pb, lds);
        }
        grid_sync(grid);
        st_rwpost(args, layer, 1, G, bid, lds); grid_sync(grid);
        st_wout(args, layer, 1, G, bid, lds); grid_sync(grid);
        st_ffn_up(args, layer, 1, G, bid, lds, 1); grid_sync(grid);
        st_ffn_down(args, layer, 1, G, bid, lds, 1); st_convp(args, layer, 1, G, bid, lds); grid_sync(grid);
        st_pu(args, layer, 1, G, bid, lds); grid_sync(grid);
        st_ple(args, layer, 1, G, bid, lds); grid_sync(grid);
    }
    {
        FRESH_TID
        const float* SSB = (const float*)(args.ws + WS_SSB); float* out = args.out;
        const int gw = bid * NWAVES + wave, NGW = G * NWAVES; const f32x4* gm = (const f32x4*)args.in[I_FINAL] + lane;
        f32x4 gv[4];
#pragma unroll
        for (int j = 0; j < 4; ++j) gv[j] = gm[64 * j];
        for (int m = gw; m < M; m += NGW) {
            const float rs = row_rstd(SSB, m); f32x4* o = (f32x4*)(out + (size_t)m * D) + lane;
#pragma unroll
            for (int j = 0; j < 4; ++j) { const f32x4 v = o[64 * j]; o[64 * j] = v * rs * gv[j]; }
        }
    }
}

extern "C" void kernel_launch(void* const* d_in, const int* in_sizes, int n_in, void* d_out, int out_size, void* d_ws, size_t ws_size, hipStream_t stream) {
    static int grid = 0;
    if (grid == 0) {
        if (n_in != N_IN || out_size != M * D || ws_size < WS_END) { fprintf(stderr, "kernel_launch: unexpected shapes (n_in %d, out %d, ws %zu)\n", n_in, out_size, ws_size); grid = -1; return; }
        int dev = 0, cus = 0, per_cu = 0;
        (void)hipGetDevice(&dev); (void)hipDeviceGetAttribute(&cus, hipDeviceAttributeMultiprocessorCount, dev);
        (void)hipFuncSetAttribute((const void*)fwd_megakernel, hipFuncAttributeMaxDynamicSharedMemorySize, LDS_BYTES);
        (void)hipOccupancyMaxActiveBlocksPerMultiprocessor(&per_cu, (const void*)fwd_megakernel, NTHREADS, LDS_BYTES);
        if (per_cu < 1) fprintf(stderr, "kernel_launch: occupancy query says %d blocks per CU\n", per_cu);
        grid = cus;
        if (grid != 256) fprintf(stderr, "kernel_launch: grid %d (expected 256)\n", grid);
        if (grid <= NSB + 64) { fprintf(stderr, "kernel_launch: grid too small\n"); grid = -1; return; }
    }
    if (grid < 0) return;
    Args a{};
    for (int i = 0; i < N_IN; ++i) a.in[i] = (const float*)d_in[i];
    a.out = (float*)d_out; a.ws = (unsigned char*)d_ws;
    void* kargs[] = {&a};
    hipError_t e = hipLaunchCooperativeKernel((const void*)fwd_megakernel, dim3(grid), dim3(NTHREADS), kargs, LDS_BYTES, stream);
    if (e != hipSuccess) fprintf(stderr, "kernel_launch: cooperative launch failed: %s\n", hipGetErrorString(e));
}
```

```cpp
#include <hip/hip_runtime.h>
#include <hip/hip_cooperative_groups.h>
#include <cstdio>
#include <cstdint>
namespace cg = cooperative_groups;
#ifndef PHM
#define PHM 0xFFFF
#endif
#define PH(k) ((PHM >> (k)) & 1)

#define LAS __attribute__((address_space(3)))
typedef _Float16 h16;
typedef _Float16 h16x2 __attribute__((ext_vector_type(2)));
typedef _Float16 h16x4 __attribute__((ext_vector_type(4)));
typedef _Float16 h16x8 __attribute__((ext_vector_type(8)));
typedef _Float16 h16x8a __attribute__((ext_vector_type(8), may_alias));
typedef float f32x2 __attribute__((ext_vector_type(2)));
typedef float f32x4 __attribute__((ext_vector_type(4)));
typedef unsigned u32x2 __attribute__((ext_vector_type(2)));
typedef unsigned u32x4 __attribute__((ext_vector_type(4)));
typedef unsigned u32x4a __attribute__((ext_vector_type(4), may_alias));

constexpr int D = 1024, FF = 2816, MP = 65536, MS = 32768, M = MP + MS, TP = 4096, TS = 16384, PLE = 256;
constexpr int NPROJ = 3584;
constexpr int NTHREADS = 512, NWAVES = 8;
constexpr int LDS_BYTES = 147456;
constexpr size_t MiB = 1u << 20;
constexpr size_t WS_CTR = 256;
constexpr size_t WS_W = 1 * MiB;
constexpr size_t WS_SSA = 46 * MiB;
constexpr size_t WS_SSB = 52 * MiB;
constexpr size_t REG_P = 58 * MiB, REG_S = 682 * MiB, WS_END = 994 * MiB;
constexpr size_t OFF_H16 = 0;
constexpr size_t OFF_MIX = 2048;
constexpr size_t OFF_KNA = 4096, OFF_VNA = 5120, OFF_RR = 6144, OFF_RK = 7168, OFF_RV = 8192;
constexpr size_t OFF_LOWS = 9216;
constexpr size_t OFF_ACT = 2048;
constexpr size_t OFF_P16 = 7680;
constexpr size_t OFF_PU = 2048;
constexpr size_t OFF_H16B = 7680;
constexpr size_t OFF_YB = 0, OFF_BSC = 1024;
constexpr size_t OFF_END = 9984;
static_assert(REG_P + OFF_END * MP <= REG_S && REG_S + OFF_END * MS <= WS_END, "group regions");
__device__ __forceinline__ unsigned char* gbuf(unsigned char* ws, int g, size_t off, size_t stride) {
    const size_t reg = g ? REG_S : REG_P, rows = g ? (size_t)MS : (size_t)MP, row0 = g ? (size_t)MP : 0;
    return ws + (reg + off * rows - row0 * stride);
}
#define GB_H16(g)  ((h16*)gbuf(ws, g, OFF_H16, 2048))
#define GB_H16B(g) ((h16*)gbuf(ws, g, OFF_H16B, 2048))
#define GB_MIX(g)  ((h16*)gbuf(ws, g, OFF_MIX, 2048))
#define GB_KNA(g)  ((h16*)gbuf(ws, g, OFF_KNA, 1024))
#define GB_VNA(g)  ((h16*)gbuf(ws, g, OFF_VNA, 1024))
#define GB_RR(g)   ((h16*)gbuf(ws, g, OFF_RR, 1024))
#define GB_RK(g)   ((h16*)gbuf(ws, g, OFF_RK, 1024))
#define GB_RV(g)   ((h16*)gbuf(ws, g, OFF_RV, 1024))
#define GB_LOWS(g) ((h16*)gbuf(ws, g, OFF_LOWS, 768))
#define GB_ACT(g)  ((h16*)gbuf(ws, g, OFF_ACT, 5632))
#define GB_P16(g)  ((h16*)gbuf(ws, g, OFF_P16, 512))
#define GB_PU(g)   ((h16*)gbuf(ws, g, OFF_PU, 2048))
#define GB_YB(g)   ((h16*)gbuf(ws, g, OFF_YB, 1024))
#define GB_BSC(g)  ((float*)gbuf(ws, g, OFF_BSC, 64))
constexpr size_t W_FFN1U = 0;
constexpr size_t W_FFN1D = W_FFN1U + (size_t)5632 * 1024;
constexpr size_t W_IN = W_FFN1D + (size_t)1024 * 2816;
constexpr size_t W_OUT = W_IN + (size_t)3584 * 1024;
constexpr size_t W_FFN2U = W_OUT + (size_t)1024 * 1024;
constexpr size_t W_FFN2D = W_FFN2U + (size_t)5632 * 1024;
constexpr size_t W_GATE = W_FFN2D + (size_t)1024 * 2816;
constexpr size_t W_UP = W_GATE + (size_t)1024 * 1024;
constexpr size_t W_ENDE = W_UP + (size_t)1024 * 256;
static_assert(WS_W + W_ENDE * 2 <= WS_SSA, "weights fit");

enum { I_XP = 0, I_XS, I_PP, I_PS, I_F1N, I_F1G, I_F1U, I_F1D, I_MIXN, I_WIN, I_RPB, I_MU, I_W0, I_WUP, I_A0, I_AUP, I_GUP, I_KK, I_KA, I_RK, I_LNW, I_LNB,
       I_WOUT, I_F2N, I_F2G, I_F2U, I_F2D, I_PLEN, I_PLEG, I_PLEU, I_FINAL, N_IN };
struct Args { const float* in[N_IN]; float* out; unsigned char* ws; };

__device__ __forceinline__ float wave_sum(float v) {
#pragma unroll
    for (int o = 1; o < 64; o <<= 1) v += __shfl_xor(v, o);
    return v;
}
__device__ __forceinline__ unsigned pk2h(float a, float b) { h16x2 p = {(h16)a, (h16)b}; return __builtin_bit_cast(unsigned, p); }
__device__ __forceinline__ h16x2 as_h2(unsigned u) { return __builtin_bit_cast(h16x2, u); }
__device__ __forceinline__ float dot2h(unsigned a, h16x2 b, float c) { return __builtin_amdgcn_fdot2(as_h2(a), b, c, false); }
__device__ __forceinline__ float dot8(u32x4 a, u32x4 b, float c) { const unsigned a0 = a[0], a1 = a[1], a2 = a[2], a3 = a[3], b0 = b[0], b1 = b[1], b2 = b[2], b3 = b[3];
    c = __builtin_amdgcn_fdot2(as_h2(a0), as_h2(b0), c, false); c = __builtin_amdgcn_fdot2(as_h2(a1), as_h2(b1), c, false); c = __builtin_amdgcn_fdot2(as_h2(a2), as_h2(b2), c, false); c = __builtin_amdgcn_fdot2(as_h2(a3), as_h2(b3), c, false); return c; }
__device__ __forceinline__ float dot8w(u32x4 a, h16x2 w0, h16x2 w1, h16x2 w2, h16x2 w3, float c) { const unsigned a0 = a[0], a1 = a[1], a2 = a[2], a3 = a[3];
    c = __builtin_amdgcn_fdot2(as_h2(a0), w0, c, false); c = __builtin_amdgcn_fdot2(as_h2(a1), w1, c, false); c = __builtin_amdgcn_fdot2(as_h2(a2), w2, c, false); c = __builtin_amdgcn_fdot2(as_h2(a3), w3, c, false); return c; }
__device__ __forceinline__ float fma_mix_lo(float p, unsigned v, float o) { asm("v_fma_mix_f32 %0, %1, %2, %0 op_sel_hi:[0,1,0]" : "+v"(o) : "v"(p), "v"(v)); return o; }
__device__ __forceinline__ float fma_mix_hi(float p, unsigned v, float o) { asm("v_fma_mix_f32 %0, %1, %2, %0 op_sel:[0,1,0] op_sel_hi:[0,1,0]" : "+v"(o) : "v"(p), "v"(v)); return o; }
__device__ __forceinline__ float sigmoidf_(float x) { return __builtin_amdgcn_rcpf(1.0f + __expf(-x)); }
__device__ __forceinline__ float row_rstd(const float* ss, int row) {
    const f32x4* p = (const f32x4*)(ss + (size_t)row * 16);
    const f32x4 a = p[0], b = p[1], c = p[2], d = p[3];
    const float s = ((a.x + a.y) + (a.z + a.w)) + ((b.x + b.y) + (b.z + b.w)) + ((c.x + c.y) + (c.z + c.w)) + ((d.x + d.y) + (d.z + d.w));
    return __builtin_amdgcn_rsqf(s * (1.0f / 1024.0f) + 1e-6f);
}
template <int CTRL> __device__ __forceinline__ float dpp_f(float v) { return __builtin_bit_cast(float, __builtin_amdgcn_update_dpp(0, __builtin_bit_cast(int, v), CTRL, 0xF, 0xF, true)); }
__device__ __forceinline__ float row16_sum(float v) {
    v += dpp_f<0xB1>(v);
    v += dpp_f<0x4E>(v);
    v += dpp_f<0x141>(v);
    v += dpp_f<0x140>(v);
    return v;
}
__device__ __forceinline__ void grid_sync(cg::grid_group& grid) {
    asm volatile("s_waitcnt vmcnt(0) lgkmcnt(0)" ::: "memory"); grid.sync();
    __builtin_amdgcn_fence(__ATOMIC_ACQUIRE, "agent"); asm volatile("s_waitcnt vmcnt(0)" ::: "memory"); }

namespace pg8 {
constexpr int BM = 256, BK = 64, HALF = 128, HTB = HALF * BK * 2, STAGE_BYTES = 8 * HTB, NXCD = 8, WGM = 8;
__host__ __device__ __forceinline__ int lds_byte(int r, int c) { const int st = (r >> 4) * 2 + (c >> 5), rr = r & 15, cc = c & 31, ob = rr * 64 + cc * 2; return st * 1024 + (ob ^ (((ob >> 9) & 1) << 5)); }
__host__ __device__ __forceinline__ void stage_rc(int b, int& R, int& C) { const int st = b / 1024, sb = b % 1024, swz = sb ^ (((sb >> 9) & 1) << 5); R = (st >> 1) * 16 + swz / 64; C = (st & 1) * 32 + (swz % 64) / 2; }
__host__ __device__ __forceinline__ int perm32(int rho) { const int n = rho >> 4, i = rho & 15; return 8 * (i >> 2) + 4 * n + (i & 3); }
struct Unit { int pm, pn; };
struct Gemm { const h16* A; const h16* Bt; int M, N, K, lda; };
struct StaticOrder {
    int nM, nN, nwg, G, c, pm0;
    __device__ void init(int M_, int N_, int G_, int c_, int pm0_) { nM = M_ / BM; nN = N_ / BM; nwg = nM * nN; G = G_; c = c_; pm0 = pm0_; }
    __device__ bool next(int i, Unit& u) const {
        const long L = (long)i * G + c; if (L >= nwg) return false;
        int wgid = (int)L; { const int q = nwg / NXCD, r = nwg % NXCD, xcd = wgid % NXCD, off = wgid / NXCD; wgid = (xcd < r ? xcd * (q + 1) : r * (q + 1) + (xcd - r) * q) + off; }
        const int nig = WGM * nN, gid = wgid / nig, fm = gid * WGM, gsz = (nM - fm) < WGM ? (nM - fm) : WGM;
        u.pm = pm0 + fm + ((wgid % nig) % gsz); u.pn = (wgid % nig) / gsz; return true;
    }
};
typedef f32x4 Acc[2][2][4][2];

template <class Epi>
__device__ __forceinline__ void gemm_phase(LAS unsigned char* lds, const Gemm g, const StaticOrder& S, const Epi& E, const int tid) {
    const int wid = __builtin_amdgcn_readfirstlane(tid >> 6), lane = tid & 63, wr = wid >> 2, wc = wid & 3, fr = lane & 15, fq = lane >> 4;
    const int K = g.K, nt = K / BK, lda = g.lda;
    unsigned voffA[2], voffB[2];
#pragma unroll
    for (int i = 0; i < 2; ++i) { int R, C; stage_rc(tid * 16 + i * 8192, R, C); const int Rb = Epi::PERM ? ((R & ~31) + perm32(R & 31)) : R;
        voffA[i] = (unsigned)(R * lda + C) * 2u; voffB[i] = (unsigned)(Rb * K + C) * 2u; }
    const size_t kstep = (size_t)(BK * 2);
    const size_t hstepA = (size_t)HALF * lda * 2, hstepB = (size_t)HALF * K * 2;
    const size_t tstepA = 2 * hstepA, tstepB = 2 * hstepB;
    const unsigned ldsw = (unsigned)wid * 1024u;
    const int aoff = lds_byte(wr * 64 + fr, fq * 8), boff = lds_byte(wc * 32 + fr, fq * 8);
#define PG8_SA(b, h) (((b) * 2 + (h)) * HTB)
#define PG8_SB(b, h) ((4 + (b) * 2 + (h)) * HTB)
#define PG8_STAGE(bufoff, gbase, voff) do { _Pragma("unroll") for (int _i = 0; _i < 2; ++_i) \
        __builtin_amdgcn_global_load_lds((const unsigned*)((const char*)(gbase) + (voff)[_i]), (LAS unsigned*)(lds + (bufoff) + ldsw + _i * 8192), 16, 0, 0); } while (0)
#define PG8_LDA(dst, b, h) do { _Pragma("unroll") for (int m = 0; m < 4; ++m) _Pragma("unroll") for (int k = 0; k < 2; ++k) dst[m][k] = *(const LAS h16x8*)(lds + PG8_SA(b, h) + aoff + m * 2048 + k * 1024); } while (0)
#define PG8_LDB(dst, b, h) do { _Pragma("unroll") for (int n = 0; n < 2; ++n) _Pragma("unroll") for (int k = 0; k < 2; ++k) dst[n][k] = *(const LAS h16x8*)(lds + PG8_SB(b, h) + boff + n * 2048 + k * 1024); } while (0)
#define PG8_MMA(ai, bj, At, Bt) do { __builtin_amdgcn_s_setprio(1); _Pragma("unroll") for (int m = 0; m < 4; ++m) _Pragma("unroll") for (int n = 0; n < 2; ++n) _Pragma("unroll") for (int k = 0; k < 2; ++k) \
        acc[ai][bj][m][n] = __builtin_amdgcn_mfma_f32_16x16x32_f16(Bt[n][k], At[m][k], acc[ai][bj][m][n], 0, 0, 0); __builtin_amdgcn_s_setprio(0); } while (0)
#define PG8_WAIT_V(n) asm volatile("s_waitcnt vmcnt(" #n ")" ::: "memory")
#define PG8_WAIT_L(n) asm volatile("s_waitcnt lgkmcnt(" #n ")" ::: "memory")
#define PG8_BAR __builtin_amdgcn_s_barrier()
#define PG8_SCHED __builtin_amdgcn_sched_barrier(0)
    Unit cur, nxt; int ui = 0;
    if (!S.next(0, cur)) return;
    f32x4 acc[2][2][4][2];
#pragma unroll
    for (int a = 0; a < 2; ++a)
#pragma unroll
        for (int b = 0; b < 2; ++b)
#pragma unroll
            for (int m = 0; m < 4; ++m)
#pragma unroll
                for (int n = 0; n < 2; ++n) acc[a][b][m][n] = (f32x4){0.f, 0.f, 0.f, 0.f};
    h16x8 At[4][2], B0[2][2], B1[2][2];
    const char* cA = (const char*)g.A + (size_t)cur.pm * tstepA; const char* cB = (const char*)g.Bt + (size_t)cur.pn * tstepB;
    PG8_STAGE(PG8_SB(0, 0), cB, voffB); PG8_STAGE(PG8_SB(0, 1), cB + hstepB, voffB); PG8_STAGE(PG8_SA(0, 0), cA, voffA); PG8_STAGE(PG8_SA(0, 1), cA + hstepA, voffA);
    if (wr == 1) PG8_BAR;
    PG8_WAIT_V(2); PG8_BAR;
    PG8_STAGE(PG8_SB(1, 0), cB + kstep, voffB); PG8_STAGE(PG8_SA(1, 0), cA + kstep, voffA); PG8_STAGE(PG8_SB(1, 1), cB + hstepB + kstep, voffB);
    PG8_WAIT_V(6); PG8_BAR;
    for (;;) {
        const bool has_next = S.next(ui + 1, nxt);
        const char* nA = has_next ? (const char*)g.A + (size_t)nxt.pm * tstepA : cA; const char* nB = has_next ? (const char*)g.Bt + (size_t)nxt.pn * tstepB : cB;
        for (int t = 0; t < nt; t += 2) {
            const bool last = (t == nt - 2);
            const char* a1 = cA + (size_t)(t + 1) * kstep;
            const char* a2 = last ? nA : cA + (size_t)(t + 2) * kstep; const char* b2 = last ? nB : cB + (size_t)(t + 2) * kstep;
            const char* a3 = a2 + kstep; const char* b3 = b2 + kstep;
            PG8_LDB(B0, 0, 0); PG8_LDB(B1, 0, 1); PG8_SCHED; PG8_LDA(At, 0, 0); PG8_STAGE(PG8_SA(1, 1), a1 + hstepA, voffA);
            PG8_WAIT_V(8); PG8_WAIT_L(0); PG8_BAR; PG8_MMA(0, 0, At, B0); PG8_MMA(0, 1, At, B1); PG8_BAR; PG8_SCHED;
            PG8_LDA(At, 0, 1); PG8_STAGE(PG8_SB(0, 0), b2, voffB); PG8_STAGE(PG8_SB(0, 1), b2 + hstepB, voffB); PG8_STAGE(PG8_SA(0, 0), a2, voffA);
            PG8_WAIT_V(8); PG8_WAIT_L(0); PG8_BAR; PG8_MMA(1, 0, At, B0); PG8_MMA(1, 1, At, B1); PG8_BAR; PG8_SCHED;
            PG8_LDB(B0, 1, 0); PG8_LDB(B1, 1, 1); PG8_SCHED; PG8_LDA(At, 1, 0); PG8_STAGE(PG8_SA(0, 1), a2 + hstepA, voffA);
            PG8_WAIT_V(8); PG8_WAIT_L(0); PG8_BAR; PG8_MMA(0, 0, At, B0); PG8_MMA(0, 1, At, B1); PG8_BAR; PG8_SCHED;
            PG8_LDA(At, 1, 1); PG8_STAGE(PG8_SB(1, 0), b3, voffB); PG8_STAGE(PG8_SB(1, 1), b3 + hstepB, voffB); PG8_STAGE(PG8_SA(1, 0), a3, voffA);
            PG8_WAIT_V(8); PG8_WAIT_L(0); PG8_BAR; PG8_MMA(1, 0, At, B0); PG8_MMA(1, 1, At, B1); PG8_BAR; PG8_SCHED;
        }
        if (wr == 0) PG8_BAR;
        E(acc, cur, wr, wc, fr, fq);
        if (!has_next) break;
#pragma unroll
        for (int a = 0; a < 2; ++a)
#pragma unroll
            for (int b = 0; b < 2; ++b)
#pragma unroll
                for (int m = 0; m < 4; ++m)
#pragma unroll
                    for (int n = 0; n < 2; ++n) acc[a][b][m][n] = (f32x4){0.f, 0.f, 0.f, 0.f};
        cur = nxt; cA = nA; cB = nB; ++ui;
        if (wr == 1) PG8_BAR;
    }
    PG8_WAIT_V(0);
    PG8_BAR;
#undef PG8_SA
#undef PG8_SB
#undef PG8_STAGE
#undef PG8_LDA
#undef PG8_LDB
#undef PG8_MMA
#undef PG8_WAIT_V
#undef PG8_WAIT_L
#undef PG8_BAR
#undef PG8_SCHED
}


struct EpiSwiglu {
    static constexpr bool PERM = true;
    h16* O; const float* ss;
    __device__ __forceinline__ void operator()(const Acc& acc, const Unit& u, int wr, int wc, int fr, int fq) const {
        const int row0 = u.pm * BM + wr * 64 + fr, col0 = u.pn * 128 + wc * 32 + 8 * fq;
#pragma unroll
        for (int ai = 0; ai < 2; ++ai)
#pragma unroll
            for (int m = 0; m < 4; ++m) {
                const int row = row0 + ai * HALF + m * 16; const float rs = row_rstd(ss, row);
                float o[8];
#pragma unroll
                for (int n = 0; n < 2; ++n)
#pragma unroll
                    for (int j = 0; j < 4; ++j) { const float gg = acc[ai][0][m][n][j] * rs, uu = acc[ai][1][m][n][j] * rs; o[n * 4 + j] = gg * sigmoidf_(gg) * uu; }
                u32x4 w; w.x = pk2h(o[0], o[1]); w.y = pk2h(o[2], o[3]); w.z = pk2h(o[4], o[5]); w.w = pk2h(o[6], o[7]);
                *(u32x4*)(O + (size_t)row * FF + col0) = w;
            }
    }
};
struct EpiResid {
    static constexpr bool PERM = false;
    const float* res_p; const float* res_s; float* out; h16* o16; float* ss; float alpha;
    __device__ __forceinline__ void operator()(const Acc& acc, const Unit& u, int wr, int wc, int fr, int fq) const {
        const int row0 = u.pm * BM + wr * 64 + fr, col0 = u.pn * BM + wc * 32 + 4 * fq;
        const float* res = (u.pm * BM < MP) ? res_p : res_s;
#pragma unroll
        for (int ai = 0; ai < 2; ++ai)
#pragma unroll
            for (int m = 0; m < 4; ++m) {
                const int row = row0 + ai * HALF + m * 16; const size_t off = (size_t)row * D + col0; float sq = 0.f;
#pragma unroll
                for (int bj = 0; bj < 2; ++bj)
#pragma unroll
                    for (int n = 0; n < 2; ++n) { const size_t o = off + bj * HALF + n * 16; const f32x4 r = *(const f32x4*)(res + o); const f32x4 v = r + acc[ai][bj][m][n] * alpha;
                        *(f32x4*)(out + o) = v; u32x2 w; w.x = pk2h(v.x, v.y); w.y = pk2h(v.z, v.w); *(u32x2*)(o16 + o) = w; sq += (v.x * v.x + v.y * v.y) + (v.z * v.z + v.w * v.w); }
                sq += __shfl_xor(sq, 16); sq += __shfl_xor(sq, 32);
                if (fq == 0) ss[(size_t)row * 16 + u.pn * 4 + wc] = sq;
                asm volatile("" ::: "memory");
            }
    }
};
struct EpiProj {
    static constexpr bool PERM = true;
    h16* mix; h16* kna; size_t bufstep; h16* lows; const float* ss;
    __device__ __forceinline__ void operator()(const Acc& acc, const Unit& u, int wr, int wc, int fr, int fq) const {
        const int pn = u.pn; h16* base; int ldc, c0; float sc = 1.f; int nbj = 2;
        if (pn < 2) { base = mix; ldc = 1024; c0 = pn * 256; sc = 0.125f; }
        else if (pn < 12) { base = kna + (size_t)((pn - 2) >> 1) * bufstep; ldc = 512; c0 = ((pn - 2) & 1) * 256; }
        else { base = lows; ldc = 384; c0 = (pn - 12) * 256; if (pn == 13) nbj = 1; }
        const int row0 = u.pm * BM + wr * 64 + fr, col0 = c0 + wc * 32 + 8 * fq;
#pragma unroll
        for (int ai = 0; ai < 2; ++ai)
#pragma unroll
            for (int m = 0; m < 4; ++m) {
                const int row = row0 + ai * HALF + m * 16; const float rs = row_rstd(ss, row) * sc;
#pragma unroll
                for (int bj = 0; bj < 2; ++bj) if (bj < nbj) {
                    const f32x4 v0 = acc[ai][bj][m][0] * rs, v1 = acc[ai][bj][m][1] * rs;
                    u32x4 w; w.x = pk2h(v0.x, v0.y); w.y = pk2h(v0.z, v0.w); w.z = pk2h(v1.x, v1.y); w.w = pk2h(v1.z, v1.w);
                    *(u32x4*)(base + (size_t)row * ldc + col0 + bj * HALF) = w; }
            }
    }
};
struct EpiPU {
    static constexpr bool PERM = true;
    h16* O;
    __device__ __forceinline__ void operator()(const Acc& acc, const Unit& u, int wr, int wc, int fr, int fq) const {
        const int row0 = u.pm * BM + wr * 64 + fr, col0 = u.pn * BM + wc * 32 + 8 * fq;
#pragma unroll
        for (int ai = 0; ai < 2; ++ai)
#pragma unroll
            for (int m = 0; m < 4; ++m) {
                const int row = row0 + ai * HALF + m * 16;
#pragma unroll
                for (int bj = 0; bj < 2; ++bj) {
                    const f32x4 v0 = acc[ai][bj][m][0], v1 = acc[ai][bj][m][1];
                    u32x4 w; w.x = pk2h(v0.x, v0.y); w.y = pk2h(v0.z, v0.w); w.z = pk2h(v1.x, v1.y); w.w = pk2h(v1.z, v1.w);
                    *(u32x4*)(O + (size_t)row * D + col0 + bj * HALF) = w; }
            }
    }
};
struct EpiPle {
    static constexpr bool PERM = false;
    float* out; h16* o16; float* ssw; const float* ssr; const h16* pu;
    __device__ __forceinline__ void operator()(const Acc& acc, const Unit& u, int wr, int wc, int fr, int fq) const {
        const int row0 = u.pm * BM + wr * 64 + fr, col0 = u.pn * BM + wc * 32 + 4 * fq;
#pragma unroll
        for (int ai = 0; ai < 2; ++ai)
#pragma unroll
            for (int m = 0; m < 4; ++m) {
                const int row = row0 + ai * HALF + m * 16; const size_t off = (size_t)row * D + col0; float sq = 0.f; const float rs = row_rstd(ssr, row);
#pragma unroll
                for (int bj = 0; bj < 2; ++bj)
#pragma unroll
                    for (int n = 0; n < 2; ++n) { const size_t o = off + bj * HALF + n * 16; const f32x4 r = *(const f32x4*)(out + o); const h16x4 p = *(const h16x4*)(pu + o);
                        const f32x4 a = acc[ai][bj][m][n] * rs; f32x4 v;
                        v.x = r.x + sigmoidf_(a.x) * (float)p.x; v.y = r.y + sigmoidf_(a.y) * (float)p.y; v.z = r.z + sigmoidf_(a.z) * (float)p.z; v.w = r.w + sigmoidf_(a.w) * (float)p.w;
                        *(f32x4*)(out + o) = v; u32x2 w; w.x = pk2h(v.x, v.y); w.y = pk2h(v.z, v.w); *(u32x2*)(o16 + o) = w; sq += (v.x * v.x + v.y * v.y) + (v.z * v.z + v.w * v.w); }
                sq += __shfl_xor(sq, 16); sq += __shfl_xor(sq, 32);
                if (fq == 0) ssw[(size_t)row * 16 + u.pn * 4 + wc] = sq;
                asm volatile("" ::: "memory");
            }
    }
};
}

__device__ __forceinline__ void convert_matrix(const float* W, int K, int N, const float* gamma, h16* WT, int mode, LAS float* scr, int gw, int NGW, int lane) {
    const int nblk = N / 32, nitems = (K / 64) * nblk;
    for (int item = gw; item < nitems; item += NGW) {
        const int kb = item / nblk, nb = item % nblk, k0 = 64 * kb, n0 = 32 * nb;
        const int drow0 = (mode == 0) ? n0 : ((n0 >> 7) * 256 + (n0 & 127) + (mode == 2 ? 128 : 0));
#pragma unroll 8
        for (int i = 0; i < 32; ++i) { const int kk = 2 * i + (lane >> 5); float v = W[(size_t)(k0 + kk) * N + n0 + (lane & 31)]; if (gamma) v *= gamma[k0 + kk]; scr[kk * 33 + (lane & 31)] = v; }
        asm volatile("s_waitcnt lgkmcnt(0)" ::: "memory");
        const int c = lane & 7;
#pragma unroll
        for (int j = 0; j < 4; ++j) { const int n = (lane >> 3) + 8 * j; const LAS float* s = scr + (8 * c) * 33 + n;
            u32x4 o; o.x = pk2h(s[0 * 33], s[1 * 33]); o.y = pk2h(s[2 * 33], s[3 * 33]); o.z = pk2h(s[4 * 33], s[5 * 33]); o.w = pk2h(s[6 * 33], s[7 * 33]);
            *(u32x4*)(WT + (size_t)(drow0 + n) * K + k0 + 8 * c) = o; }
        asm volatile("s_waitcnt lgkmcnt(0)" ::: "memory");
    }
}

__device__ __forceinline__ void phase_convert(const Args& a, int layer, LAS unsigned char* lds, int tid, int lane, int wave, int bid, int G) {
    LAS float* scr = (LAS float*)(lds + wave * 16384);
    const int gw = bid * NWAVES + wave, NGW = G * NWAVES;
    h16* W = (h16*)(a.ws + WS_W);
    const size_t l = (size_t)layer;
    convert_matrix(a.in[I_F1G] + l * D * FF, D, FF, a.in[I_F1N] + l * D, W + W_FFN1U, 1, scr, gw, NGW, lane);
    convert_matrix(a.in[I_F1U] + l * D * FF, D, FF, a.in[I_F1N] + l * D, W + W_FFN1U, 2, scr, gw, NGW, lane);
    convert_matrix(a.in[I_F1D] + l * FF * D, FF, D, nullptr, W + W_FFN1D, 0, scr, gw, NGW, lane);
    convert_matrix(a.in[I_WIN] + l * D * 3456, D, 3456, a.in[I_MIXN] + l * D, W + W_IN, 0, scr, gw, NGW, lane);
    convert_matrix(a.in[I_WOUT] + l * D * D, D, D, nullptr, W + W_OUT, 0, scr, gw, NGW, lane);
    convert_matrix(a.in[I_F2G] + l * D * FF, D, FF, a.in[I_F2N] + l * D, W + W_FFN2U, 1, scr, gw, NGW, lane);
    convert_matrix(a.in[I_F2U] + l * D * FF, D, FF, a.in[I_F2N] + l * D, W + W_FFN2U, 2, scr, gw, NGW, lane);
    convert_matrix(a.in[I_F2D] + l * FF * D, FF, D, nullptr, W + W_FFN2D, 0, scr, gw, NGW, lane);
    convert_matrix(a.in[I_PLEG] + l * D * D, D, D, a.in[I_PLEN] + l * D, W + W_GATE, 0, scr, gw, NGW, lane);
    convert_matrix(a.in[I_PLEU] + l * PLE * D, PLE, D, nullptr, W + W_UP, 0, scr, gw, NGW, lane);
    { u32x4* z = (u32x4*)(W + W_IN + (size_t)3456 * 1024); const int n16 = 128 * 1024 * 2 / 16;
      for (int i = bid * NTHREADS + tid; i < n16; i += G * NTHREADS) z[i] = (u32x4){0u, 0u, 0u, 0u}; }
    if (layer == 0) {
        unsigned char* ws = a.ws; h16* Hp = GB_H16B(0); h16* Hs = GB_H16B(1); float* ss = (float*)(a.ws + WS_SSB);
        for (int m = gw; m < M; m += NGW) {
            h16* H = (m < MP) ? Hp : Hs;
            const float* xr = (m < MP) ? a.in[I_XP] + (size_t)m * D : a.in[I_XS] + (size_t)(m - MP) * D;
            const f32x4* x4 = (const f32x4*)xr + lane; float s = 0.f;
            u32x2* o = (u32x2*)(H + (size_t)m * D) + lane;
#pragma unroll
            for (int j = 0; j < 4; ++j) { const f32x4 v = x4[64 * j]; s += (v.x * v.x + v.y * v.y) + (v.z * v.z + v.w * v.w); u32x2 w; w.x = pk2h(v.x, v.y); w.y = pk2h(v.z, v.w); o[64 * j] = w; }
            s = wave_sum(s);
            if (lane < 16) ss[(size_t)m * 16 + lane] = (lane == 0) ? s : 0.f;
        }
    }
}

__device__ __forceinline__ void convert_p(const Args& a, int layer, int g, int nb, int cb, int tid) {
    unsigned char* ws = a.ws; const int rows = g ? MS : MP, row0 = g ? MP : 0;
    u32x2* o = (u32x2*)(GB_P16(g) + (size_t)row0 * PLE);
    const f32x4* p = (const f32x4*)((g ? a.in[I_PS] + (size_t)layer * MS * PLE : a.in[I_PP] + (size_t)layer * MP * PLE));
    const int N4 = rows * PLE / 4;
    for (int i = cb * NTHREADS + tid; i < N4; i += nb * NTHREADS) { const f32x4 v = p[i]; u32x2 w; w.x = pk2h(v.x, v.y); w.y = pk2h(v.z, v.w); o[i] = w; }
}

constexpr int NA_PITCH = 144;
constexpr int NA_VOFF = 512 * NA_PITCH;
constexpr int NA_PP = 67;
__device__ __forceinline__ void na_item(const Args& a, int layer, int item, LAS unsigned char* lds, int tid, int lane, int wave) {
    int tok0, i, rows;
    if (item < 1024) { tok0 = (item >> 6) * TP; i = item & 63; rows = 64; } else { const int it2 = item - 1024; tok0 = MP + (it2 >> 8) * TS; i = it2 & 255; rows = 256; }
    int rs = i - 4; rs = rs < 0 ? 0 : (rs > rows - 8 ? rows - 8 : rs);
    unsigned char* ws = a.ws; const int g = item < 1024 ? 0 : 1;
    h16* MIX = GB_MIX(g); const h16* KNA = GB_KNA(g); const h16* VNA = GB_VNA(g);
    const float* rpb = a.in[I_RPB] + (size_t)layer * 8 * 15 * 31;
    const int wtok0 = tok0 + rs * 64;
    const int j = lane, aw = wave;
    const int tokq = tok0 + i * 64 + j;
    int cs = j - 8; cs = cs < 0 ? 0 : (cs > 48 ? 48 : cs);
#pragma unroll 1
    for (int h = 0; h < 8; ++h) {
#pragma unroll
        for (int it = 0; it < 8; ++it) { const int key = (tid >> 3) + 64 * it, ch = tid & 7;
            const u32x4 kv = *(const u32x4*)(KNA + (size_t)(wtok0 + key) * 512 + h * 64 + ch * 8);
            const u32x4 vv = *(const u32x4*)(VNA + (size_t)(wtok0 + key) * 512 + h * 64 + ch * 8);
            *(LAS u32x4*)(lds + key * NA_PITCH + ch * 16) = kv; *(LAS u32x4*)(lds + NA_VOFF + key * NA_PITCH + ch * 16) = vv; }
        u32x4 qv[8];
#pragma unroll
        for (int c = 0; c < 8; ++c) qv[c] = *(const u32x4*)(MIX + (size_t)tokq * 1024 + h * 64 + c * 8);
        __syncthreads();
        float sc[16];
        const float* bias = rpb + ((size_t)h * 15 + (rs + aw - i + 7)) * 31 + (cs - j + 15);
#pragma unroll
        for (int c = 0; c < 16; ++c) {
            const LAS unsigned char* kp = lds + (aw * 64 + cs + c) * NA_PITCH; float s = 0.f;
#pragma unroll
            for (int c8 = 0; c8 < 8; ++c8) { const u32x4 kk = *(const LAS u32x4*)(kp + c8 * 16); s = dot8(qv[c8], kk, s); }
            sc[c] = s + bias[c];
            asm volatile("" ::: "memory");
        }
        float mx = sc[0];
#pragma unroll
        for (int c = 1; c < 16; ++c) mx = fmaxf(mx, sc[c]);
        float l = 0.f;
#pragma unroll
        for (int c = 0; c < 16; ++c) { sc[c] = __expf(sc[c] - mx); l += sc[c]; }
        float o[64];
#pragma unroll
        for (int d = 0; d < 64; ++d) o[d] = 0.f;
#pragma unroll
        for (int c = 0; c < 16; ++c) {
            const LAS unsigned char* vp = lds + NA_VOFF + (aw * 64 + cs + c) * NA_PITCH; const float p = sc[c];
#pragma unroll
            for (int c8 = 0; c8 < 8; ++c8) { const u32x4 vv = *(const LAS u32x4*)(vp + c8 * 16);
#pragma unroll
                for (int e = 0; e < 4; ++e) { const unsigned ve = vv[e]; o[c8 * 8 + 2 * e] = fma_mix_lo(p, ve, o[c8 * 8 + 2 * e]); o[c8 * 8 + 2 * e + 1] = fma_mix_hi(p, ve, o[c8 * 8 + 2 * e + 1]); } }
            asm volatile("" ::: "memory");
        }
        __syncthreads();
        LAS float* part = (LAS float*)lds + (size_t)(aw * 64 + j) * NA_PP;
#pragma unroll
        for (int d = 0; d < 64; ++d) part[d] = o[d];
        part[64] = mx; part[65] = l;
        __syncthreads();
        {
            const int jq = tid & 63, e8 = tid >> 6;
            float mw[8], M_ = -3.0e38f;
#pragma unroll
            for (int w = 0; w < 8; ++w) { mw[w] = ((const LAS float*)lds)[(size_t)(w * 64 + jq) * NA_PP + 64]; M_ = fmaxf(M_, mw[w]); }
            float L = 0.f, ov[8];
#pragma unroll
            for (int e = 0; e < 8; ++e) ov[e] = 0.f;
#pragma unroll
            for (int w = 0; w < 8; ++w) { const float f = __expf(mw[w] - M_); const LAS float* pw = (const LAS float*)lds + (size_t)(w * 64 + jq) * NA_PP; L += f * pw[65];
#pragma unroll
                for (int e = 0; e < 8; ++e) ov[e] += f * pw[e8 * 8 + e]; }
            const float inv = 1.0f / L;
            u32x4 w4; w4.x = pk2h(ov[0] * inv, ov[1] * inv); w4.y = pk2h(ov[2] * inv, ov[3] * inv); w4.z = pk2h(ov[4] * inv, ov[5] * inv); w4.w = pk2h(ov[6] * inv, ov[7] * inv);
            *(u32x4*)(MIX + (size_t)(tok0 + i * 64 + jq) * 1024 + h * 64 + e8 * 8) = w4;
        }
        __syncthreads();
    }
}

__device__ __forceinline__ float shiftmix(const h16* base, size_t stride, int t, int T, float mu) {
    const float c = (float)base[0];
    const float p = (t > 0) ? (float)*(base - stride) : 0.f;
    const float n = (t < T - 1) ? (float)*(base + stride) : 0.f;
    return c + mu * (0.5f * (p + n) - c);
}
constexpr int SC_CH = 32;
constexpr int SC_OPB = SC_CH * 6 * 64 * 4;
constexpr int SC_YOFF = 2 * SC_OPB;
constexpr int SC_YB = SC_CH * 64 * 4;
constexpr int SC_XOFF = SC_YOFF + 2 * SC_YB;
constexpr int SC_ZOFF = SC_XOFF + 8192;
static_assert(SC_ZOFF + 4 * 4096 <= LDS_BYTES, "scan LDS");
__device__ __forceinline__ float wave_sum_fast(float v) {
    v = row16_sum(v);
    { const auto r = __builtin_amdgcn_permlane16_swap(__builtin_bit_cast(unsigned, v), __builtin_bit_cast(unsigned, v), false, false);
      const unsigned r0 = r[0], r1 = r[1]; v = __builtin_bit_cast(float, r0) + __builtin_bit_cast(float, r1); }
    { const auto r = __builtin_amdgcn_permlane32_swap(__builtin_bit_cast(unsigned, v), __builtin_bit_cast(unsigned, v), false, false);
      const unsigned r0 = r[0], r1 = r[1]; v = __builtin_bit_cast(float, r0) + __builtin_bit_cast(float, r1); }
    return v;
}
__device__ __forceinline__ float mix3(h16 p, h16 c, h16 n, float mu) { const float cf = (float)c; return cf + mu * (0.5f * ((float)p + (float)n) - cf); }
struct ScanWin { h16 r[10], k[10], v[10], wl[10], al[10]; };
template <int R>
__device__ __forceinline__ void scan_flush(LAS unsigned char* lds, int cf, int pw, int lane, int d, int T, int tok0, int h, int rowbase, h16* Yf, h16* Yb) {
    const LAS float* yb = (const LAS float*)(lds + SC_YOFF + (cf & 1) * SC_YB);
    const int s = pw * 8 + (lane >> 3); const int g = cf * SC_CH + s; const int t = d ? (T - 1 - g) : g;
    if (R == 4) {
        const int r8 = (lane & 7) * 8;
        const f32x4 y0 = *(const LAS f32x4*)(yb + s * 64 + r8), y1 = *(const LAS f32x4*)(yb + s * 64 + r8 + 4);
        u32x4 w4; w4.x = pk2h(y0.x, y0.y); w4.y = pk2h(y0.z, y0.w); w4.z = pk2h(y1.x, y1.y); w4.w = pk2h(y1.z, y1.w);
        if (d == 0) *(u32x4*)(Yf + (size_t)(tok0 + t) * 1024 + 512 + h * 64 + r8) = w4; else *(u32x4*)(Yb + (size_t)(tok0 + t) * 512 + h * 64 + r8) = w4;
    } else {
        const int r4 = (lane & 7) * 4;
        const f32x4 y0 = *(const LAS f32x4*)(yb + s * 32 + r4);
        u32x2 w2; w2.x = pk2h(y0.x, y0.y); w2.y = pk2h(y0.z, y0.w);
        if (d == 0) *(u32x2*)(Yf + (size_t)(tok0 + t) * 1024 + 512 + h * 64 + rowbase + r4) = w2; else *(u32x2*)(Yb + (size_t)(tok0 + t) * 512 + h * 64 + rowbase + r4) = w2;
    }
}
template <int R>
__device__ __forceinline__ void scan_item(const Args& a, int layer, int q, int rowhalf, LAS unsigned char* lds, int tid, int lane, int wave) {
    int tok0, T, h, d;
    if (q < 32) { tok0 = MP + (q >> 4) * TS; T = TS; h = (q >> 1) & 7; d = q & 1; } else { const int q2 = q - 32; tok0 = (q2 >> 4) * TP; T = TP; h = (q2 >> 1) & 7; d = q2 & 1; }
    const int nch = T / SC_CH, rowbase = rowhalf * 16 * R;
    unsigned char* ws = a.ws; const int g = q < 32 ? 1 : 0;
    const h16* RR = GB_RR(g); const h16* RK = GB_RK(g); const h16* RV = GB_RV(g); const h16* LOWS = GB_LOWS(g);
    h16* Yf = GB_MIX(g); h16* Yb = GB_YB(g); float* BSC = GB_BSC(g);
    const size_t l = (size_t)layer;
    if (wave >= 4) {
        const int pw = wave - 4, j = lane, col = h * 64 + j;
        const float* mu = a.in[I_MU] + l * 1920;
        const float mu_r = mu[col], mu_k = mu[512 + col], mu_v = mu[1024 + col], mu_wl = mu[1536 + d * 64 + j], mu_al = mu[1536 + 128 + d * 64 + j];
        const float k_k = a.in[I_KK][l * 512 + col], k_a = a.in[I_KA][l * 512 + col], r_k = a.in[I_RK][l * 512 + col];
        const float w0 = a.in[I_W0][(l * 2 + d) * 512 + col], a0 = a.in[I_A0][(l * 2 + d) * 512 + col];
        h16x8 bw[4][2], ba[4][2];
        { const int n = lane & 15, kg = lane >> 4;
          const float* wu = a.in[I_WUP] + ((l * 2 + d) * 64 + 8 * kg) * 512 + h * 64 + n; const float* au = a.in[I_AUP] + ((l * 2 + d) * 64 + 8 * kg) * 512 + h * 64 + n;
#pragma unroll
          for (int ks = 0; ks < 2; ++ks) {
#pragma unroll
              for (int e = 0; e < 8; ++e) {
                  const float w_0 = wu[0], w_1 = wu[16], w_2 = wu[32], w_3 = wu[48], a_0 = au[0], a_1 = au[16], a_2 = au[32], a_3 = au[48];
                  wu += 512; au += 512; asm volatile("" : "+v"(wu), "+v"(au));
                  bw[0][ks][e] = (h16)w_0; bw[1][ks][e] = (h16)w_1; bw[2][ks][e] = (h16)w_2; bw[3][ks][e] = (h16)w_3;
                  ba[0][ks][e] = (h16)a_0; ba[1][ks][e] = (h16)a_1; ba[2][ks][e] = (h16)a_2; ba[3][ks][e] = (h16)a_3; }
              wu += 24 * 512; au += 24 * 512; asm volatile("" : "+v"(wu), "+v"(au)); } }
        LAS float* zl = (LAS float*)(lds + SC_ZOFF + pw * 4096);
        LAS unsigned char* xsb = lds + SC_XOFF + pw * 2048;
        ScanWin cur, nxt;
#define SCAN_LOAD_WIN(W_, cp_) do { const int g0_ = (cp_) * SC_CH + pw * 8; \
            _Pragma("unroll") for (int w = 0; w < 10; ++w) { const int tt = d ? (T - 1 - g0_) + 1 - w : g0_ - 1 + w; const bool ok = (tt >= 0) && (tt < T); const size_t tok = (size_t)(tok0 + (ok ? tt : 0)); \
                const h16 z_ = (h16)0.f; const h16 r_ = RR[tok * 512 + col], k_ = RK[tok * 512 + col], v_ = RV[tok * 512 + col], wl_ = LOWS[tok * 384 + d * 64 + j], al_ = LOWS[tok * 384 + 128 + d * 64 + j]; \
                W_.r[w] = ok ? r_ : z_; W_.k[w] = ok ? k_ : z_; W_.v[w] = ok ? v_ : z_; W_.wl[w] = ok ? wl_ : z_; W_.al[w] = ok ? al_ : z_; } } while (0)
        SCAN_LOAD_WIN(cur, 0);
        for (int c = -1; c < nch; ++c) {
            if (c >= 1) scan_flush<R>(lds, c - 1, pw, lane, d, T, tok0, h, rowbase, Yf, Yb);
            if (c + 1 < nch) {
                const int cp = c + 1; LAS float* op = (LAS float*)(lds + (cp & 1) * SC_OPB);
                if (c + 2 < nch) SCAN_LOAD_WIN(nxt, c + 2);
#pragma unroll
                for (int s8 = 0; s8 < 8; ++s8) {
                    const float wl = mix3(cur.wl[s8], cur.wl[s8 + 1], cur.wl[s8 + 2], mu_wl);
                    const float al = mix3(cur.al[s8], cur.al[s8 + 1], cur.al[s8 + 2], mu_al);
                    const float e2 = __expf(2.0f * wl); const float th = 1.0f - 2.0f * __builtin_amdgcn_rcpf(e2 + 1.0f);
                    LAS h16* xs = (LAS h16*)(xsb + s8 * 256);
                    xs[j] = (h16)th; xs[64 + j] = (h16)al;
                }
                {
                    const LAS unsigned char* xr = xsb + (lane & 7) * 256 + (lane >> 4) * 16;
                    const h16x8 xw0 = *(const LAS h16x8a*)(xr), xw1 = *(const LAS h16x8a*)(xr + 64), xa0 = *(const LAS h16x8a*)(xr + 128), xa1 = *(const LAS h16x8a*)(xr + 192);
                    f32x4 accw[4], acca[4];
#pragma unroll
                    for (int nt = 0; nt < 4; ++nt) {
                        accw[nt] = __builtin_amdgcn_mfma_f32_16x16x32_f16(xw0, bw[nt][0], (f32x4){0.f, 0.f, 0.f, 0.f}, 0, 0, 0);
                        accw[nt] = __builtin_amdgcn_mfma_f32_16x16x32_f16(xw1, bw[nt][1], accw[nt], 0, 0, 0);
                        acca[nt] = __builtin_amdgcn_mfma_f32_16x16x32_f16(xa0, ba[nt][0], (f32x4){0.f, 0.f, 0.f, 0.f}, 0, 0, 0);
                        acca[nt] = __builtin_amdgcn_mfma_f32_16x16x32_f16(xa1, ba[nt][1], acca[nt], 0, 0, 0); }
                    if (lane < 32) {
                        LAS float* zw = zl + (4 * (lane >> 4)) * 64 + (lane & 15);
#pragma unroll
                        for (int nt = 0; nt < 4; ++nt)
#pragma unroll
                            for (int r = 0; r < 4; ++r) { zw[r * 64 + 16 * nt] = accw[nt][r]; zw[512 + r * 64 + 16 * nt] = acca[nt][r]; }
                    }
                }
#pragma unroll
                for (int s8 = 0; s8 < 8; ++s8) {
                    const int s = pw * 8 + s8; const int g = cp * SC_CH + s; const int t = d ? (T - 1 - g) : g; const size_t tok = (size_t)(tok0 + t);
                    const float rr = mix3(cur.r[s8], cur.r[s8 + 1], cur.r[s8 + 2], mu_r);
                    const float kk0 = mix3(cur.k[s8], cur.k[s8 + 1], cur.k[s8 + 2], mu_k);
                    const float vv = mix3(cur.v[s8], cur.v[s8 + 1], cur.v[s8 + 2], mu_v);
                    const float z = w0 + zl[s8 * 64 + j], az = a0 + zl[512 + s8 * 64 + j];
                    const float wdec = __expf(-0.606531f * sigmoidf_(z)); const float av = sigmoidf_(az);
                    float kk = kk0 * k_k; const float n2 = wave_sum_fast(kk * kk); kk = kk * __builtin_amdgcn_rcpf(fmaxf(__builtin_amdgcn_sqrtf(n2), 1e-12f));
                    const float kd = kk0 * (1.0f + (av - 1.0f) * k_a); const float bb = kk * av;
                    const float bs = wave_sum_fast(rr * kd * r_k);
                    if (lane == 0 && rowhalf == 0) BSC[(tok * 8 + h) * 2 + d] = bs;
                    LAS float* o = op + s * 384 + j;
                    o[0] = -kk; o[64] = wdec; o[128] = bb; o[192] = kd; o[256] = rr; o[320] = vv;
                }
                cur = nxt;
            }
            __syncthreads();
        }
        scan_flush<R>(lds, nch - 1, pw, lane, d, T, tok0, h, rowbase, Yf, Yb);
#undef SCAN_LOAD_WIN
    } else {
        constexpr int RL = R / 2;
        const int ri = lane >> 3, ci = lane & 7;
        const int yrow = wave * 8 * RL + ri * RL, vrow = rowbase + yrow;
        f32x2 S[RL][4];
#pragma unroll
        for (int i = 0; i < RL; ++i)
#pragma unroll
            for (int c2 = 0; c2 < 4; ++c2) S[i][c2] = (f32x2){0.f, 0.f};
        typedef float vecR __attribute__((ext_vector_type(RL)));
        __syncthreads();
        for (int c = 0; c < nch; ++c) {
            const LAS f32x4* op = (const LAS f32x4*)(lds + (c & 1) * SC_OPB);
            LAS float* yb = (LAS float*)(lds + SC_YOFF + (c & 1) * SC_YB);
            f32x4 a0 = op[2 * ci], a1 = op[2 * ci + 1], w0 = op[16 + 2 * ci], w1 = op[17 + 2 * ci], b0 = op[32 + 2 * ci], b1 = op[33 + 2 * ci];
            f32x4 k0 = op[48 + 2 * ci], k1 = op[49 + 2 * ci], r0 = op[64 + 2 * ci], r1 = op[65 + 2 * ci]; vecR v4 = *(const LAS vecR*)((const LAS float*)op + 320 + vrow);
#pragma unroll 2
            for (int s = 0; s < SC_CH; ++s) {
                const int sn = (s + 1 < SC_CH) ? s + 1 : s; const LAS f32x4* on = op + sn * 96;
                const f32x4 na0 = on[2 * ci], na1 = on[2 * ci + 1], nw0 = on[16 + 2 * ci], nw1 = on[17 + 2 * ci], nb0 = on[32 + 2 * ci], nb1 = on[33 + 2 * ci];
                const f32x4 nk0 = on[48 + 2 * ci], nk1 = on[49 + 2 * ci], nr0 = on[64 + 2 * ci], nr1 = on[65 + 2 * ci]; const vecR nv4 = *(const LAS vecR*)((const LAS float*)on + 320 + vrow);
                const f32x2 av[4] = {{a0.x, a0.y}, {a0.z, a0.w}, {a1.x, a1.y}, {a1.z, a1.w}}, wv[4] = {{w0.x, w0.y}, {w0.z, w0.w}, {w1.x, w1.y}, {w1.z, w1.w}};
                const f32x2 bv[4] = {{b0.x, b0.y}, {b0.z, b0.w}, {b1.x, b1.y}, {b1.z, b1.w}}, kv[4] = {{k0.x, k0.y}, {k0.z, k0.w}, {k1.x, k1.y}, {k1.z, k1.w}};
                const f32x2 rv[4] = {{r0.x, r0.y}, {r0.z, r0.w}, {r1.x, r1.y}, {r1.z, r1.w}};
                float sa[RL];
#pragma unroll
                for (int i = 0; i < RL; ++i) { f32x2 p = S[i][0] * av[0]; p = S[i][1] * av[1] + p; p = S[i][2] * av[2] + p; p = S[i][3] * av[3] + p;
                    float t = p.x + p.y; t += dpp_f<0xB1>(t); t += dpp_f<0x4E>(t); t += dpp_f<0x141>(t); sa[i] = t; }
                vecR y;
#pragma unroll
                for (int i = 0; i < RL; ++i) { const f32x2 sa2 = {sa[i], sa[i]}, v2 = {v4[i], v4[i]};
#pragma unroll
                    for (int c2 = 0; c2 < 4; ++c2) S[i][c2] = S[i][c2] * wv[c2] + sa2 * bv[c2] + v2 * kv[c2];
                    f32x2 p = S[i][0] * rv[0]; p = S[i][1] * rv[1] + p; p = S[i][2] * rv[2] + p; p = S[i][3] * rv[3] + p;
                    float t = p.x + p.y; t += dpp_f<0xB1>(t); t += dpp_f<0x4E>(t); t += dpp_f<0x141>(t); y[i] = t; }
                if (ci == 0) *(LAS vecR*)(yb + s * (32 * RL) + yrow) = y;
                a0 = na0; a1 = na1; w0 = nw0; w1 = nw1; b0 = nb0; b1 = nb1; k0 = nk0; k1 = nk1; r0 = nr0; r1 = nr1; v4 = nv4;
            }
            __syncthreads();
        }
    }
}

__device__ __forceinline__ void rwpost_tile(const Args& a, int layer, int tile, LAS unsigned char* lds, int tid, int lane, int wave, const h16x2 (&gup)[64]) {
    const size_t l = (size_t)layer; const int col = tid, h = wave;
    const int m0 = tile * 64; int tok0s, T; if (m0 < MP) { T = TP; tok0s = (m0 / TP) * TP; } else { T = TS; tok0s = MP + ((m0 - MP) / TS) * TS; }
    unsigned char* ws = a.ws; const int g = m0 < MP ? 0 : 1;
    const h16* LOWS = GB_LOWS(g); const h16* RV = GB_RV(g); h16* MIX = GB_MIX(g); const h16* Yb = GB_YB(g); const float* BSC = GB_BSC(g);
    const float* mu = a.in[I_MU] + l * 1920;
    LAS h16* G = (LAS h16*)lds;
    { const int c = tid & 127; const float mug = mu[1536 + 256 + c];
#pragma unroll 4
      for (int e = tid; e < 64 * 128; e += NTHREADS) { const int tk = e >> 7; const int m = m0 + tk; const int t = m - tok0s;
        const float gl = shiftmix(LOWS + (size_t)m * 384 + 256 + c, 384, t, T, mug); G[e] = (h16)sigmoidf_(gl); } }
    const float mu_v = mu[1024 + col], lw = a.in[I_LNW][l * 512 + col], lb = a.in[I_LNB][l * 512 + col];
    __syncthreads();
#pragma unroll 1
    for (int tk0 = 0; tk0 < 64; tk0 += 8) {
        h16 ym[8], yb[8], rv[10]; float b0[8], b1[8];
#pragma unroll
        for (int w = 0; w < 10; ++w) { const int m = m0 + tk0 - 1 + w; const int t = m - tok0s; const bool ok = (t >= 0) && (t < T); const h16 v = RV[(size_t)(ok ? m : m0) * 512 + col]; rv[w] = ok ? v : (h16)0.f; }
#pragma unroll
        for (int jj = 0; jj < 8; ++jj) { const size_t m = (size_t)(m0 + tk0 + jj); ym[jj] = MIX[m * 1024 + 512 + col]; yb[jj] = Yb[m * 512 + col]; b0[jj] = BSC[(m * 8 + h) * 2]; b1[jj] = BSC[(m * 8 + h) * 2 + 1]; }
#pragma unroll
        for (int jj = 0; jj < 8; ++jj) {
            const int tk = tk0 + jj; const size_t m = (size_t)(m0 + tk);
            float gg = 0.f;
#pragma unroll
            for (int c8 = 0; c8 < 16; ++c8) { const u32x4 x = *(const LAS u32x4a*)((const LAS unsigned char*)G + tk * 256 + c8 * 16);
                gg = dot8w(x, gup[c8 * 4 + 0], gup[c8 * 4 + 1], gup[c8 * 4 + 2], gup[c8 * 4 + 3], gg); }
            const float wkv = (float)ym[jj] + (float)yb[jj];
            const float mean = wave_sum_fast(wkv) * (1.0f / 64.0f); const float dv = wkv - mean; const float var = wave_sum_fast(dv * dv) * (1.0f / 64.0f);
            const float yn = dv * __builtin_amdgcn_rsqf(var + 64e-5f) * lw + lb;
            const float vv = mix3(rv[jj], rv[jj + 1], rv[jj + 2], mu_v);
            MIX[m * 1024 + 512 + col] = (h16)((yn + (b0[jj] + b1[jj]) * vv) * gg);
        }
    }
    __syncthreads();
}

#define STAGE_ARGS const Args& args, int layer, int g, int nb, int cb, LAS unsigned char* lds
#define FRESH_TID int tid = threadIdx.x; asm volatile("" : "+v"(tid)); const int lane = tid & 63, wave = __builtin_amdgcn_readfirstlane(tid >> 6); (void)lane; (void)wave;
__device__ __forceinline__ int g_rows(int g) { return g ? MS : MP; }
__device__ __forceinline__ int g_pm0(int g) { return g ? MP / 256 : 0; }
template <class Epi> __device__ __forceinline__ void run_gemm(LAS unsigned char* lds, const h16* A, int lda, const h16* Bt, int N, int K, int g, int nb, int cb, const Epi& E, int tid) {
    pg8::Gemm gm{A, Bt, g_rows(g), N, K, lda}; pg8::StaticOrder S; S.init(g_rows(g), N, nb, cb, g_pm0(g)); pg8::gemm_phase(lds, gm, S, E, tid);
}
__device__ __forceinline__ void st_ffn_up(STAGE_ARGS, int which) {
    FRESH_TID unsigned char* ws = args.ws; const h16* W = (const h16*)(ws + WS_W);
    pg8::EpiSwiglu E{GB_ACT(g), (const float*)(ws + (which ? WS_SSA : WS_SSB))};
    run_gemm(lds, which ? GB_H16(g) : GB_H16B(g), D, W + (which ? W_FFN2U : W_FFN1U), 2 * FF, D, g, nb, cb, E, tid);
}
__device__ __forceinline__ void st_ffn_down(STAGE_ARGS, int which) {
    FRESH_TID unsigned char* ws = args.ws; const h16* W = (const h16*)(ws + WS_W); float* out = args.out;
    const bool first = (which == 0 && layer == 0);
    const float* rp = first ? args.in[I_XP] : (const float*)out; const float* rsm = first ? args.in[I_XS] - (size_t)MP * D : (const float*)out;
    pg8::EpiResid E{rp, rsm, out, GB_H16(g), (float*)(ws + WS_SSA), 0.5f};
    run_gemm(lds, GB_ACT(g), FF, W + (which ? W_FFN2D : W_FFN1D), D, FF, g, nb, cb, E, tid);
}
__device__ __forceinline__ void st_win(STAGE_ARGS) {
    FRESH_TID unsigned char* ws = args.ws; const h16* W = (const h16*)(ws + WS_W);
    pg8::EpiProj E{GB_MIX(g), GB_KNA(g), (size_t)512 * g_rows(g), GB_LOWS(g), (const float*)(ws + WS_SSA)};
    run_gemm(lds, GB_H16(g), D, W + W_IN, NPROJ, D, g, nb, cb, E, tid);
}
__device__ __forceinline__ void st_wout(STAGE_ARGS) {
    FRESH_TID unsigned char* ws = args.ws; const h16* W = (const h16*)(ws + WS_W); float* out = args.out;
    pg8::EpiResid E{out, out, out, GB_H16(g), (float*)(ws + WS_SSA), 1.0f};
    run_gemm(lds, GB_MIX(g), D, W + W_OUT, D, D, g, nb, cb, E, tid);
}
__device__ __forceinline__ void st_pu(STAGE_ARGS) {
    FRESH_TID unsigned char* ws = args.ws; const h16* W = (const h16*)(ws + WS_W);
    int kpu = PLE; asm volatile("" : "+s"(kpu));
    pg8::EpiPU E{GB_PU(g)};
    run_gemm(lds, GB_P16(g), kpu, W + W_UP, D, kpu, g, nb, cb, E, tid);
}
__device__ __forceinline__ void st_ple(STAGE_ARGS) {
    FRESH_TID unsigned char* ws = args.ws; const h16* W = (const h16*)(ws + WS_W); float* out = args.out;
    pg8::EpiPle E{out, GB_H16B(g), (float*)(ws + WS_SSB), (const float*)(ws + WS_SSA), GB_PU(g)};
    run_gemm(lds, GB_H16(g), D, W + W_GATE, D, D, g, nb, cb, E, tid);
}
__device__ __forceinline__ void st_rwpost(STAGE_ARGS) {
    FRESH_TID const int t0 = g ? MP / 64 : 0, nt = g_rows(g) / 64;
    h16x2 gup[64];
    { const float* gu = args.in[I_GUP] + (size_t)layer * 128 * 512 + tid;
#pragma unroll
      for (int i2 = 0; i2 < 64; ++i2) { const float g0 = gu[0], g1 = gu[512]; gu += 1024; asm volatile("" : "+v"(gu)); gup[i2] = (h16x2){(h16)g0, (h16)g1}; } }
    for (int tile = cb; tile < nt; tile += nb) rwpost_tile(args, layer, t0 + tile, lds, tid, lane, wave, gup);
}
__device__ __forceinline__ void st_convp(STAGE_ARGS) { FRESH_TID convert_p(args, layer, g, nb, cb, tid); }

__device__ __forceinline__ void sub_sync(unsigned* ctr, unsigned target) {
    asm volatile("s_waitcnt vmcnt(0) lgkmcnt(0)" ::: "memory");
    __syncthreads();
    if (threadIdx.x == 0) {
        __builtin_amdgcn_fence(__ATOMIC_RELEASE, "agent"); asm volatile("s_waitcnt vmcnt(0)" ::: "memory");
        __hip_atomic_fetch_add(ctr, 1u, __ATOMIC_RELAXED, __HIP_MEMORY_SCOPE_AGENT);
        while (__hip_atomic_load(ctr, __ATOMIC_RELAXED, __HIP_MEMORY_SCOPE_AGENT) < target) __builtin_amdgcn_s_sleep(2);
    }
    __syncthreads();
    __builtin_amdgcn_fence(__ATOMIC_ACQUIRE, "agent"); asm volatile("s_waitcnt vmcnt(0)" ::: "memory");
}

constexpr int NSB = 32;
__global__ void __launch_bounds__(NTHREADS, 2) fwd_megakernel(Args args) {
    extern __shared__ __attribute__((aligned(16))) unsigned char lds_raw[];
    LAS unsigned char* lds = (LAS unsigned char*)lds_raw;
    cg::grid_group grid = cg::this_grid();
    const int bid = blockIdx.x, G = gridDim.x;
    const int NPB = G - NSB, pb = bid - NSB;
    unsigned* ctr = (unsigned*)(args.ws + WS_CTR);
    if (bid == 0 && threadIdx.x == 0) __hip_atomic_store(ctr, 0u, __ATOMIC_RELAXED, __HIP_MEMORY_SCOPE_AGENT);
    unsigned sbt = 0;
#define SUBSYNC() do { sbt += (unsigned)NPB; sub_sync(ctr, sbt); } while (0)

    for (int layer = 0; layer < 2; ++layer) {
        { FRESH_TID phase_convert(args, layer, lds, tid, lane, wave, bid, G); }
        grid_sync(grid);
        st_ffn_up(args, layer, 1, G, bid, lds, 0); grid_sync(grid);
        st_ffn_down(args, layer, 1, G, bid, lds, 0); grid_sync(grid);
        st_win(args, layer, 1, G, bid, lds); grid_sync(grid);
        { FRESH_TID for (int it = 1024 + bid; it < 1536; it += G) na_item(args, layer, it, lds, tid, lane, wave); }
        grid_sync(grid);
        if (bid < NSB) {
            FRESH_TID scan_item<4>(args, layer, bid, 0, lds, tid, lane, wave);
        } else {
            st_ffn_up(args, layer, 0, NPB, pb, lds, 0); SUBSYNC();
            st_ffn_down(args, layer, 0, NPB, pb, lds, 0); SUBSYNC();
            st_win(args, layer, 0, NPB, pb, lds); SUBSYNC();
            { FRESH_TID
              scan_item<4>(args, layer, 32 + pb, 0, lds, tid, lane, wave); __syncthreads();
              if (pb < 2 * (256 - NPB)) { scan_item<2>(args, layer, 32 + NPB + (pb >> 1), pb & 1, lds, tid, lane, wave); __syncthreads(); }
              else { for (int it = pb - 2 * (256 - NPB); it < 1024; it += NPB - 2 * (256 - NPB)) na_item(args, layer, it, lds, tid, lane, wave); } }
            SUBSYNC();
            st_rwpost(args, layer, 0, NPB, pb, lds); SUBSYNC();
            st_wout(args, layer, 0, NPB, pb, lds); SUBSYNC();
            st_ffn_up(args, layer, 0, NPB, pb, lds, 1);
        }
        grid_sync(grid);
        st_rwpost(args, layer, 1, G, bid, lds); st_ffn_down(args, layer, 0, G, bid, lds, 1); st_convp(args, layer, 0, G, bid, lds); grid_sync(grid);
        st_wout(args, layer, 1, G, bid, lds); st_pu(args, layer, 0, G, bid, lds); grid_sync(grid);
        st_ffn_up(args, layer, 1, G, bid, lds, 1); st_ple(args, layer, 0, G, bid, lds); grid_sync(grid);
        st_ffn_down(args, layer, 1, G, bid, lds, 1); st_convp(args, layer, 1, G, bid, lds); grid_sync(grid);
        st_pu(args, layer, 1, G, bid, lds); grid_sync(grid);
        st_ple(args, layer, 1, G, bid, lds); grid_sync(grid);
    }
    {
        FRESH_TID
        const float* SSB = (const float*)(args.ws + WS_SSB); float* out = args.out;
        const int gw = bid * NWAVES + wave, NGW = G * NWAVES; const f32x4* gm = (const f32x4*)args.in[I_FINAL] + lane;
        f32x4 gv[4];
#pragma unroll
        for (int j = 0; j < 4; ++j) gv[j] = gm[64 * j];
        for (int m = gw; m < M; m += NGW) {
            const float rs = row_rstd(SSB, m); f32x4* o = (f32x4*)(out + (size_t)m * D) + lane;
#pragma unroll
            for (int j = 0; j < 4; ++j) { const f32x4 v = o[64 * j]; o[64 * j] = v * rs * gv[j]; }
        }
    }
}

extern "C" void kernel_launch(void* const* d_in, const int* in_sizes, int n_in, void* d_out, int out_size, void* d_ws, size_t ws_size, hipStream_t stream) {
    static int grid = 0;
    if (grid == 0) {
        if (n_in != N_IN || out_size != M * D || ws_size < WS_END) { fprintf(stderr, "kernel_launch: unexpected shapes (n_in %d, out %d, ws %zu)\n", n_in, out_size, ws_size); grid = -1; return; }
        int dev = 0, cus = 0, per_cu = 0;
        (void)hipGetDevice(&dev); (void)hipDeviceGetAttribute(&cus, hipDeviceAttributeMultiprocessorCount, dev);
        (void)hipFuncSetAttribute((const void*)fwd_megakernel, hipFuncAttributeMaxDynamicSharedMemorySize, LDS_BYTES);
        (void)hipOccupancyMaxActiveBlocksPerMultiprocessor(&per_cu, (const void*)fwd_megakernel, NTHREADS, LDS_BYTES);
        if (per_cu < 1) fprintf(stderr, "kernel_launch: occupancy query says %d blocks per CU\n", per_cu);
        grid = cus;
        if (grid != 256) fprintf(stderr, "kernel_launch: grid %d (expected 256)\n", grid);
        if (grid <= NSB + 64) { fprintf(stderr, "kernel_launch: grid too small\n"); grid = -1; return; }
    }
    if (grid < 0) return;
    Args a{};
    for (int i = 0; i < N_IN; ++i) a.in[i] = (const float*)d_in[i];
    a.out = (float*)d_out; a.ws = (unsigned char*)d_ws;
    void* kargs[] = {&a};
    hipError_t e = hipLaunchCooperativeKernel((const void*)fwd_megakernel, dim3(grid), dim3(NTHREADS), kargs, LDS_BYTES, stream);
    if (e != hipSuccess) fprintf(stderr, "kernel_launch: cooperative launch failed: %s\n", hipGetErrorString(e));
}
```

```cpp
#include <hip/hip_runtime.h>
#include <hip/hip_cooperative_groups.h>
#include <cstdio>
#include <cstdint>
namespace cg = cooperative_groups;
#ifndef PHM
#define PHM 0xFFFF
#endif
#define PH(k) ((PHM >> (k)) & 1)

#define LAS __attribute__((address_space(3)))
typedef _Float16 h16;
typedef _Float16 h16x2 __attribute__((ext_vector_type(2)));
typedef _Float16 h16x4 __attribute__((ext_vector_type(4)));
typedef _Float16 h16x8 __attribute__((ext_vector_type(8)));
typedef _Float16 h16x8a __attribute__((ext_vector_type(8), may_alias));
typedef float f32x2 __attribute__((ext_vector_type(2)));
typedef float f32x4 __attribute__((ext_vector_type(4)));
typedef unsigned u32x2 __attribute__((ext_vector_type(2)));
typedef unsigned u32x4 __attribute__((ext_vector_type(4)));
typedef unsigned u32x4a __attribute__((ext_vector_type(4), may_alias));

constexpr int D = 1024, FF = 2816, MP = 65536, MS = 32768, M = MP + MS, TP = 4096, TS = 16384, PLE = 256;
constexpr int NPROJ = 3584;
constexpr int NTHREADS = 512, NWAVES = 8;
constexpr int LDS_BYTES = 147456;
constexpr size_t MiB = 1u << 20;
constexpr size_t WS_CTR = 256;
constexpr size_t WS_W = 1 * MiB;
constexpr size_t WS_SSA = 46 * MiB;
constexpr size_t WS_SSB = 52 * MiB;
constexpr size_t REG_P = 58 * MiB, REG_S = 682 * MiB, WS_END = 994 * MiB;
constexpr size_t OFF_H16 = 0;
constexpr size_t OFF_MIX = 2048;
constexpr size_t OFF_KNA = 4096, OFF_VNA = 5120, OFF_RR = 6144, OFF_RK = 7168, OFF_RV = 8192;
constexpr size_t OFF_LOWS = 9216;
constexpr size_t OFF_ACT = 2048;
constexpr size_t OFF_P16 = 7680;
constexpr size_t OFF_PU = 2048;
constexpr size_t OFF_H16B = 7680;
constexpr size_t OFF_YB = 0, OFF_BSC = 1024;
constexpr size_t OFF_END = 9984;
static_assert(REG_P + OFF_END * MP <= REG_S && REG_S + OFF_END * MS <= WS_END, "group regions");
__device__ __forceinline__ unsigned char* gbuf(unsigned char* ws, int g, size_t off, size_t stride) {
    const size_t reg = g ? REG_S : REG_P, rows = g ? (size_t)MS : (size_t)MP, row0 = g ? (size_t)MP : 0;
    return ws + (reg + off * rows - row0 * stride);
}
#define GB_H16(g)  ((h16*)gbuf(ws, g, OFF_H16, 2048))
#define GB_H16B(g) ((h16*)gbuf(ws, g, OFF_H16B, 2048))
#define GB_MIX(g)  ((h16*)gbuf(ws, g, OFF_MIX, 2048))
#define GB_KNA(g)  ((h16*)gbuf(ws, g, OFF_KNA, 1024))
#define GB_VNA(g)  ((h16*)gbuf(ws, g, OFF_VNA, 1024))
#define GB_RR(g)   ((h16*)gbuf(ws, g, OFF_RR, 1024))
#define GB_RK(g)   ((h16*)gbuf(ws, g, OFF_RK, 1024))
#define GB_RV(g)   ((h16*)gbuf(ws, g, OFF_RV, 1024))
#define GB_LOWS(g) ((h16*)gbuf(ws, g, OFF_LOWS, 768))
#define GB_ACT(g)  ((h16*)gbuf(ws, g, OFF_ACT, 5632))
#define GB_P16(g)  ((h16*)gbuf(ws, g, OFF_P16, 512))
#define GB_PU(g)   ((h16*)gbuf(ws, g, OFF_PU, 2048))
#define GB_YB(g)   ((h16*)gbuf(ws, g, OFF_YB, 1024))
#define GB_BSC(g)  ((float*)gbuf(ws, g, OFF_BSC, 64))
constexpr size_t W_FFN1U = 0;
constexpr size_t W_FFN1D = W_FFN1U + (size_t)5632 * 1024;
constexpr size_t W_IN = W_FFN1D + (size_t)1024 * 2816;
constexpr size_t W_OUT = W_IN + (size_t)3584 * 1024;
constexpr size_t W_FFN2U = W_OUT + (size_t)1024 * 1024;
constexpr size_t W_FFN2D = W_FFN2U + (size_t)5632 * 1024;
constexpr size_t W_GATE = W_FFN2D + (size_t)1024 * 2816;
constexpr size_t W_UP = W_GATE + (size_t)1024 * 1024;
constexpr size_t W_ENDE = W_UP + (size_t)1024 * 256;
static_assert(WS_W + W_ENDE * 2 <= WS_SSA, "weights fit");

enum { I_XP = 0, I_XS, I_PP, I_PS, I_F1N, I_F1G, I_F1U, I_F1D, I_MIXN, I_WIN, I_RPB, I_MU, I_W0, I_WUP, I_A0, I_AUP, I_GUP, I_KK, I_KA, I_RK, I_LNW, I_LNB,
       I_WOUT, I_F2N, I_F2G, I_F2U, I_F2D, I_PLEN, I_PLEG, I_PLEU, I_FINAL, N_IN };
struct Args { const float* in[N_IN]; float* out; unsigned char* ws; };

__device__ __forceinline__ float wave_sum(float v) {
#pragma unroll
    for (int o = 1; o < 64; o <<= 1) v += __shfl_xor(v, o);
    return v;
}
__device__ __forceinline__ unsigned pk2h(float a, float b) { h16x2 p = {(h16)a, (h16)b}; return __builtin_bit_cast(unsigned, p); }
__device__ __forceinline__ h16x2 as_h2(unsigned u) { return __builtin_bit_cast(h16x2, u); }
__device__ __forceinline__ float dot2h(unsigned a, h16x2 b, float c) { return __builtin_amdgcn_fdot2(as_h2(a), b, c, false); }
__device__ __forceinline__ float dot8(u32x4 a, u32x4 b, float c) { const unsigned a0 = a[0], a1 = a[1], a2 = a[2], a3 = a[3], b0 = b[0], b1 = b[1], b2 = b[2], b3 = b[3];
    c = __builtin_amdgcn_fdot2(as_h2(a0), as_h2(b0), c, false); c = __builtin_amdgcn_fdot2(as_h2(a1), as_h2(b1), c, false); c = __builtin_amdgcn_fdot2(as_h2(a2), as_h2(b2), c, false); c = __builtin_amdgcn_fdot2(as_h2(a3), as_h2(b3), c, false); return c; }
__device__ __forceinline__ float dot8w(u32x4 a, h16x2 w0, h16x2 w1, h16x2 w2, h16x2 w3, float c) { const unsigned a0 = a[0], a1 = a[1], a2 = a[2], a3 = a[3];
    c = __builtin_amdgcn_fdot2(as_h2(a0), w0, c, false); c = __builtin_amdgcn_fdot2(as_h2(a1), w1, c, false); c = __builtin_amdgcn_fdot2(as_h2(a2), w2, c, false); c = __builtin_amdgcn_fdot2(as_h2(a3), w3, c, false); return c; }
__device__ __forceinline__ float fma_mix_lo(float p, unsigned v, float o) { asm("v_fma_mix_f32 %0, %1, %2, %0 op_sel_hi:[0,1,0]" : "+v"(o) : "v"(p), "v"(v)); return o; }
__device__ __forceinline__ float fma_mix_hi(float p, unsigned v, float o) { asm("v_fma_mix_f32 %0, %1, %2, %0 op_sel:[0,1,0] op_sel_hi:[0,1,0]" : "+v"(o) : "v"(p), "v"(v)); return o; }
__device__ __forceinline__ float sigmoidf_(float x) { return __builtin_amdgcn_rcpf(1.0f + __expf(-x)); }
__device__ __forceinline__ float row_rstd(const float* ss, int row) {
    const f32x4* p = (const f32x4*)(ss + (size_t)row * 16);
    const f32x4 a = p[0], b = p[1], c = p[2], d = p[3];
    const float s = ((a.x + a.y) + (a.z + a.w)) + ((b.x + b.y) + (b.z + b.w)) + ((c.x + c.y) + (c.z + c.w)) + ((d.x + d.y) + (d.z + d.w));
    return __builtin_amdgcn_rsqf(s * (1.0f / 1024.0f) + 1e-6f);
}
template <int CTRL> __device__ __forceinline__ float dpp_f(float v) { return __builtin_bit_cast(float, __builtin_amdgcn_update_dpp(0, __builtin_bit_cast(int, v), CTRL, 0xF, 0xF, true)); }
__device__ __forceinline__ float row16_sum(float v) {
    v += dpp_f<0xB1>(v);
    v += dpp_f<0x4E>(v);
    v += dpp_f<0x141>(v);
    v += dpp_f<0x140>(v);
    return v;
}
__device__ __forceinline__ void grid_sync(cg::grid_group& grid) {
    asm volatile("s_waitcnt vmcnt(0) lgkmcnt(0)" ::: "memory"); grid.sync();
    __builtin_amdgcn_fence(__ATOMIC_ACQUIRE, "agent"); asm volatile("s_waitcnt vmcnt(0)" ::: "memory"); }

namespace pg8 {
constexpr int BM = 256, BK = 64, HALF = 128, HTB = HALF * BK * 2, STAGE_BYTES = 8 * HTB, NXCD = 8, WGM = 8;
__host__ __device__ __forceinline__ int lds_byte(int r, int c) { const int st = (r >> 4) * 2 + (c >> 5), rr = r & 15, cc = c & 31, ob = rr * 64 + cc * 2; return st * 1024 + (ob ^ (((ob >> 9) & 1) << 5)); }
__host__ __device__ __forceinline__ void stage_rc(int b, int& R, int& C) { const int st = b / 1024, sb = b % 1024, swz = sb ^ (((sb >> 9) & 1) << 5); R = (st >> 1) * 16 + swz / 64; C = (st & 1) * 32 + (swz % 64) / 2; }
__host__ __device__ __forceinline__ int perm32(int rho) { const int n = rho >> 4, i = rho & 15; return 8 * (i >> 2) + 4 * n + (i & 3); }
struct Unit { int pm, pn; };
struct Gemm { const h16* A; const h16* Bt; int M, N, K, lda; };
struct StaticOrder {
    int nM, nN, nwg, G, c, pm0;
    __device__ void init(int M_, int N_, int G_, int c_, int pm0_) { nM = M_ / BM; nN = N_ / BM; nwg = nM * nN; G = G_; c = c_; pm0 = pm0_; }
    __device__ bool next(int i, Unit& u) const {
        const long L = (long)i * G + c; if (L >= nwg) return false;
        int wgid = (int)L; { const int q = nwg / NXCD, r = nwg % NXCD, xcd = wgid % NXCD, off = wgid / NXCD; wgid = (xcd < r ? xcd * (q + 1) : r * (q + 1) + (xcd - r) * q) + off; }
        const int nig = WGM * nN, gid = wgid / nig, fm = gid * WGM, gsz = (nM - fm) < WGM ? (nM - fm) : WGM;
        u.pm = pm0 + fm + ((wgid % nig) % gsz); u.pn = (wgid % nig) / gsz; return true;
    }
};
typedef f32x4 Acc[2][2][4][2];

template <class Epi>
__device__ __forceinline__ void gemm_phase(LAS unsigned char* lds, const Gemm g, const StaticOrder& S, const Epi& E, const int tid) {
    const int wid = __builtin_amdgcn_readfirstlane(tid >> 6), lane = tid & 63, wr = wid >> 2, wc = wid & 3, fr = lane & 15, fq = lane >> 4;
    const int K = g.K, nt = K / BK, lda = g.lda;
    unsigned voffA[2], voffB[2];
#pragma unroll
    for (int i = 0; i < 2; ++i) { int R, C; stage_rc(tid * 16 + i * 8192, R, C); const int Rb = Epi::PERM ? ((R & ~31) + perm32(R & 31)) : R;
        voffA[i] = (unsigned)(R * lda + C) * 2u; voffB[i] = (unsigned)(Rb * K + C) * 2u; }
    const size_t kstep = (size_t)(BK * 2);
    const size_t hstepA = (size_t)HALF * lda * 2, hstepB = (size_t)HALF * K * 2;
    const size_t tstepA = 2 * hstepA, tstepB = 2 * hstepB;
    const unsigned ldsw = (unsigned)wid * 1024u;
    const int aoff = lds_byte(wr * 64 + fr, fq * 8), boff = lds_byte(wc * 32 + fr, fq * 8);
#define PG8_SA(b, h) (((b) * 2 + (h)) * HTB)
#define PG8_SB(b, h) ((4 + (b) * 2 + (h)) * HTB)
#define PG8_STAGE(bufoff, gbase, voff) do { _Pragma("unroll") for (int _i = 0; _i < 2; ++_i) \
        __builtin_amdgcn_global_load_lds((const unsigned*)((const char*)(gbase) + (voff)[_i]), (LAS unsigned*)(lds + (bufoff) + ldsw + _i * 8192), 16, 0, 0); } while (0)
#define PG8_LDA(dst, b, h) do { _Pragma("unroll") for (int m = 0; m < 4; ++m) _Pragma("unroll") for (int k = 0; k < 2; ++k) dst[m][k] = *(const LAS h16x8*)(lds + PG8_SA(b, h) + aoff + m * 2048 + k * 1024); } while (0)
#define PG8_LDB(dst, b, h) do { _Pragma("unroll") for (int n = 0; n < 2; ++n) _Pragma("unroll") for (int k = 0; k < 2; ++k) dst[n][k] = *(const LAS h16x8*)(lds + PG8_SB(b, h) + boff + n * 2048 + k * 1024); } while (0)
#define PG8_MMA(ai, bj, At, Bt) do { __builtin_amdgcn_s_setprio(1); _Pragma("unroll") for (int m = 0; m < 4; ++m) _Pragma("unroll") for (int n = 0; n < 2; ++n) _Pragma("unroll") for (int k = 0; k < 2; ++k) \
        acc[ai][bj][m][n] = __builtin_amdgcn_mfma_f32_16x16x32_f16(Bt[n][k], At[m][k], acc[ai][bj][m][n], 0, 0, 0); __builtin_amdgcn_s_setprio(0); } while (0)
#define PG8_WAIT_V(n) asm volatile("s_waitcnt vmcnt(" #n ")" ::: "memory")
#define PG8_WAIT_L(n) asm volatile("s_waitcnt lgkmcnt(" #n ")" ::: "memory")
#define PG8_BAR __builtin_amdgcn_s_barrier()
#define PG8_SCHED __builtin_amdgcn_sched_barrier(0)
    Unit cur, nxt; int ui = 0;
    if (!S.next(0, cur)) return;
    f32x4 acc[2][2][4][2];
#pragma unroll
    for (int a = 0; a < 2; ++a)
#pragma unroll
        for (int b = 0; b < 2; ++b)
#pragma unroll
            for (int m = 0; m < 4; ++m)
#pragma unroll
                for (int n = 0; n < 2; ++n) acc[a][b][m][n] = (f32x4){0.f, 0.f, 0.f, 0.f};
    h16x8 At[4][2], B0[2][2], B1[2][2];
    const char* cA = (const char*)g.A + (size_t)cur.pm * tstepA; const char* cB = (const char*)g.Bt + (size_t)cur.pn * tstepB;
    PG8_STAGE(PG8_SB(0, 0), cB, voffB); PG8_STAGE(PG8_SB(0, 1), cB + hstepB, voffB); PG8_STAGE(PG8_SA(0, 0), cA, voffA); PG8_STAGE(PG8_SA(0, 1), cA + hstepA, voffA);
    if (wr == 1) PG8_BAR;
    PG8_WAIT_V(2); PG8_BAR;
    PG8_STAGE(PG8_SB(1, 0), cB + kstep, voffB); PG8_STAGE(PG8_SA(1, 0), cA + kstep, voffA); PG8_STAGE(PG8_SB(1, 1), cB + hstepB + kstep, voffB);
    PG8_WAIT_V(6); PG8_BAR;
    for (;;) {
        const bool has_next = S.next(ui + 1, nxt);
        const char* nA = has_next ? (const char*)g.A + (size_t)nxt.pm * tstepA : cA; const char* nB = has_next ? (const char*)g.Bt + (size_t)nxt.pn * tstepB : cB;
        for (int t = 0; t < nt; t += 2) {
            const bool last = (t == nt - 2);
            const char* a1 = cA + (size_t)(t + 1) * kstep;
            const char* a2 = last ? nA : cA + (size_t)(t + 2) * kstep; const char* b2 = last ? nB : cB + (size_t)(t + 2) * kstep;
            const char* a3 = a2 + kstep; const char* b3 = b2 + kstep;
            PG8_LDB(B0, 0, 0); PG8_LDB(B1, 0, 1); PG8_SCHED; PG8_LDA(At, 0, 0); PG8_STAGE(PG8_SA(1, 1), a1 + hstepA, voffA);
            PG8_WAIT_V(8); PG8_WAIT_L(0); PG8_BAR; PG8_MMA(0, 0, At, B0); PG8_MMA(0, 1, At, B1); PG8_BAR; PG8_SCHED;
            PG8_LDA(At, 0, 1); PG8_STAGE(PG8_SB(0, 0), b2, voffB); PG8_STAGE(PG8_SB(0, 1), b2 + hstepB, voffB); PG8_STAGE(PG8_SA(0, 0), a2, voffA);
            PG8_WAIT_V(8); PG8_WAIT_L(0); PG8_BAR; PG8_MMA(1, 0, At, B0); PG8_MMA(1, 1, At, B1); PG8_BAR; PG8_SCHED;
            PG8_LDB(B0, 1, 0); PG8_LDB(B1, 1, 1); PG8_SCHED; PG8_LDA(At, 1, 0); PG8_STAGE(PG8_SA(0, 1), a2 + hstepA, voffA);
            PG8_WAIT_V(8); PG8_WAIT_L(0); PG8_BAR; PG8_MMA(0, 0, At, B0); PG8_MMA(0, 1, At, B1); PG8_BAR; PG8_SCHED;
            PG8_LDA(At, 1, 1); PG8_STAGE(PG8_SB(1, 0), b3, voffB); PG8_STAGE(PG8_SB(1, 1), b3 + hstepB, voffB); PG8_STAGE(PG8_SA(1, 0), a3, voffA);
            PG8_WAIT_V(8); PG8_WAIT_L(0); PG8_BAR; PG8_MMA(1, 0, At, B0); PG8_MMA(1, 1, At, B1); PG8_BAR; PG8_SCHED;
        }
        if (wr == 0) PG8_BAR;
        E(acc, cur, wr, wc, fr, fq);
        if (!has_next) break;
#pragma unroll
        for (int a = 0; a < 2; ++a)
#pragma unroll
            for (int b = 0; b < 2; ++b)
#pragma unroll
                for (int m = 0; m < 4; ++m)
#pragma unroll
                    for (int n = 0; n < 2; ++n) acc[a][b][m][n] = (f32x4){0.f, 0.f, 0.f, 0.f};
        cur = nxt; cA = nA; cB = nB; ++ui;
        if (wr == 1) PG8_BAR;
    }
    PG8_WAIT_V(0);
    PG8_BAR;
#undef PG8_SA
#undef PG8_SB
#undef PG8_STAGE
#undef PG8_LDA
#undef PG8_LDB
#undef PG8_MMA
#undef PG8_WAIT_V
#undef PG8_WAIT_L
#undef PG8_BAR
#undef PG8_SCHED
}


struct EpiSwiglu {
    static constexpr bool PERM = true;
    h16* O; const float* ss;
    __device__ __forceinline__ void operator()(const Acc& acc, const Unit& u, int wr, int wc, int fr, int fq) const {
        const int row0 = u.pm * BM + wr * 64 + fr, col0 = u.pn * 128 + wc * 32 + 8 * fq;
#pragma unroll
        for (int ai = 0; ai < 2; ++ai)
#pragma unroll
            for (int m = 0; m < 4; ++m) {
                const int row = row0 + ai * HALF + m * 16; const float rs = row_rstd(ss, row);
                float o[8];
#pragma unroll
                for (int n = 0; n < 2; ++n)
#pragma unroll
                    for (int j = 0; j < 4; ++j) { const float gg = acc[ai][0][m][n][j] * rs, uu = acc[ai][1][m][n][j] * rs; o[n * 4 + j] = gg * sigmoidf_(gg) * uu; }
                u32x4 w; w.x = pk2h(o[0], o[1]); w.y = pk2h(o[2], o[3]); w.z = pk2h(o[4], o[5]); w.w = pk2h(o[6], o[7]);
                *(u32x4*)(O + (size_t)row * FF + col0) = w;
            }
    }
};
struct EpiResid {
    static constexpr bool PERM = false;
    const float* res_p; const float* res_s; float* out; h16* o16; float* ss; float alpha;
    __device__ __forceinline__ void operator()(const Acc& acc, const Unit& u, int wr, int wc, int fr, int fq) const {
        const int row0 = u.pm * BM + wr * 64 + fr, col0 = u.pn * BM + wc * 32 + 4 * fq;
        const float* res = (u.pm * BM < MP) ? res_p : res_s;
#pragma unroll
        for (int ai = 0; ai < 2; ++ai)
#pragma unroll
            for (int m = 0; m < 4; ++m) {
                const int row = row0 + ai * HALF + m * 16; const size_t off = (size_t)row * D + col0; float sq = 0.f;
#pragma unroll
                for (int bj = 0; bj < 2; ++bj)
#pragma unroll
                    for (int n = 0; n < 2; ++n) { const size_t o = off + bj * HALF + n * 16; const f32x4 r = *(const f32x4*)(res + o); const f32x4 v = r + acc[ai][bj][m][n] * alpha;
                        *(f32x4*)(out + o) = v; u32x2 w; w.x = pk2h(v.x, v.y); w.y = pk2h(v.z, v.w); *(u32x2*)(o16 + o) = w; sq += (v.x * v.x + v.y * v.y) + (v.z * v.z + v.w * v.w); }
                sq += __shfl_xor(sq, 16); sq += __shfl_xor(sq, 32);
                if (fq == 0) ss[(size_t)row * 16 + u.pn * 4 + wc] = sq;
                asm volatile("" ::: "memory");
            }
    }
};
struct EpiProj {
    static constexpr bool PERM = true;
    h16* mix; h16* kna; size_t bufstep; h16* lows; const float* ss;
    __device__ __forceinline__ void operator()(const Acc& acc, const Unit& u, int wr, int wc, int fr, int fq) const {
        const int pn = u.pn; h16* base; int ldc, c0; float sc = 1.f; int nbj = 2;
        if (pn < 2) { base = mix; ldc = 1024; c0 = pn * 256; sc = 0.125f; }
        else if (pn < 12) { base = kna + (size_t)((pn - 2) >> 1) * bufstep; ldc = 512; c0 = ((pn - 2) & 1) * 256; }
        else { base = lows; ldc = 384; c0 = (pn - 12) * 256; if (pn == 13) nbj = 1; }
        const int row0 = u.pm * BM + wr * 64 + fr, col0 = c0 + wc * 32 + 8 * fq;
#pragma unroll
        for (int ai = 0; ai < 2; ++ai)
#pragma unroll
            for (int m = 0; m < 4; ++m) {
                const int row = row0 + ai * HALF + m * 16; const float rs = row_rstd(ss, row) * sc;
#pragma unroll
                for (int bj = 0; bj < 2; ++bj) if (bj < nbj) {
                    const f32x4 v0 = acc[ai][bj][m][0] * rs, v1 = acc[ai][bj][m][1] * rs;
                    u32x4 w; w.x = pk2h(v0.x, v0.y); w.y = pk2h(v0.z, v0.w); w.z = pk2h(v1.x, v1.y); w.w = pk2h(v1.z, v1.w);
                    *(u32x4*)(base + (size_t)row * ldc + col0 + bj * HALF) = w; }
            }
    }
};
struct EpiPU {
    static constexpr bool PERM = true;
    h16* O;
    __device__ __forceinline__ void operator()(const Acc& acc, const Unit& u, int wr, int wc, int fr, int fq) const {
        const int row0 = u.pm * BM + wr * 64 + fr, col0 = u.pn * BM + wc * 32 + 8 * fq;
#pragma unroll
        for (int ai = 0; ai < 2; ++ai)
#pragma unroll
            for (int m = 0; m < 4; ++m) {
                const int row = row0 + ai * HALF + m * 16;
#pragma unroll
                for (int bj = 0; bj < 2; ++bj) {
                    const f32x4 v0 = acc[ai][bj][m][0], v1 = acc[ai][bj][m][1];
                    u32x4 w; w.x = pk2h(v0.x, v0.y); w.y = pk2h(v0.z, v0.w); w.z = pk2h(v1.x, v1.y); w.w = pk2h(v1.z, v1.w);
                    *(u32x4*)(O + (size_t)row * D + col0 + bj * HALF) = w; }
            }
    }
};
struct EpiPle {
    static constexpr bool PERM = false;
    float* out; h16* o16; float* ssw; const float* ssr; const h16* pu;
    __device__ __forceinline__ void operator()(const Acc& acc, const Unit& u, int wr, int wc, int fr, int fq) const {
        const int row0 = u.pm * BM + wr * 64 + fr, col0 = u.pn * BM + wc * 32 + 4 * fq;
#pragma unroll
        for (int ai = 0; ai < 2; ++ai)
#pragma unroll
            for (int m = 0; m < 4; ++m) {
                const int row = row0 + ai * HALF + m * 16; const size_t off = (size_t)row * D + col0; float sq = 0.f; const float rs = row_rstd(ssr, row);
#pragma unroll
                for (int bj = 0; bj < 2; ++bj)
#pragma unroll
                    for (int n = 0; n < 2; ++n) { const size_t o = off + bj * HALF + n * 16; const f32x4 r = *(const f32x4*)(out + o); const h16x4 p = *(const h16x4*)(pu + o);
                        const f32x4 a = acc[ai][bj][m][n] * rs; f32x4 v;
                        v.x = r.x + sigmoidf_(a.x) * (float)p.x; v.y = r.y + sigmoidf_(a.y) * (float)p.y; v.z = r.z + sigmoidf_(a.z) * (float)p.z; v.w = r.w + sigmoidf_(a.w) * (float)p.w;
                        *(f32x4*)(out + o) = v; u32x2 w; w.x = pk2h(v.x, v.y); w.y = pk2h(v.z, v.w); *(u32x2*)(o16 + o) = w; sq += (v.x * v.x + v.y * v.y) + (v.z * v.z + v.w * v.w); }
                sq += __shfl_xor(sq, 16); sq += __shfl_xor(sq, 32);
                if (fq == 0) ssw[(size_t)row * 16 + u.pn * 4 + wc] = sq;
                asm volatile("" ::: "memory");
            }
    }
};
}

__device__ __forceinline__ void convert_matrix(const float* W, int K, int N, const float* gamma, h16* WT, int mode, LAS float* scr, int gw, int NGW, int lane) {
    const int nblk = N / 32, nitems = (K / 64) * nblk;
    for (int item = gw; item < nitems; item += NGW) {
        const int kb = item / nblk, nb = item % nblk, k0 = 64 * kb, n0 = 32 * nb;
        const int drow0 = (mode == 0) ? n0 : ((n0 >> 7) * 256 + (n0 & 127) + (mode == 2 ? 128 : 0));
#pragma unroll 8
        for (int i = 0; i < 32; ++i) { const int kk = 2 * i + (lane >> 5); float v = W[(size_t)(k0 + kk) * N + n0 + (lane & 31)]; if (gamma) v *= gamma[k0 + kk]; scr[kk * 33 + (lane & 31)] = v; }
        asm volatile("s_waitcnt lgkmcnt(0)" ::: "memory");
        const int c = lane & 7;
#pragma unroll
        for (int j = 0; j < 4; ++j) { const int n = (lane >> 3) + 8 * j; const LAS float* s = scr + (8 * c) * 33 + n;
            u32x4 o; o.x = pk2h(s[0 * 33], s[1 * 33]); o.y = pk2h(s[2 * 33], s[3 * 33]); o.z = pk2h(s[4 * 33], s[5 * 33]); o.w = pk2h(s[6 * 33], s[7 * 33]);
            *(u32x4*)(WT + (size_t)(drow0 + n) * K + k0 + 8 * c) = o; }
        asm volatile("s_waitcnt lgkmcnt(0)" ::: "memory");
    }
}

__device__ __forceinline__ void phase_convert(const Args& a, int layer, LAS unsigned char* lds, int tid, int lane, int wave, int bid, int G) {
    LAS float* scr = (LAS float*)(lds + wave * 16384);
    const int gw = bid * NWAVES + wave, NGW = G * NWAVES;
    h16* W = (h16*)(a.ws + WS_W);
    const size_t l = (size_t)layer;
    convert_matrix(a.in[I_F1G] + l * D * FF, D, FF, a.in[I_F1N] + l * D, W + W_FFN1U, 1, scr, gw, NGW, lane);
    convert_matrix(a.in[I_F1U] + l * D * FF, D, FF, a.in[I_F1N] + l * D, W + W_FFN1U, 2, scr, gw, NGW, lane);
    convert_matrix(a.in[I_F1D] + l * FF * D, FF, D, nullptr, W + W_FFN1D, 0, scr, gw, NGW, lane);
    convert_matrix(a.in[I_WIN] + l * D * 3456, D, 3456, a.in[I_MIXN] + l * D, W + W_IN, 0, scr, gw, NGW, lane);
    convert_matrix(a.in[I_WOUT] + l * D * D, D, D, nullptr, W + W_OUT, 0, scr, gw, NGW, lane);
    convert_matrix(a.in[I_F2G] + l * D * FF, D, FF, a.in[I_F2N] + l * D, W + W_FFN2U, 1, scr, gw, NGW, lane);
    convert_matrix(a.in[I_F2U] + l * D * FF, D, FF, a.in[I_F2N] + l * D, W + W_FFN2U, 2, scr, gw, NGW, lane);
    convert_matrix(a.in[I_F2D] + l * FF * D, FF, D, nullptr, W + W_FFN2D, 0, scr, gw, NGW, lane);
    convert_matrix(a.in[I_PLEG] + l * D * D, D, D, a.in[I_PLEN] + l * D, W + W_GATE, 0, scr, gw, NGW, lane);
    convert_matrix(a.in[I_PLEU] + l * PLE * D, PLE, D, nullptr, W + W_UP, 0, scr, gw, NGW, lane);
    { u32x4* z = (u32x4*)(W + W_IN + (size_t)3456 * 1024); const int n16 = 128 * 1024 * 2 / 16;
      for (int i = bid * NTHREADS + tid; i < n16; i += G * NTHREADS) z[i] = (u32x4){0u, 0u, 0u, 0u}; }
    if (layer == 0) {
        unsigned char* ws = a.ws; h16* Hp = GB_H16B(0); h16* Hs = GB_H16B(1); float* ss = (float*)(a.ws + WS_SSB);
        for (int m = gw; m < M; m += NGW) {
            h16* H = (m < MP) ? Hp : Hs;
            const float* xr = (m < MP) ? a.in[I_XP] + (size_t)m * D : a.in[I_XS] + (size_t)(m - MP) * D;
            const f32x4* x4 = (const f32x4*)xr + lane; float s = 0.f;
            u32x2* o = (u32x2*)(H + (size_t)m * D) + lane;
#pragma unroll
            for (int j = 0; j < 4; ++j) { const f32x4 v = x4[64 * j]; s += (v.x * v.x + v.y * v.y) + (v.z * v.z + v.w * v.w); u32x2 w; w.x = pk2h(v.x, v.y); w.y = pk2h(v.z, v.w); o[64 * j] = w; }
            s = wave_sum(s);
            if (lane < 16) ss[(size_t)m * 16 + lane] = (lane == 0) ? s : 0.f;
        }
    }
}

__device__ __forceinline__ void convert_p(const Args& a, int layer, int g, int nb, int cb, int tid) {
    unsigned char* ws = a.ws; const int rows = g ? MS : MP, row0 = g ? MP : 0;
    u32x2* o = (u32x2*)(GB_P16(g) + (size_t)row0 * PLE);
    const f32x4* p = (const f32x4*)((g ? a.in[I_PS] + (size_t)layer * MS * PLE : a.in[I_PP] + (size_t)layer * MP * PLE));
    const int N4 = rows * PLE / 4;
    for (int i = cb * NTHREADS + tid; i < N4; i += nb * NTHREADS) { const f32x4 v = p[i]; u32x2 w; w.x = pk2h(v.x, v.y); w.y = pk2h(v.z, v.w); o[i] = w; }
}

constexpr int NA_PITCH = 144;
constexpr int NA_VOFF = 512 * NA_PITCH;
constexpr int NA_PP = 67;
__device__ __forceinline__ void na_item(const Args& a, int layer, int item, LAS unsigned char* lds, int tid, int lane, int wave) {
    int tok0, i, rows;
    if (item < 1024) { tok0 = (item >> 6) * TP; i = item & 63; rows = 64; } else { const int it2 = item - 1024; tok0 = MP + (it2 >> 8) * TS; i = it2 & 255; rows = 256; }
    int rs = i - 4; rs = rs < 0 ? 0 : (rs > rows - 8 ? rows - 8 : rs);
    unsigned char* ws = a.ws; const int g = item < 1024 ? 0 : 1;
    h16* MIX = GB_MIX(g); const h16* KNA = GB_KNA(g); const h16* VNA = GB_VNA(g);
    const float* rpb = a.in[I_RPB] + (size_t)layer * 8 * 15 * 31;
    const int wtok0 = tok0 + rs * 64;
    const int j = lane, aw = wave;
    const int tokq = tok0 + i * 64 + j;
    int cs = j - 8; cs = cs < 0 ? 0 : (cs > 48 ? 48 : cs);
    u32x4 kreg[8], vreg[8];
    const size_t kvoff = (size_t)(wtok0 + (tid >> 3)) * 512 + (tid & 7) * 8;
#pragma unroll
    for (int it = 0; it < 8; ++it) { kreg[it] = *(const u32x4*)(KNA + kvoff + (size_t)it * (64 * 512)); vreg[it] = *(const u32x4*)(VNA + kvoff + (size_t)it * (64 * 512)); }
#pragma unroll 1
    for (int h = 0; h < 8; ++h) {
#pragma unroll
        for (int it = 0; it < 8; ++it) { const int key = (tid >> 3) + 64 * it, ch = tid & 7;
            *(LAS u32x4*)(lds + key * NA_PITCH + ch * 16) = kreg[it]; *(LAS u32x4*)(lds + NA_VOFF + key * NA_PITCH + ch * 16) = vreg[it]; }
        u32x4 qv[8];
#pragma unroll
        for (int c = 0; c < 8; ++c) qv[c] = *(const u32x4*)(MIX + (size_t)tokq * 1024 + h * 64 + c * 8);
        float sc[16];
        { const float* bias = rpb + ((size_t)h * 15 + (rs + aw - i + 7)) * 31 + (cs - j + 15);
#pragma unroll
          for (int c = 0; c < 16; ++c) sc[c] = bias[c]; }
        __syncthreads();
        if (h + 1 < 8) {
#pragma unroll
            for (int it = 0; it < 8; ++it) { kreg[it] = *(const u32x4*)(KNA + kvoff + (size_t)it * (64 * 512) + (h + 1) * 64); vreg[it] = *(const u32x4*)(VNA + kvoff + (size_t)it * (64 * 512) + (h + 1) * 64); }
        }
#pragma unroll
        for (int c = 0; c < 16; ++c) {
            const LAS unsigned char* kp = lds + (aw * 64 + cs + c) * NA_PITCH; float s = sc[c];
#pragma unroll
            for (int c8 = 0; c8 < 8; ++c8) { const u32x4 kk = *(const LAS u32x4*)(kp + c8 * 16); s = dot8(qv[c8], kk, s); }
            sc[c] = s;
        }
        float mx = sc[0];
#pragma unroll
        for (int c = 1; c < 16; ++c) mx = fmaxf(mx, sc[c]);
        float l = 0.f;
#pragma unroll
        for (int c = 0; c < 16; ++c) { sc[c] = __expf(sc[c] - mx); l += sc[c]; }
        float o[64];
#pragma unroll
        for (int d = 0; d < 64; ++d) o[d] = 0.f;
#pragma unroll
        for (int c = 0; c < 16; ++c) {
            const LAS unsigned char* vp = lds + NA_VOFF + (aw * 64 + cs + c) * NA_PITCH; const float p = sc[c];
#pragma unroll
            for (int c8 = 0; c8 < 8; ++c8) { const u32x4 vv = *(const LAS u32x4*)(vp + c8 * 16);
#pragma unroll
                for (int e = 0; e < 4; ++e) { const unsigned ve = vv[e]; o[c8 * 8 + 2 * e] = fma_mix_lo(p, ve, o[c8 * 8 + 2 * e]); o[c8 * 8 + 2 * e + 1] = fma_mix_hi(p, ve, o[c8 * 8 + 2 * e + 1]); } }
            asm volatile("" ::: "memory");
        }
        __syncthreads();
        LAS float* part = (LAS float*)lds + (size_t)(aw * 64 + j) * NA_PP;
#pragma unroll
        for (int d = 0; d < 64; ++d) part[d] = o[d];
        part[64] = mx; part[65] = l;
        __syncthreads();
        {
            const int jq = tid & 63, e8 = tid >> 6;
            float mw[8], M_ = -3.0e38f;
#pragma unroll
            for (int w = 0; w < 8; ++w) { mw[w] = ((const LAS float*)lds)[(size_t)(w * 64 + jq) * NA_PP + 64]; M_ = fmaxf(M_, mw[w]); }
            float L = 0.f, ov[8];
#pragma unroll
            for (int e = 0; e < 8; ++e) ov[e] = 0.f;
#pragma unroll
            for (int w = 0; w < 8; ++w) { const float f = __expf(mw[w] - M_); const LAS float* pw = (const LAS float*)lds + (size_t)(w * 64 + jq) * NA_PP; L += f * pw[65];
#pragma unroll
                for (int e = 0; e < 8; ++e) ov[e] += f * pw[e8 * 8 + e]; }
            const float inv = 1.0f / L;
            u32x4 w4; w4.x = pk2h(ov[0] * inv, ov[1] * inv); w4.y = pk2h(ov[2] * inv, ov[3] * inv); w4.z = pk2h(ov[4] * inv, ov[5] * inv); w4.w = pk2h(ov[6] * inv, ov[7] * inv);
            *(u32x4*)(MIX + (size_t)(tok0 + i * 64 + jq) * 1024 + h * 64 + e8 * 8) = w4;
        }
        __syncthreads();
    }
}

__device__ __forceinline__ float shiftmix(const h16* base, size_t stride, int t, int T, float mu) {
    const float c = (float)base[0];
    const float p = (t > 0) ? (float)*(base - stride) : 0.f;
    const float n = (t < T - 1) ? (float)*(base + stride) : 0.f;
    return c + mu * (0.5f * (p + n) - c);
}
constexpr int SC_CH = 32;
constexpr int SC_OPB = SC_CH * 6 * 64 * 4;
constexpr int SC_YOFF = 2 * SC_OPB;
constexpr int SC_YB = SC_CH * 64 * 4;
constexpr int SC_XOFF = SC_YOFF + 2 * SC_YB;
constexpr int SC_ZOFF = SC_XOFF + 8192;
static_assert(SC_ZOFF + 4 * 4096 <= LDS_BYTES, "scan LDS");
__device__ __forceinline__ float wave_sum_fast(float v) {
    v = row16_sum(v);
    { const auto r = __builtin_amdgcn_permlane16_swap(__builtin_bit_cast(unsigned, v), __builtin_bit_cast(unsigned, v), false, false);
      const unsigned r0 = r[0], r1 = r[1]; v = __builtin_bit_cast(float, r0) + __builtin_bit_cast(float, r1); }
    { const auto r = __builtin_amdgcn_permlane32_swap(__builtin_bit_cast(unsigned, v), __builtin_bit_cast(unsigned, v), false, false);
      const unsigned r0 = r[0], r1 = r[1]; v = __builtin_bit_cast(float, r0) + __builtin_bit_cast(float, r1); }
    return v;
}
__device__ __forceinline__ float mix3(h16 p, h16 c, h16 n, float mu) { const float cf = (float)c; return cf + mu * (0.5f * ((float)p + (float)n) - cf); }
struct ScanWin { float r[10], k[10], v[10], wl[10], al[10]; };
__device__ __forceinline__ float mix3f(float p, float c, float n, float mu) { return c + mu * (0.5f * (p + n) - c); }
template <int R>
__device__ __forceinline__ void scan_flush(LAS unsigned char* lds, int cf, int pw, int lane, int d, int T, int tok0, int h, int rowbase, h16* Yf, h16* Yb) {
    const LAS float* yb = (const LAS float*)(lds + SC_YOFF + (cf & 1) * SC_YB);
    const int s = pw * 8 + (lane >> 3); const int g = cf * SC_CH + s; const int t = d ? (T - 1 - g) : g;
    if (R == 4) {
        const int r8 = (lane & 7) * 8;
        const f32x4 y0 = *(const LAS f32x4*)(yb + s * 64 + r8), y1 = *(const LAS f32x4*)(yb + s * 64 + r8 + 4);
        u32x4 w4; w4.x = pk2h(y0.x, y0.y); w4.y = pk2h(y0.z, y0.w); w4.z = pk2h(y1.x, y1.y); w4.w = pk2h(y1.z, y1.w);
        if (d == 0) *(u32x4*)(Yf + (size_t)(tok0 + t) * 1024 + 512 + h * 64 + r8) = w4; else *(u32x4*)(Yb + (size_t)(tok0 + t) * 512 + h * 64 + r8) = w4;
    } else {
        const int r4 = (lane & 7) * 4;
        const f32x4 y0 = *(const LAS f32x4*)(yb + s * 32 + r4);
        u32x2 w2; w2.x = pk2h(y0.x, y0.y); w2.y = pk2h(y0.z, y0.w);
        if (d == 0) *(u32x2*)(Yf + (size_t)(tok0 + t) * 1024 + 512 + h * 64 + rowbase + r4) = w2; else *(u32x2*)(Yb + (size_t)(tok0 + t) * 512 + h * 64 + rowbase + r4) = w2;
    }
}
template <int R>
__device__ __forceinline__ void scan_item(const Args& a, int layer, int q, int rowhalf, LAS unsigned char* lds, int tid, int lane, int wave) {
    int tok0, T, h, d;
    if (q < 32) { tok0 = MP + (q >> 4) * TS; T = TS; h = (q >> 1) & 7; d = q & 1; } else { const int q2 = q - 32; tok0 = (q2 >> 4) * TP; T = TP; h = (q2 >> 1) & 7; d = q2 & 1; }
    const int nch = T / SC_CH, rowbase = rowhalf * 16 * R;
    unsigned char* ws = a.ws; const int g = q < 32 ? 1 : 0;
    const h16* RR = GB_RR(g); const h16* RK = GB_RK(g); const h16* RV = GB_RV(g); const h16* LOWS = GB_LOWS(g);
    h16* Yf = GB_MIX(g); h16* Yb = GB_YB(g); float* BSC = GB_BSC(g);
    const size_t l = (size_t)layer;
    if (wave >= 4) {
        const int pw = wave - 4, j = lane, col = h * 64 + j;
        const float* mu = a.in[I_MU] + l * 1920;
        const float mu_r = mu[col], mu_k = mu[512 + col], mu_v = mu[1024 + col], mu_wl = mu[1536 + d * 64 + j], mu_al = mu[1536 + 128 + d * 64 + j];
        const float k_k = a.in[I_KK][l * 512 + col], k_a = a.in[I_KA][l * 512 + col], r_k = a.in[I_RK][l * 512 + col];
        const float w0 = a.in[I_W0][(l * 2 + d) * 512 + col], a0 = a.in[I_A0][(l * 2 + d) * 512 + col];
        h16x8 bw[4][2], ba[4][2];
        { const int n = lane & 15, kg = lane >> 4;
          const float* wu = a.in[I_WUP] + ((l * 2 + d) * 64 + 8 * kg) * 512 + h * 64 + n; const float* au = a.in[I_AUP] + ((l * 2 + d) * 64 + 8 * kg) * 512 + h * 64 + n;
#pragma unroll
          for (int ks = 0; ks < 2; ++ks) {
#pragma unroll
              for (int e = 0; e < 8; ++e) {
                  const float w_0 = wu[0], w_1 = wu[16], w_2 = wu[32], w_3 = wu[48], a_0 = au[0], a_1 = au[16], a_2 = au[32], a_3 = au[48];
                  wu += 512; au += 512; asm volatile("" : "+v"(wu), "+v"(au));
                  bw[0][ks][e] = (h16)w_0; bw[1][ks][e] = (h16)w_1; bw[2][ks][e] = (h16)w_2; bw[3][ks][e] = (h16)w_3;
                  ba[0][ks][e] = (h16)a_0; ba[1][ks][e] = (h16)a_1; ba[2][ks][e] = (h16)a_2; ba[3][ks][e] = (h16)a_3; }
              wu += 24 * 512; au += 24 * 512; asm volatile("" : "+v"(wu), "+v"(au)); } }
        LAS float* zl = (LAS float*)(lds + SC_ZOFF + pw * 4096);
        LAS unsigned char* xsb = lds + SC_XOFF + pw * 2048;
        ScanWin cur, nxt;
#define SCAN_LOAD_WIN(W_, cp_) do { const int g0_ = (cp_) * SC_CH + pw * 8; \
            _Pragma("unroll") for (int w = 0; w < 10; ++w) { const int tt = d ? (T - 1 - g0_) + 1 - w : g0_ - 1 + w; const bool ok = (tt >= 0) && (tt < T); const size_t tok = (size_t)(tok0 + (ok ? tt : 0)); \
                const h16 z_ = (h16)0.f; const h16 r_ = RR[tok * 512 + col], k_ = RK[tok * 512 + col], v_ = RV[tok * 512 + col], wl_ = LOWS[tok * 384 + d * 64 + j], al_ = LOWS[tok * 384 + 128 + d * 64 + j]; \
                W_.r[w] = (float)(ok ? r_ : z_); W_.k[w] = (float)(ok ? k_ : z_); W_.v[w] = (float)(ok ? v_ : z_); W_.wl[w] = (float)(ok ? wl_ : z_); W_.al[w] = (float)(ok ? al_ : z_); } } while (0)
        SCAN_LOAD_WIN(cur, 0);
        for (int c = -1; c < nch; ++c) {
            if (c >= 1) scan_flush<R>(lds, c - 1, pw, lane, d, T, tok0, h, rowbase, Yf, Yb);
            if (c + 1 < nch) {
                const int cp = c + 1; LAS float* op = (LAS float*)(lds + (cp & 1) * SC_OPB);
                if (c + 2 < nch) SCAN_LOAD_WIN(nxt, c + 2);
#pragma unroll
                for (int s8 = 0; s8 < 8; ++s8) {
                    const float wl = mix3f(cur.wl[s8], cur.wl[s8 + 1], cur.wl[s8 + 2], mu_wl);
                    const float al = mix3f(cur.al[s8], cur.al[s8 + 1], cur.al[s8 + 2], mu_al);
                    const float e2 = __expf(2.0f * wl); const float th = 1.0f - 2.0f * __builtin_amdgcn_rcpf(e2 + 1.0f);
                    LAS h16* xs = (LAS h16*)(xsb + s8 * 256);
                    xs[j] = (h16)th; xs[64 + j] = (h16)al;
                }
                {
                    const LAS unsigned char* xr = xsb + (lane & 7) * 256 + (lane >> 4) * 16;
                    const h16x8 xw0 = *(const LAS h16x8a*)(xr), xw1 = *(const LAS h16x8a*)(xr + 64), xa0 = *(const LAS h16x8a*)(xr + 128), xa1 = *(const LAS h16x8a*)(xr + 192);
                    f32x4 accw[4], acca[4];
#pragma unroll
                    for (int nt = 0; nt < 4; ++nt) {
                        accw[nt] = __builtin_amdgcn_mfma_f32_16x16x32_f16(xw0, bw[nt][0], (f32x4){0.f, 0.f, 0.f, 0.f}, 0, 0, 0);
                        accw[nt] = __builtin_amdgcn_mfma_f32_16x16x32_f16(xw1, bw[nt][1], accw[nt], 0, 0, 0);
                        acca[nt] = __builtin_amdgcn_mfma_f32_16x16x32_f16(xa0, ba[nt][0], (f32x4){0.f, 0.f, 0.f, 0.f}, 0, 0, 0);
                        acca[nt] = __builtin_amdgcn_mfma_f32_16x16x32_f16(xa1, ba[nt][1], acca[nt], 0, 0, 0); }
                    if (lane < 32) {
                        LAS float* zw = zl + (4 * (lane >> 4)) * 64 + (lane & 15);
#pragma unroll
                        for (int nt = 0; nt < 4; ++nt)
#pragma unroll
                            for (int r = 0; r < 4; ++r) { zw[r * 64 + 16 * nt] = accw[nt][r]; zw[512 + r * 64 + 16 * nt] = acca[nt][r]; }
                    }
                }
#pragma unroll
                for (int s8 = 0; s8 < 8; ++s8) {
                    const int s = pw * 8 + s8; const int g = cp * SC_CH + s; const int t = d ? (T - 1 - g) : g; const size_t tok = (size_t)(tok0 + t);
                    const float rr = mix3f(cur.r[s8], cur.r[s8 + 1], cur.r[s8 + 2], mu_r);
                    const float kk0 = mix3f(cur.k[s8], cur.k[s8 + 1], cur.k[s8 + 2], mu_k);
                    const float vv = mix3f(cur.v[s8], cur.v[s8 + 1], cur.v[s8 + 2], mu_v);
                    const float z = w0 + zl[s8 * 64 + j], az = a0 + zl[512 + s8 * 64 + j];
                    const float wdec = __expf(-0.606531f * sigmoidf_(z)); const float av = sigmoidf_(az);
                    float kk = kk0 * k_k; const float n2 = wave_sum_fast(kk * kk); kk = kk * __builtin_amdgcn_rsqf(fmaxf(n2, 1e-24f));
                    const float kd = kk0 * (1.0f + (av - 1.0f) * k_a); const float bb = kk * av;
                    const float bs = wave_sum_fast(rr * kd * r_k);
                    if (lane == 0 && rowhalf == 0) BSC[(tok * 8 + h) * 2 + d] = bs;
                    LAS float* o = op + s * 384 + j;
                    o[0] = -kk; o[64] = wdec; o[128] = bb; o[192] = kd; o[256] = rr; o[320] = vv;
                }
                cur = nxt;
            }
            __syncthreads();
        }
        scan_flush<R>(lds, nch - 1, pw, lane, d, T, tok0, h, rowbase, Yf, Yb);
#undef SCAN_LOAD_WIN
    } else {
        constexpr int RL = R / 2;
        const int ri = lane >> 3, ci = lane & 7;
        const int yrow = wave * 8 * RL + ri * RL, vrow = rowbase + yrow;
        f32x2 S[RL][4];
#pragma unroll
        for (int i = 0; i < RL; ++i)
#pragma unroll
            for (int c2 = 0; c2 < 4; ++c2) S[i][c2] = (f32x2){0.f, 0.f};
        typedef float vecR __attribute__((ext_vector_type(RL)));
        __syncthreads();
        for (int c = 0; c < nch; ++c) {
            const LAS f32x4* op = (const LAS f32x4*)(lds + (c & 1) * SC_OPB);
            LAS float* yb = (LAS float*)(lds + SC_YOFF + (c & 1) * SC_YB);
            f32x4 a0 = op[2 * ci], a1 = op[2 * ci + 1], w0 = op[16 + 2 * ci], w1 = op[17 + 2 * ci], b0 = op[32 + 2 * ci], b1 = op[33 + 2 * ci];
            f32x4 k0 = op[48 + 2 * ci], k1 = op[49 + 2 * ci], r0 = op[64 + 2 * ci], r1 = op[65 + 2 * ci]; vecR v4 = *(const LAS vecR*)((const LAS float*)op + 320 + vrow);
#pragma unroll 4
            for (int s = 0; s < SC_CH; ++s) {
                const LAS f32x4* on = op + (s + 1) * 96;
                const f32x4 na0 = on[2 * ci], na1 = on[2 * ci + 1], nw0 = on[16 + 2 * ci], nw1 = on[17 + 2 * ci], nb0 = on[32 + 2 * ci], nb1 = on[33 + 2 * ci];
                const f32x4 nk0 = on[48 + 2 * ci], nk1 = on[49 + 2 * ci], nr0 = on[64 + 2 * ci], nr1 = on[65 + 2 * ci]; const vecR nv4 = *(const LAS vecR*)((const LAS float*)on + 320 + vrow);
                const f32x2 av[4] = {{a0.x, a0.y}, {a0.z, a0.w}, {a1.x, a1.y}, {a1.z, a1.w}}, wv[4] = {{w0.x, w0.y}, {w0.z, w0.w}, {w1.x, w1.y}, {w1.z, w1.w}};
                const f32x2 bv[4] = {{b0.x, b0.y}, {b0.z, b0.w}, {b1.x, b1.y}, {b1.z, b1.w}}, kv[4] = {{k0.x, k0.y}, {k0.z, k0.w}, {k1.x, k1.y}, {k1.z, k1.w}};
                const f32x2 rv[4] = {{r0.x, r0.y}, {r0.z, r0.w}, {r1.x, r1.y}, {r1.z, r1.w}};
                float sa[RL];
#pragma unroll
                for (int i = 0; i < RL; ++i) { f32x2 p = S[i][0] * av[0]; p = S[i][1] * av[1] + p; p = S[i][2] * av[2] + p; p = S[i][3] * av[3] + p;
                    float t = p.x + p.y; t += dpp_f<0xB1>(t); t += dpp_f<0x4E>(t); t += dpp_f<0x141>(t); sa[i] = t; }
                vecR y;
#pragma unroll
                for (int i = 0; i < RL; ++i) { const f32x2 sa2 = {sa[i], sa[i]}, v2 = {v4[i], v4[i]};
#pragma unroll
                    for (int c2 = 0; c2 < 4; ++c2) S[i][c2] = S[i][c2] * wv[c2] + sa2 * bv[c2] + v2 * kv[c2];
                    f32x2 p = S[i][0] * rv[0]; p = S[i][1] * rv[1] + p; p = S[i][2] * rv[2] + p; p = S[i][3] * rv[3] + p;
                    float t = p.x + p.y; t += dpp_f<0xB1>(t); t += dpp_f<0x4E>(t); t += dpp_f<0x141>(t); y[i] = t; }
                if (ci == 0) *(LAS vecR*)(yb + s * (32 * RL) + yrow) = y;
                a0 = na0; a1 = na1; w0 = nw0; w1 = nw1; b0 = nb0; b1 = nb1; k0 = nk0; k1 = nk1; r0 = nr0; r1 = nr1; v4 = nv4;
            }
            __syncthreads();
        }
    }
}

__device__ __forceinline__ void rwpost_tile(const Args& a, int layer, int tile, LAS unsigned char* lds, int tid, int lane, int wave, const h16x2 (&gup)[64]) {
    const size_t l = (size_t)layer; const int col = tid, h = wave;
    const int m0 = tile * 64; int tok0s, T; if (m0 < MP) { T = TP; tok0s = (m0 / TP) * TP; } else { T = TS; tok0s = MP + ((m0 - MP) / TS) * TS; }
    unsigned char* ws = a.ws; const int g = m0 < MP ? 0 : 1;
    const h16* LOWS = GB_LOWS(g); const h16* RV = GB_RV(g); h16* MIX = GB_MIX(g); const h16* Yb = GB_YB(g); const float* BSC = GB_BSC(g);
    const float* mu = a.in[I_MU] + l * 1920;
    LAS h16* G = (LAS h16*)lds;
    { const int c = tid & 127; const float mug = mu[1536 + 256 + c];
#pragma unroll 4
      for (int e = tid; e < 64 * 128; e += NTHREADS) { const int tk = e >> 7; const int m = m0 + tk; const int t = m - tok0s;
        const float gl = shiftmix(LOWS + (size_t)m * 384 + 256 + c, 384, t, T, mug); G[e] = (h16)sigmoidf_(gl); } }
    const float mu_v = mu[1024 + col], lw = a.in[I_LNW][l * 512 + col], lb = a.in[I_LNB][l * 512 + col];
    __syncthreads();
#pragma unroll 1
    for (int tk0 = 0; tk0 < 64; tk0 += 8) {
        h16 ym[8], yb[8], rv[10]; float b0[8], b1[8];
#pragma unroll
        for (int w = 0; w < 10; ++w) { const int m = m0 + tk0 - 1 + w; const int t = m - tok0s; const bool ok = (t >= 0) && (t < T); const h16 v = RV[(size_t)(ok ? m : m0) * 512 + col]; rv[w] = ok ? v : (h16)0.f; }
#pragma unroll
        for (int jj = 0; jj < 8; ++jj) { const size_t m = (size_t)(m0 + tk0 + jj); ym[jj] = MIX[m * 1024 + 512 + col]; yb[jj] = Yb[m * 512 + col]; b0[jj] = BSC[(m * 8 + h) * 2]; b1[jj] = BSC[(m * 8 + h) * 2 + 1]; }
#pragma unroll
        for (int jj = 0; jj < 8; ++jj) {
            const int tk = tk0 + jj; const size_t m = (size_t)(m0 + tk);
            float gg = 0.f;
#pragma unroll
            for (int c8 = 0; c8 < 16; ++c8) { const u32x4 x = *(const LAS u32x4a*)((const LAS unsigned char*)G + tk * 256 + c8 * 16);
                gg = dot8w(x, gup[c8 * 4 + 0], gup[c8 * 4 + 1], gup[c8 * 4 + 2], gup[c8 * 4 + 3], gg); }
            const float wkv = (float)ym[jj] + (float)yb[jj];
            const float mean = wave_sum_fast(wkv) * (1.0f / 64.0f); const float dv = wkv - mean; const float var = wave_sum_fast(dv * dv) * (1.0f / 64.0f);
            const float yn = dv * __builtin_amdgcn_rsqf(var + 64e-5f) * lw + lb;
            const float vv = mix3(rv[jj], rv[jj + 1], rv[jj + 2], mu_v);
            MIX[m * 1024 + 512 + col] = (h16)((yn + (b0[jj] + b1[jj]) * vv) * gg);
        }
    }
    __syncthreads();
}

#define STAGE_ARGS const Args& args, int layer, int g, int nb, int cb, LAS unsigned char* lds
#define FRESH_TID int tid = threadIdx.x; asm volatile("" : "+v"(tid)); const int lane = tid & 63, wave = __builtin_amdgcn_readfirstlane(tid >> 6); (void)lane; (void)wave;
__device__ __forceinline__ int g_rows(int g) { return g ? MS : MP; }
__device__ __forceinline__ int g_pm0(int g) { return g ? MP / 256 : 0; }
template <class Epi> __device__ __forceinline__ void run_gemm(LAS unsigned char* lds, const h16* A, int lda, const h16* Bt, int N, int K, int g, int nb, int cb, const Epi& E, int tid) {
    pg8::Gemm gm{A, Bt, g_rows(g), N, K, lda}; pg8::StaticOrder S; S.init(g_rows(g), N, nb, cb, g_pm0(g)); pg8::gemm_phase(lds, gm, S, E, tid);
}
__device__ __forceinline__ void st_ffn_up(STAGE_ARGS, int which) {
    FRESH_TID unsigned char* ws = args.ws; const h16* W = (const h16*)(ws + WS_W);
    pg8::EpiSwiglu E{GB_ACT(g), (const float*)(ws + (which ? WS_SSA : WS_SSB))};
    run_gemm(lds, which ? GB_H16(g) : GB_H16B(g), D, W + (which ? W_FFN2U : W_FFN1U), 2 * FF, D, g, nb, cb, E, tid);
}
__device__ __forceinline__ void st_ffn_down(STAGE_ARGS, int which) {
    FRESH_TID unsigned char* ws = args.ws; const h16* W = (const h16*)(ws + WS_W); float* out = args.out;
    const bool first = (which == 0 && layer == 0);
    const float* rp = first ? args.in[I_XP] : (const float*)out; const float* rsm = first ? args.in[I_XS] - (size_t)MP * D : (const float*)out;
    pg8::EpiResid E{rp, rsm, out, GB_H16(g), (float*)(ws + WS_SSA), 0.5f};
    run_gemm(lds, GB_ACT(g), FF, W + (which ? W_FFN2D : W_FFN1D), D, FF, g, nb, cb, E, tid);
}
__device__ __forceinline__ void st_win(STAGE_ARGS) {
    FRESH_TID unsigned char* ws = args.ws; const h16* W = (const h16*)(ws + WS_W);
    pg8::EpiProj E{GB_MIX(g), GB_KNA(g), (size_t)512 * g_rows(g), GB_LOWS(g), (const float*)(ws + WS_SSA)};
    run_gemm(lds, GB_H16(g), D, W + W_IN, NPROJ, D, g, nb, cb, E, tid);
}
__device__ __forceinline__ void st_wout(STAGE_ARGS) {
    FRESH_TID unsigned char* ws = args.ws; const h16* W = (const h16*)(ws + WS_W); float* out = args.out;
    pg8::EpiResid E{out, out, out, GB_H16(g), (float*)(ws + WS_SSA), 1.0f};
    run_gemm(lds, GB_MIX(g), D, W + W_OUT, D, D, g, nb, cb, E, tid);
}
__device__ __forceinline__ void st_pu(STAGE_ARGS) {
    FRESH_TID unsigned char* ws = args.ws; const h16* W = (const h16*)(ws + WS_W);
    int kpu = PLE; asm volatile("" : "+s"(kpu));
    pg8::EpiPU E{GB_PU(g)};
    run_gemm(lds, GB_P16(g), kpu, W + W_UP, D, kpu, g, nb, cb, E, tid);
}
__device__ __forceinline__ void st_ple(STAGE_ARGS) {
    FRESH_TID unsigned char* ws = args.ws; const h16* W = (const h16*)(ws + WS_W); float* out = args.out;
    pg8::EpiPle E{out, GB_H16B(g), (float*)(ws + WS_SSB), (const float*)(ws + WS_SSA), GB_PU(g)};
    run_gemm(lds, GB_H16(g), D, W + W_GATE, D, D, g, nb, cb, E, tid);
}
__device__ __forceinline__ void st_rwpost(STAGE_ARGS) {
    FRESH_TID const int t0 = g ? MP / 64 : 0, nt = g_rows(g) / 64;
    h16x2 gup[64];
    { const float* gu = args.in[I_GUP] + (size_t)layer * 128 * 512 + tid;
#pragma unroll
      for (int i2 = 0; i2 < 64; ++i2) { const float g0 = gu[0], g1 = gu[512]; gu += 1024; asm volatile("" : "+v"(gu)); gup[i2] = (h16x2){(h16)g0, (h16)g1}; } }
    for (int tile = cb; tile < nt; tile += nb) rwpost_tile(args, layer, t0 + tile, lds, tid, lane, wave, gup);
}
__device__ __forceinline__ void st_convp(STAGE_ARGS) { FRESH_TID convert_p(args, layer, g, nb, cb, tid); }

__device__ __forceinline__ void sub_sync(unsigned* ctr, unsigned target) {
    asm volatile("s_waitcnt vmcnt(0) lgkmcnt(0)" ::: "memory");
    __syncthreads();
    if (threadIdx.x == 0) {
        __builtin_amdgcn_fence(__ATOMIC_RELEASE, "agent"); asm volatile("s_waitcnt vmcnt(0)" ::: "memory");
        __hip_atomic_fetch_add(ctr, 1u, __ATOMIC_RELAXED, __HIP_MEMORY_SCOPE_AGENT);
        while (__hip_atomic_load(ctr, __ATOMIC_RELAXED, __HIP_MEMORY_SCOPE_AGENT) < target) __builtin_amdgcn_s_sleep(2);
    }
    __syncthreads();
    __builtin_amdgcn_fence(__ATOMIC_ACQUIRE, "agent"); asm volatile("s_waitcnt vmcnt(0)" ::: "memory");
}

constexpr int NSB = 32;
__global__ void __launch_bounds__(NTHREADS, 2) fwd_megakernel(Args args) {
    extern __shared__ __attribute__((aligned(16))) unsigned char lds_raw[];
    LAS unsigned char* lds = (LAS unsigned char*)lds_raw;
    cg::grid_group grid = cg::this_grid();
    const int bid = blockIdx.x, G = gridDim.x;
    const int NPB = G - NSB, pb = bid - NSB;
    unsigned* ctr = (unsigned*)(args.ws + WS_CTR);
    if (bid == 0 && threadIdx.x == 0) __hip_atomic_store(ctr, 0u, __ATOMIC_RELAXED, __HIP_MEMORY_SCOPE_AGENT);
    unsigned sbt = 0;
#define SUBSYNC() do { sbt += (unsigned)NPB; sub_sync(ctr, sbt); } while (0)

    for (int layer = 0; layer < 2; ++layer) {
        { FRESH_TID phase_convert(args, layer, lds, tid, lane, wave, bid, G); }
        grid_sync(grid);
        st_ffn_up(args, layer, 1, G, bid, lds, 0); grid_sync(grid);
        st_ffn_down(args, layer, 1, G, bid, lds, 0); grid_sync(grid);
        st_win(args, layer, 1, G, bid, lds); grid_sync(grid);
        { FRESH_TID for (int it = 1024 + bid; it < 1536; it += G) na_item(args, layer, it, lds, tid, lane, wave); }
        grid_sync(grid);
        if (bid < NSB) {
            FRESH_TID scan_item<4>(args, layer, bid, 0, lds, tid, lane, wave);
        } else {
            st_ffn_up(args, layer, 0, NPB, pb, lds, 0); SUBSYNC();
            st_ffn_down(args, layer, 0, NPB, pb, lds, 0); SUBSYNC();
            st_win(args, layer, 0, NPB, pb, lds); SUBSYNC();
            { FRESH_TID
              scan_item<4>(args, layer, 32 + pb, 0, lds, tid, lane, wave); __syncthreads();
              if (pb < 2 * (256 - NPB)) { scan_item<2>(args, layer, 32 + NPB + (pb >> 1), pb & 1, lds, tid, lane, wave); __syncthreads(); }
              else { for (int it = pb - 2 * (256 - NPB); it < 1024; it += NPB - 2 * (256 - NPB)) na_item(args, layer, it, lds, tid, lane, wave); } }
            SUBSYNC();
            st_rwpost(args, layer, 0, NPB, pb, lds); SUBSYNC();
            st_wout(args, layer, 0, NPB, pb, lds); SUBSYNC();
            st_ffn_up(args, layer, 0, NPB, pb, lds, 1);
        }
        grid_sync(grid);
        st_rwpost(args, layer, 1, G, bid, lds); st_ffn_down(args, layer, 0, G, bid, lds, 1); st_convp(args, layer, 0, G, bid, lds); grid_sync(grid);
        st_wout(args, layer, 1, G, bid, lds); st_pu(args, layer, 0, G, bid, lds); grid_sync(grid);
        st_ffn_up(args, layer, 1, G, bid, lds, 1); st_ple(args, layer, 0, G, bid, lds); grid_sync(grid);
        st_ffn_down(args, layer, 1, G, bid, lds, 1); st_convp(args, layer, 1, G, bid, lds); grid_sync(grid);
        st_pu(args, layer, 1, G, bid, lds); grid_sync(grid);
        st_ple(args, layer, 1, G, bid, lds); grid_sync(grid);
    }
    {
        FRESH_TID
        const float* SSB = (const float*)(args.ws + WS_SSB); float* out = args.out;
        const int gw = bid * NWAVES + wave, NGW = G * NWAVES; const f32x4* gm = (const f32x4*)args.in[I_FINAL] + lane;
        f32x4 gv[4];
#pragma unroll
        for (int j = 0; j < 4; ++j) gv[j] = gm[64 * j];
        for (int m = gw; m < M; m += 2 * NGW) {
            const int m2 = m + NGW;
            const float rs = row_rstd(SSB, m), rs2 = row_rstd(SSB, m2); f32x4* o = (f32x4*)(out + (size_t)m * D) + lane; f32x4* o2 = (f32x4*)(out + (size_t)m2 * D) + lane;
            f32x4 v[4], v2[4];
#pragma unroll
            for (int j = 0; j < 4; ++j) { v[j] = o[64 * j]; v2[j] = o2[64 * j]; }
#pragma unroll
            for (int j = 0; j < 4; ++j) { o[64 * j] = v[j] * rs * gv[j]; o2[64 * j] = v2[j] * rs2 * gv[j]; }
        }
    }
}

extern "C" void kernel_launch(void* const* d_in, const int* in_sizes, int n_in, void* d_out, int out_size, void* d_ws, size_t ws_size, hipStream_t stream) {
    static int grid = 0;
    if (grid == 0) {
        if (n_in != N_IN || out_size != M * D || ws_size < WS_END) { fprintf(stderr, "kernel_launch: unexpected shapes (n_in %d, out %d, ws %zu)\n", n_in, out_size, ws_size); grid = -1; return; }
        int dev = 0, cus = 0, per_cu = 0;
        (void)hipGetDevice(&dev); (void)hipDeviceGetAttribute(&cus, hipDeviceAttributeMultiprocessorCount, dev);
        (void)hipFuncSetAttribute((const void*)fwd_megakernel, hipFuncAttributeMaxDynamicSharedMemorySize, LDS_BYTES);
        (void)hipOccupancyMaxActiveBlocksPerMultiprocessor(&per_cu, (const void*)fwd_megakernel, NTHREADS, LDS_BYTES);
        if (per_cu < 1) fprintf(stderr, "kernel_launch: occupancy query says %d blocks per CU\n", per_cu);
        grid = cus;
        if (grid != 256) fprintf(stderr, "kernel_launch: grid %d (expected 256)\n", grid);
        if (grid <= NSB + 64) { fprintf(stderr, "kernel_launch: grid too small\n"); grid = -1; return; }
    }
    if (grid < 0) return;
    Args a{};
    for (int i = 0; i < N_IN; ++i) a.in[i] = (const float*)d_in[i];
    a.out = (float*)d_out; a.ws = (unsigned char*)d_ws;
    void* kargs[] = {&a};
    hipError_t e = hipLaunchCooperativeKernel((const void*)fwd_megakernel, dim3(grid), dim3(NTHREADS), kargs, LDS_BYTES, stream);
    if (e != hipSuccess) fprintf(stderr, "kernel_launch: cooperative launch failed: %s\n", hipGetErrorString(e));
}
```

```cpp
#include <hip/hip_runtime.h>
#include <hip/hip_cooperative_groups.h>
#include <cstdio>
#include <cstdint>
namespace cg = cooperative_groups;
#ifndef PHM
#define PHM 0xFFFF
#endif
#define PH(k) ((PHM >> (k)) & 1)

#define LAS __attribute__((address_space(3)))
typedef _Float16 h16;
typedef _Float16 h16x2 __attribute__((ext_vector_type(2)));
typedef _Float16 h16x4 __attribute__((ext_vector_type(4)));
typedef _Float16 h16x8 __attribute__((ext_vector_type(8)));
typedef _Float16 h16x8a __attribute__((ext_vector_type(8), may_alias));
typedef float f32x2 __attribute__((ext_vector_type(2)));
typedef float f32x4 __attribute__((ext_vector_type(4)));
typedef float f32x16 __attribute__((ext_vector_type(16)));
typedef unsigned u32x2 __attribute__((ext_vector_type(2)));
typedef unsigned u32x4 __attribute__((ext_vector_type(4)));
typedef unsigned u32x4a __attribute__((ext_vector_type(4), may_alias));

constexpr int D = 1024, FF = 2816, MP = 65536, MS = 32768, M = MP + MS, TP = 4096, TS = 16384, PLE = 256;
constexpr int NPROJ = 3584;
constexpr int NTHREADS = 512, NWAVES = 8;
constexpr int LDS_BYTES = 151552;
constexpr size_t MiB = 1u << 20;
constexpr size_t WS_CTR = 256;
constexpr size_t WS_W = 1 * MiB;
constexpr size_t WS_SSA = 46 * MiB;
constexpr size_t WS_SSB = 52 * MiB;
constexpr size_t REG_P = 58 * MiB, REG_S = 682 * MiB, WS_END = 994 * MiB;
constexpr size_t OFF_H16 = 0;
constexpr size_t OFF_MIX = 2048;
constexpr size_t OFF_KNA = 4096, OFF_VNA = 5120, OFF_RR = 6144, OFF_RK = 7168, OFF_RV = 8192;
constexpr size_t OFF_LOWS = 9216;
constexpr size_t OFF_ACT = 2048;
constexpr size_t OFF_P16 = 7680;
constexpr size_t OFF_PU = 2048;
constexpr size_t OFF_H16B = 7680;
constexpr size_t OFF_YB = 0, OFF_BSC = 1024;
constexpr size_t OFF_END = 9984;
static_assert(REG_P + OFF_END * MP <= REG_S && REG_S + OFF_END * MS <= WS_END, "group regions");
__device__ __forceinline__ unsigned char* gbuf(unsigned char* ws, int g, size_t off, size_t stride) {
    const size_t reg = g ? REG_S : REG_P, rows = g ? (size_t)MS : (size_t)MP, row0 = g ? (size_t)MP : 0;
    return ws + (reg + off * rows - row0 * stride);
}
#define GB_H16(g)  ((h16*)gbuf(ws, g, OFF_H16, 2048))
#define GB_H16B(g) ((h16*)gbuf(ws, g, OFF_H16B, 2048))
#define GB_MIX(g)  ((h16*)gbuf(ws, g, OFF_MIX, 2048))
#define GB_KNA(g)  ((h16*)gbuf(ws, g, OFF_KNA, 1024))
#define GB_VNA(g)  ((h16*)gbuf(ws, g, OFF_VNA, 1024))
#define GB_RR(g)   ((h16*)gbuf(ws, g, OFF_RR, 1024))
#define GB_RK(g)   ((h16*)gbuf(ws, g, OFF_RK, 1024))
#define GB_RV(g)   ((h16*)gbuf(ws, g, OFF_RV, 1024))
#define GB_LOWS(g) ((h16*)gbuf(ws, g, OFF_LOWS, 768))
#define GB_ACT(g)  ((h16*)gbuf(ws, g, OFF_ACT, 5632))
#define GB_P16(g)  ((h16*)gbuf(ws, g, OFF_P16, 512))
#define GB_PU(g)   ((h16*)gbuf(ws, g, OFF_PU, 2048))
#define GB_YB(g)   ((h16*)gbuf(ws, g, OFF_YB, 1024))
#define GB_BSC(g)  ((float*)gbuf(ws, g, OFF_BSC, 64))
constexpr size_t W_FFN1U = 0;
constexpr size_t W_FFN1D = W_FFN1U + (size_t)5632 * 1024;
constexpr size_t W_IN = W_FFN1D + (size_t)1024 * 2816;
constexpr size_t W_OUT = W_IN + (size_t)3584 * 1024;
constexpr size_t W_FFN2U = W_OUT + (size_t)1024 * 1024;
constexpr size_t W_FFN2D = W_FFN2U + (size_t)5632 * 1024;
constexpr size_t W_GATE = W_FFN2D + (size_t)1024 * 2816;
constexpr size_t W_UP = W_GATE + (size_t)1024 * 1024;
constexpr size_t W_ENDE = W_UP + (size_t)1024 * 256;
static_assert(WS_W + W_ENDE * 2 <= WS_SSA, "weights fit");

enum { I_XP = 0, I_XS, I_PP, I_PS, I_F1N, I_F1G, I_F1U, I_F1D, I_MIXN, I_WIN, I_RPB, I_MU, I_W0, I_WUP, I_A0, I_AUP, I_GUP, I_KK, I_KA, I_RK, I_LNW, I_LNB,
       I_WOUT, I_F2N, I_F2G, I_F2U, I_F2D, I_PLEN, I_PLEG, I_PLEU, I_FINAL, N_IN };
struct Args { const float* in[N_IN]; float* out; unsigned char* ws; };

__device__ __forceinline__ float wave_sum(float v) {
#pragma unroll
    for (int o = 1; o < 64; o <<= 1) v += __shfl_xor(v, o);
    return v;
}
__device__ __forceinline__ unsigned pk2h(float a, float b) { h16x2 p = {(h16)a, (h16)b}; return __builtin_bit_cast(unsigned, p); }
__device__ __forceinline__ h16x2 as_h2(unsigned u) { return __builtin_bit_cast(h16x2, u); }
__device__ __forceinline__ float dot2h(unsigned a, h16x2 b, float c) { return __builtin_amdgcn_fdot2(as_h2(a), b, c, false); }
__device__ __forceinline__ float dot8(u32x4 a, u32x4 b, float c) { const unsigned a0 = a[0], a1 = a[1], a2 = a[2], a3 = a[3], b0 = b[0], b1 = b[1], b2 = b[2], b3 = b[3];
    c = __builtin_amdgcn_fdot2(as_h2(a0), as_h2(b0), c, false); c = __builtin_amdgcn_fdot2(as_h2(a1), as_h2(b1), c, false); c = __builtin_amdgcn_fdot2(as_h2(a2), as_h2(b2), c, false); c = __builtin_amdgcn_fdot2(as_h2(a3), as_h2(b3), c, false); return c; }
__device__ __forceinline__ float dot8w(u32x4 a, h16x2 w0, h16x2 w1, h16x2 w2, h16x2 w3, float c) { const unsigned a0 = a[0], a1 = a[1], a2 = a[2], a3 = a[3];
    c = __builtin_amdgcn_fdot2(as_h2(a0), w0, c, false); c = __builtin_amdgcn_fdot2(as_h2(a1), w1, c, false); c = __builtin_amdgcn_fdot2(as_h2(a2), w2, c, false); c = __builtin_amdgcn_fdot2(as_h2(a3), w3, c, false); return c; }
__device__ __forceinline__ float fma_mix_lo(float p, unsigned v, float o) { asm("v_fma_mix_f32 %0, %1, %2, %0 op_sel_hi:[0,1,0]" : "+v"(o) : "v"(p), "v"(v)); return o; }
__device__ __forceinline__ float fma_mix_hi(float p, unsigned v, float o) { asm("v_fma_mix_f32 %0, %1, %2, %0 op_sel:[0,1,0] op_sel_hi:[0,1,0]" : "+v"(o) : "v"(p), "v"(v)); return o; }
__device__ __forceinline__ float sigmoidf_(float x) { return __builtin_amdgcn_rcpf(1.0f + __expf(-x)); }
__device__ __forceinline__ float row_rstd(const float* ss, int row) {
    const f32x4* p = (const f32x4*)(ss + (size_t)row * 16);
    const f32x4 a = p[0], b = p[1], c = p[2], d = p[3];
    const float s = ((a.x + a.y) + (a.z + a.w)) + ((b.x + b.y) + (b.z + b.w)) + ((c.x + c.y) + (c.z + c.w)) + ((d.x + d.y) + (d.z + d.w));
    return __builtin_amdgcn_rsqf(s * (1.0f / 1024.0f) + 1e-6f);
}
template <int CTRL> __device__ __forceinline__ float dpp_f(float v) { return __builtin_bit_cast(float, __builtin_amdgcn_update_dpp(0, __builtin_bit_cast(int, v), CTRL, 0xF, 0xF, true)); }
__device__ __forceinline__ float row16_sum(float v) {
    v += dpp_f<0xB1>(v);
    v += dpp_f<0x4E>(v);
    v += dpp_f<0x141>(v);
    v += dpp_f<0x140>(v);
    return v;
}
__device__ __forceinline__ void grid_sync(cg::grid_group& grid) {
    asm volatile("s_waitcnt vmcnt(0) lgkmcnt(0)" ::: "memory"); grid.sync();
    __builtin_amdgcn_fence(__ATOMIC_ACQUIRE, "agent"); asm volatile("s_waitcnt vmcnt(0)" ::: "memory"); }

namespace pg8 {
constexpr int BM = 256, BK = 64, HALF = 128, HTB = HALF * BK * 2, STAGE_BYTES = 8 * HTB, NXCD = 8, WGM = 8;
__host__ __device__ __forceinline__ int lds_byte(int r, int c) { const int st = (r >> 4) * 2 + (c >> 5), rr = r & 15, cc = c & 31, ob = rr * 64 + cc * 2; return st * 1024 + (ob ^ (((ob >> 9) & 1) << 5)); }
__host__ __device__ __forceinline__ void stage_rc(int b, int& R, int& C) { const int st = b / 1024, sb = b % 1024, swz = sb ^ (((sb >> 9) & 1) << 5); R = (st >> 1) * 16 + swz / 64; C = (st & 1) * 32 + (swz % 64) / 2; }
__host__ __device__ __forceinline__ int perm32(int rho) { const int n = rho >> 4, i = rho & 15; return 8 * (i >> 2) + 4 * n + (i & 3); }
struct Unit { int pm, pn; };
struct Gemm { const h16* A; const h16* Bt; int M, N, K, lda; };
struct StaticOrder {
    int nM, nN, nwg, G, c, pm0;
    __device__ void init(int M_, int N_, int G_, int c_, int pm0_) { nM = M_ / BM; nN = N_ / BM; nwg = nM * nN; G = G_; c = c_; pm0 = pm0_; }
    __device__ bool next(int i, Unit& u) const {
        const long L = (long)i * G + c; if (L >= nwg) return false;
        int wgid = (int)L; { const int q = nwg / NXCD, r = nwg % NXCD, xcd = wgid % NXCD, off = wgid / NXCD; wgid = (xcd < r ? xcd * (q + 1) : r * (q + 1) + (xcd - r) * q) + off; }
        const int nig = WGM * nN, gid = wgid / nig, fm = gid * WGM, gsz = (nM - fm) < WGM ? (nM - fm) : WGM;
        u.pm = pm0 + fm + ((wgid % nig) % gsz); u.pn = (wgid % nig) / gsz; return true;
    }
};
typedef f32x4 Acc[2][2][4][2];

template <class Epi>
__device__ __forceinline__ void gemm_phase(LAS unsigned char* lds, const Gemm g, const StaticOrder& S, const Epi& E, const int tid) {
    const int wid = __builtin_amdgcn_readfirstlane(tid >> 6), lane = tid & 63, wr = wid >> 2, wc = wid & 3, fr = lane & 15, fq = lane >> 4;
    const int K = g.K, nt = K / BK, lda = g.lda;
    unsigned voffA[2], voffB[2];
#pragma unroll
    for (int i = 0; i < 2; ++i) { int R, C; stage_rc(tid * 16 + i * 8192, R, C); const int Rb = Epi::PERM ? ((R & ~31) + perm32(R & 31)) : R;
        voffA[i] = (unsigned)(R * lda + C) * 2u; voffB[i] = (unsigned)(Rb * K + C) * 2u; }
    const size_t kstep = (size_t)(BK * 2);
    const size_t hstepA = (size_t)HALF * lda * 2, hstepB = (size_t)HALF * K * 2;
    const size_t tstepA = 2 * hstepA, tstepB = 2 * hstepB;
    const unsigned ldsw = (unsigned)wid * 1024u;
    const int aoff = lds_byte(wr * 64 + fr, fq * 8), boff = lds_byte(wc * 32 + fr, fq * 8);
#define PG8_SA(b, h) (((b) * 2 + (h)) * HTB)
#define PG8_SB(b, h) ((4 + (b) * 2 + (h)) * HTB)
#define PG8_STAGE(bufoff, gbase, voff) do { _Pragma("unroll") for (int _i = 0; _i < 2; ++_i) \
        __builtin_amdgcn_global_load_lds((const unsigned*)((const char*)(gbase) + (voff)[_i]), (LAS unsigned*)(lds + (bufoff) + ldsw + _i * 8192), 16, 0, 0); } while (0)
#define PG8_LDA(dst, b, h) do { _Pragma("unroll") for (int m = 0; m < 4; ++m) _Pragma("unroll") for (int k = 0; k < 2; ++k) dst[m][k] = *(const LAS h16x8*)(lds + PG8_SA(b, h) + aoff + m * 2048 + k * 1024); } while (0)
#define PG8_LDB(dst, b, h) do { _Pragma("unroll") for (int n = 0; n < 2; ++n) _Pragma("unroll") for (int k = 0; k < 2; ++k) dst[n][k] = *(const LAS h16x8*)(lds + PG8_SB(b, h) + boff + n * 2048 + k * 1024); } while (0)
#define PG8_MMA(ai, bj, At, Bt) do { __builtin_amdgcn_s_setprio(1); _Pragma("unroll") for (int m = 0; m < 4; ++m) _Pragma("unroll") for (int n = 0; n < 2; ++n) _Pragma("unroll") for (int k = 0; k < 2; ++k) \
        acc[ai][bj][m][n] = __builtin_amdgcn_mfma_f32_16x16x32_f16(Bt[n][k], At[m][k], acc[ai][bj][m][n], 0, 0, 0); __builtin_amdgcn_s_setprio(0); } while (0)
#define PG8_WAIT_V(n) asm volatile("s_waitcnt vmcnt(" #n ")" ::: "memory")
#define PG8_WAIT_L(n) asm volatile("s_waitcnt lgkmcnt(" #n ")" ::: "memory")
#define PG8_BAR __builtin_amdgcn_s_barrier()
#define PG8_SCHED __builtin_amdgcn_sched_barrier(0)
    Unit cur, nxt; int ui = 0;
    if (!S.next(0, cur)) return;
    f32x4 acc[2][2][4][2];
#pragma unroll
    for (int a = 0; a < 2; ++a)
#pragma unroll
        for (int b = 0; b < 2; ++b)
#pragma unroll
            for (int m = 0; m < 4; ++m)
#pragma unroll
                for (int n = 0; n < 2; ++n) acc[a][b][m][n] = (f32x4){0.f, 0.f, 0.f, 0.f};
    h16x8 At[4][2], B0[2][2], B1[2][2];
    const char* cA = (const char*)g.A + (size_t)cur.pm * tstepA; const char* cB = (const char*)g.Bt + (size_t)cur.pn * tstepB;
    PG8_STAGE(PG8_SB(0, 0), cB, voffB); PG8_STAGE(PG8_SB(0, 1), cB + hstepB, voffB); PG8_STAGE(PG8_SA(0, 0), cA, voffA); PG8_STAGE(PG8_SA(0, 1), cA + hstepA, voffA);
    if (wr == 1) PG8_BAR;
    PG8_WAIT_V(2); PG8_BAR;
    PG8_STAGE(PG8_SB(1, 0), cB + kstep, voffB); PG8_STAGE(PG8_SA(1, 0), cA + kstep, voffA); PG8_STAGE(PG8_SB(1, 1), cB + hstepB + kstep, voffB);
    PG8_WAIT_V(6); PG8_BAR;
    for (;;) {
        const bool has_next = S.next(ui + 1, nxt);
        const char* nA = has_next ? (const char*)g.A + (size_t)nxt.pm * tstepA : cA; const char* nB = has_next ? (const char*)g.Bt + (size_t)nxt.pn * tstepB : cB;
        for (int t = 0; t < nt; t += 2) {
            const bool last = (t == nt - 2);
            const char* a1 = cA + (size_t)(t + 1) * kstep;
            const char* a2 = last ? nA : cA + (size_t)(t + 2) * kstep; const char* b2 = last ? nB : cB + (size_t)(t + 2) * kstep;
            const char* a3 = a2 + kstep; const char* b3 = b2 + kstep;
            PG8_LDB(B0, 0, 0); PG8_LDB(B1, 0, 1); PG8_SCHED; PG8_LDA(At, 0, 0); PG8_STAGE(PG8_SA(1, 1), a1 + hstepA, voffA);
            PG8_WAIT_V(8); PG8_WAIT_L(0); PG8_BAR; PG8_MMA(0, 0, At, B0); PG8_MMA(0, 1, At, B1); PG8_BAR; PG8_SCHED;
            PG8_LDA(At, 0, 1); PG8_STAGE(PG8_SB(0, 0), b2, voffB); PG8_STAGE(PG8_SB(0, 1), b2 + hstepB, voffB); PG8_STAGE(PG8_SA(0, 0), a2, voffA);
            PG8_WAIT_V(8); PG8_WAIT_L(0); PG8_BAR; PG8_MMA(1, 0, At, B0); PG8_MMA(1, 1, At, B1); PG8_BAR; PG8_SCHED;
            PG8_LDB(B0, 1, 0); PG8_LDB(B1, 1, 1); PG8_SCHED; PG8_LDA(At, 1, 0); PG8_STAGE(PG8_SA(0, 1), a2 + hstepA, voffA);
            PG8_WAIT_V(8); PG8_WAIT_L(0); PG8_BAR; PG8_MMA(0, 0, At, B0); PG8_MMA(0, 1, At, B1); PG8_BAR; PG8_SCHED;
            PG8_LDA(At, 1, 1); PG8_STAGE(PG8_SB(1, 0), b3, voffB); PG8_STAGE(PG8_SB(1, 1), b3 + hstepB, voffB); PG8_STAGE(PG8_SA(1, 0), a3, voffA);
            PG8_WAIT_V(8); PG8_WAIT_L(0); PG8_BAR; PG8_MMA(1, 0, At, B0); PG8_MMA(1, 1, At, B1); PG8_BAR; PG8_SCHED;
        }
        if (wr == 0) PG8_BAR;
        E(acc, cur, wr, wc, fr, fq);
        if (!has_next) break;
#pragma unroll
        for (int a = 0; a < 2; ++a)
#pragma unroll
            for (int b = 0; b < 2; ++b)
#pragma unroll
                for (int m = 0; m < 4; ++m)
#pragma unroll
                    for (int n = 0; n < 2; ++n) acc[a][b][m][n] = (f32x4){0.f, 0.f, 0.f, 0.f};
        cur = nxt; cA = nA; cB = nB; ++ui;
        if (wr == 1) PG8_BAR;
    }
    PG8_WAIT_V(0);
    PG8_BAR;
#undef PG8_SA
#undef PG8_SB
#undef PG8_STAGE
#undef PG8_LDA
#undef PG8_LDB
#undef PG8_MMA
#undef PG8_WAIT_V
#undef PG8_WAIT_L
#undef PG8_BAR
#undef PG8_SCHED
}


struct EpiSwiglu {
    static constexpr bool PERM = true;
    h16* O; const float* ss;
    __device__ __forceinline__ void operator()(const Acc& acc, const Unit& u, int wr, int wc, int fr, int fq) const {
        const int row0 = u.pm * BM + wr * 64 + fr, col0 = u.pn * 128 + wc * 32 + 8 * fq;
#pragma unroll
        for (int ai = 0; ai < 2; ++ai)
#pragma unroll
            for (int m = 0; m < 4; ++m) {
                const int row = row0 + ai * HALF + m * 16; const float rs = row_rstd(ss, row);
                float o[8];
#pragma unroll
                for (int n = 0; n < 2; ++n)
#pragma unroll
                    for (int j = 0; j < 4; ++j) { const float gg = acc[ai][0][m][n][j] * rs, uu = acc[ai][1][m][n][j] * rs; o[n * 4 + j] = gg * sigmoidf_(gg) * uu; }
                u32x4 w; w.x = pk2h(o[0], o[1]); w.y = pk2h(o[2], o[3]); w.z = pk2h(o[4], o[5]); w.w = pk2h(o[6], o[7]);
                *(u32x4*)(O + (size_t)row * FF + col0) = w;
            }
    }
};
struct EpiResid {
    static constexpr bool PERM = false;
    const float* res_p; const float* res_s; float* out; h16* o16; float* ss; float alpha;
    __device__ __forceinline__ void operator()(const Acc& acc, const Unit& u, int wr, int wc, int fr, int fq) const {
        const int row0 = u.pm * BM + wr * 64 + fr, col0 = u.pn * BM + wc * 32 + 4 * fq;
        const float* res = (u.pm * BM < MP) ? res_p : res_s;
#pragma unroll
        for (int ai = 0; ai < 2; ++ai)
#pragma unroll
            for (int m = 0; m < 4; ++m) {
                const int row = row0 + ai * HALF + m * 16; const size_t off = (size_t)row * D + col0; float sq = 0.f;
#pragma unroll
                for (int bj = 0; bj < 2; ++bj)
#pragma unroll
                    for (int n = 0; n < 2; ++n) { const size_t o = off + bj * HALF + n * 16; const f32x4 r = *(const f32x4*)(res + o); const f32x4 v = r + acc[ai][bj][m][n] * alpha;
                        *(f32x4*)(out + o) = v; u32x2 w; w.x = pk2h(v.x, v.y); w.y = pk2h(v.z, v.w); *(u32x2*)(o16 + o) = w; sq += (v.x * v.x + v.y * v.y) + (v.z * v.z + v.w * v.w); }
                sq += __shfl_xor(sq, 16); sq += __shfl_xor(sq, 32);
                if (fq == 0) ss[(size_t)row * 16 + u.pn * 4 + wc] = sq;
                asm volatile("" ::: "memory");
            }
    }
};
struct EpiProj {
    static constexpr bool PERM = true;
    h16* mix; h16* kna; size_t bufstep; h16* lows; const float* ss;
    __device__ __forceinline__ void operator()(const Acc& acc, const Unit& u, int wr, int wc, int fr, int fq) const {
        const int pn = u.pn; h16* base; int ldc, c0; float sc = 1.f; int nbj = 2;
        if (pn < 2) { base = mix; ldc = 1024; c0 = pn * 256; sc = 0.125f; }
        else if (pn < 12) { base = kna + (size_t)((pn - 2) >> 1) * bufstep; ldc = 512; c0 = ((pn - 2) & 1) * 256; }
        else { base = lows; ldc = 384; c0 = (pn - 12) * 256; if (pn == 13) nbj = 1; }
        const int row0 = u.pm * BM + wr * 64 + fr, col0 = c0 + wc * 32 + 8 * fq;
#pragma unroll
        for (int ai = 0; ai < 2; ++ai)
#pragma unroll
            for (int m = 0; m < 4; ++m) {
                const int row = row0 + ai * HALF + m * 16; const float rs = row_rstd(ss, row) * sc;
#pragma unroll
                for (int bj = 0; bj < 2; ++bj) if (bj < nbj) {
                    const f32x4 v0 = acc[ai][bj][m][0] * rs, v1 = acc[ai][bj][m][1] * rs;
                    u32x4 w; w.x = pk2h(v0.x, v0.y); w.y = pk2h(v0.z, v0.w); w.z = pk2h(v1.x, v1.y); w.w = pk2h(v1.z, v1.w);
                    *(u32x4*)(base + (size_t)row * ldc + col0 + bj * HALF) = w; }
            }
    }
};
struct EpiPU {
    static constexpr bool PERM = true;
    h16* O;
    __device__ __forceinline__ void operator()(const Acc& acc, const Unit& u, int wr, int wc, int fr, int fq) const {
        const int row0 = u.pm * BM + wr * 64 + fr, col0 = u.pn * BM + wc * 32 + 8 * fq;
#pragma unroll
        for (int ai = 0; ai < 2; ++ai)
#pragma unroll
            for (int m = 0; m < 4; ++m) {
                const int row = row0 + ai * HALF + m * 16;
#pragma unroll
                for (int bj = 0; bj < 2; ++bj) {
                    const f32x4 v0 = acc[ai][bj][m][0], v1 = acc[ai][bj][m][1];
                    u32x4 w; w.x = pk2h(v0.x, v0.y); w.y = pk2h(v0.z, v0.w); w.z = pk2h(v1.x, v1.y); w.w = pk2h(v1.z, v1.w);
                    *(u32x4*)(O + (size_t)row * D + col0 + bj * HALF) = w; }
            }
    }
};
struct EpiPle {
    static constexpr bool PERM = false;
    float* out; h16* o16; float* ssw; const float* ssr; const h16* pu;
    __device__ __forceinline__ void operator()(const Acc& acc, const Unit& u, int wr, int wc, int fr, int fq) const {
        const int row0 = u.pm * BM + wr * 64 + fr, col0 = u.pn * BM + wc * 32 + 4 * fq;
#pragma unroll
        for (int ai = 0; ai < 2; ++ai)
#pragma unroll
            for (int m = 0; m < 4; ++m) {
                const int row = row0 + ai * HALF + m * 16; const size_t off = (size_t)row * D + col0; float sq = 0.f; const float rs = row_rstd(ssr, row);
#pragma unroll
                for (int bj = 0; bj < 2; ++bj)
#pragma unroll
                    for (int n = 0; n < 2; ++n) { const size_t o = off + bj * HALF + n * 16; const f32x4 r = *(const f32x4*)(out + o); const h16x4 p = *(const h16x4*)(pu + o);
                        const f32x4 a = acc[ai][bj][m][n] * rs; f32x4 v;
                        v.x = r.x + sigmoidf_(a.x) * (float)p.x; v.y = r.y + sigmoidf_(a.y) * (float)p.y; v.z = r.z + sigmoidf_(a.z) * (float)p.z; v.w = r.w + sigmoidf_(a.w) * (float)p.w;
                        *(f32x4*)(out + o) = v; u32x2 w; w.x = pk2h(v.x, v.y); w.y = pk2h(v.z, v.w); *(u32x2*)(o16 + o) = w; sq += (v.x * v.x + v.y * v.y) + (v.z * v.z + v.w * v.w); }
                sq += __shfl_xor(sq, 16); sq += __shfl_xor(sq, 32);
                if (fq == 0) ssw[(size_t)row * 16 + u.pn * 4 + wc] = sq;
                asm volatile("" ::: "memory");
            }
    }
};
}

__device__ __forceinline__ void convert_matrix(const float* W, int K, int N, const float* gamma, h16* WT, int mode, LAS float* scr, int gw, int NGW, int lane) {
    const int nblk = N / 32, nitems = (K / 64) * nblk;
    for (int item = gw; item < nitems; item += NGW) {
        const int kb = item / nblk, nb = item % nblk, k0 = 64 * kb, n0 = 32 * nb;
        const int drow0 = (mode == 0) ? n0 : ((n0 >> 7) * 256 + (n0 & 127) + (mode == 2 ? 128 : 0));
#pragma unroll 8
        for (int i = 0; i < 32; ++i) { const int kk = 2 * i + (lane >> 5); float v = W[(size_t)(k0 + kk) * N + n0 + (lane & 31)]; if (gamma) v *= gamma[k0 + kk]; scr[kk * 33 + (lane & 31)] = v; }
        asm volatile("s_waitcnt lgkmcnt(0)" ::: "memory");
        const int c = lane & 7;
#pragma unroll
        for (int j = 0; j < 4; ++j) { const int n = (lane >> 3) + 8 * j; const LAS float* s = scr + (8 * c) * 33 + n;
            u32x4 o; o.x = pk2h(s[0 * 33], s[1 * 33]); o.y = pk2h(s[2 * 33], s[3 * 33]); o.z = pk2h(s[4 * 33], s[5 * 33]); o.w = pk2h(s[6 * 33], s[7 * 33]);
            *(u32x4*)(WT + (size_t)(drow0 + n) * K + k0 + 8 * c) = o; }
        asm volatile("s_waitcnt lgkmcnt(0)" ::: "memory");
    }
}

__device__ __forceinline__ void phase_convert(const Args& a, int layer, LAS unsigned char* lds, int tid, int lane, int wave, int bid, int G) {
    LAS float* scr = (LAS float*)(lds + wave * 16384);
    const int gw = bid * NWAVES + wave, NGW = G * NWAVES;
    h16* W = (h16*)(a.ws + WS_W);
    const size_t l = (size_t)layer;
    convert_matrix(a.in[I_F1G] + l * D * FF, D, FF, a.in[I_F1N] + l * D, W + W_FFN1U, 1, scr, gw, NGW, lane);
    convert_matrix(a.in[I_F1U] + l * D * FF, D, FF, a.in[I_F1N] + l * D, W + W_FFN1U, 2, scr, gw, NGW, lane);
    convert_matrix(a.in[I_F1D] + l * FF * D, FF, D, nullptr, W + W_FFN1D, 0, scr, gw, NGW, lane);
    convert_matrix(a.in[I_WIN] + l * D * 3456, D, 3456, a.in[I_MIXN] + l * D, W + W_IN, 0, scr, gw, NGW, lane);
    convert_matrix(a.in[I_WOUT] + l * D * D, D, D, nullptr, W + W_OUT, 0, scr, gw, NGW, lane);
    convert_matrix(a.in[I_F2G] + l * D * FF, D, FF, a.in[I_F2N] + l * D, W + W_FFN2U, 1, scr, gw, NGW, lane);
    convert_matrix(a.in[I_F2U] + l * D * FF, D, FF, a.in[I_F2N] + l * D, W + W_FFN2U, 2, scr, gw, NGW, lane);
    convert_matrix(a.in[I_F2D] + l * FF * D, FF, D, nullptr, W + W_FFN2D, 0, scr, gw, NGW, lane);
    convert_matrix(a.in[I_PLEG] + l * D * D, D, D, a.in[I_PLEN] + l * D, W + W_GATE, 0, scr, gw, NGW, lane);
    convert_matrix(a.in[I_PLEU] + l * PLE * D, PLE, D, nullptr, W + W_UP, 0, scr, gw, NGW, lane);
    { u32x4* z = (u32x4*)(W + W_IN + (size_t)3456 * 1024); const int n16 = 128 * 1024 * 2 / 16;
      for (int i = bid * NTHREADS + tid; i < n16; i += G * NTHREADS) z[i] = (u32x4){0u, 0u, 0u, 0u}; }
    if (layer == 0) {
        unsigned char* ws = a.ws; h16* Hp = GB_H16B(0); h16* Hs = GB_H16B(1); float* ss = (float*)(a.ws + WS_SSB);
        for (int m = gw; m < M; m += NGW) {
            h16* H = (m < MP) ? Hp : Hs;
            const float* xr = (m < MP) ? a.in[I_XP] + (size_t)m * D : a.in[I_XS] + (size_t)(m - MP) * D;
            const f32x4* x4 = (const f32x4*)xr + lane; float s = 0.f;
            u32x2* o = (u32x2*)(H + (size_t)m * D) + lane;
#pragma unroll
            for (int j = 0; j < 4; ++j) { const f32x4 v = x4[64 * j]; s += (v.x * v.x + v.y * v.y) + (v.z * v.z + v.w * v.w); u32x2 w; w.x = pk2h(v.x, v.y); w.y = pk2h(v.z, v.w); o[64 * j] = w; }
            s = wave_sum(s);
            if (lane < 16) ss[(size_t)m * 16 + lane] = (lane == 0) ? s : 0.f;
        }
    }
}

__device__ __forceinline__ void convert_p(const Args& a, int layer, int g, int nb, int cb, int tid) {
    unsigned char* ws = a.ws; const int rows = g ? MS : MP, row0 = g ? MP : 0;
    u32x2* o = (u32x2*)(GB_P16(g) + (size_t)row0 * PLE);
    const f32x4* p = (const f32x4*)((g ? a.in[I_PS] + (size_t)layer * MS * PLE : a.in[I_PP] + (size_t)layer * MP * PLE));
    const int N4 = rows * PLE / 4;
    for (int i = cb * NTHREADS + tid; i < N4; i += nb * NTHREADS) { const f32x4 v = p[i]; u32x2 w; w.x = pk2h(v.x, v.y); w.y = pk2h(v.z, v.w); o[i] = w; }
}

constexpr int NA_PITCH = 144;
constexpr int NA_VOFF = 512 * NA_PITCH;
constexpr int NA_PP = 67;
constexpr int NA_BTOFF = 2 * 512 * NA_PITCH;
__device__ __forceinline__ void na_item(const Args& a, int layer, int item, LAS unsigned char* lds, int tid, int lane, int wave) {
    int tok0, i, rows;
    if (item < 1024) { tok0 = (item >> 6) * TP; i = item & 63; rows = 64; } else { const int it2 = item - 1024; tok0 = MP + (it2 >> 8) * TS; i = it2 & 255; rows = 256; }
    int rs = i - 4; rs = rs < 0 ? 0 : (rs > rows - 8 ? rows - 8 : rs);
    unsigned char* ws = a.ws; const int g = item < 1024 ? 0 : 1;
    h16* MIX = GB_MIX(g); const h16* KNA = GB_KNA(g); const h16* VNA = GB_VNA(g);
    const float* rpb = a.in[I_RPB] + (size_t)layer * 8 * 15 * 31;
    const int wtok0 = tok0 + rs * 64;
    const int j = lane, aw = wave;
    const int tokq = tok0 + i * 64 + j;
    int cs = j - 8; cs = cs < 0 ? 0 : (cs > 48 ? 48 : cs);
    const int l31 = lane & 31, half = lane >> 5;
    LAS float* bt = (LAS float*)(lds + NA_BTOFF) + wave * 128;
    bt[lane] = 0.f; bt[64 + lane] = 0.f;
    u32x4 kreg[8], vreg[8];
    const size_t kvoff = (size_t)(wtok0 + (tid >> 3)) * 512 + (tid & 7) * 8;
#pragma unroll
    for (int it = 0; it < 8; ++it) { kreg[it] = *(const u32x4*)(KNA + kvoff + (size_t)it * (64 * 512)); vreg[it] = *(const u32x4*)(VNA + kvoff + (size_t)it * (64 * 512)); }
#pragma unroll 1
    for (int h = 0; h < 8; ++h) {
#pragma unroll
        for (int it = 0; it < 8; ++it) { const int key = (tid >> 3) + 64 * it, ch = tid & 7;
            *(LAS u32x4*)(lds + key * NA_PITCH + ch * 16) = kreg[it]; *(LAS u32x4*)(lds + NA_VOFF + key * NA_PITCH + ch * 16) = vreg[it]; }
        h16x8 qf[2][4];
#pragma unroll
        for (int nt = 0; nt < 2; ++nt)
#pragma unroll
            for (int ks = 0; ks < 4; ++ks) qf[nt][ks] = *(const h16x8*)(MIX + (size_t)(tok0 + i * 64 + l31 + 32 * nt) * 1024 + h * 64 + 16 * ks + 8 * half);
        if (lane < 31) bt[48 + lane] = rpb[((size_t)h * 15 + (rs + aw - i + 7)) * 31 + lane];
        __syncthreads();
        if (h + 1 < 8) {
#pragma unroll
            for (int it = 0; it < 8; ++it) { kreg[it] = *(const u32x4*)(KNA + kvoff + (size_t)it * (64 * 512) + (h + 1) * 64); vreg[it] = *(const u32x4*)(VNA + kvoff + (size_t)it * (64 * 512) + (h + 1) * 64); }
        }
        f32x16 acc[2][2];
#pragma unroll
        for (int mt = 0; mt < 2; ++mt)
#pragma unroll
            for (int nt = 0; nt < 2; ++nt)
#pragma unroll
                for (int r = 0; r < 16; ++r) acc[mt][nt][r] = 0.f;
#pragma unroll
        for (int mt = 0; mt < 2; ++mt)
#pragma unroll
            for (int ks = 0; ks < 4; ++ks) {
                const h16x8 kf = *(const LAS h16x8*)(lds + (aw * 64 + 32 * mt + l31) * NA_PITCH + (16 * ks + 8 * half) * 2);
                acc[mt][0] = __builtin_amdgcn_mfma_f32_32x32x16_f16(kf, qf[0][ks], acc[mt][0], 0, 0, 0);
                acc[mt][1] = __builtin_amdgcn_mfma_f32_32x32x16_f16(kf, qf[1][ks], acc[mt][1], 0, 0, 0);
            }
        float mxq[2], lq[2];
#pragma unroll
        for (int nt = 0; nt < 2; ++nt) {
            const int qc = l31 + 32 * nt; int csq = qc - 8; csq = csq < 0 ? 0 : (csq > 48 ? 48 : csq);
            const int dlt = 4 * half - csq;
            const LAS float* bq = bt + (48 + 15 + 4 * half - qc - 32);
            float m = -3.0e38f;
#pragma unroll
            for (int mt = 0; mt < 2; ++mt)
#pragma unroll
                for (int r = 0; r < 16; ++r) { const int kr = (r & 3) + 8 * (r >> 2) + 32 * mt;
                    const float sv = acc[mt][nt][r] + bq[32 + kr]; const bool ok = (unsigned)(dlt + kr) < 16u; const float sm = ok ? sv : -1.0e30f; acc[mt][nt][r] = sm; m = fmaxf(m, sm); }
            { const auto sw = __builtin_amdgcn_permlane32_swap(__builtin_bit_cast(unsigned, m), __builtin_bit_cast(unsigned, m), false, false); const unsigned s0 = sw[0], s1 = sw[1]; m = fmaxf(__builtin_bit_cast(float, s0), __builtin_bit_cast(float, s1)); }
            float l = 0.f;
#pragma unroll
            for (int mt = 0; mt < 2; ++mt)
#pragma unroll
                for (int r = 0; r < 16; ++r) { const float p = __expf(acc[mt][nt][r] - m); acc[mt][nt][r] = p; l += p; }
            { const auto sw = __builtin_amdgcn_permlane32_swap(__builtin_bit_cast(unsigned, l), __builtin_bit_cast(unsigned, l), false, false); const unsigned s0 = sw[0], s1 = sw[1]; l = __builtin_bit_cast(float, s0) + __builtin_bit_cast(float, s1); }
            mxq[nt] = m; lq[nt] = l;
        }
        h16x8 pf[2][2][2];
#pragma unroll
        for (int kt = 0; kt < 2; ++kt)
#pragma unroll
            for (int nt = 0; nt < 2; ++nt)
#pragma unroll
                for (int sx = 0; sx < 2; ++sx)
#pragma unroll
                    for (int e = 0; e < 8; ++e) pf[kt][nt][sx][e] = (h16)acc[kt][nt][8 * sx + e];
        f32x16 o[2][2];
#pragma unroll
        for (int dm = 0; dm < 2; ++dm)
#pragma unroll
            for (int nt = 0; nt < 2; ++nt)
#pragma unroll
                for (int r = 0; r < 16; ++r) o[dm][nt][r] = 0.f;
#pragma unroll
        for (int dm = 0; dm < 2; ++dm)
#pragma unroll
            for (int kt = 0; kt < 2; ++kt)
#pragma unroll
                for (int sx = 0; sx < 2; ++sx) {
                    h16x8 vf;
                    const LAS unsigned char* vb = lds + NA_VOFF + (aw * 64 + 32 * kt + 16 * sx + 4 * half) * NA_PITCH + (l31 + 32 * dm) * 2;
#pragma unroll
                    for (int e = 0; e < 8; ++e) vf[e] = *(const LAS h16*)(vb + ((e & 3) + 8 * (e >> 2)) * NA_PITCH);
                    o[dm][0] = __builtin_amdgcn_mfma_f32_32x32x16_f16(vf, pf[kt][0][sx], o[dm][0], 0, 0, 0);
                    o[dm][1] = __builtin_amdgcn_mfma_f32_32x32x16_f16(vf, pf[kt][1][sx], o[dm][1], 0, 0, 0);
                }
        __syncthreads();
#pragma unroll
        for (int nt = 0; nt < 2; ++nt) {
            LAS float* part = (LAS float*)lds + (size_t)(aw * 64 + l31 + 32 * nt) * NA_PP;
#pragma unroll
            for (int dm = 0; dm < 2; ++dm)
#pragma unroll
                for (int r = 0; r < 16; ++r) part[(r & 3) + 8 * (r >> 2) + 4 * half + 32 * dm] = o[dm][nt][r];
            if (half == 0) { part[64] = mxq[nt]; part[65] = lq[nt]; }
        }
        __syncthreads();
        {
            const int jq = tid & 63, e8 = tid >> 6;
            float mw[8], M_ = -3.0e38f;
#pragma unroll
            for (int w = 0; w < 8; ++w) { mw[w] = ((const LAS float*)lds)[(size_t)(w * 64 + jq) * NA_PP + 64]; M_ = fmaxf(M_, mw[w]); }
            float L = 0.f, ov[8];
#pragma unroll
            for (int e = 0; e < 8; ++e) ov[e] = 0.f;
#pragma unroll
            for (int w = 0; w < 8; ++w) { const float f = __expf(mw[w] - M_); const LAS float* pw = (const LAS float*)lds + (size_t)(w * 64 + jq) * NA_PP; L += f * pw[65];
#pragma unroll
                for (int e = 0; e < 8; ++e) ov[e] += f * pw[e8 * 8 + e]; }
            const float inv = 1.0f / L;
            u32x4 w4; w4.x = pk2h(ov[0] * inv, ov[1] * inv); w4.y = pk2h(ov[2] * inv, ov[3] * inv); w4.z = pk2h(ov[4] * inv, ov[5] * inv); w4.w = pk2h(ov[6] * inv, ov[7] * inv);
            *(u32x4*)(MIX + (size_t)(tok0 + i * 64 + jq) * 1024 + h * 64 + e8 * 8) = w4;
        }
        __syncthreads();
    }
}

__device__ __forceinline__ float shiftmix(const h16* base, size_t stride, int t, int T, float mu) {
    const float c = (float)base[0];
    const float p = (t > 0) ? (float)*(base - stride) : 0.f;
    const float n = (t < T - 1) ? (float)*(base + stride) : 0.f;
    return c + mu * (0.5f * (p + n) - c);
}
constexpr int SC_CH = 32;
constexpr int SC_OPB = SC_CH * 6 * 64 * 4;
constexpr int SC_YOFF = 2 * SC_OPB;
constexpr int SC_YB = SC_CH * 64 * 4;
constexpr int SC_XOFF = SC_YOFF + 2 * SC_YB;
constexpr int SC_ZOFF = SC_XOFF + 8192;
static_assert(SC_ZOFF + 4 * 4096 <= LDS_BYTES, "scan LDS");
__device__ __forceinline__ float wave_sum_fast(float v) {
    v = row16_sum(v);
    { const auto r = __builtin_amdgcn_permlane16_swap(__builtin_bit_cast(unsigned, v), __builtin_bit_cast(unsigned, v), false, false);
      const unsigned r0 = r[0], r1 = r[1]; v = __builtin_bit_cast(float, r0) + __builtin_bit_cast(float, r1); }
    { const auto r = __builtin_amdgcn_permlane32_swap(__builtin_bit_cast(unsigned, v), __builtin_bit_cast(unsigned, v), false, false);
      const unsigned r0 = r[0], r1 = r[1]; v = __builtin_bit_cast(float, r0) + __builtin_bit_cast(float, r1); }
    return v;
}
__device__ __forceinline__ float mix3(h16 p, h16 c, h16 n, float mu) { const float cf = (float)c; return cf + mu * (0.5f * ((float)p + (float)n) - cf); }
struct ScanWin { float r[10], k[10], v[10], wl[10], al[10]; };
__device__ __forceinline__ float mix3f(float p, float c, float n, float mu) { return c + mu * (0.5f * (p + n) - c); }
template <int R>
__device__ __forceinline__ void scan_flush(LAS unsigned char* lds, int cf, int pw, int lane, int d, int T, int tok0, int h, int rowbase, h16* Yf, h16* Yb) {
    const LAS float* yb = (const LAS float*)(lds + SC_YOFF + (cf & 1) * SC_YB);
    const int s = pw * 8 + (lane >> 3); const int g = cf * SC_CH + s; const int t = d ? (T - 1 - g) : g;
    if (R == 4) {
        const int r8 = (lane & 7) * 8;
        const f32x4 y0 = *(const LAS f32x4*)(yb + s * 64 + r8), y1 = *(const LAS f32x4*)(yb + s * 64 + r8 + 4);
        u32x4 w4; w4.x = pk2h(y0.x, y0.y); w4.y = pk2h(y0.z, y0.w); w4.z = pk2h(y1.x, y1.y); w4.w = pk2h(y1.z, y1.w);
        if (d == 0) *(u32x4*)(Yf + (size_t)(tok0 + t) * 1024 + 512 + h * 64 + r8) = w4; else *(u32x4*)(Yb + (size_t)(tok0 + t) * 512 + h * 64 + r8) = w4;
    } else {
        const int r4 = (lane & 7) * 4;
        const f32x4 y0 = *(const LAS f32x4*)(yb + s * 32 + r4);
        u32x2 w2; w2.x = pk2h(y0.x, y0.y); w2.y = pk2h(y0.z, y0.w);
        if (d == 0) *(u32x2*)(Yf + (size_t)(tok0 + t) * 1024 + 512 + h * 64 + rowbase + r4) = w2; else *(u32x2*)(Yb + (size_t)(tok0 + t) * 512 + h * 64 + rowbase + r4) = w2;
    }
}
template <int R>
__device__ __forceinline__ void scan_item(const Args& a, int layer, int q, int rowhalf, LAS unsigned char* lds, int tid, int lane, int wave) {
    int tok0, T, h, d;
    if (q < 32) { tok0 = MP + (q >> 4) * TS; T = TS; h = (q >> 1) & 7; d = q & 1; } else { const int q2 = q - 32; tok0 = (q2 >> 4) * TP; T = TP; h = (q2 >> 1) & 7; d = q2 & 1; }
    const int nch = T / SC_CH, rowbase = rowhalf * 16 * R;
    unsigned char* ws = a.ws; const int g = q < 32 ? 1 : 0;
    const h16* RR = GB_RR(g); const h16* RK = GB_RK(g); const h16* RV = GB_RV(g); const h16* LOWS = GB_LOWS(g);
    h16* Yf = GB_MIX(g); h16* Yb = GB_YB(g); float* BSC = GB_BSC(g);
    const size_t l = (size_t)layer;
    if (wave >= 4) {
        const int pw = wave - 4, j = lane, col = h * 64 + j;
        const float* mu = a.in[I_MU] + l * 1920;
        const float mu_r = mu[col], mu_k = mu[512 + col], mu_v = mu[1024 + col], mu_wl = mu[1536 + d * 64 + j], mu_al = mu[1536 + 128 + d * 64 + j];
        const float k_k = a.in[I_KK][l * 512 + col], k_a = a.in[I_KA][l * 512 + col], r_k = a.in[I_RK][l * 512 + col];
        const float w0 = a.in[I_W0][(l * 2 + d) * 512 + col], a0 = a.in[I_A0][(l * 2 + d) * 512 + col];
        h16x8 bw[4][2], ba[4][2];
        { const int n = lane & 15, kg = lane >> 4;
          const float* wu = a.in[I_WUP] + ((l * 2 + d) * 64 + 8 * kg) * 512 + h * 64 + n; const float* au = a.in[I_AUP] + ((l * 2 + d) * 64 + 8 * kg) * 512 + h * 64 + n;
#pragma unroll
          for (int ks = 0; ks < 2; ++ks) {
#pragma unroll
              for (int e = 0; e < 8; ++e) {
                  const float w_0 = wu[0], w_1 = wu[16], w_2 = wu[32], w_3 = wu[48], a_0 = au[0], a_1 = au[16], a_2 = au[32], a_3 = au[48];
                  wu += 512; au += 512; asm volatile("" : "+v"(wu), "+v"(au));
                  bw[0][ks][e] = (h16)w_0; bw[1][ks][e] = (h16)w_1; bw[2][ks][e] = (h16)w_2; bw[3][ks][e] = (h16)w_3;
                  ba[0][ks][e] = (h16)a_0; ba[1][ks][e] = (h16)a_1; ba[2][ks][e] = (h16)a_2; ba[3][ks][e] = (h16)a_3; }
              wu += 24 * 512; au += 24 * 512; asm volatile("" : "+v"(wu), "+v"(au)); } }
        LAS float* zl = (LAS float*)(lds + SC_ZOFF + pw * 4096);
        LAS unsigned char* xsb = lds + SC_XOFF + pw * 2048;
        ScanWin cur, nxt;
#define SCAN_LOAD_WIN(W_, cp_) do { const int g0_ = (cp_) * SC_CH + pw * 8; \
            _Pragma("unroll") for (int w = 0; w < 10; ++w) { const int tt = d ? (T - 1 - g0_) + 1 - w : g0_ - 1 + w; const bool ok = (tt >= 0) && (tt < T); const size_t tok = (size_t)(tok0 + (ok ? tt : 0)); \
                const h16 z_ = (h16)0.f; const h16 r_ = RR[tok * 512 + col], k_ = RK[tok * 512 + col], v_ = RV[tok * 512 + col], wl_ = LOWS[tok * 384 + d * 64 + j], al_ = LOWS[tok * 384 + 128 + d * 64 + j]; \
                W_.r[w] = (float)(ok ? r_ : z_); W_.k[w] = (float)(ok ? k_ : z_); W_.v[w] = (float)(ok ? v_ : z_); W_.wl[w] = (float)(ok ? wl_ : z_); W_.al[w] = (float)(ok ? al_ : z_); } } while (0)
        SCAN_LOAD_WIN(cur, 0);
        for (int c = -1; c < nch; ++c) {
            if (c >= 1) scan_flush<R>(lds, c - 1, pw, lane, d, T, tok0, h, rowbase, Yf, Yb);
            if (c + 1 < nch) {
                const int cp = c + 1; LAS float* op = (LAS float*)(lds + (cp & 1) * SC_OPB);
                if (c + 2 < nch) SCAN_LOAD_WIN(nxt, c + 2);
#pragma unroll
                for (int s8 = 0; s8 < 8; ++s8) {
                    const float wl = mix3f(cur.wl[s8], cur.wl[s8 + 1], cur.wl[s8 + 2], mu_wl);
                    const float al = mix3f(cur.al[s8], cur.al[s8 + 1], cur.al[s8 + 2], mu_al);
                    const float e2 = __expf(2.0f * wl); const float th = 1.0f - 2.0f * __builtin_amdgcn_rcpf(e2 + 1.0f);
                    LAS h16* xs = (LAS h16*)(xsb + s8 * 256);
                    xs[j] = (h16)th; xs[64 + j] = (h16)al;
                }
                {
                    const LAS unsigned char* xr = xsb + (lane & 7) * 256 + (lane >> 4) * 16;
                    const h16x8 xw0 = *(const LAS h16x8a*)(xr), xw1 = *(const LAS h16x8a*)(xr + 64), xa0 = *(const LAS h16x8a*)(xr + 128), xa1 = *(const LAS h16x8a*)(xr + 192);
                    f32x4 accw[4], acca[4];
#pragma unroll
                    for (int nt = 0; nt < 4; ++nt) {
                        accw[nt] = __builtin_amdgcn_mfma_f32_16x16x32_f16(xw0, bw[nt][0], (f32x4){0.f, 0.f, 0.f, 0.f}, 0, 0, 0);
                        accw[nt] = __builtin_amdgcn_mfma_f32_16x16x32_f16(xw1, bw[nt][1], accw[nt], 0, 0, 0);
                        acca[nt] = __builtin_amdgcn_mfma_f32_16x16x32_f16(xa0, ba[nt][0], (f32x4){0.f, 0.f, 0.f, 0.f}, 0, 0, 0);
                        acca[nt] = __builtin_amdgcn_mfma_f32_16x16x32_f16(xa1, ba[nt][1], acca[nt], 0, 0, 0); }
                    if (lane < 32) {
                        LAS float* zw = zl + (4 * (lane >> 4)) * 64 + (lane & 15);
#pragma unroll
                        for (int nt = 0; nt < 4; ++nt)
#pragma unroll
                            for (int r = 0; r < 4; ++r) { zw[r * 64 + 16 * nt] = accw[nt][r]; zw[512 + r * 64 + 16 * nt] = acca[nt][r]; }
                    }
                }
#pragma unroll
                for (int s8 = 0; s8 < 8; ++s8) {
                    const int s = pw * 8 + s8; const int g = cp * SC_CH + s; const int t = d ? (T - 1 - g) : g; const size_t tok = (size_t)(tok0 + t);
                    const float rr = mix3f(cur.r[s8], cur.r[s8 + 1], cur.r[s8 + 2], mu_r);
                    const float kk0 = mix3f(cur.k[s8], cur.k[s8 + 1], cur.k[s8 + 2], mu_k);
                    const float vv = mix3f(cur.v[s8], cur.v[s8 + 1], cur.v[s8 + 2], mu_v);
                    const float z = w0 + zl[s8 * 64 + j], az = a0 + zl[512 + s8 * 64 + j];
                    const float wdec = __expf(-0.606531f * sigmoidf_(z)); const float av = sigmoidf_(az);
                    float kk = kk0 * k_k; const float n2 = wave_sum_fast(kk * kk); kk = kk * __builtin_amdgcn_rsqf(fmaxf(n2, 1e-24f));
                    const float kd = kk0 * (1.0f + (av - 1.0f) * k_a); const float bb = kk * av;
                    const float bs = wave_sum_fast(rr * kd * r_k);
                    if (lane == 0 && rowhalf == 0) BSC[(tok * 8 + h) * 2 + d] = bs;
                    LAS float* o = op + s * 384 + j;
                    o[0] = -kk; o[64] = wdec; o[128] = bb; o[192] = kd; o[256] = rr; o[320] = vv;
                }
                cur = nxt;
            }
            __syncthreads();
        }
        scan_flush<R>(lds, nch - 1, pw, lane, d, T, tok0, h, rowbase, Yf, Yb);
#undef SCAN_LOAD_WIN
    } else {
        constexpr int RL = R / 2;
        const int ri = lane >> 3, ci = lane & 7;
        const int yrow = wave * 8 * RL + ri * RL, vrow = rowbase + yrow;
        f32x2 S[RL][4];
#pragma unroll
        for (int i = 0; i < RL; ++i)
#pragma unroll
            for (int c2 = 0; c2 < 4; ++c2) S[i][c2] = (f32x2){0.f, 0.f};
        typedef float vecR __attribute__((ext_vector_type(RL)));
        __syncthreads();
        for (int c = 0; c < nch; ++c) {
            const LAS f32x4* op = (const LAS f32x4*)(lds + (c & 1) * SC_OPB);
            LAS float* yb = (LAS float*)(lds + SC_YOFF + (c & 1) * SC_YB);
            f32x4 a0 = op[2 * ci], a1 = op[2 * ci + 1], w0 = op[16 + 2 * ci], w1 = op[17 + 2 * ci], b0 = op[32 + 2 * ci], b1 = op[33 + 2 * ci];
            f32x4 k0 = op[48 + 2 * ci], k1 = op[49 + 2 * ci], r0 = op[64 + 2 * ci], r1 = op[65 + 2 * ci]; vecR v4 = *(const LAS vecR*)((const LAS float*)op + 320 + vrow);
#pragma unroll 4
            for (int s = 0; s < SC_CH; ++s) {
                const LAS f32x4* on = op + (s + 1) * 96;
                const f32x4 na0 = on[2 * ci], na1 = on[2 * ci + 1], nw0 = on[16 + 2 * ci], nw1 = on[17 + 2 * ci], nb0 = on[32 + 2 * ci], nb1 = on[33 + 2 * ci];
                const f32x4 nk0 = on[48 + 2 * ci], nk1 = on[49 + 2 * ci], nr0 = on[64 + 2 * ci], nr1 = on[65 + 2 * ci]; const vecR nv4 = *(const LAS vecR*)((const LAS float*)on + 320 + vrow);
                const f32x2 av[4] = {{a0.x, a0.y}, {a0.z, a0.w}, {a1.x, a1.y}, {a1.z, a1.w}}, wv[4] = {{w0.x, w0.y}, {w0.z, w0.w}, {w1.x, w1.y}, {w1.z, w1.w}};
                const f32x2 bv[4] = {{b0.x, b0.y}, {b0.z, b0.w}, {b1.x, b1.y}, {b1.z, b1.w}}, kv[4] = {{k0.x, k0.y}, {k0.z, k0.w}, {k1.x, k1.y}, {k1.z, k1.w}};
                const f32x2 rv[4] = {{r0.x, r0.y}, {r0.z, r0.w}, {r1.x, r1.y}, {r1.z, r1.w}};
                float sa[RL];
#pragma unroll
                for (int i = 0; i < RL; ++i) { f32x2 p = S[i][0] * av[0]; p = S[i][1] * av[1] + p; p = S[i][2] * av[2] + p; p = S[i][3] * av[3] + p;
                    float t = p.x + p.y; t += dpp_f<0xB1>(t); t += dpp_f<0x4E>(t); t += dpp_f<0x141>(t); sa[i] = t; }
                vecR y;
#pragma unroll
                for (int i = 0; i < RL; ++i) { const f32x2 sa2 = {sa[i], sa[i]}, v2 = {v4[i], v4[i]};
#pragma unroll
                    for (int c2 = 0; c2 < 4; ++c2) S[i][c2] = S[i][c2] * wv[c2] + sa2 * bv[c2] + v2 * kv[c2];
                    f32x2 p = S[i][0] * rv[0]; p = S[i][1] * rv[1] + p; p = S[i][2] * rv[2] + p; p = S[i][3] * rv[3] + p;
                    float t = p.x + p.y; t += dpp_f<0xB1>(t); t += dpp_f<0x4E>(t); t += dpp_f<0x141>(t); y[i] = t; }
                if (ci == 0) *(LAS vecR*)(yb + s * (32 * RL) + yrow) = y;
                a0 = na0; a1 = na1; w0 = nw0; w1 = nw1; b0 = nb0; b1 = nb1; k0 = nk0; k1 = nk1; r0 = nr0; r1 = nr1; v4 = nv4;
            }
            __syncthreads();
        }
    }
}

__device__ __forceinline__ void rwpost_tile(const Args& a, int layer, int tile, LAS unsigned char* lds, int tid, int lane, int wave, const h16x2 (&gup)[64]) {
    const size_t l = (size_t)layer; const int col = tid, h = wave;
    const int m0 = tile * 64; int tok0s, T; if (m0 < MP) { T = TP; tok0s = (m0 / TP) * TP; } else { T = TS; tok0s = MP + ((m0 - MP) / TS) * TS; }
    unsigned char* ws = a.ws; const int g = m0 < MP ? 0 : 1;
    const h16* LOWS = GB_LOWS(g); const h16* RV = GB_RV(g); h16* MIX = GB_MIX(g); const h16* Yb = GB_YB(g); const float* BSC = GB_BSC(g);
    const float* mu = a.in[I_MU] + l * 1920;
    LAS h16* G = (LAS h16*)lds;
    { const int c = tid & 127; const float mug = mu[1536 + 256 + c];
#pragma unroll 4
      for (int e = tid; e < 64 * 128; e += NTHREADS) { const int tk = e >> 7; const int m = m0 + tk; const int t = m - tok0s;
        const float gl = shiftmix(LOWS + (size_t)m * 384 + 256 + c, 384, t, T, mug); G[e] = (h16)sigmoidf_(gl); } }
    const float mu_v = mu[1024 + col], lw = a.in[I_LNW][l * 512 + col], lb = a.in[I_LNB][l * 512 + col];
    __syncthreads();
#pragma unroll 1
    for (int tk0 = 0; tk0 < 64; tk0 += 8) {
        h16 ym[8], yb[8], rv[10]; float b0[8], b1[8];
#pragma unroll
        for (int w = 0; w < 10; ++w) { const int m = m0 + tk0 - 1 + w; const int t = m - tok0s; const bool ok = (t >= 0) && (t < T); const h16 v = RV[(size_t)(ok ? m : m0) * 512 + col]; rv[w] = ok ? v : (h16)0.f; }
#pragma unroll
        for (int jj = 0; jj < 8; ++jj) { const size_t m = (size_t)(m0 + tk0 + jj); ym[jj] = MIX[m * 1024 + 512 + col]; yb[jj] = Yb[m * 512 + col]; b0[jj] = BSC[(m * 8 + h) * 2]; b1[jj] = BSC[(m * 8 + h) * 2 + 1]; }
#pragma unroll
        for (int jj = 0; jj < 8; ++jj) {
            const int tk = tk0 + jj; const size_t m = (size_t)(m0 + tk);
            float gg = 0.f;
#pragma unroll
            for (int c8 = 0; c8 < 16; ++c8) { const u32x4 x = *(const LAS u32x4a*)((const LAS unsigned char*)G + tk * 256 + c8 * 16);
                gg = dot8w(x, gup[c8 * 4 + 0], gup[c8 * 4 + 1], gup[c8 * 4 + 2], gup[c8 * 4 + 3], gg); }
            const float wkv = (float)ym[jj] + (float)yb[jj];
            const float mean = wave_sum_fast(wkv) * (1.0f / 64.0f); const float dv = wkv - mean; const float var = wave_sum_fast(dv * dv) * (1.0f / 64.0f);
            const float yn = dv * __builtin_amdgcn_rsqf(var + 64e-5f) * lw + lb;
            const float vv = mix3(rv[jj], rv[jj + 1], rv[jj + 2], mu_v);
            MIX[m * 1024 + 512 + col] = (h16)((yn + (b0[jj] + b1[jj]) * vv) * gg);
        }
    }
    __syncthreads();
}

#define STAGE_ARGS const Args& args, int layer, int g, int nb, int cb, LAS unsigned char* lds
#define FRESH_TID int tid = threadIdx.x; asm volatile("" : "+v"(tid)); const int lane = tid & 63, wave = __builtin_amdgcn_readfirstlane(tid >> 6); (void)lane; (void)wave;
__device__ __forceinline__ int g_rows(int g) { return g ? MS : MP; }
__device__ __forceinline__ int g_pm0(int g) { return g ? MP / 256 : 0; }
template <class Epi> __device__ __forceinline__ void run_gemm(LAS unsigned char* lds, const h16* A, int lda, const h16* Bt, int N, int K, int g, int nb, int cb, const Epi& E, int tid) {
    pg8::Gemm gm{A, Bt, g_rows(g), N, K, lda}; pg8::StaticOrder S; S.init(g_rows(g), N, nb, cb, g_pm0(g)); pg8::gemm_phase(lds, gm, S, E, tid);
}
__device__ __forceinline__ void st_ffn_up(STAGE_ARGS, int which) {
    FRESH_TID unsigned char* ws = args.ws; const h16* W = (const h16*)(ws + WS_W);
    pg8::EpiSwiglu E{GB_ACT(g), (const float*)(ws + (which ? WS_SSA : WS_SSB))};
    run_gemm(lds, which ? GB_H16(g) : GB_H16B(g), D, W + (which ? W_FFN2U : W_FFN1U), 2 * FF, D, g, nb, cb, E, tid);
}
__device__ __forceinline__ void st_ffn_down(STAGE_ARGS, int which) {
    FRESH_TID unsigned char* ws = args.ws; const h16* W = (const h16*)(ws + WS_W); float* out = args.out;
    const bool first = (which == 0 && layer == 0);
    const float* rp = first ? args.in[I_XP] : (const float*)out; const float* rsm = first ? args.in[I_XS] - (size_t)MP * D : (const float*)out;
    pg8::EpiResid E{rp, rsm, out, GB_H16(g), (float*)(ws + WS_SSA), 0.5f};
    run_gemm(lds, GB_ACT(g), FF, W + (which ? W_FFN2D : W_FFN1D), D, FF, g, nb, cb, E, tid);
}
__device__ __forceinline__ void st_win(STAGE_ARGS) {
    FRESH_TID unsigned char* ws = args.ws; const h16* W = (const h16*)(ws + WS_W);
    pg8::EpiProj E{GB_MIX(g), GB_KNA(g), (size_t)512 * g_rows(g), GB_LOWS(g), (const float*)(ws + WS_SSA)};
    run_gemm(lds, GB_H16(g), D, W + W_IN, NPROJ, D, g, nb, cb, E, tid);
}
__device__ __forceinline__ void st_wout(STAGE_ARGS) {
    FRESH_TID unsigned char* ws = args.ws; const h16* W = (const h16*)(ws + WS_W); float* out = args.out;
    pg8::EpiResid E{out, out, out, GB_H16(g), (float*)(ws + WS_SSA), 1.0f};
    run_gemm(lds, GB_MIX(g), D, W + W_OUT, D, D, g, nb, cb, E, tid);
}
__device__ __forceinline__ void st_pu(STAGE_ARGS) {
    FRESH_TID unsigned char* ws = args.ws; const h16* W = (const h16*)(ws + WS_W);
    int kpu = PLE; asm volatile("" : "+s"(kpu));
    pg8::EpiPU E{GB_PU(g)};
    run_gemm(lds, GB_P16(g), kpu, W + W_UP, D, kpu, g, nb, cb, E, tid);
}
__device__ __forceinline__ void st_ple(STAGE_ARGS) {
    FRESH_TID unsigned char* ws = args.ws; const h16* W = (const h16*)(ws + WS_W); float* out = args.out;
    pg8::EpiPle E{out, GB_H16B(g), (float*)(ws + WS_SSB), (const float*)(ws + WS_SSA), GB_PU(g)};
    run_gemm(lds, GB_H16(g), D, W + W_GATE, D, D, g, nb, cb, E, tid);
}
__device__ __forceinline__ void st_rwpost(STAGE_ARGS) {
    FRESH_TID const int t0 = g ? MP / 64 : 0, nt = g_rows(g) / 64;
    h16x2 gup[64];
    { const float* gu = args.in[I_GUP] + (size_t)layer * 128 * 512 + tid;
#pragma unroll
      for (int i2 = 0; i2 < 64; ++i2) { const float g0 = gu[0], g1 = gu[512]; gu += 1024; asm volatile("" : "+v"(gu)); gup[i2] = (h16x2){(h16)g0, (h16)g1}; } }
    for (int tile = cb; tile < nt; tile += nb) rwpost_tile(args, layer, t0 + tile, lds, tid, lane, wave, gup);
}
__device__ __forceinline__ void st_convp(STAGE_ARGS) { FRESH_TID convert_p(args, layer, g, nb, cb, tid); }

__device__ __forceinline__ void sub_sync(unsigned* ctr, unsigned target) {
    asm volatile("s_waitcnt vmcnt(0) lgkmcnt(0)" ::: "memory");
    __syncthreads();
    if (threadIdx.x == 0) {
        __builtin_amdgcn_fence(__ATOMIC_RELEASE, "agent"); asm volatile("s_waitcnt vmcnt(0)" ::: "memory");
        __hip_atomic_fetch_add(ctr, 1u, __ATOMIC_RELAXED, __HIP_MEMORY_SCOPE_AGENT);
        while (__hip_atomic_load(ctr, __ATOMIC_RELAXED, __HIP_MEMORY_SCOPE_AGENT) < target) __builtin_amdgcn_s_sleep(2);
    }
    __syncthreads();
    __builtin_amdgcn_fence(__ATOMIC_ACQUIRE, "agent"); asm volatile("s_waitcnt vmcnt(0)" ::: "memory");
}

constexpr int NSB = 32;
__global__ void __launch_bounds__(NTHREADS, 2) fwd_megakernel(Args args) {
    extern __shared__ __attribute__((aligned(16))) unsigned char lds_raw[];
    LAS unsigned char* lds = (LAS unsigned char*)lds_raw;
    cg::grid_group grid = cg::this_grid();
    const int bid = blockIdx.x, G = gridDim.x;
    const int NPB = G - NSB, pb = bid - NSB;
    unsigned* ctr = (unsigned*)(args.ws + WS_CTR);
    if (bid == 0 && threadIdx.x == 0) __hip_atomic_store(ctr, 0u, __ATOMIC_RELAXED, __HIP_MEMORY_SCOPE_AGENT);
    unsigned sbt = 0;
#define SUBSYNC() do { sbt += (unsigned)NPB; sub_sync(ctr, sbt); } while (0)

    for (int layer = 0; layer < 2; ++layer) {
        { FRESH_TID phase_convert(args, layer, lds, tid, lane, wave, bid, G); }
        grid_sync(grid);
        st_ffn_up(args, layer, 1, G, bid, lds, 0); grid_sync(grid);
        st_ffn_down(args, layer, 1, G, bid, lds, 0); grid_sync(grid);
        st_win(args, layer, 1, G, bid, lds); grid_sync(grid);
        { FRESH_TID for (int it = 1024 + bid; it < 1536; it += G) na_item(args, layer, it, lds, tid, lane, wave); }
        grid_sync(grid);
        if (bid < NSB) {
            FRESH_TID scan_item<4>(args, layer, bid, 0, lds, tid, lane, wave);
        } else {
            st_ffn_up(args, layer, 0, NPB, pb, lds, 0); SUBSYNC();
            st_ffn_down(args, layer, 0, NPB, pb, lds, 0); SUBSYNC();
            st_win(args, layer, 0, NPB, pb, lds); SUBSYNC();
            { FRESH_TID
              scan_item<4>(args, layer, 32 + pb, 0, lds, tid, lane, wave); __syncthreads();
              if (pb < 2 * (256 - NPB)) { scan_item<2>(args, layer, 32 + NPB + (pb >> 1), pb & 1, lds, tid, lane, wave); __syncthreads(); }
              else { for (int it = pb - 2 * (256 - NPB); it < 1024; it += NPB - 2 * (256 - NPB)) na_item(args, layer, it, lds, tid, lane, wave); } }
            SUBSYNC();
            st_rwpost(args, layer, 0, NPB, pb, lds); SUBSYNC();
            st_wout(args, layer, 0, NPB, pb, lds); SUBSYNC();
            st_ffn_up(args, layer, 0, NPB, pb, lds, 1);
        }
        grid_sync(grid);
        st_rwpost(args, layer, 1, G, bid, lds); st_ffn_down(args, layer, 0, G, bid, lds, 1); st_convp(args, layer, 0, G, bid, lds); grid_sync(grid);
        st_wout(args, layer, 1, G, bid, lds); st_pu(args, layer, 0, G, bid, lds); grid_sync(grid);
        st_ffn_up(args, layer, 1, G, bid, lds, 1); st_ple(args, layer, 0, G, bid, lds); grid_sync(grid);
        st_ffn_down(args, layer, 1, G, bid, lds, 1); st_convp(args, layer, 1, G, bid, lds); grid_sync(grid);
        st_pu(args, layer, 1, G, bid, lds); grid_sync(grid);
        st_ple(args, layer, 1, G, bid, lds); grid_sync(grid);
    }
    {
        FRESH_TID
        const float* SSB = (const float*)(args.ws + WS_SSB); float* out = args.out;
        const int gw = bid * NWAVES + wave, NGW = G * NWAVES; const f32x4* gm = (const f32x4*)args.in[I_FINAL] + lane;
        f32x4 gv[4];
#pragma unroll
        for (int j = 0; j < 4; ++j) gv[j] = gm[64 * j];
        for (int m = gw; m < M; m += 2 * NGW) {
            const int m2 = m + NGW;
            const float rs = row_rstd(SSB, m), rs2 = row_rstd(SSB, m2); f32x4* o = (f32x4*)(out + (size_t)m * D) + lane; f32x4* o2 = (f32x4*)(out + (size_t)m2 * D) + lane;
            f32x4 v[4], v2[4];
#pragma unroll
            for (int j = 0; j < 4; ++j) { v[j] = o[64 * j]; v2[j] = o2[64 * j]; }
#pragma unroll
            for (int j = 0; j < 4; ++j) { o[64 * j] = v[j] * rs * gv[j]; o2[64 * j] = v2[j] * rs2 * gv[j]; }
        }
    }
}

extern "C" void kernel_launch(void* const* d_in, const int* in_sizes, int n_in, void* d_out, int out_size, void* d_ws, size_t ws_size, hipStream_t stream) {
    static int grid = 0;
    if (grid == 0) {
        if (n_in != N_IN || out_size != M * D || ws_size < WS_END) { fprintf(stderr, "kernel_launch: unexpected shapes (n_in %d, out %d, ws %zu)\n", n_in, out_size, ws_size); grid = -1; return; }
        int dev = 0, cus = 0, per_cu = 0;
        (void)hipGetDevice(&dev); (void)hipDeviceGetAttribute(&cus, hipDeviceAttributeMultiprocessorCount, dev);
        (void)hipFuncSetAttribute((const void*)fwd_megakernel, hipFuncAttributeMaxDynamicSharedMemorySize, LDS_BYTES);
        (void)hipOccupancyMaxActiveBlocksPerMultiprocessor(&per_cu, (const void*)fwd_megakernel, NTHREADS, LDS_BYTES);
        if (per_cu < 1) fprintf(stderr, "kernel_launch: occupancy query says %d blocks per CU\n", per_cu);
        grid = cus;
        if (grid != 256) fprintf(stderr, "kernel_launch: grid %d (expected 256)\n", grid);
        if (grid <= NSB + 64) { fprintf(stderr, "kernel_launch: grid too small\n"); grid = -1; return; }
    }
    if (grid < 0) return;
    Args a{};
    for (int i = 0; i < N_IN; ++i) a.in[i] = (const float*)d_in[i];
    a.out = (float*)d_out; a.ws = (unsigned char*)d_ws;
    void* kargs[] = {&a};
    hipError_t e = hipLaunchCooperativeKernel((const void*)fwd_megakernel, dim3(grid), dim3(NTHREADS), kargs, LDS_BYTES, stream);
    if (e != hipSuccess) fprintf(stderr, "kernel_launch: cooperative launch failed: %s\n", hipGetErrorString(e));
}
```

```cpp
#include <hip/hip_runtime.h>
#include <hip/hip_cooperative_groups.h>
#include <cstdio>
#include <cstdint>
namespace cg = cooperative_groups;
#ifndef PHM
#define PHM 0xFFFF
#endif
#define PH(k) ((PHM >> (k)) & 1)

#define LAS __attribute__((address_space(3)))
typedef _Float16 h16;
typedef _Float16 h16x2 __attribute__((ext_vector_type(2)));
typedef _Float16 h16x4 __attribute__((ext_vector_type(4)));
typedef _Float16 h16x8 __attribute__((ext_vector_type(8)));
typedef _Float16 h16x8a __attribute__((ext_vector_type(8), may_alias));
typedef float f32x2 __attribute__((ext_vector_type(2)));
typedef float f32x4 __attribute__((ext_vector_type(4)));
typedef float f32x16 __attribute__((ext_vector_type(16)));
typedef unsigned u32x2 __attribute__((ext_vector_type(2)));
typedef unsigned u32x4 __attribute__((ext_vector_type(4)));
typedef unsigned u32x4a __attribute__((ext_vector_type(4), may_alias));

constexpr int D = 1024, FF = 2816, MP = 65536, MS = 32768, M = MP + MS, TP = 4096, TS = 16384, PLE = 256;
constexpr int NPROJ = 3584;
constexpr int NTHREADS = 512, NWAVES = 8;
constexpr int LDS_BYTES = 151552;
constexpr size_t MiB = 1u << 20;
constexpr size_t WS_CTR = 256;
constexpr size_t WS_W = 1 * MiB;
constexpr size_t WS_SSA = 46 * MiB;
constexpr size_t WS_SSB = 52 * MiB;
constexpr size_t REG_P = 58 * MiB, REG_S = 682 * MiB, WS_END = 994 * MiB;
constexpr size_t OFF_H16 = 0;
constexpr size_t OFF_MIX = 2048;
constexpr size_t OFF_KNA = 4096, OFF_VNA = 5120, OFF_RR = 6144, OFF_RK = 7168, OFF_RV = 8192;
constexpr size_t OFF_LOWS = 9216;
constexpr size_t OFF_ACT = 2048;
constexpr size_t OFF_P16 = 7680;
constexpr size_t OFF_PU = 2048;
constexpr size_t OFF_H16B = 7680;
constexpr size_t OFF_YB = 0, OFF_BSC = 1024;
constexpr size_t OFF_END = 9984;
static_assert(REG_P + OFF_END * MP <= REG_S && REG_S + OFF_END * MS <= WS_END, "group regions");
__device__ __forceinline__ unsigned char* gbuf(unsigned char* ws, int g, size_t off, size_t stride) {
    const size_t reg = g ? REG_S : REG_P, rows = g ? (size_t)MS : (size_t)MP, row0 = g ? (size_t)MP : 0;
    return ws + (reg + off * rows - row0 * stride);
}
#define GB_H16(g)  ((h16*)gbuf(ws, g, OFF_H16, 2048))
#define GB_H16B(g) ((h16*)gbuf(ws, g, OFF_H16B, 2048))
#define GB_MIX(g)  ((h16*)gbuf(ws, g, OFF_MIX, 2048))
#define GB_KNA(g)  ((h16*)gbuf(ws, g, OFF_KNA, 1024))
#define GB_VNA(g)  ((h16*)gbuf(ws, g, OFF_VNA, 1024))
#define GB_RR(g)   ((h16*)gbuf(ws, g, OFF_RR, 1024))
#define GB_RK(g)   ((h16*)gbuf(ws, g, OFF_RK, 1024))
#define GB_RV(g)   ((h16*)gbuf(ws, g, OFF_RV, 1024))
#define GB_LOWS(g) ((h16*)gbuf(ws, g, OFF_LOWS, 768))
#define GB_ACT(g)  ((h16*)gbuf(ws, g, OFF_ACT, 5632))
#define GB_P16(g)  ((h16*)gbuf(ws, g, OFF_P16, 512))
#define GB_PU(g)   ((h16*)gbuf(ws, g, OFF_PU, 2048))
#define GB_YB(g)   ((h16*)gbuf(ws, g, OFF_YB, 1024))
#define GB_BSC(g)  ((float*)gbuf(ws, g, OFF_BSC, 64))
constexpr size_t W_FFN1U = 0;
constexpr size_t W_FFN1D = W_FFN1U + (size_t)5632 * 1024;
constexpr size_t W_IN = W_FFN1D + (size_t)1024 * 2816;
constexpr size_t W_OUT = W_IN + (size_t)3584 * 1024;
constexpr size_t W_FFN2U = W_OUT + (size_t)1024 * 1024;
constexpr size_t W_FFN2D = W_FFN2U + (size_t)5632 * 1024;
constexpr size_t W_GATE = W_FFN2D + (size_t)1024 * 2816;
constexpr size_t W_UP = W_GATE + (size_t)1024 * 1024;
constexpr size_t W_ENDE = W_UP + (size_t)1024 * 256;
static_assert(WS_W + W_ENDE * 2 <= WS_SSA, "weights fit");

enum { I_XP = 0, I_XS, I_PP, I_PS, I_F1N, I_F1G, I_F1U, I_F1D, I_MIXN, I_WIN, I_RPB, I_MU, I_W0, I_WUP, I_A0, I_AUP, I_GUP, I_KK, I_KA, I_RK, I_LNW, I_LNB,
       I_WOUT, I_F2N, I_F2G, I_F2U, I_F2D, I_PLEN, I_PLEG, I_PLEU, I_FINAL, N_IN };
struct Args { const float* in[N_IN]; float* out; unsigned char* ws; };

__device__ __forceinline__ float wave_sum(float v) {
#pragma unroll
    for (int o = 1; o < 64; o <<= 1) v += __shfl_xor(v, o);
    return v;
}
__device__ __forceinline__ unsigned pk2h(float a, float b) { h16x2 p = {(h16)a, (h16)b}; return __builtin_bit_cast(unsigned, p); }
__device__ __forceinline__ h16x2 as_h2(unsigned u) { return __builtin_bit_cast(h16x2, u); }
__device__ __forceinline__ float dot2h(unsigned a, h16x2 b, float c) { return __builtin_amdgcn_fdot2(as_h2(a), b, c, false); }
__device__ __forceinline__ float dot8(u32x4 a, u32x4 b, float c) { const unsigned a0 = a[0], a1 = a[1], a2 = a[2], a3 = a[3], b0 = b[0], b1 = b[1], b2 = b[2], b3 = b[3];
    c = __builtin_amdgcn_fdot2(as_h2(a0), as_h2(b0), c, false); c = __builtin_amdgcn_fdot2(as_h2(a1), as_h2(b1), c, false); c = __builtin_amdgcn_fdot2(as_h2(a2), as_h2(b2), c, false); c = __builtin_amdgcn_fdot2(as_h2(a3), as_h2(b3), c, false); return c; }
__device__ __forceinline__ float dot8w(u32x4 a, h16x2 w0, h16x2 w1, h16x2 w2, h16x2 w3, float c) { const unsigned a0 = a[0], a1 = a[1], a2 = a[2], a3 = a[3];
    c = __builtin_amdgcn_fdot2(as_h2(a0), w0, c, false); c = __builtin_amdgcn_fdot2(as_h2(a1), w1, c, false); c = __builtin_amdgcn_fdot2(as_h2(a2), w2, c, false); c = __builtin_amdgcn_fdot2(as_h2(a3), w3, c, false); return c; }
__device__ __forceinline__ float fma_mix_lo(float p, unsigned v, float o) { asm("v_fma_mix_f32 %0, %1, %2, %0 op_sel_hi:[0,1,0]" : "+v"(o) : "v"(p), "v"(v)); return o; }
__device__ __forceinline__ float fma_mix_hi(float p, unsigned v, float o) { asm("v_fma_mix_f32 %0, %1, %2, %0 op_sel:[0,1,0] op_sel_hi:[0,1,0]" : "+v"(o) : "v"(p), "v"(v)); return o; }
__device__ __forceinline__ float sigmoidf_(float x) { return __builtin_amdgcn_rcpf(1.0f + __expf(-x)); }
__device__ __forceinline__ float row_rstd(const float* ss, int row) {
    const f32x4* p = (const f32x4*)(ss + (size_t)row * 16);
    const f32x4 a = p[0], b = p[1], c = p[2], d = p[3];
    const float s = ((a.x + a.y) + (a.z + a.w)) + ((b.x + b.y) + (b.z + b.w)) + ((c.x + c.y) + (c.z + c.w)) + ((d.x + d.y) + (d.z + d.w));
    return __builtin_amdgcn_rsqf(s * (1.0f / 1024.0f) + 1e-6f);
}
template <int CTRL> __device__ __forceinline__ float dpp_f(float v) { return __builtin_bit_cast(float, __builtin_amdgcn_update_dpp(0, __builtin_bit_cast(int, v), CTRL, 0xF, 0xF, true)); }
__device__ __forceinline__ float row16_sum(float v) {
    v += dpp_f<0xB1>(v);
    v += dpp_f<0x4E>(v);
    v += dpp_f<0x141>(v);
    v += dpp_f<0x140>(v);
    return v;
}
__device__ __forceinline__ void grid_sync(cg::grid_group& grid) {
    asm volatile("s_waitcnt vmcnt(0) lgkmcnt(0)" ::: "memory"); grid.sync();
    __builtin_amdgcn_fence(__ATOMIC_ACQUIRE, "agent"); asm volatile("s_waitcnt vmcnt(0)" ::: "memory"); }

namespace pg8 {
constexpr int BM = 256, BK = 64, HALF = 128, HTB = HALF * BK * 2, STAGE_BYTES = 8 * HTB, NXCD = 8, WGM = 8;
__host__ __device__ __forceinline__ int lds_byte(int r, int c) { const int st = (r >> 4) * 2 + (c >> 5), rr = r & 15, cc = c & 31, ob = rr * 64 + cc * 2; return st * 1024 + (ob ^ (((ob >> 9) & 1) << 5)); }
__host__ __device__ __forceinline__ void stage_rc(int b, int& R, int& C) { const int st = b / 1024, sb = b % 1024, swz = sb ^ (((sb >> 9) & 1) << 5); R = (st >> 1) * 16 + swz / 64; C = (st & 1) * 32 + (swz % 64) / 2; }
__host__ __device__ __forceinline__ int perm32(int rho) { const int n = rho >> 4, i = rho & 15; return 8 * (i >> 2) + 4 * n + (i & 3); }
struct Unit { int pm, pn; };
struct Gemm { const h16* A; const h16* Bt; int M, N, K, lda; };
struct StaticOrder {
    int nM, nN, nwg, G, c, pm0;
    __device__ void init(int M_, int N_, int G_, int c_, int pm0_) { nM = M_ / BM; nN = N_ / BM; nwg = nM * nN; G = G_; c = c_; pm0 = pm0_; }
    __device__ bool next(int i, Unit& u) const {
        const long L = (long)i * G + c; if (L >= nwg) return false;
        int wgid = (int)L; { const int q = nwg / NXCD, r = nwg % NXCD, xcd = wgid % NXCD, off = wgid / NXCD; wgid = (xcd < r ? xcd * (q + 1) : r * (q + 1) + (xcd - r) * q) + off; }
        const int nig = WGM * nN, gid = wgid / nig, fm = gid * WGM, gsz = (nM - fm) < WGM ? (nM - fm) : WGM;
        u.pm = pm0 + fm + ((wgid % nig) % gsz); u.pn = (wgid % nig) / gsz; return true;
    }
};
typedef f32x4 Acc[2][2][4][2];

template <class Epi>
__device__ __forceinline__ void gemm_phase(LAS unsigned char* lds, const Gemm g, const StaticOrder& S, const Epi& E, const int tid) {
    const int wid = __builtin_amdgcn_readfirstlane(tid >> 6), lane = tid & 63, wr = wid >> 2, wc = wid & 3, fr = lane & 15, fq = lane >> 4;
    const int K = g.K, nt = K / BK, lda = g.lda;
    unsigned voffA[2], voffB[2];
#pragma unroll
    for (int i = 0; i < 2; ++i) { int R, C; stage_rc(tid * 16 + i * 8192, R, C); const int Rb = Epi::PERM ? ((R & ~31) + perm32(R & 31)) : R;
        voffA[i] = (unsigned)(R * lda + C) * 2u; voffB[i] = (unsigned)(Rb * K + C) * 2u; }
    const size_t kstep = (size_t)(BK * 2);
    const size_t hstepA = (size_t)HALF * lda * 2, hstepB = (size_t)HALF * K * 2;
    const size_t tstepA = 2 * hstepA, tstepB = 2 * hstepB;
    const unsigned ldsw = (unsigned)wid * 1024u;
    const int aoff = lds_byte(wr * 64 + fr, fq * 8), boff = lds_byte(wc * 32 + fr, fq * 8);
#define PG8_SA(b, h) (((b) * 2 + (h)) * HTB)
#define PG8_SB(b, h) ((4 + (b) * 2 + (h)) * HTB)
#define PG8_STAGE(bufoff, gbase, voff) do { _Pragma("unroll") for (int _i = 0; _i < 2; ++_i) \
        __builtin_amdgcn_global_load_lds((const unsigned*)((const char*)(gbase) + (voff)[_i]), (LAS unsigned*)(lds + (bufoff) + ldsw + _i * 8192), 16, 0, 0); } while (0)
#define PG8_LDA(dst, b, h) do { _Pragma("unroll") for (int m = 0; m < 4; ++m) _Pragma("unroll") for (int k = 0; k < 2; ++k) dst[m][k] = *(const LAS h16x8*)(lds + PG8_SA(b, h) + aoff + m * 2048 + k * 1024); } while (0)
#define PG8_LDB(dst, b, h) do { _Pragma("unroll") for (int n = 0; n < 2; ++n) _Pragma("unroll") for (int k = 0; k < 2; ++k) dst[n][k] = *(const LAS h16x8*)(lds + PG8_SB(b, h) + boff + n * 2048 + k * 1024); } while (0)
#define PG8_MMA(ai, bj, At, Bt) do { __builtin_amdgcn_s_setprio(1); _Pragma("unroll") for (int m = 0; m < 4; ++m) _Pragma("unroll") for (int n = 0; n < 2; ++n) _Pragma("unroll") for (int k = 0; k < 2; ++k) \
        acc[ai][bj][m][n] = __builtin_amdgcn_mfma_f32_16x16x32_f16(Bt[n][k], At[m][k], acc[ai][bj][m][n], 0, 0, 0); __builtin_amdgcn_s_setprio(0); } while (0)
#define PG8_WAIT_V(n) asm volatile("s_waitcnt vmcnt(" #n ")" ::: "memory")
#define PG8_WAIT_L(n) asm volatile("s_waitcnt lgkmcnt(" #n ")" ::: "memory")
#define PG8_BAR __builtin_amdgcn_s_barrier()
#define PG8_SCHED __builtin_amdgcn_sched_barrier(0)
    Unit cur, nxt; int ui = 0;
    if (!S.next(0, cur)) return;
    f32x4 acc[2][2][4][2];
#pragma unroll
    for (int a = 0; a < 2; ++a)
#pragma unroll
        for (int b = 0; b < 2; ++b)
#pragma unroll
            for (int m = 0; m < 4; ++m)
#pragma unroll
                for (int n = 0; n < 2; ++n) acc[a][b][m][n] = (f32x4){0.f, 0.f, 0.f, 0.f};
    h16x8 At[4][2], B0[2][2], B1[2][2];
    const char* cA = (const char*)g.A + (size_t)cur.pm * tstepA; const char* cB = (const char*)g.Bt + (size_t)cur.pn * tstepB;
    PG8_STAGE(PG8_SB(0, 0), cB, voffB); PG8_STAGE(PG8_SB(0, 1), cB + hstepB, voffB); PG8_STAGE(PG8_SA(0, 0), cA, voffA); PG8_STAGE(PG8_SA(0, 1), cA + hstepA, voffA);
    if (wr == 1) PG8_BAR;
    PG8_WAIT_V(2); PG8_BAR;
    PG8_STAGE(PG8_SB(1, 0), cB + kstep, voffB); PG8_STAGE(PG8_SA(1, 0), cA + kstep, voffA); PG8_STAGE(PG8_SB(1, 1), cB + hstepB + kstep, voffB);
    PG8_WAIT_V(6); PG8_BAR;
    for (;;) {
        const bool has_next = S.next(ui + 1, nxt);
        const char* nA = has_next ? (const char*)g.A + (size_t)nxt.pm * tstepA : cA; const char* nB = has_next ? (const char*)g.Bt + (size_t)nxt.pn * tstepB : cB;
        for (int t = 0; t < nt; t += 2) {
            const bool last = (t == nt - 2);
            const char* a1 = cA + (size_t)(t + 1) * kstep;
            const char* a2 = last ? nA : cA + (size_t)(t + 2) * kstep; const char* b2 = last ? nB : cB + (size_t)(t + 2) * kstep;
            const char* a3 = a2 + kstep; const char* b3 = b2 + kstep;
            PG8_LDB(B0, 0, 0); PG8_LDB(B1, 0, 1); PG8_SCHED; PG8_LDA(At, 0, 0); PG8_STAGE(PG8_SA(1, 1), a1 + hstepA, voffA);
            PG8_WAIT_V(8); PG8_WAIT_L(0); PG8_BAR; PG8_MMA(0, 0, At, B0); PG8_MMA(0, 1, At, B1); PG8_BAR; PG8_SCHED;
            PG8_LDA(At, 0, 1); PG8_STAGE(PG8_SB(0, 0), b2, voffB); PG8_STAGE(PG8_SB(0, 1), b2 + hstepB, voffB); PG8_STAGE(PG8_SA(0, 0), a2, voffA);
            PG8_WAIT_V(8); PG8_WAIT_L(0); PG8_BAR; PG8_MMA(1, 0, At, B0); PG8_MMA(1, 1, At, B1); PG8_BAR; PG8_SCHED;
            PG8_LDB(B0, 1, 0); PG8_LDB(B1, 1, 1); PG8_SCHED; PG8_LDA(At, 1, 0); PG8_STAGE(PG8_SA(0, 1), a2 + hstepA, voffA);
            PG8_WAIT_V(8); PG8_WAIT_L(0); PG8_BAR; PG8_MMA(0, 0, At, B0); PG8_MMA(0, 1, At, B1); PG8_BAR; PG8_SCHED;
            PG8_LDA(At, 1, 1); PG8_STAGE(PG8_SB(1, 0), b3, voffB); PG8_STAGE(PG8_SB(1, 1), b3 + hstepB, voffB); PG8_STAGE(PG8_SA(1, 0), a3, voffA);
            PG8_WAIT_V(8); PG8_WAIT_L(0); PG8_BAR; PG8_MMA(1, 0, At, B0); PG8_MMA(1, 1, At, B1); PG8_BAR; PG8_SCHED;
        }
        if (wr == 0) PG8_BAR;
        E(acc, cur, wr, wc, fr, fq);
        if (!has_next) break;
#pragma unroll
        for (int a = 0; a < 2; ++a)
#pragma unroll
            for (int b = 0; b < 2; ++b)
#pragma unroll
                for (int m = 0; m < 4; ++m)
#pragma unroll
                    for (int n = 0; n < 2; ++n) acc[a][b][m][n] = (f32x4){0.f, 0.f, 0.f, 0.f};
        cur = nxt; cA = nA; cB = nB; ++ui;
        if (wr == 1) PG8_BAR;
    }
    PG8_WAIT_V(0);
    PG8_BAR;
#undef PG8_SA
#undef PG8_SB
#undef PG8_STAGE
#undef PG8_LDA
#undef PG8_LDB
#undef PG8_MMA
#undef PG8_WAIT_V
#undef PG8_WAIT_L
#undef PG8_BAR
#undef PG8_SCHED
}


struct EpiSwiglu {
    static constexpr bool PERM = true;
    h16* O; const float* ss;
    __device__ __forceinline__ void operator()(const Acc& acc, const Unit& u, int wr, int wc, int fr, int fq) const {
        const int row0 = u.pm * BM + wr * 64 + fr, col0 = u.pn * 128 + wc * 32 + 8 * fq;
#pragma unroll
        for (int ai = 0; ai < 2; ++ai)
#pragma unroll
            for (int m = 0; m < 4; ++m) {
                const int row = row0 + ai * HALF + m * 16; const float rs = row_rstd(ss, row);
                float o[8];
#pragma unroll
                for (int n = 0; n < 2; ++n)
#pragma unroll
                    for (int j = 0; j < 4; ++j) { const float gg = acc[ai][0][m][n][j] * rs, uu = acc[ai][1][m][n][j] * rs; o[n * 4 + j] = gg * sigmoidf_(gg) * uu; }
                u32x4 w; w.x = pk2h(o[0], o[1]); w.y = pk2h(o[2], o[3]); w.z = pk2h(o[4], o[5]); w.w = pk2h(o[6], o[7]);
                *(u32x4*)(O + (size_t)row * FF + col0) = w;
            }
    }
};
struct EpiResid {
    static constexpr bool PERM = false;
    const float* res_p; const float* res_s; float* out; h16* o16; float* ss; float alpha;
    __device__ __forceinline__ void operator()(const Acc& acc, const Unit& u, int wr, int wc, int fr, int fq) const {
        const int row0 = u.pm * BM + wr * 64 + fr, col0 = u.pn * BM + wc * 32 + 4 * fq;
        const float* res = (u.pm * BM < MP) ? res_p : res_s;
#pragma unroll
        for (int ai = 0; ai < 2; ++ai)
#pragma unroll
            for (int m = 0; m < 4; ++m) {
                const int row = row0 + ai * HALF + m * 16; const size_t off = (size_t)row * D + col0; float sq = 0.f;
#pragma unroll
                for (int bj = 0; bj < 2; ++bj)
#pragma unroll
                    for (int n = 0; n < 2; ++n) { const size_t o = off + bj * HALF + n * 16; const f32x4 r = *(const f32x4*)(res + o); const f32x4 v = r + acc[ai][bj][m][n] * alpha;
                        *(f32x4*)(out + o) = v; u32x2 w; w.x = pk2h(v.x, v.y); w.y = pk2h(v.z, v.w); *(u32x2*)(o16 + o) = w; sq += (v.x * v.x + v.y * v.y) + (v.z * v.z + v.w * v.w); }
                sq += __shfl_xor(sq, 16); sq += __shfl_xor(sq, 32);
                if (fq == 0) ss[(size_t)row * 16 + u.pn * 4 + wc] = sq;
                asm volatile("" ::: "memory");
            }
    }
};
struct EpiProj {
    static constexpr bool PERM = true;
    h16* mix; h16* kna; size_t bufstep; h16* lows; const float* ss;
    __device__ __forceinline__ void operator()(const Acc& acc, const Unit& u, int wr, int wc, int fr, int fq) const {
        const int pn = u.pn; h16* base; int ldc, c0; float sc = 1.f; int nbj = 2;
        if (pn < 2) { base = mix; ldc = 1024; c0 = pn * 256; sc = 0.125f; }
        else if (pn < 12) { base = kna + (size_t)((pn - 2) >> 1) * bufstep; ldc = 512; c0 = ((pn - 2) & 1) * 256; }
        else { base = lows; ldc = 384; c0 = (pn - 12) * 256; if (pn == 13) nbj = 1; }
        const int row0 = u.pm * BM + wr * 64 + fr, col0 = c0 + wc * 32 + 8 * fq;
#pragma unroll
        for (int ai = 0; ai < 2; ++ai)
#pragma unroll
            for (int m = 0; m < 4; ++m) {
                const int row = row0 + ai * HALF + m * 16; const float rs = row_rstd(ss, row) * sc;
#pragma unroll
                for (int bj = 0; bj < 2; ++bj) if (bj < nbj) {
                    const f32x4 v0 = acc[ai][bj][m][0] * rs, v1 = acc[ai][bj][m][1] * rs;
                    u32x4 w; w.x = pk2h(v0.x, v0.y); w.y = pk2h(v0.z, v0.w); w.z = pk2h(v1.x, v1.y); w.w = pk2h(v1.z, v1.w);
                    *(u32x4*)(base + (size_t)row * ldc + col0 + bj * HALF) = w; }
            }
    }
};
struct EpiPU {
    static constexpr bool PERM = true;
    h16* O;
    __device__ __forceinline__ void operator()(const Acc& acc, const Unit& u, int wr, int wc, int fr, int fq) const {
        const int row0 = u.pm * BM + wr * 64 + fr, col0 = u.pn * BM + wc * 32 + 8 * fq;
#pragma unroll
        for (int ai = 0; ai < 2; ++ai)
#pragma unroll
            for (int m = 0; m < 4; ++m) {
                const int row = row0 + ai * HALF + m * 16;
#pragma unroll
                for (int bj = 0; bj < 2; ++bj) {
                    const f32x4 v0 = acc[ai][bj][m][0], v1 = acc[ai][bj][m][1];
                    u32x4 w; w.x = pk2h(v0.x, v0.y); w.y = pk2h(v0.z, v0.w); w.z = pk2h(v1.x, v1.y); w.w = pk2h(v1.z, v1.w);
                    *(u32x4*)(O + (size_t)row * D + col0 + bj * HALF) = w; }
            }
    }
};
struct EpiPle {
    static constexpr bool PERM = false;
    float* out; h16* o16; float* ssw; const float* ssr; const h16* pu;
    __device__ __forceinline__ void operator()(const Acc& acc, const Unit& u, int wr, int wc, int fr, int fq) const {
        const int row0 = u.pm * BM + wr * 64 + fr, col0 = u.pn * BM + wc * 32 + 4 * fq;
#pragma unroll
        for (int ai = 0; ai < 2; ++ai)
#pragma unroll
            for (int m = 0; m < 4; ++m) {
                const int row = row0 + ai * HALF + m * 16; const size_t off = (size_t)row * D + col0; float sq = 0.f; const float rs = row_rstd(ssr, row);
#pragma unroll
                for (int bj = 0; bj < 2; ++bj)
#pragma unroll
                    for (int n = 0; n < 2; ++n) { const size_t o = off + bj * HALF + n * 16; const f32x4 r = *(const f32x4*)(out + o); const h16x4 p = *(const h16x4*)(pu + o);
                        const f32x4 a = acc[ai][bj][m][n] * rs; f32x4 v;
                        v.x = r.x + sigmoidf_(a.x) * (float)p.x; v.y = r.y + sigmoidf_(a.y) * (float)p.y; v.z = r.z + sigmoidf_(a.z) * (float)p.z; v.w = r.w + sigmoidf_(a.w) * (float)p.w;
                        *(f32x4*)(out + o) = v; u32x2 w; w.x = pk2h(v.x, v.y); w.y = pk2h(v.z, v.w); *(u32x2*)(o16 + o) = w; sq += (v.x * v.x + v.y * v.y) + (v.z * v.z + v.w * v.w); }
                sq += __shfl_xor(sq, 16); sq += __shfl_xor(sq, 32);
                if (fq == 0) ssw[(size_t)row * 16 + u.pn * 4 + wc] = sq;
                asm volatile("" ::: "memory");
            }
    }
};
}

__device__ __forceinline__ void convert_matrix(const float* W, int K, int N, const float* gamma, h16* WT, int mode, LAS float* scr, int gw, int NGW, int lane) {
    const int nblk = N / 32, nitems = (K / 64) * nblk;
    for (int item = gw; item < nitems; item += NGW) {
        const int kb = item / nblk, nb = item % nblk, k0 = 64 * kb, n0 = 32 * nb;
        const int drow0 = (mode == 0) ? n0 : ((n0 >> 7) * 256 + (n0 & 127) + (mode == 2 ? 128 : 0));
#pragma unroll 8
        for (int i = 0; i < 32; ++i) { const int kk = 2 * i + (lane >> 5); float v = W[(size_t)(k0 + kk) * N + n0 + (lane & 31)]; if (gamma) v *= gamma[k0 + kk]; scr[kk * 33 + (lane & 31)] = v; }
        asm volatile("s_waitcnt lgkmcnt(0)" ::: "memory");
        const int c = lane & 7;
#pragma unroll
        for (int j = 0; j < 4; ++j) { const int n = (lane >> 3) + 8 * j; const LAS float* s = scr + (8 * c) * 33 + n;
            u32x4 o; o.x = pk2h(s[0 * 33], s[1 * 33]); o.y = pk2h(s[2 * 33], s[3 * 33]); o.z = pk2h(s[4 * 33], s[5 * 33]); o.w = pk2h(s[6 * 33], s[7 * 33]);
            *(u32x4*)(WT + (size_t)(drow0 + n) * K + k0 + 8 * c) = o; }
        asm volatile("s_waitcnt lgkmcnt(0)" ::: "memory");
    }
}

__device__ __forceinline__ void phase_convert(const Args& a, int layer, LAS unsigned char* lds, int tid, int lane, int wave, int bid, int G) {
    LAS float* scr = (LAS float*)(lds + wave * 16384);
    const int gw = bid * NWAVES + wave, NGW = G * NWAVES;
    h16* W = (h16*)(a.ws + WS_W);
    const size_t l = (size_t)layer;
    convert_matrix(a.in[I_F1G] + l * D * FF, D, FF, a.in[I_F1N] + l * D, W + W_FFN1U, 1, scr, gw, NGW, lane);
    convert_matrix(a.in[I_F1U] + l * D * FF, D, FF, a.in[I_F1N] + l * D, W + W_FFN1U, 2, scr, gw, NGW, lane);
    convert_matrix(a.in[I_F1D] + l * FF * D, FF, D, nullptr, W + W_FFN1D, 0, scr, gw, NGW, lane);
    convert_matrix(a.in[I_WIN] + l * D * 3456, D, 3456, a.in[I_MIXN] + l * D, W + W_IN, 0, scr, gw, NGW, lane);
    convert_matrix(a.in[I_WOUT] + l * D * D, D, D, nullptr, W + W_OUT, 0, scr, gw, NGW, lane);
    convert_matrix(a.in[I_F2G] + l * D * FF, D, FF, a.in[I_F2N] + l * D, W + W_FFN2U, 1, scr, gw, NGW, lane);
    convert_matrix(a.in[I_F2U] + l * D * FF, D, FF, a.in[I_F2N] + l * D, W + W_FFN2U, 2, scr, gw, NGW, lane);
    convert_matrix(a.in[I_F2D] + l * FF * D, FF, D, nullptr, W + W_FFN2D, 0, scr, gw, NGW, lane);
    convert_matrix(a.in[I_PLEG] + l * D * D, D, D, a.in[I_PLEN] + l * D, W + W_GATE, 0, scr, gw, NGW, lane);
    convert_matrix(a.in[I_PLEU] + l * PLE * D, PLE, D, nullptr, W + W_UP, 0, scr, gw, NGW, lane);
    { u32x4* z = (u32x4*)(W + W_IN + (size_t)3456 * 1024); const int n16 = 128 * 1024 * 2 / 16;
      for (int i = bid * NTHREADS + tid; i < n16; i += G * NTHREADS) z[i] = (u32x4){0u, 0u, 0u, 0u}; }
    if (layer == 0) {
        unsigned char* ws = a.ws; h16* Hp = GB_H16B(0); h16* Hs = GB_H16B(1); float* ss = (float*)(a.ws + WS_SSB);
        for (int m = gw; m < M; m += NGW) {
            h16* H = (m < MP) ? Hp : Hs;
            const float* xr = (m < MP) ? a.in[I_XP] + (size_t)m * D : a.in[I_XS] + (size_t)(m - MP) * D;
            const f32x4* x4 = (const f32x4*)xr + lane; float s = 0.f;
            u32x2* o = (u32x2*)(H + (size_t)m * D) + lane;
#pragma unroll
            for (int j = 0; j < 4; ++j) { const f32x4 v = x4[64 * j]; s += (v.x * v.x + v.y * v.y) + (v.z * v.z + v.w * v.w); u32x2 w; w.x = pk2h(v.x, v.y); w.y = pk2h(v.z, v.w); o[64 * j] = w; }
            s = wave_sum(s);
            if (lane < 16) ss[(size_t)m * 16 + lane] = (lane == 0) ? s : 0.f;
        }
    }
}

__device__ __forceinline__ void convert_p(const Args& a, int layer, int g, int nb, int cb, int tid) {
    unsigned char* ws = a.ws; const int rows = g ? MS : MP, row0 = g ? MP : 0;
    u32x2* o = (u32x2*)(GB_P16(g) + (size_t)row0 * PLE);
    const f32x4* p = (const f32x4*)((g ? a.in[I_PS] + (size_t)layer * MS * PLE : a.in[I_PP] + (size_t)layer * MP * PLE));
    const int N4 = rows * PLE / 4;
    for (int i = cb * NTHREADS + tid; i < N4; i += nb * NTHREADS) { const f32x4 v = p[i]; u32x2 w; w.x = pk2h(v.x, v.y); w.y = pk2h(v.z, v.w); o[i] = w; }
}

constexpr int NA_PITCH = 144;
constexpr int NA_VOFF = 512 * NA_PITCH;
constexpr int NA_PP = 67;
constexpr int NA_BTOFF = 2 * 512 * NA_PITCH;
__device__ __forceinline__ void na_item(const Args& a, int layer, int item, LAS unsigned char* lds, int tid, int lane, int wave) {
    int tok0, i, rows;
    if (item < 1024) { tok0 = (item >> 6) * TP; i = item & 63; rows = 64; } else { const int it2 = item - 1024; tok0 = MP + (it2 >> 8) * TS; i = it2 & 255; rows = 256; }
    int rs = i - 4; rs = rs < 0 ? 0 : (rs > rows - 8 ? rows - 8 : rs);
    unsigned char* ws = a.ws; const int g = item < 1024 ? 0 : 1;
    h16* MIX = GB_MIX(g); const h16* KNA = GB_KNA(g); const h16* VNA = GB_VNA(g);
    const float* rpb = a.in[I_RPB] + (size_t)layer * 8 * 15 * 31;
    const int wtok0 = tok0 + rs * 64;
    const int j = lane, aw = wave;
    const int tokq = tok0 + i * 64 + j;
    int cs = j - 8; cs = cs < 0 ? 0 : (cs > 48 ? 48 : cs);
    const int l31 = lane & 31, half = lane >> 5;
    LAS float* bt = (LAS float*)(lds + NA_BTOFF) + wave * 128;
    bt[lane] = 0.f; bt[64 + lane] = 0.f;
    u32x4 kreg[8], vreg[8];
    const size_t kvoff = (size_t)(wtok0 + (tid >> 3)) * 512 + (tid & 7) * 8;
#pragma unroll
    for (int it = 0; it < 8; ++it) { kreg[it] = *(const u32x4*)(KNA + kvoff + (size_t)it * (64 * 512)); vreg[it] = *(const u32x4*)(VNA + kvoff + (size_t)it * (64 * 512)); }
#pragma unroll 1
    for (int h = 0; h < 8; ++h) {
#pragma unroll
        for (int it = 0; it < 8; ++it) { const int key = (tid >> 3) + 64 * it, ch = tid & 7;
            *(LAS u32x4*)(lds + key * NA_PITCH + ch * 16) = kreg[it]; *(LAS u32x4*)(lds + NA_VOFF + key * NA_PITCH + ch * 16) = vreg[it]; }
        h16x8 qf[2][4];
#pragma unroll
        for (int nt = 0; nt < 2; ++nt)
#pragma unroll
            for (int ks = 0; ks < 4; ++ks) qf[nt][ks] = *(const h16x8*)(MIX + (size_t)(tok0 + i * 64 + l31 + 32 * nt) * 1024 + h * 64 + 16 * ks + 8 * half);
        if (lane < 31) bt[48 + lane] = rpb[((size_t)h * 15 + (rs + aw - i + 7)) * 31 + lane];
        __syncthreads();
        if (h + 1 < 8) {
#pragma unroll
            for (int it = 0; it < 8; ++it) { kreg[it] = *(const u32x4*)(KNA + kvoff + (size_t)it * (64 * 512) + (h + 1) * 64); vreg[it] = *(const u32x4*)(VNA + kvoff + (size_t)it * (64 * 512) + (h + 1) * 64); }
        }
        f32x16 acc[2][2];
#pragma unroll
        for (int mt = 0; mt < 2; ++mt)
#pragma unroll
            for (int nt = 0; nt < 2; ++nt)
#pragma unroll
                for (int r = 0; r < 16; ++r) acc[mt][nt][r] = 0.f;
#pragma unroll
        for (int mt = 0; mt < 2; ++mt)
#pragma unroll
            for (int ks = 0; ks < 4; ++ks) {
                const h16x8 kf = *(const LAS h16x8*)(lds + (aw * 64 + 32 * mt + l31) * NA_PITCH + (16 * ks + 8 * half) * 2);
                acc[mt][0] = __builtin_amdgcn_mfma_f32_32x32x16_f16(kf, qf[0][ks], acc[mt][0], 0, 0, 0);
                acc[mt][1] = __builtin_amdgcn_mfma_f32_32x32x16_f16(kf, qf[1][ks], acc[mt][1], 0, 0, 0);
            }
        float mxq[2], lq[2];
#pragma unroll
        for (int nt = 0; nt < 2; ++nt) {
            const int qc = l31 + 32 * nt; int csq = qc - 8; csq = csq < 0 ? 0 : (csq > 48 ? 48 : csq);
            const int dlt = 4 * half - csq;
            const LAS float* bq = bt + (48 + 15 + 4 * half - qc - 32);
            float m = -3.0e38f;
#pragma unroll
            for (int mt = 0; mt < 2; ++mt)
#pragma unroll
                for (int r = 0; r < 16; ++r) { const int kr = (r & 3) + 8 * (r >> 2) + 32 * mt;
                    const float sv = acc[mt][nt][r] + bq[32 + kr]; const bool ok = (unsigned)(dlt + kr) < 16u; const float sm = ok ? sv : -1.0e30f; acc[mt][nt][r] = sm; m = fmaxf(m, sm); }
            { const auto sw = __builtin_amdgcn_permlane32_swap(__builtin_bit_cast(unsigned, m), __builtin_bit_cast(unsigned, m), false, false); const unsigned s0 = sw[0], s1 = sw[1]; m = fmaxf(__builtin_bit_cast(float, s0), __builtin_bit_cast(float, s1)); }
            float l = 0.f;
#pragma unroll
            for (int mt = 0; mt < 2; ++mt)
#pragma unroll
                for (int r = 0; r < 16; ++r) { const float p = __expf(acc[mt][nt][r] - m); acc[mt][nt][r] = p; l += p; }
            { const auto sw = __builtin_amdgcn_permlane32_swap(__builtin_bit_cast(unsigned, l), __builtin_bit_cast(unsigned, l), false, false); const unsigned s0 = sw[0], s1 = sw[1]; l = __builtin_bit_cast(float, s0) + __builtin_bit_cast(float, s1); }
            mxq[nt] = m; lq[nt] = l;
        }
        h16x8 pf[2][2][2];
#pragma unroll
        for (int kt = 0; kt < 2; ++kt)
#pragma unroll
            for (int nt = 0; nt < 2; ++nt)
#pragma unroll
                for (int sx = 0; sx < 2; ++sx)
#pragma unroll
                    for (int e = 0; e < 8; ++e) pf[kt][nt][sx][e] = (h16)acc[kt][nt][8 * sx + e];
        f32x16 o[2][2];
#pragma unroll
        for (int dm = 0; dm < 2; ++dm)
#pragma unroll
            for (int nt = 0; nt < 2; ++nt)
#pragma unroll
                for (int r = 0; r < 16; ++r) o[dm][nt][r] = 0.f;
#pragma unroll
        for (int dm = 0; dm < 2; ++dm)
#pragma unroll
            for (int kt = 0; kt < 2; ++kt)
#pragma unroll
                for (int sx = 0; sx < 2; ++sx) {
                    h16x8 vf;
                    const LAS unsigned char* vb = lds + NA_VOFF + (aw * 64 + 32 * kt + 16 * sx + 4 * half) * NA_PITCH + (l31 + 32 * dm) * 2;
#pragma unroll
                    for (int e = 0; e < 8; ++e) vf[e] = *(const LAS h16*)(vb + ((e & 3) + 8 * (e >> 2)) * NA_PITCH);
                    o[dm][0] = __builtin_amdgcn_mfma_f32_32x32x16_f16(vf, pf[kt][0][sx], o[dm][0], 0, 0, 0);
                    o[dm][1] = __builtin_amdgcn_mfma_f32_32x32x16_f16(vf, pf[kt][1][sx], o[dm][1], 0, 0, 0);
                }
        __syncthreads();
#pragma unroll
        for (int nt = 0; nt < 2; ++nt) {
            LAS float* part = (LAS float*)lds + (size_t)(aw * 64 + l31 + 32 * nt) * NA_PP;
#pragma unroll
            for (int dm = 0; dm < 2; ++dm)
#pragma unroll
                for (int r = 0; r < 16; ++r) part[(r & 3) + 8 * (r >> 2) + 4 * half + 32 * dm] = o[dm][nt][r];
            if (half == 0) { part[64] = mxq[nt]; part[65] = lq[nt]; }
        }
        __syncthreads();
        {
            const int jq = tid & 63, e8 = tid >> 6;
            float mw[8], M_ = -3.0e38f;
#pragma unroll
            for (int w = 0; w < 8; ++w) { mw[w] = ((const LAS float*)lds)[(size_t)(w * 64 + jq) * NA_PP + 64]; M_ = fmaxf(M_, mw[w]); }
            float L = 0.f, ov[8];
#pragma unroll
            for (int e = 0; e < 8; ++e) ov[e] = 0.f;
#pragma unroll
            for (int w = 0; w < 8; ++w) { const float f = __expf(mw[w] - M_); const LAS float* pw = (const LAS float*)lds + (size_t)(w * 64 + jq) * NA_PP; L += f * pw[65];
#pragma unroll
                for (int e = 0; e < 8; ++e) ov[e] += f * pw[e8 * 8 + e]; }
            const float inv = 1.0f / L;
            u32x4 w4; w4.x = pk2h(ov[0] * inv, ov[1] * inv); w4.y = pk2h(ov[2] * inv, ov[3] * inv); w4.z = pk2h(ov[4] * inv, ov[5] * inv); w4.w = pk2h(ov[6] * inv, ov[7] * inv);
            *(u32x4*)(MIX + (size_t)(tok0 + i * 64 + jq) * 1024 + h * 64 + e8 * 8) = w4;
        }
        __syncthreads();
    }
}

__device__ __forceinline__ float shiftmix(const h16* base, size_t stride, int t, int T, float mu) {
    const float c = (float)base[0];
    const float p = (t > 0) ? (float)*(base - stride) : 0.f;
    const float n = (t < T - 1) ? (float)*(base + stride) : 0.f;
    return c + mu * (0.5f * (p + n) - c);
}
constexpr int SC_CH = 32;
constexpr int SC_OPB = SC_CH * 6 * 64 * 4;
constexpr int SC_YOFF = 2 * SC_OPB;
constexpr int SC_YB = SC_CH * 64 * 4;
constexpr int SC_XOFF = SC_YOFF + 2 * SC_YB;
constexpr int SC_ZOFF = SC_XOFF + 8192;
static_assert(SC_ZOFF + 4 * 4096 <= LDS_BYTES, "scan LDS");
__device__ __forceinline__ float wave_sum_fast(float v) {
    v = row16_sum(v);
    { const auto r = __builtin_amdgcn_permlane16_swap(__builtin_bit_cast(unsigned, v), __builtin_bit_cast(unsigned, v), false, false);
      const unsigned r0 = r[0], r1 = r[1]; v = __builtin_bit_cast(float, r0) + __builtin_bit_cast(float, r1); }
    { const auto r = __builtin_amdgcn_permlane32_swap(__builtin_bit_cast(unsigned, v), __builtin_bit_cast(unsigned, v), false, false);
      const unsigned r0 = r[0], r1 = r[1]; v = __builtin_bit_cast(float, r0) + __builtin_bit_cast(float, r1); }
    return v;
}
__device__ __forceinline__ float mix3(h16 p, h16 c, h16 n, float mu) { const float cf = (float)c; return cf + mu * (0.5f * ((float)p + (float)n) - cf); }
struct ScanWin { float r[10], k[10], v[10], wl[10], al[10]; };
__device__ __forceinline__ float mix3f(float p, float c, float n, float mu) { return c + mu * (0.5f * (p + n) - c); }
template <int R>
__device__ __forceinline__ void scan_flush(LAS unsigned char* lds, int cf, int pw, int lane, int d, int T, int tok0, int h, int rowbase, h16* Yf, h16* Yb) {
    const LAS float* yb = (const LAS float*)(lds + SC_YOFF + (cf & 1) * SC_YB);
    const int s = pw * 8 + (lane >> 3); const int g = cf * SC_CH + s; const int t = d ? (T - 1 - g) : g;
    if (R == 4) {
        const int r8 = (lane & 7) * 8;
        const f32x4 y0 = *(const LAS f32x4*)(yb + s * 64 + r8), y1 = *(const LAS f32x4*)(yb + s * 64 + r8 + 4);
        u32x4 w4; w4.x = pk2h(y0.x, y0.y); w4.y = pk2h(y0.z, y0.w); w4.z = pk2h(y1.x, y1.y); w4.w = pk2h(y1.z, y1.w);
        if (d == 0) *(u32x4*)(Yf + (size_t)(tok0 + t) * 1024 + 512 + h * 64 + r8) = w4; else *(u32x4*)(Yb + (size_t)(tok0 + t) * 512 + h * 64 + r8) = w4;
    } else {
        const int r4 = (lane & 7) * 4;
        const f32x4 y0 = *(const LAS f32x4*)(yb + s * 32 + r4);
        u32x2 w2; w2.x = pk2h(y0.x, y0.y); w2.y = pk2h(y0.z, y0.w);
        if (d == 0) *(u32x2*)(Yf + (size_t)(tok0 + t) * 1024 + 512 + h * 64 + rowbase + r4) = w2; else *(u32x2*)(Yb + (size_t)(tok0 + t) * 512 + h * 64 + rowbase + r4) = w2;
    }
}
template <int R>
__device__ __forceinline__ void scan_item(const Args& a, int layer, int q, int rowhalf, LAS unsigned char* lds, int tid, int lane, int wave) {
    int tok0, T, h, d;
    if (q < 32) { tok0 = MP + (q >> 4) * TS; T = TS; h = (q >> 1) & 7; d = q & 1; } else { const int q2 = q - 32; tok0 = (q2 >> 4) * TP; T = TP; h = (q2 >> 1) & 7; d = q2 & 1; }
    const int nch = T / SC_CH, rowbase = rowhalf * 16 * R;
    unsigned char* ws = a.ws; const int g = q < 32 ? 1 : 0;
    const h16* RR = GB_RR(g); const h16* RK = GB_RK(g); const h16* RV = GB_RV(g); const h16* LOWS = GB_LOWS(g);
    h16* Yf = GB_MIX(g); h16* Yb = GB_YB(g); float* BSC = GB_BSC(g);
    const size_t l = (size_t)layer;
    if (wave >= 4) {
        const int pw = wave - 4, j = lane, col = h * 64 + j;
        const float* mu = a.in[I_MU] + l * 1920;
        const float mu_r = mu[col], mu_k = mu[512 + col], mu_v = mu[1024 + col], mu_wl = mu[1536 + d * 64 + j], mu_al = mu[1536 + 128 + d * 64 + j];
        const float k_k = a.in[I_KK][l * 512 + col], k_a = a.in[I_KA][l * 512 + col], r_k = a.in[I_RK][l * 512 + col];
        const float w0 = a.in[I_W0][(l * 2 + d) * 512 + col], a0 = a.in[I_A0][(l * 2 + d) * 512 + col];
        h16x8 bw[4][2], ba[4][2];
        { const int n = lane & 15, kg = lane >> 4;
          const float* wu = a.in[I_WUP] + ((l * 2 + d) * 64 + 8 * kg) * 512 + h * 64 + n; const float* au = a.in[I_AUP] + ((l * 2 + d) * 64 + 8 * kg) * 512 + h * 64 + n;
#pragma unroll
          for (int ks = 0; ks < 2; ++ks) {
#pragma unroll
              for (int e = 0; e < 8; ++e) {
                  const float w_0 = wu[0], w_1 = wu[16], w_2 = wu[32], w_3 = wu[48], a_0 = au[0], a_1 = au[16], a_2 = au[32], a_3 = au[48];
                  wu += 512; au += 512; asm volatile("" : "+v"(wu), "+v"(au));
                  bw[0][ks][e] = (h16)w_0; bw[1][ks][e] = (h16)w_1; bw[2][ks][e] = (h16)w_2; bw[3][ks][e] = (h16)w_3;
                  ba[0][ks][e] = (h16)a_0; ba[1][ks][e] = (h16)a_1; ba[2][ks][e] = (h16)a_2; ba[3][ks][e] = (h16)a_3; }
              wu += 24 * 512; au += 24 * 512; asm volatile("" : "+v"(wu), "+v"(au)); } }
        LAS float* zl = (LAS float*)(lds + SC_ZOFF + pw * 4096);
        LAS unsigned char* xsb = lds + SC_XOFF + pw * 2048;
        ScanWin cur, nxt;
#define SCAN_LOAD_WIN(W_, cp_) do { const int g0_ = (cp_) * SC_CH + pw * 8; \
            _Pragma("unroll") for (int w = 0; w < 10; ++w) { const int tt = d ? (T - 1 - g0_) + 1 - w : g0_ - 1 + w; const bool ok = (tt >= 0) && (tt < T); const size_t tok = (size_t)(tok0 + (ok ? tt : 0)); \
                const h16 z_ = (h16)0.f; const h16 r_ = RR[tok * 512 + col], k_ = RK[tok * 512 + col], v_ = RV[tok * 512 + col], wl_ = LOWS[tok * 384 + d * 64 + j], al_ = LOWS[tok * 384 + 128 + d * 64 + j]; \
                W_.r[w] = (float)(ok ? r_ : z_); W_.k[w] = (float)(ok ? k_ : z_); W_.v[w] = (float)(ok ? v_ : z_); W_.wl[w] = (float)(ok ? wl_ : z_); W_.al[w] = (float)(ok ? al_ : z_); } } while (0)
        SCAN_LOAD_WIN(cur, 0);
        for (int c = -1; c < nch; ++c) {
            if (c >= 1) scan_flush<R>(lds, c - 1, pw, lane, d, T, tok0, h, rowbase, Yf, Yb);
            if (c + 1 < nch) {
                const int cp = c + 1; LAS float* op = (LAS float*)(lds + (cp & 1) * SC_OPB);
                if (c + 2 < nch) SCAN_LOAD_WIN(nxt, c + 2);
#pragma unroll
                for (int s8 = 0; s8 < 8; ++s8) {
                    const float wl = mix3f(cur.wl[s8], cur.wl[s8 + 1], cur.wl[s8 + 2], mu_wl);
                    const float al = mix3f(cur.al[s8], cur.al[s8 + 1], cur.al[s8 + 2], mu_al);
                    const float e2 = __expf(2.0f * wl); const float th = 1.0f - 2.0f * __builtin_amdgcn_rcpf(e2 + 1.0f);
                    LAS h16* xs = (LAS h16*)(xsb + s8 * 256);
                    xs[j] = (h16)th; xs[64 + j] = (h16)al;
                }
                {
                    const LAS unsigned char* xr = xsb + (lane & 7) * 256 + (lane >> 4) * 16;
                    const h16x8 xw0 = *(const LAS h16x8a*)(xr), xw1 = *(const LAS h16x8a*)(xr + 64), xa0 = *(const LAS h16x8a*)(xr + 128), xa1 = *(const LAS h16x8a*)(xr + 192);
                    f32x4 accw[4], acca[4];
#pragma unroll
                    for (int nt = 0; nt < 4; ++nt) {
                        accw[nt] = __builtin_amdgcn_mfma_f32_16x16x32_f16(xw0, bw[nt][0], (f32x4){0.f, 0.f, 0.f, 0.f}, 0, 0, 0);
                        accw[nt] = __builtin_amdgcn_mfma_f32_16x16x32_f16(xw1, bw[nt][1], accw[nt], 0, 0, 0);
                        acca[nt] = __builtin_amdgcn_mfma_f32_16x16x32_f16(xa0, ba[nt][0], (f32x4){0.f, 0.f, 0.f, 0.f}, 0, 0, 0);
                        acca[nt] = __builtin_amdgcn_mfma_f32_16x16x32_f16(xa1, ba[nt][1], acca[nt], 0, 0, 0); }
                    if (lane < 32) {
                        LAS float* zw = zl + (4 * (lane >> 4)) * 64 + (lane & 15);
#pragma unroll
                        for (int nt = 0; nt < 4; ++nt)
#pragma unroll
                            for (int r = 0; r < 4; ++r) { zw[r * 64 + 16 * nt] = accw[nt][r]; zw[512 + r * 64 + 16 * nt] = acca[nt][r]; }
                    }
                }
#pragma unroll
                for (int s8 = 0; s8 < 8; ++s8) {
                    const int s = pw * 8 + s8; const int g = cp * SC_CH + s; const int t = d ? (T - 1 - g) : g; const size_t tok = (size_t)(tok0 + t);
                    const float rr = mix3f(cur.r[s8], cur.r[s8 + 1], cur.r[s8 + 2], mu_r);
                    const float kk0 = mix3f(cur.k[s8], cur.k[s8 + 1], cur.k[s8 + 2], mu_k);
                    const float vv = mix3f(cur.v[s8], cur.v[s8 + 1], cur.v[s8 + 2], mu_v);
                    const float z = w0 + zl[s8 * 64 + j], az = a0 + zl[512 + s8 * 64 + j];
                    const float wdec = __expf(-0.606531f * sigmoidf_(z)); const float av = sigmoidf_(az);
                    float kk = kk0 * k_k; const float n2 = wave_sum_fast(kk * kk); kk = kk * __builtin_amdgcn_rsqf(fmaxf(n2, 1e-24f));
                    const float kd = kk0 * (1.0f + (av - 1.0f) * k_a); const float bb = kk * av;
                    const float bs = wave_sum_fast(rr * kd * r_k);
                    if (lane == 0 && rowhalf == 0) BSC[(tok * 8 + h) * 2 + d] = bs;
                    LAS float* o = op + s * 384 + j;
                    o[0] = -kk; o[64] = wdec; o[128] = bb; o[192] = kd; o[256] = rr; o[320] = vv;
                }
                cur = nxt;
            }
            __syncthreads();
        }
        scan_flush<R>(lds, nch - 1, pw, lane, d, T, tok0, h, rowbase, Yf, Yb);
#undef SCAN_LOAD_WIN
    } else {
        constexpr int RL = R / 2;
        const int ri = lane >> 3, ci = lane & 7;
        const int yrow = wave * 8 * RL + ri * RL, vrow = rowbase + yrow;
        f32x2 S[RL][4];
#pragma unroll
        for (int i = 0; i < RL; ++i)
#pragma unroll
            for (int c2 = 0; c2 < 4; ++c2) S[i][c2] = (f32x2){0.f, 0.f};
        typedef float vecR __attribute__((ext_vector_type(RL)));
        __syncthreads();
        for (int c = 0; c < nch; ++c) {
            const LAS f32x4* op = (const LAS f32x4*)(lds + (c & 1) * SC_OPB);
            LAS float* yb = (LAS float*)(lds + SC_YOFF + (c & 1) * SC_YB);
            f32x4 a0 = op[2 * ci], a1 = op[2 * ci + 1], w0 = op[16 + 2 * ci], w1 = op[17 + 2 * ci], b0 = op[32 + 2 * ci], b1 = op[33 + 2 * ci];
            f32x4 k0 = op[48 + 2 * ci], k1 = op[49 + 2 * ci], r0 = op[64 + 2 * ci], r1 = op[65 + 2 * ci]; vecR v4 = *(const LAS vecR*)((const LAS float*)op + 320 + vrow);
#pragma unroll 4
            for (int s = 0; s < SC_CH; ++s) {
                const LAS f32x4* on = op + (s + 1) * 96;
                const f32x4 na0 = on[2 * ci], na1 = on[2 * ci + 1], nw0 = on[16 + 2 * ci], nw1 = on[17 + 2 * ci], nb0 = on[32 + 2 * ci], nb1 = on[33 + 2 * ci];
                const f32x4 nk0 = on[48 + 2 * ci], nk1 = on[49 + 2 * ci], nr0 = on[64 + 2 * ci], nr1 = on[65 + 2 * ci]; const vecR nv4 = *(const LAS vecR*)((const LAS float*)on + 320 + vrow);
                const f32x2 av[4] = {{a0.x, a0.y}, {a0.z, a0.w}, {a1.x, a1.y}, {a1.z, a1.w}}, wv[4] = {{w0.x, w0.y}, {w0.z, w0.w}, {w1.x, w1.y}, {w1.z, w1.w}};
                const f32x2 bv[4] = {{b0.x, b0.y}, {b0.z, b0.w}, {b1.x, b1.y}, {b1.z, b1.w}}, kv[4] = {{k0.x, k0.y}, {k0.z, k0.w}, {k1.x, k1.y}, {k1.z, k1.w}};
                const f32x2 rv[4] = {{r0.x, r0.y}, {r0.z, r0.w}, {r1.x, r1.y}, {r1.z, r1.w}};
                float sa[RL];
#pragma unroll
                for (int i = 0; i < RL; ++i) { f32x2 p = S[i][0] * av[0]; p = S[i][1] * av[1] + p; p = S[i][2] * av[2] + p; p = S[i][3] * av[3] + p;
                    float t = p.x + p.y; t += dpp_f<0xB1>(t); t += dpp_f<0x4E>(t); t += dpp_f<0x141>(t); sa[i] = t; }
                vecR y;
#pragma unroll
                for (int i = 0; i < RL; ++i) { const f32x2 sa2 = {sa[i], sa[i]}, v2 = {v4[i], v4[i]};
#pragma unroll
                    for (int c2 = 0; c2 < 4; ++c2) S[i][c2] = S[i][c2] * wv[c2] + sa2 * bv[c2] + v2 * kv[c2];
                    f32x2 p = S[i][0] * rv[0]; p = S[i][1] * rv[1] + p; p = S[i][2] * rv[2] + p; p = S[i][3] * rv[3] + p;
                    float t = p.x + p.y; t += dpp_f<0xB1>(t); t += dpp_f<0x4E>(t); t += dpp_f<0x141>(t); y[i] = t; }
                if (ci == 0) *(LAS vecR*)(yb + s * (32 * RL) + yrow) = y;
                a0 = na0; a1 = na1; w0 = nw0; w1 = nw1; b0 = nb0; b1 = nb1; k0 = nk0; k1 = nk1; r0 = nr0; r1 = nr1; v4 = nv4;
            }
            __syncthreads();
        }
    }
}

__device__ __forceinline__ void rwpost_tile(const Args& a, int layer, int tile, LAS unsigned char* lds, int tid, int lane, int wave, const h16x2 (&gup)[64]) {
    const size_t l = (size_t)layer; const int col = tid, h = wave;
    const int m0 = tile * 64; int tok0s, T; if (m0 < MP) { T = TP; tok0s = (m0 / TP) * TP; } else { T = TS; tok0s = MP + ((m0 - MP) / TS) * TS; }
    unsigned char* ws = a.ws; const int g = m0 < MP ? 0 : 1;
    const h16* LOWS = GB_LOWS(g); const h16* RV = GB_RV(g); h16* MIX = GB_MIX(g); const h16* Yb = GB_YB(g); const float* BSC = GB_BSC(g);
    const float* mu = a.in[I_MU] + l * 1920;
    LAS h16* G = (LAS h16*)lds;
    { const int c = tid & 127; const float mug = mu[1536 + 256 + c];
#pragma unroll 4
      for (int e = tid; e < 64 * 128; e += NTHREADS) { const int tk = e >> 7; const int m = m0 + tk; const int t = m - tok0s;
        const float gl = shiftmix(LOWS + (size_t)m * 384 + 256 + c, 384, t, T, mug); G[e] = (h16)sigmoidf_(gl); } }
    const float mu_v = mu[1024 + col], lw = a.in[I_LNW][l * 512 + col], lb = a.in[I_LNB][l * 512 + col];
    __syncthreads();
#pragma unroll 1
    for (int tk0 = 0; tk0 < 64; tk0 += 8) {
        h16 ym[8], yb[8], rv[10]; float b0[8], b1[8];
#pragma unroll
        for (int w = 0; w < 10; ++w) { const int m = m0 + tk0 - 1 + w; const int t = m - tok0s; const bool ok = (t >= 0) && (t < T); const h16 v = RV[(size_t)(ok ? m : m0) * 512 + col]; rv[w] = ok ? v : (h16)0.f; }
#pragma unroll
        for (int jj = 0; jj < 8; ++jj) { const size_t m = (size_t)(m0 + tk0 + jj); ym[jj] = MIX[m * 1024 + 512 + col]; yb[jj] = Yb[m * 512 + col]; b0[jj] = BSC[(m * 8 + h) * 2]; b1[jj] = BSC[(m * 8 + h) * 2 + 1]; }
#pragma unroll
        for (int jj = 0; jj < 8; ++jj) {
            const int tk = tk0 + jj; const size_t m = (size_t)(m0 + tk);
            float gg = 0.f;
#pragma unroll
            for (int c8 = 0; c8 < 16; ++c8) { const u32x4 x = *(const LAS u32x4a*)((const LAS unsigned char*)G + tk * 256 + c8 * 16);
                gg = dot8w(x, gup[c8 * 4 + 0], gup[c8 * 4 + 1], gup[c8 * 4 + 2], gup[c8 * 4 + 3], gg); }
            const float wkv = (float)ym[jj] + (float)yb[jj];
            const float mean = wave_sum_fast(wkv) * (1.0f / 64.0f); const float dv = wkv - mean; const float var = wave_sum_fast(dv * dv) * (1.0f / 64.0f);
            const float yn = dv * __builtin_amdgcn_rsqf(var + 64e-5f) * lw + lb;
            const float vv = mix3(rv[jj], rv[jj + 1], rv[jj + 2], mu_v);
            MIX[m * 1024 + 512 + col] = (h16)((yn + (b0[jj] + b1[jj]) * vv) * gg);
        }
    }
    __syncthreads();
}

#define STAGE_ARGS const Args& args, int layer, int g, int nb, int cb, LAS unsigned char* lds
#define FRESH_TID int tid = threadIdx.x; asm volatile("" : "+v"(tid)); const int lane = tid & 63, wave = __builtin_amdgcn_readfirstlane(tid >> 6); (void)lane; (void)wave;
__device__ __forceinline__ int g_rows(int g) { return g ? MS : MP; }
__device__ __forceinline__ int g_pm0(int g) { return g ? MP / 256 : 0; }
template <class Epi> __device__ __forceinline__ void run_gemm(LAS unsigned char* lds, const h16* A, int lda, const h16* Bt, int N, int K, int g, int nb, int cb, const Epi& E, int tid) {
    pg8::Gemm gm{A, Bt, g_rows(g), N, K, lda}; pg8::StaticOrder S; S.init(g_rows(g), N, nb, cb, g_pm0(g)); pg8::gemm_phase(lds, gm, S, E, tid);
}
__device__ __forceinline__ void st_ffn_up(STAGE_ARGS, int which) {
    FRESH_TID unsigned char* ws = args.ws; const h16* W = (const h16*)(ws + WS_W);
    pg8::EpiSwiglu E{GB_ACT(g), (const float*)(ws + (which ? WS_SSA : WS_SSB))};
    run_gemm(lds, which ? GB_H16(g) : GB_H16B(g), D, W + (which ? W_FFN2U : W_FFN1U), 2 * FF, D, g, nb, cb, E, tid);
}
__device__ __forceinline__ void st_ffn_down(STAGE_ARGS, int which) {
    FRESH_TID unsigned char* ws = args.ws; const h16* W = (const h16*)(ws + WS_W); float* out = args.out;
    const bool first = (which == 0 && layer == 0);
    const float* rp = first ? args.in[I_XP] : (const float*)out; const float* rsm = first ? args.in[I_XS] - (size_t)MP * D : (const float*)out;
    pg8::EpiResid E{rp, rsm, out, GB_H16(g), (float*)(ws + WS_SSA), 0.5f};
    run_gemm(lds, GB_ACT(g), FF, W + (which ? W_FFN2D : W_FFN1D), D, FF, g, nb, cb, E, tid);
}
__device__ __forceinline__ void st_win(STAGE_ARGS) {
    FRESH_TID unsigned char* ws = args.ws; const h16* W = (const h16*)(ws + WS_W);
    pg8::EpiProj E{GB_MIX(g), GB_KNA(g), (size_t)512 * g_rows(g), GB_LOWS(g), (const float*)(ws + WS_SSA)};
    run_gemm(lds, GB_H16(g), D, W + W_IN, NPROJ, D, g, nb, cb, E, tid);
}
__device__ __forceinline__ void st_wout(STAGE_ARGS) {
    FRESH_TID unsigned char* ws = args.ws; const h16* W = (const h16*)(ws + WS_W); float* out = args.out;
    pg8::EpiResid E{out, out, out, GB_H16(g), (float*)(ws + WS_SSA), 1.0f};
    run_gemm(lds, GB_MIX(g), D, W + W_OUT, D, D, g, nb, cb, E, tid);
}
__device__ __forceinline__ void st_pu(STAGE_ARGS) {
    FRESH_TID unsigned char* ws = args.ws; const h16* W = (const h16*)(ws + WS_W);
    int kpu = PLE; asm volatile("" : "+s"(kpu));
    pg8::EpiPU E{GB_PU(g)};
    run_gemm(lds, GB_P16(g), kpu, W + W_UP, D, kpu, g, nb, cb, E, tid);
}
__device__ __forceinline__ void st_ple(STAGE_ARGS) {
    FRESH_TID unsigned char* ws = args.ws; const h16* W = (const h16*)(ws + WS_W); float* out = args.out;
    pg8::EpiPle E{out, GB_H16B(g), (float*)(ws + WS_SSB), (const float*)(ws + WS_SSA), GB_PU(g)};
    run_gemm(lds, GB_H16(g), D, W + W_GATE, D, D, g, nb, cb, E, tid);
}
__device__ __forceinline__ void st_rwpost(STAGE_ARGS) {
    FRESH_TID const int t0 = g ? MP / 64 : 0, nt = g_rows(g) / 64;
    h16x2 gup[64];
    { const float* gu = args.in[I_GUP] + (size_t)layer * 128 * 512 + tid;
#pragma unroll
      for (int i2 = 0; i2 < 64; ++i2) { const float g0 = gu[0], g1 = gu[512]; gu += 1024; asm volatile("" : "+v"(gu)); gup[i2] = (h16x2){(h16)g0, (h16)g1}; } }
    for (int tile = cb; tile < nt; tile += nb) rwpost_tile(args, layer, t0 + tile, lds, tid, lane, wave, gup);
}
__device__ __forceinline__ void st_convp(STAGE_ARGS) { FRESH_TID convert_p(args, layer, g, nb, cb, tid); }

__device__ __forceinline__ void sub_sync(unsigned* ctr, unsigned target) {
    asm volatile("s_waitcnt vmcnt(0) lgkmcnt(0)" ::: "memory");
    __syncthreads();
    if (threadIdx.x == 0) {
        __builtin_amdgcn_fence(__ATOMIC_RELEASE, "agent"); asm volatile("s_waitcnt vmcnt(0)" ::: "memory");
        __hip_atomic_fetch_add(ctr, 1u, __ATOMIC_RELAXED, __HIP_MEMORY_SCOPE_AGENT);
        while (__hip_atomic_load(ctr, __ATOMIC_RELAXED, __HIP_MEMORY_SCOPE_AGENT) < target) __builtin_amdgcn_s_sleep(2);
    }
    __syncthreads();
    __builtin_amdgcn_fence(__ATOMIC_ACQUIRE, "agent"); asm volatile("s_waitcnt vmcnt(0)" ::: "memory");
}

constexpr int NSB = 32;
__global__ void __launch_bounds__(NTHREADS, 2) fwd_megakernel(Args args) {
    extern __shared__ __attribute__((aligned(16))) unsigned char lds_raw[];
    LAS unsigned char* lds = (LAS unsigned char*)lds_raw;
    cg::grid_group grid = cg::this_grid();
    const int bid = blockIdx.x, G = gridDim.x;
    const int NPB = G - NSB, pb = bid - NSB;
    unsigned* ctr = (unsigned*)(args.ws + WS_CTR);
    if (bid == 0 && threadIdx.x == 0) __hip_atomic_store(ctr, 0u, __ATOMIC_RELAXED, __HIP_MEMORY_SCOPE_AGENT);
    unsigned sbt = 0;
#define SUBSYNC() do { sbt += (unsigned)NPB; sub_sync(ctr, sbt); } while (0)

    for (int layer = 0; layer < 2; ++layer) {
        { FRESH_TID phase_convert(args, layer, lds, tid, lane, wave, bid, G); }
        grid_sync(grid);
        st_ffn_up(args, layer, 1, G, bid, lds, 0); grid_sync(grid);
        st_ffn_down(args, layer, 1, G, bid, lds, 0); grid_sync(grid);
        st_win(args, layer, 1, G, bid, lds); grid_sync(grid);
        if (bid < NSB) {
            FRESH_TID scan_item<4>(args, layer, bid, 0, lds, tid, lane, wave);
        } else {
            st_ffn_up(args, layer, 0, NPB, pb, lds, 0); SUBSYNC();
            st_ffn_down(args, layer, 0, NPB, pb, lds, 0); SUBSYNC();
            st_win(args, layer, 0, NPB, pb, lds); SUBSYNC();
            { FRESH_TID
              scan_item<4>(args, layer, 32 + pb, 0, lds, tid, lane, wave); __syncthreads();
              if (pb < 2 * (256 - NPB)) { scan_item<2>(args, layer, 32 + NPB + (pb >> 1), pb & 1, lds, tid, lane, wave); __syncthreads(); }
              else { for (int it = pb - 2 * (256 - NPB); it < 1536; it += NPB - 2 * (256 - NPB)) na_item(args, layer, it, lds, tid, lane, wave); } }
            SUBSYNC();
            st_rwpost(args, layer, 0, NPB, pb, lds); SUBSYNC();
            st_wout(args, layer, 0, NPB, pb, lds); SUBSYNC();
            st_ffn_up(args, layer, 0, NPB, pb, lds, 1);
        }
        grid_sync(grid);
        st_rwpost(args, layer, 1, G, bid, lds); st_ffn_down(args, layer, 0, G, bid, lds, 1); st_convp(args, layer, 0, G, bid, lds); grid_sync(grid);
        st_wout(args, layer, 1, G, bid, lds); st_pu(args, layer, 0, G, bid, lds); grid_sync(grid);
        st_ffn_up(args, layer, 1, G, bid, lds, 1); st_ple(args, layer, 0, G, bid, lds); grid_sync(grid);
        st_ffn_down(args, layer, 1, G, bid, lds, 1); st_convp(args, layer, 1, G, bid, lds); grid_sync(grid);
        st_pu(args, layer, 1, G, bid, lds); grid_sync(grid);
        st_ple(args, layer, 1, G, bid, lds); grid_sync(grid);
    }
    {
        FRESH_TID
        const float* SSB = (const float*)(args.ws + WS_SSB); float* out = args.out;
        const int gw = bid * NWAVES + wave, NGW = G * NWAVES; const f32x4* gm = (const f32x4*)args.in[I_FINAL] + lane;
        f32x4 gv[4];
#pragma unroll
        for (int j = 0; j < 4; ++j) gv[j] = gm[64 * j];
        for (int m = gw; m < M; m += 2 * NGW) {
            const int m2 = m + NGW;
            const float rs = row_rstd(SSB, m), rs2 = row_rstd(SSB, m2); f32x4* o = (f32x4*)(out + (size_t)m * D) + lane; f32x4* o2 = (f32x4*)(out + (size_t)m2 * D) + lane;
            f32x4 v[4], v2[4];
#pragma unroll
            for (int j = 0; j < 4; ++j) { v[j] = o[64 * j]; v2[j] = o2[64 * j]; }
#pragma unroll
            for (int j = 0; j < 4; ++j) { o[64 * j] = v[j] * rs * gv[j]; o2[64 * j] = v2[j] * rs2 * gv[j]; }
        }
    }
}

extern "C" void kernel_launch(void* const* d_in, const int* in_sizes, int n_in, void* d_out, int out_size, void* d_ws, size_t ws_size, hipStream_t stream) {
    static int grid = 0;
    if (grid == 0) {
        if (n_in != N_IN || out_size != M * D || ws_size < WS_END) { fprintf(stderr, "kernel_launch: unexpected shapes (n_in %d, out %d, ws %zu)\n", n_in, out_size, ws_size); grid = -1; return; }
        int dev = 0, cus = 0, per_cu = 0;
        (void)hipGetDevice(&dev); (void)hipDeviceGetAttribute(&cus, hipDeviceAttributeMultiprocessorCount, dev);
        (void)hipFuncSetAttribute((const void*)fwd_megakernel, hipFuncAttributeMaxDynamicSharedMemorySize, LDS_BYTES);
        (void)hipOccupancyMaxActiveBlocksPerMultiprocessor(&per_cu, (const void*)fwd_megakernel, NTHREADS, LDS_BYTES);
        if (per_cu < 1) fprintf(stderr, "kernel_launch: occupancy query says %d blocks per CU\n", per_cu);
        grid = cus;
        if (grid != 256) fprintf(stderr, "kernel_launch: grid %d (expected 256)\n", grid);
        if (grid <= NSB + 64) { fprintf(stderr, "kernel_launch: grid too small\n"); grid = -1; return; }
    }
    if (grid < 0) return;
    Args a{};
    for (int i = 0; i < N_IN; ++i) a.in[i] = (const float*)d_in[i];
    a.out = (float*)d_out; a.ws = (unsigned char*)d_ws;
    void* kargs[] = {&a};
    hipError_t e = hipLaunchCooperativeKernel((const void*)fwd_megakernel, dim3(grid), dim3(NTHREADS), kargs, LDS_BYTES, stream);
    if (e != hipSuccess) fprintf(stderr, "kernel_launch: cooperative launch failed: %s\n", hipGetErrorString(e));
}
```

```cpp
#include <hip/hip_runtime.h>
#include <hip/hip_cooperative_groups.h>
#include <cstdio>
#include <cstdint>
namespace cg = cooperative_groups;
#ifndef PHM
#define PHM 0xFFFF
#endif
#define PH(k) ((PHM >> (k)) & 1)

#define LAS __attribute__((address_space(3)))
typedef _Float16 h16;
typedef _Float16 h16x2 __attribute__((ext_vector_type(2)));
typedef _Float16 h16x4 __attribute__((ext_vector_type(4)));
typedef _Float16 h16x8 __attribute__((ext_vector_type(8)));
typedef _Float16 h16x8a __attribute__((ext_vector_type(8), may_alias));
typedef float f32x2 __attribute__((ext_vector_type(2)));
typedef float f32x4 __attribute__((ext_vector_type(4)));
typedef float f32x16 __attribute__((ext_vector_type(16)));
typedef unsigned u32x2 __attribute__((ext_vector_type(2)));
typedef unsigned u32x4 __attribute__((ext_vector_type(4)));
typedef unsigned u32x4a __attribute__((ext_vector_type(4), may_alias));

constexpr int D = 1024, FF = 2816, MP = 65536, MS = 32768, M = MP + MS, TP = 4096, TS = 16384, PLE = 256;
constexpr int NPROJ = 3584;
constexpr int NTHREADS = 512, NWAVES = 8;
constexpr int LDS_BYTES = 151552;
constexpr size_t MiB = 1u << 20;
constexpr size_t WS_CTR = 256;
constexpr size_t WS_W = 1 * MiB;
constexpr size_t WS_SSA = 46 * MiB;
constexpr size_t WS_SSB = 52 * MiB;
constexpr size_t REG_P = 58 * MiB, REG_S = 682 * MiB, WS_END = 994 * MiB;
constexpr size_t OFF_H16 = 0;
constexpr size_t OFF_MIX = 2048;
constexpr size_t OFF_KNA = 4096, OFF_VNA = 5120, OFF_RR = 6144, OFF_RK = 7168, OFF_RV = 8192;
constexpr size_t OFF_LOWS = 9216;
constexpr size_t OFF_ACT = 2048;
constexpr size_t OFF_P16 = 7680;
constexpr size_t OFF_PU = 2048;
constexpr size_t OFF_H16B = 7680;
constexpr size_t OFF_YB = 0, OFF_BSC = 1024;
constexpr size_t OFF_END = 9984;
static_assert(REG_P + OFF_END * MP <= REG_S && REG_S + OFF_END * MS <= WS_END, "group regions");
__device__ __forceinline__ unsigned char* gbuf(unsigned char* ws, int g, size_t off, size_t stride) {
    const size_t reg = g ? REG_S : REG_P, rows = g ? (size_t)MS : (size_t)MP, row0 = g ? (size_t)MP : 0;
    return ws + (reg + off * rows - row0 * stride);
}
#define GB_H16(g)  ((h16*)gbuf(ws, g, OFF_H16, 2048))
#define GB_H16B(g) ((h16*)gbuf(ws, g, OFF_H16B, 2048))
#define GB_MIX(g)  ((h16*)gbuf(ws, g, OFF_MIX, 2048))
#define GB_KNA(g)  ((h16*)gbuf(ws, g, OFF_KNA, 1024))
#define GB_VNA(g)  ((h16*)gbuf(ws, g, OFF_VNA, 1024))
#define GB_RR(g)   ((h16*)gbuf(ws, g, OFF_RR, 1024))
#define GB_RK(g)   ((h16*)gbuf(ws, g, OFF_RK, 1024))
#define GB_RV(g)   ((h16*)gbuf(ws, g, OFF_RV, 1024))
#define GB_LOWS(g) ((h16*)gbuf(ws, g, OFF_LOWS, 768))
#define GB_ACT(g)  ((h16*)gbuf(ws, g, OFF_ACT, 5632))
#define GB_P16(g)  ((h16*)gbuf(ws, g, OFF_P16, 512))
#define GB_PU(g)   ((h16*)gbuf(ws, g, OFF_PU, 2048))
#define GB_YB(g)   ((h16*)gbuf(ws, g, OFF_YB, 1024))
#define GB_BSC(g)  ((float*)gbuf(ws, g, OFF_BSC, 64))
constexpr size_t W_FFN1U = 0;
constexpr size_t W_FFN1D = W_FFN1U + (size_t)5632 * 1024;
constexpr size_t W_IN = W_FFN1D + (size_t)1024 * 2816;
constexpr size_t W_OUT = W_IN + (size_t)3584 * 1024;
constexpr size_t W_FFN2U = W_OUT + (size_t)1024 * 1024;
constexpr size_t W_FFN2D = W_FFN2U + (size_t)5632 * 1024;
constexpr size_t W_GATE = W_FFN2D + (size_t)1024 * 2816;
constexpr size_t W_UP = W_GATE + (size_t)1024 * 1024;
constexpr size_t W_ENDE = W_UP + (size_t)1024 * 256;
static_assert(WS_W + W_ENDE * 2 <= WS_SSA, "weights fit");

enum { I_XP = 0, I_XS, I_PP, I_PS, I_F1N, I_F1G, I_F1U, I_F1D, I_MIXN, I_WIN, I_RPB, I_MU, I_W0, I_WUP, I_A0, I_AUP, I_GUP, I_KK, I_KA, I_RK, I_LNW, I_LNB,
       I_WOUT, I_F2N, I_F2G, I_F2U, I_F2D, I_PLEN, I_PLEG, I_PLEU, I_FINAL, N_IN };
struct Args { const float* in[N_IN]; float* out; unsigned char* ws; };

__device__ __forceinline__ float wave_sum(float v) {
#pragma unroll
    for (int o = 1; o < 64; o <<= 1) v += __shfl_xor(v, o);
    return v;
}
__device__ __forceinline__ unsigned pk2h(float a, float b) { h16x2 p = {(h16)a, (h16)b}; return __builtin_bit_cast(unsigned, p); }
__device__ __forceinline__ h16x2 as_h2(unsigned u) { return __builtin_bit_cast(h16x2, u); }
__device__ __forceinline__ float dot2h(unsigned a, h16x2 b, float c) { return __builtin_amdgcn_fdot2(as_h2(a), b, c, false); }
__device__ __forceinline__ float dot8(u32x4 a, u32x4 b, float c) { const unsigned a0 = a[0], a1 = a[1], a2 = a[2], a3 = a[3], b0 = b[0], b1 = b[1], b2 = b[2], b3 = b[3];
    c = __builtin_amdgcn_fdot2(as_h2(a0), as_h2(b0), c, false); c = __builtin_amdgcn_fdot2(as_h2(a1), as_h2(b1), c, false); c = __builtin_amdgcn_fdot2(as_h2(a2), as_h2(b2), c, false); c = __builtin_amdgcn_fdot2(as_h2(a3), as_h2(b3), c, false); return c; }
__device__ __forceinline__ float dot8w(u32x4 a, h16x2 w0, h16x2 w1, h16x2 w2, h16x2 w3, float c) { const unsigned a0 = a[0], a1 = a[1], a2 = a[2], a3 = a[3];
    c = __builtin_amdgcn_fdot2(as_h2(a0), w0, c, false); c = __builtin_amdgcn_fdot2(as_h2(a1), w1, c, false); c = __builtin_amdgcn_fdot2(as_h2(a2), w2, c, false); c = __builtin_amdgcn_fdot2(as_h2(a3), w3, c, false); return c; }
__device__ __forceinline__ float fma_mix_lo(float p, unsigned v, float o) { asm("v_fma_mix_f32 %0, %1, %2, %0 op_sel_hi:[0,1,0]" : "+v"(o) : "v"(p), "v"(v)); return o; }
__device__ __forceinline__ float fma_mix_hi(float p, unsigned v, float o) { asm("v_fma_mix_f32 %0, %1, %2, %0 op_sel:[0,1,0] op_sel_hi:[0,1,0]" : "+v"(o) : "v"(p), "v"(v)); return o; }
__device__ __forceinline__ float sigmoidf_(float x) { return __builtin_amdgcn_rcpf(1.0f + __expf(-x)); }
__device__ __forceinline__ float row_rstd(const float* ss, int row) {
    const f32x4* p = (const f32x4*)(ss + (size_t)row * 16);
    const f32x4 a = p[0], b = p[1], c = p[2], d = p[3];
    const float s = ((a.x + a.y) + (a.z + a.w)) + ((b.x + b.y) + (b.z + b.w)) + ((c.x + c.y) + (c.z + c.w)) + ((d.x + d.y) + (d.z + d.w));
    return __builtin_amdgcn_rsqf(s * (1.0f / 1024.0f) + 1e-6f);
}
template <int CTRL> __device__ __forceinline__ float dpp_f(float v) { return __builtin_bit_cast(float, __builtin_amdgcn_update_dpp(0, __builtin_bit_cast(int, v), CTRL, 0xF, 0xF, true)); }
__device__ __forceinline__ float row16_sum(float v) {
    v += dpp_f<0xB1>(v);
    v += dpp_f<0x4E>(v);
    v += dpp_f<0x141>(v);
    v += dpp_f<0x140>(v);
    return v;
}
__device__ __forceinline__ void grid_sync(cg::grid_group& grid) {
    asm volatile("s_waitcnt vmcnt(0) lgkmcnt(0)" ::: "memory"); grid.sync();
    __builtin_amdgcn_fence(__ATOMIC_ACQUIRE, "agent"); asm volatile("s_waitcnt vmcnt(0)" ::: "memory"); }

namespace pg8 {
constexpr int BM = 256, BK = 64, HALF = 128, HTB = HALF * BK * 2, STAGE_BYTES = 8 * HTB, NXCD = 8, WGM = 8;
__host__ __device__ __forceinline__ int lds_byte(int r, int c) { const int st = (r >> 4) * 2 + (c >> 5), rr = r & 15, cc = c & 31, ob = rr * 64 + cc * 2; return st * 1024 + (ob ^ (((ob >> 9) & 1) << 5)); }
__host__ __device__ __forceinline__ void stage_rc(int b, int& R, int& C) { const int st = b / 1024, sb = b % 1024, swz = sb ^ (((sb >> 9) & 1) << 5); R = (st >> 1) * 16 + swz / 64; C = (st & 1) * 32 + (swz % 64) / 2; }
__host__ __device__ __forceinline__ int perm32(int rho) { const int n = rho >> 4, i = rho & 15; return 8 * (i >> 2) + 4 * n + (i & 3); }
struct Unit { int pm, pn; };
struct Gemm { const h16* A; const h16* Bt; int M, N, K, lda; };
struct StaticOrder {
    int nM, nN, nwg, G, c, pm0;
    __device__ void init(int M_, int N_, int G_, int c_, int pm0_) { nM = M_ / BM; nN = N_ / BM; nwg = nM * nN; G = G_; c = c_; pm0 = pm0_; }
    __device__ bool next(int i, Unit& u) const {
        const long L = (long)i * G + c; if (L >= nwg) return false;
        int wgid = (int)L; { const int q = nwg / NXCD, r = nwg % NXCD, xcd = wgid % NXCD, off = wgid / NXCD; wgid = (xcd < r ? xcd * (q + 1) : r * (q + 1) + (xcd - r) * q) + off; }
        const int nig = WGM * nN, gid = wgid / nig, fm = gid * WGM, gsz = (nM - fm) < WGM ? (nM - fm) : WGM;
        u.pm = pm0 + fm + ((wgid % nig) % gsz); u.pn = (wgid % nig) / gsz; return true;
    }
};
typedef f32x4 Acc[2][2][4][2];

template <class Epi>
__device__ __forceinline__ void gemm_phase(LAS unsigned char* lds, const Gemm g, const StaticOrder& S, const Epi& E, const int tid) {
    const int wid = __builtin_amdgcn_readfirstlane(tid >> 6), lane = tid & 63, wr = wid >> 2, wc = wid & 3, fr = lane & 15, fq = lane >> 4;
    const int K = g.K, nt = K / BK, lda = g.lda;
    unsigned voffA[2], voffB[2];
#pragma unroll
    for (int i = 0; i < 2; ++i) { int R, C; stage_rc(tid * 16 + i * 8192, R, C); const int Rb = Epi::PERM ? ((R & ~31) + perm32(R & 31)) : R;
        voffA[i] = (unsigned)(R * lda + C) * 2u; voffB[i] = (unsigned)(Rb * K + C) * 2u; }
    const size_t kstep = (size_t)(BK * 2);
    const size_t hstepA = (size_t)HALF * lda * 2, hstepB = (size_t)HALF * K * 2;
    const size_t tstepA = 2 * hstepA, tstepB = 2 * hstepB;
    const unsigned ldsw = (unsigned)wid * 1024u;
    const int aoff = lds_byte(wr * 64 + fr, fq * 8), boff = lds_byte(wc * 32 + fr, fq * 8);
#define PG8_SA(b, h) (((b) * 2 + (h)) * HTB)
#define PG8_SB(b, h) ((4 + (b) * 2 + (h)) * HTB)
#define PG8_STAGE(bufoff, gbase, voff) do { _Pragma("unroll") for (int _i = 0; _i < 2; ++_i) \
        __builtin_amdgcn_global_load_lds((const unsigned*)((const char*)(gbase) + (voff)[_i]), (LAS unsigned*)(lds + (bufoff) + ldsw + _i * 8192), 16, 0, 0); } while (0)
#define PG8_LDA(dst, b, h) do { _Pragma("unroll") for (int m = 0; m < 4; ++m) _Pragma("unroll") for (int k = 0; k < 2; ++k) dst[m][k] = *(const LAS h16x8*)(lds + PG8_SA(b, h) + aoff + m * 2048 + k * 1024); } while (0)
#define PG8_LDB(dst, b, h) do { _Pragma("unroll") for (int n = 0; n < 2; ++n) _Pragma("unroll") for (int k = 0; k < 2; ++k) dst[n][k] = *(const LAS h16x8*)(lds + PG8_SB(b, h) + boff + n * 2048 + k * 1024); } while (0)
#define PG8_MMA(ai, bj, At, Bt) do { __builtin_amdgcn_s_setprio(1); _Pragma("unroll") for (int m = 0; m < 4; ++m) _Pragma("unroll") for (int n = 0; n < 2; ++n) _Pragma("unroll") for (int k = 0; k < 2; ++k) \
        acc[ai][bj][m][n] = __builtin_amdgcn_mfma_f32_16x16x32_f16(Bt[n][k], At[m][k], acc[ai][bj][m][n], 0, 0, 0); __builtin_amdgcn_s_setprio(0); } while (0)
#define PG8_WAIT_V(n) asm volatile("s_waitcnt vmcnt(" #n ")" ::: "memory")
#define PG8_WAIT_L(n) asm volatile("s_waitcnt lgkmcnt(" #n ")" ::: "memory")
#define PG8_BAR __builtin_amdgcn_s_barrier()
#define PG8_SCHED __builtin_amdgcn_sched_barrier(0)
    Unit cur, nxt; int ui = 0;
    if (!S.next(0, cur)) return;
    f32x4 acc[2][2][4][2];
#pragma unroll
    for (int a = 0; a < 2; ++a)
#pragma unroll
        for (int b = 0; b < 2; ++b)
#pragma unroll
            for (int m = 0; m < 4; ++m)
#pragma unroll
                for (int n = 0; n < 2; ++n) acc[a][b][m][n] = (f32x4){0.f, 0.f, 0.f, 0.f};
    h16x8 At[4][2], B0[2][2], B1[2][2];
    const char* cA = (const char*)g.A + (size_t)cur.pm * tstepA; const char* cB = (const char*)g.Bt + (size_t)cur.pn * tstepB;
    PG8_STAGE(PG8_SB(0, 0), cB, voffB); PG8_STAGE(PG8_SB(0, 1), cB + hstepB, voffB); PG8_STAGE(PG8_SA(0, 0), cA, voffA); PG8_STAGE(PG8_SA(0, 1), cA + hstepA, voffA);
    if (wr == 1) PG8_BAR;
    PG8_WAIT_V(2); PG8_BAR;
    PG8_STAGE(PG8_SB(1, 0), cB + kstep, voffB); PG8_STAGE(PG8_SA(1, 0), cA + kstep, voffA); PG8_STAGE(PG8_SB(1, 1), cB + hstepB + kstep, voffB);
    PG8_WAIT_V(6); PG8_BAR;
    for (;;) {
        const bool has_next = S.next(ui + 1, nxt);
        const char* nA = has_next ? (const char*)g.A + (size_t)nxt.pm * tstepA : cA; const char* nB = has_next ? (const char*)g.Bt + (size_t)nxt.pn * tstepB : cB;
        for (int t = 0; t < nt; t += 2) {
            const bool last = (t == nt - 2);
            const char* a1 = cA + (size_t)(t + 1) * kstep;
            const char* a2 = last ? nA : cA + (size_t)(t + 2) * kstep; const char* b2 = last ? nB : cB + (size_t)(t + 2) * kstep;
            const char* a3 = a2 + kstep; const char* b3 = b2 + kstep;
            PG8_LDB(B0, 0, 0); PG8_LDB(B1, 0, 1); PG8_SCHED; PG8_LDA(At, 0, 0); PG8_STAGE(PG8_SA(1, 1), a1 + hstepA, voffA);
            PG8_WAIT_V(8); PG8_WAIT_L(0); PG8_BAR; PG8_MMA(0, 0, At, B0); PG8_MMA(0, 1, At, B1); PG8_BAR; PG8_SCHED;
            PG8_LDA(At, 0, 1); PG8_STAGE(PG8_SB(0, 0), b2, voffB); PG8_STAGE(PG8_SB(0, 1), b2 + hstepB, voffB); PG8_STAGE(PG8_SA(0, 0), a2, voffA);
            PG8_WAIT_V(8); PG8_WAIT_L(0); PG8_BAR; PG8_MMA(1, 0, At, B0); PG8_MMA(1, 1, At, B1); PG8_BAR; PG8_SCHED;
            PG8_LDB(B0, 1, 0); PG8_LDB(B1, 1, 1); PG8_SCHED; PG8_LDA(At, 1, 0); PG8_STAGE(PG8_SA(0, 1), a2 + hstepA, voffA);
            PG8_WAIT_V(8); PG8_WAIT_L(0); PG8_BAR; PG8_MMA(0, 0, At, B0); PG8_MMA(0, 1, At, B1); PG8_BAR; PG8_SCHED;
            PG8_LDA(At, 1, 1); PG8_STAGE(PG8_SB(1, 0), b3, voffB); PG8_STAGE(PG8_SB(1, 1), b3 + hstepB, voffB); PG8_STAGE(PG8_SA(1, 0), a3, voffA);
            PG8_WAIT_V(8); PG8_WAIT_L(0); PG8_BAR; PG8_MMA(1, 0, At, B0); PG8_MMA(1, 1, At, B1); PG8_BAR; PG8_SCHED;
        }
        if (wr == 0) PG8_BAR;
        E(acc, cur, wr, wc, fr, fq);
        if (!has_next) break;
#pragma unroll
        for (int a = 0; a < 2; ++a)
#pragma unroll
            for (int b = 0; b < 2; ++b)
#pragma unroll
                for (int m = 0; m < 4; ++m)
#pragma unroll
                    for (int n = 0; n < 2; ++n) acc[a][b][m][n] = (f32x4){0.f, 0.f, 0.f, 0.f};
        cur = nxt; cA = nA; cB = nB; ++ui;
        if (wr == 1) PG8_BAR;
    }
    PG8_WAIT_V(0);
    PG8_BAR;
#undef PG8_SA
#undef PG8_SB
#undef PG8_STAGE
#undef PG8_LDA
#undef PG8_LDB
#undef PG8_MMA
#undef PG8_WAIT_V
#undef PG8_WAIT_L
#undef PG8_BAR
#undef PG8_SCHED
}


struct EpiSwiglu {
    static constexpr bool PERM = true;
    h16* O; const float* ss;
    __device__ __forceinline__ void operator()(const Acc& acc, const Unit& u, int wr, int wc, int fr, int fq) const {
        const int row0 = u.pm * BM + wr * 64 + fr, col0 = u.pn * 128 + wc * 32 + 8 * fq;
#pragma unroll
        for (int ai = 0; ai < 2; ++ai)
#pragma unroll
            for (int m = 0; m < 4; ++m) {
                const int row = row0 + ai * HALF + m * 16; const float rs = row_rstd(ss, row);
                float o[8];
#pragma unroll
                for (int n = 0; n < 2; ++n)
#pragma unroll
                    for (int j = 0; j < 4; ++j) { const float gg = acc[ai][0][m][n][j] * rs, uu = acc[ai][1][m][n][j] * rs; o[n * 4 + j] = gg * sigmoidf_(gg) * uu; }
                u32x4 w; w.x = pk2h(o[0], o[1]); w.y = pk2h(o[2], o[3]); w.z = pk2h(o[4], o[5]); w.w = pk2h(o[6], o[7]);
                *(u32x4*)(O + (size_t)row * FF + col0) = w;
            }
    }
};
struct EpiResid {
    static constexpr bool PERM = false;
    const float* res_p; const float* res_s; float* out; h16* o16; float* ss; float alpha;
    __device__ __forceinline__ void operator()(const Acc& acc, const Unit& u, int wr, int wc, int fr, int fq) const {
        const int row0 = u.pm * BM + wr * 64 + fr, col0 = u.pn * BM + wc * 32 + 4 * fq;
        const float* res = (u.pm * BM < MP) ? res_p : res_s;
#pragma unroll
        for (int ai = 0; ai < 2; ++ai)
#pragma unroll
            for (int m = 0; m < 4; ++m) {
                const int row = row0 + ai * HALF + m * 16; const size_t off = (size_t)row * D + col0; float sq = 0.f;
#pragma unroll
                for (int bj = 0; bj < 2; ++bj)
#pragma unroll
                    for (int n = 0; n < 2; ++n) { const size_t o = off + bj * HALF + n * 16; const f32x4 r = *(const f32x4*)(res + o); const f32x4 v = r + acc[ai][bj][m][n] * alpha;
                        *(f32x4*)(out + o) = v; u32x2 w; w.x = pk2h(v.x, v.y); w.y = pk2h(v.z, v.w); *(u32x2*)(o16 + o) = w; sq += (v.x * v.x + v.y * v.y) + (v.z * v.z + v.w * v.w); }
                sq += __shfl_xor(sq, 16); sq += __shfl_xor(sq, 32);
                if (fq == 0) ss[(size_t)row * 16 + u.pn * 4 + wc] = sq;
                asm volatile("" ::: "memory");
            }
    }
};
struct EpiProj {
    static constexpr bool PERM = true;
    h16* mix; h16* kna; size_t bufstep; h16* lows; const float* ss;
    __device__ __forceinline__ void operator()(const Acc& acc, const Unit& u, int wr, int wc, int fr, int fq) const {
        const int pn = u.pn; h16* base; int ldc, c0; float sc = 1.f; int nbj = 2;
        if (pn < 2) { base = mix; ldc = 1024; c0 = pn * 256; sc = 0.125f; }
        else if (pn < 12) { base = kna + (size_t)((pn - 2) >> 1) * bufstep; ldc = 512; c0 = ((pn - 2) & 1) * 256; }
        else { base = lows; ldc = 384; c0 = (pn - 12) * 256; if (pn == 13) nbj = 1; }
        const int row0 = u.pm * BM + wr * 64 + fr, col0 = c0 + wc * 32 + 8 * fq;
#pragma unroll
        for (int ai = 0; ai < 2; ++ai)
#pragma unroll
            for (int m = 0; m < 4; ++m) {
                const int row = row0 + ai * HALF + m * 16; const float rs = row_rstd(ss, row) * sc;
#pragma unroll
                for (int bj = 0; bj < 2; ++bj) if (bj < nbj) {
                    const f32x4 v0 = acc[ai][bj][m][0] * rs, v1 = acc[ai][bj][m][1] * rs;
                    u32x4 w; w.x = pk2h(v0.x, v0.y); w.y = pk2h(v0.z, v0.w); w.z = pk2h(v1.x, v1.y); w.w = pk2h(v1.z, v1.w);
                    *(u32x4*)(base + (size_t)row * ldc + col0 + bj * HALF) = w; }
            }
    }
};
struct EpiPU {
    static constexpr bool PERM = true;
    h16* O;
    __device__ __forceinline__ void operator()(const Acc& acc, const Unit& u, int wr, int wc, int fr, int fq) const {
        const int row0 = u.pm * BM + wr * 64 + fr, col0 = u.pn * BM + wc * 32 + 8 * fq;
#pragma unroll
        for (int ai = 0; ai < 2; ++ai)
#pragma unroll
            for (int m = 0; m < 4; ++m) {
                const int row = row0 + ai * HALF + m * 16;
#pragma unroll
                for (int bj = 0; bj < 2; ++bj) {
                    const f32x4 v0 = acc[ai][bj][m][0], v1 = acc[ai][bj][m][1];
                    u32x4 w; w.x = pk2h(v0.x, v0.y); w.y = pk2h(v0.z, v0.w); w.z = pk2h(v1.x, v1.y); w.w = pk2h(v1.z, v1.w);
                    *(u32x4*)(O + (size_t)row * D + col0 + bj * HALF) = w; }
            }
    }
};
struct EpiPle {
    static constexpr bool PERM = false;
    float* out; h16* o16; float* ssw; const float* ssr; const h16* pu;
    __device__ __forceinline__ void operator()(const Acc& acc, const Unit& u, int wr, int wc, int fr, int fq) const {
        const int row0 = u.pm * BM + wr * 64 + fr, col0 = u.pn * BM + wc * 32 + 4 * fq;
#pragma unroll
        for (int ai = 0; ai < 2; ++ai)
#pragma unroll
            for (int m = 0; m < 4; ++m) {
                const int row = row0 + ai * HALF + m * 16; const size_t off = (size_t)row * D + col0; float sq = 0.f; const float rs = row_rstd(ssr, row);
#pragma unroll
                for (int bj = 0; bj < 2; ++bj)
#pragma unroll
                    for (int n = 0; n < 2; ++n) { const size_t o = off + bj * HALF + n * 16; const f32x4 r = *(const f32x4*)(out + o); const h16x4 p = *(const h16x4*)(pu + o);
                        const f32x4 a = acc[ai][bj][m][n] * rs; f32x4 v;
                        v.x = r.x + sigmoidf_(a.x) * (float)p.x; v.y = r.y + sigmoidf_(a.y) * (float)p.y; v.z = r.z + sigmoidf_(a.z) * (float)p.z; v.w = r.w + sigmoidf_(a.w) * (float)p.w;
                        *(f32x4*)(out + o) = v; u32x2 w; w.x = pk2h(v.x, v.y); w.y = pk2h(v.z, v.w); *(u32x2*)(o16 + o) = w; sq += (v.x * v.x + v.y * v.y) + (v.z * v.z + v.w * v.w); }
                sq += __shfl_xor(sq, 16); sq += __shfl_xor(sq, 32);
                if (fq == 0) ssw[(size_t)row * 16 + u.pn * 4 + wc] = sq;
                asm volatile("" ::: "memory");
            }
    }
};
}

__device__ __forceinline__ void convert_matrix(const float* W, int K, int N, const float* gamma, h16* WT, int mode, LAS float* scr, int gw, int NGW, int lane) {
    const int nblk = N / 32, nitems = (K / 64) * nblk;
    for (int item = gw; item < nitems; item += NGW) {
        const int kb = item / nblk, nb = item % nblk, k0 = 64 * kb, n0 = 32 * nb;
        const int drow0 = (mode == 0) ? n0 : ((n0 >> 7) * 256 + (n0 & 127) + (mode == 2 ? 128 : 0));
#pragma unroll 8
        for (int i = 0; i < 32; ++i) { const int kk = 2 * i + (lane >> 5); float v = W[(size_t)(k0 + kk) * N + n0 + (lane & 31)]; if (gamma) v *= gamma[k0 + kk]; scr[kk * 33 + (lane & 31)] = v; }
        asm volatile("s_waitcnt lgkmcnt(0)" ::: "memory");
        const int c = lane & 7;
#pragma unroll
        for (int j = 0; j < 4; ++j) { const int n = (lane >> 3) + 8 * j; const LAS float* s = scr + (8 * c) * 33 + n;
            u32x4 o; o.x = pk2h(s[0 * 33], s[1 * 33]); o.y = pk2h(s[2 * 33], s[3 * 33]); o.z = pk2h(s[4 * 33], s[5 * 33]); o.w = pk2h(s[6 * 33], s[7 * 33]);
            *(u32x4*)(WT + (size_t)(drow0 + n) * K + k0 + 8 * c) = o; }
        asm volatile("s_waitcnt lgkmcnt(0)" ::: "memory");
    }
}

__device__ __forceinline__ void phase_convert(const Args& a, int layer, LAS unsigned char* lds, int tid, int lane, int wave, int bid, int G) {
    LAS float* scr = (LAS float*)(lds + wave * 16384);
    const int gw = bid * NWAVES + wave, NGW = G * NWAVES;
    h16* W = (h16*)(a.ws + WS_W);
    const size_t l = (size_t)layer;
    convert_matrix(a.in[I_F1G] + l * D * FF, D, FF, a.in[I_F1N] + l * D, W + W_FFN1U, 1, scr, gw, NGW, lane);
    convert_matrix(a.in[I_F1U] + l * D * FF, D, FF, a.in[I_F1N] + l * D, W + W_FFN1U, 2, scr, gw, NGW, lane);
    convert_matrix(a.in[I_F1D] + l * FF * D, FF, D, nullptr, W + W_FFN1D, 0, scr, gw, NGW, lane);
    convert_matrix(a.in[I_WIN] + l * D * 3456, D, 3456, a.in[I_MIXN] + l * D, W + W_IN, 0, scr, gw, NGW, lane);
    convert_matrix(a.in[I_WOUT] + l * D * D, D, D, nullptr, W + W_OUT, 0, scr, gw, NGW, lane);
    convert_matrix(a.in[I_F2G] + l * D * FF, D, FF, a.in[I_F2N] + l * D, W + W_FFN2U, 1, scr, gw, NGW, lane);
    convert_matrix(a.in[I_F2U] + l * D * FF, D, FF, a.in[I_F2N] + l * D, W + W_FFN2U, 2, scr, gw, NGW, lane);
    convert_matrix(a.in[I_F2D] + l * FF * D, FF, D, nullptr, W + W_FFN2D, 0, scr, gw, NGW, lane);
    convert_matrix(a.in[I_PLEG] + l * D * D, D, D, a.in[I_PLEN] + l * D, W + W_GATE, 0, scr, gw, NGW, lane);
    convert_matrix(a.in[I_PLEU] + l * PLE * D, PLE, D, nullptr, W + W_UP, 0, scr, gw, NGW, lane);
    { u32x4* z = (u32x4*)(W + W_IN + (size_t)3456 * 1024); const int n16 = 128 * 1024 * 2 / 16;
      for (int i = bid * NTHREADS + tid; i < n16; i += G * NTHREADS) z[i] = (u32x4){0u, 0u, 0u, 0u}; }
    if (layer == 0) {
        unsigned char* ws = a.ws; h16* Hp = GB_H16B(0); h16* Hs = GB_H16B(1); float* ss = (float*)(a.ws + WS_SSB);
        for (int m = gw; m < M; m += NGW) {
            h16* H = (m < MP) ? Hp : Hs;
            const float* xr = (m < MP) ? a.in[I_XP] + (size_t)m * D : a.in[I_XS] + (size_t)(m - MP) * D;
            const f32x4* x4 = (const f32x4*)xr + lane; float s = 0.f;
            u32x2* o = (u32x2*)(H + (size_t)m * D) + lane;
#pragma unroll
            for (int j = 0; j < 4; ++j) { const f32x4 v = x4[64 * j]; s += (v.x * v.x + v.y * v.y) + (v.z * v.z + v.w * v.w); u32x2 w; w.x = pk2h(v.x, v.y); w.y = pk2h(v.z, v.w); o[64 * j] = w; }
            s = wave_sum(s);
            if (lane < 16) ss[(size_t)m * 16 + lane] = (lane == 0) ? s : 0.f;
        }
    }
}

__device__ __forceinline__ void convert_p(const Args& a, int layer, int g, int nb, int cb, int tid) {
    unsigned char* ws = a.ws; const int rows = g ? MS : MP, row0 = g ? MP : 0;
    u32x2* o = (u32x2*)(GB_P16(g) + (size_t)row0 * PLE);
    const f32x4* p = (const f32x4*)((g ? a.in[I_PS] + (size_t)layer * MS * PLE : a.in[I_PP] + (size_t)layer * MP * PLE));
    const int N4 = rows * PLE / 4;
    for (int i = cb * NTHREADS + tid; i < N4; i += nb * NTHREADS) { const f32x4 v = p[i]; u32x2 w; w.x = pk2h(v.x, v.y); w.y = pk2h(v.z, v.w); o[i] = w; }
}

constexpr int NA_PITCH = 144;
constexpr int NA_VOFF = 512 * NA_PITCH;
constexpr int NA_PP = 67;
constexpr int NA_BTOFF = 2 * 512 * NA_PITCH;
__device__ __forceinline__ void na_item(const Args& a, int layer, int item, LAS unsigned char* lds, int tid, int lane, int wave) {
    int tok0, i, rows;
    if (item < 1024) { tok0 = (item >> 6) * TP; i = item & 63; rows = 64; } else { const int it2 = item - 1024; tok0 = MP + (it2 >> 8) * TS; i = it2 & 255; rows = 256; }
    int rs = i - 4; rs = rs < 0 ? 0 : (rs > rows - 8 ? rows - 8 : rs);
    unsigned char* ws = a.ws; const int g = item < 1024 ? 0 : 1;
    h16* MIX = GB_MIX(g); const h16* KNA = GB_KNA(g); const h16* VNA = GB_VNA(g);
    const float* rpb = a.in[I_RPB] + (size_t)layer * 8 * 15 * 31;
    const int wtok0 = tok0 + rs * 64;
    const int j = lane, aw = wave;
    const int tokq = tok0 + i * 64 + j;
    int cs = j - 8; cs = cs < 0 ? 0 : (cs > 48 ? 48 : cs);
    const int l31 = lane & 31, half = lane >> 5;
    LAS float* bt = (LAS float*)(lds + NA_BTOFF) + wave * 128;
    bt[lane] = 0.f; bt[64 + lane] = 0.f;
    u32x4 kreg[8], vreg[8];
    const size_t kvoff = (size_t)(wtok0 + (tid >> 3)) * 512 + (tid & 7) * 8;
#pragma unroll
    for (int it = 0; it < 8; ++it) { kreg[it] = *(const u32x4*)(KNA + kvoff + (size_t)it * (64 * 512)); vreg[it] = *(const u32x4*)(VNA + kvoff + (size_t)it * (64 * 512)); }
#pragma unroll 1
    for (int h = 0; h < 8; ++h) {
#pragma unroll
        for (int it = 0; it < 8; ++it) { const int key = (tid >> 3) + 64 * it, ch = tid & 7;
            *(LAS u32x4*)(lds + key * NA_PITCH + ch * 16) = kreg[it]; *(LAS u32x4*)(lds + NA_VOFF + key * NA_PITCH + ch * 16) = vreg[it]; }
        h16x8 qf[2][4];
#pragma unroll
        for (int nt = 0; nt < 2; ++nt)
#pragma unroll
            for (int ks = 0; ks < 4; ++ks) qf[nt][ks] = *(const h16x8*)(MIX + (size_t)(tok0 + i * 64 + l31 + 32 * nt) * 1024 + h * 64 + 16 * ks + 8 * half);
        if (lane < 31) bt[48 + lane] = rpb[((size_t)h * 15 + (rs + aw - i + 7)) * 31 + lane];
        __syncthreads();
        if (h + 1 < 8) {
#pragma unroll
            for (int it = 0; it < 8; ++it) { kreg[it] = *(const u32x4*)(KNA + kvoff + (size_t)it * (64 * 512) + (h + 1) * 64); vreg[it] = *(const u32x4*)(VNA + kvoff + (size_t)it * (64 * 512) + (h + 1) * 64); }
        }
        f32x16 acc[2][2];
#pragma unroll
        for (int mt = 0; mt < 2; ++mt)
#pragma unroll
            for (int nt = 0; nt < 2; ++nt)
#pragma unroll
                for (int r = 0; r < 16; ++r) acc[mt][nt][r] = 0.f;
#pragma unroll
        for (int mt = 0; mt < 2; ++mt)
#pragma unroll
            for (int ks = 0; ks < 4; ++ks) {
                const h16x8 kf = *(const LAS h16x8*)(lds + (aw * 64 + 32 * mt + l31) * NA_PITCH + (16 * ks + 8 * half) * 2);
                acc[mt][0] = __builtin_amdgcn_mfma_f32_32x32x16_f16(kf, qf[0][ks], acc[mt][0], 0, 0, 0);
                acc[mt][1] = __builtin_amdgcn_mfma_f32_32x32x16_f16(kf, qf[1][ks], acc[mt][1], 0, 0, 0);
            }
        float mxq[2], lq[2];
#pragma unroll
        for (int nt = 0; nt < 2; ++nt) {
            const int qc = l31 + 32 * nt; int csq = qc - 8; csq = csq < 0 ? 0 : (csq > 48 ? 48 : csq);
            const int dlt = 4 * half - csq;
            const LAS float* bq = bt + (48 + 15 + 4 * half - qc - 32);
            float m = -3.0e38f;
#pragma unroll
            for (int mt = 0; mt < 2; ++mt)
#pragma unroll
                for (int r = 0; r < 16; ++r) { const int kr = (r & 3) + 8 * (r >> 2) + 32 * mt;
                    const float sv = acc[mt][nt][r] + bq[32 + kr]; const bool ok = (unsigned)(dlt + kr) < 16u; const float sm = ok ? sv : -1.0e30f; acc[mt][nt][r] = sm; m = fmaxf(m, sm); }
            { const auto sw = __builtin_amdgcn_permlane32_swap(__builtin_bit_cast(unsigned, m), __builtin_bit_cast(unsigned, m), false, false); const unsigned s0 = sw[0], s1 = sw[1]; m = fmaxf(__builtin_bit_cast(float, s0), __builtin_bit_cast(float, s1)); }
            float l = 0.f;
#pragma unroll
            for (int mt = 0; mt < 2; ++mt)
#pragma unroll
                for (int r = 0; r < 16; ++r) { const float p = __expf(acc[mt][nt][r] - m); acc[mt][nt][r] = p; l += p; }
            { const auto sw = __builtin_amdgcn_permlane32_swap(__builtin_bit_cast(unsigned, l), __builtin_bit_cast(unsigned, l), false, false); const unsigned s0 = sw[0], s1 = sw[1]; l = __builtin_bit_cast(float, s0) + __builtin_bit_cast(float, s1); }
            mxq[nt] = m; lq[nt] = l;
        }
        h16x8 pf[2][2][2];
#pragma unroll
        for (int kt = 0; kt < 2; ++kt)
#pragma unroll
            for (int nt = 0; nt < 2; ++nt)
#pragma unroll
                for (int sx = 0; sx < 2; ++sx)
#pragma unroll
                    for (int e = 0; e < 8; ++e) pf[kt][nt][sx][e] = (h16)acc[kt][nt][8 * sx + e];
        f32x16 o[2][2];
#pragma unroll
        for (int dm = 0; dm < 2; ++dm)
#pragma unroll
            for (int nt = 0; nt < 2; ++nt)
#pragma unroll
                for (int r = 0; r < 16; ++r) o[dm][nt][r] = 0.f;
#pragma unroll
        for (int dm = 0; dm < 2; ++dm)
#pragma unroll
            for (int kt = 0; kt < 2; ++kt)
#pragma unroll
                for (int sx = 0; sx < 2; ++sx) {
                    h16x8 vf;
                    const LAS unsigned char* vb = lds + NA_VOFF + (aw * 64 + 32 * kt + 16 * sx + 4 * half) * NA_PITCH + (l31 + 32 * dm) * 2;
#pragma unroll
                    for (int e = 0; e < 8; ++e) vf[e] = *(const LAS h16*)(vb + ((e & 3) + 8 * (e >> 2)) * NA_PITCH);
                    o[dm][0] = __builtin_amdgcn_mfma_f32_32x32x16_f16(vf, pf[kt][0][sx], o[dm][0], 0, 0, 0);
                    o[dm][1] = __builtin_amdgcn_mfma_f32_32x32x16_f16(vf, pf[kt][1][sx], o[dm][1], 0, 0, 0);
                }
        __syncthreads();
#pragma unroll
        for (int nt = 0; nt < 2; ++nt) {
            LAS float* part = (LAS float*)lds + (size_t)(aw * 64 + l31 + 32 * nt) * NA_PP;
#pragma unroll
            for (int dm = 0; dm < 2; ++dm)
#pragma unroll
                for (int r = 0; r < 16; ++r) part[(r & 3) + 8 * (r >> 2) + 4 * half + 32 * dm] = o[dm][nt][r];
            if (half == 0) { part[64] = mxq[nt]; part[65] = lq[nt]; }
        }
        __syncthreads();
        {
            const int jq = tid & 63, e8 = tid >> 6;
            float mw[8], M_ = -3.0e38f;
#pragma unroll
            for (int w = 0; w < 8; ++w) { mw[w] = ((const LAS float*)lds)[(size_t)(w * 64 + jq) * NA_PP + 64]; M_ = fmaxf(M_, mw[w]); }
            float L = 0.f, ov[8];
#pragma unroll
            for (int e = 0; e < 8; ++e) ov[e] = 0.f;
#pragma unroll
            for (int w = 0; w < 8; ++w) { const float f = __expf(mw[w] - M_); const LAS float* pw = (const LAS float*)lds + (size_t)(w * 64 + jq) * NA_PP; L += f * pw[65];
#pragma unroll
                for (int e = 0; e < 8; ++e) ov[e] += f * pw[e8 * 8 + e]; }
            const float inv = 1.0f / L;
            u32x4 w4; w4.x = pk2h(ov[0] * inv, ov[1] * inv); w4.y = pk2h(ov[2] * inv, ov[3] * inv); w4.z = pk2h(ov[4] * inv, ov[5] * inv); w4.w = pk2h(ov[6] * inv, ov[7] * inv);
            *(u32x4*)(MIX + (size_t)(tok0 + i * 64 + jq) * 1024 + h * 64 + e8 * 8) = w4;
        }
        __syncthreads();
    }
}

__device__ __forceinline__ float shiftmix(const h16* base, size_t stride, int t, int T, float mu) {
    const float c = (float)base[0];
    const float p = (t > 0) ? (float)*(base - stride) : 0.f;
    const float n = (t < T - 1) ? (float)*(base + stride) : 0.f;
    return c + mu * (0.5f * (p + n) - c);
}
constexpr int SC_CH = 32;
constexpr int SC_OPB = SC_CH * 6 * 64 * 4;
constexpr int SC_YOFF = 2 * SC_OPB;
constexpr int SC_YB = SC_CH * 64 * 4;
constexpr int SC_XOFF = SC_YOFF + 2 * SC_YB;
constexpr int SC_ZOFF = SC_XOFF + 8192;
static_assert(SC_ZOFF + 4 * 4096 <= LDS_BYTES, "scan LDS");
__device__ __forceinline__ float wave_sum_fast(float v) {
    v = row16_sum(v);
    { const auto r = __builtin_amdgcn_permlane16_swap(__builtin_bit_cast(unsigned, v), __builtin_bit_cast(unsigned, v), false, false);
      const unsigned r0 = r[0], r1 = r[1]; v = __builtin_bit_cast(float, r0) + __builtin_bit_cast(float, r1); }
    { const auto r = __builtin_amdgcn_permlane32_swap(__builtin_bit_cast(unsigned, v), __builtin_bit_cast(unsigned, v), false, false);
      const unsigned r0 = r[0], r1 = r[1]; v = __builtin_bit_cast(float, r0) + __builtin_bit_cast(float, r1); }
    return v;
}
__device__ __forceinline__ float mix3(h16 p, h16 c, h16 n, float mu) { const float cf = (float)c; return cf + mu * (0.5f * ((float)p + (float)n) - cf); }
struct ScanWin { float r[10], k[10], v[10], wl[10], al[10]; };
__device__ __forceinline__ float mix3f(float p, float c, float n, float mu) { return c + mu * (0.5f * (p + n) - c); }
template <int R>
__device__ __forceinline__ void scan_flush(LAS unsigned char* lds, int cf, int pw, int lane, int d, int T, int tok0, int h, int rowbase, h16* Yf, h16* Yb) {
    const LAS float* yb = (const LAS float*)(lds + SC_YOFF + (cf & 1) * SC_YB);
    const int s = pw * 8 + (lane >> 3); const int g = cf * SC_CH + s; const int t = d ? (T - 1 - g) : g;
    if (R == 4) {
        const int r8 = (lane & 7) * 8;
        const f32x4 y0 = *(const LAS f32x4*)(yb + s * 64 + r8), y1 = *(const LAS f32x4*)(yb + s * 64 + r8 + 4);
        u32x4 w4; w4.x = pk2h(y0.x, y0.y); w4.y = pk2h(y0.z, y0.w); w4.z = pk2h(y1.x, y1.y); w4.w = pk2h(y1.z, y1.w);
        if (d == 0) *(u32x4*)(Yf + (size_t)(tok0 + t) * 1024 + 512 + h * 64 + r8) = w4; else *(u32x4*)(Yb + (size_t)(tok0 + t) * 512 + h * 64 + r8) = w4;
    } else {
        const int r4 = (lane & 7) * 4;
        const f32x4 y0 = *(const LAS f32x4*)(yb + s * 32 + r4);
        u32x2 w2; w2.x = pk2h(y0.x, y0.y); w2.y = pk2h(y0.z, y0.w);
        if (d == 0) *(u32x2*)(Yf + (size_t)(tok0 + t) * 1024 + 512 + h * 64 + rowbase + r4) = w2; else *(u32x2*)(Yb + (size_t)(tok0 + t) * 512 + h * 64 + rowbase + r4) = w2;
    }
}
template <int R>
__device__ __forceinline__ void scan_item(const Args& a, int layer, int q, int rowhalf, LAS unsigned char* lds, int tid, int lane, int wave) {
    int tok0, T, h, d;
    if (q < 32) { tok0 = MP + (q >> 4) * TS; T = TS; h = (q >> 1) & 7; d = q & 1; } else { const int q2 = q - 32; tok0 = (q2 >> 4) * TP; T = TP; h = (q2 >> 1) & 7; d = q2 & 1; }
    const int nch = T / SC_CH, rowbase = rowhalf * 16 * R;
    unsigned char* ws = a.ws; const int g = q < 32 ? 1 : 0;
    const h16* RR = GB_RR(g); const h16* RK = GB_RK(g); const h16* RV = GB_RV(g); const h16* LOWS = GB_LOWS(g);
    h16* Yf = GB_MIX(g); h16* Yb = GB_YB(g); float* BSC = GB_BSC(g);
    const size_t l = (size_t)layer;
    if (wave >= 4) {
        const int pw = wave - 4, j = lane, col = h * 64 + j;
        const float* mu = a.in[I_MU] + l * 1920;
        const float mu_r = mu[col], mu_k = mu[512 + col], mu_v = mu[1024 + col], mu_wl = mu[1536 + d * 64 + j], mu_al = mu[1536 + 128 + d * 64 + j];
        const float k_k = a.in[I_KK][l * 512 + col], k_a = a.in[I_KA][l * 512 + col], r_k = a.in[I_RK][l * 512 + col];
        const float w0 = a.in[I_W0][(l * 2 + d) * 512 + col], a0 = a.in[I_A0][(l * 2 + d) * 512 + col];
        h16x8 bw[4][2], ba[4][2];
        { const int n = lane & 15, kg = lane >> 4;
          const float* wu = a.in[I_WUP] + ((l * 2 + d) * 64 + 8 * kg) * 512 + h * 64 + n; const float* au = a.in[I_AUP] + ((l * 2 + d) * 64 + 8 * kg) * 512 + h * 64 + n;
#pragma unroll
          for (int ks = 0; ks < 2; ++ks) {
#pragma unroll
              for (int e = 0; e < 8; ++e) {
                  const float w_0 = wu[0], w_1 = wu[16], w_2 = wu[32], w_3 = wu[48], a_0 = au[0], a_1 = au[16], a_2 = au[32], a_3 = au[48];
                  wu += 512; au += 512; asm volatile("" : "+v"(wu), "+v"(au));
                  bw[0][ks][e] = (h16)w_0; bw[1][ks][e] = (h16)w_1; bw[2][ks][e] = (h16)w_2; bw[3][ks][e] = (h16)w_3;
                  ba[0][ks][e] = (h16)a_0; ba[1][ks][e] = (h16)a_1; ba[2][ks][e] = (h16)a_2; ba[3][ks][e] = (h16)a_3; }
              wu += 24 * 512; au += 24 * 512; asm volatile("" : "+v"(wu), "+v"(au)); } }
        LAS float* zl = (LAS float*)(lds + SC_ZOFF + pw * 4096);
        LAS unsigned char* xsb = lds + SC_XOFF + pw * 2048;
        ScanWin cur, nxt;
#define SCAN_LOAD_WIN(W_, cp_) do { const int g0_ = (cp_) * SC_CH + pw * 8; \
            _Pragma("unroll") for (int w = 0; w < 10; ++w) { const int tt = d ? (T - 1 - g0_) + 1 - w : g0_ - 1 + w; const bool ok = (tt >= 0) && (tt < T); const size_t tok = (size_t)(tok0 + (ok ? tt : 0)); \
                const h16 z_ = (h16)0.f; const h16 r_ = RR[tok * 512 + col], k_ = RK[tok * 512 + col], v_ = RV[tok * 512 + col], wl_ = LOWS[tok * 384 + d * 64 + j], al_ = LOWS[tok * 384 + 128 + d * 64 + j]; \
                W_.r[w] = (float)(ok ? r_ : z_); W_.k[w] = (float)(ok ? k_ : z_); W_.v[w] = (float)(ok ? v_ : z_); W_.wl[w] = (float)(ok ? wl_ : z_); W_.al[w] = (float)(ok ? al_ : z_); } } while (0)
        SCAN_LOAD_WIN(cur, 0);
        for (int c = -1; c < nch; ++c) {
            if (c >= 1) scan_flush<R>(lds, c - 1, pw, lane, d, T, tok0, h, rowbase, Yf, Yb);
            if (c + 1 < nch) {
                const int cp = c + 1; LAS float* op = (LAS float*)(lds + (cp & 1) * SC_OPB);
                if (c + 2 < nch) SCAN_LOAD_WIN(nxt, c + 2);
                float bsv = 0.f;
#pragma unroll
                for (int s8 = 0; s8 < 8; ++s8) {
                    const float wl = mix3f(cur.wl[s8], cur.wl[s8 + 1], cur.wl[s8 + 2], mu_wl);
                    const float al = mix3f(cur.al[s8], cur.al[s8 + 1], cur.al[s8 + 2], mu_al);
                    const float e2 = __expf(2.0f * wl); const float th = 1.0f - 2.0f * __builtin_amdgcn_rcpf(e2 + 1.0f);
                    LAS h16* xs = (LAS h16*)(xsb + s8 * 256);
                    xs[j] = (h16)th; xs[64 + j] = (h16)al;
                }
                {
                    const LAS unsigned char* xr = xsb + (lane & 7) * 256 + (lane >> 4) * 16;
                    const h16x8 xw0 = *(const LAS h16x8a*)(xr), xw1 = *(const LAS h16x8a*)(xr + 64), xa0 = *(const LAS h16x8a*)(xr + 128), xa1 = *(const LAS h16x8a*)(xr + 192);
                    f32x4 accw[4], acca[4];
#pragma unroll
                    for (int nt = 0; nt < 4; ++nt) {
                        accw[nt] = __builtin_amdgcn_mfma_f32_16x16x32_f16(xw0, bw[nt][0], (f32x4){0.f, 0.f, 0.f, 0.f}, 0, 0, 0);
                        accw[nt] = __builtin_amdgcn_mfma_f32_16x16x32_f16(xw1, bw[nt][1], accw[nt], 0, 0, 0);
                        acca[nt] = __builtin_amdgcn_mfma_f32_16x16x32_f16(xa0, ba[nt][0], (f32x4){0.f, 0.f, 0.f, 0.f}, 0, 0, 0);
                        acca[nt] = __builtin_amdgcn_mfma_f32_16x16x32_f16(xa1, ba[nt][1], acca[nt], 0, 0, 0); }
                    if (lane < 32) {
                        LAS float* zw = zl + (4 * (lane >> 4)) * 64 + (lane & 15);
#pragma unroll
                        for (int nt = 0; nt < 4; ++nt)
#pragma unroll
                            for (int r = 0; r < 4; ++r) { zw[r * 64 + 16 * nt] = accw[nt][r]; zw[512 + r * 64 + 16 * nt] = acca[nt][r]; }
                    }
                }
#pragma unroll
                for (int s8 = 0; s8 < 8; ++s8) {
                    const int s = pw * 8 + s8; const int g = cp * SC_CH + s; const int t = d ? (T - 1 - g) : g; const size_t tok = (size_t)(tok0 + t);
                    const float rr = mix3f(cur.r[s8], cur.r[s8 + 1], cur.r[s8 + 2], mu_r);
                    const float kk0 = mix3f(cur.k[s8], cur.k[s8 + 1], cur.k[s8 + 2], mu_k);
                    const float vv = mix3f(cur.v[s8], cur.v[s8 + 1], cur.v[s8 + 2], mu_v);
                    const float z = w0 + zl[s8 * 64 + j], az = a0 + zl[512 + s8 * 64 + j];
                    const float wdec = __expf(-0.606531f * sigmoidf_(z)); const float av = sigmoidf_(az);
                    float kk = kk0 * k_k; const float n2 = wave_sum_fast(kk * kk); kk = kk * __builtin_amdgcn_rsqf(fmaxf(n2, 1e-24f));
                    const float kd = kk0 * (1.0f + (av - 1.0f) * k_a); const float bb = kk * av;
                    const float bs = wave_sum_fast(rr * kd * r_k);
                    bsv = (lane == s8) ? bs : bsv;
                    LAS float* o = op + s * 384 + j;
                    o[0] = -kk; o[64] = wdec; o[128] = bb; o[192] = kd; o[256] = rr; o[320] = vv;
                }
                if (lane < 8 && rowhalf == 0) { const int gs = cp * SC_CH + pw * 8 + lane; const int t = d ? (T - 1 - gs) : gs; BSC[((size_t)(tok0 + t) * 8 + h) * 2 + d] = bsv; }
                cur = nxt;
            }
            __syncthreads();
        }
        scan_flush<R>(lds, nch - 1, pw, lane, d, T, tok0, h, rowbase, Yf, Yb);
#undef SCAN_LOAD_WIN
    } else {
        constexpr int RL = R / 2;
        const int ri = lane >> 3, ci = lane & 7;
        const int yrow = wave * 8 * RL + ri * RL, vrow = rowbase + yrow;
        f32x2 S[RL][4];
#pragma unroll
        for (int i = 0; i < RL; ++i)
#pragma unroll
            for (int c2 = 0; c2 < 4; ++c2) S[i][c2] = (f32x2){0.f, 0.f};
        typedef float vecR __attribute__((ext_vector_type(RL)));
        __syncthreads();
        for (int c = 0; c < nch; ++c) {
            const LAS f32x4* op = (const LAS f32x4*)(lds + (c & 1) * SC_OPB);
            LAS float* yb = (LAS float*)(lds + SC_YOFF + (c & 1) * SC_YB);
            f32x4 a0 = op[2 * ci], a1 = op[2 * ci + 1], w0 = op[16 + 2 * ci], w1 = op[17 + 2 * ci], b0 = op[32 + 2 * ci], b1 = op[33 + 2 * ci];
            f32x4 k0 = op[48 + 2 * ci], k1 = op[49 + 2 * ci], r0 = op[64 + 2 * ci], r1 = op[65 + 2 * ci]; vecR v4 = *(const LAS vecR*)((const LAS float*)op + 320 + vrow);
#pragma unroll 4
            for (int s = 0; s < SC_CH; ++s) {
                const LAS f32x4* on = op + (s + 1) * 96;
                const f32x4 na0 = on[2 * ci], na1 = on[2 * ci + 1], nw0 = on[16 + 2 * ci], nw1 = on[17 + 2 * ci], nb0 = on[32 + 2 * ci], nb1 = on[33 + 2 * ci];
                const f32x4 nk0 = on[48 + 2 * ci], nk1 = on[49 + 2 * ci], nr0 = on[64 + 2 * ci], nr1 = on[65 + 2 * ci]; const vecR nv4 = *(const LAS vecR*)((const LAS float*)on + 320 + vrow);
                const f32x2 av[4] = {{a0.x, a0.y}, {a0.z, a0.w}, {a1.x, a1.y}, {a1.z, a1.w}}, wv[4] = {{w0.x, w0.y}, {w0.z, w0.w}, {w1.x, w1.y}, {w1.z, w1.w}};
                const f32x2 bv[4] = {{b0.x, b0.y}, {b0.z, b0.w}, {b1.x, b1.y}, {b1.z, b1.w}}, kv[4] = {{k0.x, k0.y}, {k0.z, k0.w}, {k1.x, k1.y}, {k1.z, k1.w}};
                const f32x2 rv[4] = {{r0.x, r0.y}, {r0.z, r0.w}, {r1.x, r1.y}, {r1.z, r1.w}};
                float sa[RL];
#pragma unroll
                for (int i = 0; i < RL; ++i) { f32x2 p = S[i][0] * av[0]; p = S[i][1] * av[1] + p; p = S[i][2] * av[2] + p; p = S[i][3] * av[3] + p;
                    float t = p.x + p.y; t += dpp_f<0xB1>(t); t += dpp_f<0x4E>(t); t += dpp_f<0x141>(t); sa[i] = t; }
                vecR y;
#pragma unroll
                for (int i = 0; i < RL; ++i) { const f32x2 sa2 = {sa[i], sa[i]}, v2 = {v4[i], v4[i]};
#pragma unroll
                    for (int c2 = 0; c2 < 4; ++c2) S[i][c2] = S[i][c2] * wv[c2] + sa2 * bv[c2] + v2 * kv[c2];
                    f32x2 p = S[i][0] * rv[0]; p = S[i][1] * rv[1] + p; p = S[i][2] * rv[2] + p; p = S[i][3] * rv[3] + p;
                    float t = p.x + p.y; t += dpp_f<0xB1>(t); t += dpp_f<0x4E>(t); t += dpp_f<0x141>(t); y[i] = t; }
                if (ci == 0) *(LAS vecR*)(yb + s * (32 * RL) + yrow) = y;
                a0 = na0; a1 = na1; w0 = nw0; w1 = nw1; b0 = nb0; b1 = nb1; k0 = nk0; k1 = nk1; r0 = nr0; r1 = nr1; v4 = nv4;
            }
            __syncthreads();
        }
    }
}

__device__ __forceinline__ void rwpost_tile(const Args& a, int layer, int tile, LAS unsigned char* lds, int tid, int lane, int wave, const h16x2 (&gup)[64]) {
    const size_t l = (size_t)layer; const int col = tid, h = wave;
    const int m0 = tile * 64; int tok0s, T; if (m0 < MP) { T = TP; tok0s = (m0 / TP) * TP; } else { T = TS; tok0s = MP + ((m0 - MP) / TS) * TS; }
    unsigned char* ws = a.ws; const int g = m0 < MP ? 0 : 1;
    const h16* LOWS = GB_LOWS(g); const h16* RV = GB_RV(g); h16* MIX = GB_MIX(g); const h16* Yb = GB_YB(g); const float* BSC = GB_BSC(g);
    const float* mu = a.in[I_MU] + l * 1920;
    LAS h16* G = (LAS h16*)lds;
    { const int c = tid & 127; const float mug = mu[1536 + 256 + c];
#pragma unroll 4
      for (int e = tid; e < 64 * 128; e += NTHREADS) { const int tk = e >> 7; const int m = m0 + tk; const int t = m - tok0s;
        const float gl = shiftmix(LOWS + (size_t)m * 384 + 256 + c, 384, t, T, mug); G[e] = (h16)sigmoidf_(gl); } }
    const float mu_v = mu[1024 + col], lw = a.in[I_LNW][l * 512 + col], lb = a.in[I_LNB][l * 512 + col];
    __syncthreads();
#pragma unroll 1
    for (int tk0 = 0; tk0 < 64; tk0 += 8) {
        h16 ym[8], yb[8], rv[10]; float b0[8], b1[8];
#pragma unroll
        for (int w = 0; w < 10; ++w) { const int m = m0 + tk0 - 1 + w; const int t = m - tok0s; const bool ok = (t >= 0) && (t < T); const h16 v = RV[(size_t)(ok ? m : m0) * 512 + col]; rv[w] = ok ? v : (h16)0.f; }
#pragma unroll
        for (int jj = 0; jj < 8; ++jj) { const size_t m = (size_t)(m0 + tk0 + jj); ym[jj] = MIX[m * 1024 + 512 + col]; yb[jj] = Yb[m * 512 + col]; b0[jj] = BSC[(m * 8 + h) * 2]; b1[jj] = BSC[(m * 8 + h) * 2 + 1]; }
#pragma unroll
        for (int jj = 0; jj < 8; ++jj) {
            const int tk = tk0 + jj; const size_t m = (size_t)(m0 + tk);
            float gg = 0.f;
#pragma unroll
            for (int c8 = 0; c8 < 16; ++c8) { const u32x4 x = *(const LAS u32x4a*)((const LAS unsigned char*)G + tk * 256 + c8 * 16);
                gg = dot8w(x, gup[c8 * 4 + 0], gup[c8 * 4 + 1], gup[c8 * 4 + 2], gup[c8 * 4 + 3], gg); }
            const float wkv = (float)ym[jj] + (float)yb[jj];
            const float mean = wave_sum_fast(wkv) * (1.0f / 64.0f); const float dv = wkv - mean; const float var = wave_sum_fast(dv * dv) * (1.0f / 64.0f);
            const float yn = dv * __builtin_amdgcn_rsqf(var + 64e-5f) * lw + lb;
            const float vv = mix3(rv[jj], rv[jj + 1], rv[jj + 2], mu_v);
            MIX[m * 1024 + 512 + col] = (h16)((yn + (b0[jj] + b1[jj]) * vv) * gg);
        }
    }
    __syncthreads();
}

#define STAGE_ARGS const Args& args, int layer, int g, int nb, int cb, LAS unsigned char* lds
#define FRESH_TID int tid = threadIdx.x; asm volatile("" : "+v"(tid)); const int lane = tid & 63, wave = __builtin_amdgcn_readfirstlane(tid >> 6); (void)lane; (void)wave;
__device__ __forceinline__ int g_rows(int g) { return g ? MS : MP; }
__device__ __forceinline__ int g_pm0(int g) { return g ? MP / 256 : 0; }
template <class Epi> __device__ __forceinline__ void run_gemm(LAS unsigned char* lds, const h16* A, int lda, const h16* Bt, int N, int K, int g, int nb, int cb, const Epi& E, int tid) {
    pg8::Gemm gm{A, Bt, g_rows(g), N, K, lda}; pg8::StaticOrder S; S.init(g_rows(g), N, nb, cb, g_pm0(g)); pg8::gemm_phase(lds, gm, S, E, tid);
}
__device__ __forceinline__ void st_ffn_up(STAGE_ARGS, int which) {
    FRESH_TID unsigned char* ws = args.ws; const h16* W = (const h16*)(ws + WS_W);
    pg8::EpiSwiglu E{GB_ACT(g), (const float*)(ws + (which ? WS_SSA : WS_SSB))};
    run_gemm(lds, which ? GB_H16(g) : GB_H16B(g), D, W + (which ? W_FFN2U : W_FFN1U), 2 * FF, D, g, nb, cb, E, tid);
}
__device__ __forceinline__ void st_ffn_down(STAGE_ARGS, int which) {
    FRESH_TID unsigned char* ws = args.ws; const h16* W = (const h16*)(ws + WS_W); float* out = args.out;
    const bool first = (which == 0 && layer == 0);
    const float* rp = first ? args.in[I_XP] : (const float*)out; const float* rsm = first ? args.in[I_XS] - (size_t)MP * D : (const float*)out;
    pg8::EpiResid E{rp, rsm, out, GB_H16(g), (float*)(ws + WS_SSA), 0.5f};
    run_gemm(lds, GB_ACT(g), FF, W + (which ? W_FFN2D : W_FFN1D), D, FF, g, nb, cb, E, tid);
}
__device__ __forceinline__ void st_win(STAGE_ARGS) {
    FRESH_TID unsigned char* ws = args.ws; const h16* W = (const h16*)(ws + WS_W);
    pg8::EpiProj E{GB_MIX(g), GB_KNA(g), (size_t)512 * g_rows(g), GB_LOWS(g), (const float*)(ws + WS_SSA)};
    run_gemm(lds, GB_H16(g), D, W + W_IN, NPROJ, D, g, nb, cb, E, tid);
}
__device__ __forceinline__ void st_wout(STAGE_ARGS) {
    FRESH_TID unsigned char* ws = args.ws; const h16* W = (const h16*)(ws + WS_W); float* out = args.out;
    pg8::EpiResid E{out, out, out, GB_H16(g), (float*)(ws + WS_SSA), 1.0f};
    run_gemm(lds, GB_MIX(g), D, W + W_OUT, D, D, g, nb, cb, E, tid);
}
__device__ __forceinline__ void st_pu(STAGE_ARGS) {
    FRESH_TID unsigned char* ws = args.ws; const h16* W = (const h16*)(ws + WS_W);
    int kpu = PLE; asm volatile("" : "+s"(kpu));
    pg8::EpiPU E{GB_PU(g)};
    run_gemm(lds, GB_P16(g), kpu, W + W_UP, D, kpu, g, nb, cb, E, tid);
}
__device__ __forceinline__ void st_ple(STAGE_ARGS) {
    FRESH_TID unsigned char* ws = args.ws; const h16* W = (const h16*)(ws + WS_W); float* out = args.out;
    pg8::EpiPle E{out, GB_H16B(g), (float*)(ws + WS_SSB), (const float*)(ws + WS_SSA), GB_PU(g)};
    run_gemm(lds, GB_H16(g), D, W + W_GATE, D, D, g, nb, cb, E, tid);
}
__device__ __forceinline__ void st_rwpost(STAGE_ARGS) {
    FRESH_TID const int t0 = g ? MP / 64 : 0, nt = g_rows(g) / 64;
    h16x2 gup[64];
    { const float* gu = args.in[I_GUP] + (size_t)layer * 128 * 512 + tid;
#pragma unroll
      for (int i2 = 0; i2 < 64; ++i2) { const float g0 = gu[0], g1 = gu[512]; gu += 1024; asm volatile("" : "+v"(gu)); gup[i2] = (h16x2){(h16)g0, (h16)g1}; } }
    for (int tile = cb; tile < nt; tile += nb) rwpost_tile(args, layer, t0 + tile, lds, tid, lane, wave, gup);
}
__device__ __forceinline__ void st_convp(STAGE_ARGS) { FRESH_TID convert_p(args, layer, g, nb, cb, tid); }

__device__ __forceinline__ void sub_sync(unsigned* ctr, unsigned target) {
    asm volatile("s_waitcnt vmcnt(0) lgkmcnt(0)" ::: "memory");
    __syncthreads();
    if (threadIdx.x == 0) {
        __builtin_amdgcn_fence(__ATOMIC_RELEASE, "agent"); asm volatile("s_waitcnt vmcnt(0)" ::: "memory");
        __hip_atomic_fetch_add(ctr, 1u, __ATOMIC_RELAXED, __HIP_MEMORY_SCOPE_AGENT);
        while (__hip_atomic_load(ctr, __ATOMIC_RELAXED, __HIP_MEMORY_SCOPE_AGENT) < target) __builtin_amdgcn_s_sleep(2);
    }
    __syncthreads();
    __builtin_amdgcn_fence(__ATOMIC_ACQUIRE, "agent"); asm volatile("s_waitcnt vmcnt(0)" ::: "memory");
}

constexpr int NSB = 32;
__global__ void __launch_bounds__(NTHREADS, 2) fwd_megakernel(Args args) {
    extern __shared__ __attribute__((aligned(16))) unsigned char lds_raw[];
    LAS unsigned char* lds = (LAS unsigned char*)lds_raw;
    cg::grid_group grid = cg::this_grid();
    const int bid = blockIdx.x, G = gridDim.x;
    const int NPB = G - NSB, pb = bid - NSB;
    unsigned* ctr = (unsigned*)(args.ws + WS_CTR);
    if (bid == 0 && threadIdx.x == 0) __hip_atomic_store(ctr, 0u, __ATOMIC_RELAXED, __HIP_MEMORY_SCOPE_AGENT);
    unsigned sbt = 0;
#define SUBSYNC() do { sbt += (unsigned)NPB; sub_sync(ctr, sbt); } while (0)

    for (int layer = 0; layer < 2; ++layer) {
        { FRESH_TID phase_convert(args, layer, lds, tid, lane, wave, bid, G); }
        grid_sync(grid);
        st_ffn_up(args, layer, 1, G, bid, lds, 0); grid_sync(grid);
        st_ffn_down(args, layer, 1, G, bid, lds, 0); grid_sync(grid);
        st_win(args, layer, 1, G, bid, lds); grid_sync(grid);
        if (bid < NSB) {
            FRESH_TID scan_item<4>(args, layer, bid, 0, lds, tid, lane, wave);
        } else {
            st_ffn_up(args, layer, 0, NPB, pb, lds, 0); SUBSYNC();
            st_ffn_down(args, layer, 0, NPB, pb, lds, 0); SUBSYNC();
            st_win(args, layer, 0, NPB, pb, lds); SUBSYNC();
            { FRESH_TID
              scan_item<4>(args, layer, 32 + pb, 0, lds, tid, lane, wave); __syncthreads();
              if (pb < 2 * (256 - NPB)) { scan_item<2>(args, layer, 32 + NPB + (pb >> 1), pb & 1, lds, tid, lane, wave); __syncthreads(); }
              else { for (int it = pb - 2 * (256 - NPB); it < 1536; it += NPB - 2 * (256 - NPB)) na_item(args, layer, it, lds, tid, lane, wave); } }
            SUBSYNC();
            st_rwpost(args, layer, 0, NPB, pb, lds); SUBSYNC();
            st_wout(args, layer, 0, NPB, pb, lds); SUBSYNC();
            st_ffn_up(args, layer, 0, NPB, pb, lds, 1);
        }
        grid_sync(grid);
        st_rwpost(args, layer, 1, G, bid, lds); st_ffn_down(args, layer, 0, G, bid, lds, 1); st_convp(args, layer, 0, G, bid, lds); grid_sync(grid);
        st_wout(args, layer, 1, G, bid, lds); st_pu(args, layer, 0, G, bid, lds); grid_sync(grid);
        st_ffn_up(args, layer, 1, G, bid, lds, 1); st_ple(args, layer, 0, G, bid, lds); grid_sync(grid);
        st_ffn_down(args, layer, 1, G, bid, lds, 1); st_convp(args, layer, 1, G, bid, lds); grid_sync(grid);
        st_pu(args, layer, 1, G, bid, lds); grid_sync(grid);
        st_ple(args, layer, 1, G, bid, lds); grid_sync(grid);
    }
    {
        FRESH_TID
        const float* SSB = (const float*)(args.ws + WS_SSB); float* out = args.out;
        const int gw = bid * NWAVES + wave, NGW = G * NWAVES; const f32x4* gm = (const f32x4*)args.in[I_FINAL] + lane;
        f32x4 gv[4];
#pragma unroll
        for (int j = 0; j < 4; ++j) gv[j] = gm[64 * j];
        for (int m = gw; m < M; m += 2 * NGW) {
            const int m2 = m + NGW;
            const float rs = row_rstd(SSB, m), rs2 = row_rstd(SSB, m2); f32x4* o = (f32x4*)(out + (size_t)m * D) + lane; f32x4* o2 = (f32x4*)(out + (size_t)m2 * D) + lane;
            f32x4 v[4], v2[4];
#pragma unroll
            for (int j = 0; j < 4; ++j) { v[j] = o[64 * j]; v2[j] = o2[64 * j]; }
#pragma unroll
            for (int j = 0; j < 4; ++j) { o[64 * j] = v[j] * rs * gv[j]; o2[64 * j] = v2[j] * rs2 * gv[j]; }
        }
    }
}

extern "C" void kernel_launch(void* const* d_in, const int* in_sizes, int n_in, void* d_out, int out_size, void* d_ws, size_t ws_size, hipStream_t stream) {
    static int grid = 0;
    if (grid == 0) {
        if (n_in != N_IN || out_size != M * D || ws_size < WS_END) { fprintf(stderr, "kernel_launch: unexpected shapes (n_in %d, out %d, ws %zu)\n", n_in, out_size, ws_size); grid = -1; return; }
        int dev = 0, cus = 0, per_cu = 0;
        (void)hipGetDevice(&dev); (void)hipDeviceGetAttribute(&cus, hipDeviceAttributeMultiprocessorCount, dev);
        (void)hipFuncSetAttribute((const void*)fwd_megakernel, hipFuncAttributeMaxDynamicSharedMemorySize, LDS_BYTES);
        (void)hipOccupancyMaxActiveBlocksPerMultiprocessor(&per_cu, (const void*)fwd_megakernel, NTHREADS, LDS_BYTES);
        if (per_cu < 1) fprintf(stderr, "kernel_launch: occupancy query says %d blocks per CU\n", per_cu);
        grid = cus;
        if (grid != 256) fprintf(stderr, "kernel_launch: grid %d (expected 256)\n", grid);
        if (grid <= NSB + 64) { fprintf(stderr, "kernel_launch: grid too small\n"); grid = -1; return; }
    }
    if (grid < 0) return;
    Args a{};
    for (int i = 0; i < N_IN; ++i) a.in[i] = (const float*)d_in[i];
    a.out = (float*)d_out; a.ws = (unsigned char*)d_ws;
    void* kargs[] = {&a};
    hipError_t e = hipLaunchCooperativeKernel((const void*)fwd_megakernel, dim3(grid), dim3(NTHREADS), kargs, LDS_BYTES, stream);
    if (e != hipSuccess) fprintf(stderr, "kernel_launch: cooperative launch failed: %s\n", hipGetErrorString(e));
}
```

```cpp
#include <hip/hip_runtime.h>
#include <hip/hip_cooperative_groups.h>
#include <cstdio>
#include <cstdint>
namespace cg = cooperative_groups;
#ifndef PHM
#define PHM 0xFFFF
#endif
#define PH(k) ((PHM >> (k)) & 1)

#define LAS __attribute__((address_space(3)))
typedef _Float16 h16;
typedef _Float16 h16x2 __attribute__((ext_vector_type(2)));
typedef _Float16 h16x4 __attribute__((ext_vector_type(4)));
typedef _Float16 h16x8 __attribute__((ext_vector_type(8)));
typedef _Float16 h16x8a __attribute__((ext_vector_type(8), may_alias));
typedef float f32x2 __attribute__((ext_vector_type(2)));
typedef float f32x4 __attribute__((ext_vector_type(4)));
typedef float f32x16 __attribute__((ext_vector_type(16)));
typedef unsigned u32x2 __attribute__((ext_vector_type(2)));
typedef unsigned u32x4 __attribute__((ext_vector_type(4)));
typedef unsigned u32x4a __attribute__((ext_vector_type(4), may_alias));

constexpr int D = 1024, FF = 2816, MP = 65536, MS = 32768, M = MP + MS, TP = 4096, TS = 16384, PLE = 256;
constexpr int NPROJ = 3584;
constexpr int NTHREADS = 512, NWAVES = 8;
constexpr int LDS_BYTES = 151552;
constexpr size_t MiB = 1u << 20;
constexpr size_t WS_CTR = 256;
constexpr size_t WS_W = 1 * MiB;
constexpr size_t WS_SSA = 46 * MiB;
constexpr size_t WS_SSB = 52 * MiB;
constexpr size_t REG_P = 58 * MiB, REG_S = 682 * MiB, WS_END = 994 * MiB;
constexpr size_t OFF_H16 = 0;
constexpr size_t OFF_MIX = 2048;
constexpr size_t OFF_KNA = 4096, OFF_VNA = 5120, OFF_RR = 6144, OFF_RK = 7168, OFF_RV = 8192;
constexpr size_t OFF_LOWS = 9216;
constexpr size_t OFF_ACT = 2048;
constexpr size_t OFF_P16 = 7680;
constexpr size_t OFF_PU = 2048;
constexpr size_t OFF_H16B = 7680;
constexpr size_t OFF_YB = 0, OFF_BSC = 1024;
constexpr size_t OFF_END = 9984;
static_assert(REG_P + OFF_END * MP <= REG_S && REG_S + OFF_END * MS <= WS_END, "group regions");
__device__ __forceinline__ unsigned char* gbuf(unsigned char* ws, int g, size_t off, size_t stride) {
    const size_t reg = g ? REG_S : REG_P, rows = g ? (size_t)MS : (size_t)MP, row0 = g ? (size_t)MP : 0;
    return ws + (reg + off * rows - row0 * stride);
}
#define GB_H16(g)  ((h16*)gbuf(ws, g, OFF_H16, 2048))
#define GB_H16B(g) ((h16*)gbuf(ws, g, OFF_H16B, 2048))
#define GB_MIX(g)  ((h16*)gbuf(ws, g, OFF_MIX, 2048))
#define GB_KNA(g)  ((h16*)gbuf(ws, g, OFF_KNA, 1024))
#define GB_VNA(g)  ((h16*)gbuf(ws, g, OFF_VNA, 1024))
#define GB_RR(g)   ((h16*)gbuf(ws, g, OFF_RR, 1024))
#define GB_RK(g)   ((h16*)gbuf(ws, g, OFF_RK, 1024))
#define GB_RV(g)   ((h16*)gbuf(ws, g, OFF_RV, 1024))
#define GB_LOWS(g) ((h16*)gbuf(ws, g, OFF_LOWS, 768))
#define GB_ACT(g)  ((h16*)gbuf(ws, g, OFF_ACT, 5632))
#define GB_P16(g)  ((h16*)gbuf(ws, g, OFF_P16, 512))
#define GB_PU(g)   ((h16*)gbuf(ws, g, OFF_PU, 2048))
#define GB_YB(g)   ((h16*)gbuf(ws, g, OFF_YB, 1024))
#define GB_BSC(g)  ((float*)gbuf(ws, g, OFF_BSC, 64))
constexpr size_t W_FFN1U = 0;
constexpr size_t W_FFN1D = W_FFN1U + (size_t)5632 * 1024;
constexpr size_t W_IN = W_FFN1D + (size_t)1024 * 2816;
constexpr size_t W_OUT = W_IN + (size_t)3584 * 1024;
constexpr size_t W_FFN2U = W_OUT + (size_t)1024 * 1024;
constexpr size_t W_FFN2D = W_FFN2U + (size_t)5632 * 1024;
constexpr size_t W_GATE = W_FFN2D + (size_t)1024 * 2816;
constexpr size_t W_UP = W_GATE + (size_t)1024 * 1024;
constexpr size_t W_ENDE = W_UP + (size_t)1024 * 256;
static_assert(WS_W + W_ENDE * 2 <= WS_SSA, "weights fit");

enum { I_XP = 0, I_XS, I_PP, I_PS, I_F1N, I_F1G, I_F1U, I_F1D, I_MIXN, I_WIN, I_RPB, I_MU, I_W0, I_WUP, I_A0, I_AUP, I_GUP, I_KK, I_KA, I_RK, I_LNW, I_LNB,
       I_WOUT, I_F2N, I_F2G, I_F2U, I_F2D, I_PLEN, I_PLEG, I_PLEU, I_FINAL, N_IN };
struct Args { const float* in[N_IN]; float* out; unsigned char* ws; };

__device__ __forceinline__ float wave_sum(float v) {
#pragma unroll
    for (int o = 1; o < 64; o <<= 1) v += __shfl_xor(v, o);
    return v;
}
__device__ __forceinline__ unsigned pk2h(float a, float b) { h16x2 p = {(h16)a, (h16)b}; return __builtin_bit_cast(unsigned, p); }
__device__ __forceinline__ h16x2 as_h2(unsigned u) { return __builtin_bit_cast(h16x2, u); }
__device__ __forceinline__ float dot2h(unsigned a, h16x2 b, float c) { return __builtin_amdgcn_fdot2(as_h2(a), b, c, false); }
__device__ __forceinline__ float dot8(u32x4 a, u32x4 b, float c) { const unsigned a0 = a[0], a1 = a[1], a2 = a[2], a3 = a[3], b0 = b[0], b1 = b[1], b2 = b[2], b3 = b[3];
    c = __builtin_amdgcn_fdot2(as_h2(a0), as_h2(b0), c, false); c = __builtin_amdgcn_fdot2(as_h2(a1), as_h2(b1), c, false); c = __builtin_amdgcn_fdot2(as_h2(a2), as_h2(b2), c, false); c = __builtin_amdgcn_fdot2(as_h2(a3), as_h2(b3), c, false); return c; }
__device__ __forceinline__ float dot8w(u32x4 a, h16x2 w0, h16x2 w1, h16x2 w2, h16x2 w3, float c) { const unsigned a0 = a[0], a1 = a[1], a2 = a[2], a3 = a[3];
    c = __builtin_amdgcn_fdot2(as_h2(a0), w0, c, false); c = __builtin_amdgcn_fdot2(as_h2(a1), w1, c, false); c = __builtin_amdgcn_fdot2(as_h2(a2), w2, c, false); c = __builtin_amdgcn_fdot2(as_h2(a3), w3, c, false); return c; }
__device__ __forceinline__ float fma_mix_lo(float p, unsigned v, float o) { asm("v_fma_mix_f32 %0, %1, %2, %0 op_sel_hi:[0,1,0]" : "+v"(o) : "v"(p), "v"(v)); return o; }
__device__ __forceinline__ float fma_mix_hi(float p, unsigned v, float o) { asm("v_fma_mix_f32 %0, %1, %2, %0 op_sel:[0,1,0] op_sel_hi:[0,1,0]" : "+v"(o) : "v"(p), "v"(v)); return o; }
__device__ __forceinline__ float sigmoidf_(float x) { return __builtin_amdgcn_rcpf(1.0f + __expf(-x)); }
__device__ __forceinline__ float row_rstd(const float* ss, int row) {
    const f32x4* p = (const f32x4*)(ss + (size_t)row * 16);
    const f32x4 a = p[0], b = p[1], c = p[2], d = p[3];
    const float s = ((a.x + a.y) + (a.z + a.w)) + ((b.x + b.y) + (b.z + b.w)) + ((c.x + c.y) + (c.z + c.w)) + ((d.x + d.y) + (d.z + d.w));
    return __builtin_amdgcn_rsqf(s * (1.0f / 1024.0f) + 1e-6f);
}
template <int CTRL> __device__ __forceinline__ float dpp_f(float v) { return __builtin_bit_cast(float, __builtin_amdgcn_update_dpp(0, __builtin_bit_cast(int, v), CTRL, 0xF, 0xF, true)); }
__device__ __forceinline__ float row16_sum(float v) {
    v += dpp_f<0xB1>(v);
    v += dpp_f<0x4E>(v);
    v += dpp_f<0x141>(v);
    v += dpp_f<0x140>(v);
    return v;
}
__device__ __forceinline__ void grid_sync(cg::grid_group& grid) {
    asm volatile("s_waitcnt vmcnt(0) lgkmcnt(0)" ::: "memory"); grid.sync();
    __builtin_amdgcn_fence(__ATOMIC_ACQUIRE, "agent"); asm volatile("s_waitcnt vmcnt(0)" ::: "memory"); }

namespace pg8 {
constexpr int BM = 256, BK = 64, HALF = 128, HTB = HALF * BK * 2, STAGE_BYTES = 8 * HTB, NXCD = 8, WGM = 8;
__host__ __device__ __forceinline__ int lds_byte(int r, int c) { const int st = (r >> 4) * 2 + (c >> 5), rr = r & 15, cc = c & 31, ob = rr * 64 + cc * 2; return st * 1024 + (ob ^ (((ob >> 9) & 1) << 5)); }
__host__ __device__ __forceinline__ void stage_rc(int b, int& R, int& C) { const int st = b / 1024, sb = b % 1024, swz = sb ^ (((sb >> 9) & 1) << 5); R = (st >> 1) * 16 + swz / 64; C = (st & 1) * 32 + (swz % 64) / 2; }
__host__ __device__ __forceinline__ int perm32(int rho) { const int n = rho >> 4, i = rho & 15; return 8 * (i >> 2) + 4 * n + (i & 3); }
struct Unit { int pm, pn; };
struct Gemm { const h16* A; const h16* Bt; int M, N, K, lda; };
struct StaticOrder {
    int nM, nN, nwg, G, c, pm0;
    __device__ void init(int M_, int N_, int G_, int c_, int pm0_) { nM = M_ / BM; nN = N_ / BM; nwg = nM * nN; G = G_; c = c_; pm0 = pm0_; }
    __device__ bool next(int i, Unit& u) const {
        const long L = (long)i * G + c; if (L >= nwg) return false;
        int wgid = (int)L; { const int q = nwg / NXCD, r = nwg % NXCD, xcd = wgid % NXCD, off = wgid / NXCD; wgid = (xcd < r ? xcd * (q + 1) : r * (q + 1) + (xcd - r) * q) + off; }
        const int nig = WGM * nN, gid = wgid / nig, fm = gid * WGM, gsz = (nM - fm) < WGM ? (nM - fm) : WGM;
        u.pm = pm0 + fm + ((wgid % nig) % gsz); u.pn = (wgid % nig) / gsz; return true;
    }
};
typedef f32x4 Acc[2][2][4][2];

template <class Epi>
__device__ __forceinline__ void gemm_phase(LAS unsigned char* lds, const Gemm g, const StaticOrder& S, const Epi& E, const int tid) {
    const int wid = __builtin_amdgcn_readfirstlane(tid >> 6), lane = tid & 63, wr = wid >> 2, wc = wid & 3, fr = lane & 15, fq = lane >> 4;
    const int K = g.K, nt = K / BK, lda = g.lda;
    unsigned voffA[2], voffB[2];
#pragma unroll
    for (int i = 0; i < 2; ++i) { int R, C; stage_rc(tid * 16 + i * 8192, R, C); const int Rb = Epi::PERM ? ((R & ~31) + perm32(R & 31)) : R;
        voffA[i] = (unsigned)(R * lda + C) * 2u; voffB[i] = (unsigned)(Rb * K + C) * 2u; }
    const size_t kstep = (size_t)(BK * 2);
    const size_t hstepA = (size_t)HALF * lda * 2, hstepB = (size_t)HALF * K * 2;
    const size_t tstepA = 2 * hstepA, tstepB = 2 * hstepB;
    const unsigned ldsw = (unsigned)wid * 1024u;
    const int aoff = lds_byte(wr * 64 + fr, fq * 8), boff = lds_byte(wc * 32 + fr, fq * 8);
#define PG8_SA(b, h) (((b) * 2 + (h)) * HTB)
#define PG8_SB(b, h) ((4 + (b) * 2 + (h)) * HTB)
#define PG8_STAGE(bufoff, gbase, voff) do { _Pragma("unroll") for (int _i = 0; _i < 2; ++_i) \
        __builtin_amdgcn_global_load_lds((const unsigned*)((const char*)(gbase) + (voff)[_i]), (LAS unsigned*)(lds + (bufoff) + ldsw + _i * 8192), 16, 0, 0); } while (0)
#define PG8_LDA(dst, b, h) do { _Pragma("unroll") for (int m = 0; m < 4; ++m) _Pragma("unroll") for (int k = 0; k < 2; ++k) dst[m][k] = *(const LAS h16x8*)(lds + PG8_SA(b, h) + aoff + m * 2048 + k * 1024); } while (0)
#define PG8_LDB(dst, b, h) do { _Pragma("unroll") for (int n = 0; n < 2; ++n) _Pragma("unroll") for (int k = 0; k < 2; ++k) dst[n][k] = *(const LAS h16x8*)(lds + PG8_SB(b, h) + boff + n * 2048 + k * 1024); } while (0)
#define PG8_MMA(ai, bj, At, Bt) do { __builtin_amdgcn_s_setprio(1); _Pragma("unroll") for (int m = 0; m < 4; ++m) _Pragma("unroll") for (int n = 0; n < 2; ++n) _Pragma("unroll") for (int k = 0; k < 2; ++k) \
        acc[ai][bj][m][n] = __builtin_amdgcn_mfma_f32_16x16x32_f16(Bt[n][k], At[m][k], acc[ai][bj][m][n], 0, 0, 0); __builtin_amdgcn_s_setprio(0); } while (0)
#define PG8_WAIT_V(n) asm volatile("s_waitcnt vmcnt(" #n ")" ::: "memory")
#define PG8_WAIT_L(n) asm volatile("s_waitcnt lgkmcnt(" #n ")" ::: "memory")
#define PG8_BAR __builtin_amdgcn_s_barrier()
#define PG8_SCHED __builtin_amdgcn_sched_barrier(0)
    Unit cur, nxt; int ui = 0;
    if (!S.next(0, cur)) return;
    f32x4 acc[2][2][4][2];
#pragma unroll
    for (int a = 0; a < 2; ++a)
#pragma unroll
        for (int b = 0; b < 2; ++b)
#pragma unroll
            for (int m = 0; m < 4; ++m)
#pragma unroll
                for (int n = 0; n < 2; ++n) acc[a][b][m][n] = (f32x4){0.f, 0.f, 0.f, 0.f};
    h16x8 At[4][2], B0[2][2], B1[2][2];
    const char* cA = (const char*)g.A + (size_t)cur.pm * tstepA; const char* cB = (const char*)g.Bt + (size_t)cur.pn * tstepB;
    PG8_STAGE(PG8_SB(0, 0), cB, voffB); PG8_STAGE(PG8_SB(0, 1), cB + hstepB, voffB); PG8_STAGE(PG8_SA(0, 0), cA, voffA); PG8_STAGE(PG8_SA(0, 1), cA + hstepA, voffA);
    if (wr == 1) PG8_BAR;
    PG8_WAIT_V(2); PG8_BAR;
    PG8_STAGE(PG8_SB(1, 0), cB + kstep, voffB); PG8_STAGE(PG8_SA(1, 0), cA + kstep, voffA); PG8_STAGE(PG8_SB(1, 1), cB + hstepB + kstep, voffB);
    PG8_WAIT_V(6); PG8_BAR;
    for (;;) {
        const bool has_next = S.next(ui + 1, nxt);
        const char* nA = has_next ? (const char*)g.A + (size_t)nxt.pm * tstepA : cA; const char* nB = has_next ? (const char*)g.Bt + (size_t)nxt.pn * tstepB : cB;
        for (int t = 0; t < nt; t += 2) {
            const bool last = (t == nt - 2);
            const char* a1 = cA + (size_t)(t + 1) * kstep;
            const char* a2 = last ? nA : cA + (size_t)(t + 2) * kstep; const char* b2 = last ? nB : cB + (size_t)(t + 2) * kstep;
            const char* a3 = a2 + kstep; const char* b3 = b2 + kstep;
            PG8_LDB(B0, 0, 0); PG8_LDB(B1, 0, 1); PG8_SCHED; PG8_LDA(At, 0, 0); PG8_STAGE(PG8_SA(1, 1), a1 + hstepA, voffA);
            PG8_WAIT_V(8); PG8_WAIT_L(0); PG8_BAR; PG8_MMA(0, 0, At, B0); PG8_MMA(0, 1, At, B1); PG8_BAR; PG8_SCHED;
            PG8_LDA(At, 0, 1); PG8_STAGE(PG8_SB(0, 0), b2, voffB); PG8_STAGE(PG8_SB(0, 1), b2 + hstepB, voffB); PG8_STAGE(PG8_SA(0, 0), a2, voffA);
            PG8_WAIT_V(8); PG8_WAIT_L(0); PG8_BAR; PG8_MMA(1, 0, At, B0); PG8_MMA(1, 1, At, B1); PG8_BAR; PG8_SCHED;
            PG8_LDB(B0, 1, 0); PG8_LDB(B1, 1, 1); PG8_SCHED; PG8_LDA(At, 1, 0); PG8_STAGE(PG8_SA(0, 1), a2 + hstepA, voffA);
            PG8_WAIT_V(8); PG8_WAIT_L(0); PG8_BAR; PG8_MMA(0, 0, At, B0); PG8_MMA(0, 1, At, B1); PG8_BAR; PG8_SCHED;
            PG8_LDA(At, 1, 1); PG8_STAGE(PG8_SB(1, 0), b3, voffB); PG8_STAGE(PG8_SB(1, 1), b3 + hstepB, voffB); PG8_STAGE(PG8_SA(1, 0), a3, voffA);
            PG8_WAIT_V(8); PG8_WAIT_L(0); PG8_BAR; PG8_MMA(1, 0, At, B0); PG8_MMA(1, 1, At, B1); PG8_BAR; PG8_SCHED;
        }
        if (wr == 0) PG8_BAR;
        E(acc, cur, wr, wc, fr, fq);
        if (!has_next) break;
#pragma unroll
        for (int a = 0; a < 2; ++a)
#pragma unroll
            for (int b = 0; b < 2; ++b)
#pragma unroll
                for (int m = 0; m < 4; ++m)
#pragma unroll
                    for (int n = 0; n < 2; ++n) acc[a][b][m][n] = (f32x4){0.f, 0.f, 0.f, 0.f};
        cur = nxt; cA = nA; cB = nB; ++ui;
        if (wr == 1) PG8_BAR;
    }
    PG8_WAIT_V(0);
    PG8_BAR;
#undef PG8_SA
#undef PG8_SB
#undef PG8_STAGE
#undef PG8_LDA
#undef PG8_LDB
#undef PG8_MMA
#undef PG8_WAIT_V
#undef PG8_WAIT_L
#undef PG8_BAR
#undef PG8_SCHED
}


struct EpiSwiglu {
    static constexpr bool PERM = true;
    h16* O; const float* ss;
    __device__ __forceinline__ void operator()(const Acc& acc, const Unit& u, int wr, int wc, int fr, int fq) const {
        const int row0 = u.pm * BM + wr * 64 + fr, col0 = u.pn * 128 + wc * 32 + 8 * fq;
#pragma unroll
        for (int ai = 0; ai < 2; ++ai)
#pragma unroll
            for (int m = 0; m < 4; ++m) {
                const int row = row0 + ai * HALF + m * 16; const float rs = row_rstd(ss, row);
                float o[8];
#pragma unroll
                for (int n = 0; n < 2; ++n) {
                    const f32x4 g4 = acc[ai][0][m][n] * rs, u4 = acc[ai][1][m][n] * rs; const f32x4 x4 = g4 * (-1.4426950408889634f);
                    f32x4 e4; e4.x = __builtin_amdgcn_exp2f(x4.x); e4.y = __builtin_amdgcn_exp2f(x4.y); e4.z = __builtin_amdgcn_exp2f(x4.z); e4.w = __builtin_amdgcn_exp2f(x4.w);
                    const f32x4 d4 = e4 + 1.0f; f32x4 r4; r4.x = __builtin_amdgcn_rcpf(d4.x); r4.y = __builtin_amdgcn_rcpf(d4.y); r4.z = __builtin_amdgcn_rcpf(d4.z); r4.w = __builtin_amdgcn_rcpf(d4.w);
                    const f32x4 o4 = (g4 * u4) * r4; o[n * 4 + 0] = o4.x; o[n * 4 + 1] = o4.y; o[n * 4 + 2] = o4.z; o[n * 4 + 3] = o4.w; }
                u32x4 w; w.x = pk2h(o[0], o[1]); w.y = pk2h(o[2], o[3]); w.z = pk2h(o[4], o[5]); w.w = pk2h(o[6], o[7]);
                *(u32x4*)(O + (size_t)row * FF + col0) = w;
            }
    }
};
struct EpiResid {
    static constexpr bool PERM = false;
    const float* res_p; const float* res_s; float* out; h16* o16; float* ss; float alpha;
    __device__ __forceinline__ void operator()(const Acc& acc, const Unit& u, int wr, int wc, int fr, int fq) const {
        const int row0 = u.pm * BM + wr * 64 + fr, col0 = u.pn * BM + wc * 32 + 4 * fq;
        const float* res = (u.pm * BM < MP) ? res_p : res_s;
#pragma unroll
        for (int ai = 0; ai < 2; ++ai)
#pragma unroll
            for (int m = 0; m < 4; ++m) {
                const int row = row0 + ai * HALF + m * 16; const size_t off = (size_t)row * D + col0; float sq = 0.f;
#pragma unroll
                for (int bj = 0; bj < 2; ++bj)
#pragma unroll
                    for (int n = 0; n < 2; ++n) { const size_t o = off + bj * HALF + n * 16; const f32x4 r = *(const f32x4*)(res + o); const f32x4 v = r + acc[ai][bj][m][n] * alpha;
                        *(f32x4*)(out + o) = v; u32x2 w; w.x = pk2h(v.x, v.y); w.y = pk2h(v.z, v.w); *(u32x2*)(o16 + o) = w; sq += (v.x * v.x + v.y * v.y) + (v.z * v.z + v.w * v.w); }
                sq += __shfl_xor(sq, 16); sq += __shfl_xor(sq, 32);
                if (fq == 0) ss[(size_t)row * 16 + u.pn * 4 + wc] = sq;
                asm volatile("" ::: "memory");
            }
    }
};
struct EpiProj {
    static constexpr bool PERM = true;
    h16* mix; h16* kna; size_t bufstep; h16* lows; const float* ss;
    __device__ __forceinline__ void operator()(const Acc& acc, const Unit& u, int wr, int wc, int fr, int fq) const {
        const int pn = u.pn; h16* base; int ldc, c0; float sc = 1.f; int nbj = 2;
        if (pn < 2) { base = mix; ldc = 1024; c0 = pn * 256; sc = 0.125f; }
        else if (pn < 12) { base = kna + (size_t)((pn - 2) >> 1) * bufstep; ldc = 512; c0 = ((pn - 2) & 1) * 256; }
        else { base = lows; ldc = 384; c0 = (pn - 12) * 256; if (pn == 13) nbj = 1; }
        const int row0 = u.pm * BM + wr * 64 + fr, col0 = c0 + wc * 32 + 8 * fq;
#pragma unroll
        for (int ai = 0; ai < 2; ++ai)
#pragma unroll
            for (int m = 0; m < 4; ++m) {
                const int row = row0 + ai * HALF + m * 16; const float rs = row_rstd(ss, row) * sc;
#pragma unroll
                for (int bj = 0; bj < 2; ++bj) if (bj < nbj) {
                    const f32x4 v0 = acc[ai][bj][m][0] * rs, v1 = acc[ai][bj][m][1] * rs;
                    u32x4 w; w.x = pk2h(v0.x, v0.y); w.y = pk2h(v0.z, v0.w); w.z = pk2h(v1.x, v1.y); w.w = pk2h(v1.z, v1.w);
                    *(u32x4*)(base + (size_t)row * ldc + col0 + bj * HALF) = w; }
            }
    }
};
struct EpiPU {
    static constexpr bool PERM = true;
    h16* O;
    __device__ __forceinline__ void operator()(const Acc& acc, const Unit& u, int wr, int wc, int fr, int fq) const {
        const int row0 = u.pm * BM + wr * 64 + fr, col0 = u.pn * BM + wc * 32 + 8 * fq;
#pragma unroll
        for (int ai = 0; ai < 2; ++ai)
#pragma unroll
            for (int m = 0; m < 4; ++m) {
                const int row = row0 + ai * HALF + m * 16;
#pragma unroll
                for (int bj = 0; bj < 2; ++bj) {
                    const f32x4 v0 = acc[ai][bj][m][0], v1 = acc[ai][bj][m][1];
                    u32x4 w; w.x = pk2h(v0.x, v0.y); w.y = pk2h(v0.z, v0.w); w.z = pk2h(v1.x, v1.y); w.w = pk2h(v1.z, v1.w);
                    *(u32x4*)(O + (size_t)row * D + col0 + bj * HALF) = w; }
            }
    }
};
struct EpiPle {
    static constexpr bool PERM = false;
    float* out; h16* o16; float* ssw; const float* ssr; const h16* pu;
    __device__ __forceinline__ void operator()(const Acc& acc, const Unit& u, int wr, int wc, int fr, int fq) const {
        const int row0 = u.pm * BM + wr * 64 + fr, col0 = u.pn * BM + wc * 32 + 4 * fq;
#pragma unroll
        for (int ai = 0; ai < 2; ++ai)
#pragma unroll
            for (int m = 0; m < 4; ++m) {
                const int row = row0 + ai * HALF + m * 16; const size_t off = (size_t)row * D + col0; float sq = 0.f; const float rs = row_rstd(ssr, row);
#pragma unroll
                for (int bj = 0; bj < 2; ++bj)
#pragma unroll
                    for (int n = 0; n < 2; ++n) { const size_t o = off + bj * HALF + n * 16; const f32x4 r = *(const f32x4*)(out + o); const h16x4 p = *(const h16x4*)(pu + o);
                        const f32x4 a = acc[ai][bj][m][n] * rs; f32x4 v;
                        v.x = r.x + sigmoidf_(a.x) * (float)p.x; v.y = r.y + sigmoidf_(a.y) * (float)p.y; v.z = r.z + sigmoidf_(a.z) * (float)p.z; v.w = r.w + sigmoidf_(a.w) * (float)p.w;
                        *(f32x4*)(out + o) = v; u32x2 w; w.x = pk2h(v.x, v.y); w.y = pk2h(v.z, v.w); *(u32x2*)(o16 + o) = w; sq += (v.x * v.x + v.y * v.y) + (v.z * v.z + v.w * v.w); }
                sq += __shfl_xor(sq, 16); sq += __shfl_xor(sq, 32);
                if (fq == 0) ssw[(size_t)row * 16 + u.pn * 4 + wc] = sq;
                asm volatile("" ::: "memory");
            }
    }
};
}

__device__ __forceinline__ void convert_matrix(const float* W, int K, int N, const float* gamma, h16* WT, int mode, LAS float* scr, int gw, int NGW, int lane) {
    const int nblk = N / 32, nitems = (K / 64) * nblk;
    for (int item = gw; item < nitems; item += NGW) {
        const int kb = item / nblk, nb = item % nblk, k0 = 64 * kb, n0 = 32 * nb;
        const int drow0 = (mode == 0) ? n0 : ((n0 >> 7) * 256 + (n0 & 127) + (mode == 2 ? 128 : 0));
#pragma unroll 8
        for (int i = 0; i < 32; ++i) { const int kk = 2 * i + (lane >> 5); float v = W[(size_t)(k0 + kk) * N + n0 + (lane & 31)]; if (gamma) v *= gamma[k0 + kk]; scr[kk * 33 + (lane & 31)] = v; }
        asm volatile("s_waitcnt lgkmcnt(0)" ::: "memory");
        const int c = lane & 7;
#pragma unroll
        for (int j = 0; j < 4; ++j) { const int n = (lane >> 3) + 8 * j; const LAS float* s = scr + (8 * c) * 33 + n;
            u32x4 o; o.x = pk2h(s[0 * 33], s[1 * 33]); o.y = pk2h(s[2 * 33], s[3 * 33]); o.z = pk2h(s[4 * 33], s[5 * 33]); o.w = pk2h(s[6 * 33], s[7 * 33]);
            *(u32x4*)(WT + (size_t)(drow0 + n) * K + k0 + 8 * c) = o; }
        asm volatile("s_waitcnt lgkmcnt(0)" ::: "memory");
    }
}

__device__ __forceinline__ void phase_convert(const Args& a, int layer, LAS unsigned char* lds, int tid, int lane, int wave, int bid, int G) {
    LAS float* scr = (LAS float*)(lds + wave * 16384);
    const int gw = bid * NWAVES + wave, NGW = G * NWAVES;
    h16* W = (h16*)(a.ws + WS_W);
    const size_t l = (size_t)layer;
    convert_matrix(a.in[I_F1G] + l * D * FF, D, FF, a.in[I_F1N] + l * D, W + W_FFN1U, 1, scr, gw, NGW, lane);
    convert_matrix(a.in[I_F1U] + l * D * FF, D, FF, a.in[I_F1N] + l * D, W + W_FFN1U, 2, scr, gw, NGW, lane);
    convert_matrix(a.in[I_F1D] + l * FF * D, FF, D, nullptr, W + W_FFN1D, 0, scr, gw, NGW, lane);
    convert_matrix(a.in[I_WIN] + l * D * 3456, D, 3456, a.in[I_MIXN] + l * D, W + W_IN, 0, scr, gw, NGW, lane);
    convert_matrix(a.in[I_WOUT] + l * D * D, D, D, nullptr, W + W_OUT, 0, scr, gw, NGW, lane);
    convert_matrix(a.in[I_F2G] + l * D * FF, D, FF, a.in[I_F2N] + l * D, W + W_FFN2U, 1, scr, gw, NGW, lane);
    convert_matrix(a.in[I_F2U] + l * D * FF, D, FF, a.in[I_F2N] + l * D, W + W_FFN2U, 2, scr, gw, NGW, lane);
    convert_matrix(a.in[I_F2D] + l * FF * D, FF, D, nullptr, W + W_FFN2D, 0, scr, gw, NGW, lane);
    convert_matrix(a.in[I_PLEG] + l * D * D, D, D, a.in[I_PLEN] + l * D, W + W_GATE, 0, scr, gw, NGW, lane);
    convert_matrix(a.in[I_PLEU] + l * PLE * D, PLE, D, nullptr, W + W_UP, 0, scr, gw, NGW, lane);
    { u32x4* z = (u32x4*)(W + W_IN + (size_t)3456 * 1024); const int n16 = 128 * 1024 * 2 / 16;
      for (int i = bid * NTHREADS + tid; i < n16; i += G * NTHREADS) z[i] = (u32x4){0u, 0u, 0u, 0u}; }
    if (layer == 0) {
        unsigned char* ws = a.ws; h16* Hp = GB_H16B(0); h16* Hs = GB_H16B(1); float* ss = (float*)(a.ws + WS_SSB);
        for (int m = gw; m < M; m += NGW) {
            h16* H = (m < MP) ? Hp : Hs;
            const float* xr = (m < MP) ? a.in[I_XP] + (size_t)m * D : a.in[I_XS] + (size_t)(m - MP) * D;
            const f32x4* x4 = (const f32x4*)xr + lane; float s = 0.f;
            u32x2* o = (u32x2*)(H + (size_t)m * D) + lane;
#pragma unroll
            for (int j = 0; j < 4; ++j) { const f32x4 v = x4[64 * j]; s += (v.x * v.x + v.y * v.y) + (v.z * v.z + v.w * v.w); u32x2 w; w.x = pk2h(v.x, v.y); w.y = pk2h(v.z, v.w); o[64 * j] = w; }
            s = wave_sum(s);
            if (lane < 16) ss[(size_t)m * 16 + lane] = (lane == 0) ? s : 0.f;
        }
    }
}

__device__ __forceinline__ void convert_p(const Args& a, int layer, int g, int nb, int cb, int tid) {
    unsigned char* ws = a.ws; const int rows = g ? MS : MP, row0 = g ? MP : 0;
    u32x2* o = (u32x2*)(GB_P16(g) + (size_t)row0 * PLE);
    const f32x4* p = (const f32x4*)((g ? a.in[I_PS] + (size_t)layer * MS * PLE : a.in[I_PP] + (size_t)layer * MP * PLE));
    const int N4 = rows * PLE / 4;
    for (int i = cb * NTHREADS + tid; i < N4; i += nb * NTHREADS) { const f32x4 v = p[i]; u32x2 w; w.x = pk2h(v.x, v.y); w.y = pk2h(v.z, v.w); o[i] = w; }
}

constexpr int NA_PITCH = 144;
constexpr int NA_VOFF = 512 * NA_PITCH;
constexpr int NA_PP = 67;
constexpr int NA_BTOFF = 2 * 512 * NA_PITCH;
__device__ __forceinline__ void na_item(const Args& a, int layer, int item, LAS unsigned char* lds, int tid, int lane, int wave) {
    int tok0, i, rows;
    if (item < 1024) { tok0 = (item >> 6) * TP; i = item & 63; rows = 64; } else { const int it2 = item - 1024; tok0 = MP + (it2 >> 8) * TS; i = it2 & 255; rows = 256; }
    int rs = i - 4; rs = rs < 0 ? 0 : (rs > rows - 8 ? rows - 8 : rs);
    unsigned char* ws = a.ws; const int g = item < 1024 ? 0 : 1;
    h16* MIX = GB_MIX(g); const h16* KNA = GB_KNA(g); const h16* VNA = GB_VNA(g);
    const float* rpb = a.in[I_RPB] + (size_t)layer * 8 * 15 * 31;
    const int wtok0 = tok0 + rs * 64;
    const int j = lane, aw = wave;
    const int tokq = tok0 + i * 64 + j;
    int cs = j - 8; cs = cs < 0 ? 0 : (cs > 48 ? 48 : cs);
    const int l31 = lane & 31, half = lane >> 5;
    LAS float* bt = (LAS float*)(lds + NA_BTOFF) + wave * 128;
    bt[lane] = 0.f; bt[64 + lane] = 0.f;
    u32x4 kreg[8], vreg[8];
    const size_t kvoff = (size_t)(wtok0 + (tid >> 3)) * 512 + (tid & 7) * 8;
#pragma unroll
    for (int it = 0; it < 8; ++it) { kreg[it] = *(const u32x4*)(KNA + kvoff + (size_t)it * (64 * 512)); vreg[it] = *(const u32x4*)(VNA + kvoff + (size_t)it * (64 * 512)); }
#pragma unroll 1
    for (int h = 0; h < 8; ++h) {
#pragma unroll
        for (int it = 0; it < 8; ++it) { const int key = (tid >> 3) + 64 * it, ch = tid & 7;
            *(LAS u32x4*)(lds + key * NA_PITCH + ch * 16) = kreg[it]; *(LAS u32x4*)(lds + NA_VOFF + key * NA_PITCH + ch * 16) = vreg[it]; }
        h16x8 qf[2][4];
#pragma unroll
        for (int nt = 0; nt < 2; ++nt)
#pragma unroll
            for (int ks = 0; ks < 4; ++ks) qf[nt][ks] = *(const h16x8*)(MIX + (size_t)(tok0 + i * 64 + l31 + 32 * nt) * 1024 + h * 64 + 16 * ks + 8 * half);
        if (lane < 31) bt[48 + lane] = rpb[((size_t)h * 15 + (rs + aw - i + 7)) * 31 + lane];
        __syncthreads();
        if (h + 1 < 8) {
#pragma unroll
            for (int it = 0; it < 8; ++it) { kreg[it] = *(const u32x4*)(KNA + kvoff + (size_t)it * (64 * 512) + (h + 1) * 64); vreg[it] = *(const u32x4*)(VNA + kvoff + (size_t)it * (64 * 512) + (h + 1) * 64); }
        }
        f32x16 acc[2][2];
#pragma unroll
        for (int mt = 0; mt < 2; ++mt)
#pragma unroll
            for (int nt = 0; nt < 2; ++nt)
#pragma unroll
                for (int r = 0; r < 16; ++r) acc[mt][nt][r] = 0.f;
#pragma unroll
        for (int mt = 0; mt < 2; ++mt)
#pragma unroll
            for (int ks = 0; ks < 4; ++ks) {
                const h16x8 kf = *(const LAS h16x8*)(lds + (aw * 64 + 32 * mt + l31) * NA_PITCH + (16 * ks + 8 * half) * 2);
                acc[mt][0] = __builtin_amdgcn_mfma_f32_32x32x16_f16(kf, qf[0][ks], acc[mt][0], 0, 0, 0);
                acc[mt][1] = __builtin_amdgcn_mfma_f32_32x32x16_f16(kf, qf[1][ks], acc[mt][1], 0, 0, 0);
            }
        float mxq[2], lq[2];
#pragma unroll
        for (int nt = 0; nt < 2; ++nt) {
            const int qc = l31 + 32 * nt; int csq = qc - 8; csq = csq < 0 ? 0 : (csq > 48 ? 48 : csq);
            const int dlt = 4 * half - csq;
            const LAS float* bq = bt + (48 + 15 + 4 * half - qc - 32);
            float m = -3.0e38f;
#pragma unroll
            for (int mt = 0; mt < 2; ++mt)
#pragma unroll
                for (int r = 0; r < 16; ++r) { const int kr = (r & 3) + 8 * (r >> 2) + 32 * mt;
                    const float sv = acc[mt][nt][r] + bq[32 + kr]; const bool ok = (unsigned)(dlt + kr) < 16u; const float sm = ok ? sv : -1.0e30f; acc[mt][nt][r] = sm; m = fmaxf(m, sm); }
            { const auto sw = __builtin_amdgcn_permlane32_swap(__builtin_bit_cast(unsigned, m), __builtin_bit_cast(unsigned, m), false, false); const unsigned s0 = sw[0], s1 = sw[1]; m = fmaxf(__builtin_bit_cast(float, s0), __builtin_bit_cast(float, s1)); }
            float l = 0.f;
#pragma unroll
            for (int mt = 0; mt < 2; ++mt)
#pragma unroll
                for (int r = 0; r < 16; ++r) { const float p = __expf(acc[mt][nt][r] - m); acc[mt][nt][r] = p; l += p; }
            { const auto sw = __builtin_amdgcn_permlane32_swap(__builtin_bit_cast(unsigned, l), __builtin_bit_cast(unsigned, l), false, false); const unsigned s0 = sw[0], s1 = sw[1]; l = __builtin_bit_cast(float, s0) + __builtin_bit_cast(float, s1); }
            mxq[nt] = m; lq[nt] = l;
        }
        h16x8 pf[2][2][2];
#pragma unroll
        for (int kt = 0; kt < 2; ++kt)
#pragma unroll
            for (int nt = 0; nt < 2; ++nt)
#pragma unroll
                for (int sx = 0; sx < 2; ++sx)
#pragma unroll
                    for (int e = 0; e < 8; ++e) pf[kt][nt][sx][e] = (h16)acc[kt][nt][8 * sx + e];
        f32x16 o[2][2];
#pragma unroll
        for (int dm = 0; dm < 2; ++dm)
#pragma unroll
            for (int nt = 0; nt < 2; ++nt)
#pragma unroll
                for (int r = 0; r < 16; ++r) o[dm][nt][r] = 0.f;
#pragma unroll
        for (int dm = 0; dm < 2; ++dm)
#pragma unroll
            for (int kt = 0; kt < 2; ++kt)
#pragma unroll
                for (int sx = 0; sx < 2; ++sx) {
                    h16x8 vf;
                    const LAS unsigned char* vb = lds + NA_VOFF + (aw * 64 + 32 * kt + 16 * sx + 4 * half) * NA_PITCH + (l31 + 32 * dm) * 2;
#pragma unroll
                    for (int e = 0; e < 8; ++e) vf[e] = *(const LAS h16*)(vb + ((e & 3) + 8 * (e >> 2)) * NA_PITCH);
                    o[dm][0] = __builtin_amdgcn_mfma_f32_32x32x16_f16(vf, pf[kt][0][sx], o[dm][0], 0, 0, 0);
                    o[dm][1] = __builtin_amdgcn_mfma_f32_32x32x16_f16(vf, pf[kt][1][sx], o[dm][1], 0, 0, 0);
                }
        __syncthreads();
#pragma unroll
        for (int nt = 0; nt < 2; ++nt) {
            LAS float* part = (LAS float*)lds + (size_t)(aw * 64 + l31 + 32 * nt) * NA_PP;
#pragma unroll
            for (int dm = 0; dm < 2; ++dm)
#pragma unroll
                for (int r = 0; r < 16; ++r) part[(r & 3) + 8 * (r >> 2) + 4 * half + 32 * dm] = o[dm][nt][r];
            if (half == 0) { part[64] = mxq[nt]; part[65] = lq[nt]; }
        }
        __syncthreads();
        {
            const int jq = tid & 63, e8 = tid >> 6;
            float mw[8], M_ = -3.0e38f;
#pragma unroll
            for (int w = 0; w < 8; ++w) { mw[w] = ((const LAS float*)lds)[(size_t)(w * 64 + jq) * NA_PP + 64]; M_ = fmaxf(M_, mw[w]); }
            float L = 0.f, ov[8];
#pragma unroll
            for (int e = 0; e < 8; ++e) ov[e] = 0.f;
#pragma unroll
            for (int w = 0; w < 8; ++w) { const float f = __expf(mw[w] - M_); const LAS float* pw = (const LAS float*)lds + (size_t)(w * 64 + jq) * NA_PP; L += f * pw[65];
#pragma unroll
                for (int e = 0; e < 8; ++e) ov[e] += f * pw[e8 * 8 + e]; }
            const float inv = 1.0f / L;
            u32x4 w4; w4.x = pk2h(ov[0] * inv, ov[1] * inv); w4.y = pk2h(ov[2] * inv, ov[3] * inv); w4.z = pk2h(ov[4] * inv, ov[5] * inv); w4.w = pk2h(ov[6] * inv, ov[7] * inv);
            *(u32x4*)(MIX + (size_t)(tok0 + i * 64 + jq) * 1024 + h * 64 + e8 * 8) = w4;
        }
        __syncthreads();
    }
}

__device__ __forceinline__ float shiftmix(const h16* base, size_t stride, int t, int T, float mu) {
    const float c = (float)base[0];
    const float p = (t > 0) ? (float)*(base - stride) : 0.f;
    const float n = (t < T - 1) ? (float)*(base + stride) : 0.f;
    return c + mu * (0.5f * (p + n) - c);
}
constexpr int SC_CH = 32;
constexpr int SC_OPB = SC_CH * 6 * 64 * 4;
constexpr int SC_YOFF = 2 * SC_OPB;
constexpr int SC_YB = SC_CH * 64 * 4;
constexpr int SC_XOFF = SC_YOFF + 2 * SC_YB;
constexpr int SC_ZOFF = SC_XOFF + 8192;
static_assert(SC_ZOFF + 4 * 4096 <= LDS_BYTES, "scan LDS");
__device__ __forceinline__ float wave_sum_fast(float v) {
    v = row16_sum(v);
    { const auto r = __builtin_amdgcn_permlane16_swap(__builtin_bit_cast(unsigned, v), __builtin_bit_cast(unsigned, v), false, false);
      const unsigned r0 = r[0], r1 = r[1]; v = __builtin_bit_cast(float, r0) + __builtin_bit_cast(float, r1); }
    { const auto r = __builtin_amdgcn_permlane32_swap(__builtin_bit_cast(unsigned, v), __builtin_bit_cast(unsigned, v), false, false);
      const unsigned r0 = r[0], r1 = r[1]; v = __builtin_bit_cast(float, r0) + __builtin_bit_cast(float, r1); }
    return v;
}
__device__ __forceinline__ float mix3(h16 p, h16 c, h16 n, float mu) { const float cf = (float)c; return cf + mu * (0.5f * ((float)p + (float)n) - cf); }
struct ScanWin { float r[10], k[10], v[10], wl[10], al[10]; };
__device__ __forceinline__ float mix3f(float p, float c, float n, float mu) { return c + mu * (0.5f * (p + n) - c); }
template <int R>
__device__ __forceinline__ void scan_flush(LAS unsigned char* lds, int cf, int pw, int lane, int d, int T, int tok0, int h, int rowbase, h16* Yf, h16* Yb) {
    const LAS float* yb = (const LAS float*)(lds + SC_YOFF + (cf & 1) * SC_YB);
    const int s = pw * 8 + (lane >> 3); const int g = cf * SC_CH + s; const int t = d ? (T - 1 - g) : g;
    if (R == 4) {
        const int r8 = (lane & 7) * 8;
        const f32x4 y0 = *(const LAS f32x4*)(yb + s * 64 + r8), y1 = *(const LAS f32x4*)(yb + s * 64 + r8 + 4);
        u32x4 w4; w4.x = pk2h(y0.x, y0.y); w4.y = pk2h(y0.z, y0.w); w4.z = pk2h(y1.x, y1.y); w4.w = pk2h(y1.z, y1.w);
        if (d == 0) *(u32x4*)(Yf + (size_t)(tok0 + t) * 1024 + 512 + h * 64 + r8) = w4; else *(u32x4*)(Yb + (size_t)(tok0 + t) * 512 + h * 64 + r8) = w4;
    } else {
        const int r4 = (lane & 7) * 4;
        const f32x4 y0 = *(const LAS f32x4*)(yb + s * 32 + r4);
        u32x2 w2; w2.x = pk2h(y0.x, y0.y); w2.y = pk2h(y0.z, y0.w);
        if (d == 0) *(u32x2*)(Yf + (size_t)(tok0 + t) * 1024 + 512 + h * 64 + rowbase + r4) = w2; else *(u32x2*)(Yb + (size_t)(tok0 + t) * 512 + h * 64 + rowbase + r4) = w2;
    }
}
template <int R>
__device__ __forceinline__ void scan_item(const Args& a, int layer, int q, int rowhalf, LAS unsigned char* lds, int tid, int lane, int wave) {
    int tok0, T, h, d;
    if (q < 32) { tok0 = MP + (q >> 4) * TS; T = TS; h = (q >> 1) & 7; d = q & 1; } else { const int q2 = q - 32; tok0 = (q2 >> 4) * TP; T = TP; h = (q2 >> 1) & 7; d = q2 & 1; }
    const int nch = T / SC_CH, rowbase = rowhalf * 16 * R;
    unsigned char* ws = a.ws; const int g = q < 32 ? 1 : 0;
    const h16* RR = GB_RR(g); const h16* RK = GB_RK(g); const h16* RV = GB_RV(g); const h16* LOWS = GB_LOWS(g);
    h16* Yf = GB_MIX(g); h16* Yb = GB_YB(g); float* BSC = GB_BSC(g);
    const size_t l = (size_t)layer;
    if (wave >= 4) {
        const int pw = wave - 4, j = lane, col = h * 64 + j;
        const float* mu = a.in[I_MU] + l * 1920;
        const float mu_r = mu[col], mu_k = mu[512 + col], mu_v = mu[1024 + col], mu_wl = mu[1536 + d * 64 + j], mu_al = mu[1536 + 128 + d * 64 + j];
        const float k_k = a.in[I_KK][l * 512 + col], k_a = a.in[I_KA][l * 512 + col], r_k = a.in[I_RK][l * 512 + col];
        const float w0 = a.in[I_W0][(l * 2 + d) * 512 + col], a0 = a.in[I_A0][(l * 2 + d) * 512 + col];
        h16x8 bw[4][2], ba[4][2];
        { const int n = lane & 15, kg = lane >> 4;
          const float* wu = a.in[I_WUP] + ((l * 2 + d) * 64 + 8 * kg) * 512 + h * 64 + n; const float* au = a.in[I_AUP] + ((l * 2 + d) * 64 + 8 * kg) * 512 + h * 64 + n;
#pragma unroll
          for (int ks = 0; ks < 2; ++ks) {
#pragma unroll
              for (int e = 0; e < 8; ++e) {
                  const float w_0 = wu[0], w_1 = wu[16], w_2 = wu[32], w_3 = wu[48], a_0 = au[0], a_1 = au[16], a_2 = au[32], a_3 = au[48];
                  wu += 512; au += 512; asm volatile("" : "+v"(wu), "+v"(au));
                  bw[0][ks][e] = (h16)w_0; bw[1][ks][e] = (h16)w_1; bw[2][ks][e] = (h16)w_2; bw[3][ks][e] = (h16)w_3;
                  ba[0][ks][e] = (h16)a_0; ba[1][ks][e] = (h16)a_1; ba[2][ks][e] = (h16)a_2; ba[3][ks][e] = (h16)a_3; }
              wu += 24 * 512; au += 24 * 512; asm volatile("" : "+v"(wu), "+v"(au)); } }
        LAS float* zl = (LAS float*)(lds + SC_ZOFF + pw * 4096);
        LAS unsigned char* xsb = lds + SC_XOFF + pw * 2048;
        ScanWin cur, nxt;
#define SCAN_LOAD_WIN(W_, cp_) do { const int g0_ = (cp_) * SC_CH + pw * 8; \
            _Pragma("unroll") for (int w = 0; w < 10; ++w) { const int tt = d ? (T - 1 - g0_) + 1 - w : g0_ - 1 + w; const bool ok = (tt >= 0) && (tt < T); const size_t tok = (size_t)(tok0 + (ok ? tt : 0)); \
                const h16 z_ = (h16)0.f; const h16 r_ = RR[tok * 512 + col], k_ = RK[tok * 512 + col], v_ = RV[tok * 512 + col], wl_ = LOWS[tok * 384 + d * 64 + j], al_ = LOWS[tok * 384 + 128 + d * 64 + j]; \
                W_.r[w] = (float)(ok ? r_ : z_); W_.k[w] = (float)(ok ? k_ : z_); W_.v[w] = (float)(ok ? v_ : z_); W_.wl[w] = (float)(ok ? wl_ : z_); W_.al[w] = (float)(ok ? al_ : z_); } } while (0)
        SCAN_LOAD_WIN(cur, 0);
        for (int c = -1; c < nch; ++c) {
            if (c >= 1) scan_flush<R>(lds, c - 1, pw, lane, d, T, tok0, h, rowbase, Yf, Yb);
            if (c + 1 < nch) {
                const int cp = c + 1; LAS float* op = (LAS float*)(lds + (cp & 1) * SC_OPB);
                if (c + 2 < nch) SCAN_LOAD_WIN(nxt, c + 2);
                float bsv = 0.f;
#pragma unroll
                for (int s8 = 0; s8 < 8; ++s8) {
                    const float wl = mix3f(cur.wl[s8], cur.wl[s8 + 1], cur.wl[s8 + 2], mu_wl);
                    const float al = mix3f(cur.al[s8], cur.al[s8 + 1], cur.al[s8 + 2], mu_al);
                    const float e2 = __expf(2.0f * wl); const float th = 1.0f - 2.0f * __builtin_amdgcn_rcpf(e2 + 1.0f);
                    LAS h16* xs = (LAS h16*)(xsb + s8 * 256);
                    xs[j] = (h16)th; xs[64 + j] = (h16)al;
                }
                {
                    const LAS unsigned char* xr = xsb + (lane & 7) * 256 + (lane >> 4) * 16;
                    const h16x8 xw0 = *(const LAS h16x8a*)(xr), xw1 = *(const LAS h16x8a*)(xr + 64), xa0 = *(const LAS h16x8a*)(xr + 128), xa1 = *(const LAS h16x8a*)(xr + 192);
                    f32x4 accw[4], acca[4];
#pragma unroll
                    for (int nt = 0; nt < 4; ++nt) {
                        accw[nt] = __builtin_amdgcn_mfma_f32_16x16x32_f16(xw0, bw[nt][0], (f32x4){0.f, 0.f, 0.f, 0.f}, 0, 0, 0);
                        accw[nt] = __builtin_amdgcn_mfma_f32_16x16x32_f16(xw1, bw[nt][1], accw[nt], 0, 0, 0);
                        acca[nt] = __builtin_amdgcn_mfma_f32_16x16x32_f16(xa0, ba[nt][0], (f32x4){0.f, 0.f, 0.f, 0.f}, 0, 0, 0);
                        acca[nt] = __builtin_amdgcn_mfma_f32_16x16x32_f16(xa1, ba[nt][1], acca[nt], 0, 0, 0); }
                    if (lane < 32) {
                        LAS float* zw = zl + (4 * (lane >> 4)) * 64 + (lane & 15);
#pragma unroll
                        for (int nt = 0; nt < 4; ++nt)
#pragma unroll
                            for (int r = 0; r < 4; ++r) { zw[r * 64 + 16 * nt] = accw[nt][r]; zw[512 + r * 64 + 16 * nt] = acca[nt][r]; }
                    }
                }
#pragma unroll
                for (int s8 = 0; s8 < 8; ++s8) {
                    const int s = pw * 8 + s8; const int g = cp * SC_CH + s; const int t = d ? (T - 1 - g) : g; const size_t tok = (size_t)(tok0 + t);
                    const float rr = mix3f(cur.r[s8], cur.r[s8 + 1], cur.r[s8 + 2], mu_r);
                    const float kk0 = mix3f(cur.k[s8], cur.k[s8 + 1], cur.k[s8 + 2], mu_k);
                    const float vv = mix3f(cur.v[s8], cur.v[s8 + 1], cur.v[s8 + 2], mu_v);
                    const float z = w0 + zl[s8 * 64 + j], az = a0 + zl[512 + s8 * 64 + j];
                    const float wdec = __expf(-0.606531f * sigmoidf_(z)); const float av = sigmoidf_(az);
                    float kk = kk0 * k_k; const float n2 = wave_sum_fast(kk * kk); kk = kk * __builtin_amdgcn_rsqf(fmaxf(n2, 1e-24f));
                    const float kd = kk0 * (1.0f + (av - 1.0f) * k_a); const float bb = kk * av;
                    const float bs = wave_sum_fast(rr * kd * r_k);
                    bsv = (lane == s8) ? bs : bsv;
                    LAS float* o = op + s * 384 + j;
                    o[0] = -kk; o[64] = wdec; o[128] = bb; o[192] = kd; o[256] = rr; o[320] = vv;
                }
                if (lane < 8 && rowhalf == 0) { const int gs = cp * SC_CH + pw * 8 + lane; const int t = d ? (T - 1 - gs) : gs; BSC[((size_t)(tok0 + t) * 8 + h) * 2 + d] = bsv; }
                cur = nxt;
            }
            __syncthreads();
        }
        scan_flush<R>(lds, nch - 1, pw, lane, d, T, tok0, h, rowbase, Yf, Yb);
#undef SCAN_LOAD_WIN
    } else {
        constexpr int RL = R / 2;
        const int ri = lane >> 3, ci = lane & 7;
        const int yrow = wave * 8 * RL + ri * RL, vrow = rowbase + yrow;
        f32x2 S[RL][4];
#pragma unroll
        for (int i = 0; i < RL; ++i)
#pragma unroll
            for (int c2 = 0; c2 < 4; ++c2) S[i][c2] = (f32x2){0.f, 0.f};
        typedef float vecR __attribute__((ext_vector_type(RL)));
        __syncthreads();
        for (int c = 0; c < nch; ++c) {
            const LAS f32x4* op = (const LAS f32x4*)(lds + (c & 1) * SC_OPB);
            LAS float* yb = (LAS float*)(lds + SC_YOFF + (c & 1) * SC_YB);
            f32x4 a0 = op[2 * ci], a1 = op[2 * ci + 1], w0 = op[16 + 2 * ci], w1 = op[17 + 2 * ci], b0 = op[32 + 2 * ci], b1 = op[33 + 2 * ci];
            f32x4 k0 = op[48 + 2 * ci], k1 = op[49 + 2 * ci], r0 = op[64 + 2 * ci], r1 = op[65 + 2 * ci]; vecR v4 = *(const LAS vecR*)((const LAS float*)op + 320 + vrow);
#pragma unroll 4
            for (int s = 0; s < SC_CH; ++s) {
                const LAS f32x4* on = op + (s + 1) * 96;
                const f32x4 na0 = on[2 * ci], na1 = on[2 * ci + 1], nw0 = on[16 + 2 * ci], nw1 = on[17 + 2 * ci], nb0 = on[32 + 2 * ci], nb1 = on[33 + 2 * ci];
                const f32x4 nk0 = on[48 + 2 * ci], nk1 = on[49 + 2 * ci], nr0 = on[64 + 2 * ci], nr1 = on[65 + 2 * ci]; const vecR nv4 = *(const LAS vecR*)((const LAS float*)on + 320 + vrow);
                const f32x2 av[4] = {{a0.x, a0.y}, {a0.z, a0.w}, {a1.x, a1.y}, {a1.z, a1.w}}, wv[4] = {{w0.x, w0.y}, {w0.z, w0.w}, {w1.x, w1.y}, {w1.z, w1.w}};
                const f32x2 bv[4] = {{b0.x, b0.y}, {b0.z, b0.w}, {b1.x, b1.y}, {b1.z, b1.w}}, kv[4] = {{k0.x, k0.y}, {k0.z, k0.w}, {k1.x, k1.y}, {k1.z, k1.w}};
                const f32x2 rv[4] = {{r0.x, r0.y}, {r0.z, r0.w}, {r1.x, r1.y}, {r1.z, r1.w}};
                float sa[RL];
#pragma unroll
                for (int i = 0; i < RL; ++i) { f32x2 p = S[i][0] * av[0]; p = S[i][1] * av[1] + p; p = S[i][2] * av[2] + p; p = S[i][3] * av[3] + p;
                    float t = p.x + p.y; t += dpp_f<0xB1>(t); t += dpp_f<0x4E>(t); t += dpp_f<0x141>(t); sa[i] = t; }
                vecR y;
#pragma unroll
                for (int i = 0; i < RL; ++i) { const f32x2 sa2 = {sa[i], sa[i]}, v2 = {v4[i], v4[i]};
#pragma unroll
                    for (int c2 = 0; c2 < 4; ++c2) S[i][c2] = S[i][c2] * wv[c2] + sa2 * bv[c2] + v2 * kv[c2];
                    f32x2 p = S[i][0] * rv[0]; p = S[i][1] * rv[1] + p; p = S[i][2] * rv[2] + p; p = S[i][3] * rv[3] + p;
                    float t = p.x + p.y; t += dpp_f<0xB1>(t); t += dpp_f<0x4E>(t); t += dpp_f<0x141>(t); y[i] = t; }
                if (ci == 0) *(LAS vecR*)(yb + s * (32 * RL) + yrow) = y;
                a0 = na0; a1 = na1; w0 = nw0; w1 = nw1; b0 = nb0; b1 = nb1; k0 = nk0; k1 = nk1; r0 = nr0; r1 = nr1; v4 = nv4;
            }
            __syncthreads();
        }
    }
}

__device__ __forceinline__ void rwpost_tile(const Args& a, int layer, int tile, LAS unsigned char* lds, int tid, int lane, int wave, const h16x2 (&gup)[64]) {
    const size_t l = (size_t)layer; const int col = tid, h = wave;
    const int m0 = tile * 64; int tok0s, T; if (m0 < MP) { T = TP; tok0s = (m0 / TP) * TP; } else { T = TS; tok0s = MP + ((m0 - MP) / TS) * TS; }
    unsigned char* ws = a.ws; const int g = m0 < MP ? 0 : 1;
    const h16* LOWS = GB_LOWS(g); const h16* RV = GB_RV(g); h16* MIX = GB_MIX(g); const h16* Yb = GB_YB(g); const float* BSC = GB_BSC(g);
    const float* mu = a.in[I_MU] + l * 1920;
    LAS h16* G = (LAS h16*)lds;
    { const int c = tid & 127; const float mug = mu[1536 + 256 + c];
#pragma unroll 4
      for (int e = tid; e < 64 * 128; e += NTHREADS) { const int tk = e >> 7; const int m = m0 + tk; const int t = m - tok0s;
        const float gl = shiftmix(LOWS + (size_t)m * 384 + 256 + c, 384, t, T, mug); G[e] = (h16)sigmoidf_(gl); } }
    const float mu_v = mu[1024 + col], lw = a.in[I_LNW][l * 512 + col], lb = a.in[I_LNB][l * 512 + col];
    __syncthreads();
#pragma unroll 1
    for (int tk0 = 0; tk0 < 64; tk0 += 8) {
        h16 ym[8], yb[8], rv[10]; float b0[8], b1[8];
#pragma unroll
        for (int w = 0; w < 10; ++w) { const int m = m0 + tk0 - 1 + w; const int t = m - tok0s; const bool ok = (t >= 0) && (t < T); const h16 v = RV[(size_t)(ok ? m : m0) * 512 + col]; rv[w] = ok ? v : (h16)0.f; }
#pragma unroll
        for (int jj = 0; jj < 8; ++jj) { const size_t m = (size_t)(m0 + tk0 + jj); ym[jj] = MIX[m * 1024 + 512 + col]; yb[jj] = Yb[m * 512 + col]; b0[jj] = BSC[(m * 8 + h) * 2]; b1[jj] = BSC[(m * 8 + h) * 2 + 1]; }
#pragma unroll
        for (int jj = 0; jj < 8; ++jj) {
            const int tk = tk0 + jj; const size_t m = (size_t)(m0 + tk);
            float gg = 0.f;
#pragma unroll
            for (int c8 = 0; c8 < 16; ++c8) { const u32x4 x = *(const LAS u32x4a*)((const LAS unsigned char*)G + tk * 256 + c8 * 16);
                gg = dot8w(x, gup[c8 * 4 + 0], gup[c8 * 4 + 1], gup[c8 * 4 + 2], gup[c8 * 4 + 3], gg); }
            const float wkv = (float)ym[jj] + (float)yb[jj];
            const float mean = wave_sum_fast(wkv) * (1.0f / 64.0f); const float dv = wkv - mean; const float var = wave_sum_fast(dv * dv) * (1.0f / 64.0f);
            const float yn = dv * __builtin_amdgcn_rsqf(var + 64e-5f) * lw + lb;
            const float vv = mix3(rv[jj], rv[jj + 1], rv[jj + 2], mu_v);
            MIX[m * 1024 + 512 + col] = (h16)((yn + (b0[jj] + b1[jj]) * vv) * gg);
        }
    }
    __syncthreads();
}

#define STAGE_ARGS const Args& args, int layer, int g, int nb, int cb, LAS unsigned char* lds
#define FRESH_TID int tid = threadIdx.x; asm volatile("" : "+v"(tid)); const int lane = tid & 63, wave = __builtin_amdgcn_readfirstlane(tid >> 6); (void)lane; (void)wave;
__device__ __forceinline__ int g_rows(int g) { return g ? MS : MP; }
__device__ __forceinline__ int g_pm0(int g) { return g ? MP / 256 : 0; }
template <class Epi> __device__ __forceinline__ void run_gemm(LAS unsigned char* lds, const h16* A, int lda, const h16* Bt, int N, int K, int g, int nb, int cb, const Epi& E, int tid) {
    pg8::Gemm gm{A, Bt, g_rows(g), N, K, lda}; pg8::StaticOrder S; S.init(g_rows(g), N, nb, cb, g_pm0(g)); pg8::gemm_phase(lds, gm, S, E, tid);
}
__device__ __forceinline__ void st_ffn_up(STAGE_ARGS, int which) {
    FRESH_TID unsigned char* ws = args.ws; const h16* W = (const h16*)(ws + WS_W);
    pg8::EpiSwiglu E{GB_ACT(g), (const float*)(ws + (which ? WS_SSA : WS_SSB))};
    run_gemm(lds, which ? GB_H16(g) : GB_H16B(g), D, W + (which ? W_FFN2U : W_FFN1U), 2 * FF, D, g, nb, cb, E, tid);
}
__device__ __forceinline__ void st_ffn_down(STAGE_ARGS, int which) {
    FRESH_TID unsigned char* ws = args.ws; const h16* W = (const h16*)(ws + WS_W); float* out = args.out;
    const bool first = (which == 0 && layer == 0);
    const float* rp = first ? args.in[I_XP] : (const float*)out; const float* rsm = first ? args.in[I_XS] - (size_t)MP * D : (const float*)out;
    pg8::EpiResid E{rp, rsm, out, GB_H16(g), (float*)(ws + WS_SSA), 0.5f};
    run_gemm(lds, GB_ACT(g), FF, W + (which ? W_FFN2D : W_FFN1D), D, FF, g, nb, cb, E, tid);
}
__device__ __forceinline__ void st_win(STAGE_ARGS) {
    FRESH_TID unsigned char* ws = args.ws; const h16* W = (const h16*)(ws + WS_W);
    pg8::EpiProj E{GB_MIX(g), GB_KNA(g), (size_t)512 * g_rows(g), GB_LOWS(g), (const float*)(ws + WS_SSA)};
    run_gemm(lds, GB_H16(g), D, W + W_IN, NPROJ, D, g, nb, cb, E, tid);
}
__device__ __forceinline__ void st_wout(STAGE_ARGS) {
    FRESH_TID unsigned char* ws = args.ws; const h16* W = (const h16*)(ws + WS_W); float* out = args.out;
    pg8::EpiResid E{out, out, out, GB_H16(g), (float*)(ws + WS_SSA), 1.0f};
    run_gemm(lds, GB_MIX(g), D, W + W_OUT, D, D, g, nb, cb, E, tid);
}
__device__ __forceinline__ void st_pu(STAGE_ARGS) {
    FRESH_TID unsigned char* ws = args.ws; const h16* W = (const h16*)(ws + WS_W);
    int kpu = PLE; asm volatile("" : "+s"(kpu));
    pg8::EpiPU E{GB_PU(g)};
    run_gemm(lds, GB_P16(g), kpu, W + W_UP, D, kpu, g, nb, cb, E, tid);
}
__device__ __forceinline__ void st_ple(STAGE_ARGS) {
    FRESH_TID unsigned char* ws = args.ws; const h16* W = (const h16*)(ws + WS_W); float* out = args.out;
    pg8::EpiPle E{out, GB_H16B(g), (float*)(ws + WS_SSB), (const float*)(ws + WS_SSA), GB_PU(g)};
    run_gemm(lds, GB_H16(g), D, W + W_GATE, D, D, g, nb, cb, E, tid);
}
__device__ __forceinline__ void st_rwpost(STAGE_ARGS) {
    FRESH_TID const int t0 = g ? MP / 64 : 0, nt = g_rows(g) / 64;
    h16x2 gup[64];
    { const float* gu = args.in[I_GUP] + (size_t)layer * 128 * 512 + tid;
#pragma unroll
      for (int i2 = 0; i2 < 64; ++i2) { const float g0 = gu[0], g1 = gu[512]; gu += 1024; asm volatile("" : "+v"(gu)); gup[i2] = (h16x2){(h16)g0, (h16)g1}; } }
    for (int tile = cb; tile < nt; tile += nb) rwpost_tile(args, layer, t0 + tile, lds, tid, lane, wave, gup);
}
__device__ __forceinline__ void st_convp(STAGE_ARGS) { FRESH_TID convert_p(args, layer, g, nb, cb, tid); }

__device__ __forceinline__ void sub_sync(unsigned* ctr, unsigned target) {
    asm volatile("s_waitcnt vmcnt(0) lgkmcnt(0)" ::: "memory");
    __syncthreads();
    if (threadIdx.x == 0) {
        __builtin_amdgcn_fence(__ATOMIC_RELEASE, "agent"); asm volatile("s_waitcnt vmcnt(0)" ::: "memory");
        __hip_atomic_fetch_add(ctr, 1u, __ATOMIC_RELAXED, __HIP_MEMORY_SCOPE_AGENT);
        while (__hip_atomic_load(ctr, __ATOMIC_RELAXED, __HIP_MEMORY_SCOPE_AGENT) < target) __builtin_amdgcn_s_sleep(2);
    }
    __syncthreads();
    __builtin_amdgcn_fence(__ATOMIC_ACQUIRE, "agent"); asm volatile("s_waitcnt vmcnt(0)" ::: "memory");
}

constexpr int NSB = 32;
__global__ void __launch_bounds__(NTHREADS, 2) fwd_megakernel(Args args) {
    extern __shared__ __attribute__((aligned(16))) unsigned char lds_raw[];
    LAS unsigned char* lds = (LAS unsigned char*)lds_raw;
    cg::grid_group grid = cg::this_grid();
    const int bid = blockIdx.x, G = gridDim.x;
    const int NPB = G - NSB, pb = bid - NSB;
    unsigned* ctr = (unsigned*)(args.ws + WS_CTR);
    if (bid == 0 && threadIdx.x == 0) __hip_atomic_store(ctr, 0u, __ATOMIC_RELAXED, __HIP_MEMORY_SCOPE_AGENT);
    unsigned sbt = 0;
#define SUBSYNC() do { sbt += (unsigned)NPB; sub_sync(ctr, sbt); } while (0)

    for (int layer = 0; layer < 2; ++layer) {
        { FRESH_TID phase_convert(args, layer, lds, tid, lane, wave, bid, G); }
        grid_sync(grid);
        st_ffn_up(args, layer, 1, G, bid, lds, 0); grid_sync(grid);
        st_ffn_down(args, layer, 1, G, bid, lds, 0); grid_sync(grid);
        st_win(args, layer, 1, G, bid, lds); grid_sync(grid);
        if (bid < NSB) {
            FRESH_TID scan_item<4>(args, layer, bid, 0, lds, tid, lane, wave);
        } else {
            st_ffn_up(args, layer, 0, NPB, pb, lds, 0); SUBSYNC();
            st_ffn_down(args, layer, 0, NPB, pb, lds, 0); SUBSYNC();
            st_win(args, layer, 0, NPB, pb, lds); SUBSYNC();
            { FRESH_TID
              scan_item<4>(args, layer, 32 + pb, 0, lds, tid, lane, wave); __syncthreads();
              if (pb < 2 * (256 - NPB)) { scan_item<2>(args, layer, 32 + NPB + (pb >> 1), pb & 1, lds, tid, lane, wave); __syncthreads(); }
              else { for (int it = pb - 2 * (256 - NPB); it < 1536; it += NPB - 2 * (256 - NPB)) na_item(args, layer, it, lds, tid, lane, wave); } }
            SUBSYNC();
            st_rwpost(args, layer, 0, NPB, pb, lds); SUBSYNC();
            st_wout(args, layer, 0, NPB, pb, lds); SUBSYNC();
            st_ffn_up(args, layer, 0, NPB, pb, lds, 1);
        }
        grid_sync(grid);
        st_rwpost(args, layer, 1, G, bid, lds); st_ffn_down(args, layer, 0, G, bid, lds, 1); st_convp(args, layer, 0, G, bid, lds); grid_sync(grid);
        st_wout(args, layer, 1, G, bid, lds); st_pu(args, layer, 0, G, bid, lds); grid_sync(grid);
        st_ffn_up(args, layer, 1, G, bid, lds, 1); st_ple(args, layer, 0, G, bid, lds); grid_sync(grid);
        st_ffn_down(args, layer, 1, G, bid, lds, 1); st_convp(args, layer, 1, G, bid, lds); grid_sync(grid);
        st_pu(args, layer, 1, G, bid, lds); grid_sync(grid);
        st_ple(args, layer, 1, G, bid, lds); grid_sync(grid);
    }
    {
        FRESH_TID
        const float* SSB = (const float*)(args.ws + WS_SSB); float* out = args.out;
        const int gw = bid * NWAVES + wave, NGW = G * NWAVES; const f32x4* gm = (const f32x4*)args.in[I_FINAL] + lane;
        f32x4 gv[4];
#pragma unroll
        for (int j = 0; j < 4; ++j) gv[j] = gm[64 * j];
        for (int m = gw; m < M; m += 2 * NGW) {
            const int m2 = m + NGW;
            const float rs = row_rstd(SSB, m), rs2 = row_rstd(SSB, m2); f32x4* o = (f32x4*)(out + (size_t)m * D) + lane; f32x4* o2 = (f32x4*)(out + (size_t)m2 * D) + lane;
            f32x4 v[4], v2[4];
#pragma unroll
            for (int j = 0; j < 4; ++j) { v[j] = o[64 * j]; v2[j] = o2[64 * j]; }
#pragma unroll
            for (int j = 0; j < 4; ++j) { o[64 * j] = v[j] * rs * gv[j]; o2[64 * j] = v2[j] * rs2 * gv[j]; }
        }
    }
}

extern "C" void kernel_launch(void* const* d_in, const int* in_sizes, int n_in, void* d_out, int out_size, void* d_ws, size_t ws_size, hipStream_t stream) {
    static int grid = 0;
    if (grid == 0) {
        if (n_in != N_IN || out_size != M * D || ws_size < WS_END) { fprintf(stderr, "kernel_launch: unexpected shapes (n_in %d, out %d, ws %zu)\n", n_in, out_size, ws_size); grid = -1; return; }
        int dev = 0, cus = 0, per_cu = 0;
        (void)hipGetDevice(&dev); (void)hipDeviceGetAttribute(&cus, hipDeviceAttributeMultiprocessorCount, dev);
        (void)hipFuncSetAttribute((const void*)fwd_megakernel, hipFuncAttributeMaxDynamicSharedMemorySize, LDS_BYTES);
        (void)hipOccupancyMaxActiveBlocksPerMultiprocessor(&per_cu, (const void*)fwd_megakernel, NTHREADS, LDS_BYTES);
        if (per_cu < 1) fprintf(stderr, "kernel_launch: occupancy query says %d blocks per CU\n", per_cu);
        grid = cus;
        if (grid != 256) fprintf(stderr, "kernel_launch: grid %d (expected 256)\n", grid);
        if (grid <= NSB + 64) { fprintf(stderr, "kernel_launch: grid too small\n"); grid = -1; return; }
    }
    if (grid < 0) return;
    Args a{};
    for (int i = 0; i < N_IN; ++i) a.in[i] = (const float*)d_in[i];
    a.out = (float*)d_out; a.ws = (unsigned char*)d_ws;
    void* kargs[] = {&a};
    hipError_t e = hipLaunchCooperativeKernel((const void*)fwd_megakernel, dim3(grid), dim3(NTHREADS), kargs, LDS_BYTES, stream);
    if (e != hipSuccess) fprintf(stderr, "kernel_launch: cooperative launch failed: %s\n", hipGetErrorString(e));
}
```

```cpp
#include <hip/hip_runtime.h>
#include <hip/hip_cooperative_groups.h>
#include <cstdio>
#include <cstdint>
namespace cg = cooperative_groups;
#ifndef PHM
#define PHM 0xFFFF
#endif
#define PH(k) ((PHM >> (k)) & 1)

#define LAS __attribute__((address_space(3)))
typedef _Float16 h16;
typedef _Float16 h16x2 __attribute__((ext_vector_type(2)));
typedef _Float16 h16x4 __attribute__((ext_vector_type(4)));
typedef _Float16 h16x8 __attribute__((ext_vector_type(8)));
typedef _Float16 h16x8a __attribute__((ext_vector_type(8), may_alias));
typedef float f32x2 __attribute__((ext_vector_type(2)));
typedef float f32x4 __attribute__((ext_vector_type(4)));
typedef float f32x16 __attribute__((ext_vector_type(16)));
typedef unsigned u32x2 __attribute__((ext_vector_type(2)));
typedef unsigned u32x4 __attribute__((ext_vector_type(4)));
typedef unsigned u32x4a __attribute__((ext_vector_type(4), may_alias));

constexpr int D = 1024, FF = 2816, MP = 65536, MS = 32768, M = MP + MS, TP = 4096, TS = 16384, PLE = 256;
constexpr int NPROJ = 3584;
constexpr int NTHREADS = 512, NWAVES = 8;
constexpr int LDS_BYTES = 151552;
constexpr size_t MiB = 1u << 20;
constexpr size_t WS_CTR = 256;
constexpr size_t WS_W = 1 * MiB;
constexpr size_t WS_SSA = 46 * MiB;
constexpr size_t WS_SSB = 52 * MiB;
constexpr size_t REG_P = 58 * MiB, REG_S = 682 * MiB, WS_END = 994 * MiB;
constexpr size_t OFF_H16 = 0;
constexpr size_t OFF_MIX = 2048;
constexpr size_t OFF_KNA = 4096, OFF_VNA = 5120, OFF_RR = 6144, OFF_RK = 7168, OFF_RV = 8192;
constexpr size_t OFF_LOWS = 9216;
constexpr size_t OFF_ACT = 2048;
constexpr size_t OFF_P16 = 7680;
constexpr size_t OFF_PU = 2048;
constexpr size_t OFF_H16B = 7680;
constexpr size_t OFF_YB = 0, OFF_BSC = 1024;
constexpr size_t OFF_END = 9984;
static_assert(REG_P + OFF_END * MP <= REG_S && REG_S + OFF_END * MS <= WS_END, "group regions");
__device__ __forceinline__ unsigned char* gbuf(unsigned char* ws, int g, size_t off, size_t stride) {
    const size_t reg = g ? REG_S : REG_P, rows = g ? (size_t)MS : (size_t)MP, row0 = g ? (size_t)MP : 0;
    return ws + (reg + off * rows - row0 * stride);
}
#define GB_H16(g)  ((h16*)gbuf(ws, g, OFF_H16, 2048))
#define GB_H16B(g) ((h16*)gbuf(ws, g, OFF_H16B, 2048))
#define GB_MIX(g)  ((h16*)gbuf(ws, g, OFF_MIX, 2048))
#define GB_KNA(g)  ((h16*)gbuf(ws, g, OFF_KNA, 1024))
#define GB_VNA(g)  ((h16*)gbuf(ws, g, OFF_VNA, 1024))
#define GB_RR(g)   ((h16*)gbuf(ws, g, OFF_RR, 1024))
#define GB_RK(g)   ((h16*)gbuf(ws, g, OFF_RK, 1024))
#define GB_RV(g)   ((h16*)gbuf(ws, g, OFF_RV, 1024))
#define GB_LOWS(g) ((h16*)gbuf(ws, g, OFF_LOWS, 768))
#define GB_ACT(g)  ((h16*)gbuf(ws, g, OFF_ACT, 5632))
#define GB_P16(g)  ((h16*)gbuf(ws, g, OFF_P16, 512))
#define GB_PU(g)   ((h16*)gbuf(ws, g, OFF_PU, 2048))
#define GB_YB(g)   ((h16*)gbuf(ws, g, OFF_YB, 1024))
#define GB_BSC(g)  ((float*)gbuf(ws, g, OFF_BSC, 64))
constexpr size_t W_FFN1U = 0;
constexpr size_t W_FFN1D = W_FFN1U + (size_t)5632 * 1024;
constexpr size_t W_IN = W_FFN1D + (size_t)1024 * 2816;
constexpr size_t W_OUT = W_IN + (size_t)3584 * 1024;
constexpr size_t W_FFN2U = W_OUT + (size_t)1024 * 1024;
constexpr size_t W_FFN2D = W_FFN2U + (size_t)5632 * 1024;
constexpr size_t W_GATE = W_FFN2D + (size_t)1024 * 2816;
constexpr size_t W_UP = W_GATE + (size_t)1024 * 1024;
constexpr size_t W_ENDE = W_UP + (size_t)1024 * 256;
static_assert(WS_W + W_ENDE * 2 <= WS_SSA, "weights fit");

enum { I_XP = 0, I_XS, I_PP, I_PS, I_F1N, I_F1G, I_F1U, I_F1D, I_MIXN, I_WIN, I_RPB, I_MU, I_W0, I_WUP, I_A0, I_AUP, I_GUP, I_KK, I_KA, I_RK, I_LNW, I_LNB,
       I_WOUT, I_F2N, I_F2G, I_F2U, I_F2D, I_PLEN, I_PLEG, I_PLEU, I_FINAL, N_IN };
struct Args { const float* in[N_IN]; float* out; unsigned char* ws; };

__device__ __forceinline__ float wave_sum(float v) {
#pragma unroll
    for (int o = 1; o < 64; o <<= 1) v += __shfl_xor(v, o);
    return v;
}
__device__ __forceinline__ unsigned pk2h(float a, float b) { h16x2 p = {(h16)a, (h16)b}; return __builtin_bit_cast(unsigned, p); }
__device__ __forceinline__ h16x2 as_h2(unsigned u) { return __builtin_bit_cast(h16x2, u); }
__device__ __forceinline__ float dot2h(unsigned a, h16x2 b, float c) { return __builtin_amdgcn_fdot2(as_h2(a), b, c, false); }
__device__ __forceinline__ float dot8(u32x4 a, u32x4 b, float c) { const unsigned a0 = a[0], a1 = a[1], a2 = a[2], a3 = a[3], b0 = b[0], b1 = b[1], b2 = b[2], b3 = b[3];
    c = __builtin_amdgcn_fdot2(as_h2(a0), as_h2(b0), c, false); c = __builtin_amdgcn_fdot2(as_h2(a1), as_h2(b1), c, false); c = __builtin_amdgcn_fdot2(as_h2(a2), as_h2(b2), c, false); c = __builtin_amdgcn_fdot2(as_h2(a3), as_h2(b3), c, false); return c; }
__device__ __forceinline__ float dot8w(u32x4 a, h16x2 w0, h16x2 w1, h16x2 w2, h16x2 w3, float c) { const unsigned a0 = a[0], a1 = a[1], a2 = a[2], a3 = a[3];
    c = __builtin_amdgcn_fdot2(as_h2(a0), w0, c, false); c = __builtin_amdgcn_fdot2(as_h2(a1), w1, c, false); c = __builtin_amdgcn_fdot2(as_h2(a2), w2, c, false); c = __builtin_amdgcn_fdot2(as_h2(a3), w3, c, false); return c; }
__device__ __forceinline__ float fma_mix_lo(float p, unsigned v, float o) { asm("v_fma_mix_f32 %0, %1, %2, %0 op_sel_hi:[0,1,0]" : "+v"(o) : "v"(p), "v"(v)); return o; }
__device__ __forceinline__ float fma_mix_hi(float p, unsigned v, float o) { asm("v_fma_mix_f32 %0, %1, %2, %0 op_sel:[0,1,0] op_sel_hi:[0,1,0]" : "+v"(o) : "v"(p), "v"(v)); return o; }
__device__ __forceinline__ float sigmoidf_(float x) { return __builtin_amdgcn_rcpf(1.0f + __expf(-x)); }
__device__ __forceinline__ float row_rstd(const float* ss, int row) {
    const f32x4* p = (const f32x4*)(ss + (size_t)row * 16);
    const f32x4 a = p[0], b = p[1], c = p[2], d = p[3];
    const float s = ((a.x + a.y) + (a.z + a.w)) + ((b.x + b.y) + (b.z + b.w)) + ((c.x + c.y) + (c.z + c.w)) + ((d.x + d.y) + (d.z + d.w));
    return __builtin_amdgcn_rsqf(s * (1.0f / 1024.0f) + 1e-6f);
}
template <int CTRL> __device__ __forceinline__ float dpp_f(float v) { return __builtin_bit_cast(float, __builtin_amdgcn_update_dpp(0, __builtin_bit_cast(int, v), CTRL, 0xF, 0xF, true)); }
__device__ __forceinline__ float row16_sum(float v) {
    v += dpp_f<0xB1>(v);
    v += dpp_f<0x4E>(v);
    v += dpp_f<0x141>(v);
    v += dpp_f<0x140>(v);
    return v;
}
__device__ __forceinline__ void grid_sync(cg::grid_group& grid) {
    asm volatile("s_waitcnt vmcnt(0) lgkmcnt(0)" ::: "memory"); grid.sync();
    __builtin_amdgcn_fence(__ATOMIC_ACQUIRE, "agent"); asm volatile("s_waitcnt vmcnt(0)" ::: "memory"); }

namespace pg8 {
constexpr int BM = 256, BK = 64, HALF = 128, HTB = HALF * BK * 2, STAGE_BYTES = 8 * HTB, NXCD = 8, WGM = 8;
__host__ __device__ __forceinline__ int lds_byte(int r, int c) { const int st = (r >> 4) * 2 + (c >> 5), rr = r & 15, cc = c & 31, ob = rr * 64 + cc * 2; return st * 1024 + (ob ^ (((ob >> 9) & 1) << 5)); }
__host__ __device__ __forceinline__ void stage_rc(int b, int& R, int& C) { const int st = b / 1024, sb = b % 1024, swz = sb ^ (((sb >> 9) & 1) << 5); R = (st >> 1) * 16 + swz / 64; C = (st & 1) * 32 + (swz % 64) / 2; }
__host__ __device__ __forceinline__ int perm32(int rho) { const int n = rho >> 4, i = rho & 15; return 8 * (i >> 2) + 4 * n + (i & 3); }
struct Unit { int pm, pn; };
struct Gemm { const h16* A; const h16* Bt; int M, N, K, lda; };
struct StaticOrder {
    int nM, nN, nwg, G, c, pm0;
    __device__ void init(int M_, int N_, int G_, int c_, int pm0_) { nM = M_ / BM; nN = N_ / BM; nwg = nM * nN; G = G_; c = c_; pm0 = pm0_; }
    __device__ bool next(int i, Unit& u) const {
        const long L = (long)i * G + c; if (L >= nwg) return false;
        int wgid = (int)L; { const int q = nwg / NXCD, r = nwg % NXCD, xcd = wgid % NXCD, off = wgid / NXCD; wgid = (xcd < r ? xcd * (q + 1) : r * (q + 1) + (xcd - r) * q) + off; }
        const int nig = WGM * nN, gid = wgid / nig, fm = gid * WGM, gsz = (nM - fm) < WGM ? (nM - fm) : WGM;
        u.pm = pm0 + fm + ((wgid % nig) % gsz); u.pn = (wgid % nig) / gsz; return true;
    }
};
typedef f32x4 Acc[2][2][4][2];

template <class Epi>
__device__ __forceinline__ void gemm_phase(LAS unsigned char* lds, const Gemm g, const StaticOrder& S, const Epi& E, const int tid) {
    const int wid = __builtin_amdgcn_readfirstlane(tid >> 6), lane = tid & 63, wr = wid >> 2, wc = wid & 3, fr = lane & 15, fq = lane >> 4;
    const int K = g.K, nt = K / BK, lda = g.lda;
    unsigned voffA[2], voffB[2];
#pragma unroll
    for (int i = 0; i < 2; ++i) { int R, C; stage_rc(tid * 16 + i * 8192, R, C); const int Rb = Epi::PERM ? ((R & ~31) + perm32(R & 31)) : R;
        voffA[i] = (unsigned)(R * lda + C) * 2u; voffB[i] = (unsigned)(Rb * K + C) * 2u; }
    const size_t kstep = (size_t)(BK * 2);
    const size_t hstepA = (size_t)HALF * lda * 2, hstepB = (size_t)HALF * K * 2;
    const size_t tstepA = 2 * hstepA, tstepB = 2 * hstepB;
    const unsigned ldsw = (unsigned)wid * 1024u;
    const int aoff = lds_byte(wr * 64 + fr, fq * 8), boff = lds_byte(wc * 32 + fr, fq * 8);
#define PG8_SA(b, h) (((b) * 2 + (h)) * HTB)
#define PG8_SB(b, h) ((4 + (b) * 2 + (h)) * HTB)
#define PG8_STAGE(bufoff, gbase, voff) do { _Pragma("unroll") for (int _i = 0; _i < 2; ++_i) \
        __builtin_amdgcn_global_load_lds((const unsigned*)((const char*)(gbase) + (voff)[_i]), (LAS unsigned*)(lds + (bufoff) + ldsw + _i * 8192), 16, 0, 0); } while (0)
#define PG8_LDA(dst, b, h) do { _Pragma("unroll") for (int m = 0; m < 4; ++m) _Pragma("unroll") for (int k = 0; k < 2; ++k) dst[m][k] = *(const LAS h16x8*)(lds + PG8_SA(b, h) + aoff + m * 2048 + k * 1024); } while (0)
#define PG8_LDB(dst, b, h) do { _Pragma("unroll") for (int n = 0; n < 2; ++n) _Pragma("unroll") for (int k = 0; k < 2; ++k) dst[n][k] = *(const LAS h16x8*)(lds + PG8_SB(b, h) + boff + n * 2048 + k * 1024); } while (0)
#define PG8_MMA(ai, bj, At, Bt) do { __builtin_amdgcn_s_setprio(1); _Pragma("unroll") for (int m = 0; m < 4; ++m) _Pragma("unroll") for (int n = 0; n < 2; ++n) _Pragma("unroll") for (int k = 0; k < 2; ++k) \
        acc[ai][bj][m][n] = __builtin_amdgcn_mfma_f32_16x16x32_f16(Bt[n][k], At[m][k], acc[ai][bj][m][n], 0, 0, 0); __builtin_amdgcn_s_setprio(0); } while (0)
#define PG8_WAIT_V(n) asm volatile("s_waitcnt vmcnt(" #n ")" ::: "memory")
#define PG8_WAIT_L(n) asm volatile("s_waitcnt lgkmcnt(" #n ")" ::: "memory")
#define PG8_BAR __builtin_amdgcn_s_barrier()
#define PG8_SCHED __builtin_amdgcn_sched_barrier(0)
    Unit cur, nxt; int ui = 0;
    if (!S.next(0, cur)) return;
    f32x4 acc[2][2][4][2];
#pragma unroll
    for (int a = 0; a < 2; ++a)
#pragma unroll
        for (int b = 0; b < 2; ++b)
#pragma unroll
            for (int m = 0; m < 4; ++m)
#pragma unroll
                for (int n = 0; n < 2; ++n) acc[a][b][m][n] = (f32x4){0.f, 0.f, 0.f, 0.f};
    h16x8 At[4][2], B0[2][2], B1[2][2];
    const char* cA = (const char*)g.A + (size_t)cur.pm * tstepA; const char* cB = (const char*)g.Bt + (size_t)cur.pn * tstepB;
    PG8_STAGE(PG8_SB(0, 0), cB, voffB); PG8_STAGE(PG8_SB(0, 1), cB + hstepB, voffB); PG8_STAGE(PG8_SA(0, 0), cA, voffA); PG8_STAGE(PG8_SA(0, 1), cA + hstepA, voffA);
    if (wr == 1) PG8_BAR;
    PG8_WAIT_V(2); PG8_BAR;
    PG8_STAGE(PG8_SB(1, 0), cB + kstep, voffB); PG8_STAGE(PG8_SA(1, 0), cA + kstep, voffA); PG8_STAGE(PG8_SB(1, 1), cB + hstepB + kstep, voffB);
    PG8_WAIT_V(6); PG8_BAR;
    for (;;) {
        const bool has_next = S.next(ui + 1, nxt);
        const char* nA = has_next ? (const char*)g.A + (size_t)nxt.pm * tstepA : cA; const char* nB = has_next ? (const char*)g.Bt + (size_t)nxt.pn * tstepB : cB;
        for (int t = 0; t < nt; t += 2) {
            const bool last = (t == nt - 2);
            const char* a1 = cA + (size_t)(t + 1) * kstep;
            const char* a2 = last ? nA : cA + (size_t)(t + 2) * kstep; const char* b2 = last ? nB : cB + (size_t)(t + 2) * kstep;
            const char* a3 = a2 + kstep; const char* b3 = b2 + kstep;
            PG8_LDB(B0, 0, 0); PG8_LDB(B1, 0, 1); PG8_SCHED; PG8_LDA(At, 0, 0); PG8_STAGE(PG8_SA(1, 1), a1 + hstepA, voffA);
            PG8_WAIT_V(8); PG8_WAIT_L(0); PG8_BAR; PG8_MMA(0, 0, At, B0); PG8_MMA(0, 1, At, B1); PG8_BAR; PG8_SCHED;
            PG8_LDA(At, 0, 1); PG8_STAGE(PG8_SB(0, 0), b2, voffB); PG8_STAGE(PG8_SB(0, 1), b2 + hstepB, voffB); PG8_STAGE(PG8_SA(0, 0), a2, voffA);
            PG8_WAIT_V(8); PG8_WAIT_L(0); PG8_BAR; PG8_MMA(1, 0, At, B0); PG8_MMA(1, 1, At, B1); PG8_BAR; PG8_SCHED;
            PG8_LDB(B0, 1, 0); PG8_LDB(B1, 1, 1); PG8_SCHED; PG8_LDA(At, 1, 0); PG8_STAGE(PG8_SA(0, 1), a2 + hstepA, voffA);
            PG8_WAIT_V(8); PG8_WAIT_L(0); PG8_BAR; PG8_MMA(0, 0, At, B0); PG8_MMA(0, 1, At, B1); PG8_BAR; PG8_SCHED;
            PG8_LDA(At, 1, 1); PG8_STAGE(PG8_SB(1, 0), b3, voffB); PG8_STAGE(PG8_SB(1, 1), b3 + hstepB, voffB); PG8_STAGE(PG8_SA(1, 0), a3, voffA);
            PG8_WAIT_V(8); PG8_WAIT_L(0); PG8_BAR; PG8_MMA(1, 0, At, B0); PG8_MMA(1, 1, At, B1); PG8_BAR; PG8_SCHED;
        }
        if (wr == 0) PG8_BAR;
        E(acc, cur, wr, wc, fr, fq);
        if (!has_next) break;
#pragma unroll
        for (int a = 0; a < 2; ++a)
#pragma unroll
            for (int b = 0; b < 2; ++b)
#pragma unroll
                for (int m = 0; m < 4; ++m)
#pragma unroll
                    for (int n = 0; n < 2; ++n) acc[a][b][m][n] = (f32x4){0.f, 0.f, 0.f, 0.f};
        cur = nxt; cA = nA; cB = nB; ++ui;
        if (wr == 1) PG8_BAR;
    }
    PG8_WAIT_V(0);
    PG8_BAR;
#undef PG8_SA
#undef PG8_SB
#undef PG8_STAGE
#undef PG8_LDA
#undef PG8_LDB
#undef PG8_MMA
#undef PG8_WAIT_V
#undef PG8_WAIT_L
#undef PG8_BAR
#undef PG8_SCHED
}


struct EpiSwiglu {
    static constexpr bool PERM = true;
    h16* O; const float* ss;
    __device__ __forceinline__ void operator()(const Acc& acc, const Unit& u, int wr, int wc, int fr, int fq) const {
        const int row0 = u.pm * BM + wr * 64 + fr, col0 = u.pn * 128 + wc * 32 + 8 * fq;
#pragma unroll
        for (int ai = 0; ai < 2; ++ai)
#pragma unroll
            for (int m = 0; m < 4; ++m) {
                const int row = row0 + ai * HALF + m * 16; const float rs = row_rstd(ss, row);
                float o[8];
#pragma unroll
                for (int n = 0; n < 2; ++n) {
                    const f32x4 g4 = acc[ai][0][m][n] * rs, u4 = acc[ai][1][m][n] * rs; const f32x4 x4 = g4 * (-1.4426950408889634f);
                    f32x4 e4; e4.x = __builtin_amdgcn_exp2f(x4.x); e4.y = __builtin_amdgcn_exp2f(x4.y); e4.z = __builtin_amdgcn_exp2f(x4.z); e4.w = __builtin_amdgcn_exp2f(x4.w);
                    const f32x4 d4 = e4 + 1.0f; f32x4 r4; r4.x = __builtin_amdgcn_rcpf(d4.x); r4.y = __builtin_amdgcn_rcpf(d4.y); r4.z = __builtin_amdgcn_rcpf(d4.z); r4.w = __builtin_amdgcn_rcpf(d4.w);
                    const f32x4 o4 = (g4 * u4) * r4; o[n * 4 + 0] = o4.x; o[n * 4 + 1] = o4.y; o[n * 4 + 2] = o4.z; o[n * 4 + 3] = o4.w; }
                u32x4 w; w.x = pk2h(o[0], o[1]); w.y = pk2h(o[2], o[3]); w.z = pk2h(o[4], o[5]); w.w = pk2h(o[6], o[7]);
                *(u32x4*)(O + (size_t)row * FF + col0) = w;
            }
    }
};
struct EpiResid {
    static constexpr bool PERM = false;
    const float* res_p; const float* res_s; float* out; h16* o16; float* ss; float alpha;
    __device__ __forceinline__ void operator()(const Acc& acc, const Unit& u, int wr, int wc, int fr, int fq) const {
        const int row0 = u.pm * BM + wr * 64 + fr, col0 = u.pn * BM + wc * 32 + 4 * fq;
        const float* res = (u.pm * BM < MP) ? res_p : res_s;
#pragma unroll
        for (int ai = 0; ai < 2; ++ai)
#pragma unroll
            for (int m = 0; m < 4; ++m) {
                const int row = row0 + ai * HALF + m * 16; const size_t off = (size_t)row * D + col0; float sq = 0.f;
#pragma unroll
                for (int bj = 0; bj < 2; ++bj)
#pragma unroll
                    for (int n = 0; n < 2; ++n) { const size_t o = off + bj * HALF + n * 16; const f32x4 r = *(const f32x4*)(res + o); const f32x4 v = r + acc[ai][bj][m][n] * alpha;
                        *(f32x4*)(out + o) = v; u32x2 w; w.x = pk2h(v.x, v.y); w.y = pk2h(v.z, v.w); *(u32x2*)(o16 + o) = w; sq += (v.x * v.x + v.y * v.y) + (v.z * v.z + v.w * v.w); }
                sq += __shfl_xor(sq, 16); sq += __shfl_xor(sq, 32);
                if (fq == 0) ss[(size_t)row * 16 + u.pn * 4 + wc] = sq;
                asm volatile("" ::: "memory");
            }
    }
};
struct EpiProj {
    static constexpr bool PERM = true;
    h16* mix; h16* kna; size_t bufstep; h16* lows; const float* ss;
    __device__ __forceinline__ void operator()(const Acc& acc, const Unit& u, int wr, int wc, int fr, int fq) const {
        const int pn = u.pn; h16* base; int ldc, c0; float sc = 1.f; int nbj = 2;
        if (pn < 2) { base = mix; ldc = 1024; c0 = pn * 256; sc = 0.125f; }
        else if (pn < 12) { base = kna + (size_t)((pn - 2) >> 1) * bufstep; ldc = 512; c0 = ((pn - 2) & 1) * 256; }
        else { base = lows; ldc = 384; c0 = (pn - 12) * 256; if (pn == 13) nbj = 1; }
        const int row0 = u.pm * BM + wr * 64 + fr, col0 = c0 + wc * 32 + 8 * fq;
#pragma unroll
        for (int ai = 0; ai < 2; ++ai)
#pragma unroll
            for (int m = 0; m < 4; ++m) {
                const int row = row0 + ai * HALF + m * 16; const float rs = row_rstd(ss, row) * sc;
#pragma unroll
                for (int bj = 0; bj < 2; ++bj) if (bj < nbj) {
                    const f32x4 v0 = acc[ai][bj][m][0] * rs, v1 = acc[ai][bj][m][1] * rs;
                    u32x4 w; w.x = pk2h(v0.x, v0.y); w.y = pk2h(v0.z, v0.w); w.z = pk2h(v1.x, v1.y); w.w = pk2h(v1.z, v1.w);
                    *(u32x4*)(base + (size_t)row * ldc + col0 + bj * HALF) = w; }
            }
    }
};
struct EpiPU {
    static constexpr bool PERM = true;
    h16* O;
    __device__ __forceinline__ void operator()(const Acc& acc, const Unit& u, int wr, int wc, int fr, int fq) const {
        const int row0 = u.pm * BM + wr * 64 + fr, col0 = u.pn * BM + wc * 32 + 8 * fq;
#pragma unroll
        for (int ai = 0; ai < 2; ++ai)
#pragma unroll
            for (int m = 0; m < 4; ++m) {
                const int row = row0 + ai * HALF + m * 16;
#pragma unroll
                for (int bj = 0; bj < 2; ++bj) {
                    const f32x4 v0 = acc[ai][bj][m][0], v1 = acc[ai][bj][m][1];
                    u32x4 w; w.x = pk2h(v0.x, v0.y); w.y = pk2h(v0.z, v0.w); w.z = pk2h(v1.x, v1.y); w.w = pk2h(v1.z, v1.w);
                    *(u32x4*)(O + (size_t)row * D + col0 + bj * HALF) = w; }
            }
    }
};
struct EpiPle {
    static constexpr bool PERM = false;
    float* out; h16* o16; float* ssw; const float* ssr; const h16* pu;
    __device__ __forceinline__ void operator()(const Acc& acc, const Unit& u, int wr, int wc, int fr, int fq) const {
        const int row0 = u.pm * BM + wr * 64 + fr, col0 = u.pn * BM + wc * 32 + 4 * fq;
#pragma unroll
        for (int ai = 0; ai < 2; ++ai)
#pragma unroll
            for (int m = 0; m < 4; ++m) {
                const int row = row0 + ai * HALF + m * 16; const size_t off = (size_t)row * D + col0; float sq = 0.f; const float rs = row_rstd(ssr, row);
#pragma unroll
                for (int bj = 0; bj < 2; ++bj)
#pragma unroll
                    for (int n = 0; n < 2; ++n) { const size_t o = off + bj * HALF + n * 16; const f32x4 r = *(const f32x4*)(out + o); const h16x4 p = *(const h16x4*)(pu + o);
                        const f32x4 a = acc[ai][bj][m][n] * rs; f32x4 v;
                        v.x = r.x + sigmoidf_(a.x) * (float)p.x; v.y = r.y + sigmoidf_(a.y) * (float)p.y; v.z = r.z + sigmoidf_(a.z) * (float)p.z; v.w = r.w + sigmoidf_(a.w) * (float)p.w;
                        *(f32x4*)(out + o) = v; u32x2 w; w.x = pk2h(v.x, v.y); w.y = pk2h(v.z, v.w); *(u32x2*)(o16 + o) = w; sq += (v.x * v.x + v.y * v.y) + (v.z * v.z + v.w * v.w); }
                sq += __shfl_xor(sq, 16); sq += __shfl_xor(sq, 32);
                if (fq == 0) ssw[(size_t)row * 16 + u.pn * 4 + wc] = sq;
                asm volatile("" ::: "memory");
            }
    }
};
}

__device__ __forceinline__ void convert_matrix(const float* W, int K, int N, const float* gamma, h16* WT, int mode, LAS float* scr, int gw, int NGW, int lane) {
    const int nblk = N / 32, nitems = (K / 64) * nblk;
    for (int item = gw; item < nitems; item += NGW) {
        const int kb = item / nblk, nb = item % nblk, k0 = 64 * kb, n0 = 32 * nb;
        const int drow0 = (mode == 0) ? n0 : ((n0 >> 7) * 256 + (n0 & 127) + (mode == 2 ? 128 : 0));
#pragma unroll 8
        for (int i = 0; i < 32; ++i) { const int kk = 2 * i + (lane >> 5); float v = W[(size_t)(k0 + kk) * N + n0 + (lane & 31)]; if (gamma) v *= gamma[k0 + kk]; scr[kk * 33 + (lane & 31)] = v; }
        asm volatile("s_waitcnt lgkmcnt(0)" ::: "memory");
        const int c = lane & 7;
#pragma unroll
        for (int j = 0; j < 4; ++j) { const int n = (lane >> 3) + 8 * j; const LAS float* s = scr + (8 * c) * 33 + n;
            u32x4 o; o.x = pk2h(s[0 * 33], s[1 * 33]); o.y = pk2h(s[2 * 33], s[3 * 33]); o.z = pk2h(s[4 * 33], s[5 * 33]); o.w = pk2h(s[6 * 33], s[7 * 33]);
            *(u32x4*)(WT + (size_t)(drow0 + n) * K + k0 + 8 * c) = o; }
        asm volatile("s_waitcnt lgkmcnt(0)" ::: "memory");
    }
}

__device__ __forceinline__ void phase_convert(const Args& a, int layer, LAS unsigned char* lds, int tid, int lane, int wave, int bid, int G) {
    LAS float* scr = (LAS float*)(lds + wave * 16384);
    const int gw = bid * NWAVES + wave, NGW = G * NWAVES;
    h16* W = (h16*)(a.ws + WS_W);
    const size_t l = (size_t)layer;
    convert_matrix(a.in[I_F1G] + l * D * FF, D, FF, a.in[I_F1N] + l * D, W + W_FFN1U, 1, scr, gw, NGW, lane);
    convert_matrix(a.in[I_F1U] + l * D * FF, D, FF, a.in[I_F1N] + l * D, W + W_FFN1U, 2, scr, gw, NGW, lane);
    convert_matrix(a.in[I_F1D] + l * FF * D, FF, D, nullptr, W + W_FFN1D, 0, scr, gw, NGW, lane);
    convert_matrix(a.in[I_WIN] + l * D * 3456, D, 3456, a.in[I_MIXN] + l * D, W + W_IN, 0, scr, gw, NGW, lane);
    convert_matrix(a.in[I_WOUT] + l * D * D, D, D, nullptr, W + W_OUT, 0, scr, gw, NGW, lane);
    convert_matrix(a.in[I_F2G] + l * D * FF, D, FF, a.in[I_F2N] + l * D, W + W_FFN2U, 1, scr, gw, NGW, lane);
    convert_matrix(a.in[I_F2U] + l * D * FF, D, FF, a.in[I_F2N] + l * D, W + W_FFN2U, 2, scr, gw, NGW, lane);
    convert_matrix(a.in[I_F2D] + l * FF * D, FF, D, nullptr, W + W_FFN2D, 0, scr, gw, NGW, lane);
    convert_matrix(a.in[I_PLEG] + l * D * D, D, D, a.in[I_PLEN] + l * D, W + W_GATE, 0, scr, gw, NGW, lane);
    convert_matrix(a.in[I_PLEU] + l * PLE * D, PLE, D, nullptr, W + W_UP, 0, scr, gw, NGW, lane);
    { u32x4* z = (u32x4*)(W + W_IN + (size_t)3456 * 1024); const int n16 = 128 * 1024 * 2 / 16;
      for (int i = bid * NTHREADS + tid; i < n16; i += G * NTHREADS) z[i] = (u32x4){0u, 0u, 0u, 0u}; }
    if (layer == 0) {
        unsigned char* ws = a.ws; h16* Hp = GB_H16B(0); h16* Hs = GB_H16B(1); float* ss = (float*)(a.ws + WS_SSB);
        for (int m = gw; m < M; m += NGW) {
            h16* H = (m < MP) ? Hp : Hs;
            const float* xr = (m < MP) ? a.in[I_XP] + (size_t)m * D : a.in[I_XS] + (size_t)(m - MP) * D;
            const f32x4* x4 = (const f32x4*)xr + lane; float s = 0.f;
            u32x2* o = (u32x2*)(H + (size_t)m * D) + lane;
#pragma unroll
            for (int j = 0; j < 4; ++j) { const f32x4 v = x4[64 * j]; s += (v.x * v.x + v.y * v.y) + (v.z * v.z + v.w * v.w); u32x2 w; w.x = pk2h(v.x, v.y); w.y = pk2h(v.z, v.w); o[64 * j] = w; }
            s = wave_sum(s);
            if (lane < 16) ss[(size_t)m * 16 + lane] = (lane == 0) ? s : 0.f;
        }
    }
}

__device__ __forceinline__ void convert_p(const Args& a, int layer, int g, int nb, int cb, int tid) {
    unsigned char* ws = a.ws; const int rows = g ? MS : MP, row0 = g ? MP : 0;
    u32x2* o = (u32x2*)(GB_P16(g) + (size_t)row0 * PLE);
    const f32x4* p = (const f32x4*)((g ? a.in[I_PS] + (size_t)layer * MS * PLE : a.in[I_PP] + (size_t)layer * MP * PLE));
    const int N4 = rows * PLE / 4;
    for (int i = cb * NTHREADS + tid; i < N4; i += nb * NTHREADS) { const f32x4 v = p[i]; u32x2 w; w.x = pk2h(v.x, v.y); w.y = pk2h(v.z, v.w); o[i] = w; }
}

constexpr int NA_PITCH = 144;
constexpr int NA_VOFF = 512 * NA_PITCH;
constexpr int NA_PP = 67;
constexpr int NA_BTOFF = 2 * 512 * NA_PITCH;
__device__ __forceinline__ void na_item(const Args& a, int layer, int item, LAS unsigned char* lds, int tid, int lane, int wave) {
    int tok0, i, rows;
    if (item < 1024) { tok0 = (item >> 6) * TP; i = item & 63; rows = 64; } else { const int it2 = item - 1024; tok0 = MP + (it2 >> 8) * TS; i = it2 & 255; rows = 256; }
    int rs = i - 4; rs = rs < 0 ? 0 : (rs > rows - 8 ? rows - 8 : rs);
    unsigned char* ws = a.ws; const int g = item < 1024 ? 0 : 1;
    h16* MIX = GB_MIX(g); const h16* KNA = GB_KNA(g); const h16* VNA = GB_VNA(g);
    const float* rpb = a.in[I_RPB] + (size_t)layer * 8 * 15 * 31;
    const int wtok0 = tok0 + rs * 64;
    const int j = lane, aw = wave;
    const int tokq = tok0 + i * 64 + j;
    int cs = j - 8; cs = cs < 0 ? 0 : (cs > 48 ? 48 : cs);
    const int l31 = lane & 31, half = lane >> 5;
    LAS float* bt = (LAS float*)(lds + NA_BTOFF) + wave * 128;
    bt[lane] = 0.f; bt[64 + lane] = 0.f;
    u32x4 kreg[8], vreg[8];
    const size_t kvoff = (size_t)(wtok0 + (tid >> 3)) * 512 + (tid & 7) * 8;
#pragma unroll
    for (int it = 0; it < 8; ++it) { kreg[it] = *(const u32x4*)(KNA + kvoff + (size_t)it * (64 * 512)); vreg[it] = *(const u32x4*)(VNA + kvoff + (size_t)it * (64 * 512)); }
#pragma unroll 1
    for (int h = 0; h < 8; ++h) {
#pragma unroll
        for (int it = 0; it < 8; ++it) { const int key = (tid >> 3) + 64 * it, ch = tid & 7;
            *(LAS u32x4*)(lds + key * NA_PITCH + ch * 16) = kreg[it]; *(LAS u32x4*)(lds + NA_VOFF + key * NA_PITCH + ch * 16) = vreg[it]; }
        h16x8 qf[2][4];
#pragma unroll
        for (int nt = 0; nt < 2; ++nt)
#pragma unroll
            for (int ks = 0; ks < 4; ++ks) qf[nt][ks] = *(const h16x8*)(MIX + (size_t)(tok0 + i * 64 + l31 + 32 * nt) * 1024 + h * 64 + 16 * ks + 8 * half);
        if (lane < 31) bt[48 + lane] = rpb[((size_t)h * 15 + (rs + aw - i + 7)) * 31 + lane];
        __syncthreads();
        if (h + 1 < 8) {
#pragma unroll
            for (int it = 0; it < 8; ++it) { kreg[it] = *(const u32x4*)(KNA + kvoff + (size_t)it * (64 * 512) + (h + 1) * 64); vreg[it] = *(const u32x4*)(VNA + kvoff + (size_t)it * (64 * 512) + (h + 1) * 64); }
        }
        f32x16 acc[2][2];
#pragma unroll
        for (int mt = 0; mt < 2; ++mt)
#pragma unroll
            for (int nt = 0; nt < 2; ++nt)
#pragma unroll
                for (int r = 0; r < 16; ++r) acc[mt][nt][r] = 0.f;
#pragma unroll
        for (int mt = 0; mt < 2; ++mt)
#pragma unroll
            for (int ks = 0; ks < 4; ++ks) {
                const h16x8 kf = *(const LAS h16x8*)(lds + (aw * 64 + 32 * mt + l31) * NA_PITCH + (16 * ks + 8 * half) * 2);
                acc[mt][0] = __builtin_amdgcn_mfma_f32_32x32x16_f16(kf, qf[0][ks], acc[mt][0], 0, 0, 0);
                acc[mt][1] = __builtin_amdgcn_mfma_f32_32x32x16_f16(kf, qf[1][ks], acc[mt][1], 0, 0, 0);
            }
        float mxq[2], lq[2];
#pragma unroll
        for (int nt = 0; nt < 2; ++nt) {
            const int qc = l31 + 32 * nt; int csq = qc - 8; csq = csq < 0 ? 0 : (csq > 48 ? 48 : csq);
            const int dlt = 4 * half - csq;
            const LAS float* bq = bt + (48 + 15 + 4 * half - qc - 32);
            float m = -3.0e38f;
#pragma unroll
            for (int mt = 0; mt < 2; ++mt)
#pragma unroll
                for (int r = 0; r < 16; ++r) { const int kr = (r & 3) + 8 * (r >> 2) + 32 * mt;
                    const float sv = acc[mt][nt][r] + bq[32 + kr]; const bool ok = (unsigned)(dlt + kr) < 16u; const float sm = ok ? sv : -1.0e30f; acc[mt][nt][r] = sm; m = fmaxf(m, sm); }
            { const auto sw = __builtin_amdgcn_permlane32_swap(__builtin_bit_cast(unsigned, m), __builtin_bit_cast(unsigned, m), false, false); const unsigned s0 = sw[0], s1 = sw[1]; m = fmaxf(__builtin_bit_cast(float, s0), __builtin_bit_cast(float, s1)); }
            float l = 0.f;
#pragma unroll
            for (int mt = 0; mt < 2; ++mt)
#pragma unroll
                for (int r = 0; r < 16; ++r) { const float p = __expf(acc[mt][nt][r] - m); acc[mt][nt][r] = p; l += p; }
            { const auto sw = __builtin_amdgcn_permlane32_swap(__builtin_bit_cast(unsigned, l), __builtin_bit_cast(unsigned, l), false, false); const unsigned s0 = sw[0], s1 = sw[1]; l = __builtin_bit_cast(float, s0) + __builtin_bit_cast(float, s1); }
            mxq[nt] = m; lq[nt] = l;
        }
        h16x8 pf[2][2][2];
#pragma unroll
        for (int kt = 0; kt < 2; ++kt)
#pragma unroll
            for (int nt = 0; nt < 2; ++nt)
#pragma unroll
                for (int sx = 0; sx < 2; ++sx)
#pragma unroll
                    for (int e = 0; e < 8; ++e) pf[kt][nt][sx][e] = (h16)acc[kt][nt][8 * sx + e];
        f32x16 o[2][2];
#pragma unroll
        for (int dm = 0; dm < 2; ++dm)
#pragma unroll
            for (int nt = 0; nt < 2; ++nt)
#pragma unroll
                for (int r = 0; r < 16; ++r) o[dm][nt][r] = 0.f;
#pragma unroll
        for (int dm = 0; dm < 2; ++dm)
#pragma unroll
            for (int kt = 0; kt < 2; ++kt)
#pragma unroll
                for (int sx = 0; sx < 2; ++sx) {
                    h16x8 vf;
                    const LAS unsigned char* vb = lds + NA_VOFF + (aw * 64 + 32 * kt + 16 * sx + 4 * half) * NA_PITCH + (l31 + 32 * dm) * 2;
#pragma unroll
                    for (int e = 0; e < 8; ++e) vf[e] = *(const LAS h16*)(vb + ((e & 3) + 8 * (e >> 2)) * NA_PITCH);
                    o[dm][0] = __builtin_amdgcn_mfma_f32_32x32x16_f16(vf, pf[kt][0][sx], o[dm][0], 0, 0, 0);
                    o[dm][1] = __builtin_amdgcn_mfma_f32_32x32x16_f16(vf, pf[kt][1][sx], o[dm][1], 0, 0, 0);
                }
        __syncthreads();
#pragma unroll
        for (int nt = 0; nt < 2; ++nt) {
            LAS float* part = (LAS float*)lds + (size_t)(aw * 64 + l31 + 32 * nt) * NA_PP;
#pragma unroll
            for (int dm = 0; dm < 2; ++dm)
#pragma unroll
                for (int r = 0; r < 16; ++r) part[(r & 3) + 8 * (r >> 2) + 4 * half + 32 * dm] = o[dm][nt][r];
            if (half == 0) { part[64] = mxq[nt]; part[65] = lq[nt]; }
        }
        __syncthreads();
        {
            const int jq = tid & 63, e8 = tid >> 6;
            float mw[8], M_ = -3.0e38f;
#pragma unroll
            for (int w = 0; w < 8; ++w) { mw[w] = ((const LAS float*)lds)[(size_t)(w * 64 + jq) * NA_PP + 64]; M_ = fmaxf(M_, mw[w]); }
            float L = 0.f, ov[8];
#pragma unroll
            for (int e = 0; e < 8; ++e) ov[e] = 0.f;
#pragma unroll
            for (int w = 0; w < 8; ++w) { const float f = __expf(mw[w] - M_); const LAS float* pw = (const LAS float*)lds + (size_t)(w * 64 + jq) * NA_PP; L += f * pw[65];
#pragma unroll
                for (int e = 0; e < 8; ++e) ov[e] += f * pw[e8 * 8 + e]; }
            const float inv = 1.0f / L;
            u32x4 w4; w4.x = pk2h(ov[0] * inv, ov[1] * inv); w4.y = pk2h(ov[2] * inv, ov[3] * inv); w4.z = pk2h(ov[4] * inv, ov[5] * inv); w4.w = pk2h(ov[6] * inv, ov[7] * inv);
            *(u32x4*)(MIX + (size_t)(tok0 + i * 64 + jq) * 1024 + h * 64 + e8 * 8) = w4;
        }
        __syncthreads();
    }
}

__device__ __forceinline__ float shiftmix(const h16* base, size_t stride, int t, int T, float mu) {
    const float c = (float)base[0];
    const float p = (t > 0) ? (float)*(base - stride) : 0.f;
    const float n = (t < T - 1) ? (float)*(base + stride) : 0.f;
    return c + mu * (0.5f * (p + n) - c);
}
constexpr int SC_CH = 32;
constexpr int SC_OPB = SC_CH * 6 * 64 * 4;
constexpr int SC_YOFF = 2 * SC_OPB;
constexpr int SC_YB = SC_CH * 64 * 4;
constexpr int SC_XOFF = SC_YOFF + 2 * SC_YB;
constexpr int SC_ZOFF = SC_XOFF + 8192;
static_assert(SC_ZOFF + 4 * 4096 <= LDS_BYTES, "scan LDS");
__device__ __forceinline__ float wave_sum_fast(float v) {
    v = row16_sum(v);
    { const auto r = __builtin_amdgcn_permlane16_swap(__builtin_bit_cast(unsigned, v), __builtin_bit_cast(unsigned, v), false, false);
      const unsigned r0 = r[0], r1 = r[1]; v = __builtin_bit_cast(float, r0) + __builtin_bit_cast(float, r1); }
    { const auto r = __builtin_amdgcn_permlane32_swap(__builtin_bit_cast(unsigned, v), __builtin_bit_cast(unsigned, v), false, false);
      const unsigned r0 = r[0], r1 = r[1]; v = __builtin_bit_cast(float, r0) + __builtin_bit_cast(float, r1); }
    return v;
}
__device__ __forceinline__ float mix3(h16 p, h16 c, h16 n, float mu) { const float cf = (float)c; return cf + mu * (0.5f * ((float)p + (float)n) - cf); }
struct ScanWin { float r[10], k[10], v[10], wl[10], al[10]; };
__device__ __forceinline__ float mix3f(float p, float c, float n, float mu) { return c + mu * (0.5f * (p + n) - c); }
template <int R>
__device__ __forceinline__ void scan_flush(LAS unsigned char* lds, int cf, int pw, int lane, int d, int T, int tok0, int h, int rowbase, h16* Yf, h16* Yb) {
    const LAS float* yb = (const LAS float*)(lds + SC_YOFF + (cf & 1) * SC_YB);
    const int s = pw * 8 + (lane >> 3); const int g = cf * SC_CH + s; const int t = d ? (T - 1 - g) : g;
    if (R == 4) {
        const int r8 = (lane & 7) * 8;
        const f32x4 y0 = *(const LAS f32x4*)(yb + s * 64 + r8), y1 = *(const LAS f32x4*)(yb + s * 64 + r8 + 4);
        u32x4 w4; w4.x = pk2h(y0.x, y0.y); w4.y = pk2h(y0.z, y0.w); w4.z = pk2h(y1.x, y1.y); w4.w = pk2h(y1.z, y1.w);
        if (d == 0) *(u32x4*)(Yf + (size_t)(tok0 + t) * 1024 + 512 + h * 64 + r8) = w4; else *(u32x4*)(Yb + (size_t)(tok0 + t) * 512 + h * 64 + r8) = w4;
    } else {
        const int r4 = (lane & 7) * 4;
        const f32x4 y0 = *(const LAS f32x4*)(yb + s * 32 + r4);
        u32x2 w2; w2.x = pk2h(y0.x, y0.y); w2.y = pk2h(y0.z, y0.w);
        if (d == 0) *(u32x2*)(Yf + (size_t)(tok0 + t) * 1024 + 512 + h * 64 + rowbase + r4) = w2; else *(u32x2*)(Yb + (size_t)(tok0 + t) * 512 + h * 64 + rowbase + r4) = w2;
    }
}
template <int R>
__device__ __forceinline__ void scan_item(const Args& a, int layer, int q, int rowhalf, LAS unsigned char* lds, int tid, int lane, int wave) {
    int tok0, T, h, d;
    if (q < 32) { tok0 = MP + (q >> 4) * TS; T = TS; h = (q >> 1) & 7; d = q & 1; } else { const int q2 = q - 32; tok0 = (q2 >> 4) * TP; T = TP; h = (q2 >> 1) & 7; d = q2 & 1; }
    const int nch = T / SC_CH, rowbase = rowhalf * 16 * R;
    unsigned char* ws = a.ws; const int g = q < 32 ? 1 : 0;
    const h16* RR = GB_RR(g); const h16* RK = GB_RK(g); const h16* RV = GB_RV(g); const h16* LOWS = GB_LOWS(g);
    h16* Yf = GB_MIX(g); h16* Yb = GB_YB(g); float* BSC = GB_BSC(g);
    const size_t l = (size_t)layer;
    if (wave >= 4) {
        const int pw = wave - 4, j = lane, col = h * 64 + j;
        const float* mu = a.in[I_MU] + l * 1920;
        const float mu_r = mu[col], mu_k = mu[512 + col], mu_v = mu[1024 + col], mu_wl = mu[1536 + d * 64 + j], mu_al = mu[1536 + 128 + d * 64 + j];
        const float k_k = a.in[I_KK][l * 512 + col], k_a = a.in[I_KA][l * 512 + col], r_k = a.in[I_RK][l * 512 + col];
        const float w0 = a.in[I_W0][(l * 2 + d) * 512 + col], a0 = a.in[I_A0][(l * 2 + d) * 512 + col];
        h16x8 bw[4][2], ba[4][2];
        { const int n = lane & 15, kg = lane >> 4;
          const float* wu = a.in[I_WUP] + ((l * 2 + d) * 64 + 8 * kg) * 512 + h * 64 + n; const float* au = a.in[I_AUP] + ((l * 2 + d) * 64 + 8 * kg) * 512 + h * 64 + n;
#pragma unroll
          for (int ks = 0; ks < 2; ++ks) {
#pragma unroll
              for (int e = 0; e < 8; ++e) {
                  const float w_0 = wu[0], w_1 = wu[16], w_2 = wu[32], w_3 = wu[48], a_0 = au[0], a_1 = au[16], a_2 = au[32], a_3 = au[48];
                  wu += 512; au += 512; asm volatile("" : "+v"(wu), "+v"(au));
                  bw[0][ks][e] = (h16)w_0; bw[1][ks][e] = (h16)w_1; bw[2][ks][e] = (h16)w_2; bw[3][ks][e] = (h16)w_3;
                  ba[0][ks][e] = (h16)a_0; ba[1][ks][e] = (h16)a_1; ba[2][ks][e] = (h16)a_2; ba[3][ks][e] = (h16)a_3; }
              wu += 24 * 512; au += 24 * 512; asm volatile("" : "+v"(wu), "+v"(au)); } }
        LAS float* zl = (LAS float*)(lds + SC_ZOFF + pw * 4096);
        LAS unsigned char* xsb = lds + SC_XOFF + pw * 2048;
        ScanWin cur, nxt;
#define SCAN_LOAD_WIN(W_, cp_) do { const int g0_ = (cp_) * SC_CH + pw * 8; \
            _Pragma("unroll") for (int w = 0; w < 10; ++w) { const int tt = d ? (T - 1 - g0_) + 1 - w : g0_ - 1 + w; const bool ok = (tt >= 0) && (tt < T); const size_t tok = (size_t)(tok0 + (ok ? tt : 0)); \
                const h16 z_ = (h16)0.f; const h16 r_ = RR[tok * 512 + col], k_ = RK[tok * 512 + col], v_ = RV[tok * 512 + col], wl_ = LOWS[tok * 384 + d * 64 + j], al_ = LOWS[tok * 384 + 128 + d * 64 + j]; \
                W_.r[w] = (float)(ok ? r_ : z_); W_.k[w] = (float)(ok ? k_ : z_); W_.v[w] = (float)(ok ? v_ : z_); W_.wl[w] = (float)(ok ? wl_ : z_); W_.al[w] = (float)(ok ? al_ : z_); } } while (0)
        SCAN_LOAD_WIN(cur, 0);
        for (int c = -1; c < nch; ++c) {
            if (c >= 1) scan_flush<R>(lds, c - 1, pw, lane, d, T, tok0, h, rowbase, Yf, Yb);
            if (c + 1 < nch) {
                const int cp = c + 1; LAS float* op = (LAS float*)(lds + (cp & 1) * SC_OPB);
                if (c + 2 < nch) SCAN_LOAD_WIN(nxt, c + 2);
                float bsv = 0.f;
#pragma unroll
                for (int s8 = 0; s8 < 8; ++s8) {
                    const float wl = mix3f(cur.wl[s8], cur.wl[s8 + 1], cur.wl[s8 + 2], mu_wl);
                    const float al = mix3f(cur.al[s8], cur.al[s8 + 1], cur.al[s8 + 2], mu_al);
                    const float e2 = __expf(2.0f * wl); const float th = 1.0f - 2.0f * __builtin_amdgcn_rcpf(e2 + 1.0f);
                    LAS h16* xs = (LAS h16*)(xsb + s8 * 256);
                    xs[j] = (h16)th; xs[64 + j] = (h16)al;
                }
                {
                    const LAS unsigned char* xr = xsb + (lane & 7) * 256 + (lane >> 4) * 16;
                    const h16x8 xw0 = *(const LAS h16x8a*)(xr), xw1 = *(const LAS h16x8a*)(xr + 64), xa0 = *(const LAS h16x8a*)(xr + 128), xa1 = *(const LAS h16x8a*)(xr + 192);
                    f32x4 accw[4], acca[4];
#pragma unroll
                    for (int nt = 0; nt < 4; ++nt) {
                        accw[nt] = __builtin_amdgcn_mfma_f32_16x16x32_f16(xw0, bw[nt][0], (f32x4){0.f, 0.f, 0.f, 0.f}, 0, 0, 0);
                        accw[nt] = __builtin_amdgcn_mfma_f32_16x16x32_f16(xw1, bw[nt][1], accw[nt], 0, 0, 0);
                        acca[nt] = __builtin_amdgcn_mfma_f32_16x16x32_f16(xa0, ba[nt][0], (f32x4){0.f, 0.f, 0.f, 0.f}, 0, 0, 0);
                        acca[nt] = __builtin_amdgcn_mfma_f32_16x16x32_f16(xa1, ba[nt][1], acca[nt], 0, 0, 0); }
                    if (lane < 32) {
                        LAS float* zw = zl + (4 * (lane >> 4)) * 64 + (lane & 15);
#pragma unroll
                        for (int nt = 0; nt < 4; ++nt)
#pragma unroll
                            for (int r = 0; r < 4; ++r) { zw[r * 64 + 16 * nt] = accw[nt][r]; zw[512 + r * 64 + 16 * nt] = acca[nt][r]; }
                    }
                }
#pragma unroll
                for (int s8 = 0; s8 < 8; ++s8) {
                    const int s = pw * 8 + s8; const int g = cp * SC_CH + s; const int t = d ? (T - 1 - g) : g; const size_t tok = (size_t)(tok0 + t);
                    const float rr = mix3f(cur.r[s8], cur.r[s8 + 1], cur.r[s8 + 2], mu_r);
                    const float kk0 = mix3f(cur.k[s8], cur.k[s8 + 1], cur.k[s8 + 2], mu_k);
                    const float vv = mix3f(cur.v[s8], cur.v[s8 + 1], cur.v[s8 + 2], mu_v);
                    const float z = w0 + zl[s8 * 64 + j], az = a0 + zl[512 + s8 * 64 + j];
                    const float wdec = __expf(-0.606531f * sigmoidf_(z)); const float av = sigmoidf_(az);
                    float kk = kk0 * k_k; const float n2 = wave_sum_fast(kk * kk); kk = kk * __builtin_amdgcn_rsqf(fmaxf(n2, 1e-24f));
                    const float kd = kk0 * (1.0f + (av - 1.0f) * k_a); const float bb = kk * av;
                    const float bs = wave_sum_fast(rr * kd * r_k);
                    bsv = (lane == s8) ? bs : bsv;
                    LAS float* o = op + s * 384 + j;
                    o[0] = -kk; o[64] = wdec; o[128] = bb; o[192] = kd; o[256] = rr; o[320] = vv;
                }
                if (lane < 8 && rowhalf == 0) { const int gs = cp * SC_CH + pw * 8 + lane; const int t = d ? (T - 1 - gs) : gs; BSC[((size_t)(tok0 + t) * 8 + h) * 2 + d] = bsv; }
                cur = nxt;
            }
            __syncthreads();
        }
        scan_flush<R>(lds, nch - 1, pw, lane, d, T, tok0, h, rowbase, Yf, Yb);
#undef SCAN_LOAD_WIN
    } else {
        constexpr int RL = R / 2;
        const int ri = lane >> 3, ci = lane & 7;
        const int yrow = wave * 8 * RL + ri * RL, vrow = rowbase + yrow;
        f32x2 S[RL][4];
#pragma unroll
        for (int i = 0; i < RL; ++i)
#pragma unroll
            for (int c2 = 0; c2 < 4; ++c2) S[i][c2] = (f32x2){0.f, 0.f};
        typedef float vecR __attribute__((ext_vector_type(RL)));
        __syncthreads();
        for (int c = 0; c < nch; ++c) {
            const LAS f32x4* op = (const LAS f32x4*)(lds + (c & 1) * SC_OPB);
            LAS float* yb = (LAS float*)(lds + SC_YOFF + (c & 1) * SC_YB);
            f32x4 a0 = op[2 * ci], a1 = op[2 * ci + 1], w0 = op[16 + 2 * ci], w1 = op[17 + 2 * ci], b0 = op[32 + 2 * ci], b1 = op[33 + 2 * ci];
            f32x4 k0 = op[48 + 2 * ci], k1 = op[49 + 2 * ci], r0 = op[64 + 2 * ci], r1 = op[65 + 2 * ci]; vecR v4 = *(const LAS vecR*)((const LAS float*)op + 320 + vrow);
#pragma unroll 4
            for (int s = 0; s < SC_CH; ++s) {
                const LAS f32x4* on = op + (s + 1) * 96;
                const f32x4 na0 = on[2 * ci], na1 = on[2 * ci + 1], nw0 = on[16 + 2 * ci], nw1 = on[17 + 2 * ci], nb0 = on[32 + 2 * ci], nb1 = on[33 + 2 * ci];
                const f32x4 nk0 = on[48 + 2 * ci], nk1 = on[49 + 2 * ci], nr0 = on[64 + 2 * ci], nr1 = on[65 + 2 * ci]; const vecR nv4 = *(const LAS vecR*)((const LAS float*)on + 320 + vrow);
                const f32x2 av[4] = {{a0.x, a0.y}, {a0.z, a0.w}, {a1.x, a1.y}, {a1.z, a1.w}}, wv[4] = {{w0.x, w0.y}, {w0.z, w0.w}, {w1.x, w1.y}, {w1.z, w1.w}};
                const f32x2 bv[4] = {{b0.x, b0.y}, {b0.z, b0.w}, {b1.x, b1.y}, {b1.z, b1.w}}, kv[4] = {{k0.x, k0.y}, {k0.z, k0.w}, {k1.x, k1.y}, {k1.z, k1.w}};
                const f32x2 rv[4] = {{r0.x, r0.y}, {r0.z, r0.w}, {r1.x, r1.y}, {r1.z, r1.w}};
                float sa[RL];
#pragma unroll
                for (int i = 0; i < RL; ++i) { f32x2 p = S[i][0] * av[0]; p = S[i][1] * av[1] + p; p = S[i][2] * av[2] + p; p = S[i][3] * av[3] + p;
                    float t = p.x + p.y; t += dpp_f<0xB1>(t); t += dpp_f<0x4E>(t); t += dpp_f<0x141>(t); sa[i] = t; }
                vecR y;
#pragma unroll
                for (int i = 0; i < RL; ++i) { const f32x2 sa2 = {sa[i], sa[i]}, v2 = {v4[i], v4[i]};
#pragma unroll
                    for (int c2 = 0; c2 < 4; ++c2) S[i][c2] = S[i][c2] * wv[c2] + sa2 * bv[c2] + v2 * kv[c2];
                    f32x2 p = S[i][0] * rv[0]; p = S[i][1] * rv[1] + p; p = S[i][2] * rv[2] + p; p = S[i][3] * rv[3] + p;
                    float t = p.x + p.y; t += dpp_f<0xB1>(t); t += dpp_f<0x4E>(t); t += dpp_f<0x141>(t); y[i] = t; }
                if (ci == 0) *(LAS vecR*)(yb + s * (32 * RL) + yrow) = y;
                a0 = na0; a1 = na1; w0 = nw0; w1 = nw1; b0 = nb0; b1 = nb1; k0 = nk0; k1 = nk1; r0 = nr0; r1 = nr1; v4 = nv4;
            }
            __syncthreads();
        }
    }
}

__device__ __forceinline__ void rwpost_tile(const Args& a, int layer, int tile, LAS unsigned char* lds, int tid, int lane, int wave, const h16x8 (&bg)[4][4]) {
    const size_t l = (size_t)layer; const int h = wave, n16 = lane & 15, g4 = lane >> 4;
    const int m0 = tile * 64; int tok0s, T; if (m0 < MP) { T = TP; tok0s = (m0 / TP) * TP; } else { T = TS; tok0s = MP + ((m0 - MP) / TS) * TS; }
    unsigned char* ws = a.ws; const int g = m0 < MP ? 0 : 1;
    const h16* LOWS = GB_LOWS(g); const h16* RV = GB_RV(g); h16* MIX = GB_MIX(g); const h16* Yb = GB_YB(g); const float* BSC = GB_BSC(g);
    const float* mu = a.in[I_MU] + l * 1920;
    LAS h16* G = (LAS h16*)lds;
    { const int c = tid & 127; const float mug = mu[1536 + 256 + c];
#pragma unroll 4
      for (int e = tid; e < 64 * 128; e += NTHREADS) { const int tk = e >> 7; const int m = m0 + tk; const int t = m - tok0s;
        const float gl = shiftmix(LOWS + (size_t)m * 384 + 256 + c, 384, t, T, mug); G[e] = (h16)sigmoidf_(gl); } }
    float muv[4], lw[4], lb[4];
#pragma unroll
    for (int nt = 0; nt < 4; ++nt) { const int col = wave * 64 + 16 * nt + n16; muv[nt] = mu[1024 + col]; lw[nt] = a.in[I_LNW][l * 512 + col]; lb[nt] = a.in[I_LNB][l * 512 + col]; }
    __syncthreads();
#pragma unroll 1
    for (int mt = 0; mt < 4; ++mt) {
        const int tk0 = 16 * mt + 4 * g4;
        h16 ym[4][4], yb[4][4], rv[6][4]; float b0[4], b1[4];
#pragma unroll
        for (int w = 0; w < 6; ++w) { const int m = m0 + tk0 - 1 + w; const int t = m - tok0s; const bool ok = (t >= 0) && (t < T);
#pragma unroll
            for (int nt = 0; nt < 4; ++nt) { const h16 v = RV[(size_t)(ok ? m : m0) * 512 + wave * 64 + 16 * nt + n16]; rv[w][nt] = ok ? v : (h16)0.f; } }
#pragma unroll
        for (int r = 0; r < 4; ++r) { const size_t m = (size_t)(m0 + tk0 + r); b0[r] = BSC[(m * 8 + h) * 2]; b1[r] = BSC[(m * 8 + h) * 2 + 1];
#pragma unroll
            for (int nt = 0; nt < 4; ++nt) { const int col = wave * 64 + 16 * nt + n16; ym[r][nt] = MIX[m * 1024 + 512 + col]; yb[r][nt] = Yb[m * 512 + col]; } }
        f32x4 acc[4];
#pragma unroll
        for (int nt = 0; nt < 4; ++nt) acc[nt] = (f32x4){0.f, 0.f, 0.f, 0.f};
#pragma unroll
        for (int ks = 0; ks < 4; ++ks) {
            const h16x8 af = *(const LAS h16x8a*)((const LAS unsigned char*)G + (16 * mt + n16) * 256 + (32 * ks + 8 * g4) * 2);
#pragma unroll
            for (int nt = 0; nt < 4; ++nt) acc[nt] = __builtin_amdgcn_mfma_f32_16x16x32_f16(af, bg[nt][ks], acc[nt], 0, 0, 0);
        }
#pragma unroll
        for (int r = 0; r < 4; ++r) {
            const size_t m = (size_t)(m0 + tk0 + r);
            float wkv[4]; float sm = 0.f;
#pragma unroll
            for (int nt = 0; nt < 4; ++nt) { wkv[nt] = (float)ym[r][nt] + (float)yb[r][nt]; sm += wkv[nt]; }
            const float mean = row16_sum(sm) * (1.0f / 64.0f); float sq = 0.f;
#pragma unroll
            for (int nt = 0; nt < 4; ++nt) { wkv[nt] -= mean; sq += wkv[nt] * wkv[nt]; }
            const float rstd = __builtin_amdgcn_rsqf(row16_sum(sq) * (1.0f / 64.0f) + 64e-5f); const float bsum = b0[r] + b1[r];
#pragma unroll
            for (int nt = 0; nt < 4; ++nt) { const float yn = wkv[nt] * rstd * lw[nt] + lb[nt]; const float vv = mix3(rv[r][nt], rv[r + 1][nt], rv[r + 2][nt], muv[nt]);
                MIX[m * 1024 + 512 + wave * 64 + 16 * nt + n16] = (h16)((yn + bsum * vv) * acc[nt][r]); }
        }
    }
    __syncthreads();
}

#define STAGE_ARGS const Args& args, int layer, int g, int nb, int cb, LAS unsigned char* lds
#define FRESH_TID int tid = threadIdx.x; asm volatile("" : "+v"(tid)); const int lane = tid & 63, wave = __builtin_amdgcn_readfirstlane(tid >> 6); (void)lane; (void)wave;
__device__ __forceinline__ int g_rows(int g) { return g ? MS : MP; }
__device__ __forceinline__ int g_pm0(int g) { return g ? MP / 256 : 0; }
template <class Epi> __device__ __forceinline__ void run_gemm(LAS unsigned char* lds, const h16* A, int lda, const h16* Bt, int N, int K, int g, int nb, int cb, const Epi& E, int tid) {
    pg8::Gemm gm{A, Bt, g_rows(g), N, K, lda}; pg8::StaticOrder S; S.init(g_rows(g), N, nb, cb, g_pm0(g)); pg8::gemm_phase(lds, gm, S, E, tid);
}
__device__ __forceinline__ void st_ffn_up(STAGE_ARGS, int which) {
    FRESH_TID unsigned char* ws = args.ws; const h16* W = (const h16*)(ws + WS_W);
    pg8::EpiSwiglu E{GB_ACT(g), (const float*)(ws + (which ? WS_SSA : WS_SSB))};
    run_gemm(lds, which ? GB_H16(g) : GB_H16B(g), D, W + (which ? W_FFN2U : W_FFN1U), 2 * FF, D, g, nb, cb, E, tid);
}
__device__ __forceinline__ void st_ffn_down(STAGE_ARGS, int which) {
    FRESH_TID unsigned char* ws = args.ws; const h16* W = (const h16*)(ws + WS_W); float* out = args.out;
    const bool first = (which == 0 && layer == 0);
    const float* rp = first ? args.in[I_XP] : (const float*)out; const float* rsm = first ? args.in[I_XS] - (size_t)MP * D : (const float*)out;
    pg8::EpiResid E{rp, rsm, out, GB_H16(g), (float*)(ws + WS_SSA), 0.5f};
    run_gemm(lds, GB_ACT(g), FF, W + (which ? W_FFN2D : W_FFN1D), D, FF, g, nb, cb, E, tid);
}
__device__ __forceinline__ void st_win(STAGE_ARGS) {
    FRESH_TID unsigned char* ws = args.ws; const h16* W = (const h16*)(ws + WS_W);
    pg8::EpiProj E{GB_MIX(g), GB_KNA(g), (size_t)512 * g_rows(g), GB_LOWS(g), (const float*)(ws + WS_SSA)};
    run_gemm(lds, GB_H16(g), D, W + W_IN, NPROJ, D, g, nb, cb, E, tid);
}
__device__ __forceinline__ void st_wout(STAGE_ARGS) {
    FRESH_TID unsigned char* ws = args.ws; const h16* W = (const h16*)(ws + WS_W); float* out = args.out;
    pg8::EpiResid E{out, out, out, GB_H16(g), (float*)(ws + WS_SSA), 1.0f};
    run_gemm(lds, GB_MIX(g), D, W + W_OUT, D, D, g, nb, cb, E, tid);
}
__device__ __forceinline__ void st_pu(STAGE_ARGS) {
    FRESH_TID unsigned char* ws = args.ws; const h16* W = (const h16*)(ws + WS_W);
    int kpu = PLE; asm volatile("" : "+s"(kpu));
    pg8::EpiPU E{GB_PU(g)};
    run_gemm(lds, GB_P16(g), kpu, W + W_UP, D, kpu, g, nb, cb, E, tid);
}
__device__ __forceinline__ void st_ple(STAGE_ARGS) {
    FRESH_TID unsigned char* ws = args.ws; const h16* W = (const h16*)(ws + WS_W); float* out = args.out;
    pg8::EpiPle E{out, GB_H16B(g), (float*)(ws + WS_SSB), (const float*)(ws + WS_SSA), GB_PU(g)};
    run_gemm(lds, GB_H16(g), D, W + W_GATE, D, D, g, nb, cb, E, tid);
}
__device__ __forceinline__ void st_rwpost(STAGE_ARGS) {
    FRESH_TID const int t0 = g ? MP / 64 : 0, nt_ = g_rows(g) / 64;
    h16x8 bg[4][4];
    { const float* gu = args.in[I_GUP] + (size_t)layer * 128 * 512 + (size_t)(8 * (lane >> 4)) * 512 + wave * 64 + (lane & 15);
#pragma unroll
      for (int ks = 0; ks < 4; ++ks) {
#pragma unroll
          for (int e = 0; e < 8; ++e) { const float g_0 = gu[0], g_1 = gu[16], g_2 = gu[32], g_3 = gu[48]; gu += 512; asm volatile("" : "+v"(gu));
              bg[0][ks][e] = (h16)g_0; bg[1][ks][e] = (h16)g_1; bg[2][ks][e] = (h16)g_2; bg[3][ks][e] = (h16)g_3; }
          gu += 24 * 512; asm volatile("" : "+v"(gu)); } }
    for (int tile = cb; tile < nt_; tile += nb) rwpost_tile(args, layer, t0 + tile, lds, tid, lane, wave, bg);
}
__device__ __forceinline__ void st_convp(STAGE_ARGS) { FRESH_TID convert_p(args, layer, g, nb, cb, tid); }

__device__ __forceinline__ void sub_sync(unsigned* ctr, unsigned target) {
    asm volatile("s_waitcnt vmcnt(0) lgkmcnt(0)" ::: "memory");
    __syncthreads();
    if (threadIdx.x == 0) {
        __builtin_amdgcn_fence(__ATOMIC_RELEASE, "agent"); asm volatile("s_waitcnt vmcnt(0)" ::: "memory");
        __hip_atomic_fetch_add(ctr, 1u, __ATOMIC_RELAXED, __HIP_MEMORY_SCOPE_AGENT);
        while (__hip_atomic_load(ctr, __ATOMIC_RELAXED, __HIP_MEMORY_SCOPE_AGENT) < target) __builtin_amdgcn_s_sleep(2);
    }
    __syncthreads();
    __builtin_amdgcn_fence(__ATOMIC_ACQUIRE, "agent"); asm volatile("s_waitcnt vmcnt(0)" ::: "memory");
}

constexpr int NSB = 32;
__global__ void __launch_bounds__(NTHREADS, 2) fwd_megakernel(Args args) {
    extern __shared__ __attribute__((aligned(16))) unsigned char lds_raw[];
    LAS unsigned char* lds = (LAS unsigned char*)lds_raw;
    cg::grid_group grid = cg::this_grid();
    const int bid = blockIdx.x, G = gridDim.x;
    const int NPB = G - NSB, pb = bid - NSB;
    unsigned* ctr = (unsigned*)(args.ws + WS_CTR);
    if (bid == 0 && threadIdx.x == 0) __hip_atomic_store(ctr, 0u, __ATOMIC_RELAXED, __HIP_MEMORY_SCOPE_AGENT);
    unsigned sbt = 0;
#define SUBSYNC() do { sbt += (unsigned)NPB; sub_sync(ctr, sbt); } while (0)

    for (int layer = 0; layer < 2; ++layer) {
        { FRESH_TID phase_convert(args, layer, lds, tid, lane, wave, bid, G); }
        grid_sync(grid);
        st_ffn_up(args, layer, 1, G, bid, lds, 0); grid_sync(grid);
        st_ffn_down(args, layer, 1, G, bid, lds, 0); grid_sync(grid);
        st_win(args, layer, 1, G, bid, lds); grid_sync(grid);
        if (bid < NSB) {
            FRESH_TID scan_item<4>(args, layer, bid, 0, lds, tid, lane, wave);
        } else {
            st_ffn_up(args, layer, 0, NPB, pb, lds, 0); SUBSYNC();
            st_ffn_down(args, layer, 0, NPB, pb, lds, 0); SUBSYNC();
            st_win(args, layer, 0, NPB, pb, lds); SUBSYNC();
            { FRESH_TID
              scan_item<4>(args, layer, 32 + pb, 0, lds, tid, lane, wave); __syncthreads();
              if (pb < 2 * (256 - NPB)) { scan_item<2>(args, layer, 32 + NPB + (pb >> 1), pb & 1, lds, tid, lane, wave); __syncthreads(); }
              else { for (int it = pb - 2 * (256 - NPB); it < 1536; it += NPB - 2 * (256 - NPB)) na_item(args, layer, it, lds, tid, lane, wave); } }
            SUBSYNC();
            st_rwpost(args, layer, 0, NPB, pb, lds); SUBSYNC();
            st_wout(args, layer, 0, NPB, pb, lds); SUBSYNC();
            st_ffn_up(args, layer, 0, NPB, pb, lds, 1);
        }
        grid_sync(grid);
        st_rwpost(args, layer, 1, G, bid, lds); st_ffn_down(args, layer, 0, G, bid, lds, 1); st_convp(args, layer, 0, G, bid, lds); grid_sync(grid);
        st_wout(args, layer, 1, G, bid, lds); st_pu(args, layer, 0, G, bid, lds); grid_sync(grid);
        st_ffn_up(args, layer, 1, G, bid, lds, 1); st_ple(args, layer, 0, G, bid, lds); grid_sync(grid);
        st_ffn_down(args, layer, 1, G, bid, lds, 1); st_convp(args, layer, 1, G, bid, lds); grid_sync(grid);
        st_pu(args, layer, 1, G, bid, lds); grid_sync(grid);
        st_ple(args, layer, 1, G, bid, lds); grid_sync(grid);
    }
    {
        FRESH_TID
        const float* SSB = (const float*)(args.ws + WS_SSB); float* out = args.out;
        const int gw = bid * NWAVES + wave, NGW = G * NWAVES; const f32x4* gm = (const f32x4*)args.in[I_FINAL] + lane;
        f32x4 gv[4];
#pragma unroll
        for (int j = 0; j < 4; ++j) gv[j] = gm[64 * j];
        for (int m = gw; m < M; m += 2 * NGW) {
            const int m2 = m + NGW;
            const float rs = row_rstd(SSB, m), rs2 = row_rstd(SSB, m2); f32x4* o = (f32x4*)(out + (size_t)m * D) + lane; f32x4* o2 = (f32x4*)(out + (size_t)m2 * D) + lane;
            f32x4 v[4], v2[4];
#pragma unroll
            for (int j = 0; j < 4; ++j) { v[j] = o[64 * j]; v2[j] = o2[64 * j]; }
#pragma unroll
            for (int j = 0; j < 4; ++j) { o[64 * j] = v[j] * rs * gv[j]; o2[64 * j] = v2[j] * rs2 * gv[j]; }
        }
    }
}

extern "C" void kernel_launch(void* const* d_in, const int* in_sizes, int n_in, void* d_out, int out_size, void* d_ws, size_t ws_size, hipStream_t stream) {
    static int grid = 0;
    if (grid == 0) {
        if (n_in != N_IN || out_size != M * D || ws_size < WS_END) { fprintf(stderr, "kernel_launch: unexpected shapes (n_in %d, out %d, ws %zu)\n", n_in, out_size, ws_size); grid = -1; return; }
        int dev = 0, cus = 0, per_cu = 0;
        (void)hipGetDevice(&dev); (void)hipDeviceGetAttribute(&cus, hipDeviceAttributeMultiprocessorCount, dev);
        (void)hipFuncSetAttribute((const void*)fwd_megakernel, hipFuncAttributeMaxDynamicSharedMemorySize, LDS_BYTES);
        (void)hipOccupancyMaxActiveBlocksPerMultiprocessor(&per_cu, (const void*)fwd_megakernel, NTHREADS, LDS_BYTES);
        if (per_cu < 1) fprintf(stderr, "kernel_launch: occupancy query says %d blocks per CU\n", per_cu);
        grid = cus;
        if (grid != 256) fprintf(stderr, "kernel_launch: grid %d (expected 256)\n", grid);
        if (grid <= NSB + 64) { fprintf(stderr, "kernel_launch: grid too small\n"); grid = -1; return; }
    }
    if (grid < 0) return;
    Args a{};
    for (int i = 0; i < N_IN; ++i) a.in[i] = (const float*)d_in[i];
    a.out = (float*)d_out; a.ws = (unsigned char*)d_ws;
    void* kargs[] = {&a};
    hipError_t e = hipLaunchCooperativeKernel((const void*)fwd_megakernel, dim3(grid), dim3(NTHREADS), kargs, LDS_BYTES, stream);
    if (e != hipSuccess) fprintf(stderr, "kernel_launch: cooperative launch failed: %s\n", hipGetErrorString(e));
}
```

```cpp
#include <hip/hip_runtime.h>
#include <hip/hip_cooperative_groups.h>
#include <cstdio>
#include <cstdint>
namespace cg = cooperative_groups;
#ifndef PHM
#define PHM 0xFFFF
#endif
#define PH(k) ((PHM >> (k)) & 1)

#define LAS __attribute__((address_space(3)))
typedef _Float16 h16;
typedef _Float16 h16x2 __attribute__((ext_vector_type(2)));
typedef _Float16 h16x4 __attribute__((ext_vector_type(4)));
typedef _Float16 h16x8 __attribute__((ext_vector_type(8)));
typedef _Float16 h16x8a __attribute__((ext_vector_type(8), may_alias));
typedef float f32x2 __attribute__((ext_vector_type(2)));
typedef float f32x4 __attribute__((ext_vector_type(4)));
typedef float f32x16 __attribute__((ext_vector_type(16)));
typedef unsigned u32x2 __attribute__((ext_vector_type(2)));
typedef unsigned u32x4 __attribute__((ext_vector_type(4)));
typedef unsigned u32x4a __attribute__((ext_vector_type(4), may_alias));

constexpr int D = 1024, FF = 2816, MP = 65536, MS = 32768, M = MP + MS, TP = 4096, TS = 16384, PLE = 256;
constexpr int NPROJ = 3584;
constexpr int NTHREADS = 512, NWAVES = 8;
constexpr int LDS_BYTES = 151552;
constexpr size_t MiB = 1u << 20;
constexpr size_t WS_CTR = 256;
constexpr size_t WS_W = 1 * MiB;
constexpr size_t WS_SSA = 46 * MiB;
constexpr size_t WS_SSB = 52 * MiB;
constexpr size_t REG_P = 58 * MiB, REG_S = 682 * MiB, WS_END = 994 * MiB;
constexpr size_t OFF_H16 = 0;
constexpr size_t OFF_MIX = 2048;
constexpr size_t OFF_KNA = 4096, OFF_VNA = 5120, OFF_RR = 6144, OFF_RK = 7168, OFF_RV = 8192;
constexpr size_t OFF_LOWS = 9216;
constexpr size_t OFF_ACT = 2048;
constexpr size_t OFF_P16 = 7680;
constexpr size_t OFF_PU = 2048;
constexpr size_t OFF_H16B = 7680;
constexpr size_t OFF_YB = 0, OFF_BSC = 1024;
constexpr size_t OFF_END = 9984;
static_assert(REG_P + OFF_END * MP <= REG_S && REG_S + OFF_END * MS <= WS_END, "group regions");
__device__ __forceinline__ unsigned char* gbuf(unsigned char* ws, int g, size_t off, size_t stride) {
    const size_t reg = g ? REG_S : REG_P, rows = g ? (size_t)MS : (size_t)MP, row0 = g ? (size_t)MP : 0;
    return ws + (reg + off * rows - row0 * stride);
}
#define GB_H16(g)  ((h16*)gbuf(ws, g, OFF_H16, 2048))
#define GB_H16B(g) ((h16*)gbuf(ws, g, OFF_H16B, 2048))
#define GB_MIX(g)  ((h16*)gbuf(ws, g, OFF_MIX, 2048))
#define GB_KNA(g)  ((h16*)gbuf(ws, g, OFF_KNA, 1024))
#define GB_VNA(g)  ((h16*)gbuf(ws, g, OFF_VNA, 1024))
#define GB_RR(g)   ((h16*)gbuf(ws, g, OFF_RR, 1024))
#define GB_RK(g)   ((h16*)gbuf(ws, g, OFF_RK, 1024))
#define GB_RV(g)   ((h16*)gbuf(ws, g, OFF_RV, 1024))
#define GB_LOWS(g) ((h16*)gbuf(ws, g, OFF_LOWS, 768))
#define GB_ACT(g)  ((h16*)gbuf(ws, g, OFF_ACT, 5632))
#define GB_P16(g)  ((h16*)gbuf(ws, g, OFF_P16, 512))
#define GB_PU(g)   ((h16*)gbuf(ws, g, OFF_PU, 2048))
#define GB_YB(g)   ((h16*)gbuf(ws, g, OFF_YB, 1024))
#define GB_BSC(g)  ((float*)gbuf(ws, g, OFF_BSC, 64))
constexpr size_t W_FFN1U = 0;
constexpr size_t W_FFN1D = W_FFN1U + (size_t)5632 * 1024;
constexpr size_t W_IN = W_FFN1D + (size_t)1024 * 2816;
constexpr size_t W_OUT = W_IN + (size_t)3584 * 1024;
constexpr size_t W_FFN2U = W_OUT + (size_t)1024 * 1024;
constexpr size_t W_FFN2D = W_FFN2U + (size_t)5632 * 1024;
constexpr size_t W_GATE = W_FFN2D + (size_t)1024 * 2816;
constexpr size_t W_UP = W_GATE + (size_t)1024 * 1024;
constexpr size_t W_ENDE = W_UP + (size_t)1024 * 256;
static_assert(WS_W + W_ENDE * 2 <= WS_SSA, "weights fit");

enum { I_XP = 0, I_XS, I_PP, I_PS, I_F1N, I_F1G, I_F1U, I_F1D, I_MIXN, I_WIN, I_RPB, I_MU, I_W0, I_WUP, I_A0, I_AUP, I_GUP, I_KK, I_KA, I_RK, I_LNW, I_LNB,
       I_WOUT, I_F2N, I_F2G, I_F2U, I_F2D, I_PLEN, I_PLEG, I_PLEU, I_FINAL, N_IN };
struct Args { const float* in[N_IN]; float* out; unsigned char* ws; };

__device__ __forceinline__ float wave_sum(float v) {
#pragma unroll
    for (int o = 1; o < 64; o <<= 1) v += __shfl_xor(v, o);
    return v;
}
__device__ __forceinline__ unsigned pk2h(float a, float b) { h16x2 p = {(h16)a, (h16)b}; return __builtin_bit_cast(unsigned, p); }
__device__ __forceinline__ h16x2 as_h2(unsigned u) { return __builtin_bit_cast(h16x2, u); }
__device__ __forceinline__ float dot2h(unsigned a, h16x2 b, float c) { return __builtin_amdgcn_fdot2(as_h2(a), b, c, false); }
__device__ __forceinline__ float dot8(u32x4 a, u32x4 b, float c) { const unsigned a0 = a[0], a1 = a[1], a2 = a[2], a3 = a[3], b0 = b[0], b1 = b[1], b2 = b[2], b3 = b[3];
    c = __builtin_amdgcn_fdot2(as_h2(a0), as_h2(b0), c, false); c = __builtin_amdgcn_fdot2(as_h2(a1), as_h2(b1), c, false); c = __builtin_amdgcn_fdot2(as_h2(a2), as_h2(b2), c, false); c = __builtin_amdgcn_fdot2(as_h2(a3), as_h2(b3), c, false); return c; }
__device__ __forceinline__ float dot8w(u32x4 a, h16x2 w0, h16x2 w1, h16x2 w2, h16x2 w3, float c) { const unsigned a0 = a[0], a1 = a[1], a2 = a[2], a3 = a[3];
    c = __builtin_amdgcn_fdot2(as_h2(a0), w0, c, false); c = __builtin_amdgcn_fdot2(as_h2(a1), w1, c, false); c = __builtin_amdgcn_fdot2(as_h2(a2), w2, c, false); c = __builtin_amdgcn_fdot2(as_h2(a3), w3, c, false); return c; }
__device__ __forceinline__ float fma_mix_lo(float p, unsigned v, float o) { asm("v_fma_mix_f32 %0, %1, %2, %0 op_sel_hi:[0,1,0]" : "+v"(o) : "v"(p), "v"(v)); return o; }
__device__ __forceinline__ float fma_mix_hi(float p, unsigned v, float o) { asm("v_fma_mix_f32 %0, %1, %2, %0 op_sel:[0,1,0] op_sel_hi:[0,1,0]" : "+v"(o) : "v"(p), "v"(v)); return o; }
__device__ __forceinline__ float sigmoidf_(float x) { return __builtin_amdgcn_rcpf(1.0f + __expf(-x)); }
__device__ __forceinline__ float row_rstd(const float* ss, int row) {
    const f32x4* p = (const f32x4*)(ss + (size_t)row * 16);
    const f32x4 a = p[0], b = p[1], c = p[2], d = p[3];
    const float s = ((a.x + a.y) + (a.z + a.w)) + ((b.x + b.y) + (b.z + b.w)) + ((c.x + c.y) + (c.z + c.w)) + ((d.x + d.y) + (d.z + d.w));
    return __builtin_amdgcn_rsqf(s * (1.0f / 1024.0f) + 1e-6f);
}
template <int CTRL> __device__ __forceinline__ float dpp_f(float v) { return __builtin_bit_cast(float, __builtin_amdgcn_update_dpp(0, __builtin_bit_cast(int, v), CTRL, 0xF, 0xF, true)); }
__device__ __forceinline__ float row16_sum(float v) {
    v += dpp_f<0xB1>(v);
    v += dpp_f<0x4E>(v);
    v += dpp_f<0x141>(v);
    v += dpp_f<0x140>(v);
    return v;
}
__device__ __forceinline__ void grid_sync(cg::grid_group& grid) {
    asm volatile("s_waitcnt vmcnt(0) lgkmcnt(0)" ::: "memory"); grid.sync();
    __builtin_amdgcn_fence(__ATOMIC_ACQUIRE, "agent"); asm volatile("s_waitcnt vmcnt(0)" ::: "memory"); }

namespace pg8 {
constexpr int BM = 256, BK = 64, HALF = 128, HTB = HALF * BK * 2, STAGE_BYTES = 8 * HTB, NXCD = 8, WGM = 8;
__host__ __device__ __forceinline__ int lds_byte(int r, int c) { const int st = (r >> 4) * 2 + (c >> 5), rr = r & 15, cc = c & 31, ob = rr * 64 + cc * 2; return st * 1024 + (ob ^ (((ob >> 9) & 1) << 5)); }
__host__ __device__ __forceinline__ void stage_rc(int b, int& R, int& C) { const int st = b / 1024, sb = b % 1024, swz = sb ^ (((sb >> 9) & 1) << 5); R = (st >> 1) * 16 + swz / 64; C = (st & 1) * 32 + (swz % 64) / 2; }
__host__ __device__ __forceinline__ int perm32(int rho) { const int n = rho >> 4, i = rho & 15; return 8 * (i >> 2) + 4 * n + (i & 3); }
struct Unit { int pm, pn; };
struct Gemm { const h16* A; const h16* Bt; int M, N, K, lda; };
struct StaticOrder {
    int nM, nN, nwg, G, c, pm0;
    __device__ void init(int M_, int N_, int G_, int c_, int pm0_) { nM = M_ / BM; nN = N_ / BM; nwg = nM * nN; G = G_; c = c_; pm0 = pm0_; }
    __device__ bool next(int i, Unit& u) const {
        const long L = (long)i * G + c; if (L >= nwg) return false;
        int wgid = (int)L; { const int q = nwg / NXCD, r = nwg % NXCD, xcd = wgid % NXCD, off = wgid / NXCD; wgid = (xcd < r ? xcd * (q + 1) : r * (q + 1) + (xcd - r) * q) + off; }
        const int nig = WGM * nN, gid = wgid / nig, fm = gid * WGM, gsz = (nM - fm) < WGM ? (nM - fm) : WGM;
        u.pm = pm0 + fm + ((wgid % nig) % gsz); u.pn = (wgid % nig) / gsz; return true;
    }
};
typedef f32x4 Acc[2][2][4][2];

template <class Epi>
__device__ __forceinline__ void gemm_phase(LAS unsigned char* lds, const Gemm g, const StaticOrder& S, const Epi& E, const int tid) {
    const int wid = __builtin_amdgcn_readfirstlane(tid >> 6), lane = tid & 63, wr = wid >> 2, wc = wid & 3, fr = lane & 15, fq = lane >> 4;
    const int K = g.K, nt = K / BK, lda = g.lda;
    unsigned voffA[2], voffB[2];
#pragma unroll
    for (int i = 0; i < 2; ++i) { int R, C; stage_rc(tid * 16 + i * 8192, R, C); const int Rb = Epi::PERM ? ((R & ~31) + perm32(R & 31)) : R;
        voffA[i] = (unsigned)(R * lda + C) * 2u; voffB[i] = (unsigned)(Rb * K + C) * 2u; }
    const size_t kstep = (size_t)(BK * 2);
    const size_t hstepA = (size_t)HALF * lda * 2, hstepB = (size_t)HALF * K * 2;
    const size_t tstepA = 2 * hstepA, tstepB = 2 * hstepB;
    const unsigned ldsw = (unsigned)wid * 1024u;
    const int aoff = lds_byte(wr * 64 + fr, fq * 8), boff = lds_byte(wc * 32 + fr, fq * 8);
#define PG8_SA(b, h) (((b) * 2 + (h)) * HTB)
#define PG8_SB(b, h) ((4 + (b) * 2 + (h)) * HTB)
#define PG8_STAGE(bufoff, gbase, voff) do { _Pragma("unroll") for (int _i = 0; _i < 2; ++_i) \
        __builtin_amdgcn_global_load_lds((const unsigned*)((const char*)(gbase) + (voff)[_i]), (LAS unsigned*)(lds + (bufoff) + ldsw + _i * 8192), 16, 0, 0); } while (0)
#define PG8_LDA(dst, b, h) do { _Pragma("unroll") for (int m = 0; m < 4; ++m) _Pragma("unroll") for (int k = 0; k < 2; ++k) dst[m][k] = *(const LAS h16x8*)(lds + PG8_SA(b, h) + aoff + m * 2048 + k * 1024); } while (0)
#define PG8_LDB(dst, b, h) do { _Pragma("unroll") for (int n = 0; n < 2; ++n) _Pragma("unroll") for (int k = 0; k < 2; ++k) dst[n][k] = *(const LAS h16x8*)(lds + PG8_SB(b, h) + boff + n * 2048 + k * 1024); } while (0)
#define PG8_MMA(ai, bj, At, Bt) do { __builtin_amdgcn_s_setprio(1); _Pragma("unroll") for (int m = 0; m < 4; ++m) _Pragma("unroll") for (int n = 0; n < 2; ++n) _Pragma("unroll") for (int k = 0; k < 2; ++k) \
        acc[ai][bj][m][n] = __builtin_amdgcn_mfma_f32_16x16x32_f16(Bt[n][k], At[m][k], acc[ai][bj][m][n], 0, 0, 0); __builtin_amdgcn_s_setprio(0); } while (0)
#define PG8_WAIT_V(n) asm volatile("s_waitcnt vmcnt(" #n ")" ::: "memory")
#define PG8_WAIT_L(n) asm volatile("s_waitcnt lgkmcnt(" #n ")" ::: "memory")
#define PG8_BAR __builtin_amdgcn_s_barrier()
#define PG8_SCHED __builtin_amdgcn_sched_barrier(0)
    Unit cur, nxt; int ui = 0;
    if (!S.next(0, cur)) return;
    f32x4 acc[2][2][4][2];
#pragma unroll
    for (int a = 0; a < 2; ++a)
#pragma unroll
        for (int b = 0; b < 2; ++b)
#pragma unroll
            for (int m = 0; m < 4; ++m)
#pragma unroll
                for (int n = 0; n < 2; ++n) acc[a][b][m][n] = (f32x4){0.f, 0.f, 0.f, 0.f};
    h16x8 At[4][2], B0[2][2], B1[2][2];
    const char* cA = (const char*)g.A + (size_t)cur.pm * tstepA; const char* cB = (const char*)g.Bt + (size_t)cur.pn * tstepB;
    PG8_STAGE(PG8_SB(0, 0), cB, voffB); PG8_STAGE(PG8_SB(0, 1), cB + hstepB, voffB); PG8_STAGE(PG8_SA(0, 0), cA, voffA); PG8_STAGE(PG8_SA(0, 1), cA + hstepA, voffA);
    if (wr == 1) PG8_BAR;
    PG8_WAIT_V(2); PG8_BAR;
    PG8_STAGE(PG8_SB(1, 0), cB + kstep, voffB); PG8_STAGE(PG8_SA(1, 0), cA + kstep, voffA); PG8_STAGE(PG8_SB(1, 1), cB + hstepB + kstep, voffB);
    PG8_WAIT_V(6); PG8_BAR;
    for (;;) {
        const bool has_next = S.next(ui + 1, nxt);
        const char* nA = has_next ? (const char*)g.A + (size_t)nxt.pm * tstepA : cA; const char* nB = has_next ? (const char*)g.Bt + (size_t)nxt.pn * tstepB : cB;
        for (int t = 0; t < nt; t += 2) {
            const bool last = (t == nt - 2);
            const char* a1 = cA + (size_t)(t + 1) * kstep;
            const char* a2 = last ? nA : cA + (size_t)(t + 2) * kstep; const char* b2 = last ? nB : cB + (size_t)(t + 2) * kstep;
            const char* a3 = a2 + kstep; const char* b3 = b2 + kstep;
            PG8_LDB(B0, 0, 0); PG8_LDB(B1, 0, 1); PG8_SCHED; PG8_LDA(At, 0, 0); PG8_STAGE(PG8_SA(1, 1), a1 + hstepA, voffA);
            PG8_WAIT_V(8); PG8_WAIT_L(0); PG8_BAR; PG8_MMA(0, 0, At, B0); PG8_MMA(0, 1, At, B1); PG8_BAR; PG8_SCHED;
            PG8_LDA(At, 0, 1); PG8_STAGE(PG8_SB(0, 0), b2, voffB); PG8_STAGE(PG8_SB(0, 1), b2 + hstepB, voffB); PG8_STAGE(PG8_SA(0, 0), a2, voffA);
            PG8_WAIT_V(8); PG8_WAIT_L(0); PG8_BAR; PG8_MMA(1, 0, At, B0); PG8_MMA(1, 1, At, B1); PG8_BAR; PG8_SCHED;
            PG8_LDB(B0, 1, 0); PG8_LDB(B1, 1, 1); PG8_SCHED; PG8_LDA(At, 1, 0); PG8_STAGE(PG8_SA(0, 1), a2 + hstepA, voffA);
            PG8_WAIT_V(8); PG8_WAIT_L(0); PG8_BAR; PG8_MMA(0, 0, At, B0); PG8_MMA(0, 1, At, B1); PG8_BAR; PG8_SCHED;
            PG8_LDA(At, 1, 1); PG8_STAGE(PG8_SB(1, 0), b3, voffB); PG8_STAGE(PG8_SB(1, 1), b3 + hstepB, voffB); PG8_STAGE(PG8_SA(1, 0), a3, voffA);
            PG8_WAIT_V(8); PG8_WAIT_L(0); PG8_BAR; PG8_MMA(1, 0, At, B0); PG8_MMA(1, 1, At, B1); PG8_BAR; PG8_SCHED;
        }
        if (wr == 0) PG8_BAR;
        E(acc, cur, wr, wc, fr, fq);
        if (!has_next) break;
#pragma unroll
        for (int a = 0; a < 2; ++a)
#pragma unroll
            for (int b = 0; b < 2; ++b)
#pragma unroll
                for (int m = 0; m < 4; ++m)
#pragma unroll
                    for (int n = 0; n < 2; ++n) acc[a][b][m][n] = (f32x4){0.f, 0.f, 0.f, 0.f};
        cur = nxt; cA = nA; cB = nB; ++ui;
        if (wr == 1) PG8_BAR;
    }
    PG8_WAIT_V(0);
    PG8_BAR;
#undef PG8_SA
#undef PG8_SB
#undef PG8_STAGE
#undef PG8_LDA
#undef PG8_LDB
#undef PG8_MMA
#undef PG8_WAIT_V
#undef PG8_WAIT_L
#undef PG8_BAR
#undef PG8_SCHED
}


struct EpiSwiglu {
    static constexpr bool PERM = true;
    h16* O; const float* ss;
    __device__ __forceinline__ void operator()(const Acc& acc, const Unit& u, int wr, int wc, int fr, int fq) const {
        const int row0 = u.pm * BM + wr * 64 + fr, col0 = u.pn * 128 + wc * 32 + 8 * fq;
#pragma unroll
        for (int ai = 0; ai < 2; ++ai)
#pragma unroll
            for (int m = 0; m < 4; ++m) {
                const int row = row0 + ai * HALF + m * 16; const float rs = row_rstd(ss, row);
                float o[8];
#pragma unroll
                for (int n = 0; n < 2; ++n) {
                    const f32x4 g4 = acc[ai][0][m][n] * rs, u4 = acc[ai][1][m][n] * rs; const f32x4 x4 = g4 * (-1.4426950408889634f);
                    f32x4 e4; e4.x = __builtin_amdgcn_exp2f(x4.x); e4.y = __builtin_amdgcn_exp2f(x4.y); e4.z = __builtin_amdgcn_exp2f(x4.z); e4.w = __builtin_amdgcn_exp2f(x4.w);
                    const f32x4 d4 = e4 + 1.0f; f32x4 r4; r4.x = __builtin_amdgcn_rcpf(d4.x); r4.y = __builtin_amdgcn_rcpf(d4.y); r4.z = __builtin_amdgcn_rcpf(d4.z); r4.w = __builtin_amdgcn_rcpf(d4.w);
                    const f32x4 o4 = (g4 * u4) * r4; o[n * 4 + 0] = o4.x; o[n * 4 + 1] = o4.y; o[n * 4 + 2] = o4.z; o[n * 4 + 3] = o4.w; }
                u32x4 w; w.x = pk2h(o[0], o[1]); w.y = pk2h(o[2], o[3]); w.z = pk2h(o[4], o[5]); w.w = pk2h(o[6], o[7]);
                *(u32x4*)(O + (size_t)row * FF + col0) = w;
            }
    }
};
struct EpiResid {
    static constexpr bool PERM = false;
    const float* res_p; const float* res_s; float* out; h16* o16; float* ss; float alpha;
    __device__ __forceinline__ void operator()(const Acc& acc, const Unit& u, int wr, int wc, int fr, int fq) const {
        const int row0 = u.pm * BM + wr * 64 + fr, col0 = u.pn * BM + wc * 32 + 4 * fq;
        const float* res = (u.pm * BM < MP) ? res_p : res_s;
#pragma unroll
        for (int ai = 0; ai < 2; ++ai)
#pragma unroll
            for (int m = 0; m < 4; ++m) {
                const int row = row0 + ai * HALF + m * 16; const size_t off = (size_t)row * D + col0; float sq = 0.f;
#pragma unroll
                for (int bj = 0; bj < 2; ++bj)
#pragma unroll
                    for (int n = 0; n < 2; ++n) { const size_t o = off + bj * HALF + n * 16; const f32x4 r = *(const f32x4*)(res + o); const f32x4 v = r + acc[ai][bj][m][n] * alpha;
                        *(f32x4*)(out + o) = v; u32x2 w; w.x = pk2h(v.x, v.y); w.y = pk2h(v.z, v.w); *(u32x2*)(o16 + o) = w; sq += (v.x * v.x + v.y * v.y) + (v.z * v.z + v.w * v.w); }
                sq += __shfl_xor(sq, 16); sq += __shfl_xor(sq, 32);
                if (fq == 0) ss[(size_t)row * 16 + u.pn * 4 + wc] = sq;
                asm volatile("" ::: "memory");
            }
    }
};
struct EpiProj {
    static constexpr bool PERM = true;
    h16* mix; h16* kna; size_t bufstep; h16* lows; const float* ss;
    __device__ __forceinline__ void operator()(const Acc& acc, const Unit& u, int wr, int wc, int fr, int fq) const {
        const int pn = u.pn; h16* base; int ldc, c0; float sc = 1.f; int nbj = 2;
        if (pn < 2) { base = mix; ldc = 1024; c0 = pn * 256; sc = 0.125f; }
        else if (pn < 12) { base = kna + (size_t)((pn - 2) >> 1) * bufstep; ldc = 512; c0 = ((pn - 2) & 1) * 256; }
        else { base = lows; ldc = 384; c0 = (pn - 12) * 256; if (pn == 13) nbj = 1; }
        const int row0 = u.pm * BM + wr * 64 + fr, col0 = c0 + wc * 32 + 8 * fq;
#pragma unroll
        for (int ai = 0; ai < 2; ++ai)
#pragma unroll
            for (int m = 0; m < 4; ++m) {
                const int row = row0 + ai * HALF + m * 16; const float rs = row_rstd(ss, row) * sc;
#pragma unroll
                for (int bj = 0; bj < 2; ++bj) if (bj < nbj) {
                    const f32x4 v0 = acc[ai][bj][m][0] * rs, v1 = acc[ai][bj][m][1] * rs;
                    u32x4 w; w.x = pk2h(v0.x, v0.y); w.y = pk2h(v0.z, v0.w); w.z = pk2h(v1.x, v1.y); w.w = pk2h(v1.z, v1.w);
                    *(u32x4*)(base + (size_t)row * ldc + col0 + bj * HALF) = w; }
            }
    }
};
struct EpiPU {
    static constexpr bool PERM = true;
    h16* O;
    __device__ __forceinline__ void operator()(const Acc& acc, const Unit& u, int wr, int wc, int fr, int fq) const {
        const int row0 = u.pm * BM + wr * 64 + fr, col0 = u.pn * BM + wc * 32 + 8 * fq;
#pragma unroll
        for (int ai = 0; ai < 2; ++ai)
#pragma unroll
            for (int m = 0; m < 4; ++m) {
                const int row = row0 + ai * HALF + m * 16;
#pragma unroll
                for (int bj = 0; bj < 2; ++bj) {
                    const f32x4 v0 = acc[ai][bj][m][0], v1 = acc[ai][bj][m][1];
                    u32x4 w; w.x = pk2h(v0.x, v0.y); w.y = pk2h(v0.z, v0.w); w.z = pk2h(v1.x, v1.y); w.w = pk2h(v1.z, v1.w);
                    *(u32x4*)(O + (size_t)row * D + col0 + bj * HALF) = w; }
            }
    }
};
struct EpiPle {
    static constexpr bool PERM = false;
    float* out; h16* o16; float* ssw; const float* ssr; const h16* pu;
    __device__ __forceinline__ void operator()(const Acc& acc, const Unit& u, int wr, int wc, int fr, int fq) const {
        const int row0 = u.pm * BM + wr * 64 + fr, col0 = u.pn * BM + wc * 32 + 4 * fq;
#pragma unroll
        for (int ai = 0; ai < 2; ++ai)
#pragma unroll
            for (int m = 0; m < 4; ++m) {
                const int row = row0 + ai * HALF + m * 16; const size_t off = (size_t)row * D + col0; float sq = 0.f; const float rs = row_rstd(ssr, row);
#pragma unroll
                for (int bj = 0; bj < 2; ++bj)
#pragma unroll
                    for (int n = 0; n < 2; ++n) { const size_t o = off + bj * HALF + n * 16; const f32x4 r = *(const f32x4*)(out + o); const h16x4 p = *(const h16x4*)(pu + o);
                        const f32x4 a = acc[ai][bj][m][n] * rs; f32x4 v;
                        v.x = r.x + sigmoidf_(a.x) * (float)p.x; v.y = r.y + sigmoidf_(a.y) * (float)p.y; v.z = r.z + sigmoidf_(a.z) * (float)p.z; v.w = r.w + sigmoidf_(a.w) * (float)p.w;
                        *(f32x4*)(out + o) = v; u32x2 w; w.x = pk2h(v.x, v.y); w.y = pk2h(v.z, v.w); *(u32x2*)(o16 + o) = w; sq += (v.x * v.x + v.y * v.y) + (v.z * v.z + v.w * v.w); }
                sq += __shfl_xor(sq, 16); sq += __shfl_xor(sq, 32);
                if (fq == 0) ssw[(size_t)row * 16 + u.pn * 4 + wc] = sq;
                asm volatile("" ::: "memory");
            }
    }
};
}

__device__ __forceinline__ void convert_matrix(const float* W, int K, int N, const float* gamma, h16* WT, int mode, LAS float* scr, int gw, int NGW, int lane) {
    const int nblk = N / 32, nitems = (K / 64) * nblk;
    for (int item = gw; item < nitems; item += NGW) {
        const int kb = item / nblk, nb = item % nblk, k0 = 64 * kb, n0 = 32 * nb;
        const int drow0 = (mode == 0) ? n0 : ((n0 >> 7) * 256 + (n0 & 127) + (mode == 2 ? 128 : 0));
#pragma unroll 8
        for (int i = 0; i < 32; ++i) { const int kk = 2 * i + (lane >> 5); float v = W[(size_t)(k0 + kk) * N + n0 + (lane & 31)]; if (gamma) v *= gamma[k0 + kk]; scr[kk * 33 + (lane & 31)] = v; }
        asm volatile("s_waitcnt lgkmcnt(0)" ::: "memory");
        const int c = lane & 7;
#pragma unroll
        for (int j = 0; j < 4; ++j) { const int n = (lane >> 3) + 8 * j; const LAS float* s = scr + (8 * c) * 33 + n;
            u32x4 o; o.x = pk2h(s[0 * 33], s[1 * 33]); o.y = pk2h(s[2 * 33], s[3 * 33]); o.z = pk2h(s[4 * 33], s[5 * 33]); o.w = pk2h(s[6 * 33], s[7 * 33]);
            *(u32x4*)(WT + (size_t)(drow0 + n) * K + k0 + 8 * c) = o; }
        asm volatile("s_waitcnt lgkmcnt(0)" ::: "memory");
    }
}

__device__ __forceinline__ void phase_convert(const Args& a, int layer, LAS unsigned char* lds, int tid, int lane, int wave, int bid, int G) {
    LAS float* scr = (LAS float*)(lds + wave * 16384);
    const int gw = bid * NWAVES + wave, NGW = G * NWAVES;
    h16* W = (h16*)(a.ws + WS_W);
    const size_t l = (size_t)layer;
    convert_matrix(a.in[I_F1G] + l * D * FF, D, FF, a.in[I_F1N] + l * D, W + W_FFN1U, 1, scr, gw, NGW, lane);
    convert_matrix(a.in[I_F1U] + l * D * FF, D, FF, a.in[I_F1N] + l * D, W + W_FFN1U, 2, scr, gw, NGW, lane);
    convert_matrix(a.in[I_F1D] + l * FF * D, FF, D, nullptr, W + W_FFN1D, 0, scr, gw, NGW, lane);
    convert_matrix(a.in[I_WIN] + l * D * 3456, D, 3456, a.in[I_MIXN] + l * D, W + W_IN, 0, scr, gw, NGW, lane);
    convert_matrix(a.in[I_WOUT] + l * D * D, D, D, nullptr, W + W_OUT, 0, scr, gw, NGW, lane);
    convert_matrix(a.in[I_F2G] + l * D * FF, D, FF, a.in[I_F2N] + l * D, W + W_FFN2U, 1, scr, gw, NGW, lane);
    convert_matrix(a.in[I_F2U] + l * D * FF, D, FF, a.in[I_F2N] + l * D, W + W_FFN2U, 2, scr, gw, NGW, lane);
    convert_matrix(a.in[I_F2D] + l * FF * D, FF, D, nullptr, W + W_FFN2D, 0, scr, gw, NGW, lane);
    convert_matrix(a.in[I_PLEG] + l * D * D, D, D, a.in[I_PLEN] + l * D, W + W_GATE, 0, scr, gw, NGW, lane);
    convert_matrix(a.in[I_PLEU] + l * PLE * D, PLE, D, nullptr, W + W_UP, 0, scr, gw, NGW, lane);
    { u32x4* z = (u32x4*)(W + W_IN + (size_t)3456 * 1024); const int n16 = 128 * 1024 * 2 / 16;
      for (int i = bid * NTHREADS + tid; i < n16; i += G * NTHREADS) z[i] = (u32x4){0u, 0u, 0u, 0u}; }
    if (layer == 0) {
        unsigned char* ws = a.ws; h16* Hp = GB_H16B(0); h16* Hs = GB_H16B(1); float* ss = (float*)(a.ws + WS_SSB);
        for (int m = gw; m < M; m += NGW) {
            h16* H = (m < MP) ? Hp : Hs;
            const float* xr = (m < MP) ? a.in[I_XP] + (size_t)m * D : a.in[I_XS] + (size_t)(m - MP) * D;
            const f32x4* x4 = (const f32x4*)xr + lane; float s = 0.f;
            u32x2* o = (u32x2*)(H + (size_t)m * D) + lane;
#pragma unroll
            for (int j = 0; j < 4; ++j) { const f32x4 v = x4[64 * j]; s += (v.x * v.x + v.y * v.y) + (v.z * v.z + v.w * v.w); u32x2 w; w.x = pk2h(v.x, v.y); w.y = pk2h(v.z, v.w); o[64 * j] = w; }
            s = wave_sum(s);
            if (lane < 16) ss[(size_t)m * 16 + lane] = (lane == 0) ? s : 0.f;
        }
    }
}

__device__ __forceinline__ void convert_p(const Args& a, int layer, int g, int nb, int cb, int tid) {
    unsigned char* ws = a.ws; const int rows = g ? MS : MP, row0 = g ? MP : 0;
    u32x2* o = (u32x2*)(GB_P16(g) + (size_t)row0 * PLE);
    const f32x4* p = (const f32x4*)((g ? a.in[I_PS] + (size_t)layer * MS * PLE : a.in[I_PP] + (size_t)layer * MP * PLE));
    const int N4 = rows * PLE / 4;
    for (int i = cb * NTHREADS + tid; i < N4; i += nb * NTHREADS) { const f32x4 v = p[i]; u32x2 w; w.x = pk2h(v.x, v.y); w.y = pk2h(v.z, v.w); o[i] = w; }
}

constexpr int NA_PITCH = 144;
constexpr int NA_VOFF = 512 * NA_PITCH;
constexpr int NA_PP = 67;
constexpr int NA_BTOFF = 2 * 512 * NA_PITCH;
__device__ __forceinline__ void na_item(const Args& a, int layer, int item, LAS unsigned char* lds, int tid, int lane, int wave) {
    int tok0, i, rows;
    if (item < 1024) { tok0 = (item >> 6) * TP; i = item & 63; rows = 64; } else { const int it2 = item - 1024; tok0 = MP + (it2 >> 8) * TS; i = it2 & 255; rows = 256; }
    int rs = i - 4; rs = rs < 0 ? 0 : (rs > rows - 8 ? rows - 8 : rs);
    unsigned char* ws = a.ws; const int g = item < 1024 ? 0 : 1;
    h16* MIX = GB_MIX(g); const h16* KNA = GB_KNA(g); const h16* VNA = GB_VNA(g);
    const float* rpb = a.in[I_RPB] + (size_t)layer * 8 * 15 * 31;
    const int wtok0 = tok0 + rs * 64;
    const int j = lane, aw = wave;
    const int tokq = tok0 + i * 64 + j;
    int cs = j - 8; cs = cs < 0 ? 0 : (cs > 48 ? 48 : cs);
    const int l31 = lane & 31, half = lane >> 5;
    LAS float* bt = (LAS float*)(lds + NA_BTOFF) + wave * 128;
    bt[lane] = 0.f; bt[64 + lane] = 0.f;
    u32x4 kreg[8], vreg[8];
    const size_t kvoff = (size_t)(wtok0 + (tid >> 3)) * 512 + (tid & 7) * 8;
#pragma unroll
    for (int it = 0; it < 8; ++it) { kreg[it] = *(const u32x4*)(KNA + kvoff + (size_t)it * (64 * 512)); vreg[it] = *(const u32x4*)(VNA + kvoff + (size_t)it * (64 * 512)); }
#pragma unroll 1
    for (int h = 0; h < 8; ++h) {
#pragma unroll
        for (int it = 0; it < 8; ++it) { const int key = (tid >> 3) + 64 * it, ch = tid & 7;
            *(LAS u32x4*)(lds + key * NA_PITCH + ch * 16) = kreg[it]; *(LAS u32x4*)(lds + NA_VOFF + key * NA_PITCH + ch * 16) = vreg[it]; }
        h16x8 qf[2][4];
#pragma unroll
        for (int nt = 0; nt < 2; ++nt)
#pragma unroll
            for (int ks = 0; ks < 4; ++ks) qf[nt][ks] = *(const h16x8*)(MIX + (size_t)(tok0 + i * 64 + l31 + 32 * nt) * 1024 + h * 64 + 16 * ks + 8 * half);
        if (lane < 31) bt[48 + lane] = rpb[((size_t)h * 15 + (rs + aw - i + 7)) * 31 + lane];
        __syncthreads();
        if (h + 1 < 8) {
#pragma unroll
            for (int it = 0; it < 8; ++it) { kreg[it] = *(const u32x4*)(KNA + kvoff + (size_t)it * (64 * 512) + (h + 1) * 64); vreg[it] = *(const u32x4*)(VNA + kvoff + (size_t)it * (64 * 512) + (h + 1) * 64); }
        }
        f32x16 acc[2][2];
#pragma unroll
        for (int mt = 0; mt < 2; ++mt)
#pragma unroll
            for (int nt = 0; nt < 2; ++nt)
#pragma unroll
                for (int r = 0; r < 16; ++r) acc[mt][nt][r] = 0.f;
#pragma unroll
        for (int mt = 0; mt < 2; ++mt)
#pragma unroll
            for (int ks = 0; ks < 4; ++ks) {
                const h16x8 kf = *(const LAS h16x8*)(lds + (aw * 64 + 32 * mt + l31) * NA_PITCH + (16 * ks + 8 * half) * 2);
                acc[mt][0] = __builtin_amdgcn_mfma_f32_32x32x16_f16(kf, qf[0][ks], acc[mt][0], 0, 0, 0);
                acc[mt][1] = __builtin_amdgcn_mfma_f32_32x32x16_f16(kf, qf[1][ks], acc[mt][1], 0, 0, 0);
            }
        float mxq[2], lq[2];
#pragma unroll
        for (int nt = 0; nt < 2; ++nt) {
            const int qc = l31 + 32 * nt; int csq = qc - 8; csq = csq < 0 ? 0 : (csq > 48 ? 48 : csq);
            const int dlt = 4 * half - csq;
            const LAS float* bq = bt + (48 + 15 + 4 * half - qc - 32);
            float m = -3.0e38f;
#pragma unroll
            for (int mt = 0; mt < 2; ++mt)
#pragma unroll
                for (int r = 0; r < 16; ++r) { const int kr = (r & 3) + 8 * (r >> 2) + 32 * mt;
                    const float sv = acc[mt][nt][r] + bq[32 + kr]; const bool ok = (unsigned)(dlt + kr) < 16u; const float sm = ok ? sv : -1.0e30f; acc[mt][nt][r] = sm; m = fmaxf(m, sm); }
            { const auto sw = __builtin_amdgcn_permlane32_swap(__builtin_bit_cast(unsigned, m), __builtin_bit_cast(unsigned, m), false, false); const unsigned s0 = sw[0], s1 = sw[1]; m = fmaxf(__builtin_bit_cast(float, s0), __builtin_bit_cast(float, s1)); }
            float l = 0.f;
#pragma unroll
            for (int mt = 0; mt < 2; ++mt)
#pragma unroll
                for (int r = 0; r < 16; ++r) { const float p = __expf(acc[mt][nt][r] - m); acc[mt][nt][r] = p; l += p; }
            { const auto sw = __builtin_amdgcn_permlane32_swap(__builtin_bit_cast(unsigned, l), __builtin_bit_cast(unsigned, l), false, false); const unsigned s0 = sw[0], s1 = sw[1]; l = __builtin_bit_cast(float, s0) + __builtin_bit_cast(float, s1); }
            mxq[nt] = m; lq[nt] = l;
        }
        h16x8 pf[2][2][2];
#pragma unroll
        for (int kt = 0; kt < 2; ++kt)
#pragma unroll
            for (int nt = 0; nt < 2; ++nt)
#pragma unroll
                for (int sx = 0; sx < 2; ++sx)
#pragma unroll
                    for (int e = 0; e < 8; ++e) pf[kt][nt][sx][e] = (h16)acc[kt][nt][8 * sx + e];
        f32x16 o[2][2];
#pragma unroll
        for (int dm = 0; dm < 2; ++dm)
#pragma unroll
            for (int nt = 0; nt < 2; ++nt)
#pragma unroll
                for (int r = 0; r < 16; ++r) o[dm][nt][r] = 0.f;
#pragma unroll
        for (int dm = 0; dm < 2; ++dm)
#pragma unroll
            for (int kt = 0; kt < 2; ++kt)
#pragma unroll
                for (int sx = 0; sx < 2; ++sx) {
                    h16x8 vf;
                    const LAS unsigned char* vb = lds + NA_VOFF + (aw * 64 + 32 * kt + 16 * sx + 4 * half) * NA_PITCH + (l31 + 32 * dm) * 2;
#pragma unroll
                    for (int e = 0; e < 8; ++e) vf[e] = *(const LAS h16*)(vb + ((e & 3) + 8 * (e >> 2)) * NA_PITCH);
                    o[dm][0] = __builtin_amdgcn_mfma_f32_32x32x16_f16(vf, pf[kt][0][sx], o[dm][0], 0, 0, 0);
                    o[dm][1] = __builtin_amdgcn_mfma_f32_32x32x16_f16(vf, pf[kt][1][sx], o[dm][1], 0, 0, 0);
                }
        __syncthreads();
#pragma unroll
        for (int nt = 0; nt < 2; ++nt) {
            LAS float* part = (LAS float*)lds + (size_t)(aw * 64 + l31 + 32 * nt) * NA_PP;
#pragma unroll
            for (int dm = 0; dm < 2; ++dm)
#pragma unroll
                for (int r = 0; r < 16; ++r) part[(r & 3) + 8 * (r >> 2) + 4 * half + 32 * dm] = o[dm][nt][r];
            if (half == 0) { part[64] = mxq[nt]; part[65] = lq[nt]; }
        }
        __syncthreads();
        {
            const int jq = tid & 63, e8 = tid >> 6;
            float mw[8], M_ = -3.0e38f;
#pragma unroll
            for (int w = 0; w < 8; ++w) { mw[w] = ((const LAS float*)lds)[(size_t)(w * 64 + jq) * NA_PP + 64]; M_ = fmaxf(M_, mw[w]); }
            float L = 0.f, ov[8];
#pragma unroll
            for (int e = 0; e < 8; ++e) ov[e] = 0.f;
#pragma unroll
            for (int w = 0; w < 8; ++w) { const float f = __expf(mw[w] - M_); const LAS float* pw = (const LAS float*)lds + (size_t)(w * 64 + jq) * NA_PP; L += f * pw[65];
#pragma unroll
                for (int e = 0; e < 8; ++e) ov[e] += f * pw[e8 * 8 + e]; }
            const float inv = 1.0f / L;
            u32x4 w4; w4.x = pk2h(ov[0] * inv, ov[1] * inv); w4.y = pk2h(ov[2] * inv, ov[3] * inv); w4.z = pk2h(ov[4] * inv, ov[5] * inv); w4.w = pk2h(ov[6] * inv, ov[7] * inv);
            *(u32x4*)(MIX + (size_t)(tok0 + i * 64 + jq) * 1024 + h * 64 + e8 * 8) = w4;
        }
        __syncthreads();
    }
}

__device__ __forceinline__ float shiftmix(const h16* base, size_t stride, int t, int T, float mu) {
    const float c = (float)base[0];
    const float p = (t > 0) ? (float)*(base - stride) : 0.f;
    const float n = (t < T - 1) ? (float)*(base + stride) : 0.f;
    return c + mu * (0.5f * (p + n) - c);
}
constexpr int SC_CH = 32;
constexpr int SC_OPB = SC_CH * 6 * 64 * 4;
constexpr int SC_YOFF = 2 * SC_OPB;
constexpr int SC_YB = SC_CH * 64 * 4;
constexpr int SC_XOFF = SC_YOFF + 2 * SC_YB;
constexpr int SC_ZOFF = SC_XOFF + 8192;
static_assert(SC_ZOFF + 4 * 4096 <= LDS_BYTES, "scan LDS");
__device__ __forceinline__ float wave_sum_fast(float v) {
    v = row16_sum(v);
    { const auto r = __builtin_amdgcn_permlane16_swap(__builtin_bit_cast(unsigned, v), __builtin_bit_cast(unsigned, v), false, false);
      const unsigned r0 = r[0], r1 = r[1]; v = __builtin_bit_cast(float, r0) + __builtin_bit_cast(float, r1); }
    { const auto r = __builtin_amdgcn_permlane32_swap(__builtin_bit_cast(unsigned, v), __builtin_bit_cast(unsigned, v), false, false);
      const unsigned r0 = r[0], r1 = r[1]; v = __builtin_bit_cast(float, r0) + __builtin_bit_cast(float, r1); }
    return v;
}
__device__ __forceinline__ float mix3(h16 p, h16 c, h16 n, float mu) { const float cf = (float)c; return cf + mu * (0.5f * ((float)p + (float)n) - cf); }
struct ScanWin { float r[10], k[10], v[10], wl[10], al[10]; };
struct ScanWinRaw { h16 r[10], k[10], v[10], wl[10], al[10]; };
__device__ __forceinline__ float mix3f(float p, float c, float n, float mu) { return c + mu * (0.5f * (p + n) - c); }
template <int R>
__device__ __forceinline__ void scan_flush(LAS unsigned char* lds, int cf, int pw, int lane, int d, int T, int tok0, int h, int rowbase, h16* Yf, h16* Yb) {
    const LAS float* yb = (const LAS float*)(lds + SC_YOFF + (cf & 1) * SC_YB);
    const int s = pw * 8 + (lane >> 3); const int g = cf * SC_CH + s; const int t = d ? (T - 1 - g) : g;
    if (R == 4) {
        const int r8 = (lane & 7) * 8;
        const f32x4 y0 = *(const LAS f32x4*)(yb + s * 64 + r8), y1 = *(const LAS f32x4*)(yb + s * 64 + r8 + 4);
        u32x4 w4; w4.x = pk2h(y0.x, y0.y); w4.y = pk2h(y0.z, y0.w); w4.z = pk2h(y1.x, y1.y); w4.w = pk2h(y1.z, y1.w);
        if (d == 0) *(u32x4*)(Yf + (size_t)(tok0 + t) * 1024 + 512 + h * 64 + r8) = w4; else *(u32x4*)(Yb + (size_t)(tok0 + t) * 512 + h * 64 + r8) = w4;
    } else {
        const int r4 = (lane & 7) * 4;
        const f32x4 y0 = *(const LAS f32x4*)(yb + s * 32 + r4);
        u32x2 w2; w2.x = pk2h(y0.x, y0.y); w2.y = pk2h(y0.z, y0.w);
        if (d == 0) *(u32x2*)(Yf + (size_t)(tok0 + t) * 1024 + 512 + h * 64 + rowbase + r4) = w2; else *(u32x2*)(Yb + (size_t)(tok0 + t) * 512 + h * 64 + rowbase + r4) = w2;
    }
}
template <int R>
__device__ __forceinline__ void scan_item(const Args& a, int layer, int q, int rowhalf, LAS unsigned char* lds, int tid, int lane, int wave) {
    int tok0, T, h, d;
    if (q < 32) { tok0 = MP + (q >> 4) * TS; T = TS; h = (q >> 1) & 7; d = q & 1; } else { const int q2 = q - 32; tok0 = (q2 >> 4) * TP; T = TP; h = (q2 >> 1) & 7; d = q2 & 1; }
    const int nch = T / SC_CH, rowbase = rowhalf * 16 * R;
    unsigned char* ws = a.ws; const int g = q < 32 ? 1 : 0;
    const h16* RR = GB_RR(g); const h16* RK = GB_RK(g); const h16* RV = GB_RV(g); const h16* LOWS = GB_LOWS(g);
    h16* Yf = GB_MIX(g); h16* Yb = GB_YB(g); float* BSC = GB_BSC(g);
    const size_t l = (size_t)layer;
    if (wave >= 4) {
        const int pw = wave - 4, j = lane, col = h * 64 + j;
        const float* mu = a.in[I_MU] + l * 1920;
        const float mu_r = mu[col], mu_k = mu[512 + col], mu_v = mu[1024 + col], mu_wl = mu[1536 + d * 64 + j], mu_al = mu[1536 + 128 + d * 64 + j];
        const float k_k = a.in[I_KK][l * 512 + col], k_a = a.in[I_KA][l * 512 + col], r_k = a.in[I_RK][l * 512 + col];
        const float w0 = a.in[I_W0][(l * 2 + d) * 512 + col], a0 = a.in[I_A0][(l * 2 + d) * 512 + col];
        h16x8 bw[4][2], ba[4][2];
        { const int n = lane & 15, kg = lane >> 4;
          const float* wu = a.in[I_WUP] + ((l * 2 + d) * 64 + 8 * kg) * 512 + h * 64 + n; const float* au = a.in[I_AUP] + ((l * 2 + d) * 64 + 8 * kg) * 512 + h * 64 + n;
#pragma unroll
          for (int ks = 0; ks < 2; ++ks) {
#pragma unroll
              for (int e = 0; e < 8; ++e) {
                  const float w_0 = wu[0], w_1 = wu[16], w_2 = wu[32], w_3 = wu[48], a_0 = au[0], a_1 = au[16], a_2 = au[32], a_3 = au[48];
                  wu += 512; au += 512; asm volatile("" : "+v"(wu), "+v"(au));
                  bw[0][ks][e] = (h16)w_0; bw[1][ks][e] = (h16)w_1; bw[2][ks][e] = (h16)w_2; bw[3][ks][e] = (h16)w_3;
                  ba[0][ks][e] = (h16)a_0; ba[1][ks][e] = (h16)a_1; ba[2][ks][e] = (h16)a_2; ba[3][ks][e] = (h16)a_3; }
              wu += 24 * 512; au += 24 * 512; asm volatile("" : "+v"(wu), "+v"(au)); } }
        LAS float* zl = (LAS float*)(lds + SC_ZOFF + pw * 4096);
        LAS unsigned char* xsb = lds + SC_XOFF + pw * 2048;
        ScanWin cur; ScanWinRaw nxt;
#define SCAN_LOAD_RAW(cp_) do { const int g0_ = (cp_) * SC_CH + pw * 8; \
            _Pragma("unroll") for (int w = 0; w < 10; ++w) { int tt = d ? (T - 1 - g0_) + 1 - w : g0_ - 1 + w; tt = tt < 0 ? 0 : (tt > T - 1 ? T - 1 : tt); const size_t tok = (size_t)(tok0 + tt); \
                nxt.r[w] = RR[tok * 512 + col]; nxt.k[w] = RK[tok * 512 + col]; nxt.v[w] = RV[tok * 512 + col]; nxt.wl[w] = LOWS[tok * 384 + d * 64 + j]; nxt.al[w] = LOWS[tok * 384 + 128 + d * 64 + j]; } } while (0)
#define SCAN_UNPACK(cp_) do { const int g0_ = (cp_) * SC_CH + pw * 8; \
            _Pragma("unroll") for (int w = 0; w < 10; ++w) { const int tt = d ? (T - 1 - g0_) + 1 - w : g0_ - 1 + w; const bool ok = (tt >= 0) && (tt < T); \
                cur.r[w] = ok ? (float)nxt.r[w] : 0.f; cur.k[w] = ok ? (float)nxt.k[w] : 0.f; cur.v[w] = ok ? (float)nxt.v[w] : 0.f; cur.wl[w] = ok ? (float)nxt.wl[w] : 0.f; cur.al[w] = ok ? (float)nxt.al[w] : 0.f; } } while (0)
        SCAN_LOAD_RAW(0); SCAN_UNPACK(0);
        for (int c = -1; c < nch; ++c) {
            if (c >= 1) scan_flush<R>(lds, c - 1, pw, lane, d, T, tok0, h, rowbase, Yf, Yb);
            if (c + 1 < nch) {
                const int cp = c + 1; LAS float* op = (LAS float*)(lds + (cp & 1) * SC_OPB);
                if (c + 2 < nch) SCAN_LOAD_RAW(c + 2);
                float bsv = 0.f;
#pragma unroll
                for (int s8 = 0; s8 < 8; ++s8) {
                    const float wl = mix3f(cur.wl[s8], cur.wl[s8 + 1], cur.wl[s8 + 2], mu_wl);
                    const float al = mix3f(cur.al[s8], cur.al[s8 + 1], cur.al[s8 + 2], mu_al);
                    const float e2 = __expf(2.0f * wl); const float th = 1.0f - 2.0f * __builtin_amdgcn_rcpf(e2 + 1.0f);
                    LAS h16* xs = (LAS h16*)(xsb + s8 * 256);
                    xs[j] = (h16)th; xs[64 + j] = (h16)al;
                }
                {
                    const LAS unsigned char* xr = xsb + (lane & 7) * 256 + (lane >> 4) * 16;
                    const h16x8 xw0 = *(const LAS h16x8a*)(xr), xw1 = *(const LAS h16x8a*)(xr + 64), xa0 = *(const LAS h16x8a*)(xr + 128), xa1 = *(const LAS h16x8a*)(xr + 192);
                    f32x4 accw[4], acca[4];
#pragma unroll
                    for (int nt = 0; nt < 4; ++nt) {
                        accw[nt] = __builtin_amdgcn_mfma_f32_16x16x32_f16(xw0, bw[nt][0], (f32x4){0.f, 0.f, 0.f, 0.f}, 0, 0, 0);
                        accw[nt] = __builtin_amdgcn_mfma_f32_16x16x32_f16(xw1, bw[nt][1], accw[nt], 0, 0, 0);
                        acca[nt] = __builtin_amdgcn_mfma_f32_16x16x32_f16(xa0, ba[nt][0], (f32x4){0.f, 0.f, 0.f, 0.f}, 0, 0, 0);
                        acca[nt] = __builtin_amdgcn_mfma_f32_16x16x32_f16(xa1, ba[nt][1], acca[nt], 0, 0, 0); }
                    if (lane < 32) {
                        LAS float* zw = zl + (4 * (lane >> 4)) * 64 + (lane & 15);
#pragma unroll
                        for (int nt = 0; nt < 4; ++nt)
#pragma unroll
                            for (int r = 0; r < 4; ++r) { zw[r * 64 + 16 * nt] = accw[nt][r]; zw[512 + r * 64 + 16 * nt] = acca[nt][r]; }
                    }
                }
#pragma unroll
                for (int s8 = 0; s8 < 8; ++s8) {
                    const int s = pw * 8 + s8; const int g = cp * SC_CH + s; const int t = d ? (T - 1 - g) : g; const size_t tok = (size_t)(tok0 + t);
                    const float rr = mix3f(cur.r[s8], cur.r[s8 + 1], cur.r[s8 + 2], mu_r);
                    const float kk0 = mix3f(cur.k[s8], cur.k[s8 + 1], cur.k[s8 + 2], mu_k);
                    const float vv = mix3f(cur.v[s8], cur.v[s8 + 1], cur.v[s8 + 2], mu_v);
                    const float z = w0 + zl[s8 * 64 + j], az = a0 + zl[512 + s8 * 64 + j];
                    const float wdec = __expf(-0.606531f * sigmoidf_(z)); const float av = sigmoidf_(az);
                    float kk = kk0 * k_k; const float n2 = wave_sum_fast(kk * kk); kk = kk * __builtin_amdgcn_rsqf(fmaxf(n2, 1e-24f));
                    const float kd = kk0 * (1.0f + (av - 1.0f) * k_a); const float bb = kk * av;
                    const float bs = wave_sum_fast(rr * kd * r_k);
                    bsv = (lane == s8) ? bs : bsv;
                    LAS float* o = op + s * 384 + j;
                    o[0] = -kk; o[64] = wdec; o[128] = bb; o[192] = kd; o[256] = rr; o[320] = vv;
                }
                if (lane < 8 && rowhalf == 0) { const int gs = cp * SC_CH + pw * 8 + lane; const int t = d ? (T - 1 - gs) : gs; BSC[((size_t)(tok0 + t) * 8 + h) * 2 + d] = bsv; }
                if (c + 2 < nch) SCAN_UNPACK(c + 2);
            }
            __syncthreads();
        }
        scan_flush<R>(lds, nch - 1, pw, lane, d, T, tok0, h, rowbase, Yf, Yb);
#undef SCAN_LOAD_RAW
#undef SCAN_UNPACK
    } else {
        constexpr int RL = R / 2;
        const int ri = lane >> 3, ci = lane & 7;
        const int yrow = wave * 8 * RL + ri * RL, vrow = rowbase + yrow;
        f32x2 S[RL][4];
#pragma unroll
        for (int i = 0; i < RL; ++i)
#pragma unroll
            for (int c2 = 0; c2 < 4; ++c2) S[i][c2] = (f32x2){0.f, 0.f};
        typedef float vecR __attribute__((ext_vector_type(RL)));
        __syncthreads();
        for (int c = 0; c < nch; ++c) {
            const LAS f32x4* op = (const LAS f32x4*)(lds + (c & 1) * SC_OPB);
            LAS float* yb = (LAS float*)(lds + SC_YOFF + (c & 1) * SC_YB);
            f32x4 a0 = op[2 * ci], a1 = op[2 * ci + 1], w0 = op[16 + 2 * ci], w1 = op[17 + 2 * ci], b0 = op[32 + 2 * ci], b1 = op[33 + 2 * ci];
            f32x4 k0 = op[48 + 2 * ci], k1 = op[49 + 2 * ci], r0 = op[64 + 2 * ci], r1 = op[65 + 2 * ci]; vecR v4 = *(const LAS vecR*)((const LAS float*)op + 320 + vrow);
#pragma unroll 4
            for (int s = 0; s < SC_CH; ++s) {
                const LAS f32x4* on = op + (s + 1) * 96;
                const f32x4 na0 = on[2 * ci], na1 = on[2 * ci + 1], nw0 = on[16 + 2 * ci], nw1 = on[17 + 2 * ci], nb0 = on[32 + 2 * ci], nb1 = on[33 + 2 * ci];
                const f32x4 nk0 = on[48 + 2 * ci], nk1 = on[49 + 2 * ci], nr0 = on[64 + 2 * ci], nr1 = on[65 + 2 * ci]; const vecR nv4 = *(const LAS vecR*)((const LAS float*)on + 320 + vrow);
                const f32x2 av[4] = {{a0.x, a0.y}, {a0.z, a0.w}, {a1.x, a1.y}, {a1.z, a1.w}}, wv[4] = {{w0.x, w0.y}, {w0.z, w0.w}, {w1.x, w1.y}, {w1.z, w1.w}};
                const f32x2 bv[4] = {{b0.x, b0.y}, {b0.z, b0.w}, {b1.x, b1.y}, {b1.z, b1.w}}, kv[4] = {{k0.x, k0.y}, {k0.z, k0.w}, {k1.x, k1.y}, {k1.z, k1.w}};
                const f32x2 rv[4] = {{r0.x, r0.y}, {r0.z, r0.w}, {r1.x, r1.y}, {r1.z, r1.w}};
                float sa[RL];
#pragma unroll
                for (int i = 0; i < RL; ++i) { f32x2 p = S[i][0] * av[0]; p = S[i][1] * av[1] + p; p = S[i][2] * av[2] + p; p = S[i][3] * av[3] + p;
                    float t = p.x + p.y; t += dpp_f<0xB1>(t); t += dpp_f<0x4E>(t); t += dpp_f<0x141>(t); sa[i] = t; }
                vecR y;
#pragma unroll
                for (int i = 0; i < RL; ++i) { const f32x2 sa2 = {sa[i], sa[i]}, v2 = {v4[i], v4[i]};
#pragma unroll
                    for (int c2 = 0; c2 < 4; ++c2) S[i][c2] = S[i][c2] * wv[c2] + sa2 * bv[c2] + v2 * kv[c2];
                    f32x2 p = S[i][0] * rv[0]; p = S[i][1] * rv[1] + p; p = S[i][2] * rv[2] + p; p = S[i][3] * rv[3] + p;
                    float t = p.x + p.y; t += dpp_f<0xB1>(t); t += dpp_f<0x4E>(t); t += dpp_f<0x141>(t); y[i] = t; }
                if (ci == 0) *(LAS vecR*)(yb + s * (32 * RL) + yrow) = y;
                a0 = na0; a1 = na1; w0 = nw0; w1 = nw1; b0 = nb0; b1 = nb1; k0 = nk0; k1 = nk1; r0 = nr0; r1 = nr1; v4 = nv4;
            }
            __syncthreads();
        }
    }
}

__device__ __forceinline__ void rwpost_tile(const Args& a, int layer, int tile, LAS unsigned char* lds, int tid, int lane, int wave, const h16x8 (&bg)[4][4]) {
    const size_t l = (size_t)layer; const int h = wave, n16 = lane & 15, g4 = lane >> 4;
    const int m0 = tile * 64; int tok0s, T; if (m0 < MP) { T = TP; tok0s = (m0 / TP) * TP; } else { T = TS; tok0s = MP + ((m0 - MP) / TS) * TS; }
    unsigned char* ws = a.ws; const int g = m0 < MP ? 0 : 1;
    const h16* LOWS = GB_LOWS(g); const h16* RV = GB_RV(g); h16* MIX = GB_MIX(g); const h16* Yb = GB_YB(g); const float* BSC = GB_BSC(g);
    const float* mu = a.in[I_MU] + l * 1920;
    LAS h16* G = (LAS h16*)lds;
    { const int c = tid & 127; const float mug = mu[1536 + 256 + c];
#pragma unroll 4
      for (int e = tid; e < 64 * 128; e += NTHREADS) { const int tk = e >> 7; const int m = m0 + tk; const int t = m - tok0s;
        const float gl = shiftmix(LOWS + (size_t)m * 384 + 256 + c, 384, t, T, mug); G[e] = (h16)sigmoidf_(gl); } }
    float muv[4], lw[4], lb[4];
#pragma unroll
    for (int nt = 0; nt < 4; ++nt) { const int col = wave * 64 + 16 * nt + n16; muv[nt] = mu[1024 + col]; lw[nt] = a.in[I_LNW][l * 512 + col]; lb[nt] = a.in[I_LNB][l * 512 + col]; }
    __syncthreads();
#pragma unroll 1
    for (int mt = 0; mt < 4; ++mt) {
        const int tk0 = 16 * mt + 4 * g4;
        h16 ym[4][4], yb[4][4], rv[6][4]; float b0[4], b1[4];
#pragma unroll
        for (int w = 0; w < 6; ++w) { const int m = m0 + tk0 - 1 + w; const int t = m - tok0s; const bool ok = (t >= 0) && (t < T);
#pragma unroll
            for (int nt = 0; nt < 4; ++nt) { const h16 v = RV[(size_t)(ok ? m : m0) * 512 + wave * 64 + 16 * nt + n16]; rv[w][nt] = ok ? v : (h16)0.f; } }
#pragma unroll
        for (int r = 0; r < 4; ++r) { const size_t m = (size_t)(m0 + tk0 + r); b0[r] = BSC[(m * 8 + h) * 2]; b1[r] = BSC[(m * 8 + h) * 2 + 1];
#pragma unroll
            for (int nt = 0; nt < 4; ++nt) { const int col = wave * 64 + 16 * nt + n16; ym[r][nt] = MIX[m * 1024 + 512 + col]; yb[r][nt] = Yb[m * 512 + col]; } }
        f32x4 acc[4];
#pragma unroll
        for (int nt = 0; nt < 4; ++nt) acc[nt] = (f32x4){0.f, 0.f, 0.f, 0.f};
#pragma unroll
        for (int ks = 0; ks < 4; ++ks) {
            const h16x8 af = *(const LAS h16x8a*)((const LAS unsigned char*)G + (16 * mt + n16) * 256 + (32 * ks + 8 * g4) * 2);
#pragma unroll
            for (int nt = 0; nt < 4; ++nt) acc[nt] = __builtin_amdgcn_mfma_f32_16x16x32_f16(af, bg[nt][ks], acc[nt], 0, 0, 0);
        }
#pragma unroll
        for (int r = 0; r < 4; ++r) {
            const size_t m = (size_t)(m0 + tk0 + r);
            float wkv[4]; float sm = 0.f;
#pragma unroll
            for (int nt = 0; nt < 4; ++nt) { wkv[nt] = (float)ym[r][nt] + (float)yb[r][nt]; sm += wkv[nt]; }
            const float mean = row16_sum(sm) * (1.0f / 64.0f); float sq = 0.f;
#pragma unroll
            for (int nt = 0; nt < 4; ++nt) { wkv[nt] -= mean; sq += wkv[nt] * wkv[nt]; }
            const float rstd = __builtin_amdgcn_rsqf(row16_sum(sq) * (1.0f / 64.0f) + 64e-5f); const float bsum = b0[r] + b1[r];
#pragma unroll
            for (int nt = 0; nt < 4; ++nt) { const float yn = wkv[nt] * rstd * lw[nt] + lb[nt]; const float vv = mix3(rv[r][nt], rv[r + 1][nt], rv[r + 2][nt], muv[nt]);
                MIX[m * 1024 + 512 + wave * 64 + 16 * nt + n16] = (h16)((yn + bsum * vv) * acc[nt][r]); }
        }
    }
    __syncthreads();
}

#define STAGE_ARGS const Args& args, int layer, int g, int nb, int cb, LAS unsigned char* lds
#define FRESH_TID int tid = threadIdx.x; asm volatile("" : "+v"(tid)); const int lane = tid & 63, wave = __builtin_amdgcn_readfirstlane(tid >> 6); (void)lane; (void)wave;
__device__ __forceinline__ int g_rows(int g) { return g ? MS : MP; }
__device__ __forceinline__ int g_pm0(int g) { return g ? MP / 256 : 0; }
template <class Epi> __device__ __forceinline__ void run_gemm(LAS unsigned char* lds, const h16* A, int lda, const h16* Bt, int N, int K, int g, int nb, int cb, const Epi& E, int tid) {
    pg8::Gemm gm{A, Bt, g_rows(g), N, K, lda}; pg8::StaticOrder S; S.init(g_rows(g), N, nb, cb, g_pm0(g)); pg8::gemm_phase(lds, gm, S, E, tid);
}
__device__ __forceinline__ void st_ffn_up(STAGE_ARGS, int which) {
    FRESH_TID unsigned char* ws = args.ws; const h16* W = (const h16*)(ws + WS_W);
    pg8::EpiSwiglu E{GB_ACT(g), (const float*)(ws + (which ? WS_SSA : WS_SSB))};
    run_gemm(lds, which ? GB_H16(g) : GB_H16B(g), D, W + (which ? W_FFN2U : W_FFN1U), 2 * FF, D, g, nb, cb, E, tid);
}
__device__ __forceinline__ void st_ffn_down(STAGE_ARGS, int which) {
    FRESH_TID unsigned char* ws = args.ws; const h16* W = (const h16*)(ws + WS_W); float* out = args.out;
    const bool first = (which == 0 && layer == 0);
    const float* rp = first ? args.in[I_XP] : (const float*)out; const float* rsm = first ? args.in[I_XS] - (size_t)MP * D : (const float*)out;
    pg8::EpiResid E{rp, rsm, out, GB_H16(g), (float*)(ws + WS_SSA), 0.5f};
    run_gemm(lds, GB_ACT(g), FF, W + (which ? W_FFN2D : W_FFN1D), D, FF, g, nb, cb, E, tid);
}
__device__ __forceinline__ void st_win(STAGE_ARGS) {
    FRESH_TID unsigned char* ws = args.ws; const h16* W = (const h16*)(ws + WS_W);
    pg8::EpiProj E{GB_MIX(g), GB_KNA(g), (size_t)512 * g_rows(g), GB_LOWS(g), (const float*)(ws + WS_SSA)};
    run_gemm(lds, GB_H16(g), D, W + W_IN, NPROJ, D, g, nb, cb, E, tid);
}
__device__ __forceinline__ void st_wout(STAGE_ARGS) {
    FRESH_TID unsigned char* ws = args.ws; const h16* W = (const h16*)(ws + WS_W); float* out = args.out;
    pg8::EpiResid E{out, out, out, GB_H16(g), (float*)(ws + WS_SSA), 1.0f};
    run_gemm(lds, GB_MIX(g), D, W + W_OUT, D, D, g, nb, cb, E, tid);
}
__device__ __forceinline__ void st_pu(STAGE_ARGS) {
    FRESH_TID unsigned char* ws = args.ws; const h16* W = (const h16*)(ws + WS_W);
    int kpu = PLE; asm volatile("" : "+s"(kpu));
    pg8::EpiPU E{GB_PU(g)};
    run_gemm(lds, GB_P16(g), kpu, W + W_UP, D, kpu, g, nb, cb, E, tid);
}
__device__ __forceinline__ void st_ple(STAGE_ARGS) {
    FRESH_TID unsigned char* ws = args.ws; const h16* W = (const h16*)(ws + WS_W); float* out = args.out;
    pg8::EpiPle E{out, GB_H16B(g), (float*)(ws + WS_SSB), (const float*)(ws + WS_SSA), GB_PU(g)};
    run_gemm(lds, GB_H16(g), D, W + W_GATE, D, D, g, nb, cb, E, tid);
}
__device__ __forceinline__ void st_rwpost(STAGE_ARGS) {
    FRESH_TID const int t0 = g ? MP / 64 : 0, nt_ = g_rows(g) / 64;
    h16x8 bg[4][4];
    { const float* gu = args.in[I_GUP] + (size_t)layer * 128 * 512 + (size_t)(8 * (lane >> 4)) * 512 + wave * 64 + (lane & 15);
#pragma unroll
      for (int ks = 0; ks < 4; ++ks) {
#pragma unroll
          for (int e = 0; e < 8; ++e) { const float g_0 = gu[0], g_1 = gu[16], g_2 = gu[32], g_3 = gu[48]; gu += 512; asm volatile("" : "+v"(gu));
              bg[0][ks][e] = (h16)g_0; bg[1][ks][e] = (h16)g_1; bg[2][ks][e] = (h16)g_2; bg[3][ks][e] = (h16)g_3; }
          gu += 24 * 512; asm volatile("" : "+v"(gu)); } }
    for (int tile = cb; tile < nt_; tile += nb) rwpost_tile(args, layer, t0 + tile, lds, tid, lane, wave, bg);
}
__device__ __forceinline__ void st_convp(STAGE_ARGS) { FRESH_TID convert_p(args, layer, g, nb, cb, tid); }

__device__ __forceinline__ void sub_sync(unsigned* ctr, unsigned target) {
    asm volatile("s_waitcnt vmcnt(0) lgkmcnt(0)" ::: "memory");
    __syncthreads();
    if (threadIdx.x == 0) {
        __builtin_amdgcn_fence(__ATOMIC_RELEASE, "agent"); asm volatile("s_waitcnt vmcnt(0)" ::: "memory");
        __hip_atomic_fetch_add(ctr, 1u, __ATOMIC_RELAXED, __HIP_MEMORY_SCOPE_AGENT);
        while (__hip_atomic_load(ctr, __ATOMIC_RELAXED, __HIP_MEMORY_SCOPE_AGENT) < target) __builtin_amdgcn_s_sleep(2);
    }
    __syncthreads();
    __builtin_amdgcn_fence(__ATOMIC_ACQUIRE, "agent"); asm volatile("s_waitcnt vmcnt(0)" ::: "memory");
}

constexpr int NSB = 32;
__global__ void __launch_bounds__(NTHREADS, 2) fwd_megakernel(Args args) {
    extern __shared__ __attribute__((aligned(16))) unsigned char lds_raw[];
    LAS unsigned char* lds = (LAS unsigned char*)lds_raw;
    cg::grid_group grid = cg::this_grid();
    const int bid = blockIdx.x, G = gridDim.x;
    const int NPB = G - NSB, pb = bid - NSB;
    unsigned* ctr = (unsigned*)(args.ws + WS_CTR);
    if (bid == 0 && threadIdx.x == 0) __hip_atomic_store(ctr, 0u, __ATOMIC_RELAXED, __HIP_MEMORY_SCOPE_AGENT);
    unsigned sbt = 0;
#define SUBSYNC() do { sbt += (unsigned)NPB; sub_sync(ctr, sbt); } while (0)

    for (int layer = 0; layer < 2; ++layer) {
        { FRESH_TID phase_convert(args, layer, lds, tid, lane, wave, bid, G); }
        grid_sync(grid);
        st_ffn_up(args, layer, 1, G, bid, lds, 0); grid_sync(grid);
        st_ffn_down(args, layer, 1, G, bid, lds, 0); grid_sync(grid);
        st_win(args, layer, 1, G, bid, lds); grid_sync(grid);
        if (bid < NSB) {
            FRESH_TID scan_item<4>(args, layer, bid, 0, lds, tid, lane, wave);
        } else {
            st_ffn_up(args, layer, 0, NPB, pb, lds, 0); SUBSYNC();
            st_ffn_down(args, layer, 0, NPB, pb, lds, 0); SUBSYNC();
            st_win(args, layer, 0, NPB, pb, lds); SUBSYNC();
            { FRESH_TID
              scan_item<4>(args, layer, 32 + pb, 0, lds, tid, lane, wave); __syncthreads();
              if (pb < 2 * (256 - NPB)) { scan_item<2>(args, layer, 32 + NPB + (pb >> 1), pb & 1, lds, tid, lane, wave); __syncthreads(); }
              else { for (int it = pb - 2 * (256 - NPB); it < 1536; it += NPB - 2 * (256 - NPB)) na_item(args, layer, it, lds, tid, lane, wave); } }
            SUBSYNC();
            st_rwpost(args, layer, 0, NPB, pb, lds); SUBSYNC();
            st_wout(args, layer, 0, NPB, pb, lds); SUBSYNC();
            st_ffn_up(args, layer, 0, NPB, pb, lds, 1);
        }
        grid_sync(grid);
        st_rwpost(args, layer, 1, G, bid, lds); st_ffn_down(args, layer, 0, G, bid, lds, 1); st_convp(args, layer, 0, G, bid, lds); grid_sync(grid);
        st_wout(args, layer, 1, G, bid, lds); st_pu(args, layer, 0, G, bid, lds); grid_sync(grid);
        st_ffn_up(args, layer, 1, G, bid, lds, 1); st_ple(args, layer, 0, G, bid, lds); grid_sync(grid);
        st_ffn_down(args, layer, 1, G, bid, lds, 1); st_convp(args, layer, 1, G, bid, lds); grid_sync(grid);
        st_pu(args, layer, 1, G, bid, lds); grid_sync(grid);
        st_ple(args, layer, 1, G, bid, lds); grid_sync(grid);
    }
    {
        FRESH_TID
        const float* SSB = (const float*)(args.ws + WS_SSB); float* out = args.out;
        const int gw = bid * NWAVES + wave, NGW = G * NWAVES; const f32x4* gm = (const f32x4*)args.in[I_FINAL] + lane;
        f32x4 gv[4];
#pragma unroll
        for (int j = 0; j < 4; ++j) gv[j] = gm[64 * j];
        for (int m = gw; m < M; m += 2 * NGW) {
            const int m2 = m + NGW;
            const float rs = row_rstd(SSB, m), rs2 = row_rstd(SSB, m2); f32x4* o = (f32x4*)(out + (size_t)m * D) + lane; f32x4* o2 = (f32x4*)(out + (size_t)m2 * D) + lane;
            f32x4 v[4], v2[4];
#pragma unroll
            for (int j = 0; j < 4; ++j) { v[j] = o[64 * j]; v2[j] = o2[64 * j]; }
#pragma unroll
            for (int j = 0; j < 4; ++j) { o[64 * j] = v[j] * rs * gv[j]; o2[64 * j] = v2[j] * rs2 * gv[j]; }
        }
    }
}

extern "C" void kernel_launch(void* const* d_in, const int* in_sizes, int n_in, void* d_out, int out_size, void* d_ws, size_t ws_size, hipStream_t stream) {
    static int grid = 0;
    if (grid == 0) {
        if (n_in != N_IN || out_size != M * D || ws_size < WS_END) { fprintf(stderr, "kernel_launch: unexpected shapes (n_in %d, out %d, ws %zu)\n", n_in, out_size, ws_size); grid = -1; return; }
        int dev = 0, cus = 0, per_cu = 0;
        (void)hipGetDevice(&dev); (void)hipDeviceGetAttribute(&cus, hipDeviceAttributeMultiprocessorCount, dev);
        (void)hipFuncSetAttribute((const void*)fwd_megakernel, hipFuncAttributeMaxDynamicSharedMemorySize, LDS_BYTES);
        (void)hipOccupancyMaxActiveBlocksPerMultiprocessor(&per_cu, (const void*)fwd_megakernel, NTHREADS, LDS_BYTES);
        if (per_cu < 1) fprintf(stderr, "kernel_launch: occupancy query says %d blocks per CU\n", per_cu);
        grid = cus;
        if (grid != 256) fprintf(stderr, "kernel_launch: grid %d (expected 256)\n", grid);
        if (grid <= NSB + 64) { fprintf(stderr, "kernel_launch: grid too small\n"); grid = -1; return; }
    }
    if (grid < 0) return;
    Args a{};
    for (int i = 0; i < N_IN; ++i) a.in[i] = (const float*)d_in[i];
    a.out = (float*)d_out; a.ws = (unsigned char*)d_ws;
    void* kargs[] = {&a};
    hipError_t e = hipLaunchCooperativeKernel((const void*)fwd_megakernel, dim3(grid), dim3(NTHREADS), kargs, LDS_BYTES, stream);
    if (e != hipSuccess) fprintf(stderr, "kernel_launch: cooperative launch failed: %s\n", hipGetErrorString(e));
}
```

```cpp
#include <hip/hip_runtime.h>
#include <hip/hip_cooperative_groups.h>
#include <cstdio>
#include <cstdint>
namespace cg = cooperative_groups;
#ifndef PHM
#define PHM 0xFFFF
#endif
#define PH(k) ((PHM >> (k)) & 1)

#define LAS __attribute__((address_space(3)))
typedef _Float16 h16;
typedef _Float16 h16x2 __attribute__((ext_vector_type(2)));
typedef _Float16 h16x4 __attribute__((ext_vector_type(4)));
typedef _Float16 h16x8 __attribute__((ext_vector_type(8)));
typedef _Float16 h16x8a __attribute__((ext_vector_type(8), may_alias));
typedef float f32x2 __attribute__((ext_vector_type(2)));
typedef float f32x4 __attribute__((ext_vector_type(4)));
typedef float f32x16 __attribute__((ext_vector_type(16)));
typedef unsigned u32x2 __attribute__((ext_vector_type(2)));
typedef unsigned u32x4 __attribute__((ext_vector_type(4)));
typedef unsigned u32x4a __attribute__((ext_vector_type(4), may_alias));

constexpr int D = 1024, FF = 2816, MP = 65536, MS = 32768, M = MP + MS, TP = 4096, TS = 16384, PLE = 256;
constexpr int NPROJ = 3584;
constexpr int NTHREADS = 512, NWAVES = 8;
constexpr int LDS_BYTES = 151552;
constexpr size_t MiB = 1u << 20;
constexpr size_t WS_CTR = 256;
constexpr size_t WS_W = 1 * MiB;
constexpr size_t WS_SSA = 46 * MiB;
constexpr size_t WS_SSB = 52 * MiB;
constexpr size_t REG_P = 58 * MiB, REG_S = 682 * MiB, WS_END = 994 * MiB;
constexpr size_t OFF_H16 = 0;
constexpr size_t OFF_MIX = 2048;
constexpr size_t OFF_KNA = 4096, OFF_VNA = 5120, OFF_RR = 6144, OFF_RK = 7168, OFF_RV = 8192;
constexpr size_t OFF_LOWS = 9216;
constexpr size_t OFF_ACT = 2048;
constexpr size_t OFF_P16 = 7680;
constexpr size_t OFF_PU = 2048;
constexpr size_t OFF_H16B = 7680;
constexpr size_t OFF_YB = 0, OFF_BSC = 1024;
constexpr size_t OFF_END = 9984;
static_assert(REG_P + OFF_END * MP <= REG_S && REG_S + OFF_END * MS <= WS_END, "group regions");
__device__ __forceinline__ unsigned char* gbuf(unsigned char* ws, int g, size_t off, size_t stride) {
    const size_t reg = g ? REG_S : REG_P, rows = g ? (size_t)MS : (size_t)MP, row0 = g ? (size_t)MP : 0;
    return ws + (reg + off * rows - row0 * stride);
}
#define GB_H16(g)  ((h16*)gbuf(ws, g, OFF_H16, 2048))
#define GB_H16B(g) ((h16*)gbuf(ws, g, OFF_H16B, 2048))
#define GB_MIX(g)  ((h16*)gbuf(ws, g, OFF_MIX, 2048))
#define GB_KNA(g)  ((h16*)gbuf(ws, g, OFF_KNA, 1024))
#define GB_VNA(g)  ((h16*)gbuf(ws, g, OFF_VNA, 1024))
#define GB_RR(g)   ((h16*)gbuf(ws, g, OFF_RR, 1024))
#define GB_RK(g)   ((h16*)gbuf(ws, g, OFF_RK, 1024))
#define GB_RV(g)   ((h16*)gbuf(ws, g, OFF_RV, 1024))
#define GB_LOWS(g) ((h16*)gbuf(ws, g, OFF_LOWS, 768))
#define GB_ACT(g)  ((h16*)gbuf(ws, g, OFF_ACT, 5632))
#define GB_P16(g)  ((h16*)gbuf(ws, g, OFF_P16, 512))
#define GB_PU(g)   ((h16*)gbuf(ws, g, OFF_PU, 2048))
#define GB_YB(g)   ((h16*)gbuf(ws, g, OFF_YB, 1024))
#define GB_BSC(g)  ((float*)gbuf(ws, g, OFF_BSC, 64))
constexpr size_t W_FFN1U = 0;
constexpr size_t W_FFN1D = W_FFN1U + (size_t)5632 * 1024;
constexpr size_t W_IN = W_FFN1D + (size_t)1024 * 2816;
constexpr size_t W_OUT = W_IN + (size_t)3584 * 1024;
constexpr size_t W_FFN2U = W_OUT + (size_t)1024 * 1024;
constexpr size_t W_FFN2D = W_FFN2U + (size_t)5632 * 1024;
constexpr size_t W_GATE = W_FFN2D + (size_t)1024 * 2816;
constexpr size_t W_UP = W_GATE + (size_t)1024 * 1024;
constexpr size_t W_ENDE = W_UP + (size_t)1024 * 256;
static_assert(WS_W + W_ENDE * 2 <= WS_SSA, "weights fit");

enum { I_XP = 0, I_XS, I_PP, I_PS, I_F1N, I_F1G, I_F1U, I_F1D, I_MIXN, I_WIN, I_RPB, I_MU, I_W0, I_WUP, I_A0, I_AUP, I_GUP, I_KK, I_KA, I_RK, I_LNW, I_LNB,
       I_WOUT, I_F2N, I_F2G, I_F2U, I_F2D, I_PLEN, I_PLEG, I_PLEU, I_FINAL, N_IN };
struct Args { const float* in[N_IN]; float* out; unsigned char* ws; };

__device__ __forceinline__ float wave_sum(float v) {
#pragma unroll
    for (int o = 1; o < 64; o <<= 1) v += __shfl_xor(v, o);
    return v;
}
__device__ __forceinline__ unsigned pk2h(float a, float b) { h16x2 p = {(h16)a, (h16)b}; return __builtin_bit_cast(unsigned, p); }
__device__ __forceinline__ h16x2 as_h2(unsigned u) { return __builtin_bit_cast(h16x2, u); }
__device__ __forceinline__ float dot2h(unsigned a, h16x2 b, float c) { return __builtin_amdgcn_fdot2(as_h2(a), b, c, false); }
__device__ __forceinline__ float dot8(u32x4 a, u32x4 b, float c) { const unsigned a0 = a[0], a1 = a[1], a2 = a[2], a3 = a[3], b0 = b[0], b1 = b[1], b2 = b[2], b3 = b[3];
    c = __builtin_amdgcn_fdot2(as_h2(a0), as_h2(b0), c, false); c = __builtin_amdgcn_fdot2(as_h2(a1), as_h2(b1), c, false); c = __builtin_amdgcn_fdot2(as_h2(a2), as_h2(b2), c, false); c = __builtin_amdgcn_fdot2(as_h2(a3), as_h2(b3), c, false); return c; }
__device__ __forceinline__ float dot8w(u32x4 a, h16x2 w0, h16x2 w1, h16x2 w2, h16x2 w3, float c) { const unsigned a0 = a[0], a1 = a[1], a2 = a[2], a3 = a[3];
    c = __builtin_amdgcn_fdot2(as_h2(a0), w0, c, false); c = __builtin_amdgcn_fdot2(as_h2(a1), w1, c, false); c = __builtin_amdgcn_fdot2(as_h2(a2), w2, c, false); c = __builtin_amdgcn_fdot2(as_h2(a3), w3, c, false); return c; }
__device__ __forceinline__ float fma_mix_lo(float p, unsigned v, float o) { asm("v_fma_mix_f32 %0, %1, %2, %0 op_sel_hi:[0,1,0]" : "+v"(o) : "v"(p), "v"(v)); return o; }
__device__ __forceinline__ float fma_mix_hi(float p, unsigned v, float o) { asm("v_fma_mix_f32 %0, %1, %2, %0 op_sel:[0,1,0] op_sel_hi:[0,1,0]" : "+v"(o) : "v"(p), "v"(v)); return o; }
__device__ __forceinline__ float sigmoidf_(float x) { return __builtin_amdgcn_rcpf(1.0f + __expf(-x)); }
__device__ __forceinline__ float row_rstd(const float* ss, int row) {
    const f32x4* p = (const f32x4*)(ss + (size_t)row * 16);
    const f32x4 a = p[0], b = p[1], c = p[2], d = p[3];
    const float s = ((a.x + a.y) + (a.z + a.w)) + ((b.x + b.y) + (b.z + b.w)) + ((c.x + c.y) + (c.z + c.w)) + ((d.x + d.y) + (d.z + d.w));
    return __builtin_amdgcn_rsqf(s * (1.0f / 1024.0f) + 1e-6f);
}
template <int CTRL> __device__ __forceinline__ float dpp_f(float v) { return __builtin_bit_cast(float, __builtin_amdgcn_update_dpp(0, __builtin_bit_cast(int, v), CTRL, 0xF, 0xF, true)); }
__device__ __forceinline__ float row16_sum(float v) {
    v += dpp_f<0xB1>(v);
    v += dpp_f<0x4E>(v);
    v += dpp_f<0x141>(v);
    v += dpp_f<0x140>(v);
    return v;
}
__device__ __forceinline__ void grid_sync(cg::grid_group& grid) {
    asm volatile("s_waitcnt vmcnt(0) lgkmcnt(0)" ::: "memory"); grid.sync();
    __builtin_amdgcn_fence(__ATOMIC_ACQUIRE, "agent"); asm volatile("s_waitcnt vmcnt(0)" ::: "memory"); }

namespace pg8 {
constexpr int BM = 256, BK = 64, HALF = 128, HTB = HALF * BK * 2, STAGE_BYTES = 8 * HTB, NXCD = 8, WGM = 8;
__host__ __device__ __forceinline__ int lds_byte(int r, int c) { const int st = (r >> 4) * 2 + (c >> 5), rr = r & 15, cc = c & 31, ob = rr * 64 + cc * 2; return st * 1024 + (ob ^ (((ob >> 9) & 1) << 5)); }
__host__ __device__ __forceinline__ void stage_rc(int b, int& R, int& C) { const int st = b / 1024, sb = b % 1024, swz = sb ^ (((sb >> 9) & 1) << 5); R = (st >> 1) * 16 + swz / 64; C = (st & 1) * 32 + (swz % 64) / 2; }
__host__ __device__ __forceinline__ int perm32(int rho) { const int n = rho >> 4, i = rho & 15; return 8 * (i >> 2) + 4 * n + (i & 3); }
struct Unit { int pm, pn; };
struct Gemm { const h16* A; const h16* Bt; int M, N, K, lda; };
struct StaticOrder {
    int nM, nN, nwg, G, c, pm0;
    __device__ void init(int M_, int N_, int G_, int c_, int pm0_) { nM = M_ / BM; nN = N_ / BM; nwg = nM * nN; G = G_; c = c_; pm0 = pm0_; }
    __device__ bool next(int i, Unit& u) const {
        const long L = (long)i * G + c; if (L >= nwg) return false;
        int wgid = (int)L; { const int q = nwg / NXCD, r = nwg % NXCD, xcd = wgid % NXCD, off = wgid / NXCD; wgid = (xcd < r ? xcd * (q + 1) : r * (q + 1) + (xcd - r) * q) + off; }
        const int nig = WGM * nN, gid = wgid / nig, fm = gid * WGM, gsz = (nM - fm) < WGM ? (nM - fm) : WGM;
        u.pm = pm0 + fm + ((wgid % nig) % gsz); u.pn = (wgid % nig) / gsz; return true;
    }
};
typedef f32x4 Acc[2][2][4][2];

template <class Epi>
__device__ __forceinline__ void gemm_phase(LAS unsigned char* lds, const Gemm g, const StaticOrder& S, const Epi& E, const int tid) {
    const int wid = __builtin_amdgcn_readfirstlane(tid >> 6), lane = tid & 63, wr = wid >> 2, wc = wid & 3, fr = lane & 15, fq = lane >> 4;
    const int K = g.K, nt = K / BK, lda = g.lda;
    unsigned voffA[2], voffB[2];
#pragma unroll
    for (int i = 0; i < 2; ++i) { int R, C; stage_rc(tid * 16 + i * 8192, R, C); const int Rb = Epi::PERM ? ((R & ~31) + perm32(R & 31)) : R;
        voffA[i] = (unsigned)(R * lda + C) * 2u; voffB[i] = (unsigned)(Rb * K + C) * 2u; }
    const size_t kstep = (size_t)(BK * 2);
    const size_t hstepA = (size_t)HALF * lda * 2, hstepB = (size_t)HALF * K * 2;
    const size_t tstepA = 2 * hstepA, tstepB = 2 * hstepB;
    const unsigned ldsw = (unsigned)wid * 1024u;
    const int aoff = lds_byte(wr * 64 + fr, fq * 8), boff = lds_byte(wc * 32 + fr, fq * 8);
#define PG8_SA(b, h) (((b) * 2 + (h)) * HTB)
#define PG8_SB(b, h) ((4 + (b) * 2 + (h)) * HTB)
#define PG8_STAGE(bufoff, gbase, voff) do { _Pragma("unroll") for (int _i = 0; _i < 2; ++_i) \
        __builtin_amdgcn_global_load_lds((const unsigned*)((const char*)(gbase) + (voff)[_i]), (LAS unsigned*)(lds + (bufoff) + ldsw + _i * 8192), 16, 0, 0); } while (0)
#define PG8_LDA(dst, b, h) do { _Pragma("unroll") for (int m = 0; m < 4; ++m) _Pragma("unroll") for (int k = 0; k < 2; ++k) dst[m][k] = *(const LAS h16x8*)(lds + PG8_SA(b, h) + aoff + m * 2048 + k * 1024); } while (0)
#define PG8_LDB(dst, b, h) do { _Pragma("unroll") for (int n = 0; n < 2; ++n) _Pragma("unroll") for (int k = 0; k < 2; ++k) dst[n][k] = *(const LAS h16x8*)(lds + PG8_SB(b, h) + boff + n * 2048 + k * 1024); } while (0)
#define PG8_MMA(ai, bj, At, Bt) do { __builtin_amdgcn_s_setprio(1); _Pragma("unroll") for (int m = 0; m < 4; ++m) _Pragma("unroll") for (int n = 0; n < 2; ++n) _Pragma("unroll") for (int k = 0; k < 2; ++k) \
        acc[ai][bj][m][n] = __builtin_amdgcn_mfma_f32_16x16x32_f16(Bt[n][k], At[m][k], acc[ai][bj][m][n], 0, 0, 0); __builtin_amdgcn_s_setprio(0); } while (0)
#define PG8_WAIT_V(n) asm volatile("s_waitcnt vmcnt(" #n ")" ::: "memory")
#define PG8_WAIT_L(n) asm volatile("s_waitcnt lgkmcnt(" #n ")" ::: "memory")
#define PG8_BAR __builtin_amdgcn_s_barrier()
#define PG8_SCHED __builtin_amdgcn_sched_barrier(0)
    Unit cur, nxt; int ui = 0;
    if (!S.next(0, cur)) return;
    f32x4 acc[2][2][4][2];
#pragma unroll
    for (int a = 0; a < 2; ++a)
#pragma unroll
        for (int b = 0; b < 2; ++b)
#pragma unroll
            for (int m = 0; m < 4; ++m)
#pragma unroll
                for (int n = 0; n < 2; ++n) acc[a][b][m][n] = (f32x4){0.f, 0.f, 0.f, 0.f};
    h16x8 At[4][2], B0[2][2], B1[2][2];
    const char* cA = (const char*)g.A + (size_t)cur.pm * tstepA; const char* cB = (const char*)g.Bt + (size_t)cur.pn * tstepB;
    PG8_STAGE(PG8_SB(0, 0), cB, voffB); PG8_STAGE(PG8_SB(0, 1), cB + hstepB, voffB); PG8_STAGE(PG8_SA(0, 0), cA, voffA); PG8_STAGE(PG8_SA(0, 1), cA + hstepA, voffA);
    if (wr == 1) PG8_BAR;
    PG8_WAIT_V(2); PG8_BAR;
    PG8_STAGE(PG8_SB(1, 0), cB + kstep, voffB); PG8_STAGE(PG8_SA(1, 0), cA + kstep, voffA); PG8_STAGE(PG8_SB(1, 1), cB + hstepB + kstep, voffB);
    PG8_WAIT_V(6); PG8_BAR;
    for (;;) {
        const bool has_next = S.next(ui + 1, nxt);
        const char* nA = has_next ? (const char*)g.A + (size_t)nxt.pm * tstepA : cA; const char* nB = has_next ? (const char*)g.Bt + (size_t)nxt.pn * tstepB : cB;
        for (int t = 0; t < nt; t += 2) {
            const bool last = (t == nt - 2);
            const char* a1 = cA + (size_t)(t + 1) * kstep;
            const char* a2 = last ? nA : cA + (size_t)(t + 2) * kstep; const char* b2 = last ? nB : cB + (size_t)(t + 2) * kstep;
            const char* a3 = a2 + kstep; const char* b3 = b2 + kstep;
            PG8_LDB(B0, 0, 0); PG8_LDB(B1, 0, 1); PG8_SCHED; PG8_LDA(At, 0, 0); PG8_STAGE(PG8_SA(1, 1), a1 + hstepA, voffA);
            PG8_WAIT_V(8); PG8_WAIT_L(0); PG8_BAR; PG8_MMA(0, 0, At, B0); PG8_MMA(0, 1, At, B1); PG8_BAR; PG8_SCHED;
            PG8_LDA(At, 0, 1); PG8_STAGE(PG8_SB(0, 0), b2, voffB); PG8_STAGE(PG8_SB(0, 1), b2 + hstepB, voffB); PG8_STAGE(PG8_SA(0, 0), a2, voffA);
            PG8_WAIT_V(8); PG8_WAIT_L(0); PG8_BAR; PG8_MMA(1, 0, At, B0); PG8_MMA(1, 1, At, B1); PG8_BAR; PG8_SCHED;
            PG8_LDB(B0, 1, 0); PG8_LDB(B1, 1, 1); PG8_SCHED; PG8_LDA(At, 1, 0); PG8_STAGE(PG8_SA(0, 1), a2 + hstepA, voffA);
            PG8_WAIT_V(8); PG8_WAIT_L(0); PG8_BAR; PG8_MMA(0, 0, At, B0); PG8_MMA(0, 1, At, B1); PG8_BAR; PG8_SCHED;
            PG8_LDA(At, 1, 1); PG8_STAGE(PG8_SB(1, 0), b3, voffB); PG8_STAGE(PG8_SB(1, 1), b3 + hstepB, voffB); PG8_STAGE(PG8_SA(1, 0), a3, voffA);
            PG8_WAIT_V(8); PG8_WAIT_L(0); PG8_BAR; PG8_MMA(1, 0, At, B0); PG8_MMA(1, 1, At, B1); PG8_BAR; PG8_SCHED;
        }
        if (wr == 0) PG8_BAR;
        E(acc, cur, wr, wc, fr, fq);
        if (!has_next) break;
#pragma unroll
        for (int a = 0; a < 2; ++a)
#pragma unroll
            for (int b = 0; b < 2; ++b)
#pragma unroll
                for (int m = 0; m < 4; ++m)
#pragma unroll
                    for (int n = 0; n < 2; ++n) acc[a][b][m][n] = (f32x4){0.f, 0.f, 0.f, 0.f};
        cur = nxt; cA = nA; cB = nB; ++ui;
        if (wr == 1) PG8_BAR;
    }
    PG8_WAIT_V(0);
    PG8_BAR;
#undef PG8_SA
#undef PG8_SB
#undef PG8_STAGE
#undef PG8_LDA
#undef PG8_LDB
#undef PG8_MMA
#undef PG8_WAIT_V
#undef PG8_WAIT_L
#undef PG8_BAR
#undef PG8_SCHED
}


struct EpiSwiglu {
    static constexpr bool PERM = true;
    h16* O; const float* ss;
    __device__ __forceinline__ void operator()(const Acc& acc, const Unit& u, int wr, int wc, int fr, int fq) const {
        const int row0 = u.pm * BM + wr * 64 + fr, col0 = u.pn * 128 + wc * 32 + 8 * fq;
#pragma unroll
        for (int ai = 0; ai < 2; ++ai)
#pragma unroll
            for (int m = 0; m < 4; ++m) {
                const int row = row0 + ai * HALF + m * 16; const float rs = row_rstd(ss, row);
                float o[8];
#pragma unroll
                for (int n = 0; n < 2; ++n) {
                    const f32x4 g4 = acc[ai][0][m][n] * rs, u4 = acc[ai][1][m][n] * rs; const f32x4 x4 = g4 * (-1.4426950408889634f);
                    f32x4 e4; e4.x = __builtin_amdgcn_exp2f(x4.x); e4.y = __builtin_amdgcn_exp2f(x4.y); e4.z = __builtin_amdgcn_exp2f(x4.z); e4.w = __builtin_amdgcn_exp2f(x4.w);
                    const f32x4 d4 = e4 + 1.0f; f32x4 r4; r4.x = __builtin_amdgcn_rcpf(d4.x); r4.y = __builtin_amdgcn_rcpf(d4.y); r4.z = __builtin_amdgcn_rcpf(d4.z); r4.w = __builtin_amdgcn_rcpf(d4.w);
                    const f32x4 o4 = (g4 * u4) * r4; o[n * 4 + 0] = o4.x; o[n * 4 + 1] = o4.y; o[n * 4 + 2] = o4.z; o[n * 4 + 3] = o4.w; }
                u32x4 w; w.x = pk2h(o[0], o[1]); w.y = pk2h(o[2], o[3]); w.z = pk2h(o[4], o[5]); w.w = pk2h(o[6], o[7]);
                *(u32x4*)(O + (size_t)row * FF + col0) = w;
            }
    }
};
struct EpiResid {
    static constexpr bool PERM = false;
    const float* res_p; const float* res_s; float* out; h16* o16; float* ss; float alpha;
    __device__ __forceinline__ void operator()(const Acc& acc, const Unit& u, int wr, int wc, int fr, int fq) const {
        const int row0 = u.pm * BM + wr * 64 + fr, col0 = u.pn * BM + wc * 32 + 4 * fq;
        const float* res = (u.pm * BM < MP) ? res_p : res_s;
#pragma unroll
        for (int ai = 0; ai < 2; ++ai)
#pragma unroll
            for (int m = 0; m < 4; ++m) {
                const int row = row0 + ai * HALF + m * 16; const size_t off = (size_t)row * D + col0; float sq = 0.f;
#pragma unroll
                for (int bj = 0; bj < 2; ++bj)
#pragma unroll
                    for (int n = 0; n < 2; ++n) { const size_t o = off + bj * HALF + n * 16; const f32x4 r = *(const f32x4*)(res + o); const f32x4 v = r + acc[ai][bj][m][n] * alpha;
                        *(f32x4*)(out + o) = v; u32x2 w; w.x = pk2h(v.x, v.y); w.y = pk2h(v.z, v.w); *(u32x2*)(o16 + o) = w; sq += (v.x * v.x + v.y * v.y) + (v.z * v.z + v.w * v.w); }
                sq += __shfl_xor(sq, 16); sq += __shfl_xor(sq, 32);
                if (fq == 0) ss[(size_t)row * 16 + u.pn * 4 + wc] = sq;
                asm volatile("" ::: "memory");
            }
    }
};
struct EpiProj {
    static constexpr bool PERM = true;
    h16* mix; h16* kna; size_t bufstep; h16* lows; const float* ss;
    __device__ __forceinline__ void operator()(const Acc& acc, const Unit& u, int wr, int wc, int fr, int fq) const {
        const int pn = u.pn; h16* base; int ldc, c0; float sc = 1.f; int nbj = 2;
        if (pn < 2) { base = mix; ldc = 1024; c0 = pn * 256; sc = 0.125f; }
        else if (pn < 12) { base = kna + (size_t)((pn - 2) >> 1) * bufstep; ldc = 512; c0 = ((pn - 2) & 1) * 256; }
        else { base = lows; ldc = 384; c0 = (pn - 12) * 256; if (pn == 13) nbj = 1; }
        const int row0 = u.pm * BM + wr * 64 + fr, col0 = c0 + wc * 32 + 8 * fq;
#pragma unroll
        for (int ai = 0; ai < 2; ++ai)
#pragma unroll
            for (int m = 0; m < 4; ++m) {
                const int row = row0 + ai * HALF + m * 16; const float rs = row_rstd(ss, row) * sc;
#pragma unroll
                for (int bj = 0; bj < 2; ++bj) if (bj < nbj) {
                    const f32x4 v0 = acc[ai][bj][m][0] * rs, v1 = acc[ai][bj][m][1] * rs;
                    u32x4 w; w.x = pk2h(v0.x, v0.y); w.y = pk2h(v0.z, v0.w); w.z = pk2h(v1.x, v1.y); w.w = pk2h(v1.z, v1.w);
                    *(u32x4*)(base + (size_t)row * ldc + col0 + bj * HALF) = w; }
            }
    }
};
struct EpiPU {
    static constexpr bool PERM = true;
    h16* O;
    __device__ __forceinline__ void operator()(const Acc& acc, const Unit& u, int wr, int wc, int fr, int fq) const {
        const int row0 = u.pm * BM + wr * 64 + fr, col0 = u.pn * BM + wc * 32 + 8 * fq;
#pragma unroll
        for (int ai = 0; ai < 2; ++ai)
#pragma unroll
            for (int m = 0; m < 4; ++m) {
                const int row = row0 + ai * HALF + m * 16;
#pragma unroll
                for (int bj = 0; bj < 2; ++bj) {
                    const f32x4 v0 = acc[ai][bj][m][0], v1 = acc[ai][bj][m][1];
                    u32x4 w; w.x = pk2h(v0.x, v0.y); w.y = pk2h(v0.z, v0.w); w.z = pk2h(v1.x, v1.y); w.w = pk2h(v1.z, v1.w);
                    *(u32x4*)(O + (size_t)row * D + col0 + bj * HALF) = w; }
            }
    }
};
struct EpiPle {
    static constexpr bool PERM = false;
    float* out; h16* o16; float* ssw; const float* ssr; const h16* pu;
    __device__ __forceinline__ void operator()(const Acc& acc, const Unit& u, int wr, int wc, int fr, int fq) const {
        const int row0 = u.pm * BM + wr * 64 + fr, col0 = u.pn * BM + wc * 32 + 4 * fq;
#pragma unroll
        for (int ai = 0; ai < 2; ++ai)
#pragma unroll
            for (int m = 0; m < 4; ++m) {
                const int row = row0 + ai * HALF + m * 16; const size_t off = (size_t)row * D + col0; float sq = 0.f; const float rs = row_rstd(ssr, row);
#pragma unroll
                for (int bj = 0; bj < 2; ++bj)
#pragma unroll
                    for (int n = 0; n < 2; ++n) { const size_t o = off + bj * HALF + n * 16; const f32x4 r = *(const f32x4*)(out + o); const h16x4 p = *(const h16x4*)(pu + o);
                        const f32x4 a = acc[ai][bj][m][n] * rs; f32x4 v;
                        v.x = r.x + sigmoidf_(a.x) * (float)p.x; v.y = r.y + sigmoidf_(a.y) * (float)p.y; v.z = r.z + sigmoidf_(a.z) * (float)p.z; v.w = r.w + sigmoidf_(a.w) * (float)p.w;
                        *(f32x4*)(out + o) = v; u32x2 w; w.x = pk2h(v.x, v.y); w.y = pk2h(v.z, v.w); *(u32x2*)(o16 + o) = w; sq += (v.x * v.x + v.y * v.y) + (v.z * v.z + v.w * v.w); }
                sq += __shfl_xor(sq, 16); sq += __shfl_xor(sq, 32);
                if (fq == 0) ssw[(size_t)row * 16 + u.pn * 4 + wc] = sq;
                asm volatile("" ::: "memory");
            }
    }
};
}

__device__ __forceinline__ void convert_matrix(const float* W, int K, int N, const float* gamma, h16* WT, int mode, LAS float* scr, int gw, int NGW, int lane) {
    const int nblk = N / 32, nitems = (K / 64) * nblk;
    for (int item = gw; item < nitems; item += NGW) {
        const int kb = item / nblk, nb = item % nblk, k0 = 64 * kb, n0 = 32 * nb;
        const int drow0 = (mode == 0) ? n0 : ((n0 >> 7) * 256 + (n0 & 127) + (mode == 2 ? 128 : 0));
#pragma unroll 8
        for (int i = 0; i < 32; ++i) { const int kk = 2 * i + (lane >> 5); float v = W[(size_t)(k0 + kk) * N + n0 + (lane & 31)]; if (gamma) v *= gamma[k0 + kk]; scr[kk * 33 + (lane & 31)] = v; }
        asm volatile("s_waitcnt lgkmcnt(0)" ::: "memory");
        const int c = lane & 7;
#pragma unroll
        for (int j = 0; j < 4; ++j) { const int n = (lane >> 3) + 8 * j; const LAS float* s = scr + (8 * c) * 33 + n;
            u32x4 o; o.x = pk2h(s[0 * 33], s[1 * 33]); o.y = pk2h(s[2 * 33], s[3 * 33]); o.z = pk2h(s[4 * 33], s[5 * 33]); o.w = pk2h(s[6 * 33], s[7 * 33]);
            *(u32x4*)(WT + (size_t)(drow0 + n) * K + k0 + 8 * c) = o; }
        asm volatile("s_waitcnt lgkmcnt(0)" ::: "memory");
    }
}

__device__ __forceinline__ void phase_convert(const Args& a, int layer, LAS unsigned char* lds, int tid, int lane, int wave, int bid, int G) {
    LAS float* scr = (LAS float*)(lds + wave * 16384);
    const int gw = bid * NWAVES + wave, NGW = G * NWAVES;
    h16* W = (h16*)(a.ws + WS_W);
    const size_t l = (size_t)layer;
    convert_matrix(a.in[I_F1G] + l * D * FF, D, FF, a.in[I_F1N] + l * D, W + W_FFN1U, 1, scr, gw, NGW, lane);
    convert_matrix(a.in[I_F1U] + l * D * FF, D, FF, a.in[I_F1N] + l * D, W + W_FFN1U, 2, scr, gw, NGW, lane);
    convert_matrix(a.in[I_F1D] + l * FF * D, FF, D, nullptr, W + W_FFN1D, 0, scr, gw, NGW, lane);
    convert_matrix(a.in[I_WIN] + l * D * 3456, D, 3456, a.in[I_MIXN] + l * D, W + W_IN, 0, scr, gw, NGW, lane);
    convert_matrix(a.in[I_WOUT] + l * D * D, D, D, nullptr, W + W_OUT, 0, scr, gw, NGW, lane);
    convert_matrix(a.in[I_F2G] + l * D * FF, D, FF, a.in[I_F2N] + l * D, W + W_FFN2U, 1, scr, gw, NGW, lane);
    convert_matrix(a.in[I_F2U] + l * D * FF, D, FF, a.in[I_F2N] + l * D, W + W_FFN2U, 2, scr, gw, NGW, lane);
    convert_matrix(a.in[I_F2D] + l * FF * D, FF, D, nullptr, W + W_FFN2D, 0, scr, gw, NGW, lane);
    convert_matrix(a.in[I_PLEG] + l * D * D, D, D, a.in[I_PLEN] + l * D, W + W_GATE, 0, scr, gw, NGW, lane);
    convert_matrix(a.in[I_PLEU] + l * PLE * D, PLE, D, nullptr, W + W_UP, 0, scr, gw, NGW, lane);
    { u32x4* z = (u32x4*)(W + W_IN + (size_t)3456 * 1024); const int n16 = 128 * 1024 * 2 / 16;
      for (int i = bid * NTHREADS + tid; i < n16; i += G * NTHREADS) z[i] = (u32x4){0u, 0u, 0u, 0u}; }
    if (layer == 0) {
        unsigned char* ws = a.ws; h16* Hp = GB_H16B(0); h16* Hs = GB_H16B(1); float* ss = (float*)(a.ws + WS_SSB);
        for (int m = gw; m < M; m += NGW) {
            h16* H = (m < MP) ? Hp : Hs;
            const float* xr = (m < MP) ? a.in[I_XP] + (size_t)m * D : a.in[I_XS] + (size_t)(m - MP) * D;
            const f32x4* x4 = (const f32x4*)xr + lane; float s = 0.f;
            u32x2* o = (u32x2*)(H + (size_t)m * D) + lane;
#pragma unroll
            for (int j = 0; j < 4; ++j) { const f32x4 v = x4[64 * j]; s += (v.x * v.x + v.y * v.y) + (v.z * v.z + v.w * v.w); u32x2 w; w.x = pk2h(v.x, v.y); w.y = pk2h(v.z, v.w); o[64 * j] = w; }
            s = wave_sum(s);
            if (lane < 16) ss[(size_t)m * 16 + lane] = (lane == 0) ? s : 0.f;
        }
    }
}

__device__ __forceinline__ void convert_p(const Args& a, int layer, int g, int nb, int cb, int tid) {
    unsigned char* ws = a.ws; const int rows = g ? MS : MP, row0 = g ? MP : 0;
    u32x2* o = (u32x2*)(GB_P16(g) + (size_t)row0 * PLE);
    const f32x4* p = (const f32x4*)((g ? a.in[I_PS] + (size_t)layer * MS * PLE : a.in[I_PP] + (size_t)layer * MP * PLE));
    const int N4 = rows * PLE / 4;
    for (int i = cb * NTHREADS + tid; i < N4; i += nb * NTHREADS) { const f32x4 v = p[i]; u32x2 w; w.x = pk2h(v.x, v.y); w.y = pk2h(v.z, v.w); o[i] = w; }
}

constexpr int NA_PITCH = 144;
constexpr int NA_VOFF = 512 * NA_PITCH;
constexpr int NA_PP = 67;
constexpr int NA_BTOFF = 2 * 512 * NA_PITCH;
__device__ __forceinline__ void na_item(const Args& a, int layer, int item, LAS unsigned char* lds, int tid, int lane, int wave) {
    int tok0, i, rows;
    if (item < 1024) { tok0 = (item >> 6) * TP; i = item & 63; rows = 64; } else { const int it2 = item - 1024; tok0 = MP + (it2 >> 8) * TS; i = it2 & 255; rows = 256; }
    int rs = i - 4; rs = rs < 0 ? 0 : (rs > rows - 8 ? rows - 8 : rs);
    unsigned char* ws = a.ws; const int g = item < 1024 ? 0 : 1;
    h16* MIX = GB_MIX(g); const h16* KNA = GB_KNA(g); const h16* VNA = GB_VNA(g);
    const float* rpb = a.in[I_RPB] + (size_t)layer * 8 * 15 * 31;
    const int wtok0 = tok0 + rs * 64;
    const int j = lane, aw = wave;
    const int tokq = tok0 + i * 64 + j;
    int cs = j - 8; cs = cs < 0 ? 0 : (cs > 48 ? 48 : cs);
    const int l31 = lane & 31, half = lane >> 5;
    LAS float* bt = (LAS float*)(lds + NA_BTOFF) + wave * 128;
    bt[lane] = 0.f; bt[64 + lane] = 0.f;
    u32x4 kreg[8], vreg[8];
    const size_t kvoff = (size_t)(wtok0 + (tid >> 3)) * 512 + (tid & 7) * 8;
#pragma unroll
    for (int it = 0; it < 8; ++it) { kreg[it] = *(const u32x4*)(KNA + kvoff + (size_t)it * (64 * 512)); vreg[it] = *(const u32x4*)(VNA + kvoff + (size_t)it * (64 * 512)); }
#pragma unroll 1
    for (int h = 0; h < 8; ++h) {
#pragma unroll
        for (int it = 0; it < 8; ++it) { const int key = (tid >> 3) + 64 * it, ch = tid & 7;
            *(LAS u32x4*)(lds + key * NA_PITCH + ch * 16) = kreg[it]; *(LAS u32x4*)(lds + NA_VOFF + key * NA_PITCH + ch * 16) = vreg[it]; }
        h16x8 qf[2][4];
#pragma unroll
        for (int nt = 0; nt < 2; ++nt)
#pragma unroll
            for (int ks = 0; ks < 4; ++ks) qf[nt][ks] = *(const h16x8*)(MIX + (size_t)(tok0 + i * 64 + l31 + 32 * nt) * 1024 + h * 64 + 16 * ks + 8 * half);
        if (lane < 31) bt[48 + lane] = rpb[((size_t)h * 15 + (rs + aw - i + 7)) * 31 + lane];
        __syncthreads();
        if (h + 1 < 8) {
#pragma unroll
            for (int it = 0; it < 8; ++it) { kreg[it] = *(const u32x4*)(KNA + kvoff + (size_t)it * (64 * 512) + (h + 1) * 64); vreg[it] = *(const u32x4*)(VNA + kvoff + (size_t)it * (64 * 512) + (h + 1) * 64); }
        }
        f32x16 acc[2][2];
#pragma unroll
        for (int mt = 0; mt < 2; ++mt)
#pragma unroll
            for (int nt = 0; nt < 2; ++nt)
#pragma unroll
                for (int r = 0; r < 16; ++r) acc[mt][nt][r] = 0.f;
#pragma unroll
        for (int mt = 0; mt < 2; ++mt)
#pragma unroll
            for (int ks = 0; ks < 4; ++ks) {
                const h16x8 kf = *(const LAS h16x8*)(lds + (aw * 64 + 32 * mt + l31) * NA_PITCH + (16 * ks + 8 * half) * 2);
                acc[mt][0] = __builtin_amdgcn_mfma_f32_32x32x16_f16(kf, qf[0][ks], acc[mt][0], 0, 0, 0);
                acc[mt][1] = __builtin_amdgcn_mfma_f32_32x32x16_f16(kf, qf[1][ks], acc[mt][1], 0, 0, 0);
            }
        float mxq[2], lq[2];
#pragma unroll
        for (int nt = 0; nt < 2; ++nt) {
            const int qc = l31 + 32 * nt; int csq = qc - 8; csq = csq < 0 ? 0 : (csq > 48 ? 48 : csq);
            const int dlt = 4 * half - csq;
            const LAS float* bq = bt + (48 + 15 + 4 * half - qc - 32);
            float m = -3.0e38f;
#pragma unroll
            for (int mt = 0; mt < 2; ++mt)
#pragma unroll
                for (int r = 0; r < 16; ++r) { const int kr = (r & 3) + 8 * (r >> 2) + 32 * mt;
                    const float sv = acc[mt][nt][r] + bq[32 + kr]; const bool ok = (unsigned)(dlt + kr) < 16u; const float sm = ok ? sv : -1.0e30f; acc[mt][nt][r] = sm; m = fmaxf(m, sm); }
            { const auto sw = __builtin_amdgcn_permlane32_swap(__builtin_bit_cast(unsigned, m), __builtin_bit_cast(unsigned, m), false, false); const unsigned s0 = sw[0], s1 = sw[1]; m = fmaxf(__builtin_bit_cast(float, s0), __builtin_bit_cast(float, s1)); }
            float l = 0.f;
#pragma unroll
            for (int mt = 0; mt < 2; ++mt)
#pragma unroll
                for (int r = 0; r < 16; ++r) { const float p = __expf(acc[mt][nt][r] - m); acc[mt][nt][r] = p; l += p; }
            { const auto sw = __builtin_amdgcn_permlane32_swap(__builtin_bit_cast(unsigned, l), __builtin_bit_cast(unsigned, l), false, false); const unsigned s0 = sw[0], s1 = sw[1]; l = __builtin_bit_cast(float, s0) + __builtin_bit_cast(float, s1); }
            mxq[nt] = m; lq[nt] = l;
        }
        h16x8 pf[2][2][2];
#pragma unroll
        for (int kt = 0; kt < 2; ++kt)
#pragma unroll
            for (int nt = 0; nt < 2; ++nt)
#pragma unroll
                for (int sx = 0; sx < 2; ++sx)
#pragma unroll
                    for (int e = 0; e < 8; ++e) pf[kt][nt][sx][e] = (h16)acc[kt][nt][8 * sx + e];
        f32x16 o[2][2];
#pragma unroll
        for (int dm = 0; dm < 2; ++dm)
#pragma unroll
            for (int nt = 0; nt < 2; ++nt)
#pragma unroll
                for (int r = 0; r < 16; ++r) o[dm][nt][r] = 0.f;
#pragma unroll
        for (int dm = 0; dm < 2; ++dm)
#pragma unroll
            for (int kt = 0; kt < 2; ++kt)
#pragma unroll
                for (int sx = 0; sx < 2; ++sx) {
                    h16x8 vf;
                    const LAS unsigned char* vb = lds + NA_VOFF + (aw * 64 + 32 * kt + 16 * sx + 4 * half) * NA_PITCH + (l31 + 32 * dm) * 2;
#pragma unroll
                    for (int e = 0; e < 8; ++e) vf[e] = *(const LAS h16*)(vb + ((e & 3) + 8 * (e >> 2)) * NA_PITCH);
                    o[dm][0] = __builtin_amdgcn_mfma_f32_32x32x16_f16(vf, pf[kt][0][sx], o[dm][0], 0, 0, 0);
                    o[dm][1] = __builtin_amdgcn_mfma_f32_32x32x16_f16(vf, pf[kt][1][sx], o[dm][1], 0, 0, 0);
                }
        __syncthreads();
#pragma unroll
        for (int nt = 0; nt < 2; ++nt) {
            LAS float* part = (LAS float*)lds + (size_t)(aw * 64 + l31 + 32 * nt) * NA_PP;
#pragma unroll
            for (int dm = 0; dm < 2; ++dm)
#pragma unroll
                for (int r = 0; r < 16; ++r) part[(r & 3) + 8 * (r >> 2) + 4 * half + 32 * dm] = o[dm][nt][r];
            if (half == 0) { part[64] = mxq[nt]; part[65] = lq[nt]; }
        }
        __syncthreads();
        {
            const int jq = tid & 63, e8 = tid >> 6;
            float mw[8], M_ = -3.0e38f;
#pragma unroll
            for (int w = 0; w < 8; ++w) { mw[w] = ((const LAS float*)lds)[(size_t)(w * 64 + jq) * NA_PP + 64]; M_ = fmaxf(M_, mw[w]); }
            float L = 0.f, ov[8];
#pragma unroll
            for (int e = 0; e < 8; ++e) ov[e] = 0.f;
#pragma unroll
            for (int w = 0; w < 8; ++w) { const float f = __expf(mw[w] - M_); const LAS float* pw = (const LAS float*)lds + (size_t)(w * 64 + jq) * NA_PP; L += f * pw[65];
#pragma unroll
                for (int e = 0; e < 8; ++e) ov[e] += f * pw[e8 * 8 + e]; }
            const float inv = 1.0f / L;
            u32x4 w4; w4.x = pk2h(ov[0] * inv, ov[1] * inv); w4.y = pk2h(ov[2] * inv, ov[3] * inv); w4.z = pk2h(ov[4] * inv, ov[5] * inv); w4.w = pk2h(ov[6] * inv, ov[7] * inv);
            *(u32x4*)(MIX + (size_t)(tok0 + i * 64 + jq) * 1024 + h * 64 + e8 * 8) = w4;
        }
        __syncthreads();
    }
}

__device__ __forceinline__ float shiftmix(const h16* base, size_t stride, int t, int T, float mu) {
    const float c = (float)base[0];
    const float p = (t > 0) ? (float)*(base - stride) : 0.f;
    const float n = (t < T - 1) ? (float)*(base + stride) : 0.f;
    return c + mu * (0.5f * (p + n) - c);
}
constexpr int SC_CH = 32;
constexpr int SC_OPB = SC_CH * 6 * 64 * 4;
constexpr int SC_YOFF = 2 * SC_OPB;
constexpr int SC_YB = SC_CH * 64 * 4;
constexpr int SC_XOFF = SC_YOFF + 2 * SC_YB;
constexpr int SC_ZOFF = SC_XOFF + 8192;
static_assert(SC_ZOFF + 4 * 4096 <= LDS_BYTES, "scan LDS");
__device__ __forceinline__ float wave_sum_fast(float v) {
    v = row16_sum(v);
    { const auto r = __builtin_amdgcn_permlane16_swap(__builtin_bit_cast(unsigned, v), __builtin_bit_cast(unsigned, v), false, false);
      const unsigned r0 = r[0], r1 = r[1]; v = __builtin_bit_cast(float, r0) + __builtin_bit_cast(float, r1); }
    { const auto r = __builtin_amdgcn_permlane32_swap(__builtin_bit_cast(unsigned, v), __builtin_bit_cast(unsigned, v), false, false);
      const unsigned r0 = r[0], r1 = r[1]; v = __builtin_bit_cast(float, r0) + __builtin_bit_cast(float, r1); }
    return v;
}
__device__ __forceinline__ float mix3(h16 p, h16 c, h16 n, float mu) { const float cf = (float)c; return cf + mu * (0.5f * ((float)p + (float)n) - cf); }
struct ScanWin { float r[10], k[10], v[10], wl[10], al[10]; };
struct ScanWinRaw { h16 r[10], k[10], v[10], wl[10], al[10]; };
__device__ __forceinline__ float mix3f(float p, float c, float n, float mu) { return c + mu * (0.5f * (p + n) - c); }
template <int R>
__device__ __forceinline__ void scan_flush(LAS unsigned char* lds, int cf, int pw, int lane, int d, int T, int tok0, int h, int rowbase, h16* Yf, h16* Yb) {
    const LAS float* yb = (const LAS float*)(lds + SC_YOFF + (cf & 1) * SC_YB);
    const int s = pw * 8 + (lane >> 3); const int g = cf * SC_CH + s; const int t = d ? (T - 1 - g) : g;
    if (R == 4) {
        const int r8 = (lane & 7) * 8;
        const f32x4 y0 = *(const LAS f32x4*)(yb + s * 64 + r8), y1 = *(const LAS f32x4*)(yb + s * 64 + r8 + 4);
        u32x4 w4; w4.x = pk2h(y0.x, y0.y); w4.y = pk2h(y0.z, y0.w); w4.z = pk2h(y1.x, y1.y); w4.w = pk2h(y1.z, y1.w);
        if (d == 0) *(u32x4*)(Yf + (size_t)(tok0 + t) * 1024 + 512 + h * 64 + r8) = w4; else *(u32x4*)(Yb + (size_t)(tok0 + t) * 512 + h * 64 + r8) = w4;
    } else {
        const int r4 = (lane & 7) * 4;
        const f32x4 y0 = *(const LAS f32x4*)(yb + s * 32 + r4);
        u32x2 w2; w2.x = pk2h(y0.x, y0.y); w2.y = pk2h(y0.z, y0.w);
        if (d == 0) *(u32x2*)(Yf + (size_t)(tok0 + t) * 1024 + 512 + h * 64 + rowbase + r4) = w2; else *(u32x2*)(Yb + (size_t)(tok0 + t) * 512 + h * 64 + rowbase + r4) = w2;
    }
}
template <int R>
__device__ __forceinline__ void scan_item(const Args& a, int layer, int q, int rowhalf, LAS unsigned char* lds, int tid, int lane, int wave) {
    int tok0, T, h, d;
    if (q < 32) { tok0 = MP + (q >> 4) * TS; T = TS; h = (q >> 1) & 7; d = q & 1; } else { const int q2 = q - 32; tok0 = (q2 >> 4) * TP; T = TP; h = (q2 >> 1) & 7; d = q2 & 1; }
    const int nch = T / SC_CH, rowbase = rowhalf * 16 * R;
    unsigned char* ws = a.ws; const int g = q < 32 ? 1 : 0;
    const h16* RR = GB_RR(g); const h16* RK = GB_RK(g); const h16* RV = GB_RV(g); const h16* LOWS = GB_LOWS(g);
    h16* Yf = GB_MIX(g); h16* Yb = GB_YB(g); float* BSC = GB_BSC(g);
    const size_t l = (size_t)layer;
    if (wave >= 4) {
        const int pw = wave - 4, j = lane, col = h * 64 + j;
        const float* mu = a.in[I_MU] + l * 1920;
        const float mu_r = mu[col], mu_k = mu[512 + col], mu_v = mu[1024 + col], mu_wl = mu[1536 + d * 64 + j], mu_al = mu[1536 + 128 + d * 64 + j];
        const float k_k = a.in[I_KK][l * 512 + col], k_a = a.in[I_KA][l * 512 + col], r_k = a.in[I_RK][l * 512 + col];
        const float w0 = a.in[I_W0][(l * 2 + d) * 512 + col], a0 = a.in[I_A0][(l * 2 + d) * 512 + col];
        h16x8 bw[4][2], ba[4][2];
        { const int n = lane & 15, kg = lane >> 4;
          const float* wu = a.in[I_WUP] + ((l * 2 + d) * 64 + 8 * kg) * 512 + h * 64 + n; const float* au = a.in[I_AUP] + ((l * 2 + d) * 64 + 8 * kg) * 512 + h * 64 + n;
#pragma unroll
          for (int ks = 0; ks < 2; ++ks) {
#pragma unroll
              for (int e = 0; e < 8; ++e) {
                  const float w_0 = wu[0], w_1 = wu[16], w_2 = wu[32], w_3 = wu[48], a_0 = au[0], a_1 = au[16], a_2 = au[32], a_3 = au[48];
                  wu += 512; au += 512; asm volatile("" : "+v"(wu), "+v"(au));
                  bw[0][ks][e] = (h16)w_0; bw[1][ks][e] = (h16)w_1; bw[2][ks][e] = (h16)w_2; bw[3][ks][e] = (h16)w_3;
                  ba[0][ks][e] = (h16)a_0; ba[1][ks][e] = (h16)a_1; ba[2][ks][e] = (h16)a_2; ba[3][ks][e] = (h16)a_3; }
              wu += 24 * 512; au += 24 * 512; asm volatile("" : "+v"(wu), "+v"(au)); } }
        LAS float* zl = (LAS float*)(lds + SC_ZOFF + pw * 4096);
        LAS unsigned char* xsb = lds + SC_XOFF + pw * 2048;
        ScanWin cur; ScanWinRaw nxt;
#define SCAN_LOAD_RAW(cp_) do { const int g0_ = (cp_) * SC_CH + pw * 8; \
            _Pragma("unroll") for (int w = 0; w < 10; ++w) { int tt = d ? (T - 1 - g0_) + 1 - w : g0_ - 1 + w; tt = tt < 0 ? 0 : (tt > T - 1 ? T - 1 : tt); const size_t tok = (size_t)(tok0 + tt); \
                nxt.r[w] = RR[tok * 512 + col]; nxt.k[w] = RK[tok * 512 + col]; nxt.v[w] = RV[tok * 512 + col]; nxt.wl[w] = LOWS[tok * 384 + d * 64 + j]; nxt.al[w] = LOWS[tok * 384 + 128 + d * 64 + j]; } } while (0)
#define SCAN_UNPACK(cp_) do { const int g0_ = (cp_) * SC_CH + pw * 8; \
            _Pragma("unroll") for (int w = 0; w < 10; ++w) { const int tt = d ? (T - 1 - g0_) + 1 - w : g0_ - 1 + w; const bool ok = (tt >= 0) && (tt < T); \
                cur.r[w] = ok ? (float)nxt.r[w] : 0.f; cur.k[w] = ok ? (float)nxt.k[w] : 0.f; cur.v[w] = ok ? (float)nxt.v[w] : 0.f; cur.wl[w] = ok ? (float)nxt.wl[w] : 0.f; cur.al[w] = ok ? (float)nxt.al[w] : 0.f; } } while (0)
        SCAN_LOAD_RAW(0); SCAN_UNPACK(0);
        for (int c = -1; c < nch; ++c) {
            if (c >= 1) scan_flush<R>(lds, c - 1, pw, lane, d, T, tok0, h, rowbase, Yf, Yb);
            if (c + 1 < nch) {
                const int cp = c + 1; LAS float* op = (LAS float*)(lds + (cp & 1) * SC_OPB);
                if (c + 2 < nch) SCAN_LOAD_RAW(c + 2);
                float bsv = 0.f;
#pragma unroll
                for (int s8 = 0; s8 < 8; ++s8) {
                    const float wl = mix3f(cur.wl[s8], cur.wl[s8 + 1], cur.wl[s8 + 2], mu_wl);
                    const float al = mix3f(cur.al[s8], cur.al[s8 + 1], cur.al[s8 + 2], mu_al);
                    const float e2 = __expf(2.0f * wl); const float th = 1.0f - 2.0f * __builtin_amdgcn_rcpf(e2 + 1.0f);
                    LAS h16* xs = (LAS h16*)(xsb + s8 * 256);
                    xs[j] = (h16)th; xs[64 + j] = (h16)al;
                }
                {
                    const LAS unsigned char* xr = xsb + (lane & 7) * 256 + (lane >> 4) * 16;
                    const h16x8 xw0 = *(const LAS h16x8a*)(xr), xw1 = *(const LAS h16x8a*)(xr + 64), xa0 = *(const LAS h16x8a*)(xr + 128), xa1 = *(const LAS h16x8a*)(xr + 192);
                    f32x4 accw[4], acca[4];
#pragma unroll
                    for (int nt = 0; nt < 4; ++nt) {
                        accw[nt] = __builtin_amdgcn_mfma_f32_16x16x32_f16(xw0, bw[nt][0], (f32x4){0.f, 0.f, 0.f, 0.f}, 0, 0, 0);
                        accw[nt] = __builtin_amdgcn_mfma_f32_16x16x32_f16(xw1, bw[nt][1], accw[nt], 0, 0, 0);
                        acca[nt] = __builtin_amdgcn_mfma_f32_16x16x32_f16(xa0, ba[nt][0], (f32x4){0.f, 0.f, 0.f, 0.f}, 0, 0, 0);
                        acca[nt] = __builtin_amdgcn_mfma_f32_16x16x32_f16(xa1, ba[nt][1], acca[nt], 0, 0, 0); }
                    if (lane < 32) {
                        LAS float* zw = zl + (4 * (lane >> 4)) * 64 + (lane & 15);
#pragma unroll
                        for (int nt = 0; nt < 4; ++nt)
#pragma unroll
                            for (int r = 0; r < 4; ++r) { zw[r * 64 + 16 * nt] = accw[nt][r]; zw[512 + r * 64 + 16 * nt] = acca[nt][r]; }
                    }
                }
#pragma unroll
                for (int s8 = 0; s8 < 8; ++s8) {
                    const int s = pw * 8 + s8; const int g = cp * SC_CH + s; const int t = d ? (T - 1 - g) : g; const size_t tok = (size_t)(tok0 + t);
                    const float rr = mix3f(cur.r[s8], cur.r[s8 + 1], cur.r[s8 + 2], mu_r);
                    const float kk0 = mix3f(cur.k[s8], cur.k[s8 + 1], cur.k[s8 + 2], mu_k);
                    const float vv = mix3f(cur.v[s8], cur.v[s8 + 1], cur.v[s8 + 2], mu_v);
                    const float z = w0 + zl[s8 * 64 + j], az = a0 + zl[512 + s8 * 64 + j];
                    const float wdec = __expf(-0.606531f * sigmoidf_(z)); const float av = sigmoidf_(az);
                    float kk = kk0 * k_k; const float n2 = wave_sum_fast(kk * kk); kk = kk * __builtin_amdgcn_rsqf(fmaxf(n2, 1e-24f));
                    const float kd = kk0 * (1.0f + (av - 1.0f) * k_a); const float bb = kk * av;
                    const float bs = wave_sum_fast(rr * kd * r_k);
                    bsv = (lane == s8) ? bs : bsv;
                    LAS float* o = op + s * 384 + j;
                    o[0] = -kk; o[64] = wdec; o[128] = bb; o[192] = kd; o[256] = rr; o[320] = vv;
                }
                if (lane < 8 && rowhalf == 0) { const int gs = cp * SC_CH + pw * 8 + lane; const int t = d ? (T - 1 - gs) : gs; BSC[((size_t)(tok0 + t) * 8 + h) * 2 + d] = bsv; }
                if (c + 2 < nch) SCAN_UNPACK(c + 2);
            }
            __syncthreads();
        }
        scan_flush<R>(lds, nch - 1, pw, lane, d, T, tok0, h, rowbase, Yf, Yb);
#undef SCAN_LOAD_RAW
#undef SCAN_UNPACK
    } else {
        constexpr int RL = R / 2;
        const int ri = lane >> 3, ci = lane & 7;
        const int yrow = wave * 8 * RL + ri * RL, vrow = rowbase + yrow;
        f32x2 S[RL][4];
#pragma unroll
        for (int i = 0; i < RL; ++i)
#pragma unroll
            for (int c2 = 0; c2 < 4; ++c2) S[i][c2] = (f32x2){0.f, 0.f};
        typedef float vecR __attribute__((ext_vector_type(RL)));
        __syncthreads();
        for (int c = 0; c < nch; ++c) {
            const LAS f32x4* op = (const LAS f32x4*)(lds + (c & 1) * SC_OPB);
            LAS float* yb = (LAS float*)(lds + SC_YOFF + (c & 1) * SC_YB);
            f32x4 a0 = op[2 * ci], a1 = op[2 * ci + 1], w0 = op[16 + 2 * ci], w1 = op[17 + 2 * ci], b0 = op[32 + 2 * ci], b1 = op[33 + 2 * ci];
            f32x4 k0 = op[48 + 2 * ci], k1 = op[49 + 2 * ci], r0 = op[64 + 2 * ci], r1 = op[65 + 2 * ci]; vecR v4 = *(const LAS vecR*)((const LAS float*)op + 320 + vrow);
#pragma unroll 4
            for (int s = 0; s < SC_CH; ++s) {
                const LAS f32x4* on = op + (s + 1) * 96;
                const f32x4 na0 = on[2 * ci], na1 = on[2 * ci + 1], nw0 = on[16 + 2 * ci], nw1 = on[17 + 2 * ci], nb0 = on[32 + 2 * ci], nb1 = on[33 + 2 * ci];
                const f32x4 nk0 = on[48 + 2 * ci], nk1 = on[49 + 2 * ci], nr0 = on[64 + 2 * ci], nr1 = on[65 + 2 * ci]; const vecR nv4 = *(const LAS vecR*)((const LAS float*)on + 320 + vrow);
                const f32x2 av[4] = {{a0.x, a0.y}, {a0.z, a0.w}, {a1.x, a1.y}, {a1.z, a1.w}}, wv[4] = {{w0.x, w0.y}, {w0.z, w0.w}, {w1.x, w1.y}, {w1.z, w1.w}};
                const f32x2 bv[4] = {{b0.x, b0.y}, {b0.z, b0.w}, {b1.x, b1.y}, {b1.z, b1.w}}, kv[4] = {{k0.x, k0.y}, {k0.z, k0.w}, {k1.x, k1.y}, {k1.z, k1.w}};
                const f32x2 rv[4] = {{r0.x, r0.y}, {r0.z, r0.w}, {r1.x, r1.y}, {r1.z, r1.w}};
                float sa[RL];
#pragma unroll
                for (int i = 0; i < RL; ++i) { f32x2 p = S[i][0] * av[0]; p = S[i][1] * av[1] + p; p = S[i][2] * av[2] + p; p = S[i][3] * av[3] + p;
                    float t = p.x + p.y; t += dpp_f<0xB1>(t); t += dpp_f<0x4E>(t); t += dpp_f<0x141>(t); sa[i] = t; }
                vecR y;
#pragma unroll
                for (int i = 0; i < RL; ++i) { const f32x2 sa2 = {sa[i], sa[i]}, v2 = {v4[i], v4[i]};
#pragma unroll
                    for (int c2 = 0; c2 < 4; ++c2) S[i][c2] = S[i][c2] * wv[c2] + sa2 * bv[c2] + v2 * kv[c2];
                    f32x2 p = S[i][0] * rv[0]; p = S[i][1] * rv[1] + p; p = S[i][2] * rv[2] + p; p = S[i][3] * rv[3] + p;
                    float t = p.x + p.y; t += dpp_f<0xB1>(t); t += dpp_f<0x4E>(t); t += dpp_f<0x141>(t); y[i] = t; }
                if (ci == 0) *(LAS vecR*)(yb + s * (32 * RL) + yrow) = y;
                a0 = na0; a1 = na1; w0 = nw0; w1 = nw1; b0 = nb0; b1 = nb1; k0 = nk0; k1 = nk1; r0 = nr0; r1 = nr1; v4 = nv4;
            }
            __syncthreads();
        }
    }
}

__device__ __forceinline__ void rwpost_tile(const Args& a, int layer, int tile, LAS unsigned char* lds, int tid, int lane, int wave, const h16x8 (&bg)[4][4]) {
    const size_t l = (size_t)layer; const int h = wave, n16 = lane & 15, g4 = lane >> 4;
    const int m0 = tile * 64; int tok0s, T; if (m0 < MP) { T = TP; tok0s = (m0 / TP) * TP; } else { T = TS; tok0s = MP + ((m0 - MP) / TS) * TS; }
    unsigned char* ws = a.ws; const int g = m0 < MP ? 0 : 1;
    const h16* LOWS = GB_LOWS(g); const h16* RV = GB_RV(g); h16* MIX = GB_MIX(g); const h16* Yb = GB_YB(g); const float* BSC = GB_BSC(g);
    const float* mu = a.in[I_MU] + l * 1920;
    LAS h16* G = (LAS h16*)lds;
    { const int c = tid & 127; const float mug = mu[1536 + 256 + c];
#pragma unroll 8
      for (int e = tid; e < 64 * 128; e += NTHREADS) { const int tk = e >> 7; const int m = m0 + tk; const int t = m - tok0s;
        const float gl = shiftmix(LOWS + (size_t)m * 384 + 256 + c, 384, t, T, mug); G[e] = (h16)sigmoidf_(gl); } }
    float muv[4], lw[4], lb[4];
#pragma unroll
    for (int nt = 0; nt < 4; ++nt) { const int col = wave * 64 + 16 * nt + n16; muv[nt] = mu[1024 + col]; lw[nt] = a.in[I_LNW][l * 512 + col]; lb[nt] = a.in[I_LNB][l * 512 + col]; }
    __syncthreads();
#pragma unroll 1
    for (int mt = 0; mt < 4; ++mt) {
        const int tk0 = 16 * mt + 4 * g4;
        h16 ym[4][4], yb[4][4], rv[6][4]; float b0[4], b1[4];
#pragma unroll
        for (int w = 0; w < 6; ++w) { const int m = m0 + tk0 - 1 + w; const int t = m - tok0s; const bool ok = (t >= 0) && (t < T);
#pragma unroll
            for (int nt = 0; nt < 4; ++nt) { const h16 v = RV[(size_t)(ok ? m : m0) * 512 + wave * 64 + 16 * nt + n16]; rv[w][nt] = ok ? v : (h16)0.f; } }
#pragma unroll
        for (int r = 0; r < 4; ++r) { const size_t m = (size_t)(m0 + tk0 + r); b0[r] = BSC[(m * 8 + h) * 2]; b1[r] = BSC[(m * 8 + h) * 2 + 1];
#pragma unroll
            for (int nt = 0; nt < 4; ++nt) { const int col = wave * 64 + 16 * nt + n16; ym[r][nt] = MIX[m * 1024 + 512 + col]; yb[r][nt] = Yb[m * 512 + col]; } }
        f32x4 acc[4];
#pragma unroll
        for (int nt = 0; nt < 4; ++nt) acc[nt] = (f32x4){0.f, 0.f, 0.f, 0.f};
#pragma unroll
        for (int ks = 0; ks < 4; ++ks) {
            const h16x8 af = *(const LAS h16x8a*)((const LAS unsigned char*)G + (16 * mt + n16) * 256 + (32 * ks + 8 * g4) * 2);
#pragma unroll
            for (int nt = 0; nt < 4; ++nt) acc[nt] = __builtin_amdgcn_mfma_f32_16x16x32_f16(af, bg[nt][ks], acc[nt], 0, 0, 0);
        }
#pragma unroll
        for (int r = 0; r < 4; ++r) {
            const size_t m = (size_t)(m0 + tk0 + r);
            float wkv[4]; float sm = 0.f;
#pragma unroll
            for (int nt = 0; nt < 4; ++nt) { wkv[nt] = (float)ym[r][nt] + (float)yb[r][nt]; sm += wkv[nt]; }
            const float mean = row16_sum(sm) * (1.0f / 64.0f); float sq = 0.f;
#pragma unroll
            for (int nt = 0; nt < 4; ++nt) { wkv[nt] -= mean; sq += wkv[nt] * wkv[nt]; }
            const float rstd = __builtin_amdgcn_rsqf(row16_sum(sq) * (1.0f / 64.0f) + 64e-5f); const float bsum = b0[r] + b1[r];
#pragma unroll
            for (int nt = 0; nt < 4; ++nt) { const float yn = wkv[nt] * rstd * lw[nt] + lb[nt]; const float vv = mix3(rv[r][nt], rv[r + 1][nt], rv[r + 2][nt], muv[nt]);
                MIX[m * 1024 + 512 + wave * 64 + 16 * nt + n16] = (h16)((yn + bsum * vv) * acc[nt][r]); }
        }
    }
    __syncthreads();
}

#define STAGE_ARGS const Args& args, int layer, int g, int nb, int cb, LAS unsigned char* lds
#define FRESH_TID int tid = threadIdx.x; asm volatile("" : "+v"(tid)); const int lane = tid & 63, wave = __builtin_amdgcn_readfirstlane(tid >> 6); (void)lane; (void)wave;
__device__ __forceinline__ int g_rows(int g) { return g ? MS : MP; }
__device__ __forceinline__ int g_pm0(int g) { return g ? MP / 256 : 0; }
template <class Epi> __device__ __forceinline__ void run_gemm(LAS unsigned char* lds, const h16* A, int lda, const h16* Bt, int N, int K, int g, int nb, int cb, const Epi& E, int tid) {
    pg8::Gemm gm{A, Bt, g_rows(g), N, K, lda}; pg8::StaticOrder S; S.init(g_rows(g), N, nb, cb, g_pm0(g)); pg8::gemm_phase(lds, gm, S, E, tid);
}
__device__ __forceinline__ void st_ffn_up(STAGE_ARGS, int which) {
    FRESH_TID unsigned char* ws = args.ws; const h16* W = (const h16*)(ws + WS_W);
    pg8::EpiSwiglu E{GB_ACT(g), (const float*)(ws + (which ? WS_SSA : WS_SSB))};
    run_gemm(lds, which ? GB_H16(g) : GB_H16B(g), D, W + (which ? W_FFN2U : W_FFN1U), 2 * FF, D, g, nb, cb, E, tid);
}
__device__ __forceinline__ void st_ffn_down(STAGE_ARGS, int which) {
    FRESH_TID unsigned char* ws = args.ws; const h16* W = (const h16*)(ws + WS_W); float* out = args.out;
    const bool first = (which == 0 && layer == 0);
    const float* rp = first ? args.in[I_XP] : (const float*)out; const float* rsm = first ? args.in[I_XS] - (size_t)MP * D : (const float*)out;
    pg8::EpiResid E{rp, rsm, out, GB_H16(g), (float*)(ws + WS_SSA), 0.5f};
    run_gemm(lds, GB_ACT(g), FF, W + (which ? W_FFN2D : W_FFN1D), D, FF, g, nb, cb, E, tid);
}
__device__ __forceinline__ void st_win(STAGE_ARGS) {
    FRESH_TID unsigned char* ws = args.ws; const h16* W = (const h16*)(ws + WS_W);
    pg8::EpiProj E{GB_MIX(g), GB_KNA(g), (size_t)512 * g_rows(g), GB_LOWS(g), (const float*)(ws + WS_SSA)};
    run_gemm(lds, GB_H16(g), D, W + W_IN, NPROJ, D, g, nb, cb, E, tid);
}
__device__ __forceinline__ void st_wout(STAGE_ARGS) {
    FRESH_TID unsigned char* ws = args.ws; const h16* W = (const h16*)(ws + WS_W); float* out = args.out;
    pg8::EpiResid E{out, out, out, GB_H16(g), (float*)(ws + WS_SSA), 1.0f};
    run_gemm(lds, GB_MIX(g), D, W + W_OUT, D, D, g, nb, cb, E, tid);
}
__device__ __forceinline__ void st_pu(STAGE_ARGS) {
    FRESH_TID unsigned char* ws = args.ws; const h16* W = (const h16*)(ws + WS_W);
    int kpu = PLE; asm volatile("" : "+s"(kpu));
    pg8::EpiPU E{GB_PU(g)};
    run_gemm(lds, GB_P16(g), kpu, W + W_UP, D, kpu, g, nb, cb, E, tid);
}
__device__ __forceinline__ void st_ple(STAGE_ARGS) {
    FRESH_TID unsigned char* ws = args.ws; const h16* W = (const h16*)(ws + WS_W); float* out = args.out;
    pg8::EpiPle E{out, GB_H16B(g), (float*)(ws + WS_SSB), (const float*)(ws + WS_SSA), GB_PU(g)};
    run_gemm(lds, GB_H16(g), D, W + W_GATE, D, D, g, nb, cb, E, tid);
}
__device__ __forceinline__ void st_rwpost(STAGE_ARGS) {
    FRESH_TID const int t0 = g ? MP / 64 : 0, nt_ = g_rows(g) / 64;
    h16x8 bg[4][4];
    { const float* gu = args.in[I_GUP] + (size_t)layer * 128 * 512 + (size_t)(8 * (lane >> 4)) * 512 + wave * 64 + (lane & 15);
#pragma unroll
      for (int ks = 0; ks < 4; ++ks) {
#pragma unroll
          for (int e = 0; e < 8; ++e) { const float g_0 = gu[0], g_1 = gu[16], g_2 = gu[32], g_3 = gu[48]; gu += 512; asm volatile("" : "+v"(gu));
              bg[0][ks][e] = (h16)g_0; bg[1][ks][e] = (h16)g_1; bg[2][ks][e] = (h16)g_2; bg[3][ks][e] = (h16)g_3; }
          gu += 24 * 512; asm volatile("" : "+v"(gu)); } }
    for (int tile = cb; tile < nt_; tile += nb) rwpost_tile(args, layer, t0 + tile, lds, tid, lane, wave, bg);
}
__device__ __forceinline__ void st_convp(STAGE_ARGS) { FRESH_TID convert_p(args, layer, g, nb, cb, tid); }

__device__ __forceinline__ void sub_sync(unsigned* ctr, unsigned target) {
    asm volatile("s_waitcnt vmcnt(0) lgkmcnt(0)" ::: "memory");
    __syncthreads();
    if (threadIdx.x == 0) {
        __builtin_amdgcn_fence(__ATOMIC_RELEASE, "agent"); asm volatile("s_waitcnt vmcnt(0)" ::: "memory");
        __hip_atomic_fetch_add(ctr, 1u, __ATOMIC_RELAXED, __HIP_MEMORY_SCOPE_AGENT);
        while (__hip_atomic_load(ctr, __ATOMIC_RELAXED, __HIP_MEMORY_SCOPE_AGENT) < target) __builtin_amdgcn_s_sleep(2);
    }
    __syncthreads();
    __builtin_amdgcn_fence(__ATOMIC_ACQUIRE, "agent"); asm volatile("s_waitcnt vmcnt(0)" ::: "memory");
}

constexpr int NSB = 32;
__global__ void __launch_bounds__(NTHREADS, 2) fwd_megakernel(Args args) {
    extern __shared__ __attribute__((aligned(16))) unsigned char lds_raw[];
    LAS unsigned char* lds = (LAS unsigned char*)lds_raw;
    cg::grid_group grid = cg::this_grid();
    const int bid = blockIdx.x, G = gridDim.x;
    const int NPB = G - NSB, pb = bid - NSB;
    unsigned* ctr = (unsigned*)(args.ws + WS_CTR);
    if (bid == 0 && threadIdx.x == 0) __hip_atomic_store(ctr, 0u, __ATOMIC_RELAXED, __HIP_MEMORY_SCOPE_AGENT);
    unsigned sbt = 0;
#define SUBSYNC() do { sbt += (unsigned)NPB; sub_sync(ctr, sbt); } while (0)

    for (int layer = 0; layer < 2; ++layer) {
        { FRESH_TID phase_convert(args, layer, lds, tid, lane, wave, bid, G); }
        grid_sync(grid);
        st_ffn_up(args, layer, 1, G, bid, lds, 0); grid_sync(grid);
        st_ffn_down(args, layer, 1, G, bid, lds, 0); grid_sync(grid);
        st_win(args, layer, 1, G, bid, lds); grid_sync(grid);
        if (bid < NSB) {
            FRESH_TID scan_item<4>(args, layer, bid, 0, lds, tid, lane, wave);
        } else {
            st_ffn_up(args, layer, 0, NPB, pb, lds, 0); SUBSYNC();
            st_ffn_down(args, layer, 0, NPB, pb, lds, 0); SUBSYNC();
            st_win(args, layer, 0, NPB, pb, lds); SUBSYNC();
            { FRESH_TID
              scan_item<4>(args, layer, 32 + pb, 0, lds, tid, lane, wave); __syncthreads();
              if (pb < 2 * (256 - NPB)) { scan_item<2>(args, layer, 32 + NPB + (pb >> 1), pb & 1, lds, tid, lane, wave); __syncthreads(); }
              else { for (int it = pb - 2 * (256 - NPB); it < 1536; it += NPB - 2 * (256 - NPB)) na_item(args, layer, it, lds, tid, lane, wave); } }
            SUBSYNC();
            st_rwpost(args, layer, 0, NPB, pb, lds); SUBSYNC();
            st_wout(args, layer, 0, NPB, pb, lds); SUBSYNC();
            st_ffn_up(args, layer, 0, NPB, pb, lds, 1);
        }
        grid_sync(grid);
        st_rwpost(args, layer, 1, G, bid, lds); st_ffn_down(args, layer, 0, G, bid, lds, 1); st_convp(args, layer, 0, G, bid, lds); grid_sync(grid);
        st_wout(args, layer, 1, G, bid, lds); st_pu(args, layer, 0, G, bid, lds); grid_sync(grid);
        st_ffn_up(args, layer, 1, G, bid, lds, 1); st_ple(args, layer, 0, G, bid, lds); grid_sync(grid);
        st_ffn_down(args, layer, 1, G, bid, lds, 1); st_convp(args, layer, 1, G, bid, lds); grid_sync(grid);
        st_pu(args, layer, 1, G, bid, lds); grid_sync(grid);
        st_ple(args, layer, 1, G, bid, lds); grid_sync(grid);
    }
    {
        FRESH_TID
        const float* SSB = (const float*)(args.ws + WS_SSB); float* out = args.out;
        const int gw = bid * NWAVES + wave, NGW = G * NWAVES; const f32x4* gm = (const f32x4*)args.in[I_FINAL] + lane;
        f32x4 gv[4];
#pragma unroll
        for (int j = 0; j < 4; ++j) gv[j] = gm[64 * j];
        for (int m = gw; m < M; m += 2 * NGW) {
            const int m2 = m + NGW;
            const float rs = row_rstd(SSB, m), rs2 = row_rstd(SSB, m2); f32x4* o = (f32x4*)(out + (size_t)m * D) + lane; f32x4* o2 = (f32x4*)(out + (size_t)m2 * D) + lane;
            f32x4 v[4], v2[4];
#pragma unroll
            for (int j = 0; j < 4; ++j) { v[j] = o[64 * j]; v2[j] = o2[64 * j]; }
#pragma unroll
            for (int j = 0; j < 4; ++j) { o[64 * j] = v[j] * rs * gv[j]; o2[64 * j] = v2[j] * rs2 * gv[j]; }
        }
    }
}

extern "C" void kernel_launch(void* const* d_in, const int* in_sizes, int n_in, void* d_out, int out_size, void* d_ws, size_t ws_size, hipStream_t stream) {
    static int grid = 0;
    if (grid == 0) {
        if (n_in != N_IN || out_size != M * D || ws_size < WS_END) { fprintf(stderr, "kernel_launch: unexpected shapes (n_in %d, out %d, ws %zu)\n", n_in, out_size, ws_size); grid = -1; return; }
        int dev = 0, cus = 0, per_cu = 0;
        (void)hipGetDevice(&dev); (void)hipDeviceGetAttribute(&cus, hipDeviceAttributeMultiprocessorCount, dev);
        (void)hipFuncSetAttribute((const void*)fwd_megakernel, hipFuncAttributeMaxDynamicSharedMemorySize, LDS_BYTES);
        (void)hipOccupancyMaxActiveBlocksPerMultiprocessor(&per_cu, (const void*)fwd_megakernel, NTHREADS, LDS_BYTES);
        if (per_cu < 1) fprintf(stderr, "kernel_launch: occupancy query says %d blocks per CU\n", per_cu);
        grid = cus;
        if (grid != 256) fprintf(stderr, "kernel_launch: grid %d (expected 256)\n", grid);
        if (grid <= NSB + 64) { fprintf(stderr, "kernel_launch: grid too small\n"); grid = -1; return; }
    }
    if (grid < 0) return;
    Args a{};
    for (int i = 0; i < N_IN; ++i) a.in[i] = (const float*)d_in[i];
    a.out = (float*)d_out; a.ws = (unsigned char*)d_ws;
    void* kargs[] = {&a};
    hipError_t e = hipLaunchCooperativeKernel((const void*)fwd_megakernel, dim3(grid), dim3(NTHREADS), kargs, LDS_BYTES, stream);
    if (e != hipSuccess) fprintf(stderr, "kernel_launch: cooperative launch failed: %s\n", hipGetErrorString(e));
}
```

```cpp
#include <hip/hip_runtime.h>
#include <hip/hip_cooperative_groups.h>
#include <cstdio>
#include <cstdint>
namespace cg = cooperative_groups;
#ifndef PHM
#define PHM 0xFFFF
#endif
#define PH(k) ((PHM >> (k)) & 1)

#define LAS __attribute__((address_space(3)))
typedef _Float16 h16;
typedef _Float16 h16x2 __attribute__((ext_vector_type(2)));
typedef _Float16 h16x4 __attribute__((ext_vector_type(4)));
typedef _Float16 h16x8 __attribute__((ext_vector_type(8)));
typedef _Float16 h16x8a __attribute__((ext_vector_type(8), may_alias));
typedef float f32x2 __attribute__((ext_vector_type(2)));
typedef float f32x4 __attribute__((ext_vector_type(4)));
typedef float f32x16 __attribute__((ext_vector_type(16)));
typedef unsigned u32x2 __attribute__((ext_vector_type(2)));
typedef unsigned u32x4 __attribute__((ext_vector_type(4)));
typedef unsigned u32x4a __attribute__((ext_vector_type(4), may_alias));

constexpr int D = 1024, FF = 2816, MP = 65536, MS = 32768, M = MP + MS, TP = 4096, TS = 16384, PLE = 256;
constexpr int NPROJ = 3584;
constexpr int NTHREADS = 512, NWAVES = 8;
constexpr int LDS_BYTES = 151552;
constexpr size_t MiB = 1u << 20;
constexpr size_t WS_CTR = 256;
constexpr size_t WS_W = 1 * MiB;
constexpr size_t WS_SSA = 46 * MiB;
constexpr size_t WS_SSB = 52 * MiB;
constexpr size_t REG_P = 58 * MiB, REG_S = 682 * MiB, WS_END = 994 * MiB;
constexpr size_t OFF_H16 = 0;
constexpr size_t OFF_MIX = 2048;
constexpr size_t OFF_KNA = 4096, OFF_VNA = 5120, OFF_RR = 6144, OFF_RK = 7168, OFF_RV = 8192;
constexpr size_t OFF_LOWS = 9216;
constexpr size_t OFF_ACT = 2048;
constexpr size_t OFF_P16 = 7680;
constexpr size_t OFF_PU = 2048;
constexpr size_t OFF_H16B = 7680;
constexpr size_t OFF_YB = 0, OFF_BSC = 1024;
constexpr size_t OFF_END = 9984;
static_assert(REG_P + OFF_END * MP <= REG_S && REG_S + OFF_END * MS <= WS_END, "group regions");
__device__ __forceinline__ unsigned char* gbuf(unsigned char* ws, int g, size_t off, size_t stride) {
    const size_t reg = g ? REG_S : REG_P, rows = g ? (size_t)MS : (size_t)MP, row0 = g ? (size_t)MP : 0;
    return ws + (reg + off * rows - row0 * stride);
}
#define GB_H16(g)  ((h16*)gbuf(ws, g, OFF_H16, 2048))
#define GB_H16B(g) ((h16*)gbuf(ws, g, OFF_H16B, 2048))
#define GB_MIX(g)  ((h16*)gbuf(ws, g, OFF_MIX, 2048))
#define GB_KNA(g)  ((h16*)gbuf(ws, g, OFF_KNA, 1024))
#define GB_VNA(g)  ((h16*)gbuf(ws, g, OFF_VNA, 1024))
#define GB_RR(g)   ((h16*)gbuf(ws, g, OFF_RR, 1024))
#define GB_RK(g)   ((h16*)gbuf(ws, g, OFF_RK, 1024))
#define GB_RV(g)   ((h16*)gbuf(ws, g, OFF_RV, 1024))
#define GB_LOWS(g) ((h16*)gbuf(ws, g, OFF_LOWS, 768))
#define GB_ACT(g)  ((h16*)gbuf(ws, g, OFF_ACT, 5632))
#define GB_P16(g)  ((h16*)gbuf(ws, g, OFF_P16, 512))
#define GB_PU(g)   ((h16*)gbuf(ws, g, OFF_PU, 2048))
#define GB_YB(g)   ((h16*)gbuf(ws, g, OFF_YB, 1024))
#define GB_BSC(g)  ((float*)gbuf(ws, g, OFF_BSC, 64))
constexpr size_t W_FFN1U = 0;
constexpr size_t W_FFN1D = W_FFN1U + (size_t)5632 * 1024;
constexpr size_t W_IN = W_FFN1D + (size_t)1024 * 2816;
constexpr size_t W_OUT = W_IN + (size_t)3584 * 1024;
constexpr size_t W_FFN2U = W_OUT + (size_t)1024 * 1024;
constexpr size_t W_FFN2D = W_FFN2U + (size_t)5632 * 1024;
constexpr size_t W_GATE = W_FFN2D + (size_t)1024 * 2816;
constexpr size_t W_UP = W_GATE + (size_t)1024 * 1024;
constexpr size_t W_ENDE = W_UP + (size_t)1024 * 256;
static_assert(WS_W + W_ENDE * 2 <= WS_SSA, "weights fit");

enum { I_XP = 0, I_XS, I_PP, I_PS, I_F1N, I_F1G, I_F1U, I_F1D, I_MIXN, I_WIN, I_RPB, I_MU, I_W0, I_WUP, I_A0, I_AUP, I_GUP, I_KK, I_KA, I_RK, I_LNW, I_LNB,
       I_WOUT, I_F2N, I_F2G, I_F2U, I_F2D, I_PLEN, I_PLEG, I_PLEU, I_FINAL, N_IN };
struct Args { const float* in[N_IN]; float* out; unsigned char* ws; };

__device__ __forceinline__ float wave_sum(float v) {
#pragma unroll
    for (int o = 1; o < 64; o <<= 1) v += __shfl_xor(v, o);
    return v;
}
__device__ __forceinline__ unsigned pk2h(float a, float b) { h16x2 p = {(h16)a, (h16)b}; return __builtin_bit_cast(unsigned, p); }
__device__ __forceinline__ h16x2 as_h2(unsigned u) { return __builtin_bit_cast(h16x2, u); }
__device__ __forceinline__ float dot2h(unsigned a, h16x2 b, float c) { return __builtin_amdgcn_fdot2(as_h2(a), b, c, false); }
__device__ __forceinline__ float dot8(u32x4 a, u32x4 b, float c) { const unsigned a0 = a[0], a1 = a[1], a2 = a[2], a3 = a[3], b0 = b[0], b1 = b[1], b2 = b[2], b3 = b[3];
    c = __builtin_amdgcn_fdot2(as_h2(a0), as_h2(b0), c, false); c = __builtin_amdgcn_fdot2(as_h2(a1), as_h2(b1), c, false); c = __builtin_amdgcn_fdot2(as_h2(a2), as_h2(b2), c, false); c = __builtin_amdgcn_fdot2(as_h2(a3), as_h2(b3), c, false); return c; }
__device__ __forceinline__ float dot8w(u32x4 a, h16x2 w0, h16x2 w1, h16x2 w2, h16x2 w3, float c) { const unsigned a0 = a[0], a1 = a[1], a2 = a[2], a3 = a[3];
    c = __builtin_amdgcn_fdot2(as_h2(a0), w0, c, false); c = __builtin_amdgcn_fdot2(as_h2(a1), w1, c, false); c = __builtin_amdgcn_fdot2(as_h2(a2), w2, c, false); c = __builtin_amdgcn_fdot2(as_h2(a3), w3, c, false); return c; }
__device__ __forceinline__ float fma_mix_lo(float p, unsigned v, float o) { asm("v_fma_mix_f32 %0, %1, %2, %0 op_sel_hi:[0,1,0]" : "+v"(o) : "v"(p), "v"(v)); return o; }
__device__ __forceinline__ float fma_mix_hi(float p, unsigned v, float o) { asm("v_fma_mix_f32 %0, %1, %2, %0 op_sel:[0,1,0] op_sel_hi:[0,1,0]" : "+v"(o) : "v"(p), "v"(v)); return o; }
__device__ __forceinline__ float sigmoidf_(float x) { return __builtin_amdgcn_rcpf(1.0f + __expf(-x)); }
__device__ __forceinline__ float row_rstd(const float* ss, int row) {
    const f32x4* p = (const f32x4*)(ss + (size_t)row * 16);
    const f32x4 a = p[0], b = p[1], c = p[2], d = p[3];
    const float s = ((a.x + a.y) + (a.z + a.w)) + ((b.x + b.y) + (b.z + b.w)) + ((c.x + c.y) + (c.z + c.w)) + ((d.x + d.y) + (d.z + d.w));
    return __builtin_amdgcn_rsqf(s * (1.0f / 1024.0f) + 1e-6f);
}
__device__ __forceinline__ void rows_rstd8(const float* ss, int row0, int fq, float (&rs)[2][4]) {
    f32x4 q[2][4];
#pragma unroll
    for (int ai = 0; ai < 2; ++ai)
#pragma unroll
        for (int m = 0; m < 4; ++m) q[ai][m] = *(const f32x4*)(ss + (size_t)(row0 + ai * 128 + m * 16) * 16 + 4 * fq);
#pragma unroll
    for (int ai = 0; ai < 2; ++ai)
#pragma unroll
        for (int m = 0; m < 4; ++m) { float t = (q[ai][m].x + q[ai][m].y) + (q[ai][m].z + q[ai][m].w); t += __shfl_xor(t, 16); t += __shfl_xor(t, 32); rs[ai][m] = __builtin_amdgcn_rsqf(t * (1.0f / 1024.0f) + 1e-6f); }
}
template <int CTRL> __device__ __forceinline__ float dpp_f(float v) { return __builtin_bit_cast(float, __builtin_amdgcn_update_dpp(0, __builtin_bit_cast(int, v), CTRL, 0xF, 0xF, true)); }
__device__ __forceinline__ float row16_sum(float v) {
    v += dpp_f<0xB1>(v);
    v += dpp_f<0x4E>(v);
    v += dpp_f<0x141>(v);
    v += dpp_f<0x140>(v);
    return v;
}
__device__ __forceinline__ void grid_sync(cg::grid_group& grid) {
    asm volatile("s_waitcnt vmcnt(0) lgkmcnt(0)" ::: "memory"); grid.sync();
    __builtin_amdgcn_fence(__ATOMIC_ACQUIRE, "agent"); asm volatile("s_waitcnt vmcnt(0)" ::: "memory"); }

namespace pg8 {
constexpr int BM = 256, BK = 64, HALF = 128, HTB = HALF * BK * 2, STAGE_BYTES = 8 * HTB, NXCD = 8, WGM = 8;
__host__ __device__ __forceinline__ int lds_byte(int r, int c) { const int st = (r >> 4) * 2 + (c >> 5), rr = r & 15, cc = c & 31, ob = rr * 64 + cc * 2; return st * 1024 + (ob ^ (((ob >> 9) & 1) << 5)); }
__host__ __device__ __forceinline__ void stage_rc(int b, int& R, int& C) { const int st = b / 1024, sb = b % 1024, swz = sb ^ (((sb >> 9) & 1) << 5); R = (st >> 1) * 16 + swz / 64; C = (st & 1) * 32 + (swz % 64) / 2; }
__host__ __device__ __forceinline__ int perm32(int rho) { const int n = rho >> 4, i = rho & 15; return 8 * (i >> 2) + 4 * n + (i & 3); }
struct Unit { int pm, pn; };
struct Gemm { const h16* A; const h16* Bt; int M, N, K, lda; };
struct StaticOrder {
    int nM, nN, nwg, G, c, pm0;
    __device__ void init(int M_, int N_, int G_, int c_, int pm0_) { nM = M_ / BM; nN = N_ / BM; nwg = nM * nN; G = G_; c = c_; pm0 = pm0_; }
    __device__ bool next(int i, Unit& u) const {
        const long L = (long)i * G + c; if (L >= nwg) return false;
        int wgid = (int)L; { const int q = nwg / NXCD, r = nwg % NXCD, xcd = wgid % NXCD, off = wgid / NXCD; wgid = (xcd < r ? xcd * (q + 1) : r * (q + 1) + (xcd - r) * q) + off; }
        const int nig = WGM * nN, gid = wgid / nig, fm = gid * WGM, gsz = (nM - fm) < WGM ? (nM - fm) : WGM;
        u.pm = pm0 + fm + ((wgid % nig) % gsz); u.pn = (wgid % nig) / gsz; return true;
    }
};
typedef f32x4 Acc[2][2][4][2];

template <class Epi>
__device__ __forceinline__ void gemm_phase(LAS unsigned char* lds, const Gemm g, const StaticOrder& S, const Epi& E, const int tid) {
    const int wid = __builtin_amdgcn_readfirstlane(tid >> 6), lane = tid & 63, wr = wid >> 2, wc = wid & 3, fr = lane & 15, fq = lane >> 4;
    const int K = g.K, nt = K / BK, lda = g.lda;
    unsigned voffA[2], voffB[2];
#pragma unroll
    for (int i = 0; i < 2; ++i) { int R, C; stage_rc(tid * 16 + i * 8192, R, C); const int Rb = Epi::PERM ? ((R & ~31) + perm32(R & 31)) : R;
        voffA[i] = (unsigned)(R * lda + C) * 2u; voffB[i] = (unsigned)(Rb * K + C) * 2u; }
    const size_t kstep = (size_t)(BK * 2);
    const size_t hstepA = (size_t)HALF * lda * 2, hstepB = (size_t)HALF * K * 2;
    const size_t tstepA = 2 * hstepA, tstepB = 2 * hstepB;
    const unsigned ldsw = (unsigned)wid * 1024u;
    const int aoff = lds_byte(wr * 64 + fr, fq * 8), boff = lds_byte(wc * 32 + fr, fq * 8);
#define PG8_SA(b, h) (((b) * 2 + (h)) * HTB)
#define PG8_SB(b, h) ((4 + (b) * 2 + (h)) * HTB)
#define PG8_STAGE(bufoff, gbase, voff) do { _Pragma("unroll") for (int _i = 0; _i < 2; ++_i) \
        __builtin_amdgcn_global_load_lds((const unsigned*)((const char*)(gbase) + (voff)[_i]), (LAS unsigned*)(lds + (bufoff) + ldsw + _i * 8192), 16, 0, 0); } while (0)
#define PG8_LDA(dst, b, h) do { _Pragma("unroll") for (int m = 0; m < 4; ++m) _Pragma("unroll") for (int k = 0; k < 2; ++k) dst[m][k] = *(const LAS h16x8*)(lds + PG8_SA(b, h) + aoff + m * 2048 + k * 1024); } while (0)
#define PG8_LDB(dst, b, h) do { _Pragma("unroll") for (int n = 0; n < 2; ++n) _Pragma("unroll") for (int k = 0; k < 2; ++k) dst[n][k] = *(const LAS h16x8*)(lds + PG8_SB(b, h) + boff + n * 2048 + k * 1024); } while (0)
#define PG8_MMA(ai, bj, At, Bt) do { __builtin_amdgcn_s_setprio(1); _Pragma("unroll") for (int m = 0; m < 4; ++m) _Pragma("unroll") for (int n = 0; n < 2; ++n) _Pragma("unroll") for (int k = 0; k < 2; ++k) \
        acc[ai][bj][m][n] = __builtin_amdgcn_mfma_f32_16x16x32_f16(Bt[n][k], At[m][k], acc[ai][bj][m][n], 0, 0, 0); __builtin_amdgcn_s_setprio(0); } while (0)
#define PG8_WAIT_V(n) asm volatile("s_waitcnt vmcnt(" #n ")" ::: "memory")
#define PG8_WAIT_L(n) asm volatile("s_waitcnt lgkmcnt(" #n ")" ::: "memory")
#define PG8_BAR __builtin_amdgcn_s_barrier()
#define PG8_SCHED __builtin_amdgcn_sched_barrier(0)
    Unit cur, nxt; int ui = 0;
    if (!S.next(0, cur)) return;
    f32x4 acc[2][2][4][2];
#pragma unroll
    for (int a = 0; a < 2; ++a)
#pragma unroll
        for (int b = 0; b < 2; ++b)
#pragma unroll
            for (int m = 0; m < 4; ++m)
#pragma unroll
                for (int n = 0; n < 2; ++n) acc[a][b][m][n] = (f32x4){0.f, 0.f, 0.f, 0.f};
    h16x8 At[4][2], B0[2][2], B1[2][2];
    const char* cA = (const char*)g.A + (size_t)cur.pm * tstepA; const char* cB = (const char*)g.Bt + (size_t)cur.pn * tstepB;
    PG8_STAGE(PG8_SB(0, 0), cB, voffB); PG8_STAGE(PG8_SB(0, 1), cB + hstepB, voffB); PG8_STAGE(PG8_SA(0, 0), cA, voffA); PG8_STAGE(PG8_SA(0, 1), cA + hstepA, voffA);
    if (wr == 1) PG8_BAR;
    PG8_WAIT_V(2); PG8_BAR;
    PG8_STAGE(PG8_SB(1, 0), cB + kstep, voffB); PG8_STAGE(PG8_SA(1, 0), cA + kstep, voffA); PG8_STAGE(PG8_SB(1, 1), cB + hstepB + kstep, voffB);
    PG8_WAIT_V(6); PG8_BAR;
    for (;;) {
        const bool has_next = S.next(ui + 1, nxt);
        const char* nA = has_next ? (const char*)g.A + (size_t)nxt.pm * tstepA : cA; const char* nB = has_next ? (const char*)g.Bt + (size_t)nxt.pn * tstepB : cB;
        for (int t = 0; t < nt; t += 2) {
            const bool last = (t == nt - 2);
            const char* a1 = cA + (size_t)(t + 1) * kstep;
            const char* a2 = last ? nA : cA + (size_t)(t + 2) * kstep; const char* b2 = last ? nB : cB + (size_t)(t + 2) * kstep;
            const char* a3 = a2 + kstep; const char* b3 = b2 + kstep;
            PG8_LDB(B0, 0, 0); PG8_LDB(B1, 0, 1); PG8_SCHED; PG8_LDA(At, 0, 0); PG8_STAGE(PG8_SA(1, 1), a1 + hstepA, voffA);
            PG8_WAIT_V(8); PG8_WAIT_L(0); PG8_BAR; PG8_MMA(0, 0, At, B0); PG8_MMA(0, 1, At, B1); PG8_BAR; PG8_SCHED;
            PG8_LDA(At, 0, 1); PG8_STAGE(PG8_SB(0, 0), b2, voffB); PG8_STAGE(PG8_SB(0, 1), b2 + hstepB, voffB); PG8_STAGE(PG8_SA(0, 0), a2, voffA);
            PG8_WAIT_V(8); PG8_WAIT_L(0); PG8_BAR; PG8_MMA(1, 0, At, B0); PG8_MMA(1, 1, At, B1); PG8_BAR; PG8_SCHED;
            PG8_LDB(B0, 1, 0); PG8_LDB(B1, 1, 1); PG8_SCHED; PG8_LDA(At, 1, 0); PG8_STAGE(PG8_SA(0, 1), a2 + hstepA, voffA);
            PG8_WAIT_V(8); PG8_WAIT_L(0); PG8_BAR; PG8_MMA(0, 0, At, B0); PG8_MMA(0, 1, At, B1); PG8_BAR; PG8_SCHED;
            PG8_LDA(At, 1, 1); PG8_STAGE(PG8_SB(1, 0), b3, voffB); PG8_STAGE(PG8_SB(1, 1), b3 + hstepB, voffB); PG8_STAGE(PG8_SA(1, 0), a3, voffA);
            PG8_WAIT_V(8); PG8_WAIT_L(0); PG8_BAR; PG8_MMA(1, 0, At, B0); PG8_MMA(1, 1, At, B1); PG8_BAR; PG8_SCHED;
        }
        if (wr == 0) PG8_BAR;
        E(acc, cur, wr, wc, fr, fq);
        if (!has_next) break;
#pragma unroll
        for (int a = 0; a < 2; ++a)
#pragma unroll
            for (int b = 0; b < 2; ++b)
#pragma unroll
                for (int m = 0; m < 4; ++m)
#pragma unroll
                    for (int n = 0; n < 2; ++n) acc[a][b][m][n] = (f32x4){0.f, 0.f, 0.f, 0.f};
        cur = nxt; cA = nA; cB = nB; ++ui;
        if (wr == 1) PG8_BAR;
    }
    PG8_WAIT_V(0);
    PG8_BAR;
#undef PG8_SA
#undef PG8_SB
#undef PG8_STAGE
#undef PG8_LDA
#undef PG8_LDB
#undef PG8_MMA
#undef PG8_WAIT_V
#undef PG8_WAIT_L
#undef PG8_BAR
#undef PG8_SCHED
}


struct EpiSwiglu {
    static constexpr bool PERM = true;
    h16* O; const float* ss;
    __device__ __forceinline__ void operator()(const Acc& acc, const Unit& u, int wr, int wc, int fr, int fq) const {
        const int row0 = u.pm * BM + wr * 64 + fr, col0 = u.pn * 128 + wc * 32 + 8 * fq;
        float rs8[2][4]; rows_rstd8(ss, row0, fq, rs8);
#pragma unroll
        for (int ai = 0; ai < 2; ++ai)
#pragma unroll
            for (int m = 0; m < 4; ++m) {
                const int row = row0 + ai * HALF + m * 16; const float rs = rs8[ai][m];
                float o[8];
#pragma unroll
                for (int n = 0; n < 2; ++n) {
                    const f32x4 g4 = acc[ai][0][m][n] * rs, u4 = acc[ai][1][m][n] * rs; const f32x4 x4 = g4 * (-1.4426950408889634f);
                    f32x4 e4; e4.x = __builtin_amdgcn_exp2f(x4.x); e4.y = __builtin_amdgcn_exp2f(x4.y); e4.z = __builtin_amdgcn_exp2f(x4.z); e4.w = __builtin_amdgcn_exp2f(x4.w);
                    const f32x4 d4 = e4 + 1.0f; f32x4 r4; r4.x = __builtin_amdgcn_rcpf(d4.x); r4.y = __builtin_amdgcn_rcpf(d4.y); r4.z = __builtin_amdgcn_rcpf(d4.z); r4.w = __builtin_amdgcn_rcpf(d4.w);
                    const f32x4 o4 = (g4 * u4) * r4; o[n * 4 + 0] = o4.x; o[n * 4 + 1] = o4.y; o[n * 4 + 2] = o4.z; o[n * 4 + 3] = o4.w; }
                u32x4 w; w.x = pk2h(o[0], o[1]); w.y = pk2h(o[2], o[3]); w.z = pk2h(o[4], o[5]); w.w = pk2h(o[6], o[7]);
                *(u32x4*)(O + (size_t)row * FF + col0) = w;
            }
    }
};
struct EpiResid {
    static constexpr bool PERM = false;
    const float* res_p; const float* res_s; float* out; h16* o16; float* ss; float alpha;
    __device__ __forceinline__ void operator()(const Acc& acc, const Unit& u, int wr, int wc, int fr, int fq) const {
        const int row0 = u.pm * BM + wr * 64 + fr, col0 = u.pn * BM + wc * 32 + 4 * fq;
        const float* res = (u.pm * BM < MP) ? res_p : res_s;
#pragma unroll
        for (int ai = 0; ai < 2; ++ai)
#pragma unroll
            for (int m = 0; m < 4; ++m) {
                const int row = row0 + ai * HALF + m * 16; const size_t off = (size_t)row * D + col0; float sq = 0.f;
#pragma unroll
                for (int bj = 0; bj < 2; ++bj)
#pragma unroll
                    for (int n = 0; n < 2; ++n) { const size_t o = off + bj * HALF + n * 16; const f32x4 r = *(const f32x4*)(res + o); const f32x4 v = r + acc[ai][bj][m][n] * alpha;
                        *(f32x4*)(out + o) = v; u32x2 w; w.x = pk2h(v.x, v.y); w.y = pk2h(v.z, v.w); *(u32x2*)(o16 + o) = w; sq += (v.x * v.x + v.y * v.y) + (v.z * v.z + v.w * v.w); }
                sq += __shfl_xor(sq, 16); sq += __shfl_xor(sq, 32);
                if (fq == 0) ss[(size_t)row * 16 + u.pn * 4 + wc] = sq;
                asm volatile("" ::: "memory");
            }
    }
};
struct EpiProj {
    static constexpr bool PERM = true;
    h16* mix; h16* kna; size_t bufstep; h16* lows; const float* ss;
    __device__ __forceinline__ void operator()(const Acc& acc, const Unit& u, int wr, int wc, int fr, int fq) const {
        const int pn = u.pn; h16* base; int ldc, c0; float sc = 1.f; int nbj = 2;
        if (pn < 2) { base = mix; ldc = 1024; c0 = pn * 256; sc = 0.125f; }
        else if (pn < 12) { base = kna + (size_t)((pn - 2) >> 1) * bufstep; ldc = 512; c0 = ((pn - 2) & 1) * 256; }
        else { base = lows; ldc = 384; c0 = (pn - 12) * 256; if (pn == 13) nbj = 1; }
        const int row0 = u.pm * BM + wr * 64 + fr, col0 = c0 + wc * 32 + 8 * fq;
        float rs8[2][4]; rows_rstd8(ss, row0, fq, rs8);
#pragma unroll
        for (int ai = 0; ai < 2; ++ai)
#pragma unroll
            for (int m = 0; m < 4; ++m) {
                const int row = row0 + ai * HALF + m * 16; const float rs = rs8[ai][m] * sc;
#pragma unroll
                for (int bj = 0; bj < 2; ++bj) if (bj < nbj) {
                    const f32x4 v0 = acc[ai][bj][m][0] * rs, v1 = acc[ai][bj][m][1] * rs;
                    u32x4 w; w.x = pk2h(v0.x, v0.y); w.y = pk2h(v0.z, v0.w); w.z = pk2h(v1.x, v1.y); w.w = pk2h(v1.z, v1.w);
                    *(u32x4*)(base + (size_t)row * ldc + col0 + bj * HALF) = w; }
            }
    }
};
struct EpiPU {
    static constexpr bool PERM = true;
    h16* O;
    __device__ __forceinline__ void operator()(const Acc& acc, const Unit& u, int wr, int wc, int fr, int fq) const {
        const int row0 = u.pm * BM + wr * 64 + fr, col0 = u.pn * BM + wc * 32 + 8 * fq;
#pragma unroll
        for (int ai = 0; ai < 2; ++ai)
#pragma unroll
            for (int m = 0; m < 4; ++m) {
                const int row = row0 + ai * HALF + m * 16;
#pragma unroll
                for (int bj = 0; bj < 2; ++bj) {
                    const f32x4 v0 = acc[ai][bj][m][0], v1 = acc[ai][bj][m][1];
                    u32x4 w; w.x = pk2h(v0.x, v0.y); w.y = pk2h(v0.z, v0.w); w.z = pk2h(v1.x, v1.y); w.w = pk2h(v1.z, v1.w);
                    *(u32x4*)(O + (size_t)row * D + col0 + bj * HALF) = w; }
            }
    }
};
struct EpiPle {
    static constexpr bool PERM = false;
    float* out; h16* o16; float* ssw; const float* ssr; const h16* pu;
    __device__ __forceinline__ void operator()(const Acc& acc, const Unit& u, int wr, int wc, int fr, int fq) const {
        const int row0 = u.pm * BM + wr * 64 + fr, col0 = u.pn * BM + wc * 32 + 4 * fq;
        float rs8[2][4]; rows_rstd8(ssr, row0, fq, rs8);
#pragma unroll
        for (int ai = 0; ai < 2; ++ai)
#pragma unroll
            for (int m = 0; m < 4; ++m) {
                const int row = row0 + ai * HALF + m * 16; const size_t off = (size_t)row * D + col0; float sq = 0.f; const float rs = rs8[ai][m];
#pragma unroll
                for (int bj = 0; bj < 2; ++bj)
#pragma unroll
                    for (int n = 0; n < 2; ++n) { const size_t o = off + bj * HALF + n * 16; const f32x4 r = *(const f32x4*)(out + o); const h16x4 p = *(const h16x4*)(pu + o);
                        const f32x4 a = acc[ai][bj][m][n] * rs; f32x4 v;
                        v.x = r.x + sigmoidf_(a.x) * (float)p.x; v.y = r.y + sigmoidf_(a.y) * (float)p.y; v.z = r.z + sigmoidf_(a.z) * (float)p.z; v.w = r.w + sigmoidf_(a.w) * (float)p.w;
                        *(f32x4*)(out + o) = v; u32x2 w; w.x = pk2h(v.x, v.y); w.y = pk2h(v.z, v.w); *(u32x2*)(o16 + o) = w; sq += (v.x * v.x + v.y * v.y) + (v.z * v.z + v.w * v.w); }
                sq += __shfl_xor(sq, 16); sq += __shfl_xor(sq, 32);
                if (fq == 0) ssw[(size_t)row * 16 + u.pn * 4 + wc] = sq;
                asm volatile("" ::: "memory");
            }
    }
};
}

__device__ __forceinline__ void convert_matrix(const float* W, int K, int N, const float* gamma, h16* WT, int mode, LAS float* scr, int gw, int NGW, int lane) {
    const int nblk = N / 32, nitems = (K / 64) * nblk;
    for (int item = gw; item < nitems; item += NGW) {
        const int kb = item / nblk, nb = item % nblk, k0 = 64 * kb, n0 = 32 * nb;
        const int drow0 = (mode == 0) ? n0 : ((n0 >> 7) * 256 + (n0 & 127) + (mode == 2 ? 128 : 0));
#pragma unroll 8
        for (int i = 0; i < 32; ++i) { const int kk = 2 * i + (lane >> 5); float v = W[(size_t)(k0 + kk) * N + n0 + (lane & 31)]; if (gamma) v *= gamma[k0 + kk]; scr[kk * 33 + (lane & 31)] = v; }
        asm volatile("s_waitcnt lgkmcnt(0)" ::: "memory");
        const int c = lane & 7;
#pragma unroll
        for (int j = 0; j < 4; ++j) { const int n = (lane >> 3) + 8 * j; const LAS float* s = scr + (8 * c) * 33 + n;
            u32x4 o; o.x = pk2h(s[0 * 33], s[1 * 33]); o.y = pk2h(s[2 * 33], s[3 * 33]); o.z = pk2h(s[4 * 33], s[5 * 33]); o.w = pk2h(s[6 * 33], s[7 * 33]);
            *(u32x4*)(WT + (size_t)(drow0 + n) * K + k0 + 8 * c) = o; }
        asm volatile("s_waitcnt lgkmcnt(0)" ::: "memory");
    }
}

__device__ __forceinline__ void phase_convert(const Args& a, int layer, LAS unsigned char* lds, int tid, int lane, int wave, int bid, int G) {
    LAS float* scr = (LAS float*)(lds + wave * 16384);
    const int gw = bid * NWAVES + wave, NGW = G * NWAVES;
    h16* W = (h16*)(a.ws + WS_W);
    const size_t l = (size_t)layer;
    convert_matrix(a.in[I_F1G] + l * D * FF, D, FF, a.in[I_F1N] + l * D, W + W_FFN1U, 1, scr, gw, NGW, lane);
    convert_matrix(a.in[I_F1U] + l * D * FF, D, FF, a.in[I_F1N] + l * D, W + W_FFN1U, 2, scr, gw, NGW, lane);
    convert_matrix(a.in[I_F1D] + l * FF * D, FF, D, nullptr, W + W_FFN1D, 0, scr, gw, NGW, lane);
    convert_matrix(a.in[I_WIN] + l * D * 3456, D, 3456, a.in[I_MIXN] + l * D, W + W_IN, 0, scr, gw, NGW, lane);
    convert_matrix(a.in[I_WOUT] + l * D * D, D, D, nullptr, W + W_OUT, 0, scr, gw, NGW, lane);
    convert_matrix(a.in[I_F2G] + l * D * FF, D, FF, a.in[I_F2N] + l * D, W + W_FFN2U, 1, scr, gw, NGW, lane);
    convert_matrix(a.in[I_F2U] + l * D * FF, D, FF, a.in[I_F2N] + l * D, W + W_FFN2U, 2, scr, gw, NGW, lane);
    convert_matrix(a.in[I_F2D] + l * FF * D, FF, D, nullptr, W + W_FFN2D, 0, scr, gw, NGW, lane);
    convert_matrix(a.in[I_PLEG] + l * D * D, D, D, a.in[I_PLEN] + l * D, W + W_GATE, 0, scr, gw, NGW, lane);
    convert_matrix(a.in[I_PLEU] + l * PLE * D, PLE, D, nullptr, W + W_UP, 0, scr, gw, NGW, lane);
    { u32x4* z = (u32x4*)(W + W_IN + (size_t)3456 * 1024); const int n16 = 128 * 1024 * 2 / 16;
      for (int i = bid * NTHREADS + tid; i < n16; i += G * NTHREADS) z[i] = (u32x4){0u, 0u, 0u, 0u}; }
    if (layer == 0) {
        unsigned char* ws = a.ws; h16* Hp = GB_H16B(0); h16* Hs = GB_H16B(1); float* ss = (float*)(a.ws + WS_SSB);
        for (int m = gw; m < M; m += NGW) {
            h16* H = (m < MP) ? Hp : Hs;
            const float* xr = (m < MP) ? a.in[I_XP] + (size_t)m * D : a.in[I_XS] + (size_t)(m - MP) * D;
            const f32x4* x4 = (const f32x4*)xr + lane; float s = 0.f;
            u32x2* o = (u32x2*)(H + (size_t)m * D) + lane;
#pragma unroll
            for (int j = 0; j < 4; ++j) { const f32x4 v = x4[64 * j]; s += (v.x * v.x + v.y * v.y) + (v.z * v.z + v.w * v.w); u32x2 w; w.x = pk2h(v.x, v.y); w.y = pk2h(v.z, v.w); o[64 * j] = w; }
            s = wave_sum(s);
            if (lane < 16) ss[(size_t)m * 16 + lane] = (lane == 0) ? s : 0.f;
        }
    }
}

__device__ __forceinline__ void convert_p(const Args& a, int layer, int g, int nb, int cb, int tid) {
    unsigned char* ws = a.ws; const int rows = g ? MS : MP, row0 = g ? MP : 0;
    u32x2* o = (u32x2*)(GB_P16(g) + (size_t)row0 * PLE);
    const f32x4* p = (const f32x4*)((g ? a.in[I_PS] + (size_t)layer * MS * PLE : a.in[I_PP] + (size_t)layer * MP * PLE));
    const int N4 = rows * PLE / 4;
    for (int i = cb * NTHREADS + tid; i < N4; i += nb * NTHREADS) { const f32x4 v = p[i]; u32x2 w; w.x = pk2h(v.x, v.y); w.y = pk2h(v.z, v.w); o[i] = w; }
}

constexpr int NA_PITCH = 144;
constexpr int NA_VOFF = 512 * NA_PITCH;
constexpr int NA_PP = 67;
constexpr int NA_BTOFF = 2 * 512 * NA_PITCH;
__device__ __forceinline__ void na_item(const Args& a, int layer, int item, LAS unsigned char* lds, int tid, int lane, int wave) {
    int tok0, i, rows;
    if (item < 1024) { tok0 = (item >> 6) * TP; i = item & 63; rows = 64; } else { const int it2 = item - 1024; tok0 = MP + (it2 >> 8) * TS; i = it2 & 255; rows = 256; }
    int rs = i - 4; rs = rs < 0 ? 0 : (rs > rows - 8 ? rows - 8 : rs);
    unsigned char* ws = a.ws; const int g = item < 1024 ? 0 : 1;
    h16* MIX = GB_MIX(g); const h16* KNA = GB_KNA(g); const h16* VNA = GB_VNA(g);
    const float* rpb = a.in[I_RPB] + (size_t)layer * 8 * 15 * 31;
    const int wtok0 = tok0 + rs * 64;
    const int j = lane, aw = wave;
    const int tokq = tok0 + i * 64 + j;
    int cs = j - 8; cs = cs < 0 ? 0 : (cs > 48 ? 48 : cs);
    const int l31 = lane & 31, half = lane >> 5;
    LAS float* bt = (LAS float*)(lds + NA_BTOFF) + wave * 128;
    bt[lane] = 0.f; bt[64 + lane] = 0.f;
    u32x4 kreg[8], vreg[8];
    const size_t kvoff = (size_t)(wtok0 + (tid >> 3)) * 512 + (tid & 7) * 8;
#pragma unroll
    for (int it = 0; it < 8; ++it) { kreg[it] = *(const u32x4*)(KNA + kvoff + (size_t)it * (64 * 512)); vreg[it] = *(const u32x4*)(VNA + kvoff + (size_t)it * (64 * 512)); }
#pragma unroll 1
    for (int h = 0; h < 8; ++h) {
#pragma unroll
        for (int it = 0; it < 8; ++it) { const int key = (tid >> 3) + 64 * it, ch = tid & 7;
            *(LAS u32x4*)(lds + key * NA_PITCH + ch * 16) = kreg[it]; *(LAS u32x4*)(lds + NA_VOFF + key * NA_PITCH + ch * 16) = vreg[it]; }
        h16x8 qf[2][4];
#pragma unroll
        for (int nt = 0; nt < 2; ++nt)
#pragma unroll
            for (int ks = 0; ks < 4; ++ks) qf[nt][ks] = *(const h16x8*)(MIX + (size_t)(tok0 + i * 64 + l31 + 32 * nt) * 1024 + h * 64 + 16 * ks + 8 * half);
        if (lane < 31) bt[48 + lane] = rpb[((size_t)h * 15 + (rs + aw - i + 7)) * 31 + lane];
        __syncthreads();
        if (h + 1 < 8) {
#pragma unroll
            for (int it = 0; it < 8; ++it) { kreg[it] = *(const u32x4*)(KNA + kvoff + (size_t)it * (64 * 512) + (h + 1) * 64); vreg[it] = *(const u32x4*)(VNA + kvoff + (size_t)it * (64 * 512) + (h + 1) * 64); }
        }
        f32x16 acc[2][2];
#pragma unroll
        for (int mt = 0; mt < 2; ++mt)
#pragma unroll
            for (int nt = 0; nt < 2; ++nt)
#pragma unroll
                for (int r = 0; r < 16; ++r) acc[mt][nt][r] = 0.f;
#pragma unroll
        for (int mt = 0; mt < 2; ++mt)
#pragma unroll
            for (int ks = 0; ks < 4; ++ks) {
                const h16x8 kf = *(const LAS h16x8*)(lds + (aw * 64 + 32 * mt + l31) * NA_PITCH + (16 * ks + 8 * half) * 2);
                acc[mt][0] = __builtin_amdgcn_mfma_f32_32x32x16_f16(kf, qf[0][ks], acc[mt][0], 0, 0, 0);
                acc[mt][1] = __builtin_amdgcn_mfma_f32_32x32x16_f16(kf, qf[1][ks], acc[mt][1], 0, 0, 0);
            }
        float mxq[2], lq[2];
#pragma unroll
        for (int nt = 0; nt < 2; ++nt) {
            const int qc = l31 + 32 * nt; int csq = qc - 8; csq = csq < 0 ? 0 : (csq > 48 ? 48 : csq);
            const int dlt = 4 * half - csq;
            const LAS float* bq = bt + (48 + 15 + 4 * half - qc - 32);
            float m = -3.0e38f;
#pragma unroll
            for (int mt = 0; mt < 2; ++mt)
#pragma unroll
                for (int r = 0; r < 16; ++r) { const int kr = (r & 3) + 8 * (r >> 2) + 32 * mt;
                    const float sv = acc[mt][nt][r] + bq[32 + kr]; const bool ok = (unsigned)(dlt + kr) < 16u; const float sm = ok ? sv : -1.0e30f; acc[mt][nt][r] = sm; m = fmaxf(m, sm); }
            { const auto sw = __builtin_amdgcn_permlane32_swap(__builtin_bit_cast(unsigned, m), __builtin_bit_cast(unsigned, m), false, false); const unsigned s0 = sw[0], s1 = sw[1]; m = fmaxf(__builtin_bit_cast(float, s0), __builtin_bit_cast(float, s1)); }
            float l = 0.f;
#pragma unroll
            for (int mt = 0; mt < 2; ++mt)
#pragma unroll
                for (int r = 0; r < 16; ++r) { const float p = __expf(acc[mt][nt][r] - m); acc[mt][nt][r] = p; l += p; }
            { const auto sw = __builtin_amdgcn_permlane32_swap(__builtin_bit_cast(unsigned, l), __builtin_bit_cast(unsigned, l), false, false); const unsigned s0 = sw[0], s1 = sw[1]; l = __builtin_bit_cast(float, s0) + __builtin_bit_cast(float, s1); }
            mxq[nt] = m; lq[nt] = l;
        }
        h16x8 pf[2][2][2];
#pragma unroll
        for (int kt = 0; kt < 2; ++kt)
#pragma unroll
            for (int nt = 0; nt < 2; ++nt)
#pragma unroll
                for (int sx = 0; sx < 2; ++sx)
#pragma unroll
                    for (int e = 0; e < 8; ++e) pf[kt][nt][sx][e] = (h16)acc[kt][nt][8 * sx + e];
        f32x16 o[2][2];
#pragma unroll
        for (int dm = 0; dm < 2; ++dm)
#pragma unroll
            for (int nt = 0; nt < 2; ++nt)
#pragma unroll
                for (int r = 0; r < 16; ++r) o[dm][nt][r] = 0.f;
#pragma unroll
        for (int dm = 0; dm < 2; ++dm)
#pragma unroll
            for (int kt = 0; kt < 2; ++kt)
#pragma unroll
                for (int sx = 0; sx < 2; ++sx) {
                    h16x8 vf;
                    const LAS unsigned char* vb = lds + NA_VOFF + (aw * 64 + 32 * kt + 16 * sx + 4 * half) * NA_PITCH + (l31 + 32 * dm) * 2;
#pragma unroll
                    for (int e = 0; e < 8; ++e) vf[e] = *(const LAS h16*)(vb + ((e & 3) + 8 * (e >> 2)) * NA_PITCH);
                    o[dm][0] = __builtin_amdgcn_mfma_f32_32x32x16_f16(vf, pf[kt][0][sx], o[dm][0], 0, 0, 0);
                    o[dm][1] = __builtin_amdgcn_mfma_f32_32x32x16_f16(vf, pf[kt][1][sx], o[dm][1], 0, 0, 0);
                }
        __syncthreads();
#pragma unroll
        for (int nt = 0; nt < 2; ++nt) {
            LAS float* part = (LAS float*)lds + (size_t)(aw * 64 + l31 + 32 * nt) * NA_PP;
#pragma unroll
            for (int dm = 0; dm < 2; ++dm)
#pragma unroll
                for (int r = 0; r < 16; ++r) part[(r & 3) + 8 * (r >> 2) + 4 * half + 32 * dm] = o[dm][nt][r];
            if (half == 0) { part[64] = mxq[nt]; part[65] = lq[nt]; }
        }
        __syncthreads();
        {
            const int jq = tid & 63, e8 = tid >> 6;
            float mw[8], M_ = -3.0e38f;
#pragma unroll
            for (int w = 0; w < 8; ++w) { mw[w] = ((const LAS float*)lds)[(size_t)(w * 64 + jq) * NA_PP + 64]; M_ = fmaxf(M_, mw[w]); }
            float L = 0.f, ov[8];
#pragma unroll
            for (int e = 0; e < 8; ++e) ov[e] = 0.f;
#pragma unroll
            for (int w = 0; w < 8; ++w) { const float f = __expf(mw[w] - M_); const LAS float* pw = (const LAS float*)lds + (size_t)(w * 64 + jq) * NA_PP; L += f * pw[65];
#pragma unroll
                for (int e = 0; e < 8; ++e) ov[e] += f * pw[e8 * 8 + e]; }
            const float inv = 1.0f / L;
            u32x4 w4; w4.x = pk2h(ov[0] * inv, ov[1] * inv); w4.y = pk2h(ov[2] * inv, ov[3] * inv); w4.z = pk2h(ov[4] * inv, ov[5] * inv); w4.w = pk2h(ov[6] * inv, ov[7] * inv);
            *(u32x4*)(MIX + (size_t)(tok0 + i * 64 + jq) * 1024 + h * 64 + e8 * 8) = w4;
        }
        __syncthreads();
    }
}

__device__ __forceinline__ float shiftmix(const h16* base, size_t stride, int t, int T, float mu) {
    const float c = (float)base[0];
    const float p = (t > 0) ? (float)*(base - stride) : 0.f;
    const float n = (t < T - 1) ? (float)*(base + stride) : 0.f;
    return c + mu * (0.5f * (p + n) - c);
}
constexpr int SC_CH = 32;
constexpr int SC_OPB = SC_CH * 6 * 64 * 4;
constexpr int SC_YOFF = 2 * SC_OPB;
constexpr int SC_YB = SC_CH * 64 * 4;
constexpr int SC_XOFF = SC_YOFF + 2 * SC_YB;
constexpr int SC_ZOFF = SC_XOFF + 8192;
static_assert(SC_ZOFF + 4 * 4096 <= LDS_BYTES, "scan LDS");
__device__ __forceinline__ float wave_sum_fast(float v) {
    v = row16_sum(v);
    { const auto r = __builtin_amdgcn_permlane16_swap(__builtin_bit_cast(unsigned, v), __builtin_bit_cast(unsigned, v), false, false);
      const unsigned r0 = r[0], r1 = r[1]; v = __builtin_bit_cast(float, r0) + __builtin_bit_cast(float, r1); }
    { const auto r = __builtin_amdgcn_permlane32_swap(__builtin_bit_cast(unsigned, v), __builtin_bit_cast(unsigned, v), false, false);
      const unsigned r0 = r[0], r1 = r[1]; v = __builtin_bit_cast(float, r0) + __builtin_bit_cast(float, r1); }
    return v;
}
__device__ __forceinline__ float mix3(h16 p, h16 c, h16 n, float mu) { const float cf = (float)c; return cf + mu * (0.5f * ((float)p + (float)n) - cf); }
struct ScanWin { float r[10], k[10], v[10], wl[10], al[10]; };
struct ScanWinRaw { h16 r[10], k[10], v[10], wl[10], al[10]; };
__device__ __forceinline__ float mix3f(float p, float c, float n, float mu) { return c + mu * (0.5f * (p + n) - c); }
template <int R>
__device__ __forceinline__ void scan_flush(LAS unsigned char* lds, int cf, int pw, int lane, int d, int T, int tok0, int h, int rowbase, h16* Yf, h16* Yb) {
    const LAS float* yb = (const LAS float*)(lds + SC_YOFF + (cf & 1) * SC_YB);
    const int s = pw * 8 + (lane >> 3); const int g = cf * SC_CH + s; const int t = d ? (T - 1 - g) : g;
    if (R == 4) {
        const int r8 = (lane & 7) * 8;
        const f32x4 y0 = *(const LAS f32x4*)(yb + s * 64 + r8), y1 = *(const LAS f32x4*)(yb + s * 64 + r8 + 4);
        u32x4 w4; w4.x = pk2h(y0.x, y0.y); w4.y = pk2h(y0.z, y0.w); w4.z = pk2h(y1.x, y1.y); w4.w = pk2h(y1.z, y1.w);
        if (d == 0) *(u32x4*)(Yf + (size_t)(tok0 + t) * 1024 + 512 + h * 64 + r8) = w4; else *(u32x4*)(Yb + (size_t)(tok0 + t) * 512 + h * 64 + r8) = w4;
    } else {
        const int r4 = (lane & 7) * 4;
        const f32x4 y0 = *(const LAS f32x4*)(yb + s * 32 + r4);
        u32x2 w2; w2.x = pk2h(y0.x, y0.y); w2.y = pk2h(y0.z, y0.w);
        if (d == 0) *(u32x2*)(Yf + (size_t)(tok0 + t) * 1024 + 512 + h * 64 + rowbase + r4) = w2; else *(u32x2*)(Yb + (size_t)(tok0 + t) * 512 + h * 64 + rowbase + r4) = w2;
    }
}
template <int R>
__device__ __forceinline__ void scan_item(const Args& a, int layer, int q, int rowhalf, LAS unsigned char* lds, int tid, int lane, int wave) {
    int tok0, T, h, d;
    if (q < 32) { tok0 = MP + (q >> 4) * TS; T = TS; h = (q >> 1) & 7; d = q & 1; } else { const int q2 = q - 32; tok0 = (q2 >> 4) * TP; T = TP; h = (q2 >> 1) & 7; d = q2 & 1; }
    const int nch = T / SC_CH, rowbase = rowhalf * 16 * R;
    unsigned char* ws = a.ws; const int g = q < 32 ? 1 : 0;
    const h16* RR = GB_RR(g); const h16* RK = GB_RK(g); const h16* RV = GB_RV(g); const h16* LOWS = GB_LOWS(g);
    h16* Yf = GB_MIX(g); h16* Yb = GB_YB(g); float* BSC = GB_BSC(g);
    const size_t l = (size_t)layer;
    if (wave >= 4) {
        const int pw = wave - 4, j = lane, col = h * 64 + j;
        const float* mu = a.in[I_MU] + l * 1920;
        const float mu_r = mu[col], mu_k = mu[512 + col], mu_v = mu[1024 + col], mu_wl = mu[1536 + d * 64 + j], mu_al = mu[1536 + 128 + d * 64 + j];
        const float k_k = a.in[I_KK][l * 512 + col], k_a = a.in[I_KA][l * 512 + col], r_k = a.in[I_RK][l * 512 + col];
        const float w0 = a.in[I_W0][(l * 2 + d) * 512 + col], a0 = a.in[I_A0][(l * 2 + d) * 512 + col];
        h16x8 bw[4][2], ba[4][2];
        { const int n = lane & 15, kg = lane >> 4;
          const float* wu = a.in[I_WUP] + ((l * 2 + d) * 64 + 8 * kg) * 512 + h * 64 + n; const float* au = a.in[I_AUP] + ((l * 2 + d) * 64 + 8 * kg) * 512 + h * 64 + n;
#pragma unroll
          for (int ks = 0; ks < 2; ++ks) {
#pragma unroll
              for (int e = 0; e < 8; ++e) {
                  const float w_0 = wu[0], w_1 = wu[16], w_2 = wu[32], w_3 = wu[48], a_0 = au[0], a_1 = au[16], a_2 = au[32], a_3 = au[48];
                  wu += 512; au += 512; asm volatile("" : "+v"(wu), "+v"(au));
                  bw[0][ks][e] = (h16)w_0; bw[1][ks][e] = (h16)w_1; bw[2][ks][e] = (h16)w_2; bw[3][ks][e] = (h16)w_3;
                  ba[0][ks][e] = (h16)a_0; ba[1][ks][e] = (h16)a_1; ba[2][ks][e] = (h16)a_2; ba[3][ks][e] = (h16)a_3; }
              wu += 24 * 512; au += 24 * 512; asm volatile("" : "+v"(wu), "+v"(au)); } }
        LAS float* zl = (LAS float*)(lds + SC_ZOFF + pw * 4096);
        LAS unsigned char* xsb = lds + SC_XOFF + pw * 2048;
        ScanWin cur; ScanWinRaw nxt;
#define SCAN_LOAD_RAW(cp_) do { const int g0_ = (cp_) * SC_CH + pw * 8; \
            _Pragma("unroll") for (int w = 0; w < 10; ++w) { int tt = d ? (T - 1 - g0_) + 1 - w : g0_ - 1 + w; tt = tt < 0 ? 0 : (tt > T - 1 ? T - 1 : tt); const size_t tok = (size_t)(tok0 + tt); \
                nxt.r[w] = RR[tok * 512 + col]; nxt.k[w] = RK[tok * 512 + col]; nxt.v[w] = RV[tok * 512 + col]; nxt.wl[w] = LOWS[tok * 384 + d * 64 + j]; nxt.al[w] = LOWS[tok * 384 + 128 + d * 64 + j]; } } while (0)
#define SCAN_UNPACK(cp_) do { const int g0_ = (cp_) * SC_CH + pw * 8; \
            _Pragma("unroll") for (int w = 0; w < 10; ++w) { const int tt = d ? (T - 1 - g0_) + 1 - w : g0_ - 1 + w; const bool ok = (tt >= 0) && (tt < T); \
                cur.r[w] = ok ? (float)nxt.r[w] : 0.f; cur.k[w] = ok ? (float)nxt.k[w] : 0.f; cur.v[w] = ok ? (float)nxt.v[w] : 0.f; cur.wl[w] = ok ? (float)nxt.wl[w] : 0.f; cur.al[w] = ok ? (float)nxt.al[w] : 0.f; } } while (0)
        SCAN_LOAD_RAW(0); SCAN_UNPACK(0);
        for (int c = -1; c < nch; ++c) {
            if (c >= 1) scan_flush<R>(lds, c - 1, pw, lane, d, T, tok0, h, rowbase, Yf, Yb);
            if (c + 1 < nch) {
                const int cp = c + 1; LAS float* op = (LAS float*)(lds + (cp & 1) * SC_OPB);
                if (c + 2 < nch) SCAN_LOAD_RAW(c + 2);
                float bsv = 0.f;
#pragma unroll
                for (int s8 = 0; s8 < 8; ++s8) {
                    const float wl = mix3f(cur.wl[s8], cur.wl[s8 + 1], cur.wl[s8 + 2], mu_wl);
                    const float al = mix3f(cur.al[s8], cur.al[s8 + 1], cur.al[s8 + 2], mu_al);
                    const float e2 = __expf(2.0f * wl); const float th = 1.0f - 2.0f * __builtin_amdgcn_rcpf(e2 + 1.0f);
                    LAS h16* xs = (LAS h16*)(xsb + s8 * 256);
                    xs[j] = (h16)th; xs[64 + j] = (h16)al;
                }
                {
                    const LAS unsigned char* xr = xsb + (lane & 7) * 256 + (lane >> 4) * 16;
                    const h16x8 xw0 = *(const LAS h16x8a*)(xr), xw1 = *(const LAS h16x8a*)(xr + 64), xa0 = *(const LAS h16x8a*)(xr + 128), xa1 = *(const LAS h16x8a*)(xr + 192);
                    f32x4 accw[4], acca[4];
#pragma unroll
                    for (int nt = 0; nt < 4; ++nt) {
                        accw[nt] = __builtin_amdgcn_mfma_f32_16x16x32_f16(xw0, bw[nt][0], (f32x4){0.f, 0.f, 0.f, 0.f}, 0, 0, 0);
                        accw[nt] = __builtin_amdgcn_mfma_f32_16x16x32_f16(xw1, bw[nt][1], accw[nt], 0, 0, 0);
                        acca[nt] = __builtin_amdgcn_mfma_f32_16x16x32_f16(xa0, ba[nt][0], (f32x4){0.f, 0.f, 0.f, 0.f}, 0, 0, 0);
                        acca[nt] = __builtin_amdgcn_mfma_f32_16x16x32_f16(xa1, ba[nt][1], acca[nt], 0, 0, 0); }
                    if (lane < 32) {
                        LAS float* zw = zl + (4 * (lane >> 4)) * 64 + (lane & 15);
#pragma unroll
                        for (int nt = 0; nt < 4; ++nt)
#pragma unroll
                            for (int r = 0; r < 4; ++r) { zw[r * 64 + 16 * nt] = accw[nt][r]; zw[512 + r * 64 + 16 * nt] = acca[nt][r]; }
                    }
                }
#pragma unroll
                for (int s8 = 0; s8 < 8; ++s8) {
                    const int s = pw * 8 + s8; const int g = cp * SC_CH + s; const int t = d ? (T - 1 - g) : g; const size_t tok = (size_t)(tok0 + t);
                    const float rr = mix3f(cur.r[s8], cur.r[s8 + 1], cur.r[s8 + 2], mu_r);
                    const float kk0 = mix3f(cur.k[s8], cur.k[s8 + 1], cur.k[s8 + 2], mu_k);
                    const float vv = mix3f(cur.v[s8], cur.v[s8 + 1], cur.v[s8 + 2], mu_v);
                    const float z = w0 + zl[s8 * 64 + j], az = a0 + zl[512 + s8 * 64 + j];
                    const float wdec = __expf(-0.606531f * sigmoidf_(z)); const float av = sigmoidf_(az);
                    float kk = kk0 * k_k; const float n2 = wave_sum_fast(kk * kk); kk = kk * __builtin_amdgcn_rsqf(fmaxf(n2, 1e-24f));
                    const float kd = kk0 * (1.0f + (av - 1.0f) * k_a); const float bb = kk * av;
                    const float bs = wave_sum_fast(rr * kd * r_k);
                    bsv = (lane == s8) ? bs : bsv;
                    LAS float* o = op + s * 384 + j;
                    o[0] = -kk; o[64] = wdec; o[128] = bb; o[192] = kd; o[256] = rr; o[320] = vv;
                }
                if (lane < 8 && rowhalf == 0) { const int gs = cp * SC_CH + pw * 8 + lane; const int t = d ? (T - 1 - gs) : gs; BSC[((size_t)(tok0 + t) * 8 + h) * 2 + d] = bsv; }
                if (c + 2 < nch) SCAN_UNPACK(c + 2);
            }
            __syncthreads();
        }
        scan_flush<R>(lds, nch - 1, pw, lane, d, T, tok0, h, rowbase, Yf, Yb);
#undef SCAN_LOAD_RAW
#undef SCAN_UNPACK
    } else {
        constexpr int RL = R / 2;
        const int ri = lane >> 3, ci = lane & 7;
        const int yrow = wave * 8 * RL + ri * RL, vrow = rowbase + yrow;
        f32x2 S[RL][4];
#pragma unroll
        for (int i = 0; i < RL; ++i)
#pragma unroll
            for (int c2 = 0; c2 < 4; ++c2) S[i][c2] = (f32x2){0.f, 0.f};
        typedef float vecR __attribute__((ext_vector_type(RL)));
        __syncthreads();
        for (int c = 0; c < nch; ++c) {
            const LAS f32x4* op = (const LAS f32x4*)(lds + (c & 1) * SC_OPB);
            LAS float* yb = (LAS float*)(lds + SC_YOFF + (c & 1) * SC_YB);
            f32x4 a0 = op[2 * ci], a1 = op[2 * ci + 1], w0 = op[16 + 2 * ci], w1 = op[17 + 2 * ci], b0 = op[32 + 2 * ci], b1 = op[33 + 2 * ci];
            f32x4 k0 = op[48 + 2 * ci], k1 = op[49 + 2 * ci], r0 = op[64 + 2 * ci], r1 = op[65 + 2 * ci]; vecR v4 = *(const LAS vecR*)((const LAS float*)op + 320 + vrow);
#pragma unroll 4
            for (int s = 0; s < SC_CH; ++s) {
                const LAS f32x4* on = op + (s + 1) * 96;
                const f32x4 na0 = on[2 * ci], na1 = on[2 * ci + 1], nw0 = on[16 + 2 * ci], nw1 = on[17 + 2 * ci], nb0 = on[32 + 2 * ci], nb1 = on[33 + 2 * ci];
                const f32x4 nk0 = on[48 + 2 * ci], nk1 = on[49 + 2 * ci], nr0 = on[64 + 2 * ci], nr1 = on[65 + 2 * ci]; const vecR nv4 = *(const LAS vecR*)((const LAS float*)on + 320 + vrow);
                const f32x2 av[4] = {{a0.x, a0.y}, {a0.z, a0.w}, {a1.x, a1.y}, {a1.z, a1.w}}, wv[4] = {{w0.x, w0.y}, {w0.z, w0.w}, {w1.x, w1.y}, {w1.z, w1.w}};
                const f32x2 bv[4] = {{b0.x, b0.y}, {b0.z, b0.w}, {b1.x, b1.y}, {b1.z, b1.w}}, kv[4] = {{k0.x, k0.y}, {k0.z, k0.w}, {k1.x, k1.y}, {k1.z, k1.w}};
                const f32x2 rv[4] = {{r0.x, r0.y}, {r0.z, r0.w}, {r1.x, r1.y}, {r1.z, r1.w}};
                float sa[RL];
#pragma unroll
                for (int i = 0; i < RL; ++i) { f32x2 p = S[i][0] * av[0]; p = S[i][1] * av[1] + p; p = S[i][2] * av[2] + p; p = S[i][3] * av[3] + p;
                    float t = p.x + p.y; t += dpp_f<0xB1>(t); t += dpp_f<0x4E>(t); t += dpp_f<0x141>(t); sa[i] = t; }
                vecR y;
#pragma unroll
                for (int i = 0; i < RL; ++i) { const f32x2 sa2 = {sa[i], sa[i]}, v2 = {v4[i], v4[i]};
#pragma unroll
                    for (int c2 = 0; c2 < 4; ++c2) S[i][c2] = S[i][c2] * wv[c2] + sa2 * bv[c2] + v2 * kv[c2];
                    f32x2 p = S[i][0] * rv[0]; p = S[i][1] * rv[1] + p; p = S[i][2] * rv[2] + p; p = S[i][3] * rv[3] + p;
                    float t = p.x + p.y; t += dpp_f<0xB1>(t); t += dpp_f<0x4E>(t); t += dpp_f<0x141>(t); y[i] = t; }
                if (ci == 0) *(LAS vecR*)(yb + s * (32 * RL) + yrow) = y;
                a0 = na0; a1 = na1; w0 = nw0; w1 = nw1; b0 = nb0; b1 = nb1; k0 = nk0; k1 = nk1; r0 = nr0; r1 = nr1; v4 = nv4;
            }
            __syncthreads();
        }
    }
}

__device__ __forceinline__ void rwpost_tile(const Args& a, int layer, int tile, LAS unsigned char* lds, int tid, int lane, int wave, const h16x8 (&bg)[4][4]) {
    const size_t l = (size_t)layer; const int h = wave, n16 = lane & 15, g4 = lane >> 4;
    const int m0 = tile * 64; int tok0s, T; if (m0 < MP) { T = TP; tok0s = (m0 / TP) * TP; } else { T = TS; tok0s = MP + ((m0 - MP) / TS) * TS; }
    unsigned char* ws = a.ws; const int g = m0 < MP ? 0 : 1;
    const h16* LOWS = GB_LOWS(g); const h16* RV = GB_RV(g); h16* MIX = GB_MIX(g); const h16* Yb = GB_YB(g); const float* BSC = GB_BSC(g);
    const float* mu = a.in[I_MU] + l * 1920;
    LAS h16* G = (LAS h16*)lds;
    { const int c = tid & 127; const float mug = mu[1536 + 256 + c];
#pragma unroll 8
      for (int e = tid; e < 64 * 128; e += NTHREADS) { const int tk = e >> 7; const int m = m0 + tk; const int t = m - tok0s;
        const float gl = shiftmix(LOWS + (size_t)m * 384 + 256 + c, 384, t, T, mug); G[e] = (h16)sigmoidf_(gl); } }
    float muv[4], lw[4], lb[4];
#pragma unroll
    for (int nt = 0; nt < 4; ++nt) { const int col = wave * 64 + 16 * nt + n16; muv[nt] = mu[1024 + col]; lw[nt] = a.in[I_LNW][l * 512 + col]; lb[nt] = a.in[I_LNB][l * 512 + col]; }
    __syncthreads();
#pragma unroll 1
    for (int mt = 0; mt < 4; ++mt) {
        const int tk0 = 16 * mt + 4 * g4;
        h16 ym[4][4], yb[4][4], rv[6][4]; float b0[4], b1[4];
#pragma unroll
        for (int w = 0; w < 6; ++w) { const int m = m0 + tk0 - 1 + w; const int t = m - tok0s; const bool ok = (t >= 0) && (t < T);
#pragma unroll
            for (int nt = 0; nt < 4; ++nt) { const h16 v = RV[(size_t)(ok ? m : m0) * 512 + wave * 64 + 16 * nt + n16]; rv[w][nt] = ok ? v : (h16)0.f; } }
#pragma unroll
        for (int r = 0; r < 4; ++r) { const size_t m = (size_t)(m0 + tk0 + r); b0[r] = BSC[(m * 8 + h) * 2]; b1[r] = BSC[(m * 8 + h) * 2 + 1];
#pragma unroll
            for (int nt = 0; nt < 4; ++nt) { const int col = wave * 64 + 16 * nt + n16; ym[r][nt] = MIX[m * 1024 + 512 + col]; yb[r][nt] = Yb[m * 512 + col]; } }
        f32x4 acc[4];
#pragma unroll
        for (int nt = 0; nt < 4; ++nt) acc[nt] = (f32x4){0.f, 0.f, 0.f, 0.f};
#pragma unroll
        for (int ks = 0; ks < 4; ++ks) {
            const h16x8 af = *(const LAS h16x8a*)((const LAS unsigned char*)G + (16 * mt + n16) * 256 + (32 * ks + 8 * g4) * 2);
#pragma unroll
            for (int nt = 0; nt < 4; ++nt) acc[nt] = __builtin_amdgcn_mfma_f32_16x16x32_f16(af, bg[nt][ks], acc[nt], 0, 0, 0);
        }
#pragma unroll
        for (int r = 0; r < 4; ++r) {
            const size_t m = (size_t)(m0 + tk0 + r);
            float wkv[4]; float sm = 0.f;
#pragma unroll
            for (int nt = 0; nt < 4; ++nt) { wkv[nt] = (float)ym[r][nt] + (float)yb[r][nt]; sm += wkv[nt]; }
            const float mean = row16_sum(sm) * (1.0f / 64.0f); float sq = 0.f;
#pragma unroll
            for (int nt = 0; nt < 4; ++nt) { wkv[nt] -= mean; sq += wkv[nt] * wkv[nt]; }
            const float rstd = __builtin_amdgcn_rsqf(row16_sum(sq) * (1.0f / 64.0f) + 64e-5f); const float bsum = b0[r] + b1[r];
#pragma unroll
            for (int nt = 0; nt < 4; ++nt) { const float yn = wkv[nt] * rstd * lw[nt] + lb[nt]; const float vv = mix3(rv[r][nt], rv[r + 1][nt], rv[r + 2][nt], muv[nt]);
                MIX[m * 1024 + 512 + wave * 64 + 16 * nt + n16] = (h16)((yn + bsum * vv) * acc[nt][r]); }
        }
    }
    __syncthreads();
}

#define STAGE_ARGS const Args& args, int layer, int g, int nb, int cb, LAS unsigned char* lds
#define FRESH_TID int tid = threadIdx.x; asm volatile("" : "+v"(tid)); const int lane = tid & 63, wave = __builtin_amdgcn_readfirstlane(tid >> 6); (void)lane; (void)wave;
__device__ __forceinline__ int g_rows(int g) { return g ? MS : MP; }
__device__ __forceinline__ int g_pm0(int g) { return g ? MP / 256 : 0; }
template <class Epi> __device__ __forceinline__ void run_gemm(LAS unsigned char* lds, const h16* A, int lda, const h16* Bt, int N, int K, int g, int nb, int cb, const Epi& E, int tid) {
    pg8::Gemm gm{A, Bt, g_rows(g), N, K, lda}; pg8::StaticOrder S; S.init(g_rows(g), N, nb, cb, g_pm0(g)); pg8::gemm_phase(lds, gm, S, E, tid);
}
__device__ __forceinline__ void st_ffn_up(STAGE_ARGS, int which) {
    FRESH_TID unsigned char* ws = args.ws; const h16* W = (const h16*)(ws + WS_W);
    pg8::EpiSwiglu E{GB_ACT(g), (const float*)(ws + (which ? WS_SSA : WS_SSB))};
    run_gemm(lds, which ? GB_H16(g) : GB_H16B(g), D, W + (which ? W_FFN2U : W_FFN1U), 2 * FF, D, g, nb, cb, E, tid);
}
__device__ __forceinline__ void st_ffn_down(STAGE_ARGS, int which) {
    FRESH_TID unsigned char* ws = args.ws; const h16* W = (const h16*)(ws + WS_W); float* out = args.out;
    const bool first = (which == 0 && layer == 0);
    const float* rp = first ? args.in[I_XP] : (const float*)out; const float* rsm = first ? args.in[I_XS] - (size_t)MP * D : (const float*)out;
    pg8::EpiResid E{rp, rsm, out, GB_H16(g), (float*)(ws + WS_SSA), 0.5f};
    run_gemm(lds, GB_ACT(g), FF, W + (which ? W_FFN2D : W_FFN1D), D, FF, g, nb, cb, E, tid);
}
__device__ __forceinline__ void st_win(STAGE_ARGS) {
    FRESH_TID unsigned char* ws = args.ws; const h16* W = (const h16*)(ws + WS_W);
    pg8::EpiProj E{GB_MIX(g), GB_KNA(g), (size_t)512 * g_rows(g), GB_LOWS(g), (const float*)(ws + WS_SSA)};
    run_gemm(lds, GB_H16(g), D, W + W_IN, NPROJ, D, g, nb, cb, E, tid);
}
__device__ __forceinline__ void st_wout(STAGE_ARGS) {
    FRESH_TID unsigned char* ws = args.ws; const h16* W = (const h16*)(ws + WS_W); float* out = args.out;
    pg8::EpiResid E{out, out, out, GB_H16(g), (float*)(ws + WS_SSA), 1.0f};
    run_gemm(lds, GB_MIX(g), D, W + W_OUT, D, D, g, nb, cb, E, tid);
}
__device__ __forceinline__ void st_pu(STAGE_ARGS) {
    FRESH_TID unsigned char* ws = args.ws; const h16* W = (const h16*)(ws + WS_W);
    int kpu = PLE; asm volatile("" : "+s"(kpu));
    pg8::EpiPU E{GB_PU(g)};
    run_gemm(lds, GB_P16(g), kpu, W + W_UP, D, kpu, g, nb, cb, E, tid);
}
__device__ __forceinline__ void st_ple(STAGE_ARGS) {
    FRESH_TID unsigned char* ws = args.ws; const h16* W = (const h16*)(ws + WS_W); float* out = args.out;
    pg8::EpiPle E{out, GB_H16B(g), (float*)(ws + WS_SSB), (const float*)(ws + WS_SSA), GB_PU(g)};
    run_gemm(lds, GB_H16(g), D, W + W_GATE, D, D, g, nb, cb, E, tid);
}
__device__ __forceinline__ void st_rwpost(STAGE_ARGS) {
    FRESH_TID const int t0 = g ? MP / 64 : 0, nt_ = g_rows(g) / 64;
    h16x8 bg[4][4];
    { const float* gu = args.in[I_GUP] + (size_t)layer * 128 * 512 + (size_t)(8 * (lane >> 4)) * 512 + wave * 64 + (lane & 15);
#pragma unroll
      for (int ks = 0; ks < 4; ++ks) {
#pragma unroll
          for (int e = 0; e < 8; ++e) { const float g_0 = gu[0], g_1 = gu[16], g_2 = gu[32], g_3 = gu[48]; gu += 512; asm volatile("" : "+v"(gu));
              bg[0][ks][e] = (h16)g_0; bg[1][ks][e] = (h16)g_1; bg[2][ks][e] = (h16)g_2; bg[3][ks][e] = (h16)g_3; }
          gu += 24 * 512; asm volatile("" : "+v"(gu)); } }
    for (int tile = cb; tile < nt_; tile += nb) rwpost_tile(args, layer, t0 + tile, lds, tid, lane, wave, bg);
}
__device__ __forceinline__ void st_convp(STAGE_ARGS) { FRESH_TID convert_p(args, layer, g, nb, cb, tid); }

__device__ __forceinline__ void sub_sync(unsigned* ctr, unsigned target) {
    asm volatile("s_waitcnt vmcnt(0) lgkmcnt(0)" ::: "memory");
    __syncthreads();
    if (threadIdx.x == 0) {
        __builtin_amdgcn_fence(__ATOMIC_RELEASE, "agent"); asm volatile("s_waitcnt vmcnt(0)" ::: "memory");
        __hip_atomic_fetch_add(ctr, 1u, __ATOMIC_RELAXED, __HIP_MEMORY_SCOPE_AGENT);
        while (__hip_atomic_load(ctr, __ATOMIC_RELAXED, __HIP_MEMORY_SCOPE_AGENT) < target) __builtin_amdgcn_s_sleep(2);
    }
    __syncthreads();
    __builtin_amdgcn_fence(__ATOMIC_ACQUIRE, "agent"); asm volatile("s_waitcnt vmcnt(0)" ::: "memory");
}

constexpr int NSB = 32;
__global__ void __launch_bounds__(NTHREADS, 2) fwd_megakernel(Args args) {
    extern __shared__ __attribute__((aligned(16))) unsigned char lds_raw[];
    LAS unsigned char* lds = (LAS unsigned char*)lds_raw;
    cg::grid_group grid = cg::this_grid();
    const int bid = blockIdx.x, G = gridDim.x;
    const int NPB = G - NSB, pb = bid - NSB;
    unsigned* ctr = (unsigned*)(args.ws + WS_CTR);
    if (bid == 0 && threadIdx.x == 0) __hip_atomic_store(ctr, 0u, __ATOMIC_RELAXED, __HIP_MEMORY_SCOPE_AGENT);
    unsigned sbt = 0;
#define SUBSYNC() do { sbt += (unsigned)NPB; sub_sync(ctr, sbt); } while (0)

    for (int layer = 0; layer < 2; ++layer) {
        { FRESH_TID phase_convert(args, layer, lds, tid, lane, wave, bid, G); }
        grid_sync(grid);
        st_ffn_up(args, layer, 1, G, bid, lds, 0); grid_sync(grid);
        st_ffn_down(args, layer, 1, G, bid, lds, 0); grid_sync(grid);
        st_win(args, layer, 1, G, bid, lds); grid_sync(grid);
        if (bid < NSB) {
            FRESH_TID scan_item<4>(args, layer, bid, 0, lds, tid, lane, wave);
        } else {
            st_ffn_up(args, layer, 0, NPB, pb, lds, 0); SUBSYNC();
            st_ffn_down(args, layer, 0, NPB, pb, lds, 0); SUBSYNC();
            st_win(args, layer, 0, NPB, pb, lds); SUBSYNC();
            { FRESH_TID
              scan_item<4>(args, layer, 32 + pb, 0, lds, tid, lane, wave); __syncthreads();
              if (pb < 2 * (256 - NPB)) { scan_item<2>(args, layer, 32 + NPB + (pb >> 1), pb & 1, lds, tid, lane, wave); __syncthreads(); }
              else { for (int it = pb - 2 * (256 - NPB); it < 1536; it += NPB - 2 * (256 - NPB)) na_item(args, layer, it, lds, tid, lane, wave); } }
            SUBSYNC();
            st_rwpost(args, layer, 0, NPB, pb, lds); SUBSYNC();
            st_wout(args, layer, 0, NPB, pb, lds); SUBSYNC();
            st_ffn_up(args, layer, 0, NPB, pb, lds, 1);
        }
        grid_sync(grid);
        st_rwpost(args, layer, 1, G, bid, lds); st_ffn_down(args, layer, 0, G, bid, lds, 1); st_convp(args, layer, 0, G, bid, lds); grid_sync(grid);
        st_wout(args, layer, 1, G, bid, lds); st_pu(args, layer, 0, G, bid, lds); grid_sync(grid);
        st_ffn_up(args, layer, 1, G, bid, lds, 1); st_ple(args, layer, 0, G, bid, lds); grid_sync(grid);
        st_ffn_down(args, layer, 1, G, bid, lds, 1); st_convp(args, layer, 1, G, bid, lds); grid_sync(grid);
        st_pu(args, layer, 1, G, bid, lds); grid_sync(grid);
        st_ple(args, layer, 1, G, bid, lds); grid_sync(grid);
    }
    {
        FRESH_TID
        const float* SSB = (const float*)(args.ws + WS_SSB); float* out = args.out;
        const int gw = bid * NWAVES + wave, NGW = G * NWAVES; const f32x4* gm = (const f32x4*)args.in[I_FINAL] + lane;
        f32x4 gv[4];
#pragma unroll
        for (int j = 0; j < 4; ++j) gv[j] = gm[64 * j];
        for (int m = gw; m < M; m += 2 * NGW) {
            const int m2 = m + NGW;
            const float rs = row_rstd(SSB, m), rs2 = row_rstd(SSB, m2); f32x4* o = (f32x4*)(out + (size_t)m * D) + lane; f32x4* o2 = (f32x4*)(out + (size_t)m2 * D) + lane;
            f32x4 v[4], v2[4];
#pragma unroll
            for (int j = 0; j < 4; ++j) { v[j] = o[64 * j]; v2[j] = o2[64 * j]; }
#pragma unroll
            for (int j = 0; j < 4; ++j) { o[64 * j] = v[j] * rs * gv[j]; o2[64 * j] = v2[j] * rs2 * gv[j]; }
        }
    }
}

extern "C" void kernel_launch(void* const* d_in, const int* in_sizes, int n_in, void* d_out, int out_size, void* d_ws, size_t ws_size, hipStream_t stream) {
    static int grid = 0;
    if (grid == 0) {
        if (n_in != N_IN || out_size != M * D || ws_size < WS_END) { fprintf(stderr, "kernel_launch: unexpected shapes (n_in %d, out %d, ws %zu)\n", n_in, out_size, ws_size); grid = -1; return; }
        int dev = 0, cus = 0, per_cu = 0;
        (void)hipGetDevice(&dev); (void)hipDeviceGetAttribute(&cus, hipDeviceAttributeMultiprocessorCount, dev);
        (void)hipFuncSetAttribute((const void*)fwd_megakernel, hipFuncAttributeMaxDynamicSharedMemorySize, LDS_BYTES);
        (void)hipOccupancyMaxActiveBlocksPerMultiprocessor(&per_cu, (const void*)fwd_megakernel, NTHREADS, LDS_BYTES);
        if (per_cu < 1) fprintf(stderr, "kernel_launch: occupancy query says %d blocks per CU\n", per_cu);
        grid = cus;
        if (grid != 256) fprintf(stderr, "kernel_launch: grid %d (expected 256)\n", grid);
        if (grid <= NSB + 64) { fprintf(stderr, "kernel_launch: grid too small\n"); grid = -1; return; }
    }
    if (grid < 0) return;
    Args a{};
    for (int i = 0; i < N_IN; ++i) a.in[i] = (const float*)d_in[i];
    a.out = (float*)d_out; a.ws = (unsigned char*)d_ws;
    void* kargs[] = {&a};
    hipError_t e = hipLaunchCooperativeKernel((const void*)fwd_megakernel, dim3(grid), dim3(NTHREADS), kargs, LDS_BYTES, stream);
    if (e != hipSuccess) fprintf(stderr, "kernel_launch: cooperative launch failed: %s\n", hipGetErrorString(e));
}
```

```cpp
#include <hip/hip_runtime.h>
#include <hip/hip_cooperative_groups.h>
#include <cstdio>
#include <cstdint>
namespace cg = cooperative_groups;
#ifndef PHM
#define PHM 0xFFFF
#endif
#define PH(k) ((PHM >> (k)) & 1)

#define LAS __attribute__((address_space(3)))
typedef _Float16 h16;
typedef _Float16 h16x2 __attribute__((ext_vector_type(2)));
typedef _Float16 h16x4 __attribute__((ext_vector_type(4)));
typedef _Float16 h16x8 __attribute__((ext_vector_type(8)));
typedef _Float16 h16x8a __attribute__((ext_vector_type(8), may_alias));
typedef float f32x2 __attribute__((ext_vector_type(2)));
typedef float f32x4 __attribute__((ext_vector_type(4)));
typedef float f32x16 __attribute__((ext_vector_type(16)));
typedef unsigned u32x2 __attribute__((ext_vector_type(2)));
typedef unsigned u32x4 __attribute__((ext_vector_type(4)));
typedef unsigned u32x4a __attribute__((ext_vector_type(4), may_alias));

constexpr int D = 1024, FF = 2816, MP = 65536, MS = 32768, M = MP + MS, TP = 4096, TS = 16384, PLE = 256;
constexpr int NPROJ = 3584;
constexpr int NTHREADS = 512, NWAVES = 8;
constexpr int LDS_BYTES = 151552;
constexpr size_t MiB = 1u << 20;
constexpr size_t WS_CTR = 256;
constexpr size_t WS_W = 1 * MiB;
constexpr size_t WS_SSA = 46 * MiB;
constexpr size_t WS_SSB = 52 * MiB;
constexpr size_t REG_P = 58 * MiB, REG_S = 682 * MiB, WS_END = 994 * MiB;
constexpr size_t OFF_H16 = 0;
constexpr size_t OFF_MIX = 2048;
constexpr size_t OFF_KNA = 4096, OFF_VNA = 5120, OFF_RR = 6144, OFF_RK = 7168, OFF_RV = 8192;
constexpr size_t OFF_LOWS = 9216;
constexpr size_t OFF_ACT = 2048;
constexpr size_t OFF_P16 = 7680;
constexpr size_t OFF_PU = 2048;
constexpr size_t OFF_H16B = 7680;
constexpr size_t OFF_YB = 0, OFF_BSC = 1024;
constexpr size_t OFF_END = 9984;
static_assert(REG_P + OFF_END * MP <= REG_S && REG_S + OFF_END * MS <= WS_END, "group regions");
__device__ __forceinline__ unsigned char* gbuf(unsigned char* ws, int g, size_t off, size_t stride) {
    const size_t reg = g ? REG_S : REG_P, rows = g ? (size_t)MS : (size_t)MP, row0 = g ? (size_t)MP : 0;
    return ws + (reg + off * rows - row0 * stride);
}
#define GB_H16(g)  ((h16*)gbuf(ws, g, OFF_H16, 2048))
#define GB_H16B(g) ((h16*)gbuf(ws, g, OFF_H16B, 2048))
#define GB_MIX(g)  ((h16*)gbuf(ws, g, OFF_MIX, 2048))
#define GB_KNA(g)  ((h16*)gbuf(ws, g, OFF_KNA, 1024))
#define GB_VNA(g)  ((h16*)gbuf(ws, g, OFF_VNA, 1024))
#define GB_RR(g)   ((h16*)gbuf(ws, g, OFF_RR, 1024))
#define GB_RK(g)   ((h16*)gbuf(ws, g, OFF_RK, 1024))
#define GB_RV(g)   ((h16*)gbuf(ws, g, OFF_RV, 1024))
#define GB_LOWS(g) ((h16*)gbuf(ws, g, OFF_LOWS, 768))
#define GB_ACT(g)  ((h16*)gbuf(ws, g, OFF_ACT, 5632))
#define GB_P16(g)  ((h16*)gbuf(ws, g, OFF_P16, 512))
#define GB_PU(g)   ((h16*)gbuf(ws, g, OFF_PU, 2048))
#define GB_YB(g)   ((h16*)gbuf(ws, g, OFF_YB, 1024))
#define GB_BSC(g)  ((float*)gbuf(ws, g, OFF_BSC, 64))
constexpr size_t W_FFN1U = 0;
constexpr size_t W_FFN1D = W_FFN1U + (size_t)5632 * 1024;
constexpr size_t W_IN = W_FFN1D + (size_t)1024 * 2816;
constexpr size_t W_OUT = W_IN + (size_t)3584 * 1024;
constexpr size_t W_FFN2U = W_OUT + (size_t)1024 * 1024;
constexpr size_t W_FFN2D = W_FFN2U + (size_t)5632 * 1024;
constexpr size_t W_GATE = W_FFN2D + (size_t)1024 * 2816;
constexpr size_t W_UP = W_GATE + (size_t)1024 * 1024;
constexpr size_t W_ENDE = W_UP + (size_t)1024 * 256;
static_assert(WS_W + W_ENDE * 2 <= WS_SSA, "weights fit");

enum { I_XP = 0, I_XS, I_PP, I_PS, I_F1N, I_F1G, I_F1U, I_F1D, I_MIXN, I_WIN, I_RPB, I_MU, I_W0, I_WUP, I_A0, I_AUP, I_GUP, I_KK, I_KA, I_RK, I_LNW, I_LNB,
       I_WOUT, I_F2N, I_F2G, I_F2U, I_F2D, I_PLEN, I_PLEG, I_PLEU, I_FINAL, N_IN };
struct Args { const float* in[N_IN]; float* out; unsigned char* ws; };

__device__ __forceinline__ float wave_sum(float v) {
#pragma unroll
    for (int o = 1; o < 64; o <<= 1) v += __shfl_xor(v, o);
    return v;
}
__device__ __forceinline__ unsigned pk2h(float a, float b) { h16x2 p = {(h16)a, (h16)b}; return __builtin_bit_cast(unsigned, p); }
__device__ __forceinline__ h16x2 as_h2(unsigned u) { return __builtin_bit_cast(h16x2, u); }
__device__ __forceinline__ float dot2h(unsigned a, h16x2 b, float c) { return __builtin_amdgcn_fdot2(as_h2(a), b, c, false); }
__device__ __forceinline__ float dot8(u32x4 a, u32x4 b, float c) { const unsigned a0 = a[0], a1 = a[1], a2 = a[2], a3 = a[3], b0 = b[0], b1 = b[1], b2 = b[2], b3 = b[3];
    c = __builtin_amdgcn_fdot2(as_h2(a0), as_h2(b0), c, false); c = __builtin_amdgcn_fdot2(as_h2(a1), as_h2(b1), c, false); c = __builtin_amdgcn_fdot2(as_h2(a2), as_h2(b2), c, false); c = __builtin_amdgcn_fdot2(as_h2(a3), as_h2(b3), c, false); return c; }
__device__ __forceinline__ float dot8w(u32x4 a, h16x2 w0, h16x2 w1, h16x2 w2, h16x2 w3, float c) { const unsigned a0 = a[0], a1 = a[1], a2 = a[2], a3 = a[3];
    c = __builtin_amdgcn_fdot2(as_h2(a0), w0, c, false); c = __builtin_amdgcn_fdot2(as_h2(a1), w1, c, false); c = __builtin_amdgcn_fdot2(as_h2(a2), w2, c, false); c = __builtin_amdgcn_fdot2(as_h2(a3), w3, c, false); return c; }
__device__ __forceinline__ float fma_mix_lo(float p, unsigned v, float o) { asm("v_fma_mix_f32 %0, %1, %2, %0 op_sel_hi:[0,1,0]" : "+v"(o) : "v"(p), "v"(v)); return o; }
__device__ __forceinline__ float fma_mix_hi(float p, unsigned v, float o) { asm("v_fma_mix_f32 %0, %1, %2, %0 op_sel:[0,1,0] op_sel_hi:[0,1,0]" : "+v"(o) : "v"(p), "v"(v)); return o; }
__device__ __forceinline__ float sigmoidf_(float x) { return __builtin_amdgcn_rcpf(1.0f + __expf(-x)); }
__device__ __forceinline__ float row_rstd(const float* ss, int row) {
    const f32x4* p = (const f32x4*)(ss + (size_t)row * 16);
    const f32x4 a = p[0], b = p[1], c = p[2], d = p[3];
    const float s = ((a.x + a.y) + (a.z + a.w)) + ((b.x + b.y) + (b.z + b.w)) + ((c.x + c.y) + (c.z + c.w)) + ((d.x + d.y) + (d.z + d.w));
    return __builtin_amdgcn_rsqf(s * (1.0f / 1024.0f) + 1e-6f);
}
__device__ __forceinline__ void rows_rstd8(const float* ss, int row0, int fq, float (&rs)[2][4]) {
    f32x4 q[2][4];
#pragma unroll
    for (int ai = 0; ai < 2; ++ai)
#pragma unroll
        for (int m = 0; m < 4; ++m) q[ai][m] = *(const f32x4*)(ss + (size_t)(row0 + ai * 128 + m * 16) * 16 + 4 * fq);
#pragma unroll
    for (int ai = 0; ai < 2; ++ai)
#pragma unroll
        for (int m = 0; m < 4; ++m) { float t = (q[ai][m].x + q[ai][m].y) + (q[ai][m].z + q[ai][m].w); t += __shfl_xor(t, 16); t += __shfl_xor(t, 32); rs[ai][m] = __builtin_amdgcn_rsqf(t * (1.0f / 1024.0f) + 1e-6f); }
}
template <int CTRL> __device__ __forceinline__ float dpp_f(float v) { return __builtin_bit_cast(float, __builtin_amdgcn_update_dpp(0, __builtin_bit_cast(int, v), CTRL, 0xF, 0xF, true)); }
__device__ __forceinline__ float row16_sum(float v) {
    v += dpp_f<0xB1>(v);
    v += dpp_f<0x4E>(v);
    v += dpp_f<0x141>(v);
    v += dpp_f<0x140>(v);
    return v;
}
__device__ __forceinline__ void grid_sync(cg::grid_group& grid) {
    asm volatile("s_waitcnt vmcnt(0) lgkmcnt(0)" ::: "memory"); grid.sync();
    __builtin_amdgcn_fence(__ATOMIC_ACQUIRE, "agent"); asm volatile("s_waitcnt vmcnt(0)" ::: "memory"); }

namespace pg8 {
constexpr int BM = 256, BK = 64, HALF = 128, HTB = HALF * BK * 2, STAGE_BYTES = 8 * HTB, NXCD = 8, WGM = 8;
__host__ __device__ __forceinline__ int lds_byte(int r, int c) { const int st = (r >> 4) * 2 + (c >> 5), rr = r & 15, cc = c & 31, ob = rr * 64 + cc * 2; return st * 1024 + (ob ^ (((ob >> 9) & 1) << 5)); }
__host__ __device__ __forceinline__ void stage_rc(int b, int& R, int& C) { const int st = b / 1024, sb = b % 1024, swz = sb ^ (((sb >> 9) & 1) << 5); R = (st >> 1) * 16 + swz / 64; C = (st & 1) * 32 + (swz % 64) / 2; }
__host__ __device__ __forceinline__ int perm32(int rho) { const int n = rho >> 4, i = rho & 15; return 8 * (i >> 2) + 4 * n + (i & 3); }
struct Unit { int pm, pn; };
struct Gemm { const h16* A; const h16* Bt; int M, N, K, lda; };
struct StaticOrder {
    int nM, nN, nwg, G, c, pm0;
    __device__ void init(int M_, int N_, int G_, int c_, int pm0_) { nM = M_ / BM; nN = N_ / BM; nwg = nM * nN; G = G_; c = c_; pm0 = pm0_; }
    __device__ bool next(int i, Unit& u) const {
        const long L = (long)i * G + c; if (L >= nwg) return false;
        int wgid = (int)L; { const int q = nwg / NXCD, r = nwg % NXCD, xcd = wgid % NXCD, off = wgid / NXCD; wgid = (xcd < r ? xcd * (q + 1) : r * (q + 1) + (xcd - r) * q) + off; }
        const int nig = WGM * nN, gid = wgid / nig, fm = gid * WGM, gsz = (nM - fm) < WGM ? (nM - fm) : WGM;
        u.pm = pm0 + fm + ((wgid % nig) % gsz); u.pn = (wgid % nig) / gsz; return true;
    }
};
typedef f32x4 Acc[2][2][4][2];

template <class Epi>
__device__ __forceinline__ void gemm_phase(LAS unsigned char* lds, const Gemm g, const StaticOrder& S, const Epi& E, const int tid) {
    const int wid = __builtin_amdgcn_readfirstlane(tid >> 6), lane = tid & 63, wr = wid >> 2, wc = wid & 3, fr = lane & 15, fq = lane >> 4;
    const int K = g.K, nt = K / BK, lda = g.lda;
    unsigned voffA[2], voffB[2];
#pragma unroll
    for (int i = 0; i < 2; ++i) { int R, C; stage_rc(tid * 16 + i * 8192, R, C); const int Rb = Epi::PERM ? ((R & ~31) + perm32(R & 31)) : R;
        voffA[i] = (unsigned)(R * lda + C) * 2u; voffB[i] = (unsigned)(Rb * K + C) * 2u; }
    const size_t kstep = (size_t)(BK * 2);
    const size_t hstepA = (size_t)HALF * lda * 2, hstepB = (size_t)HALF * K * 2;
    const size_t tstepA = 2 * hstepA, tstepB = 2 * hstepB;
    const unsigned ldsw = (unsigned)wid * 1024u;
    const int aoff = lds_byte(wr * 64 + fr, fq * 8), boff = lds_byte(wc * 32 + fr, fq * 8);
#define PG8_SA(b, h) (((b) * 2 + (h)) * HTB)
#define PG8_SB(b, h) ((4 + (b) * 2 + (h)) * HTB)
#define PG8_STAGE(bufoff, gbase, voff) do { _Pragma("unroll") for (int _i = 0; _i < 2; ++_i) \
        __builtin_amdgcn_global_load_lds((const unsigned*)((const char*)(gbase) + (voff)[_i]), (LAS unsigned*)(lds + (bufoff) + ldsw + _i * 8192), 16, 0, 0); } while (0)
#define PG8_LDA(dst, b, h) do { _Pragma("unroll") for (int m = 0; m < 4; ++m) _Pragma("unroll") for (int k = 0; k < 2; ++k) dst[m][k] = *(const LAS h16x8*)(lds + PG8_SA(b, h) + aoff + m * 2048 + k * 1024); } while (0)
#define PG8_LDB(dst, b, h) do { _Pragma("unroll") for (int n = 0; n < 2; ++n) _Pragma("unroll") for (int k = 0; k < 2; ++k) dst[n][k] = *(const LAS h16x8*)(lds + PG8_SB(b, h) + boff + n * 2048 + k * 1024); } while (0)
#define PG8_MMA(ai, bj, At, Bt) do { __builtin_amdgcn_s_setprio(1); _Pragma("unroll") for (int m = 0; m < 4; ++m) _Pragma("unroll") for (int n = 0; n < 2; ++n) _Pragma("unroll") for (int k = 0; k < 2; ++k) \
        acc[ai][bj][m][n] = __builtin_amdgcn_mfma_f32_16x16x32_f16(Bt[n][k], At[m][k], acc[ai][bj][m][n], 0, 0, 0); __builtin_amdgcn_s_setprio(0); } while (0)
#define PG8_WAIT_V(n) asm volatile("s_waitcnt vmcnt(" #n ")" ::: "memory")
#define PG8_WAIT_L(n) asm volatile("s_waitcnt lgkmcnt(" #n ")" ::: "memory")
#define PG8_BAR __builtin_amdgcn_s_barrier()
#define PG8_SCHED __builtin_amdgcn_sched_barrier(0)
    Unit cur, nxt; int ui = 0;
    if (!S.next(0, cur)) return;
    f32x4 acc[2][2][4][2];
#pragma unroll
    for (int a = 0; a < 2; ++a)
#pragma unroll
        for (int b = 0; b < 2; ++b)
#pragma unroll
            for (int m = 0; m < 4; ++m)
#pragma unroll
                for (int n = 0; n < 2; ++n) acc[a][b][m][n] = (f32x4){0.f, 0.f, 0.f, 0.f};
    h16x8 At[4][2], B0[2][2], B1[2][2];
    const char* cA = (const char*)g.A + (size_t)cur.pm * tstepA; const char* cB = (const char*)g.Bt + (size_t)cur.pn * tstepB;
    PG8_STAGE(PG8_SB(0, 0), cB, voffB); PG8_STAGE(PG8_SB(0, 1), cB + hstepB, voffB); PG8_STAGE(PG8_SA(0, 0), cA, voffA); PG8_STAGE(PG8_SA(0, 1), cA + hstepA, voffA);
    if (wr == 1) PG8_BAR;
    PG8_WAIT_V(2); PG8_BAR;
    PG8_STAGE(PG8_SB(1, 0), cB + kstep, voffB); PG8_STAGE(PG8_SA(1, 0), cA + kstep, voffA); PG8_STAGE(PG8_SB(1, 1), cB + hstepB + kstep, voffB);
    PG8_WAIT_V(6); PG8_BAR;
    for (;;) {
        const bool has_next = S.next(ui + 1, nxt);
        const char* nA = has_next ? (const char*)g.A + (size_t)nxt.pm * tstepA : cA; const char* nB = has_next ? (const char*)g.Bt + (size_t)nxt.pn * tstepB : cB;
        for (int t = 0; t < nt; t += 2) {
            const bool last = (t == nt - 2);
            const char* a1 = cA + (size_t)(t + 1) * kstep;
            const char* a2 = last ? nA : cA + (size_t)(t + 2) * kstep; const char* b2 = last ? nB : cB + (size_t)(t + 2) * kstep;
            const char* a3 = a2 + kstep; const char* b3 = b2 + kstep;
            PG8_LDB(B0, 0, 0); PG8_LDB(B1, 0, 1); PG8_SCHED; PG8_LDA(At, 0, 0); PG8_STAGE(PG8_SA(1, 1), a1 + hstepA, voffA);
            PG8_WAIT_V(8); PG8_WAIT_L(0); PG8_BAR; PG8_MMA(0, 0, At, B0); PG8_MMA(0, 1, At, B1); PG8_BAR; PG8_SCHED;
            PG8_LDA(At, 0, 1); PG8_STAGE(PG8_SB(0, 0), b2, voffB); PG8_STAGE(PG8_SB(0, 1), b2 + hstepB, voffB); PG8_STAGE(PG8_SA(0, 0), a2, voffA);
            PG8_WAIT_V(8); PG8_WAIT_L(0); PG8_BAR; PG8_MMA(1, 0, At, B0); PG8_MMA(1, 1, At, B1); PG8_BAR; PG8_SCHED;
            PG8_LDB(B0, 1, 0); PG8_LDB(B1, 1, 1); PG8_SCHED; PG8_LDA(At, 1, 0); PG8_STAGE(PG8_SA(0, 1), a2 + hstepA, voffA);
            PG8_WAIT_V(8); PG8_WAIT_L(0); PG8_BAR; PG8_MMA(0, 0, At, B0); PG8_MMA(0, 1, At, B1); PG8_BAR; PG8_SCHED;
            PG8_LDA(At, 1, 1); PG8_STAGE(PG8_SB(1, 0), b3, voffB); PG8_STAGE(PG8_SB(1, 1), b3 + hstepB, voffB); PG8_STAGE(PG8_SA(1, 0), a3, voffA);
            PG8_WAIT_V(8); PG8_WAIT_L(0); PG8_BAR; PG8_MMA(1, 0, At, B0); PG8_MMA(1, 1, At, B1); PG8_BAR; PG8_SCHED;
        }
        if (wr == 0) PG8_BAR;
        E(acc, cur, wr, wc, fr, fq);
        if (!has_next) break;
#pragma unroll
        for (int a = 0; a < 2; ++a)
#pragma unroll
            for (int b = 0; b < 2; ++b)
#pragma unroll
                for (int m = 0; m < 4; ++m)
#pragma unroll
                    for (int n = 0; n < 2; ++n) acc[a][b][m][n] = (f32x4){0.f, 0.f, 0.f, 0.f};
        cur = nxt; cA = nA; cB = nB; ++ui;
        if (wr == 1) PG8_BAR;
    }
    PG8_WAIT_V(0);
    PG8_BAR;
#undef PG8_SA
#undef PG8_SB
#undef PG8_STAGE
#undef PG8_LDA
#undef PG8_LDB
#undef PG8_MMA
#undef PG8_WAIT_V
#undef PG8_WAIT_L
#undef PG8_BAR
#undef PG8_SCHED
}


struct EpiSwiglu {
    static constexpr bool PERM = true;
    h16* O; const float* ss;
    __device__ __forceinline__ void operator()(const Acc& acc, const Unit& u, int wr, int wc, int fr, int fq) const {
        const int row0 = u.pm * BM + wr * 64 + fr, col0 = u.pn * 128 + wc * 32 + 8 * fq;
        float rs8[2][4]; rows_rstd8(ss, row0, fq, rs8);
#pragma unroll
        for (int ai = 0; ai < 2; ++ai)
#pragma unroll
            for (int m = 0; m < 4; ++m) {
                const int row = row0 + ai * HALF + m * 16; const float rs = rs8[ai][m];
                float o[8];
#pragma unroll
                for (int n = 0; n < 2; ++n) {
                    const f32x4 g4 = acc[ai][0][m][n] * rs, u4 = acc[ai][1][m][n] * rs; const f32x4 x4 = g4 * (-1.4426950408889634f);
                    f32x4 e4; e4.x = __builtin_amdgcn_exp2f(x4.x); e4.y = __builtin_amdgcn_exp2f(x4.y); e4.z = __builtin_amdgcn_exp2f(x4.z); e4.w = __builtin_amdgcn_exp2f(x4.w);
                    const f32x4 d4 = e4 + 1.0f; f32x4 r4; r4.x = __builtin_amdgcn_rcpf(d4.x); r4.y = __builtin_amdgcn_rcpf(d4.y); r4.z = __builtin_amdgcn_rcpf(d4.z); r4.w = __builtin_amdgcn_rcpf(d4.w);
                    const f32x4 o4 = (g4 * u4) * r4; o[n * 4 + 0] = o4.x; o[n * 4 + 1] = o4.y; o[n * 4 + 2] = o4.z; o[n * 4 + 3] = o4.w; }
                u32x4 w; w.x = pk2h(o[0], o[1]); w.y = pk2h(o[2], o[3]); w.z = pk2h(o[4], o[5]); w.w = pk2h(o[6], o[7]);
                *(u32x4*)(O + (size_t)row * FF + col0) = w;
            }
    }
};
struct EpiResid {
    static constexpr bool PERM = false;
    const float* res_p; const float* res_s; float* out; h16* o16; float* ss; float alpha;
    __device__ __forceinline__ void operator()(const Acc& acc, const Unit& u, int wr, int wc, int fr, int fq) const {
        const int row0 = u.pm * BM + wr * 64 + fr, col0 = u.pn * BM + wc * 32 + 4 * fq;
        const float* res = (u.pm * BM < MP) ? res_p : res_s;
        f32x4 rc[4], rn[4];
#pragma unroll
        for (int k = 0; k < 4; ++k) rc[k] = *(const f32x4*)(res + (size_t)row0 * D + col0 + (k >> 1) * HALF + (k & 1) * 16);
#pragma unroll
        for (int i = 0; i < 8; ++i) {
            const int ai = i >> 2, m = i & 3;
            const int row = row0 + ai * HALF + m * 16; const size_t off = (size_t)row * D + col0; float sq = 0.f;
            if (i + 1 < 8) { const size_t offn = (size_t)(row0 + ((i + 1) >> 2) * HALF + ((i + 1) & 3) * 16) * D + col0;
#pragma unroll
                for (int k = 0; k < 4; ++k) rn[k] = *(const f32x4*)(res + offn + (k >> 1) * HALF + (k & 1) * 16); }
#pragma unroll
            for (int bj = 0; bj < 2; ++bj)
#pragma unroll
                for (int n = 0; n < 2; ++n) { const size_t o = off + bj * HALF + n * 16; const f32x4 v = rc[bj * 2 + n] + acc[ai][bj][m][n] * alpha;
                    *(f32x4*)(out + o) = v; u32x2 w; w.x = pk2h(v.x, v.y); w.y = pk2h(v.z, v.w); *(u32x2*)(o16 + o) = w; sq += (v.x * v.x + v.y * v.y) + (v.z * v.z + v.w * v.w); }
            sq += __shfl_xor(sq, 16); sq += __shfl_xor(sq, 32);
            if (fq == 0) ss[(size_t)row * 16 + u.pn * 4 + wc] = sq;
#pragma unroll
            for (int k = 0; k < 4; ++k) rc[k] = rn[k];
        }
    }
};
struct EpiProj {
    static constexpr bool PERM = true;
    h16* mix; h16* kna; size_t bufstep; h16* lows; const float* ss;
    __device__ __forceinline__ void operator()(const Acc& acc, const Unit& u, int wr, int wc, int fr, int fq) const {
        const int pn = u.pn; h16* base; int ldc, c0; float sc = 1.f; int nbj = 2;
        if (pn < 2) { base = mix; ldc = 1024; c0 = pn * 256; sc = 0.125f; }
        else if (pn < 12) { base = kna + (size_t)((pn - 2) >> 1) * bufstep; ldc = 512; c0 = ((pn - 2) & 1) * 256; }
        else { base = lows; ldc = 384; c0 = (pn - 12) * 256; if (pn == 13) nbj = 1; }
        const int row0 = u.pm * BM + wr * 64 + fr, col0 = c0 + wc * 32 + 8 * fq;
        float rs8[2][4]; rows_rstd8(ss, row0, fq, rs8);
#pragma unroll
        for (int ai = 0; ai < 2; ++ai)
#pragma unroll
            for (int m = 0; m < 4; ++m) {
                const int row = row0 + ai * HALF + m * 16; const float rs = rs8[ai][m] * sc;
#pragma unroll
                for (int bj = 0; bj < 2; ++bj) if (bj < nbj) {
                    const f32x4 v0 = acc[ai][bj][m][0] * rs, v1 = acc[ai][bj][m][1] * rs;
                    u32x4 w; w.x = pk2h(v0.x, v0.y); w.y = pk2h(v0.z, v0.w); w.z = pk2h(v1.x, v1.y); w.w = pk2h(v1.z, v1.w);
                    *(u32x4*)(base + (size_t)row * ldc + col0 + bj * HALF) = w; }
            }
    }
};
struct EpiPU {
    static constexpr bool PERM = true;
    h16* O;
    __device__ __forceinline__ void operator()(const Acc& acc, const Unit& u, int wr, int wc, int fr, int fq) const {
        const int row0 = u.pm * BM + wr * 64 + fr, col0 = u.pn * BM + wc * 32 + 8 * fq;
#pragma unroll
        for (int ai = 0; ai < 2; ++ai)
#pragma unroll
            for (int m = 0; m < 4; ++m) {
                const int row = row0 + ai * HALF + m * 16;
#pragma unroll
                for (int bj = 0; bj < 2; ++bj) {
                    const f32x4 v0 = acc[ai][bj][m][0], v1 = acc[ai][bj][m][1];
                    u32x4 w; w.x = pk2h(v0.x, v0.y); w.y = pk2h(v0.z, v0.w); w.z = pk2h(v1.x, v1.y); w.w = pk2h(v1.z, v1.w);
                    *(u32x4*)(O + (size_t)row * D + col0 + bj * HALF) = w; }
            }
    }
};
struct EpiPle {
    static constexpr bool PERM = false;
    float* out; h16* o16; float* ssw; const float* ssr; const h16* pu;
    __device__ __forceinline__ void operator()(const Acc& acc, const Unit& u, int wr, int wc, int fr, int fq) const {
        const int row0 = u.pm * BM + wr * 64 + fr, col0 = u.pn * BM + wc * 32 + 4 * fq;
        float rs8[2][4]; rows_rstd8(ssr, row0, fq, rs8);
#pragma unroll
        for (int ai = 0; ai < 2; ++ai)
#pragma unroll
            for (int m = 0; m < 4; ++m) {
                const int row = row0 + ai * HALF + m * 16; const size_t off = (size_t)row * D + col0; float sq = 0.f; const float rs = rs8[ai][m];
#pragma unroll
                for (int bj = 0; bj < 2; ++bj)
#pragma unroll
                    for (int n = 0; n < 2; ++n) { const size_t o = off + bj * HALF + n * 16; const f32x4 r = *(const f32x4*)(out + o); const h16x4 p = *(const h16x4*)(pu + o);
                        const f32x4 a = acc[ai][bj][m][n] * rs; f32x4 v;
                        v.x = r.x + sigmoidf_(a.x) * (float)p.x; v.y = r.y + sigmoidf_(a.y) * (float)p.y; v.z = r.z + sigmoidf_(a.z) * (float)p.z; v.w = r.w + sigmoidf_(a.w) * (float)p.w;
                        *(f32x4*)(out + o) = v; u32x2 w; w.x = pk2h(v.x, v.y); w.y = pk2h(v.z, v.w); *(u32x2*)(o16 + o) = w; sq += (v.x * v.x + v.y * v.y) + (v.z * v.z + v.w * v.w); }
                sq += __shfl_xor(sq, 16); sq += __shfl_xor(sq, 32);
                if (fq == 0) ssw[(size_t)row * 16 + u.pn * 4 + wc] = sq;
                asm volatile("" ::: "memory");
            }
    }
};
}

__device__ __forceinline__ void convert_matrix(const float* W, int K, int N, const float* gamma, h16* WT, int mode, LAS float* scr, int gw, int NGW, int lane) {
    const int nblk = N / 32, nitems = (K / 64) * nblk;
    for (int item = gw; item < nitems; item += NGW) {
        const int kb = item / nblk, nb = item % nblk, k0 = 64 * kb, n0 = 32 * nb;
        const int drow0 = (mode == 0) ? n0 : ((n0 >> 7) * 256 + (n0 & 127) + (mode == 2 ? 128 : 0));
#pragma unroll 8
        for (int i = 0; i < 32; ++i) { const int kk = 2 * i + (lane >> 5); float v = W[(size_t)(k0 + kk) * N + n0 + (lane & 31)]; if (gamma) v *= gamma[k0 + kk]; scr[kk * 33 + (lane & 31)] = v; }
        asm volatile("s_waitcnt lgkmcnt(0)" ::: "memory");
        const int c = lane & 7;
#pragma unroll
        for (int j = 0; j < 4; ++j) { const int n = (lane >> 3) + 8 * j; const LAS float* s = scr + (8 * c) * 33 + n;
            u32x4 o; o.x = pk2h(s[0 * 33], s[1 * 33]); o.y = pk2h(s[2 * 33], s[3 * 33]); o.z = pk2h(s[4 * 33], s[5 * 33]); o.w = pk2h(s[6 * 33], s[7 * 33]);
            *(u32x4*)(WT + (size_t)(drow0 + n) * K + k0 + 8 * c) = o; }
        asm volatile("s_waitcnt lgkmcnt(0)" ::: "memory");
    }
}

__device__ __forceinline__ void phase_convert(const Args& a, int layer, LAS unsigned char* lds, int tid, int lane, int wave, int bid, int G) {
    LAS float* scr = (LAS float*)(lds + wave * 16384);
    const int gw = bid * NWAVES + wave, NGW = G * NWAVES;
    h16* W = (h16*)(a.ws + WS_W);
    const size_t l = (size_t)layer;
    convert_matrix(a.in[I_F1G] + l * D * FF, D, FF, a.in[I_F1N] + l * D, W + W_FFN1U, 1, scr, gw, NGW, lane);
    convert_matrix(a.in[I_F1U] + l * D * FF, D, FF, a.in[I_F1N] + l * D, W + W_FFN1U, 2, scr, gw, NGW, lane);
    convert_matrix(a.in[I_F1D] + l * FF * D, FF, D, nullptr, W + W_FFN1D, 0, scr, gw, NGW, lane);
    convert_matrix(a.in[I_WIN] + l * D * 3456, D, 3456, a.in[I_MIXN] + l * D, W + W_IN, 0, scr, gw, NGW, lane);
    convert_matrix(a.in[I_WOUT] + l * D * D, D, D, nullptr, W + W_OUT, 0, scr, gw, NGW, lane);
    convert_matrix(a.in[I_F2G] + l * D * FF, D, FF, a.in[I_F2N] + l * D, W + W_FFN2U, 1, scr, gw, NGW, lane);
    convert_matrix(a.in[I_F2U] + l * D * FF, D, FF, a.in[I_F2N] + l * D, W + W_FFN2U, 2, scr, gw, NGW, lane);
    convert_matrix(a.in[I_F2D] + l * FF * D, FF, D, nullptr, W + W_FFN2D, 0, scr, gw, NGW, lane);
    convert_matrix(a.in[I_PLEG] + l * D * D, D, D, a.in[I_PLEN] + l * D, W + W_GATE, 0, scr, gw, NGW, lane);
    convert_matrix(a.in[I_PLEU] + l * PLE * D, PLE, D, nullptr, W + W_UP, 0, scr, gw, NGW, lane);
    { u32x4* z = (u32x4*)(W + W_IN + (size_t)3456 * 1024); const int n16 = 128 * 1024 * 2 / 16;
      for (int i = bid * NTHREADS + tid; i < n16; i += G * NTHREADS) z[i] = (u32x4){0u, 0u, 0u, 0u}; }
    if (layer == 0) {
        unsigned char* ws = a.ws; h16* Hp = GB_H16B(0); h16* Hs = GB_H16B(1); float* ss = (float*)(a.ws + WS_SSB);
        for (int m = gw; m < M; m += NGW) {
            h16* H = (m < MP) ? Hp : Hs;
            const float* xr = (m < MP) ? a.in[I_XP] + (size_t)m * D : a.in[I_XS] + (size_t)(m - MP) * D;
            const f32x4* x4 = (const f32x4*)xr + lane; float s = 0.f;
            u32x2* o = (u32x2*)(H + (size_t)m * D) + lane;
#pragma unroll
            for (int j = 0; j < 4; ++j) { const f32x4 v = x4[64 * j]; s += (v.x * v.x + v.y * v.y) + (v.z * v.z + v.w * v.w); u32x2 w; w.x = pk2h(v.x, v.y); w.y = pk2h(v.z, v.w); o[64 * j] = w; }
            s = wave_sum(s);
            if (lane < 16) ss[(size_t)m * 16 + lane] = (lane == 0) ? s : 0.f;
        }
    }
}

__device__ __forceinline__ void convert_p(const Args& a, int layer, int g, int nb, int cb, int tid) {
    unsigned char* ws = a.ws; const int rows = g ? MS : MP, row0 = g ? MP : 0;
    u32x2* o = (u32x2*)(GB_P16(g) + (size_t)row0 * PLE);
    const f32x4* p = (const f32x4*)((g ? a.in[I_PS] + (size_t)layer * MS * PLE : a.in[I_PP] + (size_t)layer * MP * PLE));
    const int N4 = rows * PLE / 4;
    for (int i = cb * NTHREADS + tid; i < N4; i += nb * NTHREADS) { const f32x4 v = p[i]; u32x2 w; w.x = pk2h(v.x, v.y); w.y = pk2h(v.z, v.w); o[i] = w; }
}

constexpr int NA_PITCH = 144;
constexpr int NA_VOFF = 512 * NA_PITCH;
constexpr int NA_PP = 67;
constexpr int NA_BTOFF = 2 * 512 * NA_PITCH;
__device__ __forceinline__ void na_item(const Args& a, int layer, int item, LAS unsigned char* lds, int tid, int lane, int wave) {
    int tok0, i, rows;
    if (item < 1024) { tok0 = (item >> 6) * TP; i = item & 63; rows = 64; } else { const int it2 = item - 1024; tok0 = MP + (it2 >> 8) * TS; i = it2 & 255; rows = 256; }
    int rs = i - 4; rs = rs < 0 ? 0 : (rs > rows - 8 ? rows - 8 : rs);
    unsigned char* ws = a.ws; const int g = item < 1024 ? 0 : 1;
    h16* MIX = GB_MIX(g); const h16* KNA = GB_KNA(g); const h16* VNA = GB_VNA(g);
    const float* rpb = a.in[I_RPB] + (size_t)layer * 8 * 15 * 31;
    const int wtok0 = tok0 + rs * 64;
    const int j = lane, aw = wave;
    const int tokq = tok0 + i * 64 + j;
    int cs = j - 8; cs = cs < 0 ? 0 : (cs > 48 ? 48 : cs);
    const int l31 = lane & 31, half = lane >> 5;
    LAS float* bt = (LAS float*)(lds + NA_BTOFF) + wave * 128;
    bt[lane] = 0.f; bt[64 + lane] = 0.f;
    u32x4 kreg[8], vreg[8];
    const size_t kvoff = (size_t)(wtok0 + (tid >> 3)) * 512 + (tid & 7) * 8;
#pragma unroll
    for (int it = 0; it < 8; ++it) { kreg[it] = *(const u32x4*)(KNA + kvoff + (size_t)it * (64 * 512)); vreg[it] = *(const u32x4*)(VNA + kvoff + (size_t)it * (64 * 512)); }
#pragma unroll 1
    for (int h = 0; h < 8; ++h) {
#pragma unroll
        for (int it = 0; it < 8; ++it) { const int key = (tid >> 3) + 64 * it, ch = tid & 7;
            *(LAS u32x4*)(lds + key * NA_PITCH + ch * 16) = kreg[it]; *(LAS u32x4*)(lds + NA_VOFF + key * NA_PITCH + ch * 16) = vreg[it]; }
        h16x8 qf[2][4];
#pragma unroll
        for (int nt = 0; nt < 2; ++nt)
#pragma unroll
            for (int ks = 0; ks < 4; ++ks) qf[nt][ks] = *(const h16x8*)(MIX + (size_t)(tok0 + i * 64 + l31 + 32 * nt) * 1024 + h * 64 + 16 * ks + 8 * half);
        if (lane < 31) bt[48 + lane] = rpb[((size_t)h * 15 + (rs + aw - i + 7)) * 31 + lane];
        __syncthreads();
        if (h + 1 < 8) {
#pragma unroll
            for (int it = 0; it < 8; ++it) { kreg[it] = *(const u32x4*)(KNA + kvoff + (size_t)it * (64 * 512) + (h + 1) * 64); vreg[it] = *(const u32x4*)(VNA + kvoff + (size_t)it * (64 * 512) + (h + 1) * 64); }
        }
        f32x16 acc[2][2];
#pragma unroll
        for (int mt = 0; mt < 2; ++mt)
#pragma unroll
            for (int nt = 0; nt < 2; ++nt)
#pragma unroll
                for (int r = 0; r < 16; ++r) acc[mt][nt][r] = 0.f;
#pragma unroll
        for (int mt = 0; mt < 2; ++mt)
#pragma unroll
            for (int ks = 0; ks < 4; ++ks) {
                const h16x8 kf = *(const LAS h16x8*)(lds + (aw * 64 + 32 * mt + l31) * NA_PITCH + (16 * ks + 8 * half) * 2);
                acc[mt][0] = __builtin_amdgcn_mfma_f32_32x32x16_f16(kf, qf[0][ks], acc[mt][0], 0, 0, 0);
                acc[mt][1] = __builtin_amdgcn_mfma_f32_32x32x16_f16(kf, qf[1][ks], acc[mt][1], 0, 0, 0);
            }
        float mxq[2], lq[2];
#pragma unroll
        for (int nt = 0; nt < 2; ++nt) {
            const int qc = l31 + 32 * nt; int csq = qc - 8; csq = csq < 0 ? 0 : (csq > 48 ? 48 : csq);
            const int dlt = 4 * half - csq;
            const LAS float* bq = bt + (48 + 15 + 4 * half - qc - 32);
            float m = -3.0e38f;
#pragma unroll
            for (int mt = 0; mt < 2; ++mt)
#pragma unroll
                for (int r = 0; r < 16; ++r) { const int kr = (r & 3) + 8 * (r >> 2) + 32 * mt;
                    const float sv = acc[mt][nt][r] + bq[32 + kr]; const bool ok = (unsigned)(dlt + kr) < 16u; const float sm = ok ? sv : -1.0e30f; acc[mt][nt][r] = sm; m = fmaxf(m, sm); }
            { const auto sw = __builtin_amdgcn_permlane32_swap(__builtin_bit_cast(unsigned, m), __builtin_bit_cast(unsigned, m), false, false); const unsigned s0 = sw[0], s1 = sw[1]; m = fmaxf(__builtin_bit_cast(float, s0), __builtin_bit_cast(float, s1)); }
            float l = 0.f;
#pragma unroll
            for (int mt = 0; mt < 2; ++mt)
#pragma unroll
                for (int r = 0; r < 16; ++r) { const float p = __expf(acc[mt][nt][r] - m); acc[mt][nt][r] = p; l += p; }
            { const auto sw = __builtin_amdgcn_permlane32_swap(__builtin_bit_cast(unsigned, l), __builtin_bit_cast(unsigned, l), false, false); const unsigned s0 = sw[0], s1 = sw[1]; l = __builtin_bit_cast(float, s0) + __builtin_bit_cast(float, s1); }
            mxq[nt] = m; lq[nt] = l;
        }
        h16x8 pf[2][2][2];
#pragma unroll
        for (int kt = 0; kt < 2; ++kt)
#pragma unroll
            for (int nt = 0; nt < 2; ++nt)
#pragma unroll
                for (int sx = 0; sx < 2; ++sx)
#pragma unroll
                    for (int e = 0; e < 8; ++e) pf[kt][nt][sx][e] = (h16)acc[kt][nt][8 * sx + e];
        f32x16 o[2][2];
#pragma unroll
        for (int dm = 0; dm < 2; ++dm)
#pragma unroll
            for (int nt = 0; nt < 2; ++nt)
#pragma unroll
                for (int r = 0; r < 16; ++r) o[dm][nt][r] = 0.f;
#pragma unroll
        for (int dm = 0; dm < 2; ++dm)
#pragma unroll
            for (int kt = 0; kt < 2; ++kt)
#pragma unroll
                for (int sx = 0; sx < 2; ++sx) {
                    h16x8 vf;
                    const LAS unsigned char* vb = lds + NA_VOFF + (aw * 64 + 32 * kt + 16 * sx + 4 * half) * NA_PITCH + (l31 + 32 * dm) * 2;
#pragma unroll
                    for (int e = 0; e < 8; ++e) vf[e] = *(const LAS h16*)(vb + ((e & 3) + 8 * (e >> 2)) * NA_PITCH);
                    o[dm][0] = __builtin_amdgcn_mfma_f32_32x32x16_f16(vf, pf[kt][0][sx], o[dm][0], 0, 0, 0);
                    o[dm][1] = __builtin_amdgcn_mfma_f32_32x32x16_f16(vf, pf[kt][1][sx], o[dm][1], 0, 0, 0);
                }
        __syncthreads();
#pragma unroll
        for (int nt = 0; nt < 2; ++nt) {
            LAS float* part = (LAS float*)lds + (size_t)(aw * 64 + l31 + 32 * nt) * NA_PP;
#pragma unroll
            for (int dm = 0; dm < 2; ++dm)
#pragma unroll
                for (int r = 0; r < 16; ++r) part[(r & 3) + 8 * (r >> 2) + 4 * half + 32 * dm] = o[dm][nt][r];
            if (half == 0) { part[64] = mxq[nt]; part[65] = lq[nt]; }
        }
        __syncthreads();
        {
            const int jq = tid & 63, e8 = tid >> 6;
            float mw[8], M_ = -3.0e38f;
#pragma unroll
            for (int w = 0; w < 8; ++w) { mw[w] = ((const LAS float*)lds)[(size_t)(w * 64 + jq) * NA_PP + 64]; M_ = fmaxf(M_, mw[w]); }
            float L = 0.f, ov[8];
#pragma unroll
            for (int e = 0; e < 8; ++e) ov[e] = 0.f;
#pragma unroll
            for (int w = 0; w < 8; ++w) { const float f = __expf(mw[w] - M_); const LAS float* pw = (const LAS float*)lds + (size_t)(w * 64 + jq) * NA_PP; L += f * pw[65];
#pragma unroll
                for (int e = 0; e < 8; ++e) ov[e] += f * pw[e8 * 8 + e]; }
            const float inv = 1.0f / L;
            u32x4 w4; w4.x = pk2h(ov[0] * inv, ov[1] * inv); w4.y = pk2h(ov[2] * inv, ov[3] * inv); w4.z = pk2h(ov[4] * inv, ov[5] * inv); w4.w = pk2h(ov[6] * inv, ov[7] * inv);
            *(u32x4*)(MIX + (size_t)(tok0 + i * 64 + jq) * 1024 + h * 64 + e8 * 8) = w4;
        }
        __syncthreads();
    }
}

__device__ __forceinline__ float shiftmix(const h16* base, size_t stride, int t, int T, float mu) {
    const float c = (float)base[0];
    const float p = (t > 0) ? (float)*(base - stride) : 0.f;
    const float n = (t < T - 1) ? (float)*(base + stride) : 0.f;
    return c + mu * (0.5f * (p + n) - c);
}
constexpr int SC_CH = 32;
constexpr int SC_OPB = SC_CH * 6 * 64 * 4;
constexpr int SC_YOFF = 2 * SC_OPB;
constexpr int SC_YB = SC_CH * 64 * 4;
constexpr int SC_XOFF = SC_YOFF + 2 * SC_YB;
constexpr int SC_ZOFF = SC_XOFF + 8192;
static_assert(SC_ZOFF + 4 * 4096 <= LDS_BYTES, "scan LDS");
__device__ __forceinline__ float wave_sum_fast(float v) {
    v = row16_sum(v);
    { const auto r = __builtin_amdgcn_permlane16_swap(__builtin_bit_cast(unsigned, v), __builtin_bit_cast(unsigned, v), false, false);
      const unsigned r0 = r[0], r1 = r[1]; v = __builtin_bit_cast(float, r0) + __builtin_bit_cast(float, r1); }
    { const auto r = __builtin_amdgcn_permlane32_swap(__builtin_bit_cast(unsigned, v), __builtin_bit_cast(unsigned, v), false, false);
      const unsigned r0 = r[0], r1 = r[1]; v = __builtin_bit_cast(float, r0) + __builtin_bit_cast(float, r1); }
    return v;
}
__device__ __forceinline__ float mix3(h16 p, h16 c, h16 n, float mu) { const float cf = (float)c; return cf + mu * (0.5f * ((float)p + (float)n) - cf); }
struct ScanWin { float r[10], k[10], v[10], wl[10], al[10]; };
struct ScanWinRaw { h16 r[10], k[10], v[10], wl[10], al[10]; };
__device__ __forceinline__ float mix3f(float p, float c, float n, float mu) { return c + mu * (0.5f * (p + n) - c); }
template <int R>
__device__ __forceinline__ void scan_flush(LAS unsigned char* lds, int cf, int pw, int lane, int d, int T, int tok0, int h, int rowbase, h16* Yf, h16* Yb) {
    const LAS float* yb = (const LAS float*)(lds + SC_YOFF + (cf & 1) * SC_YB);
    const int s = pw * 8 + (lane >> 3); const int g = cf * SC_CH + s; const int t = d ? (T - 1 - g) : g;
    if (R == 4) {
        const int r8 = (lane & 7) * 8;
        const f32x4 y0 = *(const LAS f32x4*)(yb + s * 64 + r8), y1 = *(const LAS f32x4*)(yb + s * 64 + r8 + 4);
        u32x4 w4; w4.x = pk2h(y0.x, y0.y); w4.y = pk2h(y0.z, y0.w); w4.z = pk2h(y1.x, y1.y); w4.w = pk2h(y1.z, y1.w);
        if (d == 0) *(u32x4*)(Yf + (size_t)(tok0 + t) * 1024 + 512 + h * 64 + r8) = w4; else *(u32x4*)(Yb + (size_t)(tok0 + t) * 512 + h * 64 + r8) = w4;
    } else {
        const int r4 = (lane & 7) * 4;
        const f32x4 y0 = *(const LAS f32x4*)(yb + s * 32 + r4);
        u32x2 w2; w2.x = pk2h(y0.x, y0.y); w2.y = pk2h(y0.z, y0.w);
        if (d == 0) *(u32x2*)(Yf + (size_t)(tok0 + t) * 1024 + 512 + h * 64 + rowbase + r4) = w2; else *(u32x2*)(Yb + (size_t)(tok0 + t) * 512 + h * 64 + rowbase + r4) = w2;
    }
}
template <int R>
__device__ __forceinline__ void scan_item(const Args& a, int layer, int q, int rowhalf, LAS unsigned char* lds, int tid, int lane, int wave) {
    int tok0, T, h, d;
    if (q < 32) { tok0 = MP + (q >> 4) * TS; T = TS; h = (q >> 1) & 7; d = q & 1; } else { const int q2 = q - 32; tok0 = (q2 >> 4) * TP; T = TP; h = (q2 >> 1) & 7; d = q2 & 1; }
    const int nch = T / SC_CH, rowbase = rowhalf * 16 * R;
    unsigned char* ws = a.ws; const int g = q < 32 ? 1 : 0;
    const h16* RR = GB_RR(g); const h16* RK = GB_RK(g); const h16* RV = GB_RV(g); const h16* LOWS = GB_LOWS(g);
    h16* Yf = GB_MIX(g); h16* Yb = GB_YB(g); float* BSC = GB_BSC(g);
    const size_t l = (size_t)layer;
    if (wave >= 4) {
        const int pw = wave - 4, j = lane, col = h * 64 + j;
        const float* mu = a.in[I_MU] + l * 1920;
        const float mu_r = mu[col], mu_k = mu[512 + col], mu_v = mu[1024 + col], mu_wl = mu[1536 + d * 64 + j], mu_al = mu[1536 + 128 + d * 64 + j];
        const float k_k = a.in[I_KK][l * 512 + col], k_a = a.in[I_KA][l * 512 + col], r_k = a.in[I_RK][l * 512 + col];
        const float w0 = a.in[I_W0][(l * 2 + d) * 512 + col], a0 = a.in[I_A0][(l * 2 + d) * 512 + col];
        h16x8 bw[4][2], ba[4][2];
        { const int n = lane & 15, kg = lane >> 4;
          const float* wu = a.in[I_WUP] + ((l * 2 + d) * 64 + 8 * kg) * 512 + h * 64 + n; const float* au = a.in[I_AUP] + ((l * 2 + d) * 64 + 8 * kg) * 512 + h * 64 + n;
#pragma unroll
          for (int ks = 0; ks < 2; ++ks) {
#pragma unroll
              for (int e = 0; e < 8; ++e) {
                  const float w_0 = wu[0], w_1 = wu[16], w_2 = wu[32], w_3 = wu[48], a_0 = au[0], a_1 = au[16], a_2 = au[32], a_3 = au[48];
                  wu += 512; au += 512; asm volatile("" : "+v"(wu), "+v"(au));
                  bw[0][ks][e] = (h16)w_0; bw[1][ks][e] = (h16)w_1; bw[2][ks][e] = (h16)w_2; bw[3][ks][e] = (h16)w_3;
                  ba[0][ks][e] = (h16)a_0; ba[1][ks][e] = (h16)a_1; ba[2][ks][e] = (h16)a_2; ba[3][ks][e] = (h16)a_3; }
              wu += 24 * 512; au += 24 * 512; asm volatile("" : "+v"(wu), "+v"(au)); } }
        LAS float* zl = (LAS float*)(lds + SC_ZOFF + pw * 4096);
        LAS unsigned char* xsb = lds + SC_XOFF + pw * 2048;
        ScanWin cur; ScanWinRaw nxt;
#define SCAN_LOAD_RAW(cp_) do { const int g0_ = (cp_) * SC_CH + pw * 8; \
            _Pragma("unroll") for (int w = 0; w < 10; ++w) { int tt = d ? (T - 1 - g0_) + 1 - w : g0_ - 1 + w; tt = tt < 0 ? 0 : (tt > T - 1 ? T - 1 : tt); const size_t tok = (size_t)(tok0 + tt); \
                nxt.r[w] = RR[tok * 512 + col]; nxt.k[w] = RK[tok * 512 + col]; nxt.v[w] = RV[tok * 512 + col]; nxt.wl[w] = LOWS[tok * 384 + d * 64 + j]; nxt.al[w] = LOWS[tok * 384 + 128 + d * 64 + j]; } } while (0)
#define SCAN_UNPACK(cp_) do { const int g0_ = (cp_) * SC_CH + pw * 8; \
            _Pragma("unroll") for (int w = 0; w < 10; ++w) { const int tt = d ? (T - 1 - g0_) + 1 - w : g0_ - 1 + w; const bool ok = (tt >= 0) && (tt < T); \
                cur.r[w] = ok ? (float)nxt.r[w] : 0.f; cur.k[w] = ok ? (float)nxt.k[w] : 0.f; cur.v[w] = ok ? (float)nxt.v[w] : 0.f; cur.wl[w] = ok ? (float)nxt.wl[w] : 0.f; cur.al[w] = ok ? (float)nxt.al[w] : 0.f; } } while (0)
        SCAN_LOAD_RAW(0); SCAN_UNPACK(0);
        for (int c = -1; c < nch; ++c) {
            if (c >= 1) scan_flush<R>(lds, c - 1, pw, lane, d, T, tok0, h, rowbase, Yf, Yb);
            if (c + 1 < nch) {
                const int cp = c + 1; LAS float* op = (LAS float*)(lds + (cp & 1) * SC_OPB);
                if (c + 2 < nch) SCAN_LOAD_RAW(c + 2);
                float bsv = 0.f;
#pragma unroll
                for (int s8 = 0; s8 < 8; ++s8) {
                    const float wl = mix3f(cur.wl[s8], cur.wl[s8 + 1], cur.wl[s8 + 2], mu_wl);
                    const float al = mix3f(cur.al[s8], cur.al[s8 + 1], cur.al[s8 + 2], mu_al);
                    const float e2 = __expf(2.0f * wl); const float th = 1.0f - 2.0f * __builtin_amdgcn_rcpf(e2 + 1.0f);
                    LAS h16* xs = (LAS h16*)(xsb + s8 * 256);
                    xs[j] = (h16)th; xs[64 + j] = (h16)al;
                }
                {
                    const LAS unsigned char* xr = xsb + (lane & 7) * 256 + (lane >> 4) * 16;
                    const h16x8 xw0 = *(const LAS h16x8a*)(xr), xw1 = *(const LAS h16x8a*)(xr + 64), xa0 = *(const LAS h16x8a*)(xr + 128), xa1 = *(const LAS h16x8a*)(xr + 192);
                    f32x4 accw[4], acca[4];
#pragma unroll
                    for (int nt = 0; nt < 4; ++nt) {
                        accw[nt] = __builtin_amdgcn_mfma_f32_16x16x32_f16(xw0, bw[nt][0], (f32x4){0.f, 0.f, 0.f, 0.f}, 0, 0, 0);
                        accw[nt] = __builtin_amdgcn_mfma_f32_16x16x32_f16(xw1, bw[nt][1], accw[nt], 0, 0, 0);
                        acca[nt] = __builtin_amdgcn_mfma_f32_16x16x32_f16(xa0, ba[nt][0], (f32x4){0.f, 0.f, 0.f, 0.f}, 0, 0, 0);
                        acca[nt] = __builtin_amdgcn_mfma_f32_16x16x32_f16(xa1, ba[nt][1], acca[nt], 0, 0, 0); }
                    if (lane < 32) {
                        LAS float* zw = zl + (4 * (lane >> 4)) * 64 + (lane & 15);
#pragma unroll
                        for (int nt = 0; nt < 4; ++nt)
#pragma unroll
                            for (int r = 0; r < 4; ++r) { zw[r * 64 + 16 * nt] = accw[nt][r]; zw[512 + r * 64 + 16 * nt] = acca[nt][r]; }
                    }
                }
#pragma unroll
                for (int s8 = 0; s8 < 8; ++s8) {
                    const int s = pw * 8 + s8; const int g = cp * SC_CH + s; const int t = d ? (T - 1 - g) : g; const size_t tok = (size_t)(tok0 + t);
                    const float rr = mix3f(cur.r[s8], cur.r[s8 + 1], cur.r[s8 + 2], mu_r);
                    const float kk0 = mix3f(cur.k[s8], cur.k[s8 + 1], cur.k[s8 + 2], mu_k);
                    const float vv = mix3f(cur.v[s8], cur.v[s8 + 1], cur.v[s8 + 2], mu_v);
                    const float z = w0 + zl[s8 * 64 + j], az = a0 + zl[512 + s8 * 64 + j];
                    const float wdec = __expf(-0.606531f * sigmoidf_(z)); const float av = sigmoidf_(az);
                    float kk = kk0 * k_k; const float n2 = wave_sum_fast(kk * kk); kk = kk * __builtin_amdgcn_rsqf(fmaxf(n2, 1e-24f));
                    const float kd = kk0 * (1.0f + (av - 1.0f) * k_a); const float bb = kk * av;
                    const float bs = wave_sum_fast(rr * kd * r_k);
                    bsv = (lane == s8) ? bs : bsv;
                    LAS float* o = op + s * 384 + j;
                    o[0] = -kk; o[64] = wdec; o[128] = bb; o[192] = kd; o[256] = rr; o[320] = vv;
                }
                if (lane < 8 && rowhalf == 0) { const int gs = cp * SC_CH + pw * 8 + lane; const int t = d ? (T - 1 - gs) : gs; BSC[((size_t)(tok0 + t) * 8 + h) * 2 + d] = bsv; }
                if (c + 2 < nch) SCAN_UNPACK(c + 2);
            }
            __syncthreads();
        }
        scan_flush<R>(lds, nch - 1, pw, lane, d, T, tok0, h, rowbase, Yf, Yb);
#undef SCAN_LOAD_RAW
#undef SCAN_UNPACK
    } else {
        constexpr int RL = R / 2;
        const int ri = lane >> 3, ci = lane & 7;
        const int yrow = wave * 8 * RL + ri * RL, vrow = rowbase + yrow;
        f32x2 S[RL][4];
#pragma unroll
        for (int i = 0; i < RL; ++i)
#pragma unroll
            for (int c2 = 0; c2 < 4; ++c2) S[i][c2] = (f32x2){0.f, 0.f};
        typedef float vecR __attribute__((ext_vector_type(RL)));
        __syncthreads();
        for (int c = 0; c < nch; ++c) {
            const LAS f32x4* op = (const LAS f32x4*)(lds + (c & 1) * SC_OPB);
            LAS float* yb = (LAS float*)(lds + SC_YOFF + (c & 1) * SC_YB);
            f32x4 a0 = op[2 * ci], a1 = op[2 * ci + 1], w0 = op[16 + 2 * ci], w1 = op[17 + 2 * ci], b0 = op[32 + 2 * ci], b1 = op[33 + 2 * ci];
            f32x4 k0 = op[48 + 2 * ci], k1 = op[49 + 2 * ci], r0 = op[64 + 2 * ci], r1 = op[65 + 2 * ci]; vecR v4 = *(const LAS vecR*)((const LAS float*)op + 320 + vrow);
#pragma unroll 4
            for (int s = 0; s < SC_CH; ++s) {
                const LAS f32x4* on = op + (s + 1) * 96;
                const f32x4 na0 = on[2 * ci], na1 = on[2 * ci + 1], nw0 = on[16 + 2 * ci], nw1 = on[17 + 2 * ci], nb0 = on[32 + 2 * ci], nb1 = on[33 + 2 * ci];
                const f32x4 nk0 = on[48 + 2 * ci], nk1 = on[49 + 2 * ci], nr0 = on[64 + 2 * ci], nr1 = on[65 + 2 * ci]; const vecR nv4 = *(const LAS vecR*)((const LAS float*)on + 320 + vrow);
                const f32x2 av[4] = {{a0.x, a0.y}, {a0.z, a0.w}, {a1.x, a1.y}, {a1.z, a1.w}}, wv[4] = {{w0.x, w0.y}, {w0.z, w0.w}, {w1.x, w1.y}, {w1.z, w1.w}};
                const f32x2 bv[4] = {{b0.x, b0.y}, {b0.z, b0.w}, {b1.x, b1.y}, {b1.z, b1.w}}, kv[4] = {{k0.x, k0.y}, {k0.z, k0.w}, {k1.x, k1.y}, {k1.z, k1.w}};
                const f32x2 rv[4] = {{r0.x, r0.y}, {r0.z, r0.w}, {r1.x, r1.y}, {r1.z, r1.w}};
                float sa[RL];
#pragma unroll
                for (int i = 0; i < RL; ++i) { f32x2 p = S[i][0] * av[0]; p = S[i][1] * av[1] + p; p = S[i][2] * av[2] + p; p = S[i][3] * av[3] + p;
                    float t = p.x + p.y; t += dpp_f<0xB1>(t); t += dpp_f<0x4E>(t); t += dpp_f<0x141>(t); sa[i] = t; }
                vecR y;
#pragma unroll
                for (int i = 0; i < RL; ++i) { const f32x2 sa2 = {sa[i], sa[i]}, v2 = {v4[i], v4[i]};
#pragma unroll
                    for (int c2 = 0; c2 < 4; ++c2) S[i][c2] = S[i][c2] * wv[c2] + sa2 * bv[c2] + v2 * kv[c2];
                    f32x2 p = S[i][0] * rv[0]; p = S[i][1] * rv[1] + p; p = S[i][2] * rv[2] + p; p = S[i][3] * rv[3] + p;
                    float t = p.x + p.y; t += dpp_f<0xB1>(t); t += dpp_f<0x4E>(t); t += dpp_f<0x141>(t); y[i] = t; }
                if (ci == 0) *(LAS vecR*)(yb + s * (32 * RL) + yrow) = y;
                a0 = na0; a1 = na1; w0 = nw0; w1 = nw1; b0 = nb0; b1 = nb1; k0 = nk0; k1 = nk1; r0 = nr0; r1 = nr1; v4 = nv4;
            }
            __syncthreads();
        }
    }
}

__device__ __forceinline__ void rwpost_tile(const Args& a, int layer, int tile, LAS unsigned char* lds, int tid, int lane, int wave, const h16x8 (&bg)[4][4]) {
    const size_t l = (size_t)layer; const int h = wave, n16 = lane & 15, g4 = lane >> 4;
    const int m0 = tile * 64; int tok0s, T; if (m0 < MP) { T = TP; tok0s = (m0 / TP) * TP; } else { T = TS; tok0s = MP + ((m0 - MP) / TS) * TS; }
    unsigned char* ws = a.ws; const int g = m0 < MP ? 0 : 1;
    const h16* LOWS = GB_LOWS(g); const h16* RV = GB_RV(g); h16* MIX = GB_MIX(g); const h16* Yb = GB_YB(g); const float* BSC = GB_BSC(g);
    const float* mu = a.in[I_MU] + l * 1920;
    LAS h16* G = (LAS h16*)lds;
    { const int c = tid & 127; const float mug = mu[1536 + 256 + c];
#pragma unroll 8
      for (int e = tid; e < 64 * 128; e += NTHREADS) { const int tk = e >> 7; const int m = m0 + tk; const int t = m - tok0s;
        const float gl = shiftmix(LOWS + (size_t)m * 384 + 256 + c, 384, t, T, mug); G[e] = (h16)sigmoidf_(gl); } }
    float muv[4], lw[4], lb[4];
#pragma unroll
    for (int nt = 0; nt < 4; ++nt) { const int col = wave * 64 + 16 * nt + n16; muv[nt] = mu[1024 + col]; lw[nt] = a.in[I_LNW][l * 512 + col]; lb[nt] = a.in[I_LNB][l * 512 + col]; }
    __syncthreads();
#pragma unroll 1
    for (int mt = 0; mt < 4; ++mt) {
        const int tk0 = 16 * mt + 4 * g4;
        h16 ym[4][4], yb[4][4], rv[6][4]; float b0[4], b1[4];
#pragma unroll
        for (int w = 0; w < 6; ++w) { const int m = m0 + tk0 - 1 + w; const int t = m - tok0s; const bool ok = (t >= 0) && (t < T);
#pragma unroll
            for (int nt = 0; nt < 4; ++nt) { const h16 v = RV[(size_t)(ok ? m : m0) * 512 + wave * 64 + 16 * nt + n16]; rv[w][nt] = ok ? v : (h16)0.f; } }
#pragma unroll
        for (int r = 0; r < 4; ++r) { const size_t m = (size_t)(m0 + tk0 + r); b0[r] = BSC[(m * 8 + h) * 2]; b1[r] = BSC[(m * 8 + h) * 2 + 1];
#pragma unroll
            for (int nt = 0; nt < 4; ++nt) { const int col = wave * 64 + 16 * nt + n16; ym[r][nt] = MIX[m * 1024 + 512 + col]; yb[r][nt] = Yb[m * 512 + col]; } }
        f32x4 acc[4];
#pragma unroll
        for (int nt = 0; nt < 4; ++nt) acc[nt] = (f32x4){0.f, 0.f, 0.f, 0.f};
#pragma unroll
        for (int ks = 0; ks < 4; ++ks) {
            const h16x8 af = *(const LAS h16x8a*)((const LAS unsigned char*)G + (16 * mt + n16) * 256 + (32 * ks + 8 * g4) * 2);
#pragma unroll
            for (int nt = 0; nt < 4; ++nt) acc[nt] = __builtin_amdgcn_mfma_f32_16x16x32_f16(af, bg[nt][ks], acc[nt], 0, 0, 0);
        }
#pragma unroll
        for (int r = 0; r < 4; ++r) {
            const size_t m = (size_t)(m0 + tk0 + r);
            float wkv[4]; float sm = 0.f;
#pragma unroll
            for (int nt = 0; nt < 4; ++nt) { wkv[nt] = (float)ym[r][nt] + (float)yb[r][nt]; sm += wkv[nt]; }
            const float mean = row16_sum(sm) * (1.0f / 64.0f); float sq = 0.f;
#pragma unroll
            for (int nt = 0; nt < 4; ++nt) { wkv[nt] -= mean; sq += wkv[nt] * wkv[nt]; }
            const float rstd = __builtin_amdgcn_rsqf(row16_sum(sq) * (1.0f / 64.0f) + 64e-5f); const float bsum = b0[r] + b1[r];
#pragma unroll
            for (int nt = 0; nt < 4; ++nt) { const float yn = wkv[nt] * rstd * lw[nt] + lb[nt]; const float vv = mix3(rv[r][nt], rv[r + 1][nt], rv[r + 2][nt], muv[nt]);
                MIX[m * 1024 + 512 + wave * 64 + 16 * nt + n16] = (h16)((yn + bsum * vv) * acc[nt][r]); }
        }
    }
    __syncthreads();
}

#define STAGE_ARGS const Args& args, int layer, int g, int nb, int cb, LAS unsigned char* lds
#define FRESH_TID int tid = threadIdx.x; asm volatile("" : "+v"(tid)); const int lane = tid & 63, wave = __builtin_amdgcn_readfirstlane(tid >> 6); (void)lane; (void)wave;
__device__ __forceinline__ int g_rows(int g) { return g ? MS : MP; }
__device__ __forceinline__ int g_pm0(int g) { return g ? MP / 256 : 0; }
template <class Epi> __device__ __forceinline__ void run_gemm(LAS unsigned char* lds, const h16* A, int lda, const h16* Bt, int N, int K, int g, int nb, int cb, const Epi& E, int tid) {
    pg8::Gemm gm{A, Bt, g_rows(g), N, K, lda}; pg8::StaticOrder S; S.init(g_rows(g), N, nb, cb, g_pm0(g)); pg8::gemm_phase(lds, gm, S, E, tid);
}
__device__ __forceinline__ void st_ffn_up(STAGE_ARGS, int which) {
    FRESH_TID unsigned char* ws = args.ws; const h16* W = (const h16*)(ws + WS_W);
    pg8::EpiSwiglu E{GB_ACT(g), (const float*)(ws + (which ? WS_SSA : WS_SSB))};
    run_gemm(lds, which ? GB_H16(g) : GB_H16B(g), D, W + (which ? W_FFN2U : W_FFN1U), 2 * FF, D, g, nb, cb, E, tid);
}
__device__ __forceinline__ void st_ffn_down(STAGE_ARGS, int which) {
    FRESH_TID unsigned char* ws = args.ws; const h16* W = (const h16*)(ws + WS_W); float* out = args.out;
    const bool first = (which == 0 && layer == 0);
    const float* rp = first ? args.in[I_XP] : (const float*)out; const float* rsm = first ? args.in[I_XS] - (size_t)MP * D : (const float*)out;
    pg8::EpiResid E{rp, rsm, out, GB_H16(g), (float*)(ws + WS_SSA), 0.5f};
    run_gemm(lds, GB_ACT(g), FF, W + (which ? W_FFN2D : W_FFN1D), D, FF, g, nb, cb, E, tid);
}
__device__ __forceinline__ void st_win(STAGE_ARGS) {
    FRESH_TID unsigned char* ws = args.ws; const h16* W = (const h16*)(ws + WS_W);
    pg8::EpiProj E{GB_MIX(g), GB_KNA(g), (size_t)512 * g_rows(g), GB_LOWS(g), (const float*)(ws + WS_SSA)};
    run_gemm(lds, GB_H16(g), D, W + W_IN, NPROJ, D, g, nb, cb, E, tid);
}
__device__ __forceinline__ void st_wout(STAGE_ARGS) {
    FRESH_TID unsigned char* ws = args.ws; const h16* W = (const h16*)(ws + WS_W); float* out = args.out;
    pg8::EpiResid E{out, out, out, GB_H16(g), (float*)(ws + WS_SSA), 1.0f};
    run_gemm(lds, GB_MIX(g), D, W + W_OUT, D, D, g, nb, cb, E, tid);
}
__device__ __forceinline__ void st_pu(STAGE_ARGS) {
    FRESH_TID unsigned char* ws = args.ws; const h16* W = (const h16*)(ws + WS_W);
    int kpu = PLE; asm volatile("" : "+s"(kpu));
    pg8::EpiPU E{GB_PU(g)};
    run_gemm(lds, GB_P16(g), kpu, W + W_UP, D, kpu, g, nb, cb, E, tid);
}
__device__ __forceinline__ void st_ple(STAGE_ARGS) {
    FRESH_TID unsigned char* ws = args.ws; const h16* W = (const h16*)(ws + WS_W); float* out = args.out;
    pg8::EpiPle E{out, GB_H16B(g), (float*)(ws + WS_SSB), (const float*)(ws + WS_SSA), GB_PU(g)};
    run_gemm(lds, GB_H16(g), D, W + W_GATE, D, D, g, nb, cb, E, tid);
}
__device__ __forceinline__ void st_rwpost(STAGE_ARGS) {
    FRESH_TID const int t0 = g ? MP / 64 : 0, nt_ = g_rows(g) / 64;
    h16x8 bg[4][4];
    { const float* gu = args.in[I_GUP] + (size_t)layer * 128 * 512 + (size_t)(8 * (lane >> 4)) * 512 + wave * 64 + (lane & 15);
#pragma unroll
      for (int ks = 0; ks < 4; ++ks) {
#pragma unroll
          for (int e = 0; e < 8; ++e) { const float g_0 = gu[0], g_1 = gu[16], g_2 = gu[32], g_3 = gu[48]; gu += 512; asm volatile("" : "+v"(gu));
              bg[0][ks][e] = (h16)g_0; bg[1][ks][e] = (h16)g_1; bg[2][ks][e] = (h16)g_2; bg[3][ks][e] = (h16)g_3; }
          gu += 24 * 512; asm volatile("" : "+v"(gu)); } }
    for (int tile = cb; tile < nt_; tile += nb) rwpost_tile(args, layer, t0 + tile, lds, tid, lane, wave, bg);
}
__device__ __forceinline__ void st_convp(STAGE_ARGS) { FRESH_TID convert_p(args, layer, g, nb, cb, tid); }

__device__ __forceinline__ void sub_sync(unsigned* ctr, unsigned target) {
    asm volatile("s_waitcnt vmcnt(0) lgkmcnt(0)" ::: "memory");
    __syncthreads();
    if (threadIdx.x == 0) {
        __builtin_amdgcn_fence(__ATOMIC_RELEASE, "agent"); asm volatile("s_waitcnt vmcnt(0)" ::: "memory");
        __hip_atomic_fetch_add(ctr, 1u, __ATOMIC_RELAXED, __HIP_MEMORY_SCOPE_AGENT);
        while (__hip_atomic_load(ctr, __ATOMIC_RELAXED, __HIP_MEMORY_SCOPE_AGENT) < target) __builtin_amdgcn_s_sleep(2);
    }
    __syncthreads();
    __builtin_amdgcn_fence(__ATOMIC_ACQUIRE, "agent"); asm volatile("s_waitcnt vmcnt(0)" ::: "memory");
}

constexpr int NSB = 32;
__global__ void __launch_bounds__(NTHREADS, 2) fwd_megakernel(Args args) {
    extern __shared__ __attribute__((aligned(16))) unsigned char lds_raw[];
    LAS unsigned char* lds = (LAS unsigned char*)lds_raw;
    cg::grid_group grid = cg::this_grid();
    const int bid = blockIdx.x, G = gridDim.x;
    const int NPB = G - NSB, pb = bid - NSB;
    unsigned* ctr = (unsigned*)(args.ws + WS_CTR);
    if (bid == 0 && threadIdx.x == 0) __hip_atomic_store(ctr, 0u, __ATOMIC_RELAXED, __HIP_MEMORY_SCOPE_AGENT);
    unsigned sbt = 0;
#define SUBSYNC() do { sbt += (unsigned)NPB; sub_sync(ctr, sbt); } while (0)

    for (int layer = 0; layer < 2; ++layer) {
        { FRESH_TID phase_convert(args, layer, lds, tid, lane, wave, bid, G); }
        grid_sync(grid);
        st_ffn_up(args, layer, 1, G, bid, lds, 0); grid_sync(grid);
        st_ffn_down(args, layer, 1, G, bid, lds, 0); grid_sync(grid);
        st_win(args, layer, 1, G, bid, lds); grid_sync(grid);
        if (bid < NSB) {
            FRESH_TID scan_item<4>(args, layer, bid, 0, lds, tid, lane, wave);
        } else {
            st_ffn_up(args, layer, 0, NPB, pb, lds, 0); SUBSYNC();
            st_ffn_down(args, layer, 0, NPB, pb, lds, 0); SUBSYNC();
            st_win(args, layer, 0, NPB, pb, lds); SUBSYNC();
            { FRESH_TID
              scan_item<4>(args, layer, 32 + pb, 0, lds, tid, lane, wave); __syncthreads();
              if (pb < 2 * (256 - NPB)) { scan_item<2>(args, layer, 32 + NPB + (pb >> 1), pb & 1, lds, tid, lane, wave); __syncthreads(); }
              else { for (int it = pb - 2 * (256 - NPB); it < 1536; it += NPB - 2 * (256 - NPB)) na_item(args, layer, it, lds, tid, lane, wave); } }
            SUBSYNC();
            st_rwpost(args, layer, 0, NPB, pb, lds); SUBSYNC();
            st_wout(args, layer, 0, NPB, pb, lds); SUBSYNC();
            st_ffn_up(args, layer, 0, NPB, pb, lds, 1);
        }
        grid_sync(grid);
        st_rwpost(args, layer, 1, G, bid, lds); st_ffn_down(args, layer, 0, G, bid, lds, 1); st_convp(args, layer, 0, G, bid, lds); grid_sync(grid);
        st_wout(args, layer, 1, G, bid, lds); st_pu(args, layer, 0, G, bid, lds); grid_sync(grid);
        st_ffn_up(args, layer, 1, G, bid, lds, 1); st_ple(args, layer, 0, G, bid, lds); grid_sync(grid);
        st_ffn_down(args, layer, 1, G, bid, lds, 1); st_convp(args, layer, 1, G, bid, lds); grid_sync(grid);
        st_pu(args, layer, 1, G, bid, lds); grid_sync(grid);
        st_ple(args, layer, 1, G, bid, lds); grid_sync(grid);
    }
    {
        FRESH_TID
        const float* SSB = (const float*)(args.ws + WS_SSB); float* out = args.out;
        const int gw = bid * NWAVES + wave, NGW = G * NWAVES; const f32x4* gm = (const f32x4*)args.in[I_FINAL] + lane;
        f32x4 gv[4];
#pragma unroll
        for (int j = 0; j < 4; ++j) gv[j] = gm[64 * j];
        for (int m = gw; m < M; m += 2 * NGW) {
            const int m2 = m + NGW;
            const float rs = row_rstd(SSB, m), rs2 = row_rstd(SSB, m2); f32x4* o = (f32x4*)(out + (size_t)m * D) + lane; f32x4* o2 = (f32x4*)(out + (size_t)m2 * D) + lane;
            f32x4 v[4], v2[4];
#pragma unroll
            for (int j = 0; j < 4; ++j) { v[j] = o[64 * j]; v2[j] = o2[64 * j]; }
#pragma unroll
            for (int j = 0; j < 4; ++j) { o[64 * j] = v[j] * rs * gv[j]; o2[64 * j] = v2[j] * rs2 * gv[j]; }
        }
    }
}

extern "C" void kernel_launch(void* const* d_in, const int* in_sizes, int n_in, void* d_out, int out_size, void* d_ws, size_t ws_size, hipStream_t stream) {
    static int grid = 0;
    if (grid == 0) {
        if (n_in != N_IN || out_size != M * D || ws_size < WS_END) { fprintf(stderr, "kernel_launch: unexpected shapes (n_in %d, out %d, ws %zu)\n", n_in, out_size, ws_size); grid = -1; return; }
        int dev = 0, cus = 0, per_cu = 0;
        (void)hipGetDevice(&dev); (void)hipDeviceGetAttribute(&cus, hipDeviceAttributeMultiprocessorCount, dev);
        (void)hipFuncSetAttribute((const void*)fwd_megakernel, hipFuncAttributeMaxDynamicSharedMemorySize, LDS_BYTES);
        (void)hipOccupancyMaxActiveBlocksPerMultiprocessor(&per_cu, (const void*)fwd_megakernel, NTHREADS, LDS_BYTES);
        if (per_cu < 1) fprintf(stderr, "kernel_launch: occupancy query says %d blocks per CU\n", per_cu);
        grid = cus;
        if (grid != 256) fprintf(stderr, "kernel_launch: grid %d (expected 256)\n", grid);
        if (grid <= NSB + 64) { fprintf(stderr, "kernel_launch: grid too small\n"); grid = -1; return; }
    }
    if (grid < 0) return;
    Args a{};
    for (int i = 0; i < N_IN; ++i) a.in[i] = (const float*)d_in[i];
    a.out = (float*)d_out; a.ws = (unsigned char*)d_ws;
    void* kargs[] = {&a};
    hipError_t e = hipLaunchCooperativeKernel((const void*)fwd_megakernel, dim3(grid), dim3(NTHREADS), kargs, LDS_BYTES, stream);
    if (e != hipSuccess) fprintf(stderr, "kernel_launch: cooperative launch failed: %s\n", hipGetErrorString(e));
}
```
